# Optimizing an MI355X kernel written in HIP

```python
import math
import jax, jax.numpy as jnp
from jax import lax
import numpy as np

D_MODEL = 1024
BATCH = 32
SEQ = 256
DEPTH = 4
DEC_BATCH = 4
DEC_SEQ = 2048
PAST_LEN = 512

GRID_W = 64
NA_HEADS = 8
NA_DH = 64
NA_ROWS = 8
NA_COLS = 16
NA_QCOL_BLOCK = 16
NA_KCOL_BLOCK = 32
DIFF_HEADS = 4
DIFF_DH = 64
RET_HEADS = 8
RET_DH = 64
RET_CHUNK = 128
LRU_WIDTH = 512
LRU_BLOCKS = 8
LRU_CONV = 4
LRU_C = 8.0
N_BRANCH = 4
BRANCH_W = 512
D_FF = 4 * D_MODEL
ROPE_BASE = 10000.0
QUERY_BLOCK = 128
EPS = 1e-6
NEG_INF = -1e30

NA_W = NA_HEADS * NA_DH
DIFF_QK_W = 2 * DIFF_HEADS * DIFF_DH
DIFF_V_W = DIFF_HEADS * 2 * DIFF_DH
RET_W = RET_HEADS * RET_DH
IN_WIDTHS = (NA_W, NA_W, NA_W, DIFF_QK_W, DIFF_QK_W, DIFF_V_W, RET_W, RET_W, RET_W, RET_W, LRU_WIDTH, LRU_WIDTH, N_BRANCH * D_MODEL)
IN_WIDTH = sum(IN_WIDTHS)

kernel_name = "hybrid_flow_backbone_ctx_prefix_step"


def rmsnorm(x, g):
    xf = x.astype(jnp.float32)
    y = xf * lax.rsqrt(jnp.mean(jnp.square(xf), axis=-1, keepdims=True) + EPS)
    return (y * g.astype(jnp.float32)).astype(x.dtype)


def modulation(cond, ada_w, ada_b):
    m = jax.nn.silu(cond) @ ada_w + ada_b
    return [part[:, None, :] for part in jnp.split(m, 6, axis=-1)]


def split_cols(z):
    outs = []
    start = 0
    for w in IN_WIDTHS:
        outs.append(z[..., start:start + w])
        start += w
    return outs


def split_heads(z, n_heads):
    b, t, _ = z.shape
    return z.reshape(b, t, n_heads, -1).transpose(0, 2, 1, 3)


def merge_heads(z):
    b, h, t, d = z.shape
    return z.transpose(0, 2, 1, 3).reshape(b, t, h * d)


def diff_qk_heads(z):
    b, t, _ = z.shape
    return z.reshape(b, t, 2, DIFF_HEADS, DIFF_DH).transpose(0, 2, 3, 1, 4)


def axial_angles(n, dim):
    t = jnp.arange(n)
    quarter = dim // 4
    inv = ROPE_BASE ** (-jnp.arange(quarter, dtype=jnp.float32) / quarter)
    ang_r = (t // GRID_W).astype(jnp.float32)[:, None] * inv
    ang_c = (t % GRID_W).astype(jnp.float32)[:, None] * inv
    return ang_r, ang_c


def rotate(x, ang):
    x1, x2 = jnp.split(x, 2, axis=-1)
    cos = jnp.cos(ang).astype(x.dtype)
    sin = jnp.sin(ang).astype(x.dtype)
    return jnp.concatenate([x1 * cos - x2 * sin, x2 * cos + x1 * sin], axis=-1)


def axial_rope(x, ang_r, ang_c):
    xr, xc = jnp.split(x, 2, axis=-1)
    return jnp.concatenate([rotate(xr, ang_r), rotate(xc, ang_c)], axis=-1)


def dense_attention(q, k, v):
    b, h, nq, d = q.shape
    nb = nq // QUERY_BLOCK
    scale = d ** -0.5
    qb = q.reshape(b, h, nb, QUERY_BLOCK, d).transpose(2, 0, 1, 3, 4)

    def one_block(qi):
        s = jnp.einsum('bhqd,bhkd->bhqk', qi, k).astype(jnp.float32) * scale
        p = jax.nn.softmax(s, axis=-1).astype(v.dtype)
        return jnp.einsum('bhqk,bhkd->bhqd', p, v)

    o = lax.map(one_block, qb)
    return o.transpose(1, 2, 0, 3, 4).reshape(b, h, nq, d)


def diff_attention(q, k, v, lam):
    b, _, h, nq, d = q.shape
    nb = nq // QUERY_BLOCK
    scale = d ** -0.5
    qb = q.reshape(b, 2, h, nb, QUERY_BLOCK, d).transpose(3, 0, 1, 2, 4, 5)

    def one_block(qi):
        s = jnp.einsum('bchqd,bchkd->bchqk', qi, k).astype(jnp.float32) * scale
        p = jax.nn.softmax(s, axis=-1)
        a = (p[:, 0] - lam * p[:, 1]).astype(v.dtype)
        return jnp.einsum('bhqk,bhkd->bhqd', a, v)

    o = lax.map(one_block, qb)
    return o.transpose(1, 2, 0, 3, 4).reshape(b, h, nq, v.shape[-1])


def neighbourhood_attention(q, k, v, k_ctx, v_ctx, rpb):
    b, h, n, d = q.shape
    rows = n // GRID_W
    kr = min(NA_ROWS, rows)
    ncb = GRID_W // NA_QCOL_BLOCK
    nloc = kr * NA_KCOL_BLOCK
    scale = d ** -0.5
    qcol = np.arange(GRID_W).reshape(ncb, NA_QCOL_BLOCK)
    kc0 = np.clip(np.arange(ncb) * NA_QCOL_BLOCK - NA_COLS // 2, 0, GRID_W - NA_KCOL_BLOCK)
    kcol = kc0[:, None] + np.arange(NA_KCOL_BLOCK)[None, :]
    cstart = np.clip(qcol - NA_COLS // 2, 0, GRID_W - NA_COLS)
    col_ok = jnp.asarray((kcol[:, None, :] >= cstart[:, :, None]) & (kcol[:, None, :] < cstart[:, :, None] + NA_COLS))
    dc_idx = np.clip(kcol[:, None, :] - qcol[:, :, None] + NA_COLS - 1, 0, 2 * NA_COLS - 2)
    bias_cols = rpb[:, :, dc_idx]
    kg = k.reshape(b, h, rows, GRID_W, d)
    vg = v.reshape(b, h, rows, GRID_W, d)
    qg = q.reshape(b, h, rows, ncb, NA_QCOL_BLOCK, d).transpose(2, 0, 1, 3, 4, 5)

    def one_row(args):
        r, qr = args
        rs = jnp.clip(r - kr // 2, 0, rows - kr)
        k_win = lax.dynamic_slice_in_dim(kg, rs, kr, axis=2)[:, :, :, kcol].transpose(0, 1, 3, 2, 4, 5)
        v_win = lax.dynamic_slice_in_dim(vg, rs, kr, axis=2)[:, :, :, kcol].transpose(0, 1, 3, 2, 4, 5)
        dr = rs + jnp.arange(kr) - r + NA_ROWS - 1
        bias = bias_cols[:, dr].transpose(0, 2, 3, 1, 4).astype(jnp.float32)
        s_loc = jnp.einsum('bhjqd,bhjikd->bhjqik', qr, k_win).astype(jnp.float32) * scale + bias
        s_loc = jnp.where(col_ok[:, :, None, :], s_loc, NEG_INF)
        s_ctx = jnp.einsum('bhjqd,bhpd->bhjqp', qr, k_ctx).astype(jnp.float32) * scale
        s = jnp.concatenate([s_loc.reshape(b, h, ncb, NA_QCOL_BLOCK, nloc), s_ctx], axis=-1)
        p = jax.nn.softmax(s, axis=-1).astype(v.dtype)
        o_loc = jnp.einsum('bhjqn,bhjnd->bhjqd', p[..., :nloc], v_win.reshape(b, h, ncb, nloc, d))
        o_ctx = jnp.einsum('bhjqp,bhpd->bhjqd', p[..., nloc:], v_ctx)
        return o_loc + o_ctx

    o = lax.map(one_row, (jnp.arange(rows), qg))
    return o.transpose(1, 2, 0, 3, 4, 5).reshape(b, h, n, d)


def retention_chunkwise(q, k, v, log_g, s0, include_diag):
    b, h, t, _ = q.shape
    dv = v.shape[-1]
    nc = t // RET_CHUNK
    f32 = jnp.float32
    pos = jnp.arange(RET_CHUNK, dtype=f32)
    rel = pos[:, None] - pos[None, :]
    mask = rel >= 0 if include_diag else rel > 0
    lg = log_g.astype(f32)
    dmat = jnp.where(mask, jnp.exp(jnp.where(mask, rel, 0.0) * lg[:, None, None]), 0.0)
    xi = jnp.exp((pos + 1.0) * lg[:, None])[..., None]
    zeta = jnp.exp((RET_CHUNK - 1.0 - pos) * lg[:, None])[..., None]
    g_chunk = jnp.exp(RET_CHUNK * lg)[:, None, None]

    def chunks(z):
        return z.astype(f32).reshape(b, h, nc, RET_CHUNK, -1).transpose(2, 0, 1, 3, 4)

    def step(s, qkv):
        qc, kc, vc = qkv
        inner = jnp.einsum('bhnd,bhmd->bhnm', qc, kc) * dmat
        o = jnp.einsum('bhnm,bhme->bhne', inner, vc) + jnp.einsum('bhnd,bhde->bhne', qc, s) * xi
        s = g_chunk * s + jnp.einsum('bhmd,bhme->bhde', kc * zeta, vc)
        return s, o

    s_fin, o = lax.scan(step, s0.astype(f32), (chunks(q), chunks(k), chunks(v)))
    return o.transpose(1, 2, 0, 3, 4).reshape(b, h, t, dv), s_fin


def retention_bidir(q, k, v, lg_f, lg_b, s_f0, s_b0):
    o_f, s_f = retention_chunkwise(q, k, v, lg_f, s_f0, True)
    o_b, s_b = retention_chunkwise(q[:, :, ::-1], k[:, :, ::-1], v[:, :, ::-1], lg_b, s_b0, False)
    return o_f + o_b[:, :, ::-1], s_f, s_b


def centred_dwconv(x, w, bias):
    ch = x.shape[-1]
    y = lax.conv_general_dilated(x, w[:, None, :].astype(x.dtype), window_strides=(1,),
                                 padding=[((LRU_CONV - 1) // 2, LRU_CONV // 2)],
                                 dimension_numbers=('NWC', 'WIO', 'NWC'), feature_group_count=ch)
    return y + bias


def rglru_gates(x, wa, ba, wx, bx, lam):
    b, t, w = x.shape
    xf = x.astype(jnp.float32)
    xb = xf.reshape(b, t, LRU_BLOCKS, -1)
    r = jax.nn.sigmoid(jnp.einsum('btnd,nde->btne', xb, wa.astype(jnp.float32)).reshape(b, t, w) + ba.astype(jnp.float32))
    i = jax.nn.sigmoid(jnp.einsum('btnd,nde->btne', xb, wx.astype(jnp.float32)).reshape(b, t, w) + bx.astype(jnp.float32))
    log_a = -LRU_C * r * jax.nn.softplus(-lam.astype(jnp.float32))
    a = jnp.exp(log_a)
    u = jnp.sqrt(-jnp.expm1(2.0 * log_a)) * (i * xf)
    return a, u


def linear_scan(a, u, h0):
    u = u.at[:, 0].add(a[:, 0] * h0.astype(jnp.float32))

    def combine(left, right):
        a_l, u_l = left
        a_r, u_r = right
        return a_l * a_r, a_r * u_l + u_r

    _, hs = lax.associative_scan(combine, (a, u), axis=1)
    return hs


def rglru_bidir(x, p_fwd, p_bwd, h_f0, h_b0):
    a, u = rglru_gates(x, *p_fwd)
    h_f = linear_scan(a, u, h_f0)
    a, u = rglru_gates(x[:, ::-1], *p_bwd)
    h_b = linear_scan(a, u, h_b0)
    return h_f + h_b[:, ::-1], h_f[:, -1], h_b[:, -1]


def merge_branches(ys, gate_logits, w_branch, w_out):
    y = jnp.stack(ys, axis=-2)
    proj = jnp.einsum('btkw,kwd->btkd', y, w_branch)
    g = jax.nn.sigmoid(gate_logits.reshape(gate_logits.shape[:-1] + (N_BRANCH, D_MODEL)))
    return jnp.sum(g * proj, axis=-2) @ w_out


def mixer(h, P, l, ctx):
    b, t, _ = h.shape
    (na_q, na_k, na_v, df_q, df_k, df_v, rt_q, rt_k, rt_v, rt_g, lr_x, lr_g, gate_logits) = split_cols(h @ P['w_in'])
    qa, ka, va = split_heads(na_q, NA_HEADS), split_heads(na_k, NA_HEADS), split_heads(na_v, NA_HEADS)
    qb, kb, vb = diff_qk_heads(df_q), diff_qk_heads(df_k), split_heads(df_v, DIFF_HEADS)
    lam_init = 0.8 - 0.6 * math.exp(-0.3 * l)
    lam = (jnp.exp(jnp.sum(P['diff_lq1'].astype(jnp.float32) * P['diff_lk1'].astype(jnp.float32)))
           - jnp.exp(jnp.sum(P['diff_lq2'].astype(jnp.float32) * P['diff_lk2'].astype(jnp.float32))) + lam_init)
    qc = split_heads(rt_q, RET_HEADS)
    kc = split_heads(rt_k, RET_HEADS) * (RET_DH ** -0.5)
    vc = split_heads(rt_v, RET_HEADS)
    lg_f = jnp.log1p(-jnp.exp(P['ret_theta_fwd'].astype(jnp.float32)))
    lg_b = jnp.log1p(-jnp.exp(P['ret_theta_bwd'].astype(jnp.float32)))
    xd = centred_dwconv(lr_x, P['lru_conv_w'], P['lru_conv_b'])
    if ctx is None:
        ya_h = dense_attention(qa, ka, va)
        yb_h = diff_attention(qb, kb, vb, lam)
        s_rf0 = jnp.zeros((b, RET_HEADS, RET_DH, RET_DH), jnp.float32)
        s_rb0 = jnp.zeros((b, RET_HEADS, RET_DH, RET_DH), jnp.float32)
        h_lf0 = jnp.zeros((b, LRU_WIDTH), jnp.float32)
        h_lb0 = jnp.zeros((b, LRU_WIDTH), jnp.float32)
    else:
        (c_na_k, c_na_v, c_df_k, c_df_v, s_rf0, s_rb0, h_lf0, h_lb0) = ctx
        ya_h = neighbourhood_attention(qa, ka, va, c_na_k, c_na_v, P['na_rpb'])
        ang_r, ang_c = axial_angles(t, DIFF_DH)
        qb_rot = axial_rope(qb, ang_r, ang_c)
        kb_rot = axial_rope(kb, ang_r, ang_c)
        yb_h = diff_attention(qb_rot, jnp.concatenate([kb_rot, c_df_k], axis=3),
                              jnp.concatenate([vb, c_df_v], axis=2), lam)
    oc, s_rf, s_rb = retention_bidir(qc, kc, vc, lg_f, lg_b, s_rf0, s_rb0)
    hd, h_lf, h_lb = rglru_bidir(xd, P['lru_fwd'], P['lru_bwd'], h_lf0, h_lb0)
    ya = merge_heads(ya_h)
    yb = merge_heads(rmsnorm(yb_h, P['diff_norm']) * (1.0 - lam_init))
    yc = merge_heads(rmsnorm(oc, P['ret_norm'].reshape(RET_HEADS, 1, RET_DH)).astype(h.dtype)) * jax.nn.silu(rt_g)
    yd = hd.astype(h.dtype) * jax.nn.gelu(lr_g)
    out = merge_branches((ya, yb, yc, yd), gate_logits, P['w_branch'], P['w_out'])
    return out, (ka, va, kb, vb, s_rf, s_rb, h_lf, h_lb)


def trunk_layer(x, cond, P, l, ctx):
    sh1, sc1, g1, sh2, sc2, g2 = modulation(cond, P['ada_w'], P['ada_b'])
    h = rmsnorm(x, P['norm_mix_pre']) * (1.0 + sc1) + sh1
    y, ctx_out = mixer(h, P, l, ctx)
    x = x + g1 * rmsnorm(y, P['norm_mix_post'])
    h = rmsnorm(x, P['norm_ffn_pre']) * (1.0 + sc2) + sh2
    y = jnp.square(jax.nn.relu(h @ P['mlp_w1'])) @ P['mlp_w2']
    x = x + g2 * rmsnorm(y, P['norm_ffn_post'])
    return x, ctx_out


def setup_inputs(seed: int = 0) -> dict:
    key = jax.random.key(seed)
    keys = iter(jax.random.split(key, 64))
    D = D_MODEL

    def nrm(shape, scale=1.0):
        return jax.random.normal(next(keys), shape, jnp.float32) * scale

    def gain(shape):
        return 1.0 + nrm(shape, 0.05)

    def lru_lambda():
        u = jax.random.uniform(next(keys), (DEPTH, LRU_WIDTH), jnp.float32, 0.9, 0.999)
        s = u ** (1.0 / LRU_C)
        return jnp.log(s) - jnp.log1p(-s)

    theta0 = jnp.linspace(math.log(1.0 / 32.0), math.log(1.0 / 512.0), RET_HEADS, dtype=jnp.float32)
    bw = LRU_WIDTH // LRU_BLOCKS
    return {
        'x_prompt': nrm((BATCH, SEQ, D)),
        'x_sample': nrm((DEC_BATCH, DEC_SEQ, D)),
        'cache_na_k': nrm((DEC_BATCH, DEPTH, NA_HEADS, PAST_LEN, NA_DH)),
        'cache_na_v': nrm((DEC_BATCH, DEPTH, NA_HEADS, PAST_LEN, NA_DH)),
        'cache_diff_k': nrm((DEC_BATCH, DEPTH, 2, DIFF_HEADS, PAST_LEN, DIFF_DH)),
        'cache_diff_v': nrm((DEC_BATCH, DEPTH, DIFF_HEADS, PAST_LEN, 2 * DIFF_DH)),
        'state_ret_fwd': nrm((DEC_BATCH, DEPTH, RET_HEADS, RET_DH, RET_DH), 0.5),
        'state_ret_bwd': nrm((DEC_BATCH, DEPTH, RET_HEADS, RET_DH, RET_DH), 0.5),
        'state_lru_fwd': nrm((DEC_BATCH, DEPTH, LRU_WIDTH), 0.5),
        'state_lru_bwd': nrm((DEC_BATCH, DEPTH, LRU_WIDTH), 0.5),
        'c': nrm((DEC_BATCH, D)),
        'c_ctx': nrm((D,)),
        'ada_w': nrm((DEPTH, D, 6 * D), 0.5 * D ** -0.5),
        'ada_b': nrm((DEPTH, 6 * D), 0.02),
        'norm_mix_pre': gain((DEPTH, D)),
        'norm_mix_post': gain((DEPTH, D)),
        'norm_ffn_pre': gain((DEPTH, D)),
        'norm_ffn_post': gain((DEPTH, D)),
        'w_in': nrm((DEPTH, D, IN_WIDTH), D ** -0.5),
        'na_rpb': nrm((DEPTH, NA_HEADS, 2 * NA_ROWS - 1, 2 * NA_COLS - 1), 0.5),
        'diff_lq1': nrm((DEPTH, DIFF_DH), 0.1),
        'diff_lk1': nrm((DEPTH, DIFF_DH), 0.1),
        'diff_lq2': nrm((DEPTH, DIFF_DH), 0.1),
        'diff_lk2': nrm((DEPTH, DIFF_DH), 0.1),
        'diff_norm': gain((DEPTH, 2 * DIFF_DH)),
        'ret_theta_fwd': theta0 + nrm((DEPTH, RET_HEADS), 0.05),
        'ret_theta_bwd': theta0 + nrm((DEPTH, RET_HEADS), 0.05),
        'ret_norm': gain((DEPTH, RET_W)),
        'lru_conv_w': nrm((DEPTH, LRU_CONV, LRU_WIDTH), LRU_CONV ** -0.5),
        'lru_conv_b': nrm((DEPTH, LRU_WIDTH), 0.02),
        'lru_wa_fwd': nrm((DEPTH, LRU_BLOCKS, bw, bw), bw ** -0.5),
        'lru_ba_fwd': nrm((DEPTH, LRU_WIDTH), 0.02),
        'lru_wx_fwd': nrm((DEPTH, LRU_BLOCKS, bw, bw), bw ** -0.5),
        'lru_bx_fwd': nrm((DEPTH, LRU_WIDTH), 0.02),
        'lru_lam_fwd': lru_lambda(),
        'lru_wa_bwd': nrm((DEPTH, LRU_BLOCKS, bw, bw), bw ** -0.5),
        'lru_ba_bwd': nrm((DEPTH, LRU_WIDTH), 0.02),
        'lru_wx_bwd': nrm((DEPTH, LRU_BLOCKS, bw, bw), bw ** -0.5),
        'lru_bx_bwd': nrm((DEPTH, LRU_WIDTH), 0.02),
        'lru_lam_bwd': lru_lambda(),
        'w_branch': nrm((DEPTH, N_BRANCH, BRANCH_W, D), BRANCH_W ** -0.5),
        'w_out': nrm((DEPTH, D, D), D ** -0.5),
        'mlp_w1': nrm((DEPTH, D, D_FF), D ** -0.5),
        'mlp_w2': nrm((DEPTH, D_FF, D), D_FF ** -0.5),
    }


def reference(x_prompt, x_sample, cache_na_k, cache_na_v, cache_diff_k, cache_diff_v,
              state_ret_fwd, state_ret_bwd, state_lru_fwd, state_lru_bwd, c, c_ctx,
              ada_w, ada_b, norm_mix_pre, norm_mix_post, norm_ffn_pre, norm_ffn_post, w_in, na_rpb,
              diff_lq1, diff_lk1, diff_lq2, diff_lk2, diff_norm, ret_theta_fwd, ret_theta_bwd, ret_norm,
              lru_conv_w, lru_conv_b, lru_wa_fwd, lru_ba_fwd, lru_wx_fwd, lru_bx_fwd, lru_lam_fwd,
              lru_wa_bwd, lru_ba_bwd, lru_wx_bwd, lru_bx_bwd, lru_lam_bwd,
              w_branch, w_out, mlp_w1, mlp_w2):
    y_p = x_prompt
    y_s = x_sample
    ctx_outs = []
    for l in range(DEPTH):
        P = {
            'ada_w': ada_w[l], 'ada_b': ada_b[l],
            'norm_mix_pre': norm_mix_pre[l], 'norm_mix_post': norm_mix_post[l],
            'norm_ffn_pre': norm_ffn_pre[l], 'norm_ffn_post': norm_ffn_post[l],
            'w_in': w_in[l], 'na_rpb': na_rpb[l],
            'diff_lq1': diff_lq1[l], 'diff_lk1': diff_lk1[l], 'diff_lq2': diff_lq2[l], 'diff_lk2': diff_lk2[l],
            'diff_norm': diff_norm[l],
            'ret_theta_fwd': ret_theta_fwd[l], 'ret_theta_bwd': ret_theta_bwd[l], 'ret_norm': ret_norm[l],
            'lru_conv_w': lru_conv_w[l], 'lru_conv_b': lru_conv_b[l],
            'lru_fwd': (lru_wa_fwd[l], lru_ba_fwd[l], lru_wx_fwd[l], lru_bx_fwd[l], lru_lam_fwd[l]),
            'lru_bwd': (lru_wa_bwd[l], lru_ba_bwd[l], lru_wx_bwd[l], lru_bx_bwd[l], lru_lam_bwd[l]),
            'w_branch': w_branch[l], 'w_out': w_out[l],
            'mlp_w1': mlp_w1[l], 'mlp_w2': mlp_w2[l],
        }
        y_p, ctx_l = trunk_layer(y_p, c_ctx[None, :], P, l, None)
        ctx_outs.append(ctx_l)
        cached = (cache_na_k[:, l], cache_na_v[:, l], cache_diff_k[:, l], cache_diff_v[:, l],
                  state_ret_fwd[:, l], state_ret_bwd[:, l], state_lru_fwd[:, l], state_lru_bwd[:, l])
        y_s, _ = trunk_layer(y_s, c, P, l, cached)
    new_na_k = jnp.stack([o[0] for o in ctx_outs], axis=1)
    new_na_v = jnp.stack([o[1] for o in ctx_outs], axis=1)
    new_diff_k = jnp.stack([o[2] for o in ctx_outs], axis=1)
    new_diff_v = jnp.stack([o[3] for o in ctx_outs], axis=1)
    new_ret_fwd = jnp.stack([o[4] for o in ctx_outs], axis=1)
    new_ret_bwd = jnp.stack([o[5] for o in ctx_outs], axis=1)
    new_lru_fwd = jnp.stack([o[6] for o in ctx_outs], axis=1)
    new_lru_bwd = jnp.stack([o[7] for o in ctx_outs], axis=1)
    return (y_p, y_s, new_na_k, new_na_v, new_diff_k, new_diff_v, new_ret_fwd, new_ret_bwd, new_lru_fwd, new_lru_bwd)
```

```cpp
#include <hip/hip_runtime.h>
#include <hip/hip_cooperative_groups.h>
#include <cstdio>
namespace cg = cooperative_groups;

#ifndef ONE_LAUNCH
#define ONE_LAUNCH 1
#endif

typedef unsigned short bf16_t;
using bf16x8 = __attribute__((ext_vector_type(8))) short;
using bf16x4 = __attribute__((ext_vector_type(4))) short;
using f32x4 = __attribute__((ext_vector_type(4))) float;
using u32x4 = __attribute__((ext_vector_type(4))) unsigned;
#define DI __device__ __forceinline__
#define MFMA16(a, b, c) __builtin_amdgcn_mfma_f32_16x16x32_bf16((a), (b), (c), 0, 0, 0)

struct P {
  const float* in[44];
  float* out;
  char* ws;
};

constexpr int D = 1024, NCTX = 8192;
constexpr int ZLD = 8704;
constexpr int ZC_NAQ = 0, ZC_NAK = 512, ZC_DFQ = 1024, ZC_DFK = 1536, ZC_RTQ = 2048, ZC_RTK = 2560, ZC_RTG = 3072,
              ZC_LRX = 3584, ZC_LRG = 4096, ZC_GATE = 4608;
constexpr int LDT = 72;

constexpr size_t WS_WIN = 0;
constexpr size_t WS_WBR = WS_WIN + (size_t)10240 * 1024 * 2;
constexpr size_t WS_WOUT = WS_WBR + (size_t)1024 * 2048 * 2;
constexpr size_t WS_W1 = WS_WOUT + (size_t)1024 * 1024 * 2;
constexpr size_t WS_W2 = WS_W1 + (size_t)4096 * 1024 * 2;
constexpr size_t WS_WLRU = WS_W2 + (size_t)4096 * 1024 * 2;
constexpr size_t WS_CKNA = WS_WLRU + (size_t)32 * 4096 * 2;
constexpr size_t WS_CVNA = WS_CKNA + (size_t)4 * 262144 * 2;
constexpr size_t WS_CKDF = WS_CVNA + (size_t)4 * 262144 * 2;
constexpr size_t WS_CVDF = WS_CKDF + (size_t)4 * 262144 * 2;
constexpr size_t WS_MOD = WS_CVDF + (size_t)4 * 262144 * 2;
constexpr size_t WS_H = WS_MOD + (size_t)4 * 5 * 6144 * 4;
constexpr size_t WS_Y4 = WS_H + (size_t)16384 * 1024 * 2;
constexpr size_t WS_VTNA = WS_Y4 + (size_t)16384 * 2048 * 2;
constexpr size_t WS_VTDF = WS_VTNA + (size_t)16384 * 512 * 2;
constexpr size_t WS_VTRT = WS_VTDF + (size_t)16384 * 512 * 2;
constexpr size_t WS_KTRT = WS_VTRT + (size_t)16384 * 512 * 2;
constexpr size_t WS_Z = WS_KTRT + (size_t)8192 * 512 * 2;
constexpr size_t WS_Y = WS_Z;
constexpr size_t WS_U = WS_Z + (size_t)16384 * 1024 * 4;
constexpr size_t WS_END = WS_Z + (size_t)16384 * ZLD * 2;

constexpr size_t O_NAK = 16777216, O_NAV = 33554432, O_DFK = 50331648, O_DFV = 67108864, O_RF = 83886080,
                 O_RB = 88080384, O_LF = 92274688, O_LB = 92340224;
constexpr int VT_LAT = 4194304;

constexpr int SMEM_BYTES = 59392;

DI int otid() {
  int t = threadIdx.x;
  asm volatile("" : "+v"(t));
  return t;
}
DI bf16_t f2bf(float x) {
  unsigned u = __float_as_uint(x);
  u += 0x7fffu + ((u >> 16) & 1u);
  return (bf16_t)(u >> 16);
}
DI float bf2f(bf16_t b) { return __uint_as_float(((unsigned)b) << 16); }
DI float bfs2f(short b) { return __uint_as_float(((unsigned)(unsigned short)b) << 16); }
DI float wave_sum(float v) {
#pragma unroll
  for (int o = 32; o > 0; o >>= 1) v += __shfl_xor(v, o);
  return v;
}
DI float sigmoidf_(float x) { return 1.f / (1.f + __expf(-x)); }
DI float gelu_tanh(float x) {
  float u = 0.7978845608028654f * (x + 0.044715f * x * x * x);
  return 0.5f * x * (1.f + tanhf(u));
}
DI bf16x8 pack8(const f32x4& a, const f32x4& b) {
  bf16x8 r;
  r[0] = (short)f2bf(a[0]); r[1] = (short)f2bf(a[1]); r[2] = (short)f2bf(a[2]); r[3] = (short)f2bf(a[3]);
  r[4] = (short)f2bf(b[0]); r[5] = (short)f2bf(b[1]); r[6] = (short)f2bf(b[2]); r[7] = (short)f2bf(b[3]);
  return r;
}
DI bf16x4 pack4(float a, float b, float c, float d) {
  bf16x4 r;
  r[0] = (short)f2bf(a); r[1] = (short)f2bf(b); r[2] = (short)f2bf(c); r[3] = (short)f2bf(d);
  return r;
}

DI void gemm_mainloop(const bf16_t* __restrict__ A, int lda, const bf16_t* __restrict__ Bt, int ldb, int K, int row0,
                      int col0, bf16_t* sA, bf16_t* sB, f32x4 (&acc)[4][4]) {
  const int tid = otid(), lane = tid & 63, wid = tid >> 6;
  const int wm = wid >> 1, wn = wid & 1, fr = lane & 15, fq = lane >> 4;
  const bf16_t* Ag = A + (size_t)row0 * lda;
  const bf16_t* Bg = Bt + (size_t)col0 * ldb;
  u32x4 ra[4], rb[4];
#pragma unroll
  for (int i = 0; i < 4; ++i) {
    int id = tid + i * 256, r = id >> 3, c = (id & 7) * 8;
    ra[i] = *(const u32x4*)(Ag + (size_t)r * lda + c);
    rb[i] = *(const u32x4*)(Bg + (size_t)r * ldb + c);
  }
#pragma unroll
  for (int i = 0; i < 4; ++i) {
    int id = tid + i * 256, r = id >> 3, c = (id & 7) * 8;
    *(u32x4*)(sA + r * LDT + c) = ra[i];
    *(u32x4*)(sB + r * LDT + c) = rb[i];
  }
  __syncthreads();
  for (int k0 = 0; k0 < K; k0 += 64) {
    const bool more = (k0 + 64) < K;
    if (more) {
#pragma unroll
      for (int i = 0; i < 4; ++i) {
        int id = tid + i * 256, r = id >> 3, c = (id & 7) * 8;
        ra[i] = *(const u32x4*)(Ag + (size_t)r * lda + k0 + 64 + c);
        rb[i] = *(const u32x4*)(Bg + (size_t)r * ldb + k0 + 64 + c);
      }
    }
#pragma unroll
    for (int ks = 0; ks < 2; ++ks) {
      bf16x8 af[4], bfr[4];
#pragma unroll
      for (int mi = 0; mi < 4; ++mi) af[mi] = *(const bf16x8*)(sA + (wm * 64 + mi * 16 + fr) * LDT + ks * 32 + fq * 8);
#pragma unroll
      for (int ni = 0; ni < 4; ++ni) bfr[ni] = *(const bf16x8*)(sB + (wn * 64 + ni * 16 + fr) * LDT + ks * 32 + fq * 8);
#pragma unroll
      for (int mi = 0; mi < 4; ++mi)
#pragma unroll
        for (int ni = 0; ni < 4; ++ni) acc[mi][ni] = MFMA16(af[mi], bfr[ni], acc[mi][ni]);
    }
    __syncthreads();
    if (more) {
#pragma unroll
      for (int i = 0; i < 4; ++i) {
        int id = tid + i * 256, r = id >> 3, c = (id & 7) * 8;
        *(u32x4*)(sA + r * LDT + c) = ra[i];
        *(u32x4*)(sB + r * LDT + c) = rb[i];
      }
      __syncthreads();
    }
  }
}

DI void zero_acc(f32x4 (&acc)[4][4]) {
#pragma unroll
  for (int mi = 0; mi < 4; ++mi)
#pragma unroll
    for (int ni = 0; ni < 4; ++ni) acc[mi][ni] = f32x4{0.f, 0.f, 0.f, 0.f};
}
DI void tile_of(int id, int ntn, int& tm, int& tn) {
  int band = id / (16 * ntn), rem = id % (16 * ntn);
  tm = band * 16 + (rem & 15);
  tn = rem >> 4;
}

DI void epi_in(const P& p, int l, int row0, int col0, f32x4 (&acc)[4][4]) {
  const int tid_ = otid(), lane = tid_ & 63, wid = tid_ >> 6, wm = wid >> 1, wn = wid & 1, fr = lane & 15, fq = lane >> 4;
  const int seg = col0 >> 9;
  const bool ctx = row0 < NCTX;
  bf16_t* Z = (bf16_t*)(p.ws + WS_Z);
  const int rbase = row0 + wm * 64;
  const int cseg0 = (col0 & 511) + wn * 64;

  if (!ctx && (seg == 3 || seg == 4)) {
    const float inv = powf(10000.f, -(float)fr * (1.f / 16.f));
#pragma unroll
    for (int mi = 0; mi < 4; ++mi)
#pragma unroll
      for (int i = 0; i < 4; ++i) {
        int r = rbase + mi * 16 + fq * 4 + i;
        int t = (r - NCTX) & 2047;
        float gr = (float)(t >> 6), gc = (float)(t & 63);
        float sr, cr, sc, cc;
        sincosf(gr * inv, &sr, &cr);
        sincosf(gc * inv, &sc, &cc);
        float a0 = acc[mi][0][i], a1 = acc[mi][1][i], a2 = acc[mi][2][i], a3 = acc[mi][3][i];
        acc[mi][0][i] = a0 * cr - a1 * sr;
        acc[mi][1][i] = a1 * cr + a0 * sr;
        acc[mi][2][i] = a2 * cc - a3 * sc;
        acc[mi][3][i] = a3 * cc + a2 * sc;
      }
  }

  int zc = -1, tf = 0;
  bf16_t* VT = nullptr;
  switch (seg) {
    case 0: zc = ZC_NAQ; break;
    case 1: zc = ZC_NAK; break;
    case 2: VT = (bf16_t*)(p.ws + WS_VTNA); break;
    case 3: zc = ZC_DFQ; break;
    case 4: zc = ZC_DFK; break;
    case 5: VT = (bf16_t*)(p.ws + WS_VTDF); break;
    case 6: zc = ZC_RTQ; break;
    case 7: zc = ZC_RTK; tf = 4; break;
    case 8: VT = (bf16_t*)(p.ws + WS_VTRT); break;
    case 9: zc = ZC_RTG; tf = 1; break;
    case 10: zc = ZC_LRX; break;
    case 11: zc = ZC_LRG; tf = 2; break;
    default: zc = ZC_GATE + (seg - 12) * 512; tf = 3; break;
  }

  if (zc >= 0) {
#pragma unroll
    for (int mi = 0; mi < 4; ++mi)
#pragma unroll
      for (int ni = 0; ni < 4; ++ni)
#pragma unroll
        for (int i = 0; i < 4; ++i) {
          int r = rbase + mi * 16 + fq * 4 + i;
          int c = cseg0 + ni * 16 + fr;
          float v = acc[mi][ni][i];
          if (tf == 1) v = v * sigmoidf_(v);
          else if (tf == 2) v = gelu_tanh(v);
          else if (tf == 3) v = sigmoidf_(v);
          else if (tf == 4) v = v * 0.125f;
          Z[(size_t)r * ZLD + zc + c] = f2bf(v);
        }
  }
  if (VT != nullptr || (seg == 7 && ctx)) {
    bf16_t* T_ = (seg == 7) ? (bf16_t*)(p.ws + WS_KTRT) : VT;
    const float scl = (seg == 7) ? 0.125f : 1.f;
#pragma unroll
    for (int mi = 0; mi < 4; ++mi)
#pragma unroll
      for (int ni = 0; ni < 4; ++ni) {
        int r0 = rbase + mi * 16 + fq * 4;
        int c = cseg0 + ni * 16 + fr;
        size_t idx;
        if (r0 < NCTX) {
          int b = r0 >> 8, t = r0 & 255;
          idx = ((size_t)(b * 512 + c)) * 256 + t;
        } else {
          int rr = r0 - NCTX, b = rr >> 11, t = rr & 2047;
          idx = (size_t)VT_LAT + ((size_t)(b * 512 + c)) * 2048 + t;
        }
        *(bf16x4*)(T_ + idx) = pack4(acc[mi][ni][0] * scl, acc[mi][ni][1] * scl, acc[mi][ni][2] * scl, acc[mi][ni][3] * scl);
      }
  }
  if (ctx && (seg == 1 || seg == 2 || seg == 4 || seg == 5)) {
    float* out = p.out;
#pragma unroll
    for (int mi = 0; mi < 4; ++mi)
#pragma unroll
      for (int ni = 0; ni < 4; ++ni)
#pragma unroll
        for (int i = 0; i < 4; ++i) {
          int r = rbase + mi * 16 + fq * 4 + i;
          int c = cseg0 + ni * 16 + fr;
          int b = r >> 8, t = r & 255;
          size_t off;
          if (seg == 1 || seg == 2) {
            int h = c >> 6, d = c & 63;
            off = (seg == 1 ? O_NAK : O_NAV) + ((((size_t)(b * 4 + l) * 8 + h) * 256 + t) * 64 + d);
          } else if (seg == 4) {
            int comp = c >> 8, h = (c >> 6) & 3, d = c & 63;
            off = O_DFK + (((((size_t)(b * 4 + l) * 2 + comp) * 4 + h) * 256 + t) * 64 + d);
          } else {
            int h = c >> 7, d = c & 127;
            off = O_DFV + ((((size_t)(b * 4 + l) * 4 + h) * 256 + t) * 128 + d);
          }
          out[off] = acc[mi][ni][i];
        }
  }
}

DI void phase_gin(const P& p, int l, char* smem) {
  bf16_t* sA = (bf16_t*)smem;
  bf16_t* sB = sA + 128 * LDT;
  const bf16_t* A = (const bf16_t*)(p.ws + WS_H);
  const bf16_t* Bt = (const bf16_t*)(p.ws + WS_WIN);
  const int ntn = 80, total = 128 * ntn;
  for (int id = blockIdx.x; id < total; id += gridDim.x) {
    int tm, tn;
    tile_of(id, ntn, tm, tn);
    f32x4 acc[4][4];
    zero_acc(acc);
    gemm_mainloop(A, 1024, Bt, 1024, 1024, tm * 128, tn * 128, sA, sB, acc);
    epi_in(p, l, tm * 128, tn * 128, acc);
  }
}

DI void phase_merge(const P& p, char* smem) {
  bf16_t* sA = (bf16_t*)smem;
  bf16_t* sB = sA + 128 * LDT;
  const bf16_t* Y4 = (const bf16_t*)(p.ws + WS_Y4);
  const bf16_t* WB = (const bf16_t*)(p.ws + WS_WBR);
  bf16_t* Z = (bf16_t*)(p.ws + WS_Z);
  bf16_t* G = (bf16_t*)(p.ws + WS_H);
  const int tid_ = otid(), lane = tid_ & 63, wid = tid_ >> 6, wm = wid >> 1, wn = wid & 1, fr = lane & 15, fq = lane >> 4;
  const int ntn = 8, total = 128 * ntn;
  for (int id = blockIdx.x; id < total; id += gridDim.x) {
    int tm, tn;
    tile_of(id, ntn, tm, tn);
    const int row0 = tm * 128, col0 = tn * 128;
#pragma unroll 1
    for (int k = 0; k < 4; ++k) {
      f32x4 acc[4][4];
      zero_acc(acc);
      gemm_mainloop(Y4 + k * 512, 2048, WB + k * 512, 2048, 512, row0, col0, sA, sB, acc);
      int rb_ = row0 + wm * 64 + fq * 4, cb_ = col0 + wn * 64 + fr;
      asm volatile("" : "+v"(rb_), "+v"(cb_));
#pragma unroll
      for (int mi = 0; mi < 4; ++mi)
#pragma unroll
        for (int ni = 0; ni < 4; ++ni)
#pragma unroll
          for (int i = 0; i < 4; ++i) {
            int r = rb_ + mi * 16 + i;
            int c = cb_ + ni * 16;
            float g = bf2f(Z[(size_t)r * ZLD + ZC_GATE + k * 1024 + c]);
            float* g32 = (float*)(Z + (size_t)r * ZLD) + c;
            float o = g * acc[mi][ni][i];
            if (k > 0) o += *g32;
            if (k < 3) *g32 = o;
            else G[(size_t)r * 1024 + c] = f2bf(o);
            if (i == 3) asm volatile("" ::: "memory");
          }
    }
  }
}

template <int MODE>
DI void phase_gemm_plain(const bf16_t* A, int K, const bf16_t* Bt, int N, void* outp, char* smem) {
  bf16_t* sA = (bf16_t*)smem;
  bf16_t* sB = sA + 128 * LDT;
  const int tid_ = otid(), lane = tid_ & 63, wid = tid_ >> 6, wm = wid >> 1, wn = wid & 1, fr = lane & 15, fq = lane >> 4;
  const int ntn = N / 128, total = 128 * ntn;
  for (int id = blockIdx.x; id < total; id += gridDim.x) {
    int tm, tn;
    tile_of(id, ntn, tm, tn);
    const int row0 = tm * 128, col0 = tn * 128;
    f32x4 acc[4][4];
    zero_acc(acc);
    gemm_mainloop(A, K, Bt, K, K, row0, col0, sA, sB, acc);
#pragma unroll
    for (int mi = 0; mi < 4; ++mi)
#pragma unroll
      for (int ni = 0; ni < 4; ++ni)
#pragma unroll
        for (int i = 0; i < 4; ++i) {
          int r = row0 + wm * 64 + mi * 16 + fq * 4 + i;
          int c = col0 + wn * 64 + ni * 16 + fr;
          float v = acc[mi][ni][i];
          if (MODE == 0) {
            ((float*)outp)[(size_t)r * N + c] = v;
          } else {
            v = fmaxf(v, 0.f);
            ((bf16_t*)outp)[(size_t)r * N + c] = f2bf(v * v);
          }
        }
  }
}

DI void phase_mod(const P& p, char* smem) {
  float* ssil = (float*)smem;
  float* red = ssil + 5 * 1024;
  const int tid = otid();
  float* MOD = (float*)(p.ws + WS_MOD);
  for (int idx = tid; idx < 5120; idx += 256) {
    int j = idx >> 10, k = idx & 1023;
    float cv = (j == 0) ? p.in[11][k] : p.in[10][(j - 1) * 1024 + k];
    ssil[idx] = cv / (1.f + expf(-cv));
  }
  __syncthreads();
  const int cl = tid & 63, kg = tid >> 6;
  for (int item = blockIdx.x; item < 384; item += gridDim.x) {
    int l = item / 96, cgp = item % 96;
    int col = cgp * 64 + cl;
    const float* W = p.in[12] + (size_t)l * 1024 * 6144 + col;
    float a0 = 0, a1 = 0, a2 = 0, a3 = 0, a4 = 0;
    for (int k = kg * 256; k < kg * 256 + 256; ++k) {
      float w = W[(size_t)k * 6144];
      a0 += ssil[k] * w;
      a1 += ssil[1024 + k] * w;
      a2 += ssil[2048 + k] * w;
      a3 += ssil[3072 + k] * w;
      a4 += ssil[4096 + k] * w;
    }
    red[(kg * 5 + 0) * 64 + cl] = a0;
    red[(kg * 5 + 1) * 64 + cl] = a1;
    red[(kg * 5 + 2) * 64 + cl] = a2;
    red[(kg * 5 + 3) * 64 + cl] = a3;
    red[(kg * 5 + 4) * 64 + cl] = a4;
    __syncthreads();
    if (kg == 0) {
      float bias = p.in[13][l * 6144 + col];
#pragma unroll
      for (int j = 0; j < 5; ++j) {
        float s = red[(0 * 5 + j) * 64 + cl] + red[(1 * 5 + j) * 64 + cl] + red[(2 * 5 + j) * 64 + cl] + red[(3 * 5 + j) * 64 + cl];
        MOD[(size_t)(l * 5 + j) * 6144 + col] = s + bias;
      }
    }
    __syncthreads();
  }
}

DI void transpose_tile(const float* __restrict__ src, int lds_, bf16_t* __restrict__ dst, int ldd, float* tile) {
  const int tid = otid();
#pragma unroll 4
  for (int i = 0; i < 16; ++i) {
    int idx = tid + i * 256, r = idx >> 6, c = idx & 63;
    tile[r * 65 + c] = src[(size_t)r * lds_ + c];
  }
  __syncthreads();
#pragma unroll 4
  for (int i = 0; i < 16; ++i) {
    int idx = tid + i * 256, c = idx >> 6, r = idx & 63;
    dst[(size_t)c * ldd + r] = f2bf(tile[r * 65 + c]);
  }
  __syncthreads();
}

DI void phase_convert(const P& p, int l, char* smem) {
  float* tile = (float*)smem;
  char* ws = p.ws;
  const int NJ = 6432;
  for (int j = blockIdx.x; j < NJ; j += gridDim.x) {
    int q = j;
    if (q < 2560) {
      int tr = q / 160, tc = q % 160;
      transpose_tile(p.in[18] + (size_t)l * 1024 * 10240 + (size_t)tr * 64 * 10240 + tc * 64, 10240,
                     (bf16_t*)(ws + WS_WIN) + (size_t)tc * 64 * 1024 + tr * 64, 1024, tile);
      continue;
    }
    q -= 2560;
    if (q < 512) {
      int tr = q / 16, tc = q % 16;
      transpose_tile(p.in[40] + (size_t)l * 2048 * 1024 + (size_t)tr * 64 * 1024 + tc * 64, 1024,
                     (bf16_t*)(ws + WS_WBR) + (size_t)tc * 64 * 2048 + tr * 64, 2048, tile);
      continue;
    }
    q -= 512;
    if (q < 256) {
      int tr = q / 16, tc = q % 16;
      transpose_tile(p.in[41] + (size_t)l * 1024 * 1024 + (size_t)tr * 64 * 1024 + tc * 64, 1024,
                     (bf16_t*)(ws + WS_WOUT) + (size_t)tc * 64 * 1024 + tr * 64, 1024, tile);
      continue;
    }
    q -= 256;
    if (q < 1024) {
      int tr = q / 64, tc = q % 64;
      transpose_tile(p.in[42] + (size_t)l * 1024 * 4096 + (size_t)tr * 64 * 4096 + tc * 64, 4096,
                     (bf16_t*)(ws + WS_W1) + (size_t)tc * 64 * 1024 + tr * 64, 1024, tile);
      continue;
    }
    q -= 1024;
    if (q < 1024) {
      int tr = q / 16, tc = q % 16;
      transpose_tile(p.in[43] + (size_t)l * 4096 * 1024 + (size_t)tr * 64 * 1024 + tc * 64, 1024,
                     (bf16_t*)(ws + WS_W2) + (size_t)tc * 64 * 4096 + tr * 64, 4096, tile);
      continue;
    }
    q -= 1024;
    if (q < 32) {
      int type = q >> 3, n = q & 7;
      const float* src = (type == 0 ? p.in[30] : type == 1 ? p.in[32] : type == 2 ? p.in[35] : p.in[37]) + (size_t)(l * 8 + n) * 4096;
      transpose_tile(src, 64, (bf16_t*)(ws + WS_WLRU) + (size_t)(type * 8 + n) * 4096, 64, tile);
      continue;
    }
    q -= 32;
    if (q < 256) {
      int bh = q >> 3, tr = q & 7, b = bh >> 3, h = bh & 7;
      transpose_tile(p.in[3] + ((size_t)((b * 4 + l) * 8 + h)) * 32768 + (size_t)tr * 64 * 64, 64,
                     (bf16_t*)(ws + WS_CVNA) + (size_t)bh * 32768 + tr * 64, 512, tile);
      continue;
    }
    q -= 256;
    if (q < 256) {
      int bh = q >> 4, t2 = q & 15, tr = t2 >> 1, tc = t2 & 1, b = bh >> 2, h = bh & 3;
      transpose_tile(p.in[5] + ((size_t)((b * 4 + l) * 4 + h)) * 65536 + (size_t)tr * 64 * 128 + tc * 64, 128,
                     (bf16_t*)(ws + WS_CVDF) + (size_t)bh * 65536 + (size_t)tc * 64 * 512 + tr * 64, 512, tile);
      continue;
    }
    q -= 256;
    {
      int tensor = q >> 8, b = (q >> 6) & 3, chunk = q & 63;
      const float* src = (tensor == 0 ? p.in[2] : p.in[4]) + (size_t)(b * 4 + l) * 262144 + (size_t)chunk * 4096;
      bf16_t* dst = (bf16_t*)(ws + (tensor == 0 ? WS_CKNA : WS_CKDF)) + (size_t)b * 262144 + (size_t)chunk * 4096;
#pragma unroll
      for (int i = 0; i < 4; ++i) {
        int e = (otid() + i * 256) * 4;
        float4 v = *(const float4*)(src + e);
        *(bf16x4*)(dst + e) = pack4(v.x, v.y, v.z, v.w);
      }
    }
  }
}

DI void phase_row(const P& p, int l, int mode) {
  const int tid_ = otid(), lane = tid_ & 63, wid = tid_ >> 6;
  const float* MOD = (const float*)(p.ws + WS_MOD);
  float* X = p.out;
  bf16_t* H = (bf16_t*)(p.ws + WS_H);
  const float* Y = (const float*)(p.ws + WS_Y);
  for (int rb = blockIdx.x; rb < 4096; rb += gridDim.x) {
    const int r = rb * 4 + wid;
    const int mi = r < NCTX ? 0 : 1 + ((r - NCTX) >> 11);
    const float* xs;
    if (mode == 0 || (mode == 1 && l == 0))
      xs = (r < NCTX) ? (p.in[0] + (size_t)r * D) : (p.in[1] + (size_t)(r - NCTX) * D);
    else
      xs = X + (size_t)r * D;
    float4 xv[4];
#pragma unroll
    for (int j = 0; j < 4; ++j) xv[j] = *(const float4*)(xs + j * 256 + lane * 4);
    if (mode != 0) {
      float4 yv[4];
      float ss = 0.f;
#pragma unroll
      for (int j = 0; j < 4; ++j) {
        yv[j] = *(const float4*)(Y + (size_t)r * D + j * 256 + lane * 4);
        ss += yv[j].x * yv[j].x + yv[j].y * yv[j].y + yv[j].z * yv[j].z + yv[j].w * yv[j].w;
      }
      ss = wave_sum(ss);
      const float rs = rsqrtf(ss * (1.f / 1024.f) + 1e-6f);
      const float* gpost = (mode == 1 ? p.in[15] : p.in[17]) + l * D;
      const float* gate = MOD + (size_t)(l * 5 + mi) * 6144 + (mode == 1 ? 2048 : 5120);
#pragma unroll
      for (int j = 0; j < 4; ++j) {
        float4 g = *(const float4*)(gpost + j * 256 + lane * 4);
        float4 gt = *(const float4*)(gate + j * 256 + lane * 4);
        xv[j].x += gt.x * (yv[j].x * rs * g.x);
        xv[j].y += gt.y * (yv[j].y * rs * g.y);
        xv[j].z += gt.z * (yv[j].z * rs * g.z);
        xv[j].w += gt.w * (yv[j].w * rs * g.w);
        *(float4*)(X + (size_t)r * D + j * 256 + lane * 4) = xv[j];
      }
    }
    int ln, off_sh, off_sc;
    const float* gpre;
    if (mode == 0) { ln = 0; gpre = p.in[14]; off_sh = 0; off_sc = 1024; }
    else if (mode == 1) { ln = l; gpre = p.in[16] + l * D; off_sh = 3072; off_sc = 4096; }
    else { ln = l + 1; gpre = p.in[14] + (l + 1) * D; off_sh = 0; off_sc = 1024; }
    if (ln < 4) {
      float ss = 0.f;
#pragma unroll
      for (int j = 0; j < 4; ++j) ss += xv[j].x * xv[j].x + xv[j].y * xv[j].y + xv[j].z * xv[j].z + xv[j].w * xv[j].w;
      ss = wave_sum(ss);
      const float rs = rsqrtf(ss * (1.f / 1024.f) + 1e-6f);
      const float* mrow = MOD + (size_t)(ln * 5 + mi) * 6144;
#pragma unroll
      for (int j = 0; j < 4; ++j) {
        int c = j * 256 + lane * 4;
        float4 g = *(const float4*)(gpre + c);
        float4 sc = *(const float4*)(mrow + off_sc + c);
        float4 sh = *(const float4*)(mrow + off_sh + c);
        *(bf16x4*)(H + (size_t)r * D + c) = pack4(xv[j].x * rs * g.x * (1.f + sc.x) + sh.x, xv[j].y * rs * g.y * (1.f + sc.y) + sh.y,
                                                  xv[j].z * rs * g.z * (1.f + sc.z) + sh.z, xv[j].w * rs * g.w * (1.f + sc.w) + sh.w);
      }
    }
  }
}

template <int DV>
DI void load_kv(const bf16_t* __restrict__ Kg, int ldk, const bf16_t* __restrict__ Vg, int ldv, bf16_t* sK, bf16_t* sV) {
  const int tid = otid();
#pragma unroll
  for (int i = 0; i < 2; ++i) {
    int id = tid + i * 256, r = id >> 3, c = (id & 7) * 8;
    *(u32x4*)(sK + r * LDT + c) = *(const u32x4*)(Kg + (size_t)r * ldk + c);
  }
#pragma unroll
  for (int i = 0; i < DV / 32; ++i) {
    int id = tid + i * 256, r = id >> 3, c = (id & 7) * 8;
    *(u32x4*)(sV + r * LDT + c) = *(const u32x4*)(Vg + (size_t)r * ldv + c);
  }
}
DI void qk_scores(const bf16x8 (&qf)[2], const bf16_t* sK, f32x4 (&S)[4], int fr, int fq) {
#pragma unroll
  for (int s = 0; s < 4; ++s) {
    f32x4 z = {0.f, 0.f, 0.f, 0.f};
#pragma unroll
    for (int ks = 0; ks < 2; ++ks) {
      bf16x8 a = *(const bf16x8*)(sK + (16 * s + fr) * LDT + ks * 32 + fq * 8);
      z = MFMA16(a, qf[ks], z);
    }
    S[s] = z;
  }
}
template <int DV>
DI void pv_step(const bf16x8 (&pb)[2], const bf16_t* sV, f32x4 (&O)[DV / 16], int fr, int fq) {
#pragma unroll
  for (int dt = 0; dt < DV / 16; ++dt) {
#pragma unroll
    for (int s2 = 0; s2 < 2; ++s2) {
      const bf16_t* base = sV + (dt * 16 + fr) * LDT + 32 * s2 + 4 * fq;
      bf16x4 lo = *(const bf16x4*)base;
      bf16x4 hi = *(const bf16x4*)(base + 16);
      bf16x8 a = __builtin_shufflevector(lo, hi, 0, 1, 2, 3, 4, 5, 6, 7);
      O[dt] = MFMA16(a, pb[s2], O[dt]);
    }
  }
}
template <int DV>
DI void softmax_pv(f32x4 (&S)[4], const bf16_t* sV, f32x4 (&O)[DV / 16], float& m, float& lsum, int fr, int fq) {
  float tm = -1e30f;
#pragma unroll
  for (int s = 0; s < 4; ++s)
#pragma unroll
    for (int i = 0; i < 4; ++i) tm = fmaxf(tm, S[s][i]);
  tm = fmaxf(tm, __shfl_xor(tm, 16));
  tm = fmaxf(tm, __shfl_xor(tm, 32));
  const float mn = fmaxf(m, tm);
  const float alpha = __expf(m - mn);
  m = mn;
  float ps = 0.f;
#pragma unroll
  for (int s = 0; s < 4; ++s)
#pragma unroll
    for (int i = 0; i < 4; ++i) {
      float pv = __expf(S[s][i] - mn);
      S[s][i] = pv;
      ps += pv;
    }
  lsum = lsum * alpha + ps;
#pragma unroll
  for (int dt = 0; dt < DV / 16; ++dt) {
    O[dt][0] *= alpha; O[dt][1] *= alpha; O[dt][2] *= alpha; O[dt][3] *= alpha;
  }
  bf16x8 pb[2];
  pb[0] = pack8(S[0], S[1]);
  pb[1] = pack8(S[2], S[3]);
  pv_step<DV>(pb, sV, O, fr, fq);
}

DI void dense_item(const P& p, int b, int h, int qb, char* smem) {
  bf16_t* sK = (bf16_t*)smem;
  bf16_t* sV = sK + 64 * LDT;
  const int tid_ = otid(), lane = tid_ & 63, wid = tid_ >> 6, fr = lane & 15, fq = lane >> 4;
  const bf16_t* Z = (const bf16_t*)(p.ws + WS_Z);
  const bf16_t* VT = (const bf16_t*)(p.ws + WS_VTNA) + (size_t)(b * 512 + h * 64) * 256;
  bf16_t* Y4 = (bf16_t*)(p.ws + WS_Y4);
  const int rowbase = b * 256;
  const int qrow = rowbase + qb * 64 + wid * 16 + fr;
  bf16x8 qf[2];
#pragma unroll
  for (int ks = 0; ks < 2; ++ks) qf[ks] = *(const bf16x8*)(Z + (size_t)qrow * ZLD + ZC_NAQ + h * 64 + ks * 32 + fq * 8);
  f32x4 O[4];
#pragma unroll
  for (int dt = 0; dt < 4; ++dt) O[dt] = f32x4{0.f, 0.f, 0.f, 0.f};
  float m = -1e30f, lsum = 0.f;
  for (int kt = 0; kt < 4; ++kt) {
    load_kv<64>(Z + (size_t)(rowbase + kt * 64) * ZLD + ZC_NAK + h * 64, ZLD, VT + kt * 64, 256, sK, sV);
    __syncthreads();
    f32x4 S[4];
    qk_scores(qf, sK, S, fr, fq);
#pragma unroll
    for (int s = 0; s < 4; ++s) { S[s][0] *= 0.125f; S[s][1] *= 0.125f; S[s][2] *= 0.125f; S[s][3] *= 0.125f; }
    softmax_pv<64>(S, sV, O, m, lsum, fr, fq);
    __syncthreads();
  }
  float lt = lsum + __shfl_xor(lsum, 16);
  lt += __shfl_xor(lt, 32);
  const float inv = 1.f / lt;
#pragma unroll
  for (int dt = 0; dt < 4; ++dt)
    *(bf16x4*)(Y4 + (size_t)qrow * 2048 + h * 64 + dt * 16 + fq * 4) = pack4(O[dt][0] * inv, O[dt][1] * inv, O[dt][2] * inv, O[dt][3] * inv);
}

DI void na_item(const P& p, int l, int b, int h, int r, char* smem) {
  bf16_t* sK = (bf16_t*)smem;
  bf16_t* sV = sK + 64 * LDT;
  float* srpb = (float*)(sV + 128 * LDT);
  const int tid = otid(), lane = tid & 63, wid = tid >> 6, fr = lane & 15, fq = lane >> 4;
  const bf16_t* Z = (const bf16_t*)(p.ws + WS_Z);
  const bf16_t* VT = (const bf16_t*)(p.ws + WS_VTNA) + VT_LAT + (size_t)(b * 512 + h * 64) * 2048;
  const bf16_t* CK = (const bf16_t*)(p.ws + WS_CKNA) + (size_t)(b * 8 + h) * 32768;
  const bf16_t* CVT = (const bf16_t*)(p.ws + WS_CVNA) + (size_t)(b * 8 + h) * 32768;
  bf16_t* Y4 = (bf16_t*)(p.ws + WS_Y4);
  for (int i = tid; i < 465; i += 256) srpb[i] = p.in[19][(size_t)(l * 8 + h) * 465 + i];
  const int rowbase = NCTX + b * 2048;
  const int qcol = wid * 16 + fr;
  const int qrow = rowbase + r * 64 + qcol;
  bf16x8 qf[2];
#pragma unroll
  for (int ks = 0; ks < 2; ++ks) qf[ks] = *(const bf16x8*)(Z + (size_t)qrow * ZLD + ZC_NAQ + h * 64 + ks * 32 + fq * 8);
  f32x4 O[4];
#pragma unroll
  for (int dt = 0; dt < 4; ++dt) O[dt] = f32x4{0.f, 0.f, 0.f, 0.f};
  float m = -1e30f, lsum = 0.f;
  int rs = r - 4;
  rs = rs < 0 ? 0 : (rs > 24 ? 24 : rs);
  int cstart = qcol - 8;
  cstart = cstart < 0 ? 0 : (cstart > 48 ? 48 : cstart);
  for (int j = 0; j < 8; ++j) {
    const int krow = rs + j;
    load_kv<64>(Z + (size_t)(rowbase + krow * 64) * ZLD + ZC_NAK + h * 64, ZLD, VT + krow * 64, 2048, sK, sV);
    __syncthreads();
    f32x4 S[4];
    qk_scores(qf, sK, S, fr, fq);
    const int dr = krow - r + 7;
#pragma unroll
    for (int s = 0; s < 4; ++s)
#pragma unroll
      for (int i = 0; i < 4; ++i) {
        int kcol = s * 16 + fq * 4 + i;
        bool ok = (kcol >= cstart) && (kcol < cstart + 16);
        int dc = kcol - qcol + 15;
        dc = dc < 0 ? 0 : (dc > 30 ? 30 : dc);
        float bias = srpb[dr * 31 + dc];
        S[s][i] = ok ? (S[s][i] * 0.125f + bias) : -1e30f;
      }
    softmax_pv<64>(S, sV, O, m, lsum, fr, fq);
    __syncthreads();
  }
  for (int j = 0; j < 8; ++j) {
    load_kv<64>(CK + (size_t)j * 64 * 64, 64, CVT + j * 64, 512, sK, sV);
    __syncthreads();
    f32x4 S[4];
    qk_scores(qf, sK, S, fr, fq);
#pragma unroll
    for (int s = 0; s < 4; ++s) { S[s][0] *= 0.125f; S[s][1] *= 0.125f; S[s][2] *= 0.125f; S[s][3] *= 0.125f; }
    softmax_pv<64>(S, sV, O, m, lsum, fr, fq);
    __syncthreads();
  }
  float lt = lsum + __shfl_xor(lsum, 16);
  lt += __shfl_xor(lt, 32);
  const float inv = 1.f / lt;
#pragma unroll
  for (int dt = 0; dt < 4; ++dt)
    *(bf16x4*)(Y4 + (size_t)qrow * 2048 + h * 64 + dt * 16 + fq * 4) = pack4(O[dt][0] * inv, O[dt][1] * inv, O[dt][2] * inv, O[dt][3] * inv);
}

DI void diff_item(const P& p, int l, bool latent, int b, int h, int qb, char* smem) {
  bf16_t* sK = (bf16_t*)smem;
  bf16_t* sV = sK + 64 * LDT;
  const int tid_ = otid(), lane = tid_ & 63, wid = tid_ >> 6, fr = lane & 15, fq = lane >> 4;
  const bf16_t* Z = (const bf16_t*)(p.ws + WS_Z);
  const int T = latent ? 2048 : 256;
  const int rowbase = latent ? NCTX + b * 2048 : b * 256;
  const bf16_t* VT = (const bf16_t*)(p.ws + WS_VTDF) + (latent ? (size_t)VT_LAT + (size_t)(b * 512 + h * 128) * 2048 : (size_t)(b * 512 + h * 128) * 256);
  const bf16_t* CVT = (const bf16_t*)(p.ws + WS_CVDF) + (size_t)(b * 4 + h) * 65536;
  bf16_t* Y4 = (bf16_t*)(p.ws + WS_Y4);
  const int qrow = rowbase + qb * 64 + wid * 16 + fr;
  float d1 = p.in[20][l * 64 + lane] * p.in[21][l * 64 + lane];
  float d2 = p.in[22][l * 64 + lane] * p.in[23][l * 64 + lane];
  d1 = wave_sum(d1);
  d2 = wave_sum(d2);
  const float lam_init = 0.8f - 0.6f * expf(-0.3f * (float)l);
  const float lam = expf(d1) - expf(d2) + lam_init;

  f32x4 O1[8];
  f32x4 O[8];
  for (int comp = 0; comp < 2; ++comp) {
    bf16x8 qf[2];
#pragma unroll
    for (int ks = 0; ks < 2; ++ks) qf[ks] = *(const bf16x8*)(Z + (size_t)qrow * ZLD + ZC_DFQ + comp * 256 + h * 64 + ks * 32 + fq * 8);
#pragma unroll
    for (int dt = 0; dt < 8; ++dt) O[dt] = f32x4{0.f, 0.f, 0.f, 0.f};
    float m = -1e30f, lsum = 0.f;
    const int nkt = T >> 6;
    for (int kt = 0; kt < nkt; ++kt) {
      load_kv<128>(Z + (size_t)(rowbase + kt * 64) * ZLD + ZC_DFK + comp * 256 + h * 64, ZLD, VT + kt * 64, T, sK, sV);
      __syncthreads();
      f32x4 S[4];
      qk_scores(qf, sK, S, fr, fq);
#pragma unroll
      for (int s = 0; s < 4; ++s) { S[s][0] *= 0.125f; S[s][1] *= 0.125f; S[s][2] *= 0.125f; S[s][3] *= 0.125f; }
      softmax_pv<128>(S, sV, O, m, lsum, fr, fq);
      __syncthreads();
    }
    if (latent) {
      const bf16_t* CK = (const bf16_t*)(p.ws + WS_CKDF) + (size_t)((b * 2 + comp) * 4 + h) * 32768;
      for (int j = 0; j < 8; ++j) {
        load_kv<128>(CK + (size_t)j * 64 * 64, 64, CVT + j * 64, 512, sK, sV);
        __syncthreads();
        f32x4 S[4];
        qk_scores(qf, sK, S, fr, fq);
#pragma unroll
        for (int s = 0; s < 4; ++s) { S[s][0] *= 0.125f; S[s][1] *= 0.125f; S[s][2] *= 0.125f; S[s][3] *= 0.125f; }
        softmax_pv<128>(S, sV, O, m, lsum, fr, fq);
        __syncthreads();
      }
    }
    float lt = lsum + __shfl_xor(lsum, 16);
    lt += __shfl_xor(lt, 32);
    const float inv = 1.f / lt;
    if (comp == 0) {
#pragma unroll
      for (int dt = 0; dt < 8; ++dt) { O1[dt][0] = O[dt][0] * inv; O1[dt][1] = O[dt][1] * inv; O1[dt][2] = O[dt][2] * inv; O1[dt][3] = O[dt][3] * inv; }
    } else {
#pragma unroll
      for (int dt = 0; dt < 8; ++dt) {
        O[dt][0] = O1[dt][0] - lam * (O[dt][0] * inv);
        O[dt][1] = O1[dt][1] - lam * (O[dt][1] * inv);
        O[dt][2] = O1[dt][2] - lam * (O[dt][2] * inv);
        O[dt][3] = O1[dt][3] - lam * (O[dt][3] * inv);
      }
    }
  }
  float ss = 0.f;
#pragma unroll
  for (int dt = 0; dt < 8; ++dt) ss += O[dt][0] * O[dt][0] + O[dt][1] * O[dt][1] + O[dt][2] * O[dt][2] + O[dt][3] * O[dt][3];
  ss += __shfl_xor(ss, 16);
  ss += __shfl_xor(ss, 32);
  const float rsn = rsqrtf(ss * (1.f / 128.f) + 1e-6f) * (1.f - lam_init);
  const float* gn = p.in[24] + l * 128;
#pragma unroll
  for (int dt = 0; dt < 8; ++dt) {
    int dv = dt * 16 + fq * 4;
    float4 g = *(const float4*)(gn + dv);
    *(bf16x4*)(Y4 + (size_t)qrow * 2048 + 512 + h * 128 + dv) = pack4(O[dt][0] * rsn * g.x, O[dt][1] * rsn * g.y, O[dt][2] * rsn * g.z, O[dt][3] * rsn * g.w);
  }
}

DI void ret_item(const P& p, int l, bool latent, int b, int h, int qb, char* smem) {
  bf16_t* sK = (bf16_t*)smem;
  bf16_t* sV = sK + 64 * LDT;
  const int tid = otid(), lane = tid & 63, wid = tid >> 6, fr = lane & 15, fq = lane >> 4;
  const bf16_t* Z = (const bf16_t*)(p.ws + WS_Z);
  const int T = latent ? 2048 : 256;
  const int rowbase = latent ? NCTX + b * 2048 : b * 256;
  const bf16_t* VT = (const bf16_t*)(p.ws + WS_VTRT) + (latent ? (size_t)VT_LAT + (size_t)(b * 512 + h * 64) * 2048 : (size_t)(b * 512 + h * 64) * 256);
  bf16_t* Y4 = (bf16_t*)(p.ws + WS_Y4);
  const int tq = qb * 64 + wid * 16 + fr;
  const int qrow = rowbase + tq;
  const float lgf = log1pf(-expf(p.in[25][l * 8 + h]));
  const float lgb = log1pf(-expf(p.in[26][l * 8 + h]));
  bf16x8 qf[2];
#pragma unroll
  for (int ks = 0; ks < 2; ++ks) qf[ks] = *(const bf16x8*)(Z + (size_t)qrow * ZLD + ZC_RTQ + h * 64 + ks * 32 + fq * 8);
  f32x4 O[4];
#pragma unroll
  for (int dt = 0; dt < 4; ++dt) O[dt] = f32x4{0.f, 0.f, 0.f, 0.f};
  const int nkt = T >> 6;
  for (int kt = 0; kt < nkt; ++kt) {
    load_kv<64>(Z + (size_t)(rowbase + kt * 64) * ZLD + ZC_RTK + h * 64, ZLD, VT + kt * 64, T, sK, sV);
    __syncthreads();
    f32x4 S[4];
    qk_scores(qf, sK, S, fr, fq);
#pragma unroll
    for (int s = 0; s < 4; ++s)
#pragma unroll
      for (int i = 0; i < 4; ++i) {
        int tk = kt * 64 + s * 16 + fq * 4 + i;
        int dd = tq - tk;
        float w = dd >= 0 ? __expf(lgf * (float)dd) : __expf(lgb * (float)(-dd));
        S[s][i] *= w;
      }
    bf16x8 pb[2];
    pb[0] = pack8(S[0], S[1]);
    pb[1] = pack8(S[2], S[3]);
    pv_step<64>(pb, sV, O, fr, fq);
    __syncthreads();
  }
  if (latent) {
    for (int dir = 0; dir < 2; ++dir) {
      const float* S0 = (dir == 0 ? p.in[6] : p.in[7]) + ((size_t)((b * 4 + l) * 8 + h)) * 4096;
#pragma unroll
      for (int i = 0; i < 4; ++i) {
        int e = (tid + i * 256) * 4;
        float4 v = *(const float4*)(S0 + e);
        int dk = e >> 6, dv = e & 63;
        sV[(dv + 0) * LDT + dk] = f2bf(v.x);
        sV[(dv + 1) * LDT + dk] = f2bf(v.y);
        sV[(dv + 2) * LDT + dk] = f2bf(v.z);
        sV[(dv + 3) * LDT + dk] = f2bf(v.w);
      }
      __syncthreads();
      const float sc = dir == 0 ? __expf(lgf * (float)(tq + 1)) : __expf(lgb * (float)(T - tq));
      bf16x8 pb[2];
#pragma unroll
      for (int s2 = 0; s2 < 2; ++s2) {
        const bf16_t* qp = Z + (size_t)qrow * ZLD + ZC_RTQ + h * 64 + 32 * s2 + 4 * fq;
        bf16x4 lo = *(const bf16x4*)qp;
        bf16x4 hi = *(const bf16x4*)(qp + 16);
        bf16x8 r;
#pragma unroll
        for (int j = 0; j < 4; ++j) {
          r[j] = (short)f2bf(bfs2f(lo[j]) * sc);
          r[4 + j] = (short)f2bf(bfs2f(hi[j]) * sc);
        }
        pb[s2] = r;
      }
      pv_step<64>(pb, sV, O, fr, fq);
      __syncthreads();
    }
  }
  float ss = 0.f;
#pragma unroll
  for (int dt = 0; dt < 4; ++dt) ss += O[dt][0] * O[dt][0] + O[dt][1] * O[dt][1] + O[dt][2] * O[dt][2] + O[dt][3] * O[dt][3];
  ss += __shfl_xor(ss, 16);
  ss += __shfl_xor(ss, 32);
  const float rsn = rsqrtf(ss * (1.f / 64.f) + 1e-6f);
  const float* gn = p.in[27] + l * 512 + h * 64;
#pragma unroll
  for (int dt = 0; dt < 4; ++dt) {
    int dv = dt * 16 + fq * 4;
    float4 g = *(const float4*)(gn + dv);
    bf16x4 sg = *(const bf16x4*)(Z + (size_t)qrow * ZLD + ZC_RTG + h * 64 + dv);
    *(bf16x4*)(Y4 + (size_t)qrow * 2048 + 1024 + h * 64 + dv) =
        pack4(O[dt][0] * rsn * g.x * bfs2f(sg[0]), O[dt][1] * rsn * g.y * bfs2f(sg[1]), O[dt][2] * rsn * g.z * bfs2f(sg[2]), O[dt][3] * rsn * g.w * bfs2f(sg[3]));
  }
}

DI void ret_state_item(const P& p, int l, int b, int h) {
  const int tid_ = otid(), lane = tid_ & 63, wid = tid_ >> 6, fr = lane & 15, fq = lane >> 4;
  const bf16_t* KT = (const bf16_t*)(p.ws + WS_KTRT) + (size_t)(b * 512 + h * 64) * 256;
  const bf16_t* VT = (const bf16_t*)(p.ws + WS_VTRT) + (size_t)(b * 512 + h * 64) * 256;
  const float lgf = log1pf(-expf(p.in[25][l * 8 + h]));
  const float lgb = log1pf(-expf(p.in[26][l * 8 + h]));
  f32x4 af[4], ab[4];
#pragma unroll
  for (int nt = 0; nt < 4; ++nt) { af[nt] = f32x4{0.f, 0.f, 0.f, 0.f}; ab[nt] = f32x4{0.f, 0.f, 0.f, 0.f}; }
  for (int ks = 0; ks < 8; ++ks) {
    const int t0 = ks * 32 + fq * 8;
    bf16x8 kraw = *(const bf16x8*)(KT + (size_t)(wid * 16 + fr) * 256 + t0);
    bf16x8 kf, kb;
#pragma unroll
    for (int j = 0; j < 8; ++j) {
      float kv = bfs2f(kraw[j]);
      int t = t0 + j;
      kf[j] = (short)f2bf(kv * __expf(lgf * (float)(255 - t)));
      kb[j] = (short)f2bf(kv * __expf(lgb * (float)t));
    }
#pragma unroll
    for (int nt = 0; nt < 4; ++nt) {
      bf16x8 vb = *(const bf16x8*)(VT + (size_t)(nt * 16 + fr) * 256 + t0);
      af[nt] = MFMA16(kf, vb, af[nt]);
      ab[nt] = MFMA16(kb, vb, ab[nt]);
    }
  }
  float* of = p.out + O_RF + ((size_t)((b * 4 + l) * 8 + h)) * 4096;
  float* ob = p.out + O_RB + ((size_t)((b * 4 + l) * 8 + h)) * 4096;
#pragma unroll
  for (int nt = 0; nt < 4; ++nt)
#pragma unroll
    for (int i = 0; i < 4; ++i) {
      int dk = wid * 16 + fq * 4 + i, dv = nt * 16 + fr;
      of[dk * 64 + dv] = af[nt][i];
      ob[dk * 64 + dv] = ab[nt][i];
    }
}

DI void lru_item(const P& p, int l, int bglob, int n, char* smem) {
  float* XDf = (float*)smem;
  float* Aa = XDf + 4096;
  float* Uu = Aa + 4096;
  bf16_t* XDb = (bf16_t*)(Uu + 4096);
  const int tid = otid(), lane = tid & 63, wid = tid >> 6, fr = lane & 15, fq = lane >> 4;
  const bool latent = bglob >= 32;
  const int T = latent ? 2048 : 256;
  const int rowbase = latent ? NCTX + (bglob - 32) * 2048 : bglob * 256;
  const bf16_t* Z = (const bf16_t*)(p.ws + WS_Z);
  bf16_t* Y4 = (bf16_t*)(p.ws + WS_Y4);
  const bf16_t* WL = (const bf16_t*)(p.ws + WS_WLRU);
  const int ch0 = n * 64;
  const float cw0 = p.in[28][(l * 4 + 0) * 512 + ch0 + lane];
  const float cw1 = p.in[28][(l * 4 + 1) * 512 + ch0 + lane];
  const float cw2 = p.in[28][(l * 4 + 2) * 512 + ch0 + lane];
  const float cw3 = p.in[28][(l * 4 + 3) * 512 + ch0 + lane];
  const float cb = p.in[29][l * 512 + ch0 + lane];
  const bf16_t* xcol = Z + ZC_LRX + ch0 + lane;
  const int nch = T >> 6;
  for (int dir = 0; dir < 2; ++dir) {
    const float* bav = (dir == 0 ? p.in[31] : p.in[36]) + l * 512 + ch0;
    const float* bxv = (dir == 0 ? p.in[33] : p.in[38]) + l * 512 + ch0;
    const float* lamv = (dir == 0 ? p.in[34] : p.in[39]) + l * 512 + ch0;
    float hc = 0.f;
    if (latent) hc = (dir == 0 ? p.in[8] : p.in[9])[((bglob - 32) * 4 + l) * 512 + ch0 + lane];
    for (int cc = 0; cc < nch; ++cc) {
      const int chunk = dir == 0 ? cc : nch - 1 - cc;
      {
        const int t0 = chunk * 64 + wid * 16;
        auto ld = [&](int t) -> float { return (t < 0 || t >= T) ? 0.f : bf2f(xcol[(size_t)(rowbase + t) * ZLD]); };
        float xm1 = ld(t0 - 1), x0 = ld(t0), x1 = ld(t0 + 1);
#pragma unroll 4
        for (int i = 0; i < 16; ++i) {
          float x2 = ld(t0 + i + 2);
          float xd = cw0 * xm1 + cw1 * x0 + cw2 * x1 + cw3 * x2 + cb;
          XDf[(wid * 16 + i) * 64 + lane] = xd;
          XDb[(wid * 16 + i) * LDT + lane] = f2bf(xd);
          xm1 = x0; x0 = x1; x1 = x2;
        }
      }
      __syncthreads();
      {
        bf16x8 af[2];
#pragma unroll
        for (int ks = 0; ks < 2; ++ks) af[ks] = *(const bf16x8*)(XDb + (wid * 16 + fr) * LDT + ks * 32 + fq * 8);
#pragma unroll
        for (int et = 0; et < 4; ++et) {
          f32x4 da = {0.f, 0.f, 0.f, 0.f}, dx = {0.f, 0.f, 0.f, 0.f};
#pragma unroll
          for (int ks = 0; ks < 2; ++ks) {
            bf16x8 wa = *(const bf16x8*)(WL + (size_t)((dir * 2 + 0) * 8 + n) * 4096 + (et * 16 + fr) * 64 + ks * 32 + fq * 8);
            bf16x8 wx = *(const bf16x8*)(WL + (size_t)((dir * 2 + 1) * 8 + n) * 4096 + (et * 16 + fr) * 64 + ks * 32 + fq * 8);
            da = MFMA16(af[ks], wa, da);
            dx = MFMA16(af[ks], wx, dx);
          }
          const int e = et * 16 + fr;
          const float ba_ = bav[e], bx_ = bxv[e];
          const float sp = log1pf(expf(-lamv[e]));
#pragma unroll
          for (int i = 0; i < 4; ++i) {
            int tl = wid * 16 + fq * 4 + i;
            float rg = 1.f / (1.f + expf(-(da[i] + ba_)));
            float ig = 1.f / (1.f + expf(-(dx[i] + bx_)));
            float la = -8.f * rg * sp;
            float a = expf(la);
            float u = sqrtf(-expm1f(2.f * la)) * (ig * XDf[tl * 64 + e]);
            Aa[tl * 64 + e] = a;
            Uu[tl * 64 + e] = u;
          }
        }
      }
      __syncthreads();
      if (wid == 0) {
        for (int s = 0; s < 64; ++s) {
          int tl = dir == 0 ? s : 63 - s;
          hc = Aa[tl * 64 + lane] * hc + Uu[tl * 64 + lane];
          Uu[tl * 64 + lane] = hc;
        }
      }
      __syncthreads();
#pragma unroll 4
      for (int i = 0; i < 16; ++i) {
        int idx = tid + i * 256, tl = idx >> 6, e = idx & 63;
        size_t row = (size_t)(rowbase + chunk * 64 + tl);
        bf16_t* yp = Y4 + row * 2048 + 1536 + ch0 + e;
        float hv = Uu[tl * 64 + e];
        if (dir == 0) {
          *yp = f2bf(hv);
        } else {
          float hf = bf2f(*yp);
          float g = bf2f(Z[row * ZLD + ZC_LRG + ch0 + e]);
          *yp = f2bf((hf + hv) * g);
        }
      }
    }
    if (!latent && wid == 0) p.out[(dir == 0 ? O_LF : O_LB) + (size_t)(bglob * 4 + l) * 512 + ch0 + lane] = hc;
    __syncthreads();
  }
}

DI void phase_mix(const P& p, int l, char* smem) {
  const int NITEMS = 5664;
  for (int it = blockIdx.x; it < NITEMS; it += gridDim.x) {
    int q = it;
    if (q < 32) { lru_item(p, l, 32 + (q >> 3), q & 7, smem); continue; }
    q -= 32;
    if (q < 512) { diff_item(p, l, true, q >> 7, (q >> 5) & 3, q & 31, smem); continue; }
    q -= 512;
    if (q < 1024) { ret_item(p, l, true, q >> 8, (q >> 5) & 7, q & 31, smem); continue; }
    q -= 1024;
    if (q < 1024) { na_item(p, l, q >> 8, (q >> 5) & 7, q & 31, smem); continue; }
    q -= 1024;
    if (q < 1024) { dense_item(p, q >> 5, (q >> 2) & 7, q & 3, smem); continue; }
    q -= 1024;
    if (q < 512) { diff_item(p, l, false, q >> 4, (q >> 2) & 3, q & 3, smem); continue; }
    q -= 512;
    if (q < 1024) { ret_item(p, l, false, q >> 5, (q >> 2) & 7, q & 3, smem); continue; }
    q -= 1024;
    if (q < 256) { ret_state_item(p, l, q >> 3, q & 7); continue; }
    q -= 256;
    lru_item(p, l, q >> 3, q & 7, smem);
  }
}

enum { PH_INIT = 0, PH_PRE0, PH_GIN, PH_MIX, PH_MERGE, PH_OUT, PH_POSTMIX, PH_FF1, PH_FF2, PH_POSTFFN };

DI void run_phase(const P& p, int ph, int l, char* smem) {
  switch (ph) {
    case PH_INIT:
      phase_mod(p, smem);
      phase_convert(p, 0, smem);
      break;
    case PH_PRE0: phase_row(p, 0, 0); break;
    case PH_GIN: phase_gin(p, l, smem); break;
    case PH_MIX: phase_mix(p, l, smem); break;
    case PH_MERGE: phase_merge(p, smem); break;
    case PH_OUT:
      phase_gemm_plain<0>((const bf16_t*)(p.ws + WS_H), 1024, (const bf16_t*)(p.ws + WS_WOUT), 1024, (void*)(p.ws + WS_Y), smem);
      break;
    case PH_POSTMIX: phase_row(p, l, 1); break;
    case PH_FF1:
      phase_gemm_plain<1>((const bf16_t*)(p.ws + WS_H), 1024, (const bf16_t*)(p.ws + WS_W1), 4096, (void*)(p.ws + WS_U), smem);
      break;
    case PH_FF2:
      phase_gemm_plain<0>((const bf16_t*)(p.ws + WS_U), 4096, (const bf16_t*)(p.ws + WS_W2), 1024, (void*)(p.ws + WS_Y), smem);
      break;
    case PH_POSTFFN:
      phase_row(p, l, 2);
      if (l < 3) phase_convert(p, l + 1, smem);
      break;
    default: break;
  }
}

DI void decode_step(int step, int& ph, int& l) {
  if (step < 2) { ph = step; l = 0; }
  else { int s = step - 2; l = s >> 3; ph = PH_GIN + (s & 7); }
}
constexpr int NSTEPS = 34;

__global__ void __launch_bounds__(256, 2) hybrid_flow_mega(P p) {
  __shared__ __attribute__((aligned(16))) char smem[SMEM_BYTES];
  cg::grid_group grid = cg::this_grid();
  for (int step = 0; step < NSTEPS; ++step) {
    int ph, l;
    decode_step(step, ph, l);
    run_phase(p, ph, l, smem);
    grid.sync();
  }
}

#if !ONE_LAUNCH
__global__ void __launch_bounds__(256, 2) hybrid_flow_phase(P p, int ph, int l) {
  __shared__ __attribute__((aligned(16))) char smem[SMEM_BYTES];
  run_phase(p, ph, l, smem);
}
#endif

extern "C" void kernel_launch(void* const* d_in, const int* in_sizes, int n_in, void* d_out, int out_size, void* d_ws,
                              size_t ws_size, hipStream_t stream) {
  (void)in_sizes; (void)n_in; (void)out_size; (void)ws_size;
  P p{};
  for (int i = 0; i < 44; ++i) p.in[i] = (const float*)d_in[i];
  p.out = (float*)d_out;
  p.ws = (char*)d_ws;
#if ONE_LAUNCH
  static int grid_blocks = 0;
  if (!grid_blocks) {
    int dev = 0, cus = 0, per_cu = 0;
    hipGetDevice(&dev);
    hipDeviceGetAttribute(&cus, hipDeviceAttributeMultiprocessorCount, dev);
    hipOccupancyMaxActiveBlocksPerMultiprocessor(&per_cu, hybrid_flow_mega, 256, 0);
    if (per_cu < 1) per_cu = 1;
    if (per_cu > 2) per_cu = 2;
    grid_blocks = cus * per_cu;
  }
  void* args[] = {&p};
  hipError_t e = hipLaunchCooperativeKernel((void*)hybrid_flow_mega, dim3(grid_blocks), dim3(256), args, 0, stream);
  if (e != hipSuccess) fprintf(stderr, "cooperative launch failed: %s (grid %d)\n", hipGetErrorString(e), grid_blocks);
#else
  const int grid_blocks = 512;
  for (int step = 0; step < NSTEPS; ++step) {
    int ph, l;
    if (step < 2) { ph = step; l = 0; }
    else { int s = step - 2; l = s >> 3; ph = PH_GIN + (s & 7); }
    hipLaunchKernelGGL(hybrid_flow_phase, dim3(grid_blocks), dim3(256), 0, stream, p, ph, l);
  }
#endif
}
```

```cpp
#include <hip/hip_runtime.h>
#include <hip/hip_cooperative_groups.h>
#include <cstdio>
namespace cg = cooperative_groups;

#ifndef ONE_LAUNCH
#define ONE_LAUNCH 1
#endif

typedef unsigned short bf16_t;
using bf16x8 = __attribute__((ext_vector_type(8))) short;
using bf16x4 = __attribute__((ext_vector_type(4))) short;
using f32x4 = __attribute__((ext_vector_type(4))) float;
using u32x4 = __attribute__((ext_vector_type(4))) unsigned;
#define DI __device__ __forceinline__
#define MFMA16(a, b, c) __builtin_amdgcn_mfma_f32_16x16x32_bf16((a), (b), (c), 0, 0, 0)

struct P {
  const float* in[44];
  float* out;
  char* ws;
};

constexpr int D = 1024, NCTX = 8192;
constexpr int ZLD = 8256;
constexpr int ZC_NAQ = 0, ZC_NAK = 512, ZC_DFQ = 1024, ZC_DFK = 1536, ZC_RTQ = 2048, ZC_RTK = 2560, ZC_RTG = 3072,
              ZC_LRX = 3584, ZC_GATE = 4096;
constexpr int LDT = 72;

constexpr size_t WS_WIN = 0;
constexpr size_t WS_WBR = WS_WIN + (size_t)10240 * 1024 * 2;
constexpr size_t WS_WOUT = WS_WBR + (size_t)1024 * 2048 * 2;
constexpr size_t WS_W1 = WS_WOUT + (size_t)1024 * 1024 * 2;
constexpr size_t WS_W2 = WS_W1 + (size_t)4096 * 1024 * 2;
constexpr size_t WS_WLRU = WS_W2 + (size_t)4096 * 1024 * 2;
constexpr size_t WS_CKNA = WS_WLRU + (size_t)32 * 4096 * 2;
constexpr size_t WS_CVNA = WS_CKNA + (size_t)4 * 262144 * 2;
constexpr size_t WS_CKDF = WS_CVNA + (size_t)4 * 262144 * 2;
constexpr size_t WS_CVDF = WS_CKDF + (size_t)4 * 262144 * 2;
constexpr size_t WS_MOD = WS_CVDF + (size_t)4 * 262144 * 2;
constexpr size_t WS_H = WS_MOD + (size_t)4 * 5 * 6144 * 4;
constexpr size_t WS_Y4 = WS_H + (size_t)16384 * 1024 * 2;
constexpr size_t WS_VTNA = WS_Y4 + (size_t)16384 * 2048 * 2;
constexpr size_t WS_VTDF = WS_VTNA + (size_t)16384 * 512 * 2;
constexpr size_t WS_VTRT = WS_VTDF + (size_t)16384 * 512 * 2;
constexpr size_t WS_KTRT = WS_VTRT + (size_t)16384 * 512 * 2;
constexpr size_t WS_Z = WS_KTRT + (size_t)8192 * 512 * 2;
constexpr size_t WS_Y = WS_Z;
constexpr size_t WS_U = WS_Z + (size_t)16384 * 1024 * 4;
constexpr size_t WS_LA = WS_Z + (size_t)16384 * ZLD * 2;
constexpr size_t WS_LU = WS_LA + (size_t)2 * 16384 * 512 * 2;
constexpr size_t WS_HF = WS_LU + (size_t)2 * 16384 * 512 * 2;
constexpr size_t WS_LG = WS_HF + (size_t)16384 * 512 * 2;
constexpr size_t WS_END = WS_LG + (size_t)16384 * 512 * 2;

constexpr size_t O_NAK = 16777216, O_NAV = 33554432, O_DFK = 50331648, O_DFV = 67108864, O_RF = 83886080,
                 O_RB = 88080384, O_LF = 92274688, O_LB = 92340224;
constexpr int VT_LAT = 4194304;

constexpr int SMEM_BYTES = 59392;

DI int otid() {
  int t = threadIdx.x;
  asm volatile("" : "+v"(t));
  return t;
}
DI bf16_t f2bf(float x) {
  unsigned u = __float_as_uint(x);
  u += 0x7fffu + ((u >> 16) & 1u);
  return (bf16_t)(u >> 16);
}
DI float bf2f(bf16_t b) { return __uint_as_float(((unsigned)b) << 16); }
DI float bfs2f(short b) { return __uint_as_float(((unsigned)(unsigned short)b) << 16); }
DI float wave_sum(float v) {
#pragma unroll
  for (int o = 32; o > 0; o >>= 1) v += __shfl_xor(v, o);
  return v;
}
DI float sigmoidf_(float x) { return 1.f / (1.f + __expf(-x)); }
DI float gelu_tanh(float x) {
  float u = 0.7978845608028654f * (x + 0.044715f * x * x * x);
  return 0.5f * x * (1.f + tanhf(u));
}
DI bf16x8 pack8(const f32x4& a, const f32x4& b) {
  bf16x8 r;
  r[0] = (short)f2bf(a[0]); r[1] = (short)f2bf(a[1]); r[2] = (short)f2bf(a[2]); r[3] = (short)f2bf(a[3]);
  r[4] = (short)f2bf(b[0]); r[5] = (short)f2bf(b[1]); r[6] = (short)f2bf(b[2]); r[7] = (short)f2bf(b[3]);
  return r;
}
DI bf16x4 pack4(float a, float b, float c, float d) {
  bf16x4 r;
  r[0] = (short)f2bf(a); r[1] = (short)f2bf(b); r[2] = (short)f2bf(c); r[3] = (short)f2bf(d);
  return r;
}

DI void gemm_mainloop(const bf16_t* __restrict__ A, int lda, const bf16_t* __restrict__ Bt, int ldb, int K, int row0,
                      int col0, bf16_t* sA, bf16_t* sB, f32x4 (&acc)[4][4]) {
  const int tid = otid(), lane = tid & 63, wid = tid >> 6;
  const int wm = wid >> 1, wn = wid & 1, fr = lane & 15, fq = lane >> 4;
  const bf16_t* Ag = A + (size_t)row0 * lda;
  const bf16_t* Bg = Bt + (size_t)col0 * ldb;
  u32x4 ra[4], rb[4];
#pragma unroll
  for (int i = 0; i < 4; ++i) {
    int id = tid + i * 256, r = id >> 3, c = (id & 7) * 8;
    ra[i] = *(const u32x4*)(Ag + (size_t)r * lda + c);
    rb[i] = *(const u32x4*)(Bg + (size_t)r * ldb + c);
  }
#pragma unroll
  for (int i = 0; i < 4; ++i) {
    int id = tid + i * 256, r = id >> 3, c = (id & 7) * 8;
    *(u32x4*)(sA + r * LDT + c) = ra[i];
    *(u32x4*)(sB + r * LDT + c) = rb[i];
  }
  __syncthreads();
  for (int k0 = 0; k0 < K; k0 += 64) {
    const bool more = (k0 + 64) < K;
    if (more) {
#pragma unroll
      for (int i = 0; i < 4; ++i) {
        int id = tid + i * 256, r = id >> 3, c = (id & 7) * 8;
        ra[i] = *(const u32x4*)(Ag + (size_t)r * lda + k0 + 64 + c);
        rb[i] = *(const u32x4*)(Bg + (size_t)r * ldb + k0 + 64 + c);
      }
    }
#pragma unroll
    for (int ks = 0; ks < 2; ++ks) {
      bf16x8 af[4], bfr[4];
#pragma unroll
      for (int mi = 0; mi < 4; ++mi) af[mi] = *(const bf16x8*)(sA + (wm * 64 + mi * 16 + fr) * LDT + ks * 32 + fq * 8);
#pragma unroll
      for (int ni = 0; ni < 4; ++ni) bfr[ni] = *(const bf16x8*)(sB + (wn * 64 + ni * 16 + fr) * LDT + ks * 32 + fq * 8);
#pragma unroll
      for (int mi = 0; mi < 4; ++mi)
#pragma unroll
        for (int ni = 0; ni < 4; ++ni) acc[mi][ni] = MFMA16(af[mi], bfr[ni], acc[mi][ni]);
    }
    __syncthreads();
    if (more) {
#pragma unroll
      for (int i = 0; i < 4; ++i) {
        int id = tid + i * 256, r = id >> 3, c = (id & 7) * 8;
        *(u32x4*)(sA + r * LDT + c) = ra[i];
        *(u32x4*)(sB + r * LDT + c) = rb[i];
      }
      __syncthreads();
    }
  }
}

DI void zero_acc(f32x4 (&acc)[4][4]) {
#pragma unroll
  for (int mi = 0; mi < 4; ++mi)
#pragma unroll
    for (int ni = 0; ni < 4; ++ni) acc[mi][ni] = f32x4{0.f, 0.f, 0.f, 0.f};
}
DI void tile_of(int id, int ntn, int& tm, int& tn) {
  int band = id / (16 * ntn), rem = id % (16 * ntn);
  tm = band * 16 + (rem & 15);
  tn = rem >> 4;
}

DI void epi_in(const P& p, int l, int row0, int col0, f32x4 (&acc)[4][4]) {
  const int tid_ = otid(), lane = tid_ & 63, wid = tid_ >> 6, wm = wid >> 1, wn = wid & 1, fr = lane & 15, fq = lane >> 4;
  const int seg = col0 >> 9;
  const bool ctx = row0 < NCTX;
  bf16_t* Z = (bf16_t*)(p.ws + WS_Z);
  const int rbase = row0 + wm * 64;
  const int cseg0 = (col0 & 511) + wn * 64;

  if (!ctx && (seg == 3 || seg == 4)) {
    const float inv = powf(10000.f, -(float)fr * (1.f / 16.f));
#pragma unroll
    for (int mi = 0; mi < 4; ++mi)
#pragma unroll
      for (int i = 0; i < 4; ++i) {
        int r = rbase + mi * 16 + fq * 4 + i;
        int t = (r - NCTX) & 2047;
        float gr = (float)(t >> 6), gc = (float)(t & 63);
        float sr, cr, sc, cc;
        sincosf(gr * inv, &sr, &cr);
        sincosf(gc * inv, &sc, &cc);
        float a0 = acc[mi][0][i], a1 = acc[mi][1][i], a2 = acc[mi][2][i], a3 = acc[mi][3][i];
        acc[mi][0][i] = a0 * cr - a1 * sr;
        acc[mi][1][i] = a1 * cr + a0 * sr;
        acc[mi][2][i] = a2 * cc - a3 * sc;
        acc[mi][3][i] = a3 * cc + a2 * sc;
      }
  }

  int zc = -1, tf = 0;
  bf16_t* VT = nullptr;
  switch (seg) {
    case 0: zc = ZC_NAQ; break;
    case 1: zc = ZC_NAK; break;
    case 2: VT = (bf16_t*)(p.ws + WS_VTNA); break;
    case 3: zc = ZC_DFQ; break;
    case 4: zc = ZC_DFK; break;
    case 5: VT = (bf16_t*)(p.ws + WS_VTDF); break;
    case 6: zc = ZC_RTQ; break;
    case 7: zc = ZC_RTK; tf = 4; break;
    case 8: VT = (bf16_t*)(p.ws + WS_VTRT); break;
    case 9: zc = ZC_RTG; tf = 1; break;
    case 10: zc = ZC_LRX; break;
    case 11: break;
    default: zc = ZC_GATE + (seg - 12) * 512; tf = 3; break;
  }

  if (zc >= 0) {
#pragma unroll
    for (int mi = 0; mi < 4; ++mi)
#pragma unroll
      for (int ni = 0; ni < 4; ++ni)
#pragma unroll
        for (int i = 0; i < 4; ++i) {
          int r = rbase + mi * 16 + fq * 4 + i;
          int c = cseg0 + ni * 16 + fr;
          float v = acc[mi][ni][i];
          if (tf == 1) v = v * sigmoidf_(v);
          else if (tf == 2) v = gelu_tanh(v);
          else if (tf == 3) v = sigmoidf_(v);
          else if (tf == 4) v = v * 0.125f;
          Z[(size_t)r * ZLD + zc + c] = f2bf(v);
        }
  }
  if (VT != nullptr || (seg == 7 && ctx)) {
    bf16_t* T_ = (seg == 7) ? (bf16_t*)(p.ws + WS_KTRT) : VT;
    const float scl = (seg == 7) ? 0.125f : 1.f;
#pragma unroll
    for (int mi = 0; mi < 4; ++mi)
#pragma unroll
      for (int ni = 0; ni < 4; ++ni) {
        int r0 = rbase + mi * 16 + fq * 4;
        int c = cseg0 + ni * 16 + fr;
        size_t idx;
        if (r0 < NCTX) {
          int b = r0 >> 8, t = r0 & 255;
          idx = ((size_t)(b * 512 + c)) * 256 + t;
        } else {
          int rr = r0 - NCTX, b = rr >> 11, t = rr & 2047;
          idx = (size_t)VT_LAT + ((size_t)(b * 512 + c)) * 2048 + t;
        }
        *(bf16x4*)(T_ + idx) = pack4(acc[mi][ni][0] * scl, acc[mi][ni][1] * scl, acc[mi][ni][2] * scl, acc[mi][ni][3] * scl);
      }
  }
  if (seg == 11) {
    bf16_t* LG = (bf16_t*)(p.ws + WS_LG);
#pragma unroll
    for (int mi = 0; mi < 4; ++mi)
#pragma unroll
      for (int ni = 0; ni < 4; ++ni) {
        int r0 = rbase + mi * 16 + fq * 4;
        int c = cseg0 + ni * 16 + fr;
        size_t idx = ((size_t)(r0 >> 6) * 512 + c) * 64 + (r0 & 63);
        *(bf16x4*)(LG + idx) = pack4(gelu_tanh(acc[mi][ni][0]), gelu_tanh(acc[mi][ni][1]), gelu_tanh(acc[mi][ni][2]), gelu_tanh(acc[mi][ni][3]));
      }
  }
  if (ctx && (seg == 1 || seg == 2 || seg == 4 || seg == 5)) {
    float* out = p.out;
#pragma unroll
    for (int mi = 0; mi < 4; ++mi)
#pragma unroll
      for (int ni = 0; ni < 4; ++ni)
#pragma unroll
        for (int i = 0; i < 4; ++i) {
          int r = rbase + mi * 16 + fq * 4 + i;
          int c = cseg0 + ni * 16 + fr;
          int b = r >> 8, t = r & 255;
          size_t off;
          if (seg == 1 || seg == 2) {
            int h = c >> 6, d = c & 63;
            off = (seg == 1 ? O_NAK : O_NAV) + ((((size_t)(b * 4 + l) * 8 + h) * 256 + t) * 64 + d);
          } else if (seg == 4) {
            int comp = c >> 8, h = (c >> 6) & 3, d = c & 63;
            off = O_DFK + (((((size_t)(b * 4 + l) * 2 + comp) * 4 + h) * 256 + t) * 64 + d);
          } else {
            int h = c >> 7, d = c & 127;
            off = O_DFV + ((((size_t)(b * 4 + l) * 4 + h) * 256 + t) * 128 + d);
          }
          out[off] = acc[mi][ni][i];
        }
  }
}

DI void phase_gin(const P& p, int l, char* smem) {
  bf16_t* sA = (bf16_t*)smem;
  bf16_t* sB = sA + 128 * LDT;
  const bf16_t* A = (const bf16_t*)(p.ws + WS_H);
  const bf16_t* Bt = (const bf16_t*)(p.ws + WS_WIN);
  const int ntn = 80, total = 128 * ntn;
  for (int id = blockIdx.x; id < total; id += gridDim.x) {
    int tm, tn;
    tile_of(id, ntn, tm, tn);
    f32x4 acc[4][4];
    zero_acc(acc);
    gemm_mainloop(A, 1024, Bt, 1024, 1024, tm * 128, tn * 128, sA, sB, acc);
    epi_in(p, l, tm * 128, tn * 128, acc);
  }
}

DI void phase_merge(const P& p, char* smem) {
  bf16_t* sA = (bf16_t*)smem;
  bf16_t* sB = sA + 128 * LDT;
  const bf16_t* Y4 = (const bf16_t*)(p.ws + WS_Y4);
  const bf16_t* WB = (const bf16_t*)(p.ws + WS_WBR);
  bf16_t* Z = (bf16_t*)(p.ws + WS_Z);
  bf16_t* G = (bf16_t*)(p.ws + WS_H);
  const int tid_ = otid(), lane = tid_ & 63, wid = tid_ >> 6, wm = wid >> 1, wn = wid & 1, fr = lane & 15, fq = lane >> 4;
  const int ntn = 8, total = 128 * ntn;
  for (int id = blockIdx.x; id < total; id += gridDim.x) {
    int tm, tn;
    tile_of(id, ntn, tm, tn);
    const int row0 = tm * 128, col0 = tn * 128;
#pragma unroll 1
    for (int k = 0; k < 4; ++k) {
      f32x4 acc[4][4];
      zero_acc(acc);
      gemm_mainloop(Y4 + k * 512, 2048, WB + k * 512, 2048, 512, row0, col0, sA, sB, acc);
      int rb_ = row0 + wm * 64 + fq * 4, cb_ = col0 + wn * 64 + fr;
      asm volatile("" : "+v"(rb_), "+v"(cb_));
#pragma unroll
      for (int mi = 0; mi < 4; ++mi)
#pragma unroll
        for (int ni = 0; ni < 4; ++ni)
#pragma unroll
          for (int i = 0; i < 4; ++i) {
            int r = rb_ + mi * 16 + i;
            int c = cb_ + ni * 16;
            float g = bf2f(Z[(size_t)r * ZLD + ZC_GATE + k * 1024 + c]);
            float* g32 = (float*)(Z + (size_t)r * ZLD) + c;
            float o = g * acc[mi][ni][i];
            if (k > 0) o += *g32;
            if (k < 3) *g32 = o;
            else G[(size_t)r * 1024 + c] = f2bf(o);
            if (i == 3) asm volatile("" ::: "memory");
          }
    }
  }
}

template <int MODE>
DI void phase_gemm_plain(const bf16_t* A, int K, const bf16_t* Bt, int N, void* outp, char* smem) {
  bf16_t* sA = (bf16_t*)smem;
  bf16_t* sB = sA + 128 * LDT;
  const int tid_ = otid(), lane = tid_ & 63, wid = tid_ >> 6, wm = wid >> 1, wn = wid & 1, fr = lane & 15, fq = lane >> 4;
  const int ntn = N / 128, total = 128 * ntn;
  for (int id = blockIdx.x; id < total; id += gridDim.x) {
    int tm, tn;
    tile_of(id, ntn, tm, tn);
    const int row0 = tm * 128, col0 = tn * 128;
    f32x4 acc[4][4];
    zero_acc(acc);
    gemm_mainloop(A, K, Bt, K, K, row0, col0, sA, sB, acc);
#pragma unroll
    for (int mi = 0; mi < 4; ++mi)
#pragma unroll
      for (int ni = 0; ni < 4; ++ni)
#pragma unroll
        for (int i = 0; i < 4; ++i) {
          int r = row0 + wm * 64 + mi * 16 + fq * 4 + i;
          int c = col0 + wn * 64 + ni * 16 + fr;
          float v = acc[mi][ni][i];
          if (MODE == 0) {
            ((float*)outp)[(size_t)r * N + c] = v;
          } else {
            v = fmaxf(v, 0.f);
            ((bf16_t*)outp)[(size_t)r * N + c] = f2bf(v * v);
          }
        }
  }
}

DI void phase_mod(const P& p, char* smem) {
  float* ssil = (float*)smem;
  float* red = ssil + 5 * 1024;
  const int tid = otid();
  float* MOD = (float*)(p.ws + WS_MOD);
  for (int idx = tid; idx < 5120; idx += 256) {
    int j = idx >> 10, k = idx & 1023;
    float cv = (j == 0) ? p.in[11][k] : p.in[10][(j - 1) * 1024 + k];
    ssil[idx] = cv / (1.f + expf(-cv));
  }
  __syncthreads();
  const int cl = tid & 63, kg = tid >> 6;
  for (int item = blockIdx.x; item < 384; item += gridDim.x) {
    int l = item / 96, cgp = item % 96;
    int col = cgp * 64 + cl;
    const float* W = p.in[12] + (size_t)l * 1024 * 6144 + col;
    float a0 = 0, a1 = 0, a2 = 0, a3 = 0, a4 = 0;
    for (int k = kg * 256; k < kg * 256 + 256; ++k) {
      float w = W[(size_t)k * 6144];
      a0 += ssil[k] * w;
      a1 += ssil[1024 + k] * w;
      a2 += ssil[2048 + k] * w;
      a3 += ssil[3072 + k] * w;
      a4 += ssil[4096 + k] * w;
    }
    red[(kg * 5 + 0) * 64 + cl] = a0;
    red[(kg * 5 + 1) * 64 + cl] = a1;
    red[(kg * 5 + 2) * 64 + cl] = a2;
    red[(kg * 5 + 3) * 64 + cl] = a3;
    red[(kg * 5 + 4) * 64 + cl] = a4;
    __syncthreads();
    if (kg == 0) {
      float bias = p.in[13][l * 6144 + col];
#pragma unroll
      for (int j = 0; j < 5; ++j) {
        float s = red[(0 * 5 + j) * 64 + cl] + red[(1 * 5 + j) * 64 + cl] + red[(2 * 5 + j) * 64 + cl] + red[(3 * 5 + j) * 64 + cl];
        MOD[(size_t)(l * 5 + j) * 6144 + col] = s + bias;
      }
    }
    __syncthreads();
  }
}

DI void transpose_tile(const float* __restrict__ src, int lds_, bf16_t* __restrict__ dst, int ldd, float* tile) {
  const int tid = otid();
#pragma unroll 4
  for (int i = 0; i < 16; ++i) {
    int idx = tid + i * 256, r = idx >> 6, c = idx & 63;
    tile[r * 65 + c] = src[(size_t)r * lds_ + c];
  }
  __syncthreads();
#pragma unroll 4
  for (int i = 0; i < 16; ++i) {
    int idx = tid + i * 256, c = idx >> 6, r = idx & 63;
    dst[(size_t)c * ldd + r] = f2bf(tile[r * 65 + c]);
  }
  __syncthreads();
}

DI void phase_convert(const P& p, int l, char* smem) {
  float* tile = (float*)smem;
  char* ws = p.ws;
  const int NJ = 6432;
  for (int j = blockIdx.x; j < NJ; j += gridDim.x) {
    int q = j;
    if (q < 2560) {
      int tr = q / 160, tc = q % 160;
      transpose_tile(p.in[18] + (size_t)l * 1024 * 10240 + (size_t)tr * 64 * 10240 + tc * 64, 10240,
                     (bf16_t*)(ws + WS_WIN) + (size_t)tc * 64 * 1024 + tr * 64, 1024, tile);
      continue;
    }
    q -= 2560;
    if (q < 512) {
      int tr = q / 16, tc = q % 16;
      transpose_tile(p.in[40] + (size_t)l * 2048 * 1024 + (size_t)tr * 64 * 1024 + tc * 64, 1024,
                     (bf16_t*)(ws + WS_WBR) + (size_t)tc * 64 * 2048 + tr * 64, 2048, tile);
      continue;
    }
    q -= 512;
    if (q < 256) {
      int tr = q / 16, tc = q % 16;
      transpose_tile(p.in[41] + (size_t)l * 1024 * 1024 + (size_t)tr * 64 * 1024 + tc * 64, 1024,
                     (bf16_t*)(ws + WS_WOUT) + (size_t)tc * 64 * 1024 + tr * 64, 1024, tile);
      continue;
    }
    q -= 256;
    if (q < 1024) {
      int tr = q / 64, tc = q % 64;
      transpose_tile(p.in[42] + (size_t)l * 1024 * 4096 + (size_t)tr * 64 * 4096 + tc * 64, 4096,
                     (bf16_t*)(ws + WS_W1) + (size_t)tc * 64 * 1024 + tr * 64, 1024, tile);
      continue;
    }
    q -= 1024;
    if (q < 1024) {
      int tr = q / 16, tc = q % 16;
      transpose_tile(p.in[43] + (size_t)l * 4096 * 1024 + (size_t)tr * 64 * 1024 + tc * 64, 1024,
                     (bf16_t*)(ws + WS_W2) + (size_t)tc * 64 * 4096 + tr * 64, 4096, tile);
      continue;
    }
    q -= 1024;
    if (q < 32) {
      int type = q >> 3, n = q & 7;
      const float* src = (type == 0 ? p.in[30] : type == 1 ? p.in[32] : type == 2 ? p.in[35] : p.in[37]) + (size_t)(l * 8 + n) * 4096;
      transpose_tile(src, 64, (bf16_t*)(ws + WS_WLRU) + (size_t)(type * 8 + n) * 4096, 64, tile);
      continue;
    }
    q -= 32;
    if (q < 256) {
      int bh = q >> 3, tr = q & 7, b = bh >> 3, h = bh & 7;
      transpose_tile(p.in[3] + ((size_t)((b * 4 + l) * 8 + h)) * 32768 + (size_t)tr * 64 * 64, 64,
                     (bf16_t*)(ws + WS_CVNA) + (size_t)bh * 32768 + tr * 64, 512, tile);
      continue;
    }
    q -= 256;
    if (q < 256) {
      int bh = q >> 4, t2 = q & 15, tr = t2 >> 1, tc = t2 & 1, b = bh >> 2, h = bh & 3;
      transpose_tile(p.in[5] + ((size_t)((b * 4 + l) * 4 + h)) * 65536 + (size_t)tr * 64 * 128 + tc * 64, 128,
                     (bf16_t*)(ws + WS_CVDF) + (size_t)bh * 65536 + (size_t)tc * 64 * 512 + tr * 64, 512, tile);
      continue;
    }
    q -= 256;
    {
      int tensor = q >> 8, b = (q >> 6) & 3, chunk = q & 63;
      const float* src = (tensor == 0 ? p.in[2] : p.in[4]) + (size_t)(b * 4 + l) * 262144 + (size_t)chunk * 4096;
      bf16_t* dst = (bf16_t*)(ws + (tensor == 0 ? WS_CKNA : WS_CKDF)) + (size_t)b * 262144 + (size_t)chunk * 4096;
#pragma unroll
      for (int i = 0; i < 4; ++i) {
        int e = (otid() + i * 256) * 4;
        float4 v = *(const float4*)(src + e);
        *(bf16x4*)(dst + e) = pack4(v.x, v.y, v.z, v.w);
      }
    }
  }
}

DI void phase_row(const P& p, int l, int mode) {
  const int tid_ = otid(), lane = tid_ & 63, wid = tid_ >> 6;
  const float* MOD = (const float*)(p.ws + WS_MOD);
  float* X = p.out;
  bf16_t* H = (bf16_t*)(p.ws + WS_H);
  const float* Y = (const float*)(p.ws + WS_Y);
  for (int rb = blockIdx.x; rb < 4096; rb += gridDim.x) {
    const int r = rb * 4 + wid;
    const int mi = r < NCTX ? 0 : 1 + ((r - NCTX) >> 11);
    const float* xs;
    if (mode == 0 || (mode == 1 && l == 0))
      xs = (r < NCTX) ? (p.in[0] + (size_t)r * D) : (p.in[1] + (size_t)(r - NCTX) * D);
    else
      xs = X + (size_t)r * D;
    float4 xv[4];
#pragma unroll
    for (int j = 0; j < 4; ++j) xv[j] = *(const float4*)(xs + j * 256 + lane * 4);
    if (mode != 0) {
      float4 yv[4];
      float ss = 0.f;
#pragma unroll
      for (int j = 0; j < 4; ++j) {
        yv[j] = *(const float4*)(Y + (size_t)r * D + j * 256 + lane * 4);
        ss += yv[j].x * yv[j].x + yv[j].y * yv[j].y + yv[j].z * yv[j].z + yv[j].w * yv[j].w;
      }
      ss = wave_sum(ss);
      const float rs = rsqrtf(ss * (1.f / 1024.f) + 1e-6f);
      const float* gpost = (mode == 1 ? p.in[15] : p.in[17]) + l * D;
      const float* gate = MOD + (size_t)(l * 5 + mi) * 6144 + (mode == 1 ? 2048 : 5120);
#pragma unroll
      for (int j = 0; j < 4; ++j) {
        float4 g = *(const float4*)(gpost + j * 256 + lane * 4);
        float4 gt = *(const float4*)(gate + j * 256 + lane * 4);
        xv[j].x += gt.x * (yv[j].x * rs * g.x);
        xv[j].y += gt.y * (yv[j].y * rs * g.y);
        xv[j].z += gt.z * (yv[j].z * rs * g.z);
        xv[j].w += gt.w * (yv[j].w * rs * g.w);
        *(float4*)(X + (size_t)r * D + j * 256 + lane * 4) = xv[j];
      }
    }
    int ln, off_sh, off_sc;
    const float* gpre;
    if (mode == 0) { ln = 0; gpre = p.in[14]; off_sh = 0; off_sc = 1024; }
    else if (mode == 1) { ln = l; gpre = p.in[16] + l * D; off_sh = 3072; off_sc = 4096; }
    else { ln = l + 1; gpre = p.in[14] + (l + 1) * D; off_sh = 0; off_sc = 1024; }
    if (ln < 4) {
      float ss = 0.f;
#pragma unroll
      for (int j = 0; j < 4; ++j) ss += xv[j].x * xv[j].x + xv[j].y * xv[j].y + xv[j].z * xv[j].z + xv[j].w * xv[j].w;
      ss = wave_sum(ss);
      const float rs = rsqrtf(ss * (1.f / 1024.f) + 1e-6f);
      const float* mrow = MOD + (size_t)(ln * 5 + mi) * 6144;
#pragma unroll
      for (int j = 0; j < 4; ++j) {
        int c = j * 256 + lane * 4;
        float4 g = *(const float4*)(gpre + c);
        float4 sc = *(const float4*)(mrow + off_sc + c);
        float4 sh = *(const float4*)(mrow + off_sh + c);
        *(bf16x4*)(H + (size_t)r * D + c) = pack4(xv[j].x * rs * g.x * (1.f + sc.x) + sh.x, xv[j].y * rs * g.y * (1.f + sc.y) + sh.y,
                                                  xv[j].z * rs * g.z * (1.f + sc.z) + sh.z, xv[j].w * rs * g.w * (1.f + sc.w) + sh.w);
      }
    }
  }
}

template <int DV>
DI void load_kv(const bf16_t* __restrict__ Kg, int ldk, const bf16_t* __restrict__ Vg, int ldv, bf16_t* sK, bf16_t* sV) {
  const int tid = otid();
#pragma unroll
  for (int i = 0; i < 2; ++i) {
    int id = tid + i * 256, r = id >> 3, c = (id & 7) * 8;
    *(u32x4*)(sK + r * LDT + c) = *(const u32x4*)(Kg + (size_t)r * ldk + c);
  }
#pragma unroll
  for (int i = 0; i < DV / 32; ++i) {
    int id = tid + i * 256, r = id >> 3, c = (id & 7) * 8;
    *(u32x4*)(sV + r * LDT + c) = *(const u32x4*)(Vg + (size_t)r * ldv + c);
  }
}
DI void qk_scores(const bf16x8 (&qf)[2], const bf16_t* sK, f32x4 (&S)[4], int fr, int fq) {
#pragma unroll
  for (int s = 0; s < 4; ++s) {
    f32x4 z = {0.f, 0.f, 0.f, 0.f};
#pragma unroll
    for (int ks = 0; ks < 2; ++ks) {
      bf16x8 a = *(const bf16x8*)(sK + (16 * s + fr) * LDT + ks * 32 + fq * 8);
      z = MFMA16(a, qf[ks], z);
    }
    S[s] = z;
  }
}
template <int DV>
DI void pv_step(const bf16x8 (&pb)[2], const bf16_t* sV, f32x4 (&O)[DV / 16], int fr, int fq) {
#pragma unroll
  for (int dt = 0; dt < DV / 16; ++dt) {
#pragma unroll
    for (int s2 = 0; s2 < 2; ++s2) {
      const bf16_t* base = sV + (dt * 16 + fr) * LDT + 32 * s2 + 4 * fq;
      bf16x4 lo = *(const bf16x4*)base;
      bf16x4 hi = *(const bf16x4*)(base + 16);
      bf16x8 a = __builtin_shufflevector(lo, hi, 0, 1, 2, 3, 4, 5, 6, 7);
      O[dt] = MFMA16(a, pb[s2], O[dt]);
    }
  }
}
template <int DV>
DI void softmax_pv(f32x4 (&S)[4], const bf16_t* sV, f32x4 (&O)[DV / 16], float& m, float& lsum, int fr, int fq) {
  float tm = -1e30f;
#pragma unroll
  for (int s = 0; s < 4; ++s)
#pragma unroll
    for (int i = 0; i < 4; ++i) tm = fmaxf(tm, S[s][i]);
  tm = fmaxf(tm, __shfl_xor(tm, 16));
  tm = fmaxf(tm, __shfl_xor(tm, 32));
  const float mn = fmaxf(m, tm);
  const float alpha = __expf(m - mn);
  m = mn;
  float ps = 0.f;
#pragma unroll
  for (int s = 0; s < 4; ++s)
#pragma unroll
    for (int i = 0; i < 4; ++i) {
      float pv = __expf(S[s][i] - mn);
      S[s][i] = pv;
      ps += pv;
    }
  lsum = lsum * alpha + ps;
#pragma unroll
  for (int dt = 0; dt < DV / 16; ++dt) {
    O[dt][0] *= alpha; O[dt][1] *= alpha; O[dt][2] *= alpha; O[dt][3] *= alpha;
  }
  bf16x8 pb[2];
  pb[0] = pack8(S[0], S[1]);
  pb[1] = pack8(S[2], S[3]);
  pv_step<DV>(pb, sV, O, fr, fq);
}

DI void dense_item(const P& p, int b, int h, int qb, char* smem) {
  bf16_t* sK = (bf16_t*)smem;
  bf16_t* sV = sK + 64 * LDT;
  const int tid_ = otid(), lane = tid_ & 63, wid = tid_ >> 6, fr = lane & 15, fq = lane >> 4;
  const bf16_t* Z = (const bf16_t*)(p.ws + WS_Z);
  const bf16_t* VT = (const bf16_t*)(p.ws + WS_VTNA) + (size_t)(b * 512 + h * 64) * 256;
  bf16_t* Y4 = (bf16_t*)(p.ws + WS_Y4);
  const int rowbase = b * 256;
  const int qrow = rowbase + qb * 64 + wid * 16 + fr;
  bf16x8 qf[2];
#pragma unroll
  for (int ks = 0; ks < 2; ++ks) qf[ks] = *(const bf16x8*)(Z + (size_t)qrow * ZLD + ZC_NAQ + h * 64 + ks * 32 + fq * 8);
  f32x4 O[4];
#pragma unroll
  for (int dt = 0; dt < 4; ++dt) O[dt] = f32x4{0.f, 0.f, 0.f, 0.f};
  float m = -1e30f, lsum = 0.f;
  for (int kt = 0; kt < 4; ++kt) {
    load_kv<64>(Z + (size_t)(rowbase + kt * 64) * ZLD + ZC_NAK + h * 64, ZLD, VT + kt * 64, 256, sK, sV);
    __syncthreads();
    f32x4 S[4];
    qk_scores(qf, sK, S, fr, fq);
#pragma unroll
    for (int s = 0; s < 4; ++s) { S[s][0] *= 0.125f; S[s][1] *= 0.125f; S[s][2] *= 0.125f; S[s][3] *= 0.125f; }
    softmax_pv<64>(S, sV, O, m, lsum, fr, fq);
    __syncthreads();
  }
  float lt = lsum + __shfl_xor(lsum, 16);
  lt += __shfl_xor(lt, 32);
  const float inv = 1.f / lt;
#pragma unroll
  for (int dt = 0; dt < 4; ++dt)
    *(bf16x4*)(Y4 + (size_t)qrow * 2048 + h * 64 + dt * 16 + fq * 4) = pack4(O[dt][0] * inv, O[dt][1] * inv, O[dt][2] * inv, O[dt][3] * inv);
}

DI void na_item(const P& p, int l, int b, int h, int r, char* smem) {
  bf16_t* sK = (bf16_t*)smem;
  bf16_t* sV = sK + 64 * LDT;
  float* srpb = (float*)(sV + 128 * LDT);
  const int tid = otid(), lane = tid & 63, wid = tid >> 6, fr = lane & 15, fq = lane >> 4;
  const bf16_t* Z = (const bf16_t*)(p.ws + WS_Z);
  const bf16_t* VT = (const bf16_t*)(p.ws + WS_VTNA) + VT_LAT + (size_t)(b * 512 + h * 64) * 2048;
  const bf16_t* CK = (const bf16_t*)(p.ws + WS_CKNA) + (size_t)(b * 8 + h) * 32768;
  const bf16_t* CVT = (const bf16_t*)(p.ws + WS_CVNA) + (size_t)(b * 8 + h) * 32768;
  bf16_t* Y4 = (bf16_t*)(p.ws + WS_Y4);
  for (int i = tid; i < 465; i += 256) srpb[i] = p.in[19][(size_t)(l * 8 + h) * 465 + i];
  const int rowbase = NCTX + b * 2048;
  const int qcol = wid * 16 + fr;
  const int qrow = rowbase + r * 64 + qcol;
  bf16x8 qf[2];
#pragma unroll
  for (int ks = 0; ks < 2; ++ks) qf[ks] = *(const bf16x8*)(Z + (size_t)qrow * ZLD + ZC_NAQ + h * 64 + ks * 32 + fq * 8);
  f32x4 O[4];
#pragma unroll
  for (int dt = 0; dt < 4; ++dt) O[dt] = f32x4{0.f, 0.f, 0.f, 0.f};
  float m = -1e30f, lsum = 0.f;
  int rs = r - 4;
  rs = rs < 0 ? 0 : (rs > 24 ? 24 : rs);
  int cstart = qcol - 8;
  cstart = cstart < 0 ? 0 : (cstart > 48 ? 48 : cstart);
  for (int j = 0; j < 8; ++j) {
    const int krow = rs + j;
    load_kv<64>(Z + (size_t)(rowbase + krow * 64) * ZLD + ZC_NAK + h * 64, ZLD, VT + krow * 64, 2048, sK, sV);
    __syncthreads();
    f32x4 S[4];
    qk_scores(qf, sK, S, fr, fq);
    const int dr = krow - r + 7;
#pragma unroll
    for (int s = 0; s < 4; ++s)
#pragma unroll
      for (int i = 0; i < 4; ++i) {
        int kcol = s * 16 + fq * 4 + i;
        bool ok = (kcol >= cstart) && (kcol < cstart + 16);
        int dc = kcol - qcol + 15;
        dc = dc < 0 ? 0 : (dc > 30 ? 30 : dc);
        float bias = srpb[dr * 31 + dc];
        S[s][i] = ok ? (S[s][i] * 0.125f + bias) : -1e30f;
      }
    softmax_pv<64>(S, sV, O, m, lsum, fr, fq);
    __syncthreads();
  }
  for (int j = 0; j < 8; ++j) {
    load_kv<64>(CK + (size_t)j * 64 * 64, 64, CVT + j * 64, 512, sK, sV);
    __syncthreads();
    f32x4 S[4];
    qk_scores(qf, sK, S, fr, fq);
#pragma unroll
    for (int s = 0; s < 4; ++s) { S[s][0] *= 0.125f; S[s][1] *= 0.125f; S[s][2] *= 0.125f; S[s][3] *= 0.125f; }
    softmax_pv<64>(S, sV, O, m, lsum, fr, fq);
    __syncthreads();
  }
  float lt = lsum + __shfl_xor(lsum, 16);
  lt += __shfl_xor(lt, 32);
  const float inv = 1.f / lt;
#pragma unroll
  for (int dt = 0; dt < 4; ++dt)
    *(bf16x4*)(Y4 + (size_t)qrow * 2048 + h * 64 + dt * 16 + fq * 4) = pack4(O[dt][0] * inv, O[dt][1] * inv, O[dt][2] * inv, O[dt][3] * inv);
}

DI void diff_item(const P& p, int l, bool latent, int b, int h, int qb, char* smem) {
  bf16_t* sK = (bf16_t*)smem;
  bf16_t* sV = sK + 64 * LDT;
  const int tid_ = otid(), lane = tid_ & 63, wid = tid_ >> 6, fr = lane & 15, fq = lane >> 4;
  const bf16_t* Z = (const bf16_t*)(p.ws + WS_Z);
  const int T = latent ? 2048 : 256;
  const int rowbase = latent ? NCTX + b * 2048 : b * 256;
  const bf16_t* VT = (const bf16_t*)(p.ws + WS_VTDF) + (latent ? (size_t)VT_LAT + (size_t)(b * 512 + h * 128) * 2048 : (size_t)(b * 512 + h * 128) * 256);
  const bf16_t* CVT = (const bf16_t*)(p.ws + WS_CVDF) + (size_t)(b * 4 + h) * 65536;
  bf16_t* Y4 = (bf16_t*)(p.ws + WS_Y4);
  const int qrow = rowbase + qb * 64 + wid * 16 + fr;
  float d1 = p.in[20][l * 64 + lane] * p.in[21][l * 64 + lane];
  float d2 = p.in[22][l * 64 + lane] * p.in[23][l * 64 + lane];
  d1 = wave_sum(d1);
  d2 = wave_sum(d2);
  const float lam_init = 0.8f - 0.6f * expf(-0.3f * (float)l);
  const float lam = expf(d1) - expf(d2) + lam_init;

  f32x4 O1[8];
  f32x4 O[8];
  for (int comp = 0; comp < 2; ++comp) {
    bf16x8 qf[2];
#pragma unroll
    for (int ks = 0; ks < 2; ++ks) qf[ks] = *(const bf16x8*)(Z + (size_t)qrow * ZLD + ZC_DFQ + comp * 256 + h * 64 + ks * 32 + fq * 8);
#pragma unroll
    for (int dt = 0; dt < 8; ++dt) O[dt] = f32x4{0.f, 0.f, 0.f, 0.f};
    float m = -1e30f, lsum = 0.f;
    const int nkt = T >> 6;
    for (int kt = 0; kt < nkt; ++kt) {
      load_kv<128>(Z + (size_t)(rowbase + kt * 64) * ZLD + ZC_DFK + comp * 256 + h * 64, ZLD, VT + kt * 64, T, sK, sV);
      __syncthreads();
      f32x4 S[4];
      qk_scores(qf, sK, S, fr, fq);
#pragma unroll
      for (int s = 0; s < 4; ++s) { S[s][0] *= 0.125f; S[s][1] *= 0.125f; S[s][2] *= 0.125f; S[s][3] *= 0.125f; }
      softmax_pv<128>(S, sV, O, m, lsum, fr, fq);
      __syncthreads();
    }
    if (latent) {
      const bf16_t* CK = (const bf16_t*)(p.ws + WS_CKDF) + (size_t)((b * 2 + comp) * 4 + h) * 32768;
      for (int j = 0; j < 8; ++j) {
        load_kv<128>(CK + (size_t)j * 64 * 64, 64, CVT + j * 64, 512, sK, sV);
        __syncthreads();
        f32x4 S[4];
        qk_scores(qf, sK, S, fr, fq);
#pragma unroll
        for (int s = 0; s < 4; ++s) { S[s][0] *= 0.125f; S[s][1] *= 0.125f; S[s][2] *= 0.125f; S[s][3] *= 0.125f; }
        softmax_pv<128>(S, sV, O, m, lsum, fr, fq);
        __syncthreads();
      }
    }
    float lt = lsum + __shfl_xor(lsum, 16);
    lt += __shfl_xor(lt, 32);
    const float inv = 1.f / lt;
    if (comp == 0) {
#pragma unroll
      for (int dt = 0; dt < 8; ++dt) { O1[dt][0] = O[dt][0] * inv; O1[dt][1] = O[dt][1] * inv; O1[dt][2] = O[dt][2] * inv; O1[dt][3] = O[dt][3] * inv; }
    } else {
#pragma unroll
      for (int dt = 0; dt < 8; ++dt) {
        O[dt][0] = O1[dt][0] - lam * (O[dt][0] * inv);
        O[dt][1] = O1[dt][1] - lam * (O[dt][1] * inv);
        O[dt][2] = O1[dt][2] - lam * (O[dt][2] * inv);
        O[dt][3] = O1[dt][3] - lam * (O[dt][3] * inv);
      }
    }
  }
  float ss = 0.f;
#pragma unroll
  for (int dt = 0; dt < 8; ++dt) ss += O[dt][0] * O[dt][0] + O[dt][1] * O[dt][1] + O[dt][2] * O[dt][2] + O[dt][3] * O[dt][3];
  ss += __shfl_xor(ss, 16);
  ss += __shfl_xor(ss, 32);
  const float rsn = rsqrtf(ss * (1.f / 128.f) + 1e-6f) * (1.f - lam_init);
  const float* gn = p.in[24] + l * 128;
#pragma unroll
  for (int dt = 0; dt < 8; ++dt) {
    int dv = dt * 16 + fq * 4;
    float4 g = *(const float4*)(gn + dv);
    *(bf16x4*)(Y4 + (size_t)qrow * 2048 + 512 + h * 128 + dv) = pack4(O[dt][0] * rsn * g.x, O[dt][1] * rsn * g.y, O[dt][2] * rsn * g.z, O[dt][3] * rsn * g.w);
  }
}

DI void ret_item(const P& p, int l, bool latent, int b, int h, int qb, char* smem) {
  bf16_t* sK = (bf16_t*)smem;
  bf16_t* sV = sK + 64 * LDT;
  const int tid = otid(), lane = tid & 63, wid = tid >> 6, fr = lane & 15, fq = lane >> 4;
  const bf16_t* Z = (const bf16_t*)(p.ws + WS_Z);
  const int T = latent ? 2048 : 256;
  const int rowbase = latent ? NCTX + b * 2048 : b * 256;
  const bf16_t* VT = (const bf16_t*)(p.ws + WS_VTRT) + (latent ? (size_t)VT_LAT + (size_t)(b * 512 + h * 64) * 2048 : (size_t)(b * 512 + h * 64) * 256);
  bf16_t* Y4 = (bf16_t*)(p.ws + WS_Y4);
  const int tq = qb * 64 + wid * 16 + fr;
  const int qrow = rowbase + tq;
  const float lgf = log1pf(-expf(p.in[25][l * 8 + h]));
  const float lgb = log1pf(-expf(p.in[26][l * 8 + h]));
  bf16x8 qf[2];
#pragma unroll
  for (int ks = 0; ks < 2; ++ks) qf[ks] = *(const bf16x8*)(Z + (size_t)qrow * ZLD + ZC_RTQ + h * 64 + ks * 32 + fq * 8);
  f32x4 O[4];
#pragma unroll
  for (int dt = 0; dt < 4; ++dt) O[dt] = f32x4{0.f, 0.f, 0.f, 0.f};
  const int nkt = T >> 6;
  for (int kt = 0; kt < nkt; ++kt) {
    load_kv<64>(Z + (size_t)(rowbase + kt * 64) * ZLD + ZC_RTK + h * 64, ZLD, VT + kt * 64, T, sK, sV);
    __syncthreads();
    f32x4 S[4];
    qk_scores(qf, sK, S, fr, fq);
#pragma unroll
    for (int s = 0; s < 4; ++s)
#pragma unroll
      for (int i = 0; i < 4; ++i) {
        int tk = kt * 64 + s * 16 + fq * 4 + i;
        int dd = tq - tk;
        float w = dd >= 0 ? __expf(lgf * (float)dd) : __expf(lgb * (float)(-dd));
        S[s][i] *= w;
      }
    bf16x8 pb[2];
    pb[0] = pack8(S[0], S[1]);
    pb[1] = pack8(S[2], S[3]);
    pv_step<64>(pb, sV, O, fr, fq);
    __syncthreads();
  }
  if (latent) {
    for (int dir = 0; dir < 2; ++dir) {
      const float* S0 = (dir == 0 ? p.in[6] : p.in[7]) + ((size_t)((b * 4 + l) * 8 + h)) * 4096;
#pragma unroll
      for (int i = 0; i < 4; ++i) {
        int e = (tid + i * 256) * 4;
        float4 v = *(const float4*)(S0 + e);
        int dk = e >> 6, dv = e & 63;
        sV[(dv + 0) * LDT + dk] = f2bf(v.x);
        sV[(dv + 1) * LDT + dk] = f2bf(v.y);
        sV[(dv + 2) * LDT + dk] = f2bf(v.z);
        sV[(dv + 3) * LDT + dk] = f2bf(v.w);
      }
      __syncthreads();
      const float sc = dir == 0 ? __expf(lgf * (float)(tq + 1)) : __expf(lgb * (float)(T - tq));
      bf16x8 pb[2];
#pragma unroll
      for (int s2 = 0; s2 < 2; ++s2) {
        const bf16_t* qp = Z + (size_t)qrow * ZLD + ZC_RTQ + h * 64 + 32 * s2 + 4 * fq;
        bf16x4 lo = *(const bf16x4*)qp;
        bf16x4 hi = *(const bf16x4*)(qp + 16);
        bf16x8 r;
#pragma unroll
        for (int j = 0; j < 4; ++j) {
          r[j] = (short)f2bf(bfs2f(lo[j]) * sc);
          r[4 + j] = (short)f2bf(bfs2f(hi[j]) * sc);
        }
        pb[s2] = r;
      }
      pv_step<64>(pb, sV, O, fr, fq);
      __syncthreads();
    }
  }
  float ss = 0.f;
#pragma unroll
  for (int dt = 0; dt < 4; ++dt) ss += O[dt][0] * O[dt][0] + O[dt][1] * O[dt][1] + O[dt][2] * O[dt][2] + O[dt][3] * O[dt][3];
  ss += __shfl_xor(ss, 16);
  ss += __shfl_xor(ss, 32);
  const float rsn = rsqrtf(ss * (1.f / 64.f) + 1e-6f);
  const float* gn = p.in[27] + l * 512 + h * 64;
#pragma unroll
  for (int dt = 0; dt < 4; ++dt) {
    int dv = dt * 16 + fq * 4;
    float4 g = *(const float4*)(gn + dv);
    bf16x4 sg = *(const bf16x4*)(Z + (size_t)qrow * ZLD + ZC_RTG + h * 64 + dv);
    *(bf16x4*)(Y4 + (size_t)qrow * 2048 + 1024 + h * 64 + dv) =
        pack4(O[dt][0] * rsn * g.x * bfs2f(sg[0]), O[dt][1] * rsn * g.y * bfs2f(sg[1]), O[dt][2] * rsn * g.z * bfs2f(sg[2]), O[dt][3] * rsn * g.w * bfs2f(sg[3]));
  }
}

DI void ret_state_item(const P& p, int l, int b, int h) {
  const int tid_ = otid(), lane = tid_ & 63, wid = tid_ >> 6, fr = lane & 15, fq = lane >> 4;
  const bf16_t* KT = (const bf16_t*)(p.ws + WS_KTRT) + (size_t)(b * 512 + h * 64) * 256;
  const bf16_t* VT = (const bf16_t*)(p.ws + WS_VTRT) + (size_t)(b * 512 + h * 64) * 256;
  const float lgf = log1pf(-expf(p.in[25][l * 8 + h]));
  const float lgb = log1pf(-expf(p.in[26][l * 8 + h]));
  f32x4 af[4], ab[4];
#pragma unroll
  for (int nt = 0; nt < 4; ++nt) { af[nt] = f32x4{0.f, 0.f, 0.f, 0.f}; ab[nt] = f32x4{0.f, 0.f, 0.f, 0.f}; }
  for (int ks = 0; ks < 8; ++ks) {
    const int t0 = ks * 32 + fq * 8;
    bf16x8 kraw = *(const bf16x8*)(KT + (size_t)(wid * 16 + fr) * 256 + t0);
    bf16x8 kf, kb;
#pragma unroll
    for (int j = 0; j < 8; ++j) {
      float kv = bfs2f(kraw[j]);
      int t = t0 + j;
      kf[j] = (short)f2bf(kv * __expf(lgf * (float)(255 - t)));
      kb[j] = (short)f2bf(kv * __expf(lgb * (float)t));
    }
#pragma unroll
    for (int nt = 0; nt < 4; ++nt) {
      bf16x8 vb = *(const bf16x8*)(VT + (size_t)(nt * 16 + fr) * 256 + t0);
      af[nt] = MFMA16(kf, vb, af[nt]);
      ab[nt] = MFMA16(kb, vb, ab[nt]);
    }
  }
  float* of = p.out + O_RF + ((size_t)((b * 4 + l) * 8 + h)) * 4096;
  float* ob = p.out + O_RB + ((size_t)((b * 4 + l) * 8 + h)) * 4096;
#pragma unroll
  for (int nt = 0; nt < 4; ++nt)
#pragma unroll
    for (int i = 0; i < 4; ++i) {
      int dk = wid * 16 + fq * 4 + i, dv = nt * 16 + fr;
      of[dk * 64 + dv] = af[nt][i];
      ob[dk * 64 + dv] = ab[nt][i];
    }
}

DI void lru_gates_item(const P& p, int l, int chunk, int n, char* smem) {
  float* XDf = (float*)smem;
  bf16_t* XDb = (bf16_t*)(XDf + 4096);
  const int tid = otid(), lane = tid & 63, wid = tid >> 6, fr = lane & 15, fq = lane >> 4;
  const int row0 = chunk * 64;
  const bool latent = row0 >= NCTX;
  const int T = latent ? 2048 : 256;
  const int tseq0 = latent ? ((row0 - NCTX) & 2047) : (row0 & 255);
  const bf16_t* Z = (const bf16_t*)(p.ws + WS_Z);
  const bf16_t* WL = (const bf16_t*)(p.ws + WS_WLRU);
  bf16_t* LA = (bf16_t*)(p.ws + WS_LA);
  bf16_t* LU = (bf16_t*)(p.ws + WS_LU);
  const int ch0 = n * 64;
  {
    const float cw0 = p.in[28][(l * 4 + 0) * 512 + ch0 + lane];
    const float cw1 = p.in[28][(l * 4 + 1) * 512 + ch0 + lane];
    const float cw2 = p.in[28][(l * 4 + 2) * 512 + ch0 + lane];
    const float cw3 = p.in[28][(l * 4 + 3) * 512 + ch0 + lane];
    const float cb = p.in[29][l * 512 + ch0 + lane];
    const bf16_t* xcol = Z + (size_t)row0 * ZLD + ZC_LRX + ch0 + lane;
    const int t0 = wid * 16;
    auto ld = [&](int tl) -> float {
      int ts = tseq0 + tl;
      return (ts < 0 || ts >= T) ? 0.f : bf2f(xcol[(ptrdiff_t)tl * ZLD]);
    };
    float xm1 = ld(t0 - 1), x0 = ld(t0), x1 = ld(t0 + 1);
#pragma unroll
    for (int i = 0; i < 16; ++i) {
      float x2 = ld(t0 + i + 2);
      float xd = cw0 * xm1 + cw1 * x0 + cw2 * x1 + cw3 * x2 + cb;
      XDf[(t0 + i) * 64 + lane] = xd;
      XDb[(t0 + i) * LDT + lane] = f2bf(xd);
      xm1 = x0; x0 = x1; x1 = x2;
    }
  }
  __syncthreads();
  bf16x8 af[2];
#pragma unroll
  for (int ks = 0; ks < 2; ++ks) af[ks] = *(const bf16x8*)(XDb + (wid * 16 + fr) * LDT + ks * 32 + fq * 8);
#pragma unroll 1
  for (int dir = 0; dir < 2; ++dir) {
    const float* bav = (dir == 0 ? p.in[31] : p.in[36]) + l * 512 + ch0;
    const float* bxv = (dir == 0 ? p.in[33] : p.in[38]) + l * 512 + ch0;
    const float* lamv = (dir == 0 ? p.in[34] : p.in[39]) + l * 512 + ch0;
#pragma unroll
    for (int et = 0; et < 4; ++et) {
      f32x4 da = {0.f, 0.f, 0.f, 0.f}, dx = {0.f, 0.f, 0.f, 0.f};
#pragma unroll
      for (int ks = 0; ks < 2; ++ks) {
        bf16x8 wa = *(const bf16x8*)(WL + (size_t)((dir * 2 + 0) * 8 + n) * 4096 + (et * 16 + fr) * 64 + ks * 32 + fq * 8);
        bf16x8 wx = *(const bf16x8*)(WL + (size_t)((dir * 2 + 1) * 8 + n) * 4096 + (et * 16 + fr) * 64 + ks * 32 + fq * 8);
        da = MFMA16(af[ks], wa, da);
        dx = MFMA16(af[ks], wx, dx);
      }
      const int e = et * 16 + fr;
      const float ba_ = bav[e], bx_ = bxv[e];
      const float sp = log1pf(expf(-lamv[e]));
      float lav[4], uv[4];
#pragma unroll
      for (int i = 0; i < 4; ++i) {
        int tl = wid * 16 + fq * 4 + i;
        float rg = 1.f / (1.f + expf(-(da[i] + ba_)));
        float ig = 1.f / (1.f + expf(-(dx[i] + bx_)));
        float la = -8.f * rg * sp;
        lav[i] = la;
        uv[i] = sqrtf(-expm1f(2.f * la)) * (ig * XDf[tl * 64 + e]);
      }
      const size_t idx = (size_t)dir * 8388608 + ((size_t)chunk * 512 + ch0 + e) * 64 + wid * 16 + fq * 4;
      *(bf16x4*)(LA + idx) = pack4(lav[0], lav[1], lav[2], lav[3]);
      *(bf16x4*)(LU + idx) = pack4(uv[0], uv[1], uv[2], uv[3]);
    }
  }
  __syncthreads();
}

DI void lru_scan_witem(const P& p, int l, int bglob, int g, int lane) {
  const bool latent = bglob >= 32;
  const int T = latent ? 2048 : 256;
  const int rowbase = latent ? NCTX + (bglob - 32) * 2048 : bglob * 256;
  const int chunk0 = rowbase >> 6, nch = T >> 6;
  const int ch = g * 64 + lane;
  const bf16_t* LA = (const bf16_t*)(p.ws + WS_LA);
  const bf16_t* LU = (const bf16_t*)(p.ws + WS_LU);
  bf16_t* HF = (bf16_t*)(p.ws + WS_HF);
  const bf16_t* LG = (const bf16_t*)(p.ws + WS_LG);
  bf16_t* Y4 = (bf16_t*)(p.ws + WS_Y4);
  {
    float h = latent ? p.in[8][((bglob - 32) * 4 + l) * 512 + ch] : 0.f;
    bf16x8 ca[8], cu[8], na[8], nu[8];
    {
      const size_t b0 = ((size_t)chunk0 * 512 + ch) * 64;
#pragma unroll
      for (int q = 0; q < 8; ++q) { ca[q] = *(const bf16x8*)(LA + b0 + q * 8); cu[q] = *(const bf16x8*)(LU + b0 + q * 8); }
    }
    for (int cc = 0; cc < nch; ++cc) {
      const size_t cbase = ((size_t)(chunk0 + cc) * 512 + ch) * 64;
      const int cn = (cc + 1 < nch) ? cc + 1 : cc;
      const size_t nb = ((size_t)(chunk0 + cn) * 512 + ch) * 64;
#pragma unroll
      for (int q = 0; q < 8; ++q) { na[q] = *(const bf16x8*)(LA + nb + q * 8); nu[q] = *(const bf16x8*)(LU + nb + q * 8); }
#pragma unroll
      for (int q = 0; q < 8; ++q) {
        bf16x8 ho;
#pragma unroll
        for (int j = 0; j < 8; ++j) {
          float a = __expf(bfs2f(ca[q][j]));
          h = a * h + bfs2f(cu[q][j]);
          ho[j] = (short)f2bf(h);
        }
        *(bf16x8*)(HF + cbase + q * 8) = ho;
      }
#pragma unroll
      for (int q = 0; q < 8; ++q) { ca[q] = na[q]; cu[q] = nu[q]; }
    }
    if (!latent) p.out[O_LF + (size_t)(bglob * 4 + l) * 512 + ch] = h;
  }
  {
    float h = latent ? p.in[9][((bglob - 32) * 4 + l) * 512 + ch] : 0.f;
    const bf16_t* LAb = LA + 8388608;
    const bf16_t* LUb = LU + 8388608;
    bf16x8 ca[4], cu[4], chf[4], cg_[4], na[4], nu[4], nhf[4], ng[4];
    const int nb_ = 2 * nch;
    {
      const size_t b0 = ((size_t)(chunk0 + nch - 1) * 512 + ch) * 64 + 32;
#pragma unroll
      for (int q = 0; q < 4; ++q) {
        ca[q] = *(const bf16x8*)(LAb + b0 + q * 8); cu[q] = *(const bf16x8*)(LUb + b0 + q * 8);
        chf[q] = *(const bf16x8*)(HF + b0 + q * 8); cg_[q] = *(const bf16x8*)(LG + b0 + q * 8);
      }
    }
    for (int bi = 0; bi < nb_; ++bi) {
      const int chunk = nch - 1 - (bi >> 1), half = 1 - (bi & 1);
      const int bn = (bi + 1 < nb_) ? bi + 1 : bi;
      const int chunkn = nch - 1 - (bn >> 1), halfn = 1 - (bn & 1);
      const size_t nb = ((size_t)(chunk0 + chunkn) * 512 + ch) * 64 + halfn * 32;
#pragma unroll
      for (int q = 0; q < 4; ++q) {
        na[q] = *(const bf16x8*)(LAb + nb + q * 8); nu[q] = *(const bf16x8*)(LUb + nb + q * 8);
        nhf[q] = *(const bf16x8*)(HF + nb + q * 8); ng[q] = *(const bf16x8*)(LG + nb + q * 8);
      }
      bf16_t* yrow = Y4 + (size_t)(rowbase + chunk * 64 + half * 32) * 2048 + 1536 + ch;
#pragma unroll
      for (int q = 3; q >= 0; --q) {
#pragma unroll
        for (int j = 7; j >= 0; --j) {
          float a = __expf(bfs2f(ca[q][j]));
          h = a * h + bfs2f(cu[q][j]);
          float y = (bfs2f(chf[q][j]) + h) * bfs2f(cg_[q][j]);
          yrow[(size_t)(q * 8 + j) * 2048] = f2bf(y);
        }
      }
#pragma unroll
      for (int q = 0; q < 4; ++q) { ca[q] = na[q]; cu[q] = nu[q]; chf[q] = nhf[q]; cg_[q] = ng[q]; }
    }
    if (!latent) p.out[O_LB + (size_t)(bglob * 4 + l) * 512 + ch] = h;
  }
}

DI void phase_mixa(const P& p, int l, char* smem) {
  const int NITEMS = 512 + 2048;
  for (int it = blockIdx.x; it < NITEMS; it += gridDim.x) {
    int q = it;
    if (q < 512) { diff_item(p, l, true, q >> 7, (q >> 5) & 3, q & 31, smem); continue; }
    q -= 512;
    lru_gates_item(p, l, q >> 3, q & 7, smem);
  }
}
DI void phase_mixb(const P& p, int l, char* smem) {
  const int NITEMS = 72 + 4864;
  for (int it = blockIdx.x; it < NITEMS; it += gridDim.x) {
    int q = it;
    if (q < 72) {
      const int tid = otid(), lane = tid & 63, wid = tid >> 6;
      int bglob, g;
      if (q < 32) {
        if (wid == 0) { bglob = 32 + (q >> 3); g = q & 7; }
        else { int ci = q * 3 + wid - 1; bglob = ci >> 3; g = ci & 7; }
      } else {
        int ci = 96 + (q - 32) * 4 + wid;
        bglob = ci >> 3; g = ci & 7;
      }
      lru_scan_witem(p, l, bglob, g, lane);
      continue;
    }
    q -= 72;
    if (q < 1024) { ret_item(p, l, true, q >> 8, (q >> 5) & 7, q & 31, smem); continue; }
    q -= 1024;
    if (q < 1024) { na_item(p, l, q >> 8, (q >> 5) & 7, q & 31, smem); continue; }
    q -= 1024;
    if (q < 1024) { dense_item(p, q >> 5, (q >> 2) & 7, q & 3, smem); continue; }
    q -= 1024;
    if (q < 512) { diff_item(p, l, false, q >> 4, (q >> 2) & 3, q & 3, smem); continue; }
    q -= 512;
    if (q < 1024) { ret_item(p, l, false, q >> 5, (q >> 2) & 7, q & 3, smem); continue; }
    q -= 1024;
    ret_state_item(p, l, q >> 3, q & 7);
  }
}

enum { PH_INIT = 0, PH_PRE0, PH_GIN, PH_MIXA, PH_MIXB, PH_MERGE, PH_OUT, PH_POSTMIX, PH_FF1, PH_FF2, PH_POSTFFN };

DI void run_phase(const P& p, int ph, int l, char* smem) {
  switch (ph) {
    case PH_INIT:
      phase_mod(p, smem);
      phase_convert(p, 0, smem);
      break;
    case PH_PRE0: phase_row(p, 0, 0); break;
    case PH_GIN: phase_gin(p, l, smem); break;
    case PH_MIXA: phase_mixa(p, l, smem); break;
    case PH_MIXB: phase_mixb(p, l, smem); break;
    case PH_MERGE: phase_merge(p, smem); break;
    case PH_OUT:
      phase_gemm_plain<0>((const bf16_t*)(p.ws + WS_H), 1024, (const bf16_t*)(p.ws + WS_WOUT), 1024, (void*)(p.ws + WS_Y), smem);
      break;
    case PH_POSTMIX: phase_row(p, l, 1); break;
    case PH_FF1:
      phase_gemm_plain<1>((const bf16_t*)(p.ws + WS_H), 1024, (const bf16_t*)(p.ws + WS_W1), 4096, (void*)(p.ws + WS_U), smem);
      break;
    case PH_FF2:
      phase_gemm_plain<0>((const bf16_t*)(p.ws + WS_U), 4096, (const bf16_t*)(p.ws + WS_W2), 1024, (void*)(p.ws + WS_Y), smem);
      break;
    case PH_POSTFFN:
      phase_row(p, l, 2);
      if (l < 3) phase_convert(p, l + 1, smem);
      break;
    default: break;
  }
}

DI void decode_step(int step, int& ph, int& l) {
  if (step < 2) { ph = step; l = 0; }
  else { int s = step - 2; l = s / 9; ph = PH_GIN + (s % 9); }
}
constexpr int NSTEPS = 38;

__global__ void __launch_bounds__(256, 2) hybrid_flow_mega(P p) {
  __shared__ __attribute__((aligned(16))) char smem[SMEM_BYTES];
  cg::grid_group grid = cg::this_grid();
  for (int step = 0; step < NSTEPS; ++step) {
    int ph, l;
    decode_step(step, ph, l);
#ifdef PROBE_DUP
    const int reps = (ph == PROBE_DUP) ? 2 : 1;
    for (int rep = 0; rep < reps; ++rep)
#endif
    run_phase(p, ph, l, smem);
    grid.sync();
  }
}

#if !ONE_LAUNCH
__global__ void __launch_bounds__(256, 2) hybrid_flow_phase(P p, int ph, int l) {
  __shared__ __attribute__((aligned(16))) char smem[SMEM_BYTES];
  run_phase(p, ph, l, smem);
}
#endif

extern "C" void kernel_launch(void* const* d_in, const int* in_sizes, int n_in, void* d_out, int out_size, void* d_ws,
                              size_t ws_size, hipStream_t stream) {
  (void)in_sizes; (void)n_in; (void)out_size; (void)ws_size;
  P p{};
  for (int i = 0; i < 44; ++i) p.in[i] = (const float*)d_in[i];
  p.out = (float*)d_out;
  p.ws = (char*)d_ws;
#if ONE_LAUNCH
  static int grid_blocks = 0;
  if (!grid_blocks) {
    int dev = 0, cus = 0, per_cu = 0;
    hipGetDevice(&dev);
    hipDeviceGetAttribute(&cus, hipDeviceAttributeMultiprocessorCount, dev);
    hipOccupancyMaxActiveBlocksPerMultiprocessor(&per_cu, hybrid_flow_mega, 256, 0);
    if (per_cu < 1) per_cu = 1;
    if (per_cu > 2) per_cu = 2;
    grid_blocks = cus * per_cu;
  }
  void* args[] = {&p};
  hipError_t e = hipLaunchCooperativeKernel((void*)hybrid_flow_mega, dim3(grid_blocks), dim3(256), args, 0, stream);
  if (e != hipSuccess) fprintf(stderr, "cooperative launch failed: %s (grid %d)\n", hipGetErrorString(e), grid_blocks);
#else
  const int grid_blocks = 512;
  for (int step = 0; step < NSTEPS; ++step) {
    int ph, l;
    if (step < 2) { ph = step; l = 0; }
    else { int s = step - 2; l = s / 9; ph = PH_GIN + (s % 9); }
    hipLaunchKernelGGL(hybrid_flow_phase, dim3(grid_blocks), dim3(256), 0, stream, p, ph, l);
  }
#endif
}
```

```cpp
#include <hip/hip_runtime.h>
#include <hip/hip_cooperative_groups.h>
#include <cstdio>
namespace cg = cooperative_groups;

#ifndef ONE_LAUNCH
#define ONE_LAUNCH 1
#endif

typedef unsigned short bf16_t;
using bf16x8 = __attribute__((ext_vector_type(8))) short;
using bf16x4 = __attribute__((ext_vector_type(4))) short;
using f32x4 = __attribute__((ext_vector_type(4))) float;
using u32x4 = __attribute__((ext_vector_type(4))) unsigned;
#define DI __device__ __forceinline__
#define MFMA16(a, b, c) __builtin_amdgcn_mfma_f32_16x16x32_bf16((a), (b), (c), 0, 0, 0)

struct P {
  const float* in[44];
  float* out;
  char* ws;
};

constexpr int D = 1024, NCTX = 8192;
constexpr int ZLD = 8256;
constexpr int ZC_NAQ = 0, ZC_NAK = 512, ZC_DFQ = 1024, ZC_DFK = 1536, ZC_RTQ = 2048, ZC_RTK = 2560, ZC_RTG = 3072,
              ZC_LRX = 3584, ZC_GATE = 4096;
constexpr int LDT = 72;

constexpr size_t WS_WIN = 0;
constexpr size_t WS_WBR = WS_WIN + (size_t)10240 * 1024 * 2;
constexpr size_t WS_WOUT = WS_WBR + (size_t)1024 * 2048 * 2;
constexpr size_t WS_W1 = WS_WOUT + (size_t)1024 * 1024 * 2;
constexpr size_t WS_W2 = WS_W1 + (size_t)4096 * 1024 * 2;
constexpr size_t WS_WLRU = WS_W2 + (size_t)4096 * 1024 * 2;
constexpr size_t WS_CKNA = WS_WLRU + (size_t)32 * 4096 * 2;
constexpr size_t WS_CVNA = WS_CKNA + (size_t)4 * 262144 * 2;
constexpr size_t WS_CKDF = WS_CVNA + (size_t)4 * 262144 * 2;
constexpr size_t WS_CVDF = WS_CKDF + (size_t)4 * 262144 * 2;
constexpr size_t WS_MOD = WS_CVDF + (size_t)4 * 262144 * 2;
constexpr size_t WS_H = WS_MOD + (size_t)4 * 5 * 6144 * 4;
constexpr size_t WS_Y4 = WS_H + (size_t)16384 * 1024 * 2;
constexpr size_t WS_VTNA = WS_Y4 + (size_t)16384 * 2048 * 2;
constexpr size_t WS_VTDF = WS_VTNA + (size_t)16384 * 512 * 2;
constexpr size_t WS_VTRT = WS_VTDF + (size_t)16384 * 512 * 2;
constexpr size_t WS_KTRT = WS_VTRT + (size_t)16384 * 512 * 2;
constexpr size_t WS_Z = WS_KTRT + (size_t)8192 * 512 * 2;
constexpr size_t WS_Y = WS_Z;
constexpr size_t WS_U = WS_Z + (size_t)16384 * 1024 * 4;
constexpr size_t WS_LA = WS_Z + (size_t)16384 * ZLD * 2;
constexpr size_t WS_LU = WS_LA + (size_t)2 * 16384 * 512 * 2;
constexpr size_t WS_HF = WS_LU + (size_t)2 * 16384 * 512 * 2;
constexpr size_t WS_LG = WS_HF + (size_t)16384 * 512 * 2;
constexpr size_t WS_BAR = WS_LG + (size_t)16384 * 512 * 2;
constexpr size_t WS_END = WS_BAR + 16384;

constexpr size_t O_NAK = 16777216, O_NAV = 33554432, O_DFK = 50331648, O_DFV = 67108864, O_RF = 83886080,
                 O_RB = 88080384, O_LF = 92274688, O_LB = 92340224;
constexpr int VT_LAT = 4194304;

constexpr int SMEM_BYTES = 59392;

DI int otid() {
  int t = threadIdx.x;
  asm volatile("" : "+v"(t));
  return t;
}
DI bf16_t f2bf(float x) {
  unsigned u = __float_as_uint(x);
  u += 0x7fffu + ((u >> 16) & 1u);
  return (bf16_t)(u >> 16);
}
DI float bf2f(bf16_t b) { return __uint_as_float(((unsigned)b) << 16); }
DI float bfs2f(short b) { return __uint_as_float(((unsigned)(unsigned short)b) << 16); }
DI float wave_sum(float v) {
#pragma unroll
  for (int o = 32; o > 0; o >>= 1) v += __shfl_xor(v, o);
  return v;
}
DI float sigmoidf_(float x) { return 1.f / (1.f + __expf(-x)); }
DI float gelu_tanh(float x) {
  float u = 0.7978845608028654f * (x + 0.044715f * x * x * x);
  return 0.5f * x * (1.f + tanhf(u));
}
DI bf16x8 pack8(const f32x4& a, const f32x4& b) {
  bf16x8 r;
  r[0] = (short)f2bf(a[0]); r[1] = (short)f2bf(a[1]); r[2] = (short)f2bf(a[2]); r[3] = (short)f2bf(a[3]);
  r[4] = (short)f2bf(b[0]); r[5] = (short)f2bf(b[1]); r[6] = (short)f2bf(b[2]); r[7] = (short)f2bf(b[3]);
  return r;
}
DI bf16x4 pack4(float a, float b, float c, float d) {
  bf16x4 r;
  r[0] = (short)f2bf(a); r[1] = (short)f2bf(b); r[2] = (short)f2bf(c); r[3] = (short)f2bf(d);
  return r;
}

DI void gemm_mainloop(const bf16_t* __restrict__ A, int lda, const bf16_t* __restrict__ Bt, int ldb, int K, int row0,
                      int col0, bf16_t* sA, bf16_t* sB, f32x4 (&acc)[4][4]) {
  const int tid = otid(), lane = tid & 63, wid = tid >> 6;
  const int wm = wid >> 1, wn = wid & 1, fr = lane & 15, fq = lane >> 4;
  const bf16_t* Ag = A + (size_t)row0 * lda;
  const bf16_t* Bg = Bt + (size_t)col0 * ldb;
  u32x4 ra[4], rb[4];
#pragma unroll
  for (int i = 0; i < 4; ++i) {
    int id = tid + i * 256, r = id >> 3, c = (id & 7) * 8;
    ra[i] = *(const u32x4*)(Ag + (size_t)r * lda + c);
    rb[i] = *(const u32x4*)(Bg + (size_t)r * ldb + c);
  }
#pragma unroll
  for (int i = 0; i < 4; ++i) {
    int id = tid + i * 256, r = id >> 3, c = (id & 7) * 8;
    *(u32x4*)(sA + r * LDT + c) = ra[i];
    *(u32x4*)(sB + r * LDT + c) = rb[i];
  }
  __syncthreads();
  for (int k0 = 0; k0 < K; k0 += 64) {
    const bool more = (k0 + 64) < K;
    if (more) {
#pragma unroll
      for (int i = 0; i < 4; ++i) {
        int id = tid + i * 256, r = id >> 3, c = (id & 7) * 8;
        ra[i] = *(const u32x4*)(Ag + (size_t)r * lda + k0 + 64 + c);
        rb[i] = *(const u32x4*)(Bg + (size_t)r * ldb + k0 + 64 + c);
      }
    }
#pragma unroll
    for (int ks = 0; ks < 2; ++ks) {
      bf16x8 af[4], bfr[4];
#pragma unroll
      for (int mi = 0; mi < 4; ++mi) af[mi] = *(const bf16x8*)(sA + (wm * 64 + mi * 16 + fr) * LDT + ks * 32 + fq * 8);
#pragma unroll
      for (int ni = 0; ni < 4; ++ni) bfr[ni] = *(const bf16x8*)(sB + (wn * 64 + ni * 16 + fr) * LDT + ks * 32 + fq * 8);
#pragma unroll
      for (int mi = 0; mi < 4; ++mi)
#pragma unroll
        for (int ni = 0; ni < 4; ++ni) acc[mi][ni] = MFMA16(af[mi], bfr[ni], acc[mi][ni]);
    }
    __syncthreads();
    if (more) {
#pragma unroll
      for (int i = 0; i < 4; ++i) {
        int id = tid + i * 256, r = id >> 3, c = (id & 7) * 8;
        *(u32x4*)(sA + r * LDT + c) = ra[i];
        *(u32x4*)(sB + r * LDT + c) = rb[i];
      }
      __syncthreads();
    }
  }
}

DI void zero_acc(f32x4 (&acc)[4][4]) {
#pragma unroll
  for (int mi = 0; mi < 4; ++mi)
#pragma unroll
    for (int ni = 0; ni < 4; ++ni) acc[mi][ni] = f32x4{0.f, 0.f, 0.f, 0.f};
}
DI void tile_of(int id, int ntn, int& tm, int& tn) {
  int band = id / (16 * ntn), rem = id % (16 * ntn);
  tm = band * 16 + (rem & 15);
  tn = rem >> 4;
}

DI void epi_in(const P& p, int l, int row0, int col0, f32x4 (&acc)[4][4]) {
  const int tid_ = otid(), lane = tid_ & 63, wid = tid_ >> 6, wm = wid >> 1, wn = wid & 1, fr = lane & 15, fq = lane >> 4;
  const int seg = col0 >> 9;
  const bool ctx = row0 < NCTX;
  bf16_t* Z = (bf16_t*)(p.ws + WS_Z);
  const int rbase = row0 + wm * 64;
  const int cseg0 = (col0 & 511) + wn * 64;

  if (!ctx && (seg == 3 || seg == 4)) {
    const float inv = powf(10000.f, -(float)fr * (1.f / 16.f));
#pragma unroll
    for (int mi = 0; mi < 4; ++mi)
#pragma unroll
      for (int i = 0; i < 4; ++i) {
        int r = rbase + mi * 16 + fq * 4 + i;
        int t = (r - NCTX) & 2047;
        float gr = (float)(t >> 6), gc = (float)(t & 63);
        float sr, cr, sc, cc;
        sincosf(gr * inv, &sr, &cr);
        sincosf(gc * inv, &sc, &cc);
        float a0 = acc[mi][0][i], a1 = acc[mi][1][i], a2 = acc[mi][2][i], a3 = acc[mi][3][i];
        acc[mi][0][i] = a0 * cr - a1 * sr;
        acc[mi][1][i] = a1 * cr + a0 * sr;
        acc[mi][2][i] = a2 * cc - a3 * sc;
        acc[mi][3][i] = a3 * cc + a2 * sc;
      }
  }

  int zc = -1, tf = 0;
  bf16_t* VT = nullptr;
  switch (seg) {
    case 0: zc = ZC_NAQ; break;
    case 1: zc = ZC_NAK; break;
    case 2: VT = (bf16_t*)(p.ws + WS_VTNA); break;
    case 3: zc = ZC_DFQ; break;
    case 4: zc = ZC_DFK; break;
    case 5: VT = (bf16_t*)(p.ws + WS_VTDF); break;
    case 6: zc = ZC_RTQ; break;
    case 7: zc = ZC_RTK; tf = 4; break;
    case 8: VT = (bf16_t*)(p.ws + WS_VTRT); break;
    case 9: zc = ZC_RTG; tf = 1; break;
    case 10: zc = ZC_LRX; break;
    case 11: break;
    default: zc = ZC_GATE + (seg - 12) * 512; tf = 3; break;
  }

  if (zc >= 0) {
#pragma unroll
    for (int mi = 0; mi < 4; ++mi)
#pragma unroll
      for (int ni = 0; ni < 4; ++ni)
#pragma unroll
        for (int i = 0; i < 4; ++i) {
          int r = rbase + mi * 16 + fq * 4 + i;
          int c = cseg0 + ni * 16 + fr;
          float v = acc[mi][ni][i];
          if (tf == 1) v = v * sigmoidf_(v);
          else if (tf == 2) v = gelu_tanh(v);
          else if (tf == 3) v = sigmoidf_(v);
          else if (tf == 4) v = v * 0.125f;
          Z[(size_t)r * ZLD + zc + c] = f2bf(v);
        }
  }
  if (VT != nullptr || (seg == 7 && ctx)) {
    bf16_t* T_ = (seg == 7) ? (bf16_t*)(p.ws + WS_KTRT) : VT;
    const float scl = (seg == 7) ? 0.125f : 1.f;
#pragma unroll
    for (int mi = 0; mi < 4; ++mi)
#pragma unroll
      for (int ni = 0; ni < 4; ++ni) {
        int r0 = rbase + mi * 16 + fq * 4;
        int c = cseg0 + ni * 16 + fr;
        size_t idx;
        if (r0 < NCTX) {
          int b = r0 >> 8, t = r0 & 255;
          idx = ((size_t)(b * 512 + c)) * 256 + t;
        } else {
          int rr = r0 - NCTX, b = rr >> 11, t = rr & 2047;
          idx = (size_t)VT_LAT + ((size_t)(b * 512 + c)) * 2048 + t;
        }
        *(bf16x4*)(T_ + idx) = pack4(acc[mi][ni][0] * scl, acc[mi][ni][1] * scl, acc[mi][ni][2] * scl, acc[mi][ni][3] * scl);
      }
  }
  if (seg == 11) {
    bf16_t* LG = (bf16_t*)(p.ws + WS_LG);
#pragma unroll
    for (int mi = 0; mi < 4; ++mi)
#pragma unroll
      for (int ni = 0; ni < 4; ++ni) {
        int r0 = rbase + mi * 16 + fq * 4;
        int c = cseg0 + ni * 16 + fr;
        size_t idx = ((size_t)(r0 >> 6) * 512 + c) * 64 + (r0 & 63);
        *(bf16x4*)(LG + idx) = pack4(gelu_tanh(acc[mi][ni][0]), gelu_tanh(acc[mi][ni][1]), gelu_tanh(acc[mi][ni][2]), gelu_tanh(acc[mi][ni][3]));
      }
  }
  if (ctx && (seg == 1 || seg == 2 || seg == 4 || seg == 5)) {
    float* out = p.out;
#pragma unroll
    for (int mi = 0; mi < 4; ++mi)
#pragma unroll
      for (int ni = 0; ni < 4; ++ni)
#pragma unroll
        for (int i = 0; i < 4; ++i) {
          int r = rbase + mi * 16 + fq * 4 + i;
          int c = cseg0 + ni * 16 + fr;
          int b = r >> 8, t = r & 255;
          size_t off;
          if (seg == 1 || seg == 2) {
            int h = c >> 6, d = c & 63;
            off = (seg == 1 ? O_NAK : O_NAV) + ((((size_t)(b * 4 + l) * 8 + h) * 256 + t) * 64 + d);
          } else if (seg == 4) {
            int comp = c >> 8, h = (c >> 6) & 3, d = c & 63;
            off = O_DFK + (((((size_t)(b * 4 + l) * 2 + comp) * 4 + h) * 256 + t) * 64 + d);
          } else {
            int h = c >> 7, d = c & 127;
            off = O_DFV + ((((size_t)(b * 4 + l) * 4 + h) * 256 + t) * 128 + d);
          }
          out[off] = acc[mi][ni][i];
        }
  }
}

DI void phase_gin(const P& p, int l, char* smem) {
  bf16_t* sA = (bf16_t*)smem;
  bf16_t* sB = sA + 128 * LDT;
  const bf16_t* A = (const bf16_t*)(p.ws + WS_H);
  const bf16_t* Bt = (const bf16_t*)(p.ws + WS_WIN);
  const int ntn = 80, total = 128 * ntn;
  for (int id = blockIdx.x; id < total; id += gridDim.x) {
    int tm, tn;
    tile_of(id, ntn, tm, tn);
    f32x4 acc[4][4];
    zero_acc(acc);
    gemm_mainloop(A, 1024, Bt, 1024, 1024, tm * 128, tn * 128, sA, sB, acc);
    epi_in(p, l, tm * 128, tn * 128, acc);
  }
}

DI void phase_merge(const P& p, char* smem) {
  bf16_t* sA = (bf16_t*)smem;
  bf16_t* sB = sA + 128 * LDT;
  const bf16_t* Y4 = (const bf16_t*)(p.ws + WS_Y4);
  const bf16_t* WB = (const bf16_t*)(p.ws + WS_WBR);
  bf16_t* Z = (bf16_t*)(p.ws + WS_Z);
  bf16_t* G = (bf16_t*)(p.ws + WS_H);
  const int tid_ = otid(), lane = tid_ & 63, wid = tid_ >> 6, wm = wid >> 1, wn = wid & 1, fr = lane & 15, fq = lane >> 4;
  const int ntn = 8, total = 128 * ntn;
  for (int id = blockIdx.x; id < total; id += gridDim.x) {
    int tm, tn;
    tile_of(id, ntn, tm, tn);
    const int row0 = tm * 128, col0 = tn * 128;
#pragma unroll 1
    for (int k = 0; k < 4; ++k) {
      f32x4 acc[4][4];
      zero_acc(acc);
      gemm_mainloop(Y4 + k * 512, 2048, WB + k * 512, 2048, 512, row0, col0, sA, sB, acc);
      int rb_ = row0 + wm * 64 + fq * 4, cb_ = col0 + wn * 64 + fr;
      asm volatile("" : "+v"(rb_), "+v"(cb_));
#pragma unroll
      for (int mi = 0; mi < 4; ++mi)
#pragma unroll
        for (int ni = 0; ni < 4; ++ni)
#pragma unroll
          for (int i = 0; i < 4; ++i) {
            int r = rb_ + mi * 16 + i;
            int c = cb_ + ni * 16;
            float g = bf2f(Z[(size_t)r * ZLD + ZC_GATE + k * 1024 + c]);
            float* g32 = (float*)(Z + (size_t)r * ZLD) + c;
            float o = g * acc[mi][ni][i];
            if (k > 0) o += *g32;
            if (k < 3) *g32 = o;
            else G[(size_t)r * 1024 + c] = f2bf(o);
            if (i == 3) asm volatile("" ::: "memory");
          }
    }
  }
}

template <int MODE>
DI void phase_gemm_plain(const bf16_t* A, int K, const bf16_t* Bt, int N, void* outp, char* smem) {
  bf16_t* sA = (bf16_t*)smem;
  bf16_t* sB = sA + 128 * LDT;
  const int tid_ = otid(), lane = tid_ & 63, wid = tid_ >> 6, wm = wid >> 1, wn = wid & 1, fr = lane & 15, fq = lane >> 4;
  const int ntn = N / 128, total = 128 * ntn;
  for (int id = blockIdx.x; id < total; id += gridDim.x) {
    int tm, tn;
    tile_of(id, ntn, tm, tn);
    const int row0 = tm * 128, col0 = tn * 128;
    f32x4 acc[4][4];
    zero_acc(acc);
    gemm_mainloop(A, K, Bt, K, K, row0, col0, sA, sB, acc);
#pragma unroll
    for (int mi = 0; mi < 4; ++mi)
#pragma unroll
      for (int ni = 0; ni < 4; ++ni)
#pragma unroll
        for (int i = 0; i < 4; ++i) {
          int r = row0 + wm * 64 + mi * 16 + fq * 4 + i;
          int c = col0 + wn * 64 + ni * 16 + fr;
          float v = acc[mi][ni][i];
          if (MODE == 0) {
            ((float*)outp)[(size_t)r * N + c] = v;
          } else {
            v = fmaxf(v, 0.f);
            ((bf16_t*)outp)[(size_t)r * N + c] = f2bf(v * v);
          }
        }
  }
}

DI void phase_mod(const P& p, char* smem) {
  float* ssil = (float*)smem;
  float* red = ssil + 5 * 1024;
  const int tid = otid();
  float* MOD = (float*)(p.ws + WS_MOD);
  for (int idx = tid; idx < 5120; idx += 256) {
    int j = idx >> 10, k = idx & 1023;
    float cv = (j == 0) ? p.in[11][k] : p.in[10][(j - 1) * 1024 + k];
    ssil[idx] = cv / (1.f + expf(-cv));
  }
  __syncthreads();
  const int cl = tid & 63, kg = tid >> 6;
  for (int item = blockIdx.x; item < 384; item += gridDim.x) {
    int l = item / 96, cgp = item % 96;
    int col = cgp * 64 + cl;
    const float* W = p.in[12] + (size_t)l * 1024 * 6144 + col;
    float a0 = 0, a1 = 0, a2 = 0, a3 = 0, a4 = 0;
    for (int k = kg * 256; k < kg * 256 + 256; ++k) {
      float w = W[(size_t)k * 6144];
      a0 += ssil[k] * w;
      a1 += ssil[1024 + k] * w;
      a2 += ssil[2048 + k] * w;
      a3 += ssil[3072 + k] * w;
      a4 += ssil[4096 + k] * w;
    }
    red[(kg * 5 + 0) * 64 + cl] = a0;
    red[(kg * 5 + 1) * 64 + cl] = a1;
    red[(kg * 5 + 2) * 64 + cl] = a2;
    red[(kg * 5 + 3) * 64 + cl] = a3;
    red[(kg * 5 + 4) * 64 + cl] = a4;
    __syncthreads();
    if (kg == 0) {
      float bias = p.in[13][l * 6144 + col];
#pragma unroll
      for (int j = 0; j < 5; ++j) {
        float s = red[(0 * 5 + j) * 64 + cl] + red[(1 * 5 + j) * 64 + cl] + red[(2 * 5 + j) * 64 + cl] + red[(3 * 5 + j) * 64 + cl];
        MOD[(size_t)(l * 5 + j) * 6144 + col] = s + bias;
      }
    }
    __syncthreads();
  }
}

DI void transpose_tile(const float* __restrict__ src, int lds_, bf16_t* __restrict__ dst, int ldd, float* tile) {
  const int tid = otid();
#pragma unroll 4
  for (int i = 0; i < 16; ++i) {
    int idx = tid + i * 256, r = idx >> 6, c = idx & 63;
    tile[r * 65 + c] = src[(size_t)r * lds_ + c];
  }
  __syncthreads();
#pragma unroll 4
  for (int i = 0; i < 16; ++i) {
    int idx = tid + i * 256, c = idx >> 6, r = idx & 63;
    dst[(size_t)c * ldd + r] = f2bf(tile[r * 65 + c]);
  }
  __syncthreads();
}

DI void phase_convert(const P& p, int l, char* smem) {
  float* tile = (float*)smem;
  char* ws = p.ws;
  const int NJ = 6432;
  for (int j = blockIdx.x; j < NJ; j += gridDim.x) {
    int q = j;
    if (q < 2560) {
      int tr = q / 160, tc = q % 160;
      transpose_tile(p.in[18] + (size_t)l * 1024 * 10240 + (size_t)tr * 64 * 10240 + tc * 64, 10240,
                     (bf16_t*)(ws + WS_WIN) + (size_t)tc * 64 * 1024 + tr * 64, 1024, tile);
      continue;
    }
    q -= 2560;
    if (q < 512) {
      int tr = q / 16, tc = q % 16;
      transpose_tile(p.in[40] + (size_t)l * 2048 * 1024 + (size_t)tr * 64 * 1024 + tc * 64, 1024,
                     (bf16_t*)(ws + WS_WBR) + (size_t)tc * 64 * 2048 + tr * 64, 2048, tile);
      continue;
    }
    q -= 512;
    if (q < 256) {
      int tr = q / 16, tc = q % 16;
      transpose_tile(p.in[41] + (size_t)l * 1024 * 1024 + (size_t)tr * 64 * 1024 + tc * 64, 1024,
                     (bf16_t*)(ws + WS_WOUT) + (size_t)tc * 64 * 1024 + tr * 64, 1024, tile);
      continue;
    }
    q -= 256;
    if (q < 1024) {
      int tr = q / 64, tc = q % 64;
      transpose_tile(p.in[42] + (size_t)l * 1024 * 4096 + (size_t)tr * 64 * 4096 + tc * 64, 4096,
                     (bf16_t*)(ws + WS_W1) + (size_t)tc * 64 * 1024 + tr * 64, 1024, tile);
      continue;
    }
    q -= 1024;
    if (q < 1024) {
      int tr = q / 16, tc = q % 16;
      transpose_tile(p.in[43] + (size_t)l * 4096 * 1024 + (size_t)tr * 64 * 1024 + tc * 64, 1024,
                     (bf16_t*)(ws + WS_W2) + (size_t)tc * 64 * 4096 + tr * 64, 4096, tile);
      continue;
    }
    q -= 1024;
    if (q < 32) {
      int type = q >> 3, n = q & 7;
      const float* src = (type == 0 ? p.in[30] : type == 1 ? p.in[32] : type == 2 ? p.in[35] : p.in[37]) + (size_t)(l * 8 + n) * 4096;
      transpose_tile(src, 64, (bf16_t*)(ws + WS_WLRU) + (size_t)(type * 8 + n) * 4096, 64, tile);
      continue;
    }
    q -= 32;
    if (q < 256) {
      int bh = q >> 3, tr = q & 7, b = bh >> 3, h = bh & 7;
      transpose_tile(p.in[3] + ((size_t)((b * 4 + l) * 8 + h)) * 32768 + (size_t)tr * 64 * 64, 64,
                     (bf16_t*)(ws + WS_CVNA) + (size_t)bh * 32768 + tr * 64, 512, tile);
      continue;
    }
    q -= 256;
    if (q < 256) {
      int bh = q >> 4, t2 = q & 15, tr = t2 >> 1, tc = t2 & 1, b = bh >> 2, h = bh & 3;
      transpose_tile(p.in[5] + ((size_t)((b * 4 + l) * 4 + h)) * 65536 + (size_t)tr * 64 * 128 + tc * 64, 128,
                     (bf16_t*)(ws + WS_CVDF) + (size_t)bh * 65536 + (size_t)tc * 64 * 512 + tr * 64, 512, tile);
      continue;
    }
    q -= 256;
    {
      int tensor = q >> 8, b = (q >> 6) & 3, chunk = q & 63;
      const float* src = (tensor == 0 ? p.in[2] : p.in[4]) + (size_t)(b * 4 + l) * 262144 + (size_t)chunk * 4096;
      bf16_t* dst = (bf16_t*)(ws + (tensor == 0 ? WS_CKNA : WS_CKDF)) + (size_t)b * 262144 + (size_t)chunk * 4096;
#pragma unroll
      for (int i = 0; i < 4; ++i) {
        int e = (otid() + i * 256) * 4;
        float4 v = *(const float4*)(src + e);
        *(bf16x4*)(dst + e) = pack4(v.x, v.y, v.z, v.w);
      }
    }
  }
}

DI void phase_row(const P& p, int l, int mode) {
  const int tid_ = otid(), lane = tid_ & 63, wid = tid_ >> 6;
  const float* MOD = (const float*)(p.ws + WS_MOD);
  float* X = p.out;
  bf16_t* H = (bf16_t*)(p.ws + WS_H);
  const float* Y = (const float*)(p.ws + WS_Y);
  for (int rb = blockIdx.x; rb < 4096; rb += gridDim.x) {
    const int r = rb * 4 + wid;
    const int mi = r < NCTX ? 0 : 1 + ((r - NCTX) >> 11);
    const float* xs;
    if (mode == 0 || (mode == 1 && l == 0))
      xs = (r < NCTX) ? (p.in[0] + (size_t)r * D) : (p.in[1] + (size_t)(r - NCTX) * D);
    else
      xs = X + (size_t)r * D;
    float4 xv[4];
#pragma unroll
    for (int j = 0; j < 4; ++j) xv[j] = *(const float4*)(xs + j * 256 + lane * 4);
    if (mode != 0) {
      float4 yv[4];
      float ss = 0.f;
#pragma unroll
      for (int j = 0; j < 4; ++j) {
        yv[j] = *(const float4*)(Y + (size_t)r * D + j * 256 + lane * 4);
        ss += yv[j].x * yv[j].x + yv[j].y * yv[j].y + yv[j].z * yv[j].z + yv[j].w * yv[j].w;
      }
      ss = wave_sum(ss);
      const float rs = rsqrtf(ss * (1.f / 1024.f) + 1e-6f);
      const float* gpost = (mode == 1 ? p.in[15] : p.in[17]) + l * D;
      const float* gate = MOD + (size_t)(l * 5 + mi) * 6144 + (mode == 1 ? 2048 : 5120);
#pragma unroll
      for (int j = 0; j < 4; ++j) {
        float4 g = *(const float4*)(gpost + j * 256 + lane * 4);
        float4 gt = *(const float4*)(gate + j * 256 + lane * 4);
        xv[j].x += gt.x * (yv[j].x * rs * g.x);
        xv[j].y += gt.y * (yv[j].y * rs * g.y);
        xv[j].z += gt.z * (yv[j].z * rs * g.z);
        xv[j].w += gt.w * (yv[j].w * rs * g.w);
        *(float4*)(X + (size_t)r * D + j * 256 + lane * 4) = xv[j];
      }
    }
    int ln, off_sh, off_sc;
    const float* gpre;
    if (mode == 0) { ln = 0; gpre = p.in[14]; off_sh = 0; off_sc = 1024; }
    else if (mode == 1) { ln = l; gpre = p.in[16] + l * D; off_sh = 3072; off_sc = 4096; }
    else { ln = l + 1; gpre = p.in[14] + (l + 1) * D; off_sh = 0; off_sc = 1024; }
    if (ln < 4) {
      float ss = 0.f;
#pragma unroll
      for (int j = 0; j < 4; ++j) ss += xv[j].x * xv[j].x + xv[j].y * xv[j].y + xv[j].z * xv[j].z + xv[j].w * xv[j].w;
      ss = wave_sum(ss);
      const float rs = rsqrtf(ss * (1.f / 1024.f) + 1e-6f);
      const float* mrow = MOD + (size_t)(ln * 5 + mi) * 6144;
#pragma unroll
      for (int j = 0; j < 4; ++j) {
        int c = j * 256 + lane * 4;
        float4 g = *(const float4*)(gpre + c);
        float4 sc = *(const float4*)(mrow + off_sc + c);
        float4 sh = *(const float4*)(mrow + off_sh + c);
        *(bf16x4*)(H + (size_t)r * D + c) = pack4(xv[j].x * rs * g.x * (1.f + sc.x) + sh.x, xv[j].y * rs * g.y * (1.f + sc.y) + sh.y,
                                                  xv[j].z * rs * g.z * (1.f + sc.z) + sh.z, xv[j].w * rs * g.w * (1.f + sc.w) + sh.w);
      }
    }
  }
}

template <int DV>
DI void load_kv(const bf16_t* __restrict__ Kg, int ldk, const bf16_t* __restrict__ Vg, int ldv, bf16_t* sK, bf16_t* sV) {
  const int tid = otid();
#pragma unroll
  for (int i = 0; i < 2; ++i) {
    int id = tid + i * 256, r = id >> 3, c = (id & 7) * 8;
    *(u32x4*)(sK + r * LDT + c) = *(const u32x4*)(Kg + (size_t)r * ldk + c);
  }
#pragma unroll
  for (int i = 0; i < DV / 32; ++i) {
    int id = tid + i * 256, r = id >> 3, c = (id & 7) * 8;
    *(u32x4*)(sV + r * LDT + c) = *(const u32x4*)(Vg + (size_t)r * ldv + c);
  }
}
DI void qk_scores(const bf16x8 (&qf)[2], const bf16_t* sK, f32x4 (&S)[4], int fr, int fq) {
#pragma unroll
  for (int s = 0; s < 4; ++s) {
    f32x4 z = {0.f, 0.f, 0.f, 0.f};
#pragma unroll
    for (int ks = 0; ks < 2; ++ks) {
      bf16x8 a = *(const bf16x8*)(sK + (16 * s + fr) * LDT + ks * 32 + fq * 8);
      z = MFMA16(a, qf[ks], z);
    }
    S[s] = z;
  }
}
template <int DV>
DI void pv_step(const bf16x8 (&pb)[2], const bf16_t* sV, f32x4 (&O)[DV / 16], int fr, int fq) {
#pragma unroll
  for (int dt = 0; dt < DV / 16; ++dt) {
#pragma unroll
    for (int s2 = 0; s2 < 2; ++s2) {
      const bf16_t* base = sV + (dt * 16 + fr) * LDT + 32 * s2 + 4 * fq;
      bf16x4 lo = *(const bf16x4*)base;
      bf16x4 hi = *(const bf16x4*)(base + 16);
      bf16x8 a = __builtin_shufflevector(lo, hi, 0, 1, 2, 3, 4, 5, 6, 7);
      O[dt] = MFMA16(a, pb[s2], O[dt]);
    }
  }
}
template <int DV>
DI void softmax_pv(f32x4 (&S)[4], const bf16_t* sV, f32x4 (&O)[DV / 16], float& m, float& lsum, int fr, int fq) {
  float tm = -1e30f;
#pragma unroll
  for (int s = 0; s < 4; ++s)
#pragma unroll
    for (int i = 0; i < 4; ++i) tm = fmaxf(tm, S[s][i]);
  tm = fmaxf(tm, __shfl_xor(tm, 16));
  tm = fmaxf(tm, __shfl_xor(tm, 32));
  const float mn = fmaxf(m, tm);
  const float alpha = __expf(m - mn);
  m = mn;
  float ps = 0.f;
#pragma unroll
  for (int s = 0; s < 4; ++s)
#pragma unroll
    for (int i = 0; i < 4; ++i) {
      float pv = __expf(S[s][i] - mn);
      S[s][i] = pv;
      ps += pv;
    }
  lsum = lsum * alpha + ps;
#pragma unroll
  for (int dt = 0; dt < DV / 16; ++dt) {
    O[dt][0] *= alpha; O[dt][1] *= alpha; O[dt][2] *= alpha; O[dt][3] *= alpha;
  }
  bf16x8 pb[2];
  pb[0] = pack8(S[0], S[1]);
  pb[1] = pack8(S[2], S[3]);
  pv_step<DV>(pb, sV, O, fr, fq);
}

DI void dense_item(const P& p, int b, int h, int qb, char* smem) {
  bf16_t* sK = (bf16_t*)smem;
  bf16_t* sV = sK + 64 * LDT;
  const int tid_ = otid(), lane = tid_ & 63, wid = tid_ >> 6, fr = lane & 15, fq = lane >> 4;
  const bf16_t* Z = (const bf16_t*)(p.ws + WS_Z);
  const bf16_t* VT = (const bf16_t*)(p.ws + WS_VTNA) + (size_t)(b * 512 + h * 64) * 256;
  bf16_t* Y4 = (bf16_t*)(p.ws + WS_Y4);
  const int rowbase = b * 256;
  const int qrow = rowbase + qb * 64 + wid * 16 + fr;
  bf16x8 qf[2];
#pragma unroll
  for (int ks = 0; ks < 2; ++ks) qf[ks] = *(const bf16x8*)(Z + (size_t)qrow * ZLD + ZC_NAQ + h * 64 + ks * 32 + fq * 8);
  f32x4 O[4];
#pragma unroll
  for (int dt = 0; dt < 4; ++dt) O[dt] = f32x4{0.f, 0.f, 0.f, 0.f};
  float m = -1e30f, lsum = 0.f;
  for (int kt = 0; kt < 4; ++kt) {
    load_kv<64>(Z + (size_t)(rowbase + kt * 64) * ZLD + ZC_NAK + h * 64, ZLD, VT + kt * 64, 256, sK, sV);
    __syncthreads();
    f32x4 S[4];
    qk_scores(qf, sK, S, fr, fq);
#pragma unroll
    for (int s = 0; s < 4; ++s) { S[s][0] *= 0.125f; S[s][1] *= 0.125f; S[s][2] *= 0.125f; S[s][3] *= 0.125f; }
    softmax_pv<64>(S, sV, O, m, lsum, fr, fq);
    __syncthreads();
  }
  float lt = lsum + __shfl_xor(lsum, 16);
  lt += __shfl_xor(lt, 32);
  const float inv = 1.f / lt;
#pragma unroll
  for (int dt = 0; dt < 4; ++dt)
    *(bf16x4*)(Y4 + (size_t)qrow * 2048 + h * 64 + dt * 16 + fq * 4) = pack4(O[dt][0] * inv, O[dt][1] * inv, O[dt][2] * inv, O[dt][3] * inv);
}

DI void na_item(const P& p, int l, int b, int h, int r, char* smem) {
  bf16_t* sK = (bf16_t*)smem;
  bf16_t* sV = sK + 64 * LDT;
  float* srpb = (float*)(sV + 128 * LDT);
  const int tid = otid(), lane = tid & 63, wid = tid >> 6, fr = lane & 15, fq = lane >> 4;
  const bf16_t* Z = (const bf16_t*)(p.ws + WS_Z);
  const bf16_t* VT = (const bf16_t*)(p.ws + WS_VTNA) + VT_LAT + (size_t)(b * 512 + h * 64) * 2048;
  const bf16_t* CK = (const bf16_t*)(p.ws + WS_CKNA) + (size_t)(b * 8 + h) * 32768;
  const bf16_t* CVT = (const bf16_t*)(p.ws + WS_CVNA) + (size_t)(b * 8 + h) * 32768;
  bf16_t* Y4 = (bf16_t*)(p.ws + WS_Y4);
  for (int i = tid; i < 465; i += 256) srpb[i] = p.in[19][(size_t)(l * 8 + h) * 465 + i];
  const int rowbase = NCTX + b * 2048;
  const int qcol = wid * 16 + fr;
  const int qrow = rowbase + r * 64 + qcol;
  bf16x8 qf[2];
#pragma unroll
  for (int ks = 0; ks < 2; ++ks) qf[ks] = *(const bf16x8*)(Z + (size_t)qrow * ZLD + ZC_NAQ + h * 64 + ks * 32 + fq * 8);
  f32x4 O[4];
#pragma unroll
  for (int dt = 0; dt < 4; ++dt) O[dt] = f32x4{0.f, 0.f, 0.f, 0.f};
  float m = -1e30f, lsum = 0.f;
  int rs = r - 4;
  rs = rs < 0 ? 0 : (rs > 24 ? 24 : rs);
  int cstart = qcol - 8;
  cstart = cstart < 0 ? 0 : (cstart > 48 ? 48 : cstart);
  for (int j = 0; j < 8; ++j) {
    const int krow = rs + j;
    load_kv<64>(Z + (size_t)(rowbase + krow * 64) * ZLD + ZC_NAK + h * 64, ZLD, VT + krow * 64, 2048, sK, sV);
    __syncthreads();
    f32x4 S[4];
    qk_scores(qf, sK, S, fr, fq);
    const int dr = krow - r + 7;
#pragma unroll
    for (int s = 0; s < 4; ++s)
#pragma unroll
      for (int i = 0; i < 4; ++i) {
        int kcol = s * 16 + fq * 4 + i;
        bool ok = (kcol >= cstart) && (kcol < cstart + 16);
        int dc = kcol - qcol + 15;
        dc = dc < 0 ? 0 : (dc > 30 ? 30 : dc);
        float bias = srpb[dr * 31 + dc];
        S[s][i] = ok ? (S[s][i] * 0.125f + bias) : -1e30f;
      }
    softmax_pv<64>(S, sV, O, m, lsum, fr, fq);
    __syncthreads();
  }
  for (int j = 0; j < 8; ++j) {
    load_kv<64>(CK + (size_t)j * 64 * 64, 64, CVT + j * 64, 512, sK, sV);
    __syncthreads();
    f32x4 S[4];
    qk_scores(qf, sK, S, fr, fq);
#pragma unroll
    for (int s = 0; s < 4; ++s) { S[s][0] *= 0.125f; S[s][1] *= 0.125f; S[s][2] *= 0.125f; S[s][3] *= 0.125f; }
    softmax_pv<64>(S, sV, O, m, lsum, fr, fq);
    __syncthreads();
  }
  float lt = lsum + __shfl_xor(lsum, 16);
  lt += __shfl_xor(lt, 32);
  const float inv = 1.f / lt;
#pragma unroll
  for (int dt = 0; dt < 4; ++dt)
    *(bf16x4*)(Y4 + (size_t)qrow * 2048 + h * 64 + dt * 16 + fq * 4) = pack4(O[dt][0] * inv, O[dt][1] * inv, O[dt][2] * inv, O[dt][3] * inv);
}

DI void diff_item(const P& p, int l, bool latent, int b, int h, int qb, char* smem) {
  bf16_t* sK = (bf16_t*)smem;
  bf16_t* sV = sK + 64 * LDT;
  const int tid_ = otid(), lane = tid_ & 63, wid = tid_ >> 6, fr = lane & 15, fq = lane >> 4;
  const bf16_t* Z = (const bf16_t*)(p.ws + WS_Z);
  const int T = latent ? 2048 : 256;
  const int rowbase = latent ? NCTX + b * 2048 : b * 256;
  const bf16_t* VT = (const bf16_t*)(p.ws + WS_VTDF) + (latent ? (size_t)VT_LAT + (size_t)(b * 512 + h * 128) * 2048 : (size_t)(b * 512 + h * 128) * 256);
  const bf16_t* CVT = (const bf16_t*)(p.ws + WS_CVDF) + (size_t)(b * 4 + h) * 65536;
  bf16_t* Y4 = (bf16_t*)(p.ws + WS_Y4);
  const int qrow = rowbase + qb * 64 + wid * 16 + fr;
  float d1 = p.in[20][l * 64 + lane] * p.in[21][l * 64 + lane];
  float d2 = p.in[22][l * 64 + lane] * p.in[23][l * 64 + lane];
  d1 = wave_sum(d1);
  d2 = wave_sum(d2);
  const float lam_init = 0.8f - 0.6f * expf(-0.3f * (float)l);
  const float lam = expf(d1) - expf(d2) + lam_init;

  f32x4 O1[8];
  f32x4 O[8];
  for (int comp = 0; comp < 2; ++comp) {
    bf16x8 qf[2];
#pragma unroll
    for (int ks = 0; ks < 2; ++ks) qf[ks] = *(const bf16x8*)(Z + (size_t)qrow * ZLD + ZC_DFQ + comp * 256 + h * 64 + ks * 32 + fq * 8);
#pragma unroll
    for (int dt = 0; dt < 8; ++dt) O[dt] = f32x4{0.f, 0.f, 0.f, 0.f};
    float m = -1e30f, lsum = 0.f;
    const int nkt = T >> 6;
    for (int kt = 0; kt < nkt; ++kt) {
      load_kv<128>(Z + (size_t)(rowbase + kt * 64) * ZLD + ZC_DFK + comp * 256 + h * 64, ZLD, VT + kt * 64, T, sK, sV);
      __syncthreads();
      f32x4 S[4];
      qk_scores(qf, sK, S, fr, fq);
#pragma unroll
      for (int s = 0; s < 4; ++s) { S[s][0] *= 0.125f; S[s][1] *= 0.125f; S[s][2] *= 0.125f; S[s][3] *= 0.125f; }
      softmax_pv<128>(S, sV, O, m, lsum, fr, fq);
      __syncthreads();
    }
    if (latent) {
      const bf16_t* CK = (const bf16_t*)(p.ws + WS_CKDF) + (size_t)((b * 2 + comp) * 4 + h) * 32768;
      for (int j = 0; j < 8; ++j) {
        load_kv<128>(CK + (size_t)j * 64 * 64, 64, CVT + j * 64, 512, sK, sV);
        __syncthreads();
        f32x4 S[4];
        qk_scores(qf, sK, S, fr, fq);
#pragma unroll
        for (int s = 0; s < 4; ++s) { S[s][0] *= 0.125f; S[s][1] *= 0.125f; S[s][2] *= 0.125f; S[s][3] *= 0.125f; }
        softmax_pv<128>(S, sV, O, m, lsum, fr, fq);
        __syncthreads();
      }
    }
    float lt = lsum + __shfl_xor(lsum, 16);
    lt += __shfl_xor(lt, 32);
    const float inv = 1.f / lt;
    if (comp == 0) {
#pragma unroll
      for (int dt = 0; dt < 8; ++dt) { O1[dt][0] = O[dt][0] * inv; O1[dt][1] = O[dt][1] * inv; O1[dt][2] = O[dt][2] * inv; O1[dt][3] = O[dt][3] * inv; }
    } else {
#pragma unroll
      for (int dt = 0; dt < 8; ++dt) {
        O[dt][0] = O1[dt][0] - lam * (O[dt][0] * inv);
        O[dt][1] = O1[dt][1] - lam * (O[dt][1] * inv);
        O[dt][2] = O1[dt][2] - lam * (O[dt][2] * inv);
        O[dt][3] = O1[dt][3] - lam * (O[dt][3] * inv);
      }
    }
  }
  float ss = 0.f;
#pragma unroll
  for (int dt = 0; dt < 8; ++dt) ss += O[dt][0] * O[dt][0] + O[dt][1] * O[dt][1] + O[dt][2] * O[dt][2] + O[dt][3] * O[dt][3];
  ss += __shfl_xor(ss, 16);
  ss += __shfl_xor(ss, 32);
  const float rsn = rsqrtf(ss * (1.f / 128.f) + 1e-6f) * (1.f - lam_init);
  const float* gn = p.in[24] + l * 128;
#pragma unroll
  for (int dt = 0; dt < 8; ++dt) {
    int dv = dt * 16 + fq * 4;
    float4 g = *(const float4*)(gn + dv);
    *(bf16x4*)(Y4 + (size_t)qrow * 2048 + 512 + h * 128 + dv) = pack4(O[dt][0] * rsn * g.x, O[dt][1] * rsn * g.y, O[dt][2] * rsn * g.z, O[dt][3] * rsn * g.w);
  }
}

DI void ret_item(const P& p, int l, bool latent, int b, int h, int qb, char* smem) {
  bf16_t* sK = (bf16_t*)smem;
  bf16_t* sV = sK + 64 * LDT;
  const int tid = otid(), lane = tid & 63, wid = tid >> 6, fr = lane & 15, fq = lane >> 4;
  const bf16_t* Z = (const bf16_t*)(p.ws + WS_Z);
  const int T = latent ? 2048 : 256;
  const int rowbase = latent ? NCTX + b * 2048 : b * 256;
  const bf16_t* VT = (const bf16_t*)(p.ws + WS_VTRT) + (latent ? (size_t)VT_LAT + (size_t)(b * 512 + h * 64) * 2048 : (size_t)(b * 512 + h * 64) * 256);
  bf16_t* Y4 = (bf16_t*)(p.ws + WS_Y4);
  const int tq = qb * 64 + wid * 16 + fr;
  const int qrow = rowbase + tq;
  const float lgf = log1pf(-expf(p.in[25][l * 8 + h]));
  const float lgb = log1pf(-expf(p.in[26][l * 8 + h]));
  bf16x8 qf[2];
#pragma unroll
  for (int ks = 0; ks < 2; ++ks) qf[ks] = *(const bf16x8*)(Z + (size_t)qrow * ZLD + ZC_RTQ + h * 64 + ks * 32 + fq * 8);
  f32x4 O[4];
#pragma unroll
  for (int dt = 0; dt < 4; ++dt) O[dt] = f32x4{0.f, 0.f, 0.f, 0.f};
  const int nkt = T >> 6;
  for (int kt = 0; kt < nkt; ++kt) {
    load_kv<64>(Z + (size_t)(rowbase + kt * 64) * ZLD + ZC_RTK + h * 64, ZLD, VT + kt * 64, T, sK, sV);
    __syncthreads();
    f32x4 S[4];
    qk_scores(qf, sK, S, fr, fq);
#pragma unroll
    for (int s = 0; s < 4; ++s)
#pragma unroll
      for (int i = 0; i < 4; ++i) {
        int tk = kt * 64 + s * 16 + fq * 4 + i;
        int dd = tq - tk;
        float w = dd >= 0 ? __expf(lgf * (float)dd) : __expf(lgb * (float)(-dd));
        S[s][i] *= w;
      }
    bf16x8 pb[2];
    pb[0] = pack8(S[0], S[1]);
    pb[1] = pack8(S[2], S[3]);
    pv_step<64>(pb, sV, O, fr, fq);
    __syncthreads();
  }
  if (latent) {
    for (int dir = 0; dir < 2; ++dir) {
      const float* S0 = (dir == 0 ? p.in[6] : p.in[7]) + ((size_t)((b * 4 + l) * 8 + h)) * 4096;
#pragma unroll
      for (int i = 0; i < 4; ++i) {
        int e = (tid + i * 256) * 4;
        float4 v = *(const float4*)(S0 + e);
        int dk = e >> 6, dv = e & 63;
        sV[(dv + 0) * LDT + dk] = f2bf(v.x);
        sV[(dv + 1) * LDT + dk] = f2bf(v.y);
        sV[(dv + 2) * LDT + dk] = f2bf(v.z);
        sV[(dv + 3) * LDT + dk] = f2bf(v.w);
      }
      __syncthreads();
      const float sc = dir == 0 ? __expf(lgf * (float)(tq + 1)) : __expf(lgb * (float)(T - tq));
      bf16x8 pb[2];
#pragma unroll
      for (int s2 = 0; s2 < 2; ++s2) {
        const bf16_t* qp = Z + (size_t)qrow * ZLD + ZC_RTQ + h * 64 + 32 * s2 + 4 * fq;
        bf16x4 lo = *(const bf16x4*)qp;
        bf16x4 hi = *(const bf16x4*)(qp + 16);
        bf16x8 r;
#pragma unroll
        for (int j = 0; j < 4; ++j) {
          r[j] = (short)f2bf(bfs2f(lo[j]) * sc);
          r[4 + j] = (short)f2bf(bfs2f(hi[j]) * sc);
        }
        pb[s2] = r;
      }
      pv_step<64>(pb, sV, O, fr, fq);
      __syncthreads();
    }
  }
  float ss = 0.f;
#pragma unroll
  for (int dt = 0; dt < 4; ++dt) ss += O[dt][0] * O[dt][0] + O[dt][1] * O[dt][1] + O[dt][2] * O[dt][2] + O[dt][3] * O[dt][3];
  ss += __shfl_xor(ss, 16);
  ss += __shfl_xor(ss, 32);
  const float rsn = rsqrtf(ss * (1.f / 64.f) + 1e-6f);
  const float* gn = p.in[27] + l * 512 + h * 64;
#pragma unroll
  for (int dt = 0; dt < 4; ++dt) {
    int dv = dt * 16 + fq * 4;
    float4 g = *(const float4*)(gn + dv);
    bf16x4 sg = *(const bf16x4*)(Z + (size_t)qrow * ZLD + ZC_RTG + h * 64 + dv);
    *(bf16x4*)(Y4 + (size_t)qrow * 2048 + 1024 + h * 64 + dv) =
        pack4(O[dt][0] * rsn * g.x * bfs2f(sg[0]), O[dt][1] * rsn * g.y * bfs2f(sg[1]), O[dt][2] * rsn * g.z * bfs2f(sg[2]), O[dt][3] * rsn * g.w * bfs2f(sg[3]));
  }
}

DI void ret_state_item(const P& p, int l, int b, int h) {
  const int tid_ = otid(), lane = tid_ & 63, wid = tid_ >> 6, fr = lane & 15, fq = lane >> 4;
  const bf16_t* KT = (const bf16_t*)(p.ws + WS_KTRT) + (size_t)(b * 512 + h * 64) * 256;
  const bf16_t* VT = (const bf16_t*)(p.ws + WS_VTRT) + (size_t)(b * 512 + h * 64) * 256;
  const float lgf = log1pf(-expf(p.in[25][l * 8 + h]));
  const float lgb = log1pf(-expf(p.in[26][l * 8 + h]));
  f32x4 af[4], ab[4];
#pragma unroll
  for (int nt = 0; nt < 4; ++nt) { af[nt] = f32x4{0.f, 0.f, 0.f, 0.f}; ab[nt] = f32x4{0.f, 0.f, 0.f, 0.f}; }
  for (int ks = 0; ks < 8; ++ks) {
    const int t0 = ks * 32 + fq * 8;
    bf16x8 kraw = *(const bf16x8*)(KT + (size_t)(wid * 16 + fr) * 256 + t0);
    bf16x8 kf, kb;
#pragma unroll
    for (int j = 0; j < 8; ++j) {
      float kv = bfs2f(kraw[j]);
      int t = t0 + j;
      kf[j] = (short)f2bf(kv * __expf(lgf * (float)(255 - t)));
      kb[j] = (short)f2bf(kv * __expf(lgb * (float)t));
    }
#pragma unroll
    for (int nt = 0; nt < 4; ++nt) {
      bf16x8 vb = *(const bf16x8*)(VT + (size_t)(nt * 16 + fr) * 256 + t0);
      af[nt] = MFMA16(kf, vb, af[nt]);
      ab[nt] = MFMA16(kb, vb, ab[nt]);
    }
  }
  float* of = p.out + O_RF + ((size_t)((b * 4 + l) * 8 + h)) * 4096;
  float* ob = p.out + O_RB + ((size_t)((b * 4 + l) * 8 + h)) * 4096;
#pragma unroll
  for (int nt = 0; nt < 4; ++nt)
#pragma unroll
    for (int i = 0; i < 4; ++i) {
      int dk = wid * 16 + fq * 4 + i, dv = nt * 16 + fr;
      of[dk * 64 + dv] = af[nt][i];
      ob[dk * 64 + dv] = ab[nt][i];
    }
}

DI void lru_gates_item(const P& p, int l, int chunk, int n, char* smem) {
  float* XDf = (float*)smem;
  bf16_t* XDb = (bf16_t*)(XDf + 4096);
  const int tid = otid(), lane = tid & 63, wid = tid >> 6, fr = lane & 15, fq = lane >> 4;
  const int row0 = chunk * 64;
  const bool latent = row0 >= NCTX;
  const int T = latent ? 2048 : 256;
  const int tseq0 = latent ? ((row0 - NCTX) & 2047) : (row0 & 255);
  const bf16_t* Z = (const bf16_t*)(p.ws + WS_Z);
  const bf16_t* WL = (const bf16_t*)(p.ws + WS_WLRU);
  bf16_t* LA = (bf16_t*)(p.ws + WS_LA);
  bf16_t* LU = (bf16_t*)(p.ws + WS_LU);
  const int ch0 = n * 64;
  {
    const float cw0 = p.in[28][(l * 4 + 0) * 512 + ch0 + lane];
    const float cw1 = p.in[28][(l * 4 + 1) * 512 + ch0 + lane];
    const float cw2 = p.in[28][(l * 4 + 2) * 512 + ch0 + lane];
    const float cw3 = p.in[28][(l * 4 + 3) * 512 + ch0 + lane];
    const float cb = p.in[29][l * 512 + ch0 + lane];
    const bf16_t* xcol = Z + (size_t)row0 * ZLD + ZC_LRX + ch0 + lane;
    const int t0 = wid * 16;
    auto ld = [&](int tl) -> float {
      int ts = tseq0 + tl;
      return (ts < 0 || ts >= T) ? 0.f : bf2f(xcol[(ptrdiff_t)tl * ZLD]);
    };
    float xm1 = ld(t0 - 1), x0 = ld(t0), x1 = ld(t0 + 1);
#pragma unroll
    for (int i = 0; i < 16; ++i) {
      float x2 = ld(t0 + i + 2);
      float xd = cw0 * xm1 + cw1 * x0 + cw2 * x1 + cw3 * x2 + cb;
      XDf[(t0 + i) * 64 + lane] = xd;
      XDb[(t0 + i) * LDT + lane] = f2bf(xd);
      xm1 = x0; x0 = x1; x1 = x2;
    }
  }
  __syncthreads();
  bf16x8 af[2];
#pragma unroll
  for (int ks = 0; ks < 2; ++ks) af[ks] = *(const bf16x8*)(XDb + (wid * 16 + fr) * LDT + ks * 32 + fq * 8);
#pragma unroll 1
  for (int dir = 0; dir < 2; ++dir) {
    const float* bav = (dir == 0 ? p.in[31] : p.in[36]) + l * 512 + ch0;
    const float* bxv = (dir == 0 ? p.in[33] : p.in[38]) + l * 512 + ch0;
    const float* lamv = (dir == 0 ? p.in[34] : p.in[39]) + l * 512 + ch0;
#pragma unroll
    for (int et = 0; et < 4; ++et) {
      f32x4 da = {0.f, 0.f, 0.f, 0.f}, dx = {0.f, 0.f, 0.f, 0.f};
#pragma unroll
      for (int ks = 0; ks < 2; ++ks) {
        bf16x8 wa = *(const bf16x8*)(WL + (size_t)((dir * 2 + 0) * 8 + n) * 4096 + (et * 16 + fr) * 64 + ks * 32 + fq * 8);
        bf16x8 wx = *(const bf16x8*)(WL + (size_t)((dir * 2 + 1) * 8 + n) * 4096 + (et * 16 + fr) * 64 + ks * 32 + fq * 8);
        da = MFMA16(af[ks], wa, da);
        dx = MFMA16(af[ks], wx, dx);
      }
      const int e = et * 16 + fr;
      const float ba_ = bav[e], bx_ = bxv[e];
      const float sp = log1pf(expf(-lamv[e]));
      float lav[4], uv[4];
#pragma unroll
      for (int i = 0; i < 4; ++i) {
        int tl = wid * 16 + fq * 4 + i;
        float rg = 1.f / (1.f + expf(-(da[i] + ba_)));
        float ig = 1.f / (1.f + expf(-(dx[i] + bx_)));
        float la = -8.f * rg * sp;
        lav[i] = la;
        uv[i] = sqrtf(-expm1f(2.f * la)) * (ig * XDf[tl * 64 + e]);
      }
      const size_t idx = (size_t)dir * 8388608 + ((size_t)chunk * 512 + ch0 + e) * 64 + wid * 16 + fq * 4;
      *(bf16x4*)(LA + idx) = pack4(lav[0], lav[1], lav[2], lav[3]);
      *(bf16x4*)(LU + idx) = pack4(uv[0], uv[1], uv[2], uv[3]);
    }
  }
  __syncthreads();
}

DI void lru_scan_witem(const P& p, int l, int bglob, int g, int lane) {
  const bool latent = bglob >= 32;
  const int T = latent ? 2048 : 256;
  const int rowbase = latent ? NCTX + (bglob - 32) * 2048 : bglob * 256;
  const int chunk0 = rowbase >> 6, nch = T >> 6;
  const int ch = g * 64 + lane;
  const bf16_t* LA = (const bf16_t*)(p.ws + WS_LA);
  const bf16_t* LU = (const bf16_t*)(p.ws + WS_LU);
  bf16_t* HF = (bf16_t*)(p.ws + WS_HF);
  const bf16_t* LG = (const bf16_t*)(p.ws + WS_LG);
  bf16_t* Y4 = (bf16_t*)(p.ws + WS_Y4);
  {
    float h = latent ? p.in[8][((bglob - 32) * 4 + l) * 512 + ch] : 0.f;
    bf16x8 ca[8], cu[8], na[8], nu[8];
    {
      const size_t b0 = ((size_t)chunk0 * 512 + ch) * 64;
#pragma unroll
      for (int q = 0; q < 8; ++q) { ca[q] = *(const bf16x8*)(LA + b0 + q * 8); cu[q] = *(const bf16x8*)(LU + b0 + q * 8); }
    }
    for (int cc = 0; cc < nch; ++cc) {
      const size_t cbase = ((size_t)(chunk0 + cc) * 512 + ch) * 64;
      const int cn = (cc + 1 < nch) ? cc + 1 : cc;
      const size_t nb = ((size_t)(chunk0 + cn) * 512 + ch) * 64;
#pragma unroll
      for (int q = 0; q < 8; ++q) { na[q] = *(const bf16x8*)(LA + nb + q * 8); nu[q] = *(const bf16x8*)(LU + nb + q * 8); }
#pragma unroll
      for (int q = 0; q < 8; ++q) {
        bf16x8 ho;
#pragma unroll
        for (int j = 0; j < 8; ++j) {
          float a = __expf(bfs2f(ca[q][j]));
          h = a * h + bfs2f(cu[q][j]);
          ho[j] = (short)f2bf(h);
        }
        *(bf16x8*)(HF + cbase + q * 8) = ho;
      }
#pragma unroll
      for (int q = 0; q < 8; ++q) { ca[q] = na[q]; cu[q] = nu[q]; }
    }
    if (!latent) p.out[O_LF + (size_t)(bglob * 4 + l) * 512 + ch] = h;
  }
  {
    float h = latent ? p.in[9][((bglob - 32) * 4 + l) * 512 + ch] : 0.f;
    const bf16_t* LAb = LA + 8388608;
    const bf16_t* LUb = LU + 8388608;
    bf16x8 ca[4], cu[4], chf[4], cg_[4], na[4], nu[4], nhf[4], ng[4];
    const int nb_ = 2 * nch;
    {
      const size_t b0 = ((size_t)(chunk0 + nch - 1) * 512 + ch) * 64 + 32;
#pragma unroll
      for (int q = 0; q < 4; ++q) {
        ca[q] = *(const bf16x8*)(LAb + b0 + q * 8); cu[q] = *(const bf16x8*)(LUb + b0 + q * 8);
        chf[q] = *(const bf16x8*)(HF + b0 + q * 8); cg_[q] = *(const bf16x8*)(LG + b0 + q * 8);
      }
    }
    for (int bi = 0; bi < nb_; ++bi) {
      const int chunk = nch - 1 - (bi >> 1), half = 1 - (bi & 1);
      const int bn = (bi + 1 < nb_) ? bi + 1 : bi;
      const int chunkn = nch - 1 - (bn >> 1), halfn = 1 - (bn & 1);
      const size_t nb = ((size_t)(chunk0 + chunkn) * 512 + ch) * 64 + halfn * 32;
#pragma unroll
      for (int q = 0; q < 4; ++q) {
        na[q] = *(const bf16x8*)(LAb + nb + q * 8); nu[q] = *(const bf16x8*)(LUb + nb + q * 8);
        nhf[q] = *(const bf16x8*)(HF + nb + q * 8); ng[q] = *(const bf16x8*)(LG + nb + q * 8);
      }
      bf16_t* yrow = Y4 + (size_t)(rowbase + chunk * 64 + half * 32) * 2048 + 1536 + ch;
#pragma unroll
      for (int q = 3; q >= 0; --q) {
#pragma unroll
        for (int j = 7; j >= 0; --j) {
          float a = __expf(bfs2f(ca[q][j]));
          h = a * h + bfs2f(cu[q][j]);
          float y = (bfs2f(chf[q][j]) + h) * bfs2f(cg_[q][j]);
          yrow[(size_t)(q * 8 + j) * 2048] = f2bf(y);
        }
      }
#pragma unroll
      for (int q = 0; q < 4; ++q) { ca[q] = na[q]; cu[q] = nu[q]; chf[q] = nhf[q]; cg_[q] = ng[q]; }
    }
    if (!latent) p.out[O_LB + (size_t)(bglob * 4 + l) * 512 + ch] = h;
  }
}

DI void phase_mixa(const P& p, int l, char* smem) {
  const int NITEMS = 512 + 2048;
  for (int it = blockIdx.x; it < NITEMS; it += gridDim.x) {
    int q = it;
    if (q < 512) { diff_item(p, l, true, q >> 7, (q >> 5) & 3, q & 31, smem); continue; }
    q -= 512;
    lru_gates_item(p, l, q >> 3, q & 7, smem);
  }
}
DI void phase_mixb(const P& p, int l, char* smem) {
  const int NITEMS = 72 + 4864;
  for (int it = blockIdx.x; it < NITEMS; it += gridDim.x) {
    int q = it;
    if (q < 72) {
      const int tid = otid(), lane = tid & 63, wid = tid >> 6;
      int bglob, g;
      if (q < 32) {
        if (wid == 0) { bglob = 32 + (q >> 3); g = q & 7; }
        else { int ci = q * 3 + wid - 1; bglob = ci >> 3; g = ci & 7; }
      } else {
        int ci = 96 + (q - 32) * 4 + wid;
        bglob = ci >> 3; g = ci & 7;
      }
      lru_scan_witem(p, l, bglob, g, lane);
      continue;
    }
    q -= 72;
    if (q < 1024) { ret_item(p, l, true, q >> 8, (q >> 5) & 7, q & 31, smem); continue; }
    q -= 1024;
    if (q < 1024) { na_item(p, l, q >> 8, (q >> 5) & 7, q & 31, smem); continue; }
    q -= 1024;
    if (q < 1024) { dense_item(p, q >> 5, (q >> 2) & 7, q & 3, smem); continue; }
    q -= 1024;
    if (q < 512) { diff_item(p, l, false, q >> 4, (q >> 2) & 3, q & 3, smem); continue; }
    q -= 512;
    if (q < 1024) { ret_item(p, l, false, q >> 5, (q >> 2) & 7, q & 3, smem); continue; }
    q -= 1024;
    ret_state_item(p, l, q >> 3, q & 7);
  }
}

#define XB_TMO 128
#define XB_XCNT(j) (256 + 64 * (j))
#define XB_XSUB(j) (1280 + 64 * (j))
#define XB_XGEN(j) (2304 + 64 * (j))
#define XB_TOP 3328
#define XB_TOPGEN 3392
#define XCD_BAR_WORDS 3456
#define XB_SPIN_CAP (1u << 18)
#define LAS __attribute__((address_space(3)))
DI unsigned xb_ld(unsigned* p) { return __hip_atomic_load(p, __ATOMIC_RELAXED, __HIP_MEMORY_SCOPE_AGENT); }
DI unsigned xb_add(unsigned* p, unsigned v) { return __hip_atomic_fetch_add(p, v, __ATOMIC_RELAXED, __HIP_MEMORY_SCOPE_AGENT); }
DI unsigned xb_xcc_id() { return (unsigned)__builtin_amdgcn_s_getreg((3 << 11) | 20) & 0xFu; }
#define XB_SPIN(cond, bar) do { unsigned _sp = 0; while (cond) { __builtin_amdgcn_s_sleep(1); \
    if ((++_sp & 255u) == 0u) { if (xb_ld(&(bar)[XB_TMO])) break; if (_sp > XB_SPIN_CAP) { atomicAdd(&(bar)[XB_TMO], 1u); break; } } } } while (0)
struct XcdBarrier { unsigned* bar; unsigned x; volatile LAS unsigned* st; };
DI XcdBarrier xcd_barrier_post(unsigned* bar, volatile LAS unsigned* st) {
  XcdBarrier b; b.bar = bar; b.x = xb_xcc_id(); b.st = st;
  if (threadIdx.x == 0) (void)xb_add(&bar[XB_XCNT(b.x)], 1u);
  return b;
}
DI void xcd_barrier_complete(unsigned* bar, unsigned x, unsigned& nloc, unsigned& nx) {
  const unsigned G = gridDim.x * gridDim.y * gridDim.z;
  unsigned sum, cnt, mine, sp = 0u;
  for (;;) {
    sum = 0u; cnt = 0u; mine = 0u;
#pragma unroll
    for (unsigned j = 0; j < 16; ++j) { const unsigned c = xb_ld(&bar[XB_XCNT(j)]); sum += c; cnt += (c > 0u) ? 1u : 0u; mine = (j == x) ? c : mine; }
    if (sum == G) break;
    __builtin_amdgcn_s_sleep(1);
    if ((++sp & 255u) == 0u) { if (xb_ld(&bar[XB_TMO])) break; if (sp > XB_SPIN_CAP) { atomicAdd(&bar[XB_TMO], 1u); break; } }
  }
  nloc = mine > 0u ? mine : 1u; nx = cnt > 0u ? cnt : 1u;
}
DI void xcd_barrier(const XcdBarrier& b) {
  asm volatile("s_waitcnt vmcnt(0)" ::: "memory");
  __syncthreads();
  if (threadIdx.x == 0) {
    unsigned* bar = b.bar;
    __builtin_amdgcn_s_waitcnt(0);
    unsigned nloc = b.st[0], nx = b.st[1];
    if (nloc == 0u) { xcd_barrier_complete(bar, b.x, nloc, nx); b.st[0] = nloc; b.st[1] = nx; }
    const unsigned old = xb_add(&bar[XB_XSUB(b.x)], 1u);
    const unsigned gen = old / nloc;
    if (old + 1u == (gen + 1u) * nloc) {
      __builtin_amdgcn_fence(__ATOMIC_RELEASE, "agent");
      asm volatile("s_waitcnt vmcnt(0)" ::: "memory");
      const unsigned og = xb_add(&bar[XB_TOP], 1u);
      const unsigned tg = og / nx;
      if (og + 1u == (tg + 1u) * nx) xb_add(&bar[XB_TOPGEN], 1u);
      else XB_SPIN(xb_ld(&bar[XB_TOPGEN]) == tg, bar);
      __builtin_amdgcn_fence(__ATOMIC_ACQUIRE, "agent");
      xb_add(&bar[XB_XGEN(b.x)], 1u);
      asm volatile("s_waitcnt vmcnt(0)" ::: "memory");
    } else {
      XB_SPIN(xb_ld(&bar[XB_XGEN(b.x)]) == gen, bar);
      __builtin_amdgcn_fence(__ATOMIC_ACQUIRE, "agent");
      asm volatile("s_waitcnt vmcnt(0)" ::: "memory");
    }
  }
  __syncthreads();
}

enum { PH_INIT = 0, PH_PRE0, PH_GIN, PH_MIXA, PH_MIXB, PH_MERGE, PH_OUT, PH_POSTMIX, PH_FF1, PH_FF2, PH_POSTFFN };

DI void run_phase(const P& p, int ph, int l, char* smem) {
  switch (ph) {
    case PH_INIT:
      phase_mod(p, smem);
      phase_convert(p, 0, smem);
      break;
    case PH_PRE0: phase_row(p, 0, 0); break;
    case PH_GIN: phase_gin(p, l, smem); break;
    case PH_MIXA: phase_mixa(p, l, smem); break;
    case PH_MIXB: phase_mixb(p, l, smem); break;
    case PH_MERGE: phase_merge(p, smem); break;
    case PH_OUT:
      phase_gemm_plain<0>((const bf16_t*)(p.ws + WS_H), 1024, (const bf16_t*)(p.ws + WS_WOUT), 1024, (void*)(p.ws + WS_Y), smem);
      break;
    case PH_POSTMIX: phase_row(p, l, 1); break;
    case PH_FF1:
      phase_gemm_plain<1>((const bf16_t*)(p.ws + WS_H), 1024, (const bf16_t*)(p.ws + WS_W1), 4096, (void*)(p.ws + WS_U), smem);
      break;
    case PH_FF2:
      phase_gemm_plain<0>((const bf16_t*)(p.ws + WS_U), 4096, (const bf16_t*)(p.ws + WS_W2), 1024, (void*)(p.ws + WS_Y), smem);
      break;
    case PH_POSTFFN:
      phase_row(p, l, 2);
      if (l < 3) phase_convert(p, l + 1, smem);
      break;
    default: break;
  }
}

DI void decode_step(int step, int& ph, int& l) {
  if (step < 2) { ph = step; l = 0; }
  else { int s = step - 2; l = s / 9; ph = PH_GIN + (s % 9); }
}
constexpr int NSTEPS = 38;

__global__ void __launch_bounds__(256, 2) hybrid_flow_mega(P p) {
  __shared__ __attribute__((aligned(16))) char smem[SMEM_BYTES];
  __shared__ uint4 xb_words;
  cg::grid_group grid = cg::this_grid();
  if (threadIdx.x == 0) xb_words = make_uint4(0u, 0u, 0u, 0u);
  __syncthreads();
  XcdBarrier xb = xcd_barrier_post((unsigned*)(p.ws + WS_BAR), (volatile LAS unsigned*)&xb_words);
  for (int step = 0; step < NSTEPS; ++step) {
    int ph, l;
    decode_step(step, ph, l);
#ifdef PROBE_DUP
    const int reps = (ph == PROBE_DUP) ? 2 : 1;
    for (int rep = 0; rep < reps; ++rep)
#endif
    run_phase(p, ph, l, smem);
#ifdef PROBE_CONV
    if (ph == PH_POSTFFN && l < 3) phase_convert(p, l + 1, smem);
#endif
    if (step == 0) grid.sync();
    else if (step + 1 < NSTEPS) xcd_barrier(xb);
#ifdef PROBE_SYNC
    if (step + 1 < NSTEPS) xcd_barrier(xb);
#endif
  }
}

#if !ONE_LAUNCH
__global__ void __launch_bounds__(256, 2) hybrid_flow_phase(P p, int ph, int l) {
  __shared__ __attribute__((aligned(16))) char smem[SMEM_BYTES];
  run_phase(p, ph, l, smem);
}
#endif

extern "C" void kernel_launch(void* const* d_in, const int* in_sizes, int n_in, void* d_out, int out_size, void* d_ws,
                              size_t ws_size, hipStream_t stream) {
  (void)in_sizes; (void)n_in; (void)out_size; (void)ws_size;
  P p{};
  for (int i = 0; i < 44; ++i) p.in[i] = (const float*)d_in[i];
  p.out = (float*)d_out;
  p.ws = (char*)d_ws;
#if ONE_LAUNCH
  static int grid_blocks = 0;
  if (!grid_blocks) {
    int dev = 0, cus = 0, per_cu = 0;
    hipGetDevice(&dev);
    hipDeviceGetAttribute(&cus, hipDeviceAttributeMultiprocessorCount, dev);
    hipOccupancyMaxActiveBlocksPerMultiprocessor(&per_cu, hybrid_flow_mega, 256, 0);
    if (per_cu < 1) per_cu = 1;
    if (per_cu > 2) per_cu = 2;
    grid_blocks = cus * per_cu;
  }
  (void)hipMemsetAsync((char*)d_ws + WS_BAR, 0, 16384, stream);
  void* args[] = {&p};
  hipError_t e = hipLaunchCooperativeKernel((void*)hybrid_flow_mega, dim3(grid_blocks), dim3(256), args, 0, stream);
  if (e != hipSuccess) fprintf(stderr, "cooperative launch failed: %s (grid %d)\n", hipGetErrorString(e), grid_blocks);
#else
  const int grid_blocks = 512;
  for (int step = 0; step < NSTEPS; ++step) {
    int ph, l;
    if (step < 2) { ph = step; l = 0; }
    else { int s = step - 2; l = s / 9; ph = PH_GIN + (s % 9); }
    hipLaunchKernelGGL(hybrid_flow_phase, dim3(grid_blocks), dim3(256), 0, stream, p, ph, l);
  }
#endif
}
```

```cpp
#include <hip/hip_runtime.h>
#include <hip/hip_cooperative_groups.h>
#include <cstdio>
namespace cg = cooperative_groups;

#ifndef ONE_LAUNCH
#define ONE_LAUNCH 1
#endif

typedef unsigned short bf16_t;
using bf16x8 = __attribute__((ext_vector_type(8))) short;
using bf16x4 = __attribute__((ext_vector_type(4))) short;
using f32x4 = __attribute__((ext_vector_type(4))) float;
using u32x4 = __attribute__((ext_vector_type(4))) unsigned;
#define DI __device__ __forceinline__
#define MFMA16(a, b, c) __builtin_amdgcn_mfma_f32_16x16x32_bf16((a), (b), (c), 0, 0, 0)

struct P {
  const float* in[44];
  float* out;
  char* ws;
};

constexpr int D = 1024, NCTX = 8192;
constexpr int ZLD = 8256;
constexpr int ZC_NAQ = 0, ZC_NAK = 512, ZC_DFQ = 1024, ZC_DFK = 1536, ZC_RTQ = 2048, ZC_RTK = 2560, ZC_RTG = 3072,
              ZC_LRX = 3584, ZC_GATE = 4096;
constexpr int LDT = 72;

constexpr size_t WS_WIN = 0;
constexpr size_t WS_WBR = WS_WIN + (size_t)10240 * 1024 * 2;
constexpr size_t WS_WOUT = WS_WBR + (size_t)1024 * 2048 * 2;
constexpr size_t WS_W1 = WS_WOUT + (size_t)1024 * 1024 * 2;
constexpr size_t WS_W2 = WS_W1 + (size_t)4096 * 1024 * 2;
constexpr size_t WS_WLRU = WS_W2 + (size_t)4096 * 1024 * 2;
constexpr size_t WS_CKNA = WS_WLRU + (size_t)32 * 4096 * 2;
constexpr size_t WS_CVNA = WS_CKNA + (size_t)4 * 262144 * 2;
constexpr size_t WS_CKDF = WS_CVNA + (size_t)4 * 262144 * 2;
constexpr size_t WS_CVDF = WS_CKDF + (size_t)4 * 262144 * 2;
constexpr size_t WS_MOD = WS_CVDF + (size_t)4 * 262144 * 2;
constexpr size_t WS_H = WS_MOD + (size_t)4 * 5 * 6144 * 4;
constexpr size_t WS_Y4 = WS_H + (size_t)16384 * 1024 * 2;
constexpr size_t WS_VTNA = WS_Y4 + (size_t)16384 * 2048 * 2;
constexpr size_t WS_VTDF = WS_VTNA + (size_t)16384 * 512 * 2;
constexpr size_t WS_VTRT = WS_VTDF + (size_t)16384 * 512 * 2;
constexpr size_t WS_KTRT = WS_VTRT + (size_t)16384 * 512 * 2;
constexpr size_t WS_Z = WS_KTRT + (size_t)8192 * 512 * 2;
constexpr size_t WS_Y = WS_Z;
constexpr size_t WS_U = WS_Z + (size_t)16384 * 1024 * 4;
constexpr size_t WS_LA = WS_Z + (size_t)16384 * ZLD * 2;
constexpr size_t WS_LU = WS_LA + (size_t)2 * 16384 * 512 * 2;
constexpr size_t WS_HF = WS_LU + (size_t)2 * 16384 * 512 * 2;
constexpr size_t WS_LG = WS_HF + (size_t)16384 * 512 * 2;
constexpr size_t WS_BAR = WS_LG + (size_t)16384 * 512 * 2;
constexpr size_t WS_END = WS_BAR + 16384;

constexpr size_t O_NAK = 16777216, O_NAV = 33554432, O_DFK = 50331648, O_DFV = 67108864, O_RF = 83886080,
                 O_RB = 88080384, O_LF = 92274688, O_LB = 92340224;
constexpr int VT_LAT = 4194304;

constexpr int SMEM_BYTES = 59392;

DI int otid() {
  int t = threadIdx.x;
  asm volatile("" : "+v"(t));
  return t;
}
typedef __bf16 hwbf2 __attribute__((ext_vector_type(2)));
typedef float f32v2 __attribute__((ext_vector_type(2)));
using u32x2 = __attribute__((ext_vector_type(2))) unsigned;
DI unsigned pk2(float a, float b) {
  f32v2 v = {a, b};
  return __builtin_bit_cast(unsigned, __builtin_convertvector(v, hwbf2));
}
DI bf16_t f2bf(float x) { return (bf16_t)(pk2(x, 0.f) & 0xffffu); }
DI float bf2f(bf16_t b) { return __uint_as_float(((unsigned)b) << 16); }
DI float bfs2f(short b) { return __uint_as_float(((unsigned)(unsigned short)b) << 16); }
DI float wave_sum(float v) {
#pragma unroll
  for (int o = 32; o > 0; o >>= 1) v += __shfl_xor(v, o);
  return v;
}
DI float sigmoidf_(float x) { return 1.f / (1.f + __expf(-x)); }
DI float gelu_tanh(float x) {
  float u = 0.7978845608028654f * (x + 0.044715f * x * x * x);
  return 0.5f * x * (1.f + tanhf(u));
}
DI bf16x8 pack8(const f32x4& a, const f32x4& b) {
  u32x4 r = {pk2(a[0], a[1]), pk2(a[2], a[3]), pk2(b[0], b[1]), pk2(b[2], b[3])};
  return __builtin_bit_cast(bf16x8, r);
}
DI bf16x4 pack4(float a, float b, float c, float d) {
  u32x2 r = {pk2(a, b), pk2(c, d)};
  return __builtin_bit_cast(bf16x4, r);
}

DI void gemm_mainloop(const bf16_t* __restrict__ A, int lda, const bf16_t* __restrict__ Bt, int ldb, int K, int row0,
                      int col0, bf16_t* sA, bf16_t* sB, f32x4 (&acc)[4][4]) {
  const int tid = otid(), lane = tid & 63, wid = tid >> 6;
  const int wm = wid >> 1, wn = wid & 1, fr = lane & 15, fq = lane >> 4;
  const bf16_t* Ag = A + (size_t)row0 * lda;
  const bf16_t* Bg = Bt + (size_t)col0 * ldb;
  u32x4 ra[4], rb[4];
#pragma unroll
  for (int i = 0; i < 4; ++i) {
    int id = tid + i * 256, r = id >> 3, c = (id & 7) * 8;
    ra[i] = *(const u32x4*)(Ag + (size_t)r * lda + c);
    rb[i] = *(const u32x4*)(Bg + (size_t)r * ldb + c);
  }
#pragma unroll
  for (int i = 0; i < 4; ++i) {
    int id = tid + i * 256, r = id >> 3, c = (id & 7) * 8;
    *(u32x4*)(sA + r * LDT + c) = ra[i];
    *(u32x4*)(sB + r * LDT + c) = rb[i];
  }
  __syncthreads();
  for (int k0 = 0; k0 < K; k0 += 64) {
    const bool more = (k0 + 64) < K;
    if (more) {
#pragma unroll
      for (int i = 0; i < 4; ++i) {
        int id = tid + i * 256, r = id >> 3, c = (id & 7) * 8;
        ra[i] = *(const u32x4*)(Ag + (size_t)r * lda + k0 + 64 + c);
        rb[i] = *(const u32x4*)(Bg + (size_t)r * ldb + k0 + 64 + c);
      }
    }
#pragma unroll
    for (int ks = 0; ks < 2; ++ks) {
      bf16x8 af[4], bfr[4];
#pragma unroll
      for (int mi = 0; mi < 4; ++mi) af[mi] = *(const bf16x8*)(sA + (wm * 64 + mi * 16 + fr) * LDT + ks * 32 + fq * 8);
#pragma unroll
      for (int ni = 0; ni < 4; ++ni) bfr[ni] = *(const bf16x8*)(sB + (wn * 64 + ni * 16 + fr) * LDT + ks * 32 + fq * 8);
#pragma unroll
      for (int mi = 0; mi < 4; ++mi)
#pragma unroll
        for (int ni = 0; ni < 4; ++ni) acc[mi][ni] = MFMA16(af[mi], bfr[ni], acc[mi][ni]);
    }
    __syncthreads();
    if (more) {
#pragma unroll
      for (int i = 0; i < 4; ++i) {
        int id = tid + i * 256, r = id >> 3, c = (id & 7) * 8;
        *(u32x4*)(sA + r * LDT + c) = ra[i];
        *(u32x4*)(sB + r * LDT + c) = rb[i];
      }
      __syncthreads();
    }
  }
}

DI void zero_acc(f32x4 (&acc)[4][4]) {
#pragma unroll
  for (int mi = 0; mi < 4; ++mi)
#pragma unroll
    for (int ni = 0; ni < 4; ++ni) acc[mi][ni] = f32x4{0.f, 0.f, 0.f, 0.f};
}
DI void tile_of(int id, int ntn, int& tm, int& tn) {
  int band = id / (16 * ntn), rem = id % (16 * ntn);
  tm = band * 16 + (rem & 15);
  tn = rem >> 4;
}

DI void epi_in(const P& p, int l, int row0, int col0, f32x4 (&acc)[4][4]) {
  const int tid_ = otid(), lane = tid_ & 63, wid = tid_ >> 6, wm = wid >> 1, wn = wid & 1, fr = lane & 15, fq = lane >> 4;
  const int seg = col0 >> 9;
  const bool ctx = row0 < NCTX;
  bf16_t* Z = (bf16_t*)(p.ws + WS_Z);
  const int rbase = row0 + wm * 64;
  const int cseg0 = (col0 & 511) + wn * 64;

  if (!ctx && (seg == 3 || seg == 4)) {
    const float inv = powf(10000.f, -(float)fr * (1.f / 16.f));
#pragma unroll
    for (int mi = 0; mi < 4; ++mi)
#pragma unroll
      for (int i = 0; i < 4; ++i) {
        int r = rbase + mi * 16 + fq * 4 + i;
        int t = (r - NCTX) & 2047;
        float gr = (float)(t >> 6), gc = (float)(t & 63);
        float sr, cr, sc, cc;
        sincosf(gr * inv, &sr, &cr);
        sincosf(gc * inv, &sc, &cc);
        float a0 = acc[mi][0][i], a1 = acc[mi][1][i], a2 = acc[mi][2][i], a3 = acc[mi][3][i];
        acc[mi][0][i] = a0 * cr - a1 * sr;
        acc[mi][1][i] = a1 * cr + a0 * sr;
        acc[mi][2][i] = a2 * cc - a3 * sc;
        acc[mi][3][i] = a3 * cc + a2 * sc;
      }
  }

  int zc = -1, tf = 0;
  bf16_t* VT = nullptr;
  switch (seg) {
    case 0: zc = ZC_NAQ; break;
    case 1: zc = ZC_NAK; break;
    case 2: VT = (bf16_t*)(p.ws + WS_VTNA); break;
    case 3: zc = ZC_DFQ; break;
    case 4: zc = ZC_DFK; break;
    case 5: VT = (bf16_t*)(p.ws + WS_VTDF); break;
    case 6: zc = ZC_RTQ; break;
    case 7: zc = ZC_RTK; tf = 4; break;
    case 8: VT = (bf16_t*)(p.ws + WS_VTRT); break;
    case 9: zc = ZC_RTG; tf = 1; break;
    case 10: zc = ZC_LRX; break;
    case 11: break;
    default: zc = ZC_GATE + (seg - 12) * 512; tf = 3; break;
  }

  if (zc >= 0) {
#pragma unroll
    for (int mi = 0; mi < 4; ++mi)
#pragma unroll
      for (int ni = 0; ni < 4; ++ni)
#pragma unroll
        for (int i = 0; i < 4; ++i) {
          int r = rbase + mi * 16 + fq * 4 + i;
          int c = cseg0 + ni * 16 + fr;
          float v = acc[mi][ni][i];
          if (tf == 1) v = v * sigmoidf_(v);
          else if (tf == 2) v = gelu_tanh(v);
          else if (tf == 3) v = sigmoidf_(v);
          else if (tf == 4) v = v * 0.125f;
          Z[(size_t)r * ZLD + zc + c] = f2bf(v);
        }
  }
  if (VT != nullptr || (seg == 7 && ctx)) {
    bf16_t* T_ = (seg == 7) ? (bf16_t*)(p.ws + WS_KTRT) : VT;
    const float scl = (seg == 7) ? 0.125f : 1.f;
#pragma unroll
    for (int mi = 0; mi < 4; ++mi)
#pragma unroll
      for (int ni = 0; ni < 4; ++ni) {
        int r0 = rbase + mi * 16 + fq * 4;
        int c = cseg0 + ni * 16 + fr;
        size_t idx;
        if (r0 < NCTX) {
          int b = r0 >> 8, t = r0 & 255;
          idx = ((size_t)(b * 512 + c)) * 256 + t;
        } else {
          int rr = r0 - NCTX, b = rr >> 11, t = rr & 2047;
          idx = (size_t)VT_LAT + ((size_t)(b * 512 + c)) * 2048 + t;
        }
        *(bf16x4*)(T_ + idx) = pack4(acc[mi][ni][0] * scl, acc[mi][ni][1] * scl, acc[mi][ni][2] * scl, acc[mi][ni][3] * scl);
      }
  }
  if (seg == 11) {
    bf16_t* LG = (bf16_t*)(p.ws + WS_LG);
#pragma unroll
    for (int mi = 0; mi < 4; ++mi)
#pragma unroll
      for (int ni = 0; ni < 4; ++ni) {
        int r0 = rbase + mi * 16 + fq * 4;
        int c = cseg0 + ni * 16 + fr;
        size_t idx = ((size_t)(r0 >> 6) * 512 + c) * 64 + (r0 & 63);
        *(bf16x4*)(LG + idx) = pack4(gelu_tanh(acc[mi][ni][0]), gelu_tanh(acc[mi][ni][1]), gelu_tanh(acc[mi][ni][2]), gelu_tanh(acc[mi][ni][3]));
      }
  }
  if (ctx && (seg == 1 || seg == 2 || seg == 4 || seg == 5)) {
    float* out = p.out;
#pragma unroll
    for (int mi = 0; mi < 4; ++mi)
#pragma unroll
      for (int ni = 0; ni < 4; ++ni)
#pragma unroll
        for (int i = 0; i < 4; ++i) {
          int r = rbase + mi * 16 + fq * 4 + i;
          int c = cseg0 + ni * 16 + fr;
          int b = r >> 8, t = r & 255;
          size_t off;
          if (seg == 1 || seg == 2) {
            int h = c >> 6, d = c & 63;
            off = (seg == 1 ? O_NAK : O_NAV) + ((((size_t)(b * 4 + l) * 8 + h) * 256 + t) * 64 + d);
          } else if (seg == 4) {
            int comp = c >> 8, h = (c >> 6) & 3, d = c & 63;
            off = O_DFK + (((((size_t)(b * 4 + l) * 2 + comp) * 4 + h) * 256 + t) * 64 + d);
          } else {
            int h = c >> 7, d = c & 127;
            off = O_DFV + ((((size_t)(b * 4 + l) * 4 + h) * 256 + t) * 128 + d);
          }
          out[off] = acc[mi][ni][i];
        }
  }
}

DI void phase_gin(const P& p, int l, char* smem) {
  bf16_t* sA = (bf16_t*)smem;
  bf16_t* sB = sA + 128 * LDT;
  const bf16_t* A = (const bf16_t*)(p.ws + WS_H);
  const bf16_t* Bt = (const bf16_t*)(p.ws + WS_WIN);
  const int ntn = 80, total = 128 * ntn;
  for (int id = blockIdx.x; id < total; id += gridDim.x) {
    int tm, tn;
    tile_of(id, ntn, tm, tn);
    f32x4 acc[4][4];
    zero_acc(acc);
    gemm_mainloop(A, 1024, Bt, 1024, 1024, tm * 128, tn * 128, sA, sB, acc);
    epi_in(p, l, tm * 128, tn * 128, acc);
  }
}

DI void phase_merge(const P& p, char* smem) {
  bf16_t* sA = (bf16_t*)smem;
  bf16_t* sB = sA + 128 * LDT;
  const bf16_t* Y4 = (const bf16_t*)(p.ws + WS_Y4);
  const bf16_t* WB = (const bf16_t*)(p.ws + WS_WBR);
  bf16_t* Z = (bf16_t*)(p.ws + WS_Z);
  bf16_t* G = (bf16_t*)(p.ws + WS_H);
  const int tid_ = otid(), lane = tid_ & 63, wid = tid_ >> 6, wm = wid >> 1, wn = wid & 1, fr = lane & 15, fq = lane >> 4;
  const int ntn = 8, total = 128 * ntn;
  for (int id = blockIdx.x; id < total; id += gridDim.x) {
    int tm, tn;
    tile_of(id, ntn, tm, tn);
    const int row0 = tm * 128, col0 = tn * 128;
#pragma unroll 1
    for (int k = 0; k < 4; ++k) {
      f32x4 acc[4][4];
      zero_acc(acc);
      gemm_mainloop(Y4 + k * 512, 2048, WB + k * 512, 2048, 512, row0, col0, sA, sB, acc);
      int rb_ = row0 + wm * 64 + fq * 4, cb_ = col0 + wn * 64 + fr;
      asm volatile("" : "+v"(rb_), "+v"(cb_));
#pragma unroll
      for (int mi = 0; mi < 4; ++mi)
#pragma unroll
        for (int ni = 0; ni < 4; ++ni)
#pragma unroll
          for (int i = 0; i < 4; ++i) {
            int r = rb_ + mi * 16 + i;
            int c = cb_ + ni * 16;
            float g = bf2f(Z[(size_t)r * ZLD + ZC_GATE + k * 1024 + c]);
            float* g32 = (float*)(Z + (size_t)r * ZLD) + c;
            float o = g * acc[mi][ni][i];
            if (k > 0) o += *g32;
            if (k < 3) *g32 = o;
            else G[(size_t)r * 1024 + c] = f2bf(o);
            if (i == 3) asm volatile("" ::: "memory");
          }
    }
  }
}

template <int MODE>
DI void phase_gemm_plain(const bf16_t* A, int K, const bf16_t* Bt, int N, void* outp, char* smem) {
  bf16_t* sA = (bf16_t*)smem;
  bf16_t* sB = sA + 128 * LDT;
  const int tid_ = otid(), lane = tid_ & 63, wid = tid_ >> 6, wm = wid >> 1, wn = wid & 1, fr = lane & 15, fq = lane >> 4;
  const int ntn = N / 128, total = 128 * ntn;
  for (int id = blockIdx.x; id < total; id += gridDim.x) {
    int tm, tn;
    tile_of(id, ntn, tm, tn);
    const int row0 = tm * 128, col0 = tn * 128;
    f32x4 acc[4][4];
    zero_acc(acc);
    gemm_mainloop(A, K, Bt, K, K, row0, col0, sA, sB, acc);
#pragma unroll
    for (int mi = 0; mi < 4; ++mi)
#pragma unroll
      for (int ni = 0; ni < 4; ++ni)
#pragma unroll
        for (int i = 0; i < 4; ++i) {
          int r = row0 + wm * 64 + mi * 16 + fq * 4 + i;
          int c = col0 + wn * 64 + ni * 16 + fr;
          float v = acc[mi][ni][i];
          if (MODE == 0) {
            ((float*)outp)[(size_t)r * N + c] = v;
          } else {
            v = fmaxf(v, 0.f);
            ((bf16_t*)outp)[(size_t)r * N + c] = f2bf(v * v);
          }
        }
  }
}

DI void phase_mod(const P& p, char* smem) {
  float* ssil = (float*)smem;
  float* red = ssil + 5 * 1024;
  const int tid = otid();
  float* MOD = (float*)(p.ws + WS_MOD);
  for (int idx = tid; idx < 5120; idx += 256) {
    int j = idx >> 10, k = idx & 1023;
    float cv = (j == 0) ? p.in[11][k] : p.in[10][(j - 1) * 1024 + k];
    ssil[idx] = cv / (1.f + expf(-cv));
  }
  __syncthreads();
  const int cl = tid & 63, kg = tid >> 6;
  for (int item = blockIdx.x; item < 384; item += gridDim.x) {
    int l = item / 96, cgp = item % 96;
    int col = cgp * 64 + cl;
    const float* W = p.in[12] + (size_t)l * 1024 * 6144 + col;
    float a0 = 0, a1 = 0, a2 = 0, a3 = 0, a4 = 0;
    for (int k = kg * 256; k < kg * 256 + 256; ++k) {
      float w = W[(size_t)k * 6144];
      a0 += ssil[k] * w;
      a1 += ssil[1024 + k] * w;
      a2 += ssil[2048 + k] * w;
      a3 += ssil[3072 + k] * w;
      a4 += ssil[4096 + k] * w;
    }
    red[(kg * 5 + 0) * 64 + cl] = a0;
    red[(kg * 5 + 1) * 64 + cl] = a1;
    red[(kg * 5 + 2) * 64 + cl] = a2;
    red[(kg * 5 + 3) * 64 + cl] = a3;
    red[(kg * 5 + 4) * 64 + cl] = a4;
    __syncthreads();
    if (kg == 0) {
      float bias = p.in[13][l * 6144 + col];
#pragma unroll
      for (int j = 0; j < 5; ++j) {
        float s = red[(0 * 5 + j) * 64 + cl] + red[(1 * 5 + j) * 64 + cl] + red[(2 * 5 + j) * 64 + cl] + red[(3 * 5 + j) * 64 + cl];
        MOD[(size_t)(l * 5 + j) * 6144 + col] = s + bias;
      }
    }
    __syncthreads();
  }
}

DI void transpose_tile(const float* __restrict__ src, int lds_, bf16_t* __restrict__ dst, int ldd, float* tile) {
  const int tid = otid();
#pragma unroll 4
  for (int i = 0; i < 16; ++i) {
    int idx = tid + i * 256, r = idx >> 6, c = idx & 63;
    tile[r * 65 + c] = src[(size_t)r * lds_ + c];
  }
  __syncthreads();
#pragma unroll 4
  for (int i = 0; i < 16; ++i) {
    int idx = tid + i * 256, c = idx >> 6, r = idx & 63;
    dst[(size_t)c * ldd + r] = f2bf(tile[r * 65 + c]);
  }
  __syncthreads();
}

DI void phase_convert(const P& p, int l, char* smem) {
  float* tile = (float*)smem;
  char* ws = p.ws;
  const int NJ = 6432;
  for (int j = blockIdx.x; j < NJ; j += gridDim.x) {
    int q = j;
    if (q < 2560) {
      int tr = q / 160, tc = q % 160;
      transpose_tile(p.in[18] + (size_t)l * 1024 * 10240 + (size_t)tr * 64 * 10240 + tc * 64, 10240,
                     (bf16_t*)(ws + WS_WIN) + (size_t)tc * 64 * 1024 + tr * 64, 1024, tile);
      continue;
    }
    q -= 2560;
    if (q < 512) {
      int tr = q / 16, tc = q % 16;
      transpose_tile(p.in[40] + (size_t)l * 2048 * 1024 + (size_t)tr * 64 * 1024 + tc * 64, 1024,
                     (bf16_t*)(ws + WS_WBR) + (size_t)tc * 64 * 2048 + tr * 64, 2048, tile);
      continue;
    }
    q -= 512;
    if (q < 256) {
      int tr = q / 16, tc = q % 16;
      transpose_tile(p.in[41] + (size_t)l * 1024 * 1024 + (size_t)tr * 64 * 1024 + tc * 64, 1024,
                     (bf16_t*)(ws + WS_WOUT) + (size_t)tc * 64 * 1024 + tr * 64, 1024, tile);
      continue;
    }
    q -= 256;
    if (q < 1024) {
      int tr = q / 64, tc = q % 64;
      transpose_tile(p.in[42] + (size_t)l * 1024 * 4096 + (size_t)tr * 64 * 4096 + tc * 64, 4096,
                     (bf16_t*)(ws + WS_W1) + (size_t)tc * 64 * 1024 + tr * 64, 1024, tile);
      continue;
    }
    q -= 1024;
    if (q < 1024) {
      int tr = q / 16, tc = q % 16;
      transpose_tile(p.in[43] + (size_t)l * 4096 * 1024 + (size_t)tr * 64 * 1024 + tc * 64, 1024,
                     (bf16_t*)(ws + WS_W2) + (size_t)tc * 64 * 4096 + tr * 64, 4096, tile);
      continue;
    }
    q -= 1024;
    if (q < 32) {
      int type = q >> 3, n = q & 7;
      const float* src = (type == 0 ? p.in[30] : type == 1 ? p.in[32] : type == 2 ? p.in[35] : p.in[37]) + (size_t)(l * 8 + n) * 4096;
      transpose_tile(src, 64, (bf16_t*)(ws + WS_WLRU) + (size_t)(type * 8 + n) * 4096, 64, tile);
      continue;
    }
    q -= 32;
    if (q < 256) {
      int bh = q >> 3, tr = q & 7, b = bh >> 3, h = bh & 7;
      transpose_tile(p.in[3] + ((size_t)((b * 4 + l) * 8 + h)) * 32768 + (size_t)tr * 64 * 64, 64,
                     (bf16_t*)(ws + WS_CVNA) + (size_t)bh * 32768 + tr * 64, 512, tile);
      continue;
    }
    q -= 256;
    if (q < 256) {
      int bh = q >> 4, t2 = q & 15, tr = t2 >> 1, tc = t2 & 1, b = bh >> 2, h = bh & 3;
      transpose_tile(p.in[5] + ((size_t)((b * 4 + l) * 4 + h)) * 65536 + (size_t)tr * 64 * 128 + tc * 64, 128,
                     (bf16_t*)(ws + WS_CVDF) + (size_t)bh * 65536 + (size_t)tc * 64 * 512 + tr * 64, 512, tile);
      continue;
    }
    q -= 256;
    {
      int tensor = q >> 8, b = (q >> 6) & 3, chunk = q & 63;
      const float* src = (tensor == 0 ? p.in[2] : p.in[4]) + (size_t)(b * 4 + l) * 262144 + (size_t)chunk * 4096;
      bf16_t* dst = (bf16_t*)(ws + (tensor == 0 ? WS_CKNA : WS_CKDF)) + (size_t)b * 262144 + (size_t)chunk * 4096;
#pragma unroll
      for (int i = 0; i < 4; ++i) {
        int e = (otid() + i * 256) * 4;
        float4 v = *(const float4*)(src + e);
        *(bf16x4*)(dst + e) = pack4(v.x, v.y, v.z, v.w);
      }
    }
  }
}

DI void phase_row(const P& p, int l, int mode) {
  const int tid_ = otid(), lane = tid_ & 63, wid = tid_ >> 6;
  const float* MOD = (const float*)(p.ws + WS_MOD);
  float* X = p.out;
  bf16_t* H = (bf16_t*)(p.ws + WS_H);
  const float* Y = (const float*)(p.ws + WS_Y);
  for (int rb = blockIdx.x; rb < 4096; rb += gridDim.x) {
    const int r = rb * 4 + wid;
    const int mi = r < NCTX ? 0 : 1 + ((r - NCTX) >> 11);
    const float* xs;
    if (mode == 0 || (mode == 1 && l == 0))
      xs = (r < NCTX) ? (p.in[0] + (size_t)r * D) : (p.in[1] + (size_t)(r - NCTX) * D);
    else
      xs = X + (size_t)r * D;
    float4 xv[4];
#pragma unroll
    for (int j = 0; j < 4; ++j) xv[j] = *(const float4*)(xs + j * 256 + lane * 4);
    if (mode != 0) {
      float4 yv[4];
      float ss = 0.f;
#pragma unroll
      for (int j = 0; j < 4; ++j) {
        yv[j] = *(const float4*)(Y + (size_t)r * D + j * 256 + lane * 4);
        ss += yv[j].x * yv[j].x + yv[j].y * yv[j].y + yv[j].z * yv[j].z + yv[j].w * yv[j].w;
      }
      ss = wave_sum(ss);
      const float rs = rsqrtf(ss * (1.f / 1024.f) + 1e-6f);
      const float* gpost = (mode == 1 ? p.in[15] : p.in[17]) + l * D;
      const float* gate = MOD + (size_t)(l * 5 + mi) * 6144 + (mode == 1 ? 2048 : 5120);
#pragma unroll
      for (int j = 0; j < 4; ++j) {
        float4 g = *(const float4*)(gpost + j * 256 + lane * 4);
        float4 gt = *(const float4*)(gate + j * 256 + lane * 4);
        xv[j].x += gt.x * (yv[j].x * rs * g.x);
        xv[j].y += gt.y * (yv[j].y * rs * g.y);
        xv[j].z += gt.z * (yv[j].z * rs * g.z);
        xv[j].w += gt.w * (yv[j].w * rs * g.w);
        *(float4*)(X + (size_t)r * D + j * 256 + lane * 4) = xv[j];
      }
    }
    int ln, off_sh, off_sc;
    const float* gpre;
    if (mode == 0) { ln = 0; gpre = p.in[14]; off_sh = 0; off_sc = 1024; }
    else if (mode == 1) { ln = l; gpre = p.in[16] + l * D; off_sh = 3072; off_sc = 4096; }
    else { ln = l + 1; gpre = p.in[14] + (l + 1) * D; off_sh = 0; off_sc = 1024; }
    if (ln < 4) {
      float ss = 0.f;
#pragma unroll
      for (int j = 0; j < 4; ++j) ss += xv[j].x * xv[j].x + xv[j].y * xv[j].y + xv[j].z * xv[j].z + xv[j].w * xv[j].w;
      ss = wave_sum(ss);
      const float rs = rsqrtf(ss * (1.f / 1024.f) + 1e-6f);
      const float* mrow = MOD + (size_t)(ln * 5 + mi) * 6144;
#pragma unroll
      for (int j = 0; j < 4; ++j) {
        int c = j * 256 + lane * 4;
        float4 g = *(const float4*)(gpre + c);
        float4 sc = *(const float4*)(mrow + off_sc + c);
        float4 sh = *(const float4*)(mrow + off_sh + c);
        *(bf16x4*)(H + (size_t)r * D + c) = pack4(xv[j].x * rs * g.x * (1.f + sc.x) + sh.x, xv[j].y * rs * g.y * (1.f + sc.y) + sh.y,
                                                  xv[j].z * rs * g.z * (1.f + sc.z) + sh.z, xv[j].w * rs * g.w * (1.f + sc.w) + sh.w);
      }
    }
  }
}

constexpr int ATT_BUF = 192 * LDT;
DI void qk_scores(const bf16x8 (&qf)[2], const bf16_t* sK, f32x4 (&S)[4], int fr, int fq) {
#pragma unroll
  for (int s = 0; s < 4; ++s) {
    f32x4 z = {0.f, 0.f, 0.f, 0.f};
#pragma unroll
    for (int ks = 0; ks < 2; ++ks) {
      bf16x8 a = *(const bf16x8*)(sK + (16 * s + fr) * LDT + ks * 32 + fq * 8);
      z = MFMA16(a, qf[ks], z);
    }
    S[s] = z;
  }
}
template <int DV>
DI void pv_step(const bf16x8 (&pb)[2], const bf16_t* sV, f32x4 (&O)[DV / 16], int fr, int fq) {
#pragma unroll
  for (int dt = 0; dt < DV / 16; ++dt) {
#pragma unroll
    for (int s2 = 0; s2 < 2; ++s2) {
      const bf16_t* base = sV + (dt * 16 + fr) * LDT + 32 * s2 + 4 * fq;
      bf16x4 lo = *(const bf16x4*)base;
      bf16x4 hi = *(const bf16x4*)(base + 16);
      bf16x8 a = __builtin_shufflevector(lo, hi, 0, 1, 2, 3, 4, 5, 6, 7);
      O[dt] = MFMA16(a, pb[s2], O[dt]);
    }
  }
}
template <int DV>
DI void softmax_pv(f32x4 (&S)[4], const bf16_t* sV, f32x4 (&O)[DV / 16], float& m, float& lsum, int fr, int fq) {
  float tm = -1e30f;
#pragma unroll
  for (int s = 0; s < 4; ++s)
#pragma unroll
    for (int i = 0; i < 4; ++i) tm = fmaxf(tm, S[s][i]);
  tm = fmaxf(tm, __shfl_xor(tm, 16));
  tm = fmaxf(tm, __shfl_xor(tm, 32));
  const float mn = fmaxf(m, tm);
  const float alpha = __expf(m - mn);
  m = mn;
  float ps = 0.f;
#pragma unroll
  for (int s = 0; s < 4; ++s)
#pragma unroll
    for (int i = 0; i < 4; ++i) {
      float pv = __expf(S[s][i] - mn);
      S[s][i] = pv;
      ps += pv;
    }
  lsum = lsum * alpha + ps;
#pragma unroll
  for (int dt = 0; dt < DV / 16; ++dt) {
    O[dt][0] *= alpha; O[dt][1] *= alpha; O[dt][2] *= alpha; O[dt][3] *= alpha;
  }
  bf16x8 pb[2];
  pb[0] = pack8(S[0], S[1]);
  pb[1] = pack8(S[2], S[3]);
  pv_step<DV>(pb, sV, O, fr, fq);
}
template <int DV, bool SOFTMAX, class TileFn, class ScoreFn>
DI void attn_loop(int ntiles, TileFn&& tile, ScoreFn&& score, const bf16x8 (&qf)[2], f32x4 (&O)[DV / 16], float& m, float& lsum,
                  bf16_t* smem, int tid) {
  const int lane = tid & 63, fr = lane & 15, fq = lane >> 4;
  u32x4 rk[2], rv[DV / 32];
  auto gload = [&](int j) {
    const bf16_t* Kg; const bf16_t* Vg; int ldk, ldv;
    tile(j, Kg, ldk, Vg, ldv);
#pragma unroll
    for (int i = 0; i < 2; ++i) {
      int id = tid + i * 256, r = id >> 3, c = (id & 7) * 8;
      rk[i] = *(const u32x4*)(Kg + (size_t)r * ldk + c);
    }
#pragma unroll
    for (int i = 0; i < DV / 32; ++i) {
      int id = tid + i * 256, r = id >> 3, c = (id & 7) * 8;
      rv[i] = *(const u32x4*)(Vg + (size_t)r * ldv + c);
    }
  };
  auto sstore = [&](int buf) {
    bf16_t* sK = smem + buf * ATT_BUF;
    bf16_t* sV = sK + 64 * LDT;
#pragma unroll
    for (int i = 0; i < 2; ++i) {
      int id = tid + i * 256, r = id >> 3, c = (id & 7) * 8;
      *(u32x4*)(sK + r * LDT + c) = rk[i];
    }
#pragma unroll
    for (int i = 0; i < DV / 32; ++i) {
      int id = tid + i * 256, r = id >> 3, c = (id & 7) * 8;
      *(u32x4*)(sV + r * LDT + c) = rv[i];
    }
  };
  gload(0);
  sstore(0);
  __syncthreads();
  for (int j = 0; j < ntiles; ++j) {
    const int jn = (j + 1 < ntiles) ? j + 1 : j;
    gload(jn);
    const bf16_t* sK = smem + (j & 1) * ATT_BUF;
    const bf16_t* sV = sK + 64 * LDT;
    f32x4 S[4];
    qk_scores(qf, sK, S, fr, fq);
    score(j, S);
    if (SOFTMAX) {
      softmax_pv<DV>(S, sV, O, m, lsum, fr, fq);
    } else {
      bf16x8 pb[2];
      pb[0] = pack8(S[0], S[1]);
      pb[1] = pack8(S[2], S[3]);
      pv_step<DV>(pb, sV, O, fr, fq);
    }
    sstore((j + 1) & 1);
    __syncthreads();
  }
}
DI void scale_scores(f32x4 (&S)[4]) {
#pragma unroll
  for (int s = 0; s < 4; ++s) { S[s][0] *= 0.125f; S[s][1] *= 0.125f; S[s][2] *= 0.125f; S[s][3] *= 0.125f; }
}

DI void dense_item(const P& p, int b, int h, int qb, char* smem) {
  const int tid = otid(), lane = tid & 63, wid = tid >> 6, fr = lane & 15, fq = lane >> 4;
  const bf16_t* Z = (const bf16_t*)(p.ws + WS_Z);
  const bf16_t* VT = (const bf16_t*)(p.ws + WS_VTNA) + (size_t)(b * 512 + h * 64) * 256;
  bf16_t* Y4 = (bf16_t*)(p.ws + WS_Y4);
  const int rowbase = b * 256;
  const int qrow = rowbase + qb * 64 + wid * 16 + fr;
  bf16x8 qf[2];
#pragma unroll
  for (int ks = 0; ks < 2; ++ks) qf[ks] = *(const bf16x8*)(Z + (size_t)qrow * ZLD + ZC_NAQ + h * 64 + ks * 32 + fq * 8);
  f32x4 O[4];
#pragma unroll
  for (int dt = 0; dt < 4; ++dt) O[dt] = f32x4{0.f, 0.f, 0.f, 0.f};
  float m = -1e30f, lsum = 0.f;
  const bf16_t* Kb = Z + (size_t)rowbase * ZLD + ZC_NAK + h * 64;
  attn_loop<64, true>(4,
      [&](int j, const bf16_t*& Kg, int& ldk, const bf16_t*& Vg, int& ldv) { Kg = Kb + (size_t)j * 64 * ZLD; ldk = ZLD; Vg = VT + j * 64; ldv = 256; },
      [&](int, f32x4 (&S)[4]) { scale_scores(S); }, qf, O, m, lsum, (bf16_t*)smem, tid);
  float lt = lsum + __shfl_xor(lsum, 16);
  lt += __shfl_xor(lt, 32);
  const float inv = 1.f / lt;
#pragma unroll
  for (int dt = 0; dt < 4; ++dt)
    *(bf16x4*)(Y4 + (size_t)qrow * 2048 + h * 64 + dt * 16 + fq * 4) = pack4(O[dt][0] * inv, O[dt][1] * inv, O[dt][2] * inv, O[dt][3] * inv);
}

DI void na_item(const P& p, int l, int b, int h, int r, char* smem) {
  float* srpb = (float*)((bf16_t*)smem + 2 * ATT_BUF);
  const int tid = otid(), lane = tid & 63, wid = tid >> 6, fr = lane & 15, fq = lane >> 4;
  const bf16_t* Z = (const bf16_t*)(p.ws + WS_Z);
  const bf16_t* VT = (const bf16_t*)(p.ws + WS_VTNA) + VT_LAT + (size_t)(b * 512 + h * 64) * 2048;
  const bf16_t* CK = (const bf16_t*)(p.ws + WS_CKNA) + (size_t)(b * 8 + h) * 32768;
  const bf16_t* CVT = (const bf16_t*)(p.ws + WS_CVNA) + (size_t)(b * 8 + h) * 32768;
  bf16_t* Y4 = (bf16_t*)(p.ws + WS_Y4);
  for (int i = tid; i < 465; i += 256) srpb[i] = p.in[19][(size_t)(l * 8 + h) * 465 + i];
  const int rowbase = NCTX + b * 2048;
  const int qcol = wid * 16 + fr;
  const int qrow = rowbase + r * 64 + qcol;
  bf16x8 qf[2];
#pragma unroll
  for (int ks = 0; ks < 2; ++ks) qf[ks] = *(const bf16x8*)(Z + (size_t)qrow * ZLD + ZC_NAQ + h * 64 + ks * 32 + fq * 8);
  f32x4 O[4];
#pragma unroll
  for (int dt = 0; dt < 4; ++dt) O[dt] = f32x4{0.f, 0.f, 0.f, 0.f};
  float m = -1e30f, lsum = 0.f;
  int rs = r - 4;
  rs = rs < 0 ? 0 : (rs > 24 ? 24 : rs);
  int cstart = qcol - 8;
  cstart = cstart < 0 ? 0 : (cstart > 48 ? 48 : cstart);
  const bf16_t* Kb = Z + (size_t)rowbase * ZLD + ZC_NAK + h * 64;
  attn_loop<64, true>(16,
      [&](int j, const bf16_t*& Kg, int& ldk, const bf16_t*& Vg, int& ldv) {
        if (j < 8) { Kg = Kb + (size_t)(rs + j) * 64 * ZLD; ldk = ZLD; Vg = VT + (rs + j) * 64; ldv = 2048; }
        else { Kg = CK + (size_t)(j - 8) * 64 * 64; ldk = 64; Vg = CVT + (j - 8) * 64; ldv = 512; }
      },
      [&](int j, f32x4 (&S)[4]) {
        if (j < 8) {
          const int dr = rs + j - r + 7;
#pragma unroll
          for (int s = 0; s < 4; ++s)
#pragma unroll
            for (int i = 0; i < 4; ++i) {
              int kcol = s * 16 + fq * 4 + i;
              bool ok = (kcol >= cstart) && (kcol < cstart + 16);
              int dc = kcol - qcol + 15;
              dc = dc < 0 ? 0 : (dc > 30 ? 30 : dc);
              float bias = srpb[dr * 31 + dc];
              S[s][i] = ok ? (S[s][i] * 0.125f + bias) : -1e30f;
            }
        } else {
          scale_scores(S);
        }
      },
      qf, O, m, lsum, (bf16_t*)smem, tid);
  float lt = lsum + __shfl_xor(lsum, 16);
  lt += __shfl_xor(lt, 32);
  const float inv = 1.f / lt;
#pragma unroll
  for (int dt = 0; dt < 4; ++dt)
    *(bf16x4*)(Y4 + (size_t)qrow * 2048 + h * 64 + dt * 16 + fq * 4) = pack4(O[dt][0] * inv, O[dt][1] * inv, O[dt][2] * inv, O[dt][3] * inv);
}

DI void diff_item(const P& p, int l, bool latent, int b, int h, int qb, char* smem) {
  const int tid = otid(), lane = tid & 63, wid = tid >> 6, fr = lane & 15, fq = lane >> 4;
  const bf16_t* Z = (const bf16_t*)(p.ws + WS_Z);
  const int T = latent ? 2048 : 256;
  const int rowbase = latent ? NCTX + b * 2048 : b * 256;
  const bf16_t* VT = (const bf16_t*)(p.ws + WS_VTDF) + (latent ? (size_t)VT_LAT + (size_t)(b * 512 + h * 128) * 2048 : (size_t)(b * 512 + h * 128) * 256);
  const bf16_t* CVT = (const bf16_t*)(p.ws + WS_CVDF) + (size_t)(b * 4 + h) * 65536;
  bf16_t* Y4 = (bf16_t*)(p.ws + WS_Y4);
  const int qrow = rowbase + qb * 64 + wid * 16 + fr;
  float d1 = p.in[20][l * 64 + lane] * p.in[21][l * 64 + lane];
  float d2 = p.in[22][l * 64 + lane] * p.in[23][l * 64 + lane];
  d1 = wave_sum(d1);
  d2 = wave_sum(d2);
  const float lam_init = 0.8f - 0.6f * expf(-0.3f * (float)l);
  const float lam = expf(d1) - expf(d2) + lam_init;
  const int nown = T >> 6;
  const int ntiles = nown + (latent ? 8 : 0);

  f32x4 O1[8];
  f32x4 O[8];
#pragma unroll 1
  for (int comp = 0; comp < 2; ++comp) {
    bf16x8 qf[2];
#pragma unroll
    for (int ks = 0; ks < 2; ++ks) qf[ks] = *(const bf16x8*)(Z + (size_t)qrow * ZLD + ZC_DFQ + comp * 256 + h * 64 + ks * 32 + fq * 8);
#pragma unroll
    for (int dt = 0; dt < 8; ++dt) O[dt] = f32x4{0.f, 0.f, 0.f, 0.f};
    float m = -1e30f, lsum = 0.f;
    const bf16_t* Kb = Z + (size_t)rowbase * ZLD + ZC_DFK + comp * 256 + h * 64;
    const bf16_t* CK = (const bf16_t*)(p.ws + WS_CKDF) + (size_t)((b * 2 + comp) * 4 + h) * 32768;
    attn_loop<128, true>(ntiles,
        [&](int j, const bf16_t*& Kg, int& ldk, const bf16_t*& Vg, int& ldv) {
          if (j < nown) { Kg = Kb + (size_t)j * 64 * ZLD; ldk = ZLD; Vg = VT + j * 64; ldv = T; }
          else { Kg = CK + (size_t)(j - nown) * 64 * 64; ldk = 64; Vg = CVT + (j - nown) * 64; ldv = 512; }
        },
        [&](int, f32x4 (&S)[4]) { scale_scores(S); }, qf, O, m, lsum, (bf16_t*)smem, tid);
    float lt = lsum + __shfl_xor(lsum, 16);
    lt += __shfl_xor(lt, 32);
    const float inv = 1.f / lt;
    if (comp == 0) {
#pragma unroll
      for (int dt = 0; dt < 8; ++dt) { O1[dt][0] = O[dt][0] * inv; O1[dt][1] = O[dt][1] * inv; O1[dt][2] = O[dt][2] * inv; O1[dt][3] = O[dt][3] * inv; }
    } else {
#pragma unroll
      for (int dt = 0; dt < 8; ++dt) {
        O[dt][0] = O1[dt][0] - lam * (O[dt][0] * inv);
        O[dt][1] = O1[dt][1] - lam * (O[dt][1] * inv);
        O[dt][2] = O1[dt][2] - lam * (O[dt][2] * inv);
        O[dt][3] = O1[dt][3] - lam * (O[dt][3] * inv);
      }
    }
  }
  float ss = 0.f;
#pragma unroll
  for (int dt = 0; dt < 8; ++dt) ss += O[dt][0] * O[dt][0] + O[dt][1] * O[dt][1] + O[dt][2] * O[dt][2] + O[dt][3] * O[dt][3];
  ss += __shfl_xor(ss, 16);
  ss += __shfl_xor(ss, 32);
  const float rsn = rsqrtf(ss * (1.f / 128.f) + 1e-6f) * (1.f - lam_init);
  const float* gn = p.in[24] + l * 128;
#pragma unroll
  for (int dt = 0; dt < 8; ++dt) {
    int dv = dt * 16 + fq * 4;
    float4 g = *(const float4*)(gn + dv);
    *(bf16x4*)(Y4 + (size_t)qrow * 2048 + 512 + h * 128 + dv) = pack4(O[dt][0] * rsn * g.x, O[dt][1] * rsn * g.y, O[dt][2] * rsn * g.z, O[dt][3] * rsn * g.w);
  }
}

DI void ret_item(const P& p, int l, bool latent, int b, int h, int qb, char* smem) {
  bf16_t* sV0 = (bf16_t*)smem + 64 * LDT;
  const int tid = otid(), lane = tid & 63, wid = tid >> 6, fr = lane & 15, fq = lane >> 4;
  const bf16_t* Z = (const bf16_t*)(p.ws + WS_Z);
  const int T = latent ? 2048 : 256;
  const int rowbase = latent ? NCTX + b * 2048 : b * 256;
  const bf16_t* VT = (const bf16_t*)(p.ws + WS_VTRT) + (latent ? (size_t)VT_LAT + (size_t)(b * 512 + h * 64) * 2048 : (size_t)(b * 512 + h * 64) * 256);
  bf16_t* Y4 = (bf16_t*)(p.ws + WS_Y4);
  const int tq = qb * 64 + wid * 16 + fr;
  const int qrow = rowbase + tq;
  const float lgf = log1pf(-expf(p.in[25][l * 8 + h]));
  const float lgb = log1pf(-expf(p.in[26][l * 8 + h]));
  bf16x8 qf[2];
#pragma unroll
  for (int ks = 0; ks < 2; ++ks) qf[ks] = *(const bf16x8*)(Z + (size_t)qrow * ZLD + ZC_RTQ + h * 64 + ks * 32 + fq * 8);
  f32x4 O[4];
#pragma unroll
  for (int dt = 0; dt < 4; ++dt) O[dt] = f32x4{0.f, 0.f, 0.f, 0.f};
  float mdummy = 0.f, ldummy = 0.f;
  const bf16_t* Kb = Z + (size_t)rowbase * ZLD + ZC_RTK + h * 64;
  attn_loop<64, false>(T >> 6,
      [&](int j, const bf16_t*& Kg, int& ldk, const bf16_t*& Vg, int& ldv) { Kg = Kb + (size_t)j * 64 * ZLD; ldk = ZLD; Vg = VT + j * 64; ldv = T; },
      [&](int j, f32x4 (&S)[4]) {
#pragma unroll
        for (int s = 0; s < 4; ++s)
#pragma unroll
          for (int i = 0; i < 4; ++i) {
            int tk = j * 64 + s * 16 + fq * 4 + i;
            int dd = tq - tk;
            float w = dd >= 0 ? __expf(lgf * (float)dd) : __expf(lgb * (float)(-dd));
            S[s][i] *= w;
          }
      },
      qf, O, mdummy, ldummy, (bf16_t*)smem, tid);
  if (latent) {
    for (int dir = 0; dir < 2; ++dir) {
      const float* S0 = (dir == 0 ? p.in[6] : p.in[7]) + ((size_t)((b * 4 + l) * 8 + h)) * 4096;
#pragma unroll
      for (int i = 0; i < 4; ++i) {
        int e = (tid + i * 256) * 4;
        float4 v = *(const float4*)(S0 + e);
        int dk = e >> 6, dv = e & 63;
        sV0[(dv + 0) * LDT + dk] = f2bf(v.x);
        sV0[(dv + 1) * LDT + dk] = f2bf(v.y);
        sV0[(dv + 2) * LDT + dk] = f2bf(v.z);
        sV0[(dv + 3) * LDT + dk] = f2bf(v.w);
      }
      __syncthreads();
      const float sc = dir == 0 ? __expf(lgf * (float)(tq + 1)) : __expf(lgb * (float)(T - tq));
      bf16x8 pb[2];
#pragma unroll
      for (int s2 = 0; s2 < 2; ++s2) {
        const bf16_t* qp = Z + (size_t)qrow * ZLD + ZC_RTQ + h * 64 + 32 * s2 + 4 * fq;
        bf16x4 lo = *(const bf16x4*)qp;
        bf16x4 hi = *(const bf16x4*)(qp + 16);
        f32x4 flo = {bfs2f(lo[0]) * sc, bfs2f(lo[1]) * sc, bfs2f(lo[2]) * sc, bfs2f(lo[3]) * sc};
        f32x4 fhi = {bfs2f(hi[0]) * sc, bfs2f(hi[1]) * sc, bfs2f(hi[2]) * sc, bfs2f(hi[3]) * sc};
        pb[s2] = pack8(flo, fhi);
      }
      pv_step<64>(pb, sV0, O, fr, fq);
      __syncthreads();
    }
  }
  float ss = 0.f;
#pragma unroll
  for (int dt = 0; dt < 4; ++dt) ss += O[dt][0] * O[dt][0] + O[dt][1] * O[dt][1] + O[dt][2] * O[dt][2] + O[dt][3] * O[dt][3];
  ss += __shfl_xor(ss, 16);
  ss += __shfl_xor(ss, 32);
  const float rsn = rsqrtf(ss * (1.f / 64.f) + 1e-6f);
  const float* gn = p.in[27] + l * 512 + h * 64;
#pragma unroll
  for (int dt = 0; dt < 4; ++dt) {
    int dv = dt * 16 + fq * 4;
    float4 g = *(const float4*)(gn + dv);
    bf16x4 sg = *(const bf16x4*)(Z + (size_t)qrow * ZLD + ZC_RTG + h * 64 + dv);
    *(bf16x4*)(Y4 + (size_t)qrow * 2048 + 1024 + h * 64 + dv) =
        pack4(O[dt][0] * rsn * g.x * bfs2f(sg[0]), O[dt][1] * rsn * g.y * bfs2f(sg[1]), O[dt][2] * rsn * g.z * bfs2f(sg[2]), O[dt][3] * rsn * g.w * bfs2f(sg[3]));
  }
}

DI void ret_state_item(const P& p, int l, int b, int h) {
  const int tid_ = otid(), lane = tid_ & 63, wid = tid_ >> 6, fr = lane & 15, fq = lane >> 4;
  const bf16_t* KT = (const bf16_t*)(p.ws + WS_KTRT) + (size_t)(b * 512 + h * 64) * 256;
  const bf16_t* VT = (const bf16_t*)(p.ws + WS_VTRT) + (size_t)(b * 512 + h * 64) * 256;
  const float lgf = log1pf(-expf(p.in[25][l * 8 + h]));
  const float lgb = log1pf(-expf(p.in[26][l * 8 + h]));
  f32x4 af[4], ab[4];
#pragma unroll
  for (int nt = 0; nt < 4; ++nt) { af[nt] = f32x4{0.f, 0.f, 0.f, 0.f}; ab[nt] = f32x4{0.f, 0.f, 0.f, 0.f}; }
  for (int ks = 0; ks < 8; ++ks) {
    const int t0 = ks * 32 + fq * 8;
    bf16x8 kraw = *(const bf16x8*)(KT + (size_t)(wid * 16 + fr) * 256 + t0);
    bf16x8 kf, kb;
#pragma unroll
    for (int j = 0; j < 8; ++j) {
      float kv = bfs2f(kraw[j]);
      int t = t0 + j;
      kf[j] = (short)f2bf(kv * __expf(lgf * (float)(255 - t)));
      kb[j] = (short)f2bf(kv * __expf(lgb * (float)t));
    }
#pragma unroll
    for (int nt = 0; nt < 4; ++nt) {
      bf16x8 vb = *(const bf16x8*)(VT + (size_t)(nt * 16 + fr) * 256 + t0);
      af[nt] = MFMA16(kf, vb, af[nt]);
      ab[nt] = MFMA16(kb, vb, ab[nt]);
    }
  }
  float* of = p.out + O_RF + ((size_t)((b * 4 + l) * 8 + h)) * 4096;
  float* ob = p.out + O_RB + ((size_t)((b * 4 + l) * 8 + h)) * 4096;
#pragma unroll
  for (int nt = 0; nt < 4; ++nt)
#pragma unroll
    for (int i = 0; i < 4; ++i) {
      int dk = wid * 16 + fq * 4 + i, dv = nt * 16 + fr;
      of[dk * 64 + dv] = af[nt][i];
      ob[dk * 64 + dv] = ab[nt][i];
    }
}

DI void lru_gates_item(const P& p, int l, int chunk, int n, char* smem) {
  float* XDf = (float*)smem;
  bf16_t* XDb = (bf16_t*)(XDf + 4096);
  const int tid = otid(), lane = tid & 63, wid = tid >> 6, fr = lane & 15, fq = lane >> 4;
  const int row0 = chunk * 64;
  const bool latent = row0 >= NCTX;
  const int T = latent ? 2048 : 256;
  const int tseq0 = latent ? ((row0 - NCTX) & 2047) : (row0 & 255);
  const bf16_t* Z = (const bf16_t*)(p.ws + WS_Z);
  const bf16_t* WL = (const bf16_t*)(p.ws + WS_WLRU);
  bf16_t* LA = (bf16_t*)(p.ws + WS_LA);
  bf16_t* LU = (bf16_t*)(p.ws + WS_LU);
  const int ch0 = n * 64;
  {
    const float cw0 = p.in[28][(l * 4 + 0) * 512 + ch0 + lane];
    const float cw1 = p.in[28][(l * 4 + 1) * 512 + ch0 + lane];
    const float cw2 = p.in[28][(l * 4 + 2) * 512 + ch0 + lane];
    const float cw3 = p.in[28][(l * 4 + 3) * 512 + ch0 + lane];
    const float cb = p.in[29][l * 512 + ch0 + lane];
    const bf16_t* xcol = Z + (size_t)row0 * ZLD + ZC_LRX + ch0 + lane;
    const int t0 = wid * 16;
    auto ld = [&](int tl) -> float {
      int ts = tseq0 + tl;
      return (ts < 0 || ts >= T) ? 0.f : bf2f(xcol[(ptrdiff_t)tl * ZLD]);
    };
    float xm1 = ld(t0 - 1), x0 = ld(t0), x1 = ld(t0 + 1);
#pragma unroll
    for (int i = 0; i < 16; ++i) {
      float x2 = ld(t0 + i + 2);
      float xd = cw0 * xm1 + cw1 * x0 + cw2 * x1 + cw3 * x2 + cb;
      XDf[(t0 + i) * 64 + lane] = xd;
      XDb[(t0 + i) * LDT + lane] = f2bf(xd);
      xm1 = x0; x0 = x1; x1 = x2;
    }
  }
  __syncthreads();
  bf16x8 af[2];
#pragma unroll
  for (int ks = 0; ks < 2; ++ks) af[ks] = *(const bf16x8*)(XDb + (wid * 16 + fr) * LDT + ks * 32 + fq * 8);
#pragma unroll 1
  for (int dir = 0; dir < 2; ++dir) {
    const float* bav = (dir == 0 ? p.in[31] : p.in[36]) + l * 512 + ch0;
    const float* bxv = (dir == 0 ? p.in[33] : p.in[38]) + l * 512 + ch0;
    const float* lamv = (dir == 0 ? p.in[34] : p.in[39]) + l * 512 + ch0;
#pragma unroll
    for (int et = 0; et < 4; ++et) {
      f32x4 da = {0.f, 0.f, 0.f, 0.f}, dx = {0.f, 0.f, 0.f, 0.f};
#pragma unroll
      for (int ks = 0; ks < 2; ++ks) {
        bf16x8 wa = *(const bf16x8*)(WL + (size_t)((dir * 2 + 0) * 8 + n) * 4096 + (et * 16 + fr) * 64 + ks * 32 + fq * 8);
        bf16x8 wx = *(const bf16x8*)(WL + (size_t)((dir * 2 + 1) * 8 + n) * 4096 + (et * 16 + fr) * 64 + ks * 32 + fq * 8);
        da = MFMA16(af[ks], wa, da);
        dx = MFMA16(af[ks], wx, dx);
      }
      const int e = et * 16 + fr;
      const float ba_ = bav[e], bx_ = bxv[e];
      const float sp = log1pf(expf(-lamv[e]));
      float lav[4], uv[4];
#pragma unroll
      for (int i = 0; i < 4; ++i) {
        int tl = wid * 16 + fq * 4 + i;
        float rg = 1.f / (1.f + expf(-(da[i] + ba_)));
        float ig = 1.f / (1.f + expf(-(dx[i] + bx_)));
        float la = -8.f * rg * sp;
        lav[i] = la;
        uv[i] = sqrtf(-expm1f(2.f * la)) * (ig * XDf[tl * 64 + e]);
      }
      const size_t idx = (size_t)dir * 8388608 + ((size_t)chunk * 512 + ch0 + e) * 64 + wid * 16 + fq * 4;
      *(bf16x4*)(LA + idx) = pack4(lav[0], lav[1], lav[2], lav[3]);
      *(bf16x4*)(LU + idx) = pack4(uv[0], uv[1], uv[2], uv[3]);
    }
  }
  __syncthreads();
}

DI void lru_scan_witem(const P& p, int l, int bglob, int g, int lane) {
  const bool latent = bglob >= 32;
  const int T = latent ? 2048 : 256;
  const int rowbase = latent ? NCTX + (bglob - 32) * 2048 : bglob * 256;
  const int chunk0 = rowbase >> 6, nch = T >> 6;
  const int ch = g * 64 + lane;
  const bf16_t* LA = (const bf16_t*)(p.ws + WS_LA);
  const bf16_t* LU = (const bf16_t*)(p.ws + WS_LU);
  bf16_t* HF = (bf16_t*)(p.ws + WS_HF);
  const bf16_t* LG = (const bf16_t*)(p.ws + WS_LG);
  bf16_t* Y4 = (bf16_t*)(p.ws + WS_Y4);
  {
    float h = latent ? p.in[8][((bglob - 32) * 4 + l) * 512 + ch] : 0.f;
    bf16x8 ca[8], cu[8], na[8], nu[8];
    {
      const size_t b0 = ((size_t)chunk0 * 512 + ch) * 64;
#pragma unroll
      for (int q = 0; q < 8; ++q) { ca[q] = *(const bf16x8*)(LA + b0 + q * 8); cu[q] = *(const bf16x8*)(LU + b0 + q * 8); }
    }
    for (int cc = 0; cc < nch; ++cc) {
      const size_t cbase = ((size_t)(chunk0 + cc) * 512 + ch) * 64;
      const int cn = (cc + 1 < nch) ? cc + 1 : cc;
      const size_t nb = ((size_t)(chunk0 + cn) * 512 + ch) * 64;
#pragma unroll
      for (int q = 0; q < 8; ++q) { na[q] = *(const bf16x8*)(LA + nb + q * 8); nu[q] = *(const bf16x8*)(LU + nb + q * 8); }
#pragma unroll
      for (int q = 0; q < 8; ++q) {
        bf16x8 ho;
#pragma unroll
        for (int j = 0; j < 8; ++j) {
          float a = __expf(bfs2f(ca[q][j]));
          h = a * h + bfs2f(cu[q][j]);
          ho[j] = (short)f2bf(h);
        }
        *(bf16x8*)(HF + cbase + q * 8) = ho;
      }
#pragma unroll
      for (int q = 0; q < 8; ++q) { ca[q] = na[q]; cu[q] = nu[q]; }
    }
    if (!latent) p.out[O_LF + (size_t)(bglob * 4 + l) * 512 + ch] = h;
  }
  {
    float h = latent ? p.in[9][((bglob - 32) * 4 + l) * 512 + ch] : 0.f;
    const bf16_t* LAb = LA + 8388608;
    const bf16_t* LUb = LU + 8388608;
    bf16x8 ca[4], cu[4], chf[4], cg_[4], na[4], nu[4], nhf[4], ng[4];
    const int nb_ = 2 * nch;
    {
      const size_t b0 = ((size_t)(chunk0 + nch - 1) * 512 + ch) * 64 + 32;
#pragma unroll
      for (int q = 0; q < 4; ++q) {
        ca[q] = *(const bf16x8*)(LAb + b0 + q * 8); cu[q] = *(const bf16x8*)(LUb + b0 + q * 8);
        chf[q] = *(const bf16x8*)(HF + b0 + q * 8); cg_[q] = *(const bf16x8*)(LG + b0 + q * 8);
      }
    }
    for (int bi = 0; bi < nb_; ++bi) {
      const int chunk = nch - 1 - (bi >> 1), half = 1 - (bi & 1);
      const int bn = (bi + 1 < nb_) ? bi + 1 : bi;
      const int chunkn = nch - 1 - (bn >> 1), halfn = 1 - (bn & 1);
      const size_t nb = ((size_t)(chunk0 + chunkn) * 512 + ch) * 64 + halfn * 32;
#pragma unroll
      for (int q = 0; q < 4; ++q) {
        na[q] = *(const bf16x8*)(LAb + nb + q * 8); nu[q] = *(const bf16x8*)(LUb + nb + q * 8);
        nhf[q] = *(const bf16x8*)(HF + nb + q * 8); ng[q] = *(const bf16x8*)(LG + nb + q * 8);
      }
      bf16_t* yrow = Y4 + (size_t)(rowbase + chunk * 64 + half * 32) * 2048 + 1536 + ch;
#pragma unroll
      for (int q = 3; q >= 0; --q) {
#pragma unroll
        for (int j = 7; j >= 0; --j) {
          float a = __expf(bfs2f(ca[q][j]));
          h = a * h + bfs2f(cu[q][j]);
          float y = (bfs2f(chf[q][j]) + h) * bfs2f(cg_[q][j]);
          yrow[(size_t)(q * 8 + j) * 2048] = f2bf(y);
        }
      }
#pragma unroll
      for (int q = 0; q < 4; ++q) { ca[q] = na[q]; cu[q] = nu[q]; chf[q] = nhf[q]; cg_[q] = ng[q]; }
    }
    if (!latent) p.out[O_LB + (size_t)(bglob * 4 + l) * 512 + ch] = h;
  }
}

DI void phase_mixa(const P& p, int l, char* smem) {
  const int NITEMS = 512 + 2048;
  for (int it = blockIdx.x; it < NITEMS; it += gridDim.x) {
    int q = it;
    if (q < 512) { diff_item(p, l, true, q >> 7, (q >> 5) & 3, q & 31, smem); continue; }
    q -= 512;
    lru_gates_item(p, l, q >> 3, q & 7, smem);
  }
}
DI void phase_mixb(const P& p, int l, char* smem) {
  const int NITEMS = 72 + 4864;
  for (int it = blockIdx.x; it < NITEMS; it += gridDim.x) {
    int q = it;
    if (q < 72) {
      const int tid = otid(), lane = tid & 63, wid = tid >> 6;
      int bglob, g;
      if (q < 32) {
        if (wid == 0) { bglob = 32 + (q >> 3); g = q & 7; }
        else { int ci = q * 3 + wid - 1; bglob = ci >> 3; g = ci & 7; }
      } else {
        int ci = 96 + (q - 32) * 4 + wid;
        bglob = ci >> 3; g = ci & 7;
      }
      lru_scan_witem(p, l, bglob, g, lane);
      continue;
    }
    q -= 72;
    if (q < 1024) { ret_item(p, l, true, q >> 8, (q >> 5) & 7, q & 31, smem); continue; }
    q -= 1024;
    if (q < 1024) { na_item(p, l, q >> 8, (q >> 5) & 7, q & 31, smem); continue; }
    q -= 1024;
    if (q < 1024) { dense_item(p, q >> 5, (q >> 2) & 7, q & 3, smem); continue; }
    q -= 1024;
    if (q < 512) { diff_item(p, l, false, q >> 4, (q >> 2) & 3, q & 3, smem); continue; }
    q -= 512;
    if (q < 1024) { ret_item(p, l, false, q >> 5, (q >> 2) & 7, q & 3, smem); continue; }
    q -= 1024;
    ret_state_item(p, l, q >> 3, q & 7);
  }
}

#define XB_TMO 128
#define XB_XCNT(j) (256 + 64 * (j))
#define XB_XSUB(j) (1280 + 64 * (j))
#define XB_XGEN(j) (2304 + 64 * (j))
#define XB_TOP 3328
#define XB_TOPGEN 3392
#define XCD_BAR_WORDS 3456
#define XB_SPIN_CAP (1u << 18)
#define LAS __attribute__((address_space(3)))
DI unsigned xb_ld(unsigned* p) { return __hip_atomic_load(p, __ATOMIC_RELAXED, __HIP_MEMORY_SCOPE_AGENT); }
DI unsigned xb_add(unsigned* p, unsigned v) { return __hip_atomic_fetch_add(p, v, __ATOMIC_RELAXED, __HIP_MEMORY_SCOPE_AGENT); }
DI unsigned xb_xcc_id() { return (unsigned)__builtin_amdgcn_s_getreg((3 << 11) | 20) & 0xFu; }
#define XB_SPIN(cond, bar) do { unsigned _sp = 0; while (cond) { __builtin_amdgcn_s_sleep(1); \
    if ((++_sp & 255u) == 0u) { if (xb_ld(&(bar)[XB_TMO])) break; if (_sp > XB_SPIN_CAP) { atomicAdd(&(bar)[XB_TMO], 1u); break; } } } } while (0)
struct XcdBarrier { unsigned* bar; unsigned x; volatile LAS unsigned* st; };
DI XcdBarrier xcd_barrier_post(unsigned* bar, volatile LAS unsigned* st) {
  XcdBarrier b; b.bar = bar; b.x = xb_xcc_id(); b.st = st;
  if (threadIdx.x == 0) (void)xb_add(&bar[XB_XCNT(b.x)], 1u);
  return b;
}
DI void xcd_barrier_complete(unsigned* bar, unsigned x, unsigned& nloc, unsigned& nx) {
  const unsigned G = gridDim.x * gridDim.y * gridDim.z;
  unsigned sum, cnt, mine, sp = 0u;
  for (;;) {
    sum = 0u; cnt = 0u; mine = 0u;
#pragma unroll
    for (unsigned j = 0; j < 16; ++j) { const unsigned c = xb_ld(&bar[XB_XCNT(j)]); sum += c; cnt += (c > 0u) ? 1u : 0u; mine = (j == x) ? c : mine; }
    if (sum == G) break;
    __builtin_amdgcn_s_sleep(1);
    if ((++sp & 255u) == 0u) { if (xb_ld(&bar[XB_TMO])) break; if (sp > XB_SPIN_CAP) { atomicAdd(&bar[XB_TMO], 1u); break; } }
  }
  nloc = mine > 0u ? mine : 1u; nx = cnt > 0u ? cnt : 1u;
}
DI void xcd_barrier(const XcdBarrier& b) {
  asm volatile("s_waitcnt vmcnt(0)" ::: "memory");
  __syncthreads();
  if (threadIdx.x == 0) {
    unsigned* bar = b.bar;
    __builtin_amdgcn_s_waitcnt(0);
    unsigned nloc = b.st[0], nx = b.st[1];
    if (nloc == 0u) { xcd_barrier_complete(bar, b.x, nloc, nx); b.st[0] = nloc; b.st[1] = nx; }
    const unsigned old = xb_add(&bar[XB_XSUB(b.x)], 1u);
    const unsigned gen = old / nloc;
    if (old + 1u == (gen + 1u) * nloc) {
      __builtin_amdgcn_fence(__ATOMIC_RELEASE, "agent");
      asm volatile("s_waitcnt vmcnt(0)" ::: "memory");
      const unsigned og = xb_add(&bar[XB_TOP], 1u);
      const unsigned tg = og / nx;
      if (og + 1u == (tg + 1u) * nx) xb_add(&bar[XB_TOPGEN], 1u);
      else XB_SPIN(xb_ld(&bar[XB_TOPGEN]) == tg, bar);
      __builtin_amdgcn_fence(__ATOMIC_ACQUIRE, "agent");
      xb_add(&bar[XB_XGEN(b.x)], 1u);
      asm volatile("s_waitcnt vmcnt(0)" ::: "memory");
    } else {
      XB_SPIN(xb_ld(&bar[XB_XGEN(b.x)]) == gen, bar);
      __builtin_amdgcn_fence(__ATOMIC_ACQUIRE, "agent");
      asm volatile("s_waitcnt vmcnt(0)" ::: "memory");
    }
  }
  __syncthreads();
}

enum { PH_INIT = 0, PH_PRE0, PH_GIN, PH_MIXA, PH_MIXB, PH_MERGE, PH_OUT, PH_POSTMIX, PH_FF1, PH_FF2, PH_POSTFFN };

DI void run_phase(const P& p, int ph, int l, char* smem) {
  switch (ph) {
    case PH_INIT:
      phase_mod(p, smem);
      phase_convert(p, 0, smem);
      break;
    case PH_PRE0: phase_row(p, 0, 0); break;
    case PH_GIN: phase_gin(p, l, smem); break;
    case PH_MIXA: phase_mixa(p, l, smem); break;
    case PH_MIXB: phase_mixb(p, l, smem); break;
    case PH_MERGE: phase_merge(p, smem); break;
    case PH_OUT:
      phase_gemm_plain<0>((const bf16_t*)(p.ws + WS_H), 1024, (const bf16_t*)(p.ws + WS_WOUT), 1024, (void*)(p.ws + WS_Y), smem);
      break;
    case PH_POSTMIX: phase_row(p, l, 1); break;
    case PH_FF1:
      phase_gemm_plain<1>((const bf16_t*)(p.ws + WS_H), 1024, (const bf16_t*)(p.ws + WS_W1), 4096, (void*)(p.ws + WS_U), smem);
      break;
    case PH_FF2:
      phase_gemm_plain<0>((const bf16_t*)(p.ws + WS_U), 4096, (const bf16_t*)(p.ws + WS_W2), 1024, (void*)(p.ws + WS_Y), smem);
      break;
    case PH_POSTFFN:
      phase_row(p, l, 2);
      if (l < 3) phase_convert(p, l + 1, smem);
      break;
    default: break;
  }
}

DI void decode_step(int step, int& ph, int& l) {
  if (step < 2) { ph = step; l = 0; }
  else { int s = step - 2; l = s / 9; ph = PH_GIN + (s % 9); }
}
constexpr int NSTEPS = 38;

__global__ void __launch_bounds__(256, 2) hybrid_flow_mega(P p) {
  __shared__ __attribute__((aligned(16))) char smem[SMEM_BYTES];
  __shared__ uint4 xb_words;
  cg::grid_group grid = cg::this_grid();
  if (threadIdx.x == 0) xb_words = make_uint4(0u, 0u, 0u, 0u);
  __syncthreads();
  XcdBarrier xb = xcd_barrier_post((unsigned*)(p.ws + WS_BAR), (volatile LAS unsigned*)&xb_words);
  for (int step = 0; step < NSTEPS; ++step) {
    int ph, l;
    decode_step(step, ph, l);
#ifdef PROBE_DUP
    const int reps = (ph == PROBE_DUP) ? 2 : 1;
    for (int rep = 0; rep < reps; ++rep)
#endif
    run_phase(p, ph, l, smem);
#ifdef PROBE_CONV
    if (ph == PH_POSTFFN && l < 3) phase_convert(p, l + 1, smem);
#endif
    if (step == 0) grid.sync();
    else if (step + 1 < NSTEPS) xcd_barrier(xb);
#ifdef PROBE_SYNC
    if (step + 1 < NSTEPS) xcd_barrier(xb);
#endif
  }
}

#if !ONE_LAUNCH
__global__ void __launch_bounds__(256, 2) hybrid_flow_phase(P p, int ph, int l) {
  __shared__ __attribute__((aligned(16))) char smem[SMEM_BYTES];
  run_phase(p, ph, l, smem);
}
#endif

extern "C" void kernel_launch(void* const* d_in, const int* in_sizes, int n_in, void* d_out, int out_size, void* d_ws,
                              size_t ws_size, hipStream_t stream) {
  (void)in_sizes; (void)n_in; (void)out_size; (void)ws_size;
  P p{};
  for (int i = 0; i < 44; ++i) p.in[i] = (const float*)d_in[i];
  p.out = (float*)d_out;
  p.ws = (char*)d_ws;
#if ONE_LAUNCH
  static int grid_blocks = 0;
  if (!grid_blocks) {
    int dev = 0, cus = 0, per_cu = 0;
    hipGetDevice(&dev);
    hipDeviceGetAttribute(&cus, hipDeviceAttributeMultiprocessorCount, dev);
    hipOccupancyMaxActiveBlocksPerMultiprocessor(&per_cu, hybrid_flow_mega, 256, 0);
    if (per_cu < 1) per_cu = 1;
    if (per_cu > 2) per_cu = 2;
    grid_blocks = cus * per_cu;
  }
  (void)hipMemsetAsync((char*)d_ws + WS_BAR, 0, 16384, stream);
  void* args[] = {&p};
  hipError_t e = hipLaunchCooperativeKernel((void*)hybrid_flow_mega, dim3(grid_blocks), dim3(256), args, 0, stream);
  if (e != hipSuccess) fprintf(stderr, "cooperative launch failed: %s (grid %d)\n", hipGetErrorString(e), grid_blocks);
#else
  const int grid_blocks = 512;
  for (int step = 0; step < NSTEPS; ++step) {
    int ph, l;
    if (step < 2) { ph = step; l = 0; }
    else { int s = step - 2; l = s / 9; ph = PH_GIN + (s % 9); }
    hipLaunchKernelGGL(hybrid_flow_phase, dim3(grid_blocks), dim3(256), 0, stream, p, ph, l);
  }
#endif
}
```

```cpp
#include <hip/hip_runtime.h>
#include <hip/hip_cooperative_groups.h>
#include <cstdio>
namespace cg = cooperative_groups;

#ifndef ONE_LAUNCH
#define ONE_LAUNCH 1
#endif

typedef unsigned short bf16_t;
using bf16x8 = __attribute__((ext_vector_type(8))) short;
using bf16x4 = __attribute__((ext_vector_type(4))) short;
using f32x4 = __attribute__((ext_vector_type(4))) float;
using u32x4 = __attribute__((ext_vector_type(4))) unsigned;
#define DI __device__ __forceinline__
#define MFMA16(a, b, c) __builtin_amdgcn_mfma_f32_16x16x32_bf16((a), (b), (c), 0, 0, 0)

struct P {
  const float* in[44];
  float* out;
  char* ws;
};

constexpr int D = 1024, NCTX = 8192;
constexpr int ZLD = 4160;
constexpr int ZC_NAQ = 0, ZC_NAK = 512, ZC_DFQ = 1024, ZC_DFK = 1536, ZC_RTQ = 2048, ZC_RTK = 2560, ZC_RTG = 3072,
              ZC_LRX = 3584;
constexpr int LDT = 72;

constexpr size_t WS_WIN = 0;
constexpr size_t WS_WBR = WS_WIN + (size_t)10240 * 1024 * 2;
constexpr size_t WS_WOUT = WS_WBR + (size_t)1024 * 2048 * 2;
constexpr size_t WS_W1 = WS_WOUT + (size_t)1024 * 1024 * 2;
constexpr size_t WS_W2 = WS_W1 + (size_t)4096 * 1024 * 2;
constexpr size_t WS_WLRU = WS_W2 + (size_t)4096 * 1024 * 2;
constexpr size_t WS_CKNA = WS_WLRU + (size_t)32 * 4096 * 2;
constexpr size_t WS_CVNA = WS_CKNA + (size_t)4 * 262144 * 2;
constexpr size_t WS_CKDF = WS_CVNA + (size_t)4 * 262144 * 2;
constexpr size_t WS_CVDF = WS_CKDF + (size_t)4 * 262144 * 2;
constexpr size_t WS_MOD = WS_CVDF + (size_t)4 * 262144 * 2;
constexpr size_t WS_H = WS_MOD + (size_t)4 * 5 * 6144 * 4;
constexpr size_t WS_Y4 = WS_H + (size_t)16384 * 1024 * 2;
constexpr size_t WS_VTNA = WS_Y4 + (size_t)16384 * 2048 * 2;
constexpr size_t WS_VTDF = WS_VTNA + (size_t)16384 * 512 * 2;
constexpr size_t WS_VTRT = WS_VTDF + (size_t)16384 * 512 * 2;
constexpr size_t WS_KTRT = WS_VTRT + (size_t)16384 * 512 * 2;
constexpr size_t WS_Z = WS_KTRT + (size_t)8192 * 512 * 2;
constexpr size_t WS_GF = WS_Z + (size_t)16384 * ZLD * 2;
constexpr size_t WS_Y = WS_Z;
constexpr size_t WS_U = WS_Z + (size_t)16384 * 1024 * 4;
constexpr size_t WS_LA = WS_GF + (size_t)16384 * 4096 * 2;
constexpr size_t WS_LU = WS_LA + (size_t)2 * 16384 * 512 * 2;
constexpr size_t WS_HF = WS_LU + (size_t)2 * 16384 * 512 * 2;
constexpr size_t WS_LG = WS_HF + (size_t)16384 * 512 * 2;
constexpr size_t WS_BAR = WS_LG + (size_t)16384 * 512 * 2;
constexpr size_t WS_END = WS_BAR + 16384;

constexpr size_t O_NAK = 16777216, O_NAV = 33554432, O_DFK = 50331648, O_DFV = 67108864, O_RF = 83886080,
                 O_RB = 88080384, O_LF = 92274688, O_LB = 92340224;
constexpr int VT_LAT = 4194304;

constexpr int SMEM_BYTES = 59392;

DI int otid() {
  int t = threadIdx.x;
  asm volatile("" : "+v"(t));
  return t;
}
typedef __bf16 hwbf2 __attribute__((ext_vector_type(2)));
typedef float f32v2 __attribute__((ext_vector_type(2)));
using u32x2 = __attribute__((ext_vector_type(2))) unsigned;
DI unsigned pk2(float a, float b) {
  f32v2 v = {a, b};
  return __builtin_bit_cast(unsigned, __builtin_convertvector(v, hwbf2));
}
DI bf16_t f2bf(float x) { return (bf16_t)(pk2(x, 0.f) & 0xffffu); }
DI float bf2f(bf16_t b) { return __uint_as_float(((unsigned)b) << 16); }
DI float bfs2f(short b) { return __uint_as_float(((unsigned)(unsigned short)b) << 16); }
DI float wave_sum(float v) {
#pragma unroll
  for (int o = 32; o > 0; o >>= 1) v += __shfl_xor(v, o);
  return v;
}
DI float sigmoidf_(float x) { return 1.f / (1.f + __expf(-x)); }
DI float gelu_tanh(float x) {
  float u = 0.7978845608028654f * (x + 0.044715f * x * x * x);
  return 0.5f * x * (1.f + tanhf(u));
}
DI bf16x8 pack8(const f32x4& a, const f32x4& b) {
  u32x4 r = {pk2(a[0], a[1]), pk2(a[2], a[3]), pk2(b[0], b[1]), pk2(b[2], b[3])};
  return __builtin_bit_cast(bf16x8, r);
}
DI bf16x4 pack4(float a, float b, float c, float d) {
  u32x2 r = {pk2(a, b), pk2(c, d)};
  return __builtin_bit_cast(bf16x4, r);
}

template <int NI>
DI void gemm_mainloop(const bf16_t* __restrict__ A, int lda, const bf16_t* __restrict__ Bt, int ldb, int K, int row0,
                      int col0, bf16_t* sA, bf16_t* sB, f32x4 (&acc)[4][NI]) {
  const int tid = otid(), lane = tid & 63, wid = tid >> 6;
  const int wm = wid >> 1, wn = wid & 1, fr = lane & 15, fq = lane >> 4;
  const bf16_t* Ag = A + (size_t)row0 * lda;
  const bf16_t* Bg = Bt + (size_t)col0 * ldb;
  u32x4 ra[4], rb[NI];
#pragma unroll
  for (int i = 0; i < 4; ++i) {
    int id = tid + i * 256, r = id >> 3, c = (id & 7) * 8;
    ra[i] = *(const u32x4*)(Ag + (size_t)r * lda + c);
  }
#pragma unroll
  for (int i = 0; i < NI; ++i) {
    int id = tid + i * 256, r = id >> 3, c = (id & 7) * 8;
    rb[i] = *(const u32x4*)(Bg + (size_t)r * ldb + c);
  }
#pragma unroll
  for (int i = 0; i < 4; ++i) {
    int id = tid + i * 256, r = id >> 3, c = (id & 7) * 8;
    *(u32x4*)(sA + r * LDT + c) = ra[i];
  }
#pragma unroll
  for (int i = 0; i < NI; ++i) {
    int id = tid + i * 256, r = id >> 3, c = (id & 7) * 8;
    *(u32x4*)(sB + r * LDT + c) = rb[i];
  }
  __syncthreads();
  for (int k0 = 0; k0 < K; k0 += 64) {
    const bool more = (k0 + 64) < K;
    if (more) {
#pragma unroll
      for (int i = 0; i < 4; ++i) {
        int id = tid + i * 256, r = id >> 3, c = (id & 7) * 8;
        ra[i] = *(const u32x4*)(Ag + (size_t)r * lda + k0 + 64 + c);
      }
#pragma unroll
      for (int i = 0; i < NI; ++i) {
        int id = tid + i * 256, r = id >> 3, c = (id & 7) * 8;
        rb[i] = *(const u32x4*)(Bg + (size_t)r * ldb + k0 + 64 + c);
      }
    }
#pragma unroll
    for (int ks = 0; ks < 2; ++ks) {
      bf16x8 af[4], bfr[NI];
#pragma unroll
      for (int mi = 0; mi < 4; ++mi) af[mi] = *(const bf16x8*)(sA + (wm * 64 + mi * 16 + fr) * LDT + ks * 32 + fq * 8);
#pragma unroll
      for (int ni = 0; ni < NI; ++ni) bfr[ni] = *(const bf16x8*)(sB + (wn * NI * 16 + ni * 16 + fr) * LDT + ks * 32 + fq * 8);
#pragma unroll
      for (int mi = 0; mi < 4; ++mi)
#pragma unroll
        for (int ni = 0; ni < NI; ++ni) acc[mi][ni] = MFMA16(af[mi], bfr[ni], acc[mi][ni]);
    }
    __syncthreads();
    if (more) {
#pragma unroll
      for (int i = 0; i < 4; ++i) {
        int id = tid + i * 256, r = id >> 3, c = (id & 7) * 8;
        *(u32x4*)(sA + r * LDT + c) = ra[i];
      }
#pragma unroll
      for (int i = 0; i < NI; ++i) {
        int id = tid + i * 256, r = id >> 3, c = (id & 7) * 8;
        *(u32x4*)(sB + r * LDT + c) = rb[i];
      }
      __syncthreads();
    }
  }
}

DI void zero_acc(f32x4 (&acc)[4][4]) {
#pragma unroll
  for (int mi = 0; mi < 4; ++mi)
#pragma unroll
    for (int ni = 0; ni < 4; ++ni) acc[mi][ni] = f32x4{0.f, 0.f, 0.f, 0.f};
}
DI void tile_of(int id, int ntn, int& tm, int& tn) {
  int band = id / (16 * ntn), rem = id % (16 * ntn);
  tm = band * 16 + (rem & 15);
  tn = rem >> 4;
}

DI void epi_in(const P& p, int l, int row0, int col0, f32x4 (&acc)[4][4]) {
  const int tid_ = otid(), lane = tid_ & 63, wid = tid_ >> 6, wm = wid >> 1, wn = wid & 1, fr = lane & 15, fq = lane >> 4;
  const int seg = col0 >> 9;
  const bool ctx = row0 < NCTX;
  bf16_t* Z = (bf16_t*)(p.ws + WS_Z);
  const int rbase = row0 + wm * 64;
  const int cseg0 = (col0 & 511) + wn * 64;

  if (!ctx && (seg == 3 || seg == 4)) {
    const float inv = powf(10000.f, -(float)fr * (1.f / 16.f));
#pragma unroll
    for (int mi = 0; mi < 4; ++mi)
#pragma unroll
      for (int i = 0; i < 4; ++i) {
        int r = rbase + mi * 16 + fq * 4 + i;
        int t = (r - NCTX) & 2047;
        float gr = (float)(t >> 6), gc = (float)(t & 63);
        float sr, cr, sc, cc;
        sincosf(gr * inv, &sr, &cr);
        sincosf(gc * inv, &sc, &cc);
        float a0 = acc[mi][0][i], a1 = acc[mi][1][i], a2 = acc[mi][2][i], a3 = acc[mi][3][i];
        acc[mi][0][i] = a0 * cr - a1 * sr;
        acc[mi][1][i] = a1 * cr + a0 * sr;
        acc[mi][2][i] = a2 * cc - a3 * sc;
        acc[mi][3][i] = a3 * cc + a2 * sc;
      }
  }

  int zc = -1, tf = 0;
  bf16_t* VT = nullptr;
  switch (seg) {
    case 0: zc = ZC_NAQ; break;
    case 1: zc = ZC_NAK; break;
    case 2: VT = (bf16_t*)(p.ws + WS_VTNA); break;
    case 3: zc = ZC_DFQ; break;
    case 4: zc = ZC_DFK; break;
    case 5: VT = (bf16_t*)(p.ws + WS_VTDF); break;
    case 6: zc = ZC_RTQ; break;
    case 7: zc = ZC_RTK; tf = 4; break;
    case 8: VT = (bf16_t*)(p.ws + WS_VTRT); break;
    case 9: zc = ZC_RTG; tf = 1; break;
    case 10: zc = ZC_LRX; break;
    case 11: break;
    default: break;
  }
  if (seg >= 12) {
    bf16_t* GF = (bf16_t*)(p.ws + WS_GF);
    const int k = (seg - 12) >> 1, tn = ((col0 - 6144) & 1023) >> 7, tm = row0 >> 7;
    bf16_t* dst = GF + ((((size_t)k * 128 + tm) * 8 + tn) * 256 + tid_) * 64;
#pragma unroll
    for (int mi = 0; mi < 4; ++mi)
#pragma unroll
      for (int ni = 0; ni < 4; ++ni)
        *(bf16x4*)(dst + (mi * 4 + ni) * 4) = pack4(sigmoidf_(acc[mi][ni][0]), sigmoidf_(acc[mi][ni][1]), sigmoidf_(acc[mi][ni][2]), sigmoidf_(acc[mi][ni][3]));
    return;
  }

  if (zc >= 0) {
#pragma unroll
    for (int mi = 0; mi < 4; ++mi)
#pragma unroll
      for (int ni = 0; ni < 4; ++ni)
#pragma unroll
        for (int i = 0; i < 4; ++i) {
          int r = rbase + mi * 16 + fq * 4 + i;
          int c = cseg0 + ni * 16 + fr;
          float v = acc[mi][ni][i];
          if (tf == 1) v = v * sigmoidf_(v);
          else if (tf == 2) v = gelu_tanh(v);
          else if (tf == 3) v = sigmoidf_(v);
          else if (tf == 4) v = v * 0.125f;
          Z[(size_t)r * ZLD + zc + c] = f2bf(v);
        }
  }
  if (VT != nullptr || (seg == 7 && ctx)) {
    bf16_t* T_ = (seg == 7) ? (bf16_t*)(p.ws + WS_KTRT) : VT;
    const float scl = (seg == 7) ? 0.125f : 1.f;
#pragma unroll
    for (int mi = 0; mi < 4; ++mi)
#pragma unroll
      for (int ni = 0; ni < 4; ++ni) {
        int r0 = rbase + mi * 16 + fq * 4;
        int c = cseg0 + ni * 16 + fr;
        size_t idx;
        if (r0 < NCTX) {
          int b = r0 >> 8, t = r0 & 255;
          idx = ((size_t)(b * 512 + c)) * 256 + t;
        } else {
          int rr = r0 - NCTX, b = rr >> 11, t = rr & 2047;
          idx = (size_t)VT_LAT + ((size_t)(b * 512 + c)) * 2048 + t;
        }
        *(bf16x4*)(T_ + idx) = pack4(acc[mi][ni][0] * scl, acc[mi][ni][1] * scl, acc[mi][ni][2] * scl, acc[mi][ni][3] * scl);
      }
  }
  if (seg == 11) {
    bf16_t* LG = (bf16_t*)(p.ws + WS_LG);
#pragma unroll
    for (int mi = 0; mi < 4; ++mi)
#pragma unroll
      for (int ni = 0; ni < 4; ++ni) {
        int r0 = rbase + mi * 16 + fq * 4;
        int c = cseg0 + ni * 16 + fr;
        size_t idx = ((size_t)(r0 >> 6) * 512 + c) * 64 + (r0 & 63);
        *(bf16x4*)(LG + idx) = pack4(gelu_tanh(acc[mi][ni][0]), gelu_tanh(acc[mi][ni][1]), gelu_tanh(acc[mi][ni][2]), gelu_tanh(acc[mi][ni][3]));
      }
  }
  if (ctx && (seg == 1 || seg == 2 || seg == 4 || seg == 5)) {
    float* out = p.out;
#pragma unroll
    for (int mi = 0; mi < 4; ++mi)
#pragma unroll
      for (int ni = 0; ni < 4; ++ni)
#pragma unroll
        for (int i = 0; i < 4; ++i) {
          int r = rbase + mi * 16 + fq * 4 + i;
          int c = cseg0 + ni * 16 + fr;
          int b = r >> 8, t = r & 255;
          size_t off;
          if (seg == 1 || seg == 2) {
            int h = c >> 6, d = c & 63;
            off = (seg == 1 ? O_NAK : O_NAV) + ((((size_t)(b * 4 + l) * 8 + h) * 256 + t) * 64 + d);
          } else if (seg == 4) {
            int comp = c >> 8, h = (c >> 6) & 3, d = c & 63;
            off = O_DFK + (((((size_t)(b * 4 + l) * 2 + comp) * 4 + h) * 256 + t) * 64 + d);
          } else {
            int h = c >> 7, d = c & 127;
            off = O_DFV + ((((size_t)(b * 4 + l) * 4 + h) * 256 + t) * 128 + d);
          }
          out[off] = acc[mi][ni][i];
        }
  }
}

DI void phase_gin(const P& p, int l, char* smem) {
  bf16_t* sA = (bf16_t*)smem;
  bf16_t* sB = sA + 128 * LDT;
  const bf16_t* A = (const bf16_t*)(p.ws + WS_H);
  const bf16_t* Bt = (const bf16_t*)(p.ws + WS_WIN);
  const int ntn = 80, total = 128 * ntn;
  for (int id = blockIdx.x; id < total; id += gridDim.x) {
    int tm, tn;
    tile_of(id, ntn, tm, tn);
    f32x4 acc[4][4];
    zero_acc(acc);
    gemm_mainloop<4>(A, 1024, Bt, 1024, 1024, tm * 128, tn * 128, sA, sB, acc);
    epi_in(p, l, tm * 128, tn * 128, acc);
  }
}

DI void phase_merge(const P& p, char* smem) {
  bf16_t* sA = (bf16_t*)smem;
  bf16_t* sB = sA + 128 * LDT;
  const bf16_t* Y4 = (const bf16_t*)(p.ws + WS_Y4);
  const bf16_t* WB = (const bf16_t*)(p.ws + WS_WBR);
  const bf16_t* GF = (const bf16_t*)(p.ws + WS_GF);
  bf16_t* G = (bf16_t*)(p.ws + WS_H);
  const int tid_ = otid(), lane = tid_ & 63, wid = tid_ >> 6, wm = wid >> 1, wn = wid & 1, fr = lane & 15, fq = lane >> 4;
  const int ntn = 16, total = 128 * ntn;
  for (int id = blockIdx.x; id < total; id += gridDim.x) {
    int tm, t64;
    tile_of(id, ntn, tm, t64);
    const int row0 = tm * 128, col0 = t64 * 64;
    f32x4 o[4][2];
#pragma unroll
    for (int mi = 0; mi < 4; ++mi) { o[mi][0] = f32x4{0.f, 0.f, 0.f, 0.f}; o[mi][1] = f32x4{0.f, 0.f, 0.f, 0.f}; }
#pragma unroll 1
    for (int k = 0; k < 4; ++k) {
      const bf16_t* gsrc = GF + ((((size_t)k * 128 + tm) * 8 + (t64 >> 1)) * 256 + (wm * 2 + (t64 & 1)) * 64 + lane) * 64 + wn * 8;
      bf16x8 gq[4];
#pragma unroll
      for (int mi = 0; mi < 4; ++mi) gq[mi] = *(const bf16x8*)(gsrc + mi * 16);
      f32x4 acc[4][2];
#pragma unroll
      for (int mi = 0; mi < 4; ++mi) { acc[mi][0] = f32x4{0.f, 0.f, 0.f, 0.f}; acc[mi][1] = f32x4{0.f, 0.f, 0.f, 0.f}; }
      gemm_mainloop<2>(Y4 + k * 512, 2048, WB + k * 512, 2048, 512, row0, col0, sA, sB, acc);
#pragma unroll
      for (int mi = 0; mi < 4; ++mi)
#pragma unroll
        for (int nj = 0; nj < 2; ++nj)
#pragma unroll
          for (int i = 0; i < 4; ++i) o[mi][nj][i] += bfs2f(gq[mi][nj * 4 + i]) * acc[mi][nj][i];
    }
#pragma unroll
    for (int mi = 0; mi < 4; ++mi)
#pragma unroll
      for (int nj = 0; nj < 2; ++nj)
#pragma unroll
        for (int i = 0; i < 4; ++i) {
          int r = row0 + wm * 64 + mi * 16 + fq * 4 + i;
          int c = col0 + wn * 32 + nj * 16 + fr;
          G[(size_t)r * 1024 + c] = f2bf(o[mi][nj][i]);
        }
  }
}

template <int MODE>
DI void phase_gemm_plain(const bf16_t* A, int K, const bf16_t* Bt, int N, void* outp, char* smem) {
  bf16_t* sA = (bf16_t*)smem;
  bf16_t* sB = sA + 128 * LDT;
  const int tid_ = otid(), lane = tid_ & 63, wid = tid_ >> 6, wm = wid >> 1, wn = wid & 1, fr = lane & 15, fq = lane >> 4;
  const int ntn = N / 128, total = 128 * ntn;
  for (int id = blockIdx.x; id < total; id += gridDim.x) {
    int tm, tn;
    tile_of(id, ntn, tm, tn);
    const int row0 = tm * 128, col0 = tn * 128;
    f32x4 acc[4][4];
    zero_acc(acc);
    gemm_mainloop<4>(A, K, Bt, K, K, row0, col0, sA, sB, acc);
#pragma unroll
    for (int mi = 0; mi < 4; ++mi)
#pragma unroll
      for (int ni = 0; ni < 4; ++ni)
#pragma unroll
        for (int i = 0; i < 4; ++i) {
          int r = row0 + wm * 64 + mi * 16 + fq * 4 + i;
          int c = col0 + wn * 64 + ni * 16 + fr;
          float v = acc[mi][ni][i];
          if (MODE == 0) {
            ((float*)outp)[(size_t)r * N + c] = v;
          } else {
            v = fmaxf(v, 0.f);
            ((bf16_t*)outp)[(size_t)r * N + c] = f2bf(v * v);
          }
        }
  }
}

DI void phase_mod(const P& p, char* smem) {
  float* ssil = (float*)smem;
  float* red = ssil + 5 * 1024;
  const int tid = otid();
  float* MOD = (float*)(p.ws + WS_MOD);
  for (int idx = tid; idx < 5120; idx += 256) {
    int j = idx >> 10, k = idx & 1023;
    float cv = (j == 0) ? p.in[11][k] : p.in[10][(j - 1) * 1024 + k];
    ssil[idx] = cv / (1.f + expf(-cv));
  }
  __syncthreads();
  const int cl = tid & 63, kg = tid >> 6;
  for (int item = blockIdx.x; item < 384; item += gridDim.x) {
    int l = item / 96, cgp = item % 96;
    int col = cgp * 64 + cl;
    const float* W = p.in[12] + (size_t)l * 1024 * 6144 + col;
    float a0 = 0, a1 = 0, a2 = 0, a3 = 0, a4 = 0;
    for (int k = kg * 256; k < kg * 256 + 256; ++k) {
      float w = W[(size_t)k * 6144];
      a0 += ssil[k] * w;
      a1 += ssil[1024 + k] * w;
      a2 += ssil[2048 + k] * w;
      a3 += ssil[3072 + k] * w;
      a4 += ssil[4096 + k] * w;
    }
    red[(kg * 5 + 0) * 64 + cl] = a0;
    red[(kg * 5 + 1) * 64 + cl] = a1;
    red[(kg * 5 + 2) * 64 + cl] = a2;
    red[(kg * 5 + 3) * 64 + cl] = a3;
    red[(kg * 5 + 4) * 64 + cl] = a4;
    __syncthreads();
    if (kg == 0) {
      float bias = p.in[13][l * 6144 + col];
#pragma unroll
      for (int j = 0; j < 5; ++j) {
        float s = red[(0 * 5 + j) * 64 + cl] + red[(1 * 5 + j) * 64 + cl] + red[(2 * 5 + j) * 64 + cl] + red[(3 * 5 + j) * 64 + cl];
        MOD[(size_t)(l * 5 + j) * 6144 + col] = s + bias;
      }
    }
    __syncthreads();
  }
}

DI void transpose_tile(const float* __restrict__ src, int lds_, bf16_t* __restrict__ dst, int ldd, float* tile) {
  const int tid = otid();
#pragma unroll 4
  for (int i = 0; i < 16; ++i) {
    int idx = tid + i * 256, r = idx >> 6, c = idx & 63;
    tile[r * 65 + c] = src[(size_t)r * lds_ + c];
  }
  __syncthreads();
#pragma unroll 4
  for (int i = 0; i < 16; ++i) {
    int idx = tid + i * 256, c = idx >> 6, r = idx & 63;
    dst[(size_t)c * ldd + r] = f2bf(tile[r * 65 + c]);
  }
  __syncthreads();
}

DI void phase_convert(const P& p, int l, char* smem) {
  float* tile = (float*)smem;
  char* ws = p.ws;
  const int NJ = 6432;
  for (int j = blockIdx.x; j < NJ; j += gridDim.x) {
    int q = j;
    if (q < 2560) {
      int tr = q / 160, tc = q % 160;
      transpose_tile(p.in[18] + (size_t)l * 1024 * 10240 + (size_t)tr * 64 * 10240 + tc * 64, 10240,
                     (bf16_t*)(ws + WS_WIN) + (size_t)tc * 64 * 1024 + tr * 64, 1024, tile);
      continue;
    }
    q -= 2560;
    if (q < 512) {
      int tr = q / 16, tc = q % 16;
      transpose_tile(p.in[40] + (size_t)l * 2048 * 1024 + (size_t)tr * 64 * 1024 + tc * 64, 1024,
                     (bf16_t*)(ws + WS_WBR) + (size_t)tc * 64 * 2048 + tr * 64, 2048, tile);
      continue;
    }
    q -= 512;
    if (q < 256) {
      int tr = q / 16, tc = q % 16;
      transpose_tile(p.in[41] + (size_t)l * 1024 * 1024 + (size_t)tr * 64 * 1024 + tc * 64, 1024,
                     (bf16_t*)(ws + WS_WOUT) + (size_t)tc * 64 * 1024 + tr * 64, 1024, tile);
      continue;
    }
    q -= 256;
    if (q < 1024) {
      int tr = q / 64, tc = q % 64;
      transpose_tile(p.in[42] + (size_t)l * 1024 * 4096 + (size_t)tr * 64 * 4096 + tc * 64, 4096,
                     (bf16_t*)(ws + WS_W1) + (size_t)tc * 64 * 1024 + tr * 64, 1024, tile);
      continue;
    }
    q -= 1024;
    if (q < 1024) {
      int tr = q / 16, tc = q % 16;
      transpose_tile(p.in[43] + (size_t)l * 4096 * 1024 + (size_t)tr * 64 * 1024 + tc * 64, 1024,
                     (bf16_t*)(ws + WS_W2) + (size_t)tc * 64 * 4096 + tr * 64, 4096, tile);
      continue;
    }
    q -= 1024;
    if (q < 32) {
      int type = q >> 3, n = q & 7;
      const float* src = (type == 0 ? p.in[30] : type == 1 ? p.in[32] : type == 2 ? p.in[35] : p.in[37]) + (size_t)(l * 8 + n) * 4096;
      transpose_tile(src, 64, (bf16_t*)(ws + WS_WLRU) + (size_t)(type * 8 + n) * 4096, 64, tile);
      continue;
    }
    q -= 32;
    if (q < 256) {
      int bh = q >> 3, tr = q & 7, b = bh >> 3, h = bh & 7;
      transpose_tile(p.in[3] + ((size_t)((b * 4 + l) * 8 + h)) * 32768 + (size_t)tr * 64 * 64, 64,
                     (bf16_t*)(ws + WS_CVNA) + (size_t)bh * 32768 + tr * 64, 512, tile);
      continue;
    }
    q -= 256;
    if (q < 256) {
      int bh = q >> 4, t2 = q & 15, tr = t2 >> 1, tc = t2 & 1, b = bh >> 2, h = bh & 3;
      transpose_tile(p.in[5] + ((size_t)((b * 4 + l) * 4 + h)) * 65536 + (size_t)tr * 64 * 128 + tc * 64, 128,
                     (bf16_t*)(ws + WS_CVDF) + (size_t)bh * 65536 + (size_t)tc * 64 * 512 + tr * 64, 512, tile);
      continue;
    }
    q -= 256;
    {
      int tensor = q >> 8, b = (q >> 6) & 3, chunk = q & 63;
      const float* src = (tensor == 0 ? p.in[2] : p.in[4]) + (size_t)(b * 4 + l) * 262144 + (size_t)chunk * 4096;
      bf16_t* dst = (bf16_t*)(ws + (tensor == 0 ? WS_CKNA : WS_CKDF)) + (size_t)b * 262144 + (size_t)chunk * 4096;
#pragma unroll
      for (int i = 0; i < 4; ++i) {
        int e = (otid() + i * 256) * 4;
        float4 v = *(const float4*)(src + e);
        *(bf16x4*)(dst + e) = pack4(v.x, v.y, v.z, v.w);
      }
    }
  }
}

DI void phase_row(const P& p, int l, int mode) {
  const int tid_ = otid(), lane = tid_ & 63, wid = tid_ >> 6;
  const float* MOD = (const float*)(p.ws + WS_MOD);
  float* X = p.out;
  bf16_t* H = (bf16_t*)(p.ws + WS_H);
  const float* Y = (const float*)(p.ws + WS_Y);
  const bool from_inputs = (mode == 0 || (mode == 1 && l == 0));
  auto xsrc = [&](int r) -> const float* {
    return from_inputs ? ((r < NCTX) ? (p.in[0] + (size_t)r * D) : (p.in[1] + (size_t)(r - NCTX) * D)) : (X + (size_t)r * D);
  };
  int rb = blockIdx.x;
  if (rb >= 4096) return;
  float4 xn[4], yn[4];
  {
    const int r = rb * 4 + wid;
    const float* xs = xsrc(r);
#pragma unroll
    for (int j = 0; j < 4; ++j) xn[j] = *(const float4*)(xs + j * 256 + lane * 4);
    if (mode != 0) {
#pragma unroll
      for (int j = 0; j < 4; ++j) yn[j] = *(const float4*)(Y + (size_t)r * D + j * 256 + lane * 4);
    }
  }
  for (; rb < 4096; rb += gridDim.x) {
    const int r = rb * 4 + wid;
    const int mi = r < NCTX ? 0 : 1 + ((r - NCTX) >> 11);
    float4 xv[4], yv[4];
#pragma unroll
    for (int j = 0; j < 4; ++j) { xv[j] = xn[j]; yv[j] = yn[j]; }
    {
      const int rbn = (rb + (int)gridDim.x < 4096) ? rb + (int)gridDim.x : rb;
      const int rn = rbn * 4 + wid;
      const float* xs = xsrc(rn);
#pragma unroll
      for (int j = 0; j < 4; ++j) xn[j] = *(const float4*)(xs + j * 256 + lane * 4);
      if (mode != 0) {
#pragma unroll
        for (int j = 0; j < 4; ++j) yn[j] = *(const float4*)(Y + (size_t)rn * D + j * 256 + lane * 4);
      }
    }
    if (mode != 0) {
      float ss = 0.f;
#pragma unroll
      for (int j = 0; j < 4; ++j) ss += yv[j].x * yv[j].x + yv[j].y * yv[j].y + yv[j].z * yv[j].z + yv[j].w * yv[j].w;
      ss = wave_sum(ss);
      const float rs = rsqrtf(ss * (1.f / 1024.f) + 1e-6f);
      const float* gpost = (mode == 1 ? p.in[15] : p.in[17]) + l * D;
      const float* gate = MOD + (size_t)(l * 5 + mi) * 6144 + (mode == 1 ? 2048 : 5120);
#pragma unroll
      for (int j = 0; j < 4; ++j) {
        float4 g = *(const float4*)(gpost + j * 256 + lane * 4);
        float4 gt = *(const float4*)(gate + j * 256 + lane * 4);
        xv[j].x += gt.x * (yv[j].x * rs * g.x);
        xv[j].y += gt.y * (yv[j].y * rs * g.y);
        xv[j].z += gt.z * (yv[j].z * rs * g.z);
        xv[j].w += gt.w * (yv[j].w * rs * g.w);
        *(float4*)(X + (size_t)r * D + j * 256 + lane * 4) = xv[j];
      }
    }
    int ln, off_sh, off_sc;
    const float* gpre;
    if (mode == 0) { ln = 0; gpre = p.in[14]; off_sh = 0; off_sc = 1024; }
    else if (mode == 1) { ln = l; gpre = p.in[16] + l * D; off_sh = 3072; off_sc = 4096; }
    else { ln = l + 1; gpre = p.in[14] + (l + 1) * D; off_sh = 0; off_sc = 1024; }
    if (ln < 4) {
      float ss = 0.f;
#pragma unroll
      for (int j = 0; j < 4; ++j) ss += xv[j].x * xv[j].x + xv[j].y * xv[j].y + xv[j].z * xv[j].z + xv[j].w * xv[j].w;
      ss = wave_sum(ss);
      const float rs = rsqrtf(ss * (1.f / 1024.f) + 1e-6f);
      const float* mrow = MOD + (size_t)(ln * 5 + mi) * 6144;
#pragma unroll
      for (int j = 0; j < 4; ++j) {
        int c = j * 256 + lane * 4;
        float4 g = *(const float4*)(gpre + c);
        float4 sc = *(const float4*)(mrow + off_sc + c);
        float4 sh = *(const float4*)(mrow + off_sh + c);
        *(bf16x4*)(H + (size_t)r * D + c) = pack4(xv[j].x * rs * g.x * (1.f + sc.x) + sh.x, xv[j].y * rs * g.y * (1.f + sc.y) + sh.y,
                                                  xv[j].z * rs * g.z * (1.f + sc.z) + sh.z, xv[j].w * rs * g.w * (1.f + sc.w) + sh.w);
      }
    }
  }
}

constexpr int ATT_BUF = 192 * LDT;
DI void qk_scores(const bf16x8 (&qf)[2], const bf16_t* sK, f32x4 (&S)[4], int fr, int fq) {
#pragma unroll
  for (int s = 0; s < 4; ++s) {
    f32x4 z = {0.f, 0.f, 0.f, 0.f};
#pragma unroll
    for (int ks = 0; ks < 2; ++ks) {
      bf16x8 a = *(const bf16x8*)(sK + (16 * s + fr) * LDT + ks * 32 + fq * 8);
      z = MFMA16(a, qf[ks], z);
    }
    S[s] = z;
  }
}
template <int DV>
DI void pv_step(const bf16x8 (&pb)[2], const bf16_t* sV, f32x4 (&O)[DV / 16], int fr, int fq) {
#pragma unroll
  for (int dt = 0; dt < DV / 16; ++dt) {
#pragma unroll
    for (int s2 = 0; s2 < 2; ++s2) {
      const bf16_t* base = sV + (dt * 16 + fr) * LDT + 32 * s2 + 4 * fq;
      bf16x4 lo = *(const bf16x4*)base;
      bf16x4 hi = *(const bf16x4*)(base + 16);
      bf16x8 a = __builtin_shufflevector(lo, hi, 0, 1, 2, 3, 4, 5, 6, 7);
      O[dt] = MFMA16(a, pb[s2], O[dt]);
    }
  }
}
template <int DV>
DI void softmax_pv(f32x4 (&S)[4], const bf16_t* sV, f32x4 (&O)[DV / 16], float& m, float& lsum, int fr, int fq) {
  float tm = -1e30f;
#pragma unroll
  for (int s = 0; s < 4; ++s)
#pragma unroll
    for (int i = 0; i < 4; ++i) tm = fmaxf(tm, S[s][i]);
  tm = fmaxf(tm, __shfl_xor(tm, 16));
  tm = fmaxf(tm, __shfl_xor(tm, 32));
  const float mn = fmaxf(m, tm);
  const float alpha = __expf(m - mn);
  m = mn;
  float ps = 0.f;
#pragma unroll
  for (int s = 0; s < 4; ++s)
#pragma unroll
    for (int i = 0; i < 4; ++i) {
      float pv = __expf(S[s][i] - mn);
      S[s][i] = pv;
      ps += pv;
    }
  lsum = lsum * alpha + ps;
#pragma unroll
  for (int dt = 0; dt < DV / 16; ++dt) {
    O[dt][0] *= alpha; O[dt][1] *= alpha; O[dt][2] *= alpha; O[dt][3] *= alpha;
  }
  bf16x8 pb[2];
  pb[0] = pack8(S[0], S[1]);
  pb[1] = pack8(S[2], S[3]);
  pv_step<DV>(pb, sV, O, fr, fq);
}
template <int DV, bool SOFTMAX, class TileFn, class ScoreFn>
DI void attn_loop(int ntiles, TileFn&& tile, ScoreFn&& score, const bf16x8 (&qf)[2], f32x4 (&O)[DV / 16], float& m, float& lsum,
                  bf16_t* smem, int tid) {
  const int lane = tid & 63, fr = lane & 15, fq = lane >> 4;
  u32x4 rk[2], rv[DV / 32];
  auto gload = [&](int j) {
    const bf16_t* Kg; const bf16_t* Vg; int ldk, ldv;
    tile(j, Kg, ldk, Vg, ldv);
#pragma unroll
    for (int i = 0; i < 2; ++i) {
      int id = tid + i * 256, r = id >> 3, c = (id & 7) * 8;
      rk[i] = *(const u32x4*)(Kg + (size_t)r * ldk + c);
    }
#pragma unroll
    for (int i = 0; i < DV / 32; ++i) {
      int id = tid + i * 256, r = id >> 3, c = (id & 7) * 8;
      rv[i] = *(const u32x4*)(Vg + (size_t)r * ldv + c);
    }
  };
  auto sstore = [&](int buf) {
    bf16_t* sK = smem + buf * ATT_BUF;
    bf16_t* sV = sK + 64 * LDT;
#pragma unroll
    for (int i = 0; i < 2; ++i) {
      int id = tid + i * 256, r = id >> 3, c = (id & 7) * 8;
      *(u32x4*)(sK + r * LDT + c) = rk[i];
    }
#pragma unroll
    for (int i = 0; i < DV / 32; ++i) {
      int id = tid + i * 256, r = id >> 3, c = (id & 7) * 8;
      *(u32x4*)(sV + r * LDT + c) = rv[i];
    }
  };
  gload(0);
  sstore(0);
  __syncthreads();
  for (int j = 0; j < ntiles; ++j) {
    const int jn = (j + 1 < ntiles) ? j + 1 : j;
    gload(jn);
    const bf16_t* sK = smem + (j & 1) * ATT_BUF;
    const bf16_t* sV = sK + 64 * LDT;
    f32x4 S[4];
    qk_scores(qf, sK, S, fr, fq);
    score(j, S);
    if (SOFTMAX) {
      softmax_pv<DV>(S, sV, O, m, lsum, fr, fq);
    } else {
      bf16x8 pb[2];
      pb[0] = pack8(S[0], S[1]);
      pb[1] = pack8(S[2], S[3]);
      pv_step<DV>(pb, sV, O, fr, fq);
    }
    sstore((j + 1) & 1);
    __syncthreads();
  }
}
DI void scale_scores(f32x4 (&S)[4]) {
#pragma unroll
  for (int s = 0; s < 4; ++s) { S[s][0] *= 0.125f; S[s][1] *= 0.125f; S[s][2] *= 0.125f; S[s][3] *= 0.125f; }
}

DI void dense_item(const P& p, int b, int h, int qb, char* smem) {
  const int tid = otid(), lane = tid & 63, wid = tid >> 6, fr = lane & 15, fq = lane >> 4;
  const bf16_t* Z = (const bf16_t*)(p.ws + WS_Z);
  const bf16_t* VT = (const bf16_t*)(p.ws + WS_VTNA) + (size_t)(b * 512 + h * 64) * 256;
  bf16_t* Y4 = (bf16_t*)(p.ws + WS_Y4);
  const int rowbase = b * 256;
  const int qrow = rowbase + qb * 64 + wid * 16 + fr;
  bf16x8 qf[2];
#pragma unroll
  for (int ks = 0; ks < 2; ++ks) qf[ks] = *(const bf16x8*)(Z + (size_t)qrow * ZLD + ZC_NAQ + h * 64 + ks * 32 + fq * 8);
  f32x4 O[4];
#pragma unroll
  for (int dt = 0; dt < 4; ++dt) O[dt] = f32x4{0.f, 0.f, 0.f, 0.f};
  float m = -1e30f, lsum = 0.f;
  const bf16_t* Kb = Z + (size_t)rowbase * ZLD + ZC_NAK + h * 64;
  attn_loop<64, true>(4,
      [&](int j, const bf16_t*& Kg, int& ldk, const bf16_t*& Vg, int& ldv) { Kg = Kb + (size_t)j * 64 * ZLD; ldk = ZLD; Vg = VT + j * 64; ldv = 256; },
      [&](int, f32x4 (&S)[4]) { scale_scores(S); }, qf, O, m, lsum, (bf16_t*)smem, tid);
  float lt = lsum + __shfl_xor(lsum, 16);
  lt += __shfl_xor(lt, 32);
  const float inv = 1.f / lt;
#pragma unroll
  for (int dt = 0; dt < 4; ++dt)
    *(bf16x4*)(Y4 + (size_t)qrow * 2048 + h * 64 + dt * 16 + fq * 4) = pack4(O[dt][0] * inv, O[dt][1] * inv, O[dt][2] * inv, O[dt][3] * inv);
}

DI void na_item(const P& p, int l, int b, int h, int r, char* smem) {
  float* srpb = (float*)((bf16_t*)smem + 2 * ATT_BUF);
  const int tid = otid(), lane = tid & 63, wid = tid >> 6, fr = lane & 15, fq = lane >> 4;
  const bf16_t* Z = (const bf16_t*)(p.ws + WS_Z);
  const bf16_t* VT = (const bf16_t*)(p.ws + WS_VTNA) + VT_LAT + (size_t)(b * 512 + h * 64) * 2048;
  const bf16_t* CK = (const bf16_t*)(p.ws + WS_CKNA) + (size_t)(b * 8 + h) * 32768;
  const bf16_t* CVT = (const bf16_t*)(p.ws + WS_CVNA) + (size_t)(b * 8 + h) * 32768;
  bf16_t* Y4 = (bf16_t*)(p.ws + WS_Y4);
  for (int i = tid; i < 465; i += 256) srpb[i] = p.in[19][(size_t)(l * 8 + h) * 465 + i];
  const int rowbase = NCTX + b * 2048;
  const int qcol = wid * 16 + fr;
  const int qrow = rowbase + r * 64 + qcol;
  bf16x8 qf[2];
#pragma unroll
  for (int ks = 0; ks < 2; ++ks) qf[ks] = *(const bf16x8*)(Z + (size_t)qrow * ZLD + ZC_NAQ + h * 64 + ks * 32 + fq * 8);
  f32x4 O[4];
#pragma unroll
  for (int dt = 0; dt < 4; ++dt) O[dt] = f32x4{0.f, 0.f, 0.f, 0.f};
  float m = -1e30f, lsum = 0.f;
  int rs = r - 4;
  rs = rs < 0 ? 0 : (rs > 24 ? 24 : rs);
  int cstart = qcol - 8;
  cstart = cstart < 0 ? 0 : (cstart > 48 ? 48 : cstart);
  const bf16_t* Kb = Z + (size_t)rowbase * ZLD + ZC_NAK + h * 64;
  attn_loop<64, true>(16,
      [&](int j, const bf16_t*& Kg, int& ldk, const bf16_t*& Vg, int& ldv) {
        if (j < 8) { Kg = Kb + (size_t)(rs + j) * 64 * ZLD; ldk = ZLD; Vg = VT + (rs + j) * 64; ldv = 2048; }
        else { Kg = CK + (size_t)(j - 8) * 64 * 64; ldk = 64; Vg = CVT + (j - 8) * 64; ldv = 512; }
      },
      [&](int j, f32x4 (&S)[4]) {
        if (j < 8) {
          const int dr = rs + j - r + 7;
#pragma unroll
          for (int s = 0; s < 4; ++s)
#pragma unroll
            for (int i = 0; i < 4; ++i) {
              int kcol = s * 16 + fq * 4 + i;
              bool ok = (kcol >= cstart) && (kcol < cstart + 16);
              int dc = kcol - qcol + 15;
              dc = dc < 0 ? 0 : (dc > 30 ? 30 : dc);
              float bias = srpb[dr * 31 + dc];
              S[s][i] = ok ? (S[s][i] * 0.125f + bias) : -1e30f;
            }
        } else {
          scale_scores(S);
        }
      },
      qf, O, m, lsum, (bf16_t*)smem, tid);
  float lt = lsum + __shfl_xor(lsum, 16);
  lt += __shfl_xor(lt, 32);
  const float inv = 1.f / lt;
#pragma unroll
  for (int dt = 0; dt < 4; ++dt)
    *(bf16x4*)(Y4 + (size_t)qrow * 2048 + h * 64 + dt * 16 + fq * 4) = pack4(O[dt][0] * inv, O[dt][1] * inv, O[dt][2] * inv, O[dt][3] * inv);
}

DI void diff_item(const P& p, int l, bool latent, int b, int h, int qb, char* smem) {
  const int tid = otid(), lane = tid & 63, wid = tid >> 6, fr = lane & 15, fq = lane >> 4;
  const bf16_t* Z = (const bf16_t*)(p.ws + WS_Z);
  const int T = latent ? 2048 : 256;
  const int rowbase = latent ? NCTX + b * 2048 : b * 256;
  const bf16_t* VT = (const bf16_t*)(p.ws + WS_VTDF) + (latent ? (size_t)VT_LAT + (size_t)(b * 512 + h * 128) * 2048 : (size_t)(b * 512 + h * 128) * 256);
  const bf16_t* CVT = (const bf16_t*)(p.ws + WS_CVDF) + (size_t)(b * 4 + h) * 65536;
  bf16_t* Y4 = (bf16_t*)(p.ws + WS_Y4);
  const int qrow = rowbase + qb * 64 + wid * 16 + fr;
  float d1 = p.in[20][l * 64 + lane] * p.in[21][l * 64 + lane];
  float d2 = p.in[22][l * 64 + lane] * p.in[23][l * 64 + lane];
  d1 = wave_sum(d1);
  d2 = wave_sum(d2);
  const float lam_init = 0.8f - 0.6f * expf(-0.3f * (float)l);
  const float lam = expf(d1) - expf(d2) + lam_init;
  const int nown = T >> 6;
  const int ntiles = nown + (latent ? 8 : 0);

  f32x4 O1[8];
  f32x4 O[8];
#pragma unroll 1
  for (int comp = 0; comp < 2; ++comp) {
    bf16x8 qf[2];
#pragma unroll
    for (int ks = 0; ks < 2; ++ks) qf[ks] = *(const bf16x8*)(Z + (size_t)qrow * ZLD + ZC_DFQ + comp * 256 + h * 64 + ks * 32 + fq * 8);
#pragma unroll
    for (int dt = 0; dt < 8; ++dt) O[dt] = f32x4{0.f, 0.f, 0.f, 0.f};
    float m = -1e30f, lsum = 0.f;
    const bf16_t* Kb = Z + (size_t)rowbase * ZLD + ZC_DFK + comp * 256 + h * 64;
    const bf16_t* CK = (const bf16_t*)(p.ws + WS_CKDF) + (size_t)((b * 2 + comp) * 4 + h) * 32768;
    attn_loop<128, true>(ntiles,
        [&](int j, const bf16_t*& Kg, int& ldk, const bf16_t*& Vg, int& ldv) {
          if (j < nown) { Kg = Kb + (size_t)j * 64 * ZLD; ldk = ZLD; Vg = VT + j * 64; ldv = T; }
          else { Kg = CK + (size_t)(j - nown) * 64 * 64; ldk = 64; Vg = CVT + (j - nown) * 64; ldv = 512; }
        },
        [&](int, f32x4 (&S)[4]) { scale_scores(S); }, qf, O, m, lsum, (bf16_t*)smem, tid);
    float lt = lsum + __shfl_xor(lsum, 16);
    lt += __shfl_xor(lt, 32);
    const float inv = 1.f / lt;
    if (comp == 0) {
#pragma unroll
      for (int dt = 0; dt < 8; ++dt) { O1[dt][0] = O[dt][0] * inv; O1[dt][1] = O[dt][1] * inv; O1[dt][2] = O[dt][2] * inv; O1[dt][3] = O[dt][3] * inv; }
    } else {
#pragma unroll
      for (int dt = 0; dt < 8; ++dt) {
        O[dt][0] = O1[dt][0] - lam * (O[dt][0] * inv);
        O[dt][1] = O1[dt][1] - lam * (O[dt][1] * inv);
        O[dt][2] = O1[dt][2] - lam * (O[dt][2] * inv);
        O[dt][3] = O1[dt][3] - lam * (O[dt][3] * inv);
      }
    }
  }
  float ss = 0.f;
#pragma unroll
  for (int dt = 0; dt < 8; ++dt) ss += O[dt][0] * O[dt][0] + O[dt][1] * O[dt][1] + O[dt][2] * O[dt][2] + O[dt][3] * O[dt][3];
  ss += __shfl_xor(ss, 16);
  ss += __shfl_xor(ss, 32);
  const float rsn = rsqrtf(ss * (1.f / 128.f) + 1e-6f) * (1.f - lam_init);
  const float* gn = p.in[24] + l * 128;
#pragma unroll
  for (int dt = 0; dt < 8; ++dt) {
    int dv = dt * 16 + fq * 4;
    float4 g = *(const float4*)(gn + dv);
    *(bf16x4*)(Y4 + (size_t)qrow * 2048 + 512 + h * 128 + dv) = pack4(O[dt][0] * rsn * g.x, O[dt][1] * rsn * g.y, O[dt][2] * rsn * g.z, O[dt][3] * rsn * g.w);
  }
}

DI void ret_item(const P& p, int l, bool latent, int b, int h, int qb, char* smem) {
  bf16_t* sV0 = (bf16_t*)smem + 64 * LDT;
  const int tid = otid(), lane = tid & 63, wid = tid >> 6, fr = lane & 15, fq = lane >> 4;
  const bf16_t* Z = (const bf16_t*)(p.ws + WS_Z);
  const int T = latent ? 2048 : 256;
  const int rowbase = latent ? NCTX + b * 2048 : b * 256;
  const bf16_t* VT = (const bf16_t*)(p.ws + WS_VTRT) + (latent ? (size_t)VT_LAT + (size_t)(b * 512 + h * 64) * 2048 : (size_t)(b * 512 + h * 64) * 256);
  bf16_t* Y4 = (bf16_t*)(p.ws + WS_Y4);
  const int tq = qb * 64 + wid * 16 + fr;
  const int qrow = rowbase + tq;
  const float lgf = log1pf(-expf(p.in[25][l * 8 + h]));
  const float lgb = log1pf(-expf(p.in[26][l * 8 + h]));
  bf16x8 qf[2];
#pragma unroll
  for (int ks = 0; ks < 2; ++ks) qf[ks] = *(const bf16x8*)(Z + (size_t)qrow * ZLD + ZC_RTQ + h * 64 + ks * 32 + fq * 8);
  f32x4 O[4];
#pragma unroll
  for (int dt = 0; dt < 4; ++dt) O[dt] = f32x4{0.f, 0.f, 0.f, 0.f};
  float mdummy = 0.f, ldummy = 0.f;
  const bf16_t* Kb = Z + (size_t)rowbase * ZLD + ZC_RTK + h * 64;
  attn_loop<64, false>(T >> 6,
      [&](int j, const bf16_t*& Kg, int& ldk, const bf16_t*& Vg, int& ldv) { Kg = Kb + (size_t)j * 64 * ZLD; ldk = ZLD; Vg = VT + j * 64; ldv = T; },
      [&](int j, f32x4 (&S)[4]) {
#pragma unroll
        for (int s = 0; s < 4; ++s)
#pragma unroll
          for (int i = 0; i < 4; ++i) {
            int tk = j * 64 + s * 16 + fq * 4 + i;
            int dd = tq - tk;
            float w = dd >= 0 ? __expf(lgf * (float)dd) : __expf(lgb * (float)(-dd));
            S[s][i] *= w;
          }
      },
      qf, O, mdummy, ldummy, (bf16_t*)smem, tid);
  if (latent) {
    for (int dir = 0; dir < 2; ++dir) {
      const float* S0 = (dir == 0 ? p.in[6] : p.in[7]) + ((size_t)((b * 4 + l) * 8 + h)) * 4096;
#pragma unroll
      for (int i = 0; i < 4; ++i) {
        int e = (tid + i * 256) * 4;
        float4 v = *(const float4*)(S0 + e);
        int dk = e >> 6, dv = e & 63;
        sV0[(dv + 0) * LDT + dk] = f2bf(v.x);
        sV0[(dv + 1) * LDT + dk] = f2bf(v.y);
        sV0[(dv + 2) * LDT + dk] = f2bf(v.z);
        sV0[(dv + 3) * LDT + dk] = f2bf(v.w);
      }
      __syncthreads();
      const float sc = dir == 0 ? __expf(lgf * (float)(tq + 1)) : __expf(lgb * (float)(T - tq));
      bf16x8 pb[2];
#pragma unroll
      for (int s2 = 0; s2 < 2; ++s2) {
        const bf16_t* qp = Z + (size_t)qrow * ZLD + ZC_RTQ + h * 64 + 32 * s2 + 4 * fq;
        bf16x4 lo = *(const bf16x4*)qp;
        bf16x4 hi = *(const bf16x4*)(qp + 16);
        f32x4 flo = {bfs2f(lo[0]) * sc, bfs2f(lo[1]) * sc, bfs2f(lo[2]) * sc, bfs2f(lo[3]) * sc};
        f32x4 fhi = {bfs2f(hi[0]) * sc, bfs2f(hi[1]) * sc, bfs2f(hi[2]) * sc, bfs2f(hi[3]) * sc};
        pb[s2] = pack8(flo, fhi);
      }
      pv_step<64>(pb, sV0, O, fr, fq);
      __syncthreads();
    }
  }
  float ss = 0.f;
#pragma unroll
  for (int dt = 0; dt < 4; ++dt) ss += O[dt][0] * O[dt][0] + O[dt][1] * O[dt][1] + O[dt][2] * O[dt][2] + O[dt][3] * O[dt][3];
  ss += __shfl_xor(ss, 16);
  ss += __shfl_xor(ss, 32);
  const float rsn = rsqrtf(ss * (1.f / 64.f) + 1e-6f);
  const float* gn = p.in[27] + l * 512 + h * 64;
#pragma unroll
  for (int dt = 0; dt < 4; ++dt) {
    int dv = dt * 16 + fq * 4;
    float4 g = *(const float4*)(gn + dv);
    bf16x4 sg = *(const bf16x4*)(Z + (size_t)qrow * ZLD + ZC_RTG + h * 64 + dv);
    *(bf16x4*)(Y4 + (size_t)qrow * 2048 + 1024 + h * 64 + dv) =
        pack4(O[dt][0] * rsn * g.x * bfs2f(sg[0]), O[dt][1] * rsn * g.y * bfs2f(sg[1]), O[dt][2] * rsn * g.z * bfs2f(sg[2]), O[dt][3] * rsn * g.w * bfs2f(sg[3]));
  }
}

DI void ret_state_item(const P& p, int l, int b, int h) {
  const int tid_ = otid(), lane = tid_ & 63, wid = tid_ >> 6, fr = lane & 15, fq = lane >> 4;
  const bf16_t* KT = (const bf16_t*)(p.ws + WS_KTRT) + (size_t)(b * 512 + h * 64) * 256;
  const bf16_t* VT = (const bf16_t*)(p.ws + WS_VTRT) + (size_t)(b * 512 + h * 64) * 256;
  const float lgf = log1pf(-expf(p.in[25][l * 8 + h]));
  const float lgb = log1pf(-expf(p.in[26][l * 8 + h]));
  f32x4 af[4], ab[4];
#pragma unroll
  for (int nt = 0; nt < 4; ++nt) { af[nt] = f32x4{0.f, 0.f, 0.f, 0.f}; ab[nt] = f32x4{0.f, 0.f, 0.f, 0.f}; }
  for (int ks = 0; ks < 8; ++ks) {
    const int t0 = ks * 32 + fq * 8;
    bf16x8 kraw = *(const bf16x8*)(KT + (size_t)(wid * 16 + fr) * 256 + t0);
    bf16x8 kf, kb;
#pragma unroll
    for (int j = 0; j < 8; ++j) {
      float kv = bfs2f(kraw[j]);
      int t = t0 + j;
      kf[j] = (short)f2bf(kv * __expf(lgf * (float)(255 - t)));
      kb[j] = (short)f2bf(kv * __expf(lgb * (float)t));
    }
#pragma unroll
    for (int nt = 0; nt < 4; ++nt) {
      bf16x8 vb = *(const bf16x8*)(VT + (size_t)(nt * 16 + fr) * 256 + t0);
      af[nt] = MFMA16(kf, vb, af[nt]);
      ab[nt] = MFMA16(kb, vb, ab[nt]);
    }
  }
  float* of = p.out + O_RF + ((size_t)((b * 4 + l) * 8 + h)) * 4096;
  float* ob = p.out + O_RB + ((size_t)((b * 4 + l) * 8 + h)) * 4096;
#pragma unroll
  for (int nt = 0; nt < 4; ++nt)
#pragma unroll
    for (int i = 0; i < 4; ++i) {
      int dk = wid * 16 + fq * 4 + i, dv = nt * 16 + fr;
      of[dk * 64 + dv] = af[nt][i];
      ob[dk * 64 + dv] = ab[nt][i];
    }
}

DI void lru_gates_item(const P& p, int l, int chunk, int n, char* smem) {
  float* XDf = (float*)smem;
  bf16_t* XDb = (bf16_t*)(XDf + 4096);
  const int tid = otid(), lane = tid & 63, wid = tid >> 6, fr = lane & 15, fq = lane >> 4;
  const int row0 = chunk * 64;
  const bool latent = row0 >= NCTX;
  const int T = latent ? 2048 : 256;
  const int tseq0 = latent ? ((row0 - NCTX) & 2047) : (row0 & 255);
  const bf16_t* Z = (const bf16_t*)(p.ws + WS_Z);
  const bf16_t* WL = (const bf16_t*)(p.ws + WS_WLRU);
  bf16_t* LA = (bf16_t*)(p.ws + WS_LA);
  bf16_t* LU = (bf16_t*)(p.ws + WS_LU);
  const int ch0 = n * 64;
  {
    const float cw0 = p.in[28][(l * 4 + 0) * 512 + ch0 + lane];
    const float cw1 = p.in[28][(l * 4 + 1) * 512 + ch0 + lane];
    const float cw2 = p.in[28][(l * 4 + 2) * 512 + ch0 + lane];
    const float cw3 = p.in[28][(l * 4 + 3) * 512 + ch0 + lane];
    const float cb = p.in[29][l * 512 + ch0 + lane];
    const bf16_t* xcol = Z + (size_t)row0 * ZLD + ZC_LRX + ch0 + lane;
    const int t0 = wid * 16;
    auto ld = [&](int tl) -> float {
      int ts = tseq0 + tl;
      return (ts < 0 || ts >= T) ? 0.f : bf2f(xcol[(ptrdiff_t)tl * ZLD]);
    };
    float xm1 = ld(t0 - 1), x0 = ld(t0), x1 = ld(t0 + 1);
#pragma unroll
    for (int i = 0; i < 16; ++i) {
      float x2 = ld(t0 + i + 2);
      float xd = cw0 * xm1 + cw1 * x0 + cw2 * x1 + cw3 * x2 + cb;
      XDf[(t0 + i) * 64 + lane] = xd;
      XDb[(t0 + i) * LDT + lane] = f2bf(xd);
      xm1 = x0; x0 = x1; x1 = x2;
    }
  }
  __syncthreads();
  bf16x8 af[2];
#pragma unroll
  for (int ks = 0; ks < 2; ++ks) af[ks] = *(const bf16x8*)(XDb + (wid * 16 + fr) * LDT + ks * 32 + fq * 8);
#pragma unroll 1
  for (int dir = 0; dir < 2; ++dir) {
    const float* bav = (dir == 0 ? p.in[31] : p.in[36]) + l * 512 + ch0;
    const float* bxv = (dir == 0 ? p.in[33] : p.in[38]) + l * 512 + ch0;
    const float* lamv = (dir == 0 ? p.in[34] : p.in[39]) + l * 512 + ch0;
#pragma unroll
    for (int et = 0; et < 4; ++et) {
      f32x4 da = {0.f, 0.f, 0.f, 0.f}, dx = {0.f, 0.f, 0.f, 0.f};
#pragma unroll
      for (int ks = 0; ks < 2; ++ks) {
        bf16x8 wa = *(const bf16x8*)(WL + (size_t)((dir * 2 + 0) * 8 + n) * 4096 + (et * 16 + fr) * 64 + ks * 32 + fq * 8);
        bf16x8 wx = *(const bf16x8*)(WL + (size_t)((dir * 2 + 1) * 8 + n) * 4096 + (et * 16 + fr) * 64 + ks * 32 + fq * 8);
        da = MFMA16(af[ks], wa, da);
        dx = MFMA16(af[ks], wx, dx);
      }
      const int e = et * 16 + fr;
      const float ba_ = bav[e], bx_ = bxv[e];
      const float sp = log1pf(expf(-lamv[e]));
      float lav[4], uv[4];
#pragma unroll
      for (int i = 0; i < 4; ++i) {
        int tl = wid * 16 + fq * 4 + i;
        float rg = 1.f / (1.f + expf(-(da[i] + ba_)));
        float ig = 1.f / (1.f + expf(-(dx[i] + bx_)));
        float la = -8.f * rg * sp;
        lav[i] = la;
        uv[i] = sqrtf(-expm1f(2.f * la)) * (ig * XDf[tl * 64 + e]);
      }
      const size_t idx = (size_t)dir * 8388608 + ((size_t)chunk * 512 + ch0 + e) * 64 + wid * 16 + fq * 4;
      *(bf16x4*)(LA + idx) = pack4(lav[0], lav[1], lav[2], lav[3]);
      *(bf16x4*)(LU + idx) = pack4(uv[0], uv[1], uv[2], uv[3]);
    }
  }
  __syncthreads();
}

DI void lru_scan_witem(const P& p, int l, int bglob, int g, int lane) {
  const bool latent = bglob >= 32;
  const int T = latent ? 2048 : 256;
  const int rowbase = latent ? NCTX + (bglob - 32) * 2048 : bglob * 256;
  const int chunk0 = rowbase >> 6, nch = T >> 6;
  const int ch = g * 64 + lane;
  const bf16_t* LA = (const bf16_t*)(p.ws + WS_LA);
  const bf16_t* LU = (const bf16_t*)(p.ws + WS_LU);
  bf16_t* HF = (bf16_t*)(p.ws + WS_HF);
  const bf16_t* LG = (const bf16_t*)(p.ws + WS_LG);
  bf16_t* Y4 = (bf16_t*)(p.ws + WS_Y4);
  {
    float h = latent ? p.in[8][((bglob - 32) * 4 + l) * 512 + ch] : 0.f;
    bf16x8 ca[8], cu[8], na[8], nu[8];
    {
      const size_t b0 = ((size_t)chunk0 * 512 + ch) * 64;
#pragma unroll
      for (int q = 0; q < 8; ++q) { ca[q] = *(const bf16x8*)(LA + b0 + q * 8); cu[q] = *(const bf16x8*)(LU + b0 + q * 8); }
    }
    for (int cc = 0; cc < nch; ++cc) {
      const size_t cbase = ((size_t)(chunk0 + cc) * 512 + ch) * 64;
      const int cn = (cc + 1 < nch) ? cc + 1 : cc;
      const size_t nb = ((size_t)(chunk0 + cn) * 512 + ch) * 64;
#pragma unroll
      for (int q = 0; q < 8; ++q) { na[q] = *(const bf16x8*)(LA + nb + q * 8); nu[q] = *(const bf16x8*)(LU + nb + q * 8); }
#pragma unroll
      for (int q = 0; q < 8; ++q) {
        bf16x8 ho;
#pragma unroll
        for (int j = 0; j < 8; ++j) {
          float a = __expf(bfs2f(ca[q][j]));
          h = a * h + bfs2f(cu[q][j]);
          ho[j] = (short)f2bf(h);
        }
        *(bf16x8*)(HF + cbase + q * 8) = ho;
      }
#pragma unroll
      for (int q = 0; q < 8; ++q) { ca[q] = na[q]; cu[q] = nu[q]; }
    }
    if (!latent) p.out[O_LF + (size_t)(bglob * 4 + l) * 512 + ch] = h;
  }
  {
    float h = latent ? p.in[9][((bglob - 32) * 4 + l) * 512 + ch] : 0.f;
    const bf16_t* LAb = LA + 8388608;
    const bf16_t* LUb = LU + 8388608;
    bf16x8 ca[4], cu[4], chf[4], cg_[4], na[4], nu[4], nhf[4], ng[4];
    const int nb_ = 2 * nch;
    {
      const size_t b0 = ((size_t)(chunk0 + nch - 1) * 512 + ch) * 64 + 32;
#pragma unroll
      for (int q = 0; q < 4; ++q) {
        ca[q] = *(const bf16x8*)(LAb + b0 + q * 8); cu[q] = *(const bf16x8*)(LUb + b0 + q * 8);
        chf[q] = *(const bf16x8*)(HF + b0 + q * 8); cg_[q] = *(const bf16x8*)(LG + b0 + q * 8);
      }
    }
    for (int bi = 0; bi < nb_; ++bi) {
      const int chunk = nch - 1 - (bi >> 1), half = 1 - (bi & 1);
      const int bn = (bi + 1 < nb_) ? bi + 1 : bi;
      const int chunkn = nch - 1 - (bn >> 1), halfn = 1 - (bn & 1);
      const size_t nb = ((size_t)(chunk0 + chunkn) * 512 + ch) * 64 + halfn * 32;
#pragma unroll
      for (int q = 0; q < 4; ++q) {
        na[q] = *(const bf16x8*)(LAb + nb + q * 8); nu[q] = *(const bf16x8*)(LUb + nb + q * 8);
        nhf[q] = *(const bf16x8*)(HF + nb + q * 8); ng[q] = *(const bf16x8*)(LG + nb + q * 8);
      }
      bf16_t* yrow = Y4 + (size_t)(rowbase + chunk * 64 + half * 32) * 2048 + 1536 + ch;
#pragma unroll
      for (int q = 3; q >= 0; --q) {
#pragma unroll
        for (int j = 7; j >= 0; --j) {
          float a = __expf(bfs2f(ca[q][j]));
          h = a * h + bfs2f(cu[q][j]);
          float y = (bfs2f(chf[q][j]) + h) * bfs2f(cg_[q][j]);
          yrow[(size_t)(q * 8 + j) * 2048] = f2bf(y);
        }
      }
#pragma unroll
      for (int q = 0; q < 4; ++q) { ca[q] = na[q]; cu[q] = nu[q]; chf[q] = nhf[q]; cg_[q] = ng[q]; }
    }
    if (!latent) p.out[O_LB + (size_t)(bglob * 4 + l) * 512 + ch] = h;
  }
}

DI void phase_mixa(const P& p, int l, char* smem) {
  const int NITEMS = 512 + 2048;
  for (int it = blockIdx.x; it < NITEMS; it += gridDim.x) {
    int q = it;
    if (q < 512) { diff_item(p, l, true, q >> 7, (q >> 5) & 3, q & 31, smem); continue; }
    q -= 512;
    lru_gates_item(p, l, q >> 3, q & 7, smem);
  }
}
DI void phase_mixb(const P& p, int l, char* smem) {
  const int NITEMS = 72 + 4864;
  for (int it = blockIdx.x; it < NITEMS; it += gridDim.x) {
    int q = it;
    if (q < 72) {
      const int tid = otid(), lane = tid & 63, wid = tid >> 6;
      int bglob, g;
      if (q < 32) {
        if (wid == 0) { bglob = 32 + (q >> 3); g = q & 7; }
        else { int ci = q * 3 + wid - 1; bglob = ci >> 3; g = ci & 7; }
      } else {
        int ci = 96 + (q - 32) * 4 + wid;
        bglob = ci >> 3; g = ci & 7;
      }
      lru_scan_witem(p, l, bglob, g, lane);
      continue;
    }
    q -= 72;
    if (q < 1024) { ret_item(p, l, true, q >> 8, (q >> 5) & 7, q & 31, smem); continue; }
    q -= 1024;
    if (q < 1024) { na_item(p, l, q >> 8, (q >> 5) & 7, q & 31, smem); continue; }
    q -= 1024;
    if (q < 1024) { dense_item(p, q >> 5, (q >> 2) & 7, q & 3, smem); continue; }
    q -= 1024;
    if (q < 512) { diff_item(p, l, false, q >> 4, (q >> 2) & 3, q & 3, smem); continue; }
    q -= 512;
    if (q < 1024) { ret_item(p, l, false, q >> 5, (q >> 2) & 7, q & 3, smem); continue; }
    q -= 1024;
    ret_state_item(p, l, q >> 3, q & 7);
  }
}

#define XB_TMO 128
#define XB_XCNT(j) (256 + 64 * (j))
#define XB_XSUB(j) (1280 + 64 * (j))
#define XB_XGEN(j) (2304 + 64 * (j))
#define XB_TOP 3328
#define XB_TOPGEN 3392
#define XCD_BAR_WORDS 3456
#define XB_SPIN_CAP (1u << 18)
#define LAS __attribute__((address_space(3)))
DI unsigned xb_ld(unsigned* p) { return __hip_atomic_load(p, __ATOMIC_RELAXED, __HIP_MEMORY_SCOPE_AGENT); }
DI unsigned xb_add(unsigned* p, unsigned v) { return __hip_atomic_fetch_add(p, v, __ATOMIC_RELAXED, __HIP_MEMORY_SCOPE_AGENT); }
DI unsigned xb_xcc_id() { return (unsigned)__builtin_amdgcn_s_getreg((3 << 11) | 20) & 0xFu; }
#define XB_SPIN(cond, bar) do { unsigned _sp = 0; while (cond) { __builtin_amdgcn_s_sleep(1); \
    if ((++_sp & 255u) == 0u) { if (xb_ld(&(bar)[XB_TMO])) break; if (_sp > XB_SPIN_CAP) { atomicAdd(&(bar)[XB_TMO], 1u); break; } } } } while (0)
struct XcdBarrier { unsigned* bar; unsigned x; volatile LAS unsigned* st; };
DI XcdBarrier xcd_barrier_post(unsigned* bar, volatile LAS unsigned* st) {
  XcdBarrier b; b.bar = bar; b.x = xb_xcc_id(); b.st = st;
  if (threadIdx.x == 0) (void)xb_add(&bar[XB_XCNT(b.x)], 1u);
  return b;
}
DI void xcd_barrier_complete(unsigned* bar, unsigned x, unsigned& nloc, unsigned& nx) {
  const unsigned G = gridDim.x * gridDim.y * gridDim.z;
  unsigned sum, cnt, mine, sp = 0u;
  for (;;) {
    sum = 0u; cnt = 0u; mine = 0u;
#pragma unroll
    for (unsigned j = 0; j < 16; ++j) { const unsigned c = xb_ld(&bar[XB_XCNT(j)]); sum += c; cnt += (c > 0u) ? 1u : 0u; mine = (j == x) ? c : mine; }
    if (sum == G) break;
    __builtin_amdgcn_s_sleep(1);
    if ((++sp & 255u) == 0u) { if (xb_ld(&bar[XB_TMO])) break; if (sp > XB_SPIN_CAP) { atomicAdd(&bar[XB_TMO], 1u); break; } }
  }
  nloc = mine > 0u ? mine : 1u; nx = cnt > 0u ? cnt : 1u;
}
DI void xcd_barrier(const XcdBarrier& b) {
  asm volatile("s_waitcnt vmcnt(0)" ::: "memory");
  __syncthreads();
  if (threadIdx.x == 0) {
    unsigned* bar = b.bar;
    __builtin_amdgcn_s_waitcnt(0);
    unsigned nloc = b.st[0], nx = b.st[1];
    if (nloc == 0u) { xcd_barrier_complete(bar, b.x, nloc, nx); b.st[0] = nloc; b.st[1] = nx; }
    const unsigned old = xb_add(&bar[XB_XSUB(b.x)], 1u);
    const unsigned gen = old / nloc;
    if (old + 1u == (gen + 1u) * nloc) {
      __builtin_amdgcn_fence(__ATOMIC_RELEASE, "agent");
      asm volatile("s_waitcnt vmcnt(0)" ::: "memory");
      const unsigned og = xb_add(&bar[XB_TOP], 1u);
      const unsigned tg = og / nx;
      if (og + 1u == (tg + 1u) * nx) xb_add(&bar[XB_TOPGEN], 1u);
      else XB_SPIN(xb_ld(&bar[XB_TOPGEN]) == tg, bar);
      __builtin_amdgcn_fence(__ATOMIC_ACQUIRE, "agent");
      xb_add(&bar[XB_XGEN(b.x)], 1u);
      asm volatile("s_waitcnt vmcnt(0)" ::: "memory");
    } else {
      XB_SPIN(xb_ld(&bar[XB_XGEN(b.x)]) == gen, bar);
      __builtin_amdgcn_fence(__ATOMIC_ACQUIRE, "agent");
      asm volatile("s_waitcnt vmcnt(0)" ::: "memory");
    }
  }
  __syncthreads();
}

enum { PH_INIT = 0, PH_PRE0, PH_GIN, PH_MIXA, PH_MIXB, PH_MERGE, PH_OUT, PH_POSTMIX, PH_FF1, PH_FF2, PH_POSTFFN };

DI void run_phase(const P& p, int ph, int l, char* smem) {
  switch (ph) {
    case PH_INIT:
      phase_mod(p, smem);
      phase_convert(p, 0, smem);
      break;
    case PH_PRE0: phase_row(p, 0, 0); break;
    case PH_GIN: phase_gin(p, l, smem); break;
    case PH_MIXA: phase_mixa(p, l, smem); break;
    case PH_MIXB: phase_mixb(p, l, smem); break;
    case PH_MERGE: phase_merge(p, smem); break;
    case PH_OUT:
      phase_gemm_plain<0>((const bf16_t*)(p.ws + WS_H), 1024, (const bf16_t*)(p.ws + WS_WOUT), 1024, (void*)(p.ws + WS_Y), smem);
      break;
    case PH_POSTMIX: phase_row(p, l, 1); break;
    case PH_FF1:
      phase_gemm_plain<1>((const bf16_t*)(p.ws + WS_H), 1024, (const bf16_t*)(p.ws + WS_W1), 4096, (void*)(p.ws + WS_U), smem);
      break;
    case PH_FF2:
      phase_gemm_plain<0>((const bf16_t*)(p.ws + WS_U), 4096, (const bf16_t*)(p.ws + WS_W2), 1024, (void*)(p.ws + WS_Y), smem);
      break;
    case PH_POSTFFN:
      phase_row(p, l, 2);
      if (l < 3) phase_convert(p, l + 1, smem);
      break;
    default: break;
  }
}

DI void decode_step(int step, int& ph, int& l) {
  if (step < 2) { ph = step; l = 0; }
  else { int s = step - 2; l = s / 9; ph = PH_GIN + (s % 9); }
}
constexpr int NSTEPS = 38;

__global__ void __launch_bounds__(256, 2) hybrid_flow_mega(P p) {
  __shared__ __attribute__((aligned(16))) char smem[SMEM_BYTES];
  __shared__ uint4 xb_words;
  cg::grid_group grid = cg::this_grid();
  if (threadIdx.x == 0) xb_words = make_uint4(0u, 0u, 0u, 0u);
  __syncthreads();
  XcdBarrier xb = xcd_barrier_post((unsigned*)(p.ws + WS_BAR), (volatile LAS unsigned*)&xb_words);
  for (int step = 0; step < NSTEPS; ++step) {
    int ph, l;
    decode_step(step, ph, l);
#ifdef PROBE_DUP
    const int reps = (ph == PROBE_DUP) ? 2 : 1;
    for (int rep = 0; rep < reps; ++rep)
#endif
    run_phase(p, ph, l, smem);
#ifdef PROBE_CONV
    if (ph == PH_POSTFFN && l < 3) phase_convert(p, l + 1, smem);
#endif
    if (step == 0) grid.sync();
    else if (step + 1 < NSTEPS) xcd_barrier(xb);
#ifdef PROBE_SYNC
    if (step + 1 < NSTEPS) xcd_barrier(xb);
#endif
  }
}

#if !ONE_LAUNCH
__global__ void __launch_bounds__(256, 2) hybrid_flow_phase(P p, int ph, int l) {
  __shared__ __attribute__((aligned(16))) char smem[SMEM_BYTES];
  run_phase(p, ph, l, smem);
}
#endif

extern "C" void kernel_launch(void* const* d_in, const int* in_sizes, int n_in, void* d_out, int out_size, void* d_ws,
                              size_t ws_size, hipStream_t stream) {
  (void)in_sizes; (void)n_in; (void)out_size; (void)ws_size;
  P p{};
  for (int i = 0; i < 44; ++i) p.in[i] = (const float*)d_in[i];
  p.out = (float*)d_out;
  p.ws = (char*)d_ws;
#if ONE_LAUNCH
  static int grid_blocks = 0;
  if (!grid_blocks) {
    int dev = 0, cus = 0, per_cu = 0;
    hipGetDevice(&dev);
    hipDeviceGetAttribute(&cus, hipDeviceAttributeMultiprocessorCount, dev);
    hipOccupancyMaxActiveBlocksPerMultiprocessor(&per_cu, hybrid_flow_mega, 256, 0);
    if (per_cu < 1) per_cu = 1;
    if (per_cu > 2) per_cu = 2;
    grid_blocks = cus * per_cu;
  }
  (void)hipMemsetAsync((char*)d_ws + WS_BAR, 0, 16384, stream);
  void* args[] = {&p};
  hipError_t e = hipLaunchCooperativeKernel((void*)hybrid_flow_mega, dim3(grid_blocks), dim3(256), args, 0, stream);
  if (e != hipSuccess) fprintf(stderr, "cooperative launch failed: %s (grid %d)\n", hipGetErrorString(e), grid_blocks);
#else
  const int grid_blocks = 512;
  for (int step = 0; step < NSTEPS; ++step) {
    int ph, l;
    if (step < 2) { ph = step; l = 0; }
    else { int s = step - 2; l = s / 9; ph = PH_GIN + (s % 9); }
    hipLaunchKernelGGL(hybrid_flow_phase, dim3(grid_blocks), dim3(256), 0, stream, p, ph, l);
  }
#endif
}
```

```cpp
#include <hip/hip_runtime.h>
#include <hip/hip_cooperative_groups.h>
#include <cstdio>
namespace cg = cooperative_groups;

#ifndef ONE_LAUNCH
#define ONE_LAUNCH 1
#endif

typedef unsigned short bf16_t;
using bf16x8 = __attribute__((ext_vector_type(8))) short;
using bf16x4 = __attribute__((ext_vector_type(4))) short;
using f32x4 = __attribute__((ext_vector_type(4))) float;
using u32x4 = __attribute__((ext_vector_type(4))) unsigned;
#define DI __device__ __forceinline__
#define MFMA16(a, b, c) __builtin_amdgcn_mfma_f32_16x16x32_bf16((a), (b), (c), 0, 0, 0)

struct P {
  const float* in[44];
  float* out;
  char* ws;
};

constexpr int D = 1024, NCTX = 8192;
constexpr int ZLD = 4160;
constexpr int ZC_NAQ = 0, ZC_NAK = 512, ZC_DFQ = 1024, ZC_DFK = 1536, ZC_RTQ = 2048, ZC_RTK = 2560, ZC_RTG = 3072,
              ZC_LRX = 3584;
constexpr int LDT = 72;

constexpr size_t WS_WIN = 0;
constexpr size_t WS_WBR = WS_WIN + (size_t)10240 * 1024 * 2;
constexpr size_t WS_WOUT = WS_WBR + (size_t)1024 * 2048 * 2;
constexpr size_t WS_W1 = WS_WOUT + (size_t)1024 * 1024 * 2;
constexpr size_t WS_W2 = WS_W1 + (size_t)4096 * 1024 * 2;
constexpr size_t WS_WLRU = WS_W2 + (size_t)4096 * 1024 * 2;
constexpr size_t WS_CKNA = WS_WLRU + (size_t)32 * 4096 * 2;
constexpr size_t WS_CVNA = WS_CKNA + (size_t)4 * 262144 * 2;
constexpr size_t WS_CKDF = WS_CVNA + (size_t)4 * 262144 * 2;
constexpr size_t WS_CVDF = WS_CKDF + (size_t)4 * 262144 * 2;
constexpr size_t WS_MOD = WS_CVDF + (size_t)4 * 262144 * 2;
constexpr size_t WS_H = WS_MOD + (size_t)4 * 5 * 6144 * 4;
constexpr size_t WS_Y4 = WS_H + (size_t)16384 * 1024 * 2;
constexpr size_t WS_VTNA = WS_Y4 + (size_t)16384 * 2048 * 2;
constexpr size_t WS_VTDF = WS_VTNA + (size_t)16384 * 512 * 2;
constexpr size_t WS_VTRT = WS_VTDF + (size_t)16384 * 512 * 2;
constexpr size_t WS_KTRT = WS_VTRT + (size_t)16384 * 512 * 2;
constexpr size_t WS_Z = WS_KTRT + (size_t)8192 * 512 * 2;
constexpr size_t WS_GF = WS_Z + (size_t)16384 * ZLD * 2;
constexpr size_t WS_Y = WS_Z;
constexpr size_t WS_U = WS_Z + (size_t)16384 * 1024 * 4;
constexpr size_t WS_LA = WS_GF + (size_t)16384 * 4096 * 2;
constexpr size_t WS_LU = WS_LA + (size_t)2 * 16384 * 512 * 2;
constexpr size_t WS_HF = WS_LU + (size_t)2 * 16384 * 512 * 2;
constexpr size_t WS_LG = WS_HF + (size_t)16384 * 512 * 2;
constexpr size_t WS_BAR = WS_LG + (size_t)16384 * 512 * 2;
constexpr size_t WS_END = WS_BAR + 16384;

constexpr size_t O_NAK = 16777216, O_NAV = 33554432, O_DFK = 50331648, O_DFV = 67108864, O_RF = 83886080,
                 O_RB = 88080384, O_LF = 92274688, O_LB = 92340224;
constexpr int VT_LAT = 4194304;

constexpr int SMEM_BYTES = 69632;

DI int otid() {
  int t = threadIdx.x;
  asm volatile("" : "+v"(t));
  return t;
}
typedef __bf16 hwbf2 __attribute__((ext_vector_type(2)));
typedef float f32v2 __attribute__((ext_vector_type(2)));
using u32x2 = __attribute__((ext_vector_type(2))) unsigned;
DI unsigned pk2(float a, float b) {
  f32v2 v = {a, b};
  return __builtin_bit_cast(unsigned, __builtin_convertvector(v, hwbf2));
}
DI bf16_t f2bf(float x) { return (bf16_t)(pk2(x, 0.f) & 0xffffu); }
DI float bf2f(bf16_t b) { return __uint_as_float(((unsigned)b) << 16); }
DI float bfs2f(short b) { return __uint_as_float(((unsigned)(unsigned short)b) << 16); }
DI float wave_sum(float v) {
#pragma unroll
  for (int o = 32; o > 0; o >>= 1) v += __shfl_xor(v, o);
  return v;
}
DI float sigmoidf_(float x) { return 1.f / (1.f + __expf(-x)); }
DI float gelu_tanh(float x) {
  float u = 0.7978845608028654f * (x + 0.044715f * x * x * x);
  return x * sigmoidf_(2.f * u);
}
DI bf16x8 pack8(const f32x4& a, const f32x4& b) {
  u32x4 r = {pk2(a[0], a[1]), pk2(a[2], a[3]), pk2(b[0], b[1]), pk2(b[2], b[3])};
  return __builtin_bit_cast(bf16x8, r);
}
DI bf16x4 pack4(float a, float b, float c, float d) {
  u32x2 r = {pk2(a, b), pk2(c, d)};
  return __builtin_bit_cast(bf16x4, r);
}

constexpr int GEMM_BUF_BYTES = 32768;
DI int swz_off(int rr, int c4) {
  int ob = rr * 64 + c4 * 16;
  return ob ^ (((ob >> 9) & 1) << 5);
}
template <int NI>
DI void gemm_mainloop(const bf16_t* __restrict__ A, int lda, const bf16_t* __restrict__ Bt, int ldb, int K, int row0,
                      int col0, char* smem, f32x4 (&acc)[4][NI]) {
  const int tid = otid(), lane = tid & 63, wid = tid >> 6;
  const int wm = wid >> 1, wn = wid & 1, fr = lane & 15, fq = lane >> 4;
  const int c4 = tid & 3, kh = (tid >> 3) & 1;
  const int srow = ((tid >> 4) << 1) + ((tid >> 2) & 1);
  const int gk = (kh * 4 + c4) * 8;
  const int soff = ((srow >> 4) * 2 + kh) * 1024 + swz_off(srow & 15, c4);
  const bf16_t* Ag = A + (size_t)(row0 + srow) * lda + gk;
  const bf16_t* Bg = Bt + (size_t)(col0 + srow) * ldb + gk;
  const int aoff = wm * 8192 + swz_off(fr, fq);
  const int boff = 16384 + wn * NI * 2048 + swz_off(fr, fq);
  u32x4 ra[4], rb[NI];
#pragma unroll
  for (int i = 0; i < 4; ++i) ra[i] = *(const u32x4*)(Ag + (size_t)(i * 32) * lda);
#pragma unroll
  for (int i = 0; i < NI; ++i) rb[i] = *(const u32x4*)(Bg + (size_t)(i * 32) * ldb);
#pragma unroll
  for (int i = 0; i < 4; ++i) *(u32x4*)(smem + soff + i * 4096) = ra[i];
#pragma unroll
  for (int i = 0; i < NI; ++i) *(u32x4*)(smem + 16384 + soff + i * 4096) = rb[i];
  __syncthreads();
  const int nk = K >> 6;
  for (int kt = 0; kt < nk; ++kt) {
    const bool more = (kt + 1) < nk;
    if (more) {
      const int k1 = (kt + 1) * 64;
#pragma unroll
      for (int i = 0; i < 4; ++i) ra[i] = *(const u32x4*)(Ag + (size_t)(i * 32) * lda + k1);
#pragma unroll
      for (int i = 0; i < NI; ++i) rb[i] = *(const u32x4*)(Bg + (size_t)(i * 32) * ldb + k1);
    }
    asm volatile("" ::: "memory");
    const char* sb = smem + (kt & 1) * GEMM_BUF_BYTES;
#pragma unroll
    for (int ks = 0; ks < 2; ++ks) {
      bf16x8 af[4], bfr[NI];
#pragma unroll
      for (int mi = 0; mi < 4; ++mi) af[mi] = *(const bf16x8*)(sb + aoff + mi * 2048 + ks * 1024);
#pragma unroll
      for (int ni = 0; ni < NI; ++ni) bfr[ni] = *(const bf16x8*)(sb + boff + ni * 2048 + ks * 1024);
#pragma unroll
      for (int mi = 0; mi < 4; ++mi)
#pragma unroll
        for (int ni = 0; ni < NI; ++ni) acc[mi][ni] = MFMA16(bfr[ni], af[mi], acc[mi][ni]);
    }
    __builtin_amdgcn_sched_barrier(0);
    if (more) {
      char* db = smem + ((kt + 1) & 1) * GEMM_BUF_BYTES;
#pragma unroll
      for (int i = 0; i < 4; ++i) *(u32x4*)(db + soff + i * 4096) = ra[i];
#pragma unroll
      for (int i = 0; i < NI; ++i) *(u32x4*)(db + 16384 + soff + i * 4096) = rb[i];
    }
    __syncthreads();
  }
}

DI void zero_acc(f32x4 (&acc)[4][4]) {
#pragma unroll
  for (int mi = 0; mi < 4; ++mi)
#pragma unroll
    for (int ni = 0; ni < 4; ++ni) acc[mi][ni] = f32x4{0.f, 0.f, 0.f, 0.f};
}
DI bool tile_sched(int iter, int tmt, int ntn, int& tm, int& tn) {
  const int G = gridDim.x, b = blockIdx.x;
  if ((G & 63) == 0 && (ntn & 7) == 0 && (tmt & 7) == 0) {
    const int groups = G >> 6, xg = b % groups, j = b / groups;
    const int srows = tmt >> 3;
    const int s = iter * groups + xg, nsuper = srows * (ntn >> 3);
    if (s >= nsuper) return false;
    tm = (s % srows) * 8 + (j & 7);
    tn = (s / srows) * 8 + (j >> 3);
    return true;
  }
  const int id = b + iter * G;
  if (id >= tmt * ntn) return false;
  tm = id % tmt;
  tn = id / tmt;
  return true;
}

constexpr int G2_STAGE = 24576;
DI void zero_acc2(f32x4 (&acc)[8][4]) {
#pragma unroll
  for (int mi = 0; mi < 8; ++mi)
#pragma unroll
    for (int ni = 0; ni < 4; ++ni) acc[mi][ni] = f32x4{0.f, 0.f, 0.f, 0.f};
}
DI void gemm2_mainloop(const bf16_t* __restrict__ A, int lda, const bf16_t* __restrict__ Bt, int ldb, int K, int row0,
                       int col0, char* smem, f32x4 (&acc)[8][4]) {
  const int tid = otid(), lane = tid & 63, wid = tid >> 6;
  const int wm = wid >> 1, wn = wid & 1, fr = lane & 15, fq = lane >> 4;
  const int c4 = tid & 3, srow = tid >> 2;
  const int soff = (srow >> 4) * 1024 + swz_off(srow & 15, c4);
  const bf16_t* Ag = A + (size_t)(row0 + srow) * lda + c4 * 8;
  const bf16_t* Bg = Bt + (size_t)(col0 + srow) * ldb + c4 * 8;
  const int aoff = wm * 8192 + swz_off(fr, fq);
  const int boff = 16384 + wn * 4096 + swz_off(fr, fq);
  u32x4 ra[4], rb[2];
#pragma unroll
  for (int i = 0; i < 4; ++i) ra[i] = *(const u32x4*)(Ag + (size_t)(i * 64) * lda);
#pragma unroll
  for (int i = 0; i < 2; ++i) rb[i] = *(const u32x4*)(Bg + (size_t)(i * 64) * ldb);
#pragma unroll
  for (int i = 0; i < 4; ++i) *(u32x4*)(smem + soff + i * 4096) = ra[i];
#pragma unroll
  for (int i = 0; i < 2; ++i) *(u32x4*)(smem + 16384 + soff + i * 4096) = rb[i];
  __syncthreads();
  const int nk = K >> 5;
  for (int kt = 0; kt < nk; ++kt) {
    const bool more = (kt + 1) < nk;
    if (more) {
      const int k1 = (kt + 1) * 32;
#pragma unroll
      for (int i = 0; i < 4; ++i) ra[i] = *(const u32x4*)(Ag + (size_t)(i * 64) * lda + k1);
#pragma unroll
      for (int i = 0; i < 2; ++i) rb[i] = *(const u32x4*)(Bg + (size_t)(i * 64) * ldb + k1);
    }
    asm volatile("" ::: "memory");
    const char* sb = smem + (kt & 1) * G2_STAGE;
    bf16x8 bfr[4];
#pragma unroll
    for (int ni = 0; ni < 4; ++ni) bfr[ni] = *(const bf16x8*)(sb + boff + ni * 1024);
#pragma unroll
    for (int mi = 0; mi < 8; ++mi) {
      bf16x8 af = *(const bf16x8*)(sb + aoff + mi * 1024);
#pragma unroll
      for (int ni = 0; ni < 4; ++ni) acc[mi][ni] = MFMA16(bfr[ni], af, acc[mi][ni]);
    }
    __builtin_amdgcn_sched_barrier(0);
    if (more) {
      char* db = smem + ((kt + 1) & 1) * G2_STAGE;
#pragma unroll
      for (int i = 0; i < 4; ++i) *(u32x4*)(db + soff + i * 4096) = ra[i];
#pragma unroll
      for (int i = 0; i < 2; ++i) *(u32x4*)(db + 16384 + soff + i * 4096) = rb[i];
    }
    __syncthreads();
  }
}

constexpr int CST_B = 272;
constexpr int CST_T = 528;
template <int MI, int NI, class F>
DI void stage_rowmajor(char* smem, f32x4 (&acc)[MI][NI], int wm, int wn, int fr, int fq, F&& tf) {
#pragma unroll
  for (int mi = 0; mi < MI; ++mi)
#pragma unroll
    for (int ni = 0; ni < NI; ++ni) {
      f32x4 v = tf(acc[mi][ni]);
      *(bf16x4*)(smem + (wm * MI * 16 + mi * 16 + fr) * CST_B + (wn * NI * 16 + ni * 16 + fq * 4) * 2) = pack4(v[0], v[1], v[2], v[3]);
      if (ni == NI - 1) __builtin_amdgcn_sched_barrier(0);
    }
}
template <int MI, int NI, class F>
DI void stage_transposed(char* smem, f32x4 (&acc)[MI][NI], int wm, int wn, int fr, int fq, F&& tf) {
#pragma unroll
  for (int mi = 0; mi < MI; ++mi)
#pragma unroll
    for (int ni = 0; ni < NI; ++ni) {
      f32x4 v = tf(acc[mi][ni]);
      char* base = smem + (wn * NI * 16 + ni * 16 + fq * 4) * CST_T + (wm * MI * 16 + mi * 16 + fr) * 2;
      *(bf16_t*)(base) = f2bf(v[0]);
      *(bf16_t*)(base + CST_T) = f2bf(v[1]);
      *(bf16_t*)(base + 2 * CST_T) = f2bf(v[2]);
      *(bf16_t*)(base + 3 * CST_T) = f2bf(v[3]);
      if (ni == NI - 1) __builtin_amdgcn_sched_barrier(0);
    }
}
template <int LINES, int CPL, int STRIDE, class D>
DI void writeout(const char* smem, int tid, D&& dst) {
#pragma unroll 4
  for (int j = 0; j < LINES * CPL / 256; ++j) {
    const int id = tid + j * 256, line = id / CPL, c = id % CPL;
    u32x4 v = *(const u32x4*)(smem + line * STRIDE + c * 16);
    *(u32x4*)dst(line, c) = v;
  }
}

DI void stage_rowmajor_rope(char* smem, f32x4 (&acc)[8][4], int wm, int wn, int fr, int fq, int rtok) {
  float inv[4];
#pragma unroll
  for (int i = 0; i < 4; ++i) inv[i] = exp2f(-(float)(fq * 4 + i) * 0.8304820237218406f);
#pragma unroll
  for (int mi = 0; mi < 8; ++mi) {
    const int t = (rtok + mi * 16 - NCTX) & 2047;
    const float gr = (float)(t >> 6), gc = (float)(t & 63);
    f32x4 o0, o1, o2, o3;
#pragma unroll
    for (int i = 0; i < 4; ++i) {
      const float sr = __sinf(gr * inv[i]), cr = __cosf(gr * inv[i]);
      const float sc = __sinf(gc * inv[i]), cc = __cosf(gc * inv[i]);
      const float a0 = acc[mi][0][i], a1 = acc[mi][1][i], a2 = acc[mi][2][i], a3 = acc[mi][3][i];
      o0[i] = a0 * cr - a1 * sr;
      o1[i] = a1 * cr + a0 * sr;
      o2[i] = a2 * cc - a3 * sc;
      o3[i] = a3 * cc + a2 * sc;
    }
    char* base = smem + (wm * 128 + mi * 16 + fr) * CST_B + (wn * 64 + fq * 4) * 2;
    *(bf16x4*)(base) = pack4(o0[0], o0[1], o0[2], o0[3]);
    *(bf16x4*)(base + 32) = pack4(o1[0], o1[1], o1[2], o1[3]);
    *(bf16x4*)(base + 64) = pack4(o2[0], o2[1], o2[2], o2[3]);
    *(bf16x4*)(base + 96) = pack4(o3[0], o3[1], o3[2], o3[3]);
    __builtin_amdgcn_sched_barrier(0);
  }
}

DI void epi_in(const P& p, int l, int row0, int col0, f32x4 (&acc)[8][4], char* smem) {
  const int tid_ = otid(), lane = tid_ & 63, wid = tid_ >> 6, wm = wid >> 1, wn = wid & 1, fr = lane & 15, fq = lane >> 4;
  const int seg = col0 >> 9;
  const bool ctx = row0 < NCTX;
  if (seg >= 12) {
    bf16_t* GF = (bf16_t*)(p.ws + WS_GF);
    const int k = (seg - 12) >> 1, tn = ((col0 - 6144) & 1023) >> 7, tm = row0 >> 8;
    bf16_t* dst = GF + (((size_t)k * 64 + tm) * 8 + tn) * 32768 + tid_ * 4;
#pragma unroll
    for (int mi = 0; mi < 8; ++mi)
#pragma unroll
      for (int ni = 0; ni < 4; ++ni)
        *(bf16x4*)(dst + (mi * 4 + ni) * 1024) = pack4(sigmoidf_(acc[mi][ni][0]), sigmoidf_(acc[mi][ni][1]), sigmoidf_(acc[mi][ni][2]), sigmoidf_(acc[mi][ni][3]));
    return;
  }
  const int ctile = col0 & 511;
  const int cseg0 = ctile + wn * 64;
  const int rtok = row0 + wm * 128 + fr;
  if (ctx && (seg == 1 || seg == 2 || seg == 4 || seg == 5)) {
    float* out = p.out;
#pragma unroll
    for (int mi = 0; mi < 8; ++mi) {
      const int r = rtok + mi * 16, b = r >> 8, t = r & 255;
      size_t off;
      if (seg == 1 || seg == 2) {
        const int h = cseg0 >> 6;
        off = (seg == 1 ? O_NAK : O_NAV) + (((size_t)(b * 4 + l) * 8 + h) * 256 + t) * 64;
      } else if (seg == 4) {
        const int comp = cseg0 >> 8, h = (cseg0 >> 6) & 3;
        off = O_DFK + ((((size_t)(b * 4 + l) * 2 + comp) * 4 + h) * 256 + t) * 64;
      } else {
        const int h = cseg0 >> 7;
        off = O_DFV + (((size_t)(b * 4 + l) * 4 + h) * 256 + t) * 128 + (cseg0 & 127);
      }
#pragma unroll
      for (int ni = 0; ni < 4; ++ni) *(f32x4*)(out + off + ni * 16 + fq * 4) = acc[mi][ni];
      __builtin_amdgcn_sched_barrier(0);
    }
  }
  auto tf_none = [](const f32x4& a) -> f32x4 { return a; };
  auto tf_scale = [](const f32x4& a) -> f32x4 { return f32x4{a[0] * 0.125f, a[1] * 0.125f, a[2] * 0.125f, a[3] * 0.125f}; };
  auto tf_silu = [](const f32x4& a) -> f32x4 { return f32x4{a[0] * sigmoidf_(a[0]), a[1] * sigmoidf_(a[1]), a[2] * sigmoidf_(a[2]), a[3] * sigmoidf_(a[3])}; };
  auto tf_gelu = [](const f32x4& a) -> f32x4 { return f32x4{gelu_tanh(a[0]), gelu_tanh(a[1]), gelu_tanh(a[2]), gelu_tanh(a[3])}; };
  const bool rowmajor = !(seg == 2 || seg == 5 || seg == 8 || seg == 11);
  if (rowmajor) {
    int zc;
    switch (seg) {
      case 0: zc = ZC_NAQ; break;
      case 1: zc = ZC_NAK; break;
      case 3: zc = ZC_DFQ; break;
      case 4: zc = ZC_DFK; break;
      case 6: zc = ZC_RTQ; break;
      case 7: zc = ZC_RTK; break;
      case 9: zc = ZC_RTG; break;
      default: zc = ZC_LRX; break;
    }
    if (!ctx && (seg == 3 || seg == 4)) stage_rowmajor_rope(smem, acc, wm, wn, fr, fq, rtok);
    else if (seg == 7) stage_rowmajor<8, 4>(smem, acc, wm, wn, fr, fq, tf_scale);
    else if (seg == 9) stage_rowmajor<8, 4>(smem, acc, wm, wn, fr, fq, tf_silu);
    else stage_rowmajor<8, 4>(smem, acc, wm, wn, fr, fq, tf_none);
    __syncthreads();
    bf16_t* zb = (bf16_t*)(p.ws + WS_Z) + (size_t)row0 * ZLD + zc + ctile;
    writeout<256, 16, CST_B>(smem, tid_, [&](int line, int c) { return zb + (size_t)line * ZLD + c * 8; });
    __syncthreads();
  }
  if (!rowmajor || (seg == 7 && ctx)) {
    if (seg == 7) stage_transposed<8, 4>(smem, acc, wm, wn, fr, fq, tf_scale);
    else if (seg == 11) stage_transposed<8, 4>(smem, acc, wm, wn, fr, fq, tf_gelu);
    else stage_transposed<8, 4>(smem, acc, wm, wn, fr, fq, tf_none);
    __syncthreads();
    if (seg == 11) {
      bf16_t* lg = (bf16_t*)(p.ws + WS_LG) + ((size_t)(row0 >> 6) * 512 + ctile) * 64;
      writeout<128, 32, CST_T>(smem, tid_, [&](int line, int c) { return lg + ((size_t)(c >> 3) * 512 + line) * 64 + (c & 7) * 8; });
    } else {
      bf16_t* tb = (bf16_t*)(p.ws + (seg == 2 ? WS_VTNA : seg == 5 ? WS_VTDF : seg == 8 ? WS_VTRT : WS_KTRT));
      int T;
      if (ctx) { T = 256; tb += ((size_t)((row0 >> 8) * 512 + ctile)) * 256 + (row0 & 255); }
      else { const int rr = row0 - NCTX; T = 2048; tb += (size_t)VT_LAT + ((size_t)((rr >> 11) * 512 + ctile)) * 2048 + (rr & 2047); }
      writeout<128, 32, CST_T>(smem, tid_, [&](int line, int c) { return tb + (size_t)line * T + c * 8; });
    }
    __syncthreads();
  }
}

DI void phase_gin(const P& p, int l, char* smem) {
  const bf16_t* A = (const bf16_t*)(p.ws + WS_H);
  const bf16_t* Bt = (const bf16_t*)(p.ws + WS_WIN);
  for (int it = 0;; ++it) {
    int tm, tn;
    if (!tile_sched(it, 64, 80, tm, tn)) break;
    f32x4 acc[8][4];
    zero_acc2(acc);
    gemm2_mainloop(A, 1024, Bt, 1024, 1024, tm * 256, tn * 128, smem, acc);
    epi_in(p, l, tm * 256, tn * 128, acc, smem);
  }
}

DI void phase_merge(const P& p, char* smem) {
  const bf16_t* Y4 = (const bf16_t*)(p.ws + WS_Y4);
  const bf16_t* WB = (const bf16_t*)(p.ws + WS_WBR);
  const bf16_t* GF = (const bf16_t*)(p.ws + WS_GF);
  bf16_t* G = (bf16_t*)(p.ws + WS_H);
  const int tid_ = otid(), lane = tid_ & 63, wid = tid_ >> 6, wm = wid >> 1, wn = wid & 1, fr = lane & 15, fq = lane >> 4;
  for (int it = 0;; ++it) {
    int tm, t64;
    if (!tile_sched(it, 128, 16, tm, t64)) break;
    const int row0 = tm * 128, col0 = t64 * 64;
    f32x4 o[4][2];
#pragma unroll
    for (int mi = 0; mi < 4; ++mi) { o[mi][0] = f32x4{0.f, 0.f, 0.f, 0.f}; o[mi][1] = f32x4{0.f, 0.f, 0.f, 0.f}; }
#pragma unroll 1
    for (int k = 0; k < 4; ++k) {
      const bf16_t* gsrc = GF + (((size_t)k * 64 + (tm >> 1)) * 8 + (t64 >> 1)) * 32768 + (((tm & 1) * 2 + (t64 & 1)) * 64 + lane) * 4 +
                           ((wm * 4) * 4 + wn * 2) * 1024;
      bf16x4 gq[4][2];
#pragma unroll
      for (int mi = 0; mi < 4; ++mi) { gq[mi][0] = *(const bf16x4*)(gsrc + (mi * 4) * 1024); gq[mi][1] = *(const bf16x4*)(gsrc + (mi * 4 + 1) * 1024); }
      f32x4 acc[4][2];
#pragma unroll
      for (int mi = 0; mi < 4; ++mi) { acc[mi][0] = f32x4{0.f, 0.f, 0.f, 0.f}; acc[mi][1] = f32x4{0.f, 0.f, 0.f, 0.f}; }
      gemm_mainloop<2>(Y4 + k * 512, 2048, WB + k * 512, 2048, 512, row0, col0, smem, acc);
#pragma unroll
      for (int mi = 0; mi < 4; ++mi)
#pragma unroll
        for (int nj = 0; nj < 2; ++nj)
#pragma unroll
          for (int i = 0; i < 4; ++i) o[mi][nj][i] += bfs2f(gq[mi][nj][i]) * acc[mi][nj][i];
    }
    stage_rowmajor<4, 2>(smem, o, wm, wn, fr, fq, [](const f32x4& a) { return a; });
    __syncthreads();
    bf16_t* gb = G + (size_t)row0 * 1024 + col0;
    writeout<128, 8, CST_B>(smem, tid_, [&](int line, int c) { return gb + (size_t)line * 1024 + c * 8; });
    __syncthreads();
  }
}

template <int MODE>
DI void phase_gemm_plain(const bf16_t* A, int K, const bf16_t* Bt, int N, bf16_t* outp, char* smem) {
  const int tid_ = otid(), lane = tid_ & 63, wid = tid_ >> 6, wm = wid >> 1, wn = wid & 1, fr = lane & 15, fq = lane >> 4;
  const int ntn = N / 128;
  for (int it = 0;; ++it) {
    int tm, tn;
    if (!tile_sched(it, 64, ntn, tm, tn)) break;
    const int row0 = tm * 256, col0 = tn * 128;
    f32x4 acc[8][4];
    zero_acc2(acc);
    gemm2_mainloop(A, K, Bt, K, K, row0, col0, smem, acc);
    stage_rowmajor<8, 4>(smem, acc, wm, wn, fr, fq, [](const f32x4& a) {
      f32x4 v = a;
      if (MODE == 1) {
        v[0] = fmaxf(v[0], 0.f); v[1] = fmaxf(v[1], 0.f); v[2] = fmaxf(v[2], 0.f); v[3] = fmaxf(v[3], 0.f);
        v[0] *= v[0]; v[1] *= v[1]; v[2] *= v[2]; v[3] *= v[3];
      }
      return v;
    });
    __syncthreads();
    bf16_t* ob = outp + (size_t)row0 * N + col0;
    writeout<256, 16, CST_B>(smem, tid_, [&](int line, int c) { return ob + (size_t)line * N + c * 8; });
    __syncthreads();
  }
}

DI void phase_mod(const P& p, char* smem) {
  float* ssil = (float*)smem;
  float* red = ssil + 5 * 1024;
  const int tid = otid();
  float* MOD = (float*)(p.ws + WS_MOD);
  for (int idx = tid; idx < 5120; idx += 256) {
    int j = idx >> 10, k = idx & 1023;
    float cv = (j == 0) ? p.in[11][k] : p.in[10][(j - 1) * 1024 + k];
    ssil[idx] = cv / (1.f + expf(-cv));
  }
  __syncthreads();
  const int cl = tid & 63, kg = tid >> 6;
  for (int item = blockIdx.x; item < 384; item += gridDim.x) {
    int l = item / 96, cgp = item % 96;
    int col = cgp * 64 + cl;
    const float* W = p.in[12] + (size_t)l * 1024 * 6144 + col;
    float a0 = 0, a1 = 0, a2 = 0, a3 = 0, a4 = 0;
    for (int k = kg * 256; k < kg * 256 + 256; ++k) {
      float w = W[(size_t)k * 6144];
      a0 += ssil[k] * w;
      a1 += ssil[1024 + k] * w;
      a2 += ssil[2048 + k] * w;
      a3 += ssil[3072 + k] * w;
      a4 += ssil[4096 + k] * w;
    }
    red[(kg * 5 + 0) * 64 + cl] = a0;
    red[(kg * 5 + 1) * 64 + cl] = a1;
    red[(kg * 5 + 2) * 64 + cl] = a2;
    red[(kg * 5 + 3) * 64 + cl] = a3;
    red[(kg * 5 + 4) * 64 + cl] = a4;
    __syncthreads();
    if (kg == 0) {
      float bias = p.in[13][l * 6144 + col];
#pragma unroll
      for (int j = 0; j < 5; ++j) {
        float s = red[(0 * 5 + j) * 64 + cl] + red[(1 * 5 + j) * 64 + cl] + red[(2 * 5 + j) * 64 + cl] + red[(3 * 5 + j) * 64 + cl];
        MOD[(size_t)(l * 5 + j) * 6144 + col] = s + bias;
      }
    }
    __syncthreads();
  }
}

DI void transpose_tile(const float* __restrict__ src, int lds_, bf16_t* __restrict__ dst, int ldd, float* tile) {
  const int tid = otid();
#pragma unroll 4
  for (int i = 0; i < 16; ++i) {
    int idx = tid + i * 256, r = idx >> 6, c = idx & 63;
    tile[r * 65 + c] = src[(size_t)r * lds_ + c];
  }
  __syncthreads();
#pragma unroll 4
  for (int i = 0; i < 16; ++i) {
    int idx = tid + i * 256, c = idx >> 6, r = idx & 63;
    dst[(size_t)c * ldd + r] = f2bf(tile[r * 65 + c]);
  }
  __syncthreads();
}

DI void phase_convert(const P& p, int l, char* smem) {
  float* tile = (float*)smem;
  char* ws = p.ws;
  const int NJ = 6432;
  for (int j = blockIdx.x; j < NJ; j += gridDim.x) {
    int q = j;
    if (q < 2560) {
      int tr = q / 160, tc = q % 160;
      transpose_tile(p.in[18] + (size_t)l * 1024 * 10240 + (size_t)tr * 64 * 10240 + tc * 64, 10240,
                     (bf16_t*)(ws + WS_WIN) + (size_t)tc * 64 * 1024 + tr * 64, 1024, tile);
      continue;
    }
    q -= 2560;
    if (q < 512) {
      int tr = q / 16, tc = q % 16;
      transpose_tile(p.in[40] + (size_t)l * 2048 * 1024 + (size_t)tr * 64 * 1024 + tc * 64, 1024,
                     (bf16_t*)(ws + WS_WBR) + (size_t)tc * 64 * 2048 + tr * 64, 2048, tile);
      continue;
    }
    q -= 512;
    if (q < 256) {
      int tr = q / 16, tc = q % 16;
      transpose_tile(p.in[41] + (size_t)l * 1024 * 1024 + (size_t)tr * 64 * 1024 + tc * 64, 1024,
                     (bf16_t*)(ws + WS_WOUT) + (size_t)tc * 64 * 1024 + tr * 64, 1024, tile);
      continue;
    }
    q -= 256;
    if (q < 1024) {
      int tr = q / 64, tc = q % 64;
      transpose_tile(p.in[42] + (size_t)l * 1024 * 4096 + (size_t)tr * 64 * 4096 + tc * 64, 4096,
                     (bf16_t*)(ws + WS_W1) + (size_t)tc * 64 * 1024 + tr * 64, 1024, tile);
      continue;
    }
    q -= 1024;
    if (q < 1024) {
      int tr = q / 16, tc = q % 16;
      transpose_tile(p.in[43] + (size_t)l * 4096 * 1024 + (size_t)tr * 64 * 1024 + tc * 64, 1024,
                     (bf16_t*)(ws + WS_W2) + (size_t)tc * 64 * 4096 + tr * 64, 4096, tile);
      continue;
    }
    q -= 1024;
    if (q < 32) {
      int type = q >> 3, n = q & 7;
      const float* src = (type == 0 ? p.in[30] : type == 1 ? p.in[32] : type == 2 ? p.in[35] : p.in[37]) + (size_t)(l * 8 + n) * 4096;
      transpose_tile(src, 64, (bf16_t*)(ws + WS_WLRU) + (size_t)(type * 8 + n) * 4096, 64, tile);
      continue;
    }
    q -= 32;
    if (q < 256) {
      int bh = q >> 3, tr = q & 7, b = bh >> 3, h = bh & 7;
      transpose_tile(p.in[3] + ((size_t)((b * 4 + l) * 8 + h)) * 32768 + (size_t)tr * 64 * 64, 64,
                     (bf16_t*)(ws + WS_CVNA) + (size_t)bh * 32768 + tr * 64, 512, tile);
      continue;
    }
    q -= 256;
    if (q < 256) {
      int bh = q >> 4, t2 = q & 15, tr = t2 >> 1, tc = t2 & 1, b = bh >> 2, h = bh & 3;
      transpose_tile(p.in[5] + ((size_t)((b * 4 + l) * 4 + h)) * 65536 + (size_t)tr * 64 * 128 + tc * 64, 128,
                     (bf16_t*)(ws + WS_CVDF) + (size_t)bh * 65536 + (size_t)tc * 64 * 512 + tr * 64, 512, tile);
      continue;
    }
    q -= 256;
    {
      int tensor = q >> 8, b = (q >> 6) & 3, chunk = q & 63;
      const float* src = (tensor == 0 ? p.in[2] : p.in[4]) + (size_t)(b * 4 + l) * 262144 + (size_t)chunk * 4096;
      bf16_t* dst = (bf16_t*)(ws + (tensor == 0 ? WS_CKNA : WS_CKDF)) + (size_t)b * 262144 + (size_t)chunk * 4096;
#pragma unroll
      for (int i = 0; i < 4; ++i) {
        int e = (otid() + i * 256) * 4;
        float4 v = *(const float4*)(src + e);
        *(bf16x4*)(dst + e) = pack4(v.x, v.y, v.z, v.w);
      }
    }
  }
}

DI void phase_row(const P& p, int l, int mode) {
  const int tid_ = otid(), lane = tid_ & 63, wid = tid_ >> 6;
  const float* MOD = (const float*)(p.ws + WS_MOD);
  float* X = p.out;
  bf16_t* H = (bf16_t*)(p.ws + WS_H);
  const bf16_t* Y = (const bf16_t*)(p.ws + WS_Y);
  const bool from_inputs = (mode == 0 || (mode == 1 && l == 0));
  auto xsrc = [&](int r) -> const float* {
    return from_inputs ? ((r < NCTX) ? (p.in[0] + (size_t)r * D) : (p.in[1] + (size_t)(r - NCTX) * D)) : (X + (size_t)r * D);
  };
  int rb = blockIdx.x;
  if (rb >= 4096) return;
  float4 xn[4];
  bf16x4 yn[4];
  {
    const int r = rb * 4 + wid;
    const float* xs = xsrc(r);
#pragma unroll
    for (int j = 0; j < 4; ++j) xn[j] = *(const float4*)(xs + j * 256 + lane * 4);
    if (mode != 0) {
#pragma unroll
      for (int j = 0; j < 4; ++j) yn[j] = *(const bf16x4*)(Y + (size_t)r * D + j * 256 + lane * 4);
    }
  }
  for (; rb < 4096; rb += gridDim.x) {
    const int r = rb * 4 + wid;
    const int mi = r < NCTX ? 0 : 1 + ((r - NCTX) >> 11);
    float4 xv[4], yv[4];
#pragma unroll
    for (int j = 0; j < 4; ++j) { xv[j] = xn[j]; yv[j] = make_float4(bfs2f(yn[j][0]), bfs2f(yn[j][1]), bfs2f(yn[j][2]), bfs2f(yn[j][3])); }
    {
      const int rbn = (rb + (int)gridDim.x < 4096) ? rb + (int)gridDim.x : rb;
      const int rn = rbn * 4 + wid;
      const float* xs = xsrc(rn);
#pragma unroll
      for (int j = 0; j < 4; ++j) xn[j] = *(const float4*)(xs + j * 256 + lane * 4);
      if (mode != 0) {
#pragma unroll
        for (int j = 0; j < 4; ++j) yn[j] = *(const bf16x4*)(Y + (size_t)rn * D + j * 256 + lane * 4);
      }
    }
    if (mode != 0) {
      float ss = 0.f;
#pragma unroll
      for (int j = 0; j < 4; ++j) ss += yv[j].x * yv[j].x + yv[j].y * yv[j].y + yv[j].z * yv[j].z + yv[j].w * yv[j].w;
      ss = wave_sum(ss);
      const float rs = rsqrtf(ss * (1.f / 1024.f) + 1e-6f);
      const float* gpost = (mode == 1 ? p.in[15] : p.in[17]) + l * D;
      const float* gate = MOD + (size_t)(l * 5 + mi) * 6144 + (mode == 1 ? 2048 : 5120);
#pragma unroll
      for (int j = 0; j < 4; ++j) {
        float4 g = *(const float4*)(gpost + j * 256 + lane * 4);
        float4 gt = *(const float4*)(gate + j * 256 + lane * 4);
        xv[j].x += gt.x * (yv[j].x * rs * g.x);
        xv[j].y += gt.y * (yv[j].y * rs * g.y);
        xv[j].z += gt.z * (yv[j].z * rs * g.z);
        xv[j].w += gt.w * (yv[j].w * rs * g.w);
        *(float4*)(X + (size_t)r * D + j * 256 + lane * 4) = xv[j];
      }
    }
    int ln, off_sh, off_sc;
    const float* gpre;
    if (mode == 0) { ln = 0; gpre = p.in[14]; off_sh = 0; off_sc = 1024; }
    else if (mode == 1) { ln = l; gpre = p.in[16] + l * D; off_sh = 3072; off_sc = 4096; }
    else { ln = l + 1; gpre = p.in[14] + (l + 1) * D; off_sh = 0; off_sc = 1024; }
    if (ln < 4) {
      float ss = 0.f;
#pragma unroll
      for (int j = 0; j < 4; ++j) ss += xv[j].x * xv[j].x + xv[j].y * xv[j].y + xv[j].z * xv[j].z + xv[j].w * xv[j].w;
      ss = wave_sum(ss);
      const float rs = rsqrtf(ss * (1.f / 1024.f) + 1e-6f);
      const float* mrow = MOD + (size_t)(ln * 5 + mi) * 6144;
#pragma unroll
      for (int j = 0; j < 4; ++j) {
        int c = j * 256 + lane * 4;
        float4 g = *(const float4*)(gpre + c);
        float4 sc = *(const float4*)(mrow + off_sc + c);
        float4 sh = *(const float4*)(mrow + off_sh + c);
        *(bf16x4*)(H + (size_t)r * D + c) = pack4(xv[j].x * rs * g.x * (1.f + sc.x) + sh.x, xv[j].y * rs * g.y * (1.f + sc.y) + sh.y,
                                                  xv[j].z * rs * g.z * (1.f + sc.z) + sh.z, xv[j].w * rs * g.w * (1.f + sc.w) + sh.w);
      }
    }
  }
}

constexpr int ATT_BUF = 192 * LDT;
DI void qk_scores(const bf16x8 (&qf)[2], const bf16_t* sK, f32x4 (&S)[4], int fr, int fq) {
#pragma unroll
  for (int s = 0; s < 4; ++s) {
    f32x4 z = {0.f, 0.f, 0.f, 0.f};
#pragma unroll
    for (int ks = 0; ks < 2; ++ks) {
      bf16x8 a = *(const bf16x8*)(sK + (16 * s + fr) * LDT + ks * 32 + fq * 8);
      z = MFMA16(a, qf[ks], z);
    }
    S[s] = z;
  }
}
template <int DV>
DI void pv_step(const bf16x8 (&pb)[2], const bf16_t* sV, f32x4 (&O)[DV / 16], int fr, int fq) {
#pragma unroll
  for (int dt = 0; dt < DV / 16; ++dt) {
#pragma unroll
    for (int s2 = 0; s2 < 2; ++s2) {
      const bf16_t* base = sV + (dt * 16 + fr) * LDT + 32 * s2 + 4 * fq;
      bf16x4 lo = *(const bf16x4*)base;
      bf16x4 hi = *(const bf16x4*)(base + 16);
      bf16x8 a = __builtin_shufflevector(lo, hi, 0, 1, 2, 3, 4, 5, 6, 7);
      O[dt] = MFMA16(a, pb[s2], O[dt]);
    }
  }
}
template <int DV>
DI void softmax_pv(f32x4 (&S)[4], const bf16_t* sV, f32x4 (&O)[DV / 16], float& m, float& lsum, int fr, int fq) {
  float tm = -1e30f;
#pragma unroll
  for (int s = 0; s < 4; ++s)
#pragma unroll
    for (int i = 0; i < 4; ++i) tm = fmaxf(tm, S[s][i]);
  tm = fmaxf(tm, __shfl_xor(tm, 16));
  tm = fmaxf(tm, __shfl_xor(tm, 32));
  const float mn = fmaxf(m, tm);
  const float alpha = __expf(m - mn);
  m = mn;
  float ps = 0.f;
#pragma unroll
  for (int s = 0; s < 4; ++s)
#pragma unroll
    for (int i = 0; i < 4; ++i) {
      float pv = __expf(S[s][i] - mn);
      S[s][i] = pv;
      ps += pv;
    }
  lsum = lsum * alpha + ps;
#pragma unroll
  for (int dt = 0; dt < DV / 16; ++dt) {
    O[dt][0] *= alpha; O[dt][1] *= alpha; O[dt][2] *= alpha; O[dt][3] *= alpha;
  }
  bf16x8 pb[2];
  pb[0] = pack8(S[0], S[1]);
  pb[1] = pack8(S[2], S[3]);
  pv_step<DV>(pb, sV, O, fr, fq);
}
template <int DV, bool SOFTMAX, class TileFn, class ScoreFn>
DI void attn_loop(int ntiles, TileFn&& tile, ScoreFn&& score, const bf16x8 (&qf)[2], f32x4 (&O)[DV / 16], float& m, float& lsum,
                  bf16_t* smem, int tid) {
  const int lane = tid & 63, fr = lane & 15, fq = lane >> 4;
  u32x4 rk[2], rv[DV / 32];
  auto gload = [&](int j) {
    const bf16_t* Kg; const bf16_t* Vg; int ldk, ldv;
    tile(j, Kg, ldk, Vg, ldv);
#pragma unroll
    for (int i = 0; i < 2; ++i) {
      int id = tid + i * 256, r = id >> 3, c = (id & 7) * 8;
      rk[i] = *(const u32x4*)(Kg + (size_t)r * ldk + c);
    }
#pragma unroll
    for (int i = 0; i < DV / 32; ++i) {
      int id = tid + i * 256, r = id >> 3, c = (id & 7) * 8;
      rv[i] = *(const u32x4*)(Vg + (size_t)r * ldv + c);
    }
  };
  auto sstore = [&](int buf) {
    bf16_t* sK = smem + buf * ATT_BUF;
    bf16_t* sV = sK + 64 * LDT;
#pragma unroll
    for (int i = 0; i < 2; ++i) {
      int id = tid + i * 256, r = id >> 3, c = (id & 7) * 8;
      *(u32x4*)(sK + r * LDT + c) = rk[i];
    }
#pragma unroll
    for (int i = 0; i < DV / 32; ++i) {
      int id = tid + i * 256, r = id >> 3, c = (id & 7) * 8;
      *(u32x4*)(sV + r * LDT + c) = rv[i];
    }
  };
  gload(0);
  sstore(0);
  __syncthreads();
  for (int j = 0; j < ntiles; ++j) {
    const int jn = (j + 1 < ntiles) ? j + 1 : j;
    gload(jn);
    asm volatile("" ::: "memory");
    const bf16_t* sK = smem + (j & 1) * ATT_BUF;
    const bf16_t* sV = sK + 64 * LDT;
    f32x4 S[4];
    qk_scores(qf, sK, S, fr, fq);
    score(j, S);
    if (SOFTMAX) {
      softmax_pv<DV>(S, sV, O, m, lsum, fr, fq);
    } else {
      bf16x8 pb[2];
      pb[0] = pack8(S[0], S[1]);
      pb[1] = pack8(S[2], S[3]);
      pv_step<DV>(pb, sV, O, fr, fq);
    }
    sstore((j + 1) & 1);
    __syncthreads();
  }
}
DI void scale_scores(f32x4 (&S)[4]) {
#pragma unroll
  for (int s = 0; s < 4; ++s) { S[s][0] *= 0.125f; S[s][1] *= 0.125f; S[s][2] *= 0.125f; S[s][3] *= 0.125f; }
}

DI void dense_item(const P& p, int b, int h, int qb, char* smem) {
  const int tid = otid(), lane = tid & 63, wid = tid >> 6, fr = lane & 15, fq = lane >> 4;
  const bf16_t* Z = (const bf16_t*)(p.ws + WS_Z);
  const bf16_t* VT = (const bf16_t*)(p.ws + WS_VTNA) + (size_t)(b * 512 + h * 64) * 256;
  bf16_t* Y4 = (bf16_t*)(p.ws + WS_Y4);
  const int rowbase = b * 256;
  const int qrow = rowbase + qb * 64 + wid * 16 + fr;
  bf16x8 qf[2];
#pragma unroll
  for (int ks = 0; ks < 2; ++ks) qf[ks] = *(const bf16x8*)(Z + (size_t)qrow * ZLD + ZC_NAQ + h * 64 + ks * 32 + fq * 8);
  f32x4 O[4];
#pragma unroll
  for (int dt = 0; dt < 4; ++dt) O[dt] = f32x4{0.f, 0.f, 0.f, 0.f};
  float m = -1e30f, lsum = 0.f;
  const bf16_t* Kb = Z + (size_t)rowbase * ZLD + ZC_NAK + h * 64;
  attn_loop<64, true>(4,
      [&](int j, const bf16_t*& Kg, int& ldk, const bf16_t*& Vg, int& ldv) { Kg = Kb + (size_t)j * 64 * ZLD; ldk = ZLD; Vg = VT + j * 64; ldv = 256; },
      [&](int, f32x4 (&S)[4]) { scale_scores(S); }, qf, O, m, lsum, (bf16_t*)smem, tid);
  float lt = lsum + __shfl_xor(lsum, 16);
  lt += __shfl_xor(lt, 32);
  const float inv = 1.f / lt;
#pragma unroll
  for (int dt = 0; dt < 4; ++dt)
    *(bf16x4*)(Y4 + (size_t)qrow * 2048 + h * 64 + dt * 16 + fq * 4) = pack4(O[dt][0] * inv, O[dt][1] * inv, O[dt][2] * inv, O[dt][3] * inv);
}

DI void na_item(const P& p, int l, int b, int h, int r, char* smem) {
  float* srpb = (float*)((bf16_t*)smem + 2 * ATT_BUF);
  const int tid = otid(), lane = tid & 63, wid = tid >> 6, fr = lane & 15, fq = lane >> 4;
  const bf16_t* Z = (const bf16_t*)(p.ws + WS_Z);
  const bf16_t* VT = (const bf16_t*)(p.ws + WS_VTNA) + VT_LAT + (size_t)(b * 512 + h * 64) * 2048;
  const bf16_t* CK = (const bf16_t*)(p.ws + WS_CKNA) + (size_t)(b * 8 + h) * 32768;
  const bf16_t* CVT = (const bf16_t*)(p.ws + WS_CVNA) + (size_t)(b * 8 + h) * 32768;
  bf16_t* Y4 = (bf16_t*)(p.ws + WS_Y4);
  for (int i = tid; i < 465; i += 256) srpb[i] = p.in[19][(size_t)(l * 8 + h) * 465 + i];
  const int rowbase = NCTX + b * 2048;
  const int qcol = wid * 16 + fr;
  const int qrow = rowbase + r * 64 + qcol;
  bf16x8 qf[2];
#pragma unroll
  for (int ks = 0; ks < 2; ++ks) qf[ks] = *(const bf16x8*)(Z + (size_t)qrow * ZLD + ZC_NAQ + h * 64 + ks * 32 + fq * 8);
  f32x4 O[4];
#pragma unroll
  for (int dt = 0; dt < 4; ++dt) O[dt] = f32x4{0.f, 0.f, 0.f, 0.f};
  float m = -1e30f, lsum = 0.f;
  int rs = r - 4;
  rs = rs < 0 ? 0 : (rs > 24 ? 24 : rs);
  int cstart = qcol - 8;
  cstart = cstart < 0 ? 0 : (cstart > 48 ? 48 : cstart);
  const bf16_t* Kb = Z + (size_t)rowbase * ZLD + ZC_NAK + h * 64;
  attn_loop<64, true>(16,
      [&](int j, const bf16_t*& Kg, int& ldk, const bf16_t*& Vg, int& ldv) {
        if (j < 8) { Kg = Kb + (size_t)(rs + j) * 64 * ZLD; ldk = ZLD; Vg = VT + (rs + j) * 64; ldv = 2048; }
        else { Kg = CK + (size_t)(j - 8) * 64 * 64; ldk = 64; Vg = CVT + (j - 8) * 64; ldv = 512; }
      },
      [&](int j, f32x4 (&S)[4]) {
        if (j < 8) {
          const int dr = rs + j - r + 7;
#pragma unroll
          for (int s = 0; s < 4; ++s)
#pragma unroll
            for (int i = 0; i < 4; ++i) {
              int kcol = s * 16 + fq * 4 + i;
              bool ok = (kcol >= cstart) && (kcol < cstart + 16);
              int dc = kcol - qcol + 15;
              dc = dc < 0 ? 0 : (dc > 30 ? 30 : dc);
              float bias = srpb[dr * 31 + dc];
              S[s][i] = ok ? (S[s][i] * 0.125f + bias) : -1e30f;
            }
        } else {
          scale_scores(S);
        }
      },
      qf, O, m, lsum, (bf16_t*)smem, tid);
  float lt = lsum + __shfl_xor(lsum, 16);
  lt += __shfl_xor(lt, 32);
  const float inv = 1.f / lt;
#pragma unroll
  for (int dt = 0; dt < 4; ++dt)
    *(bf16x4*)(Y4 + (size_t)qrow * 2048 + h * 64 + dt * 16 + fq * 4) = pack4(O[dt][0] * inv, O[dt][1] * inv, O[dt][2] * inv, O[dt][3] * inv);
}

DI void diff_item(const P& p, int l, bool latent, int b, int h, int qb, char* smem) {
  const int tid = otid(), lane = tid & 63, wid = tid >> 6, fr = lane & 15, fq = lane >> 4;
  const bf16_t* Z = (const bf16_t*)(p.ws + WS_Z);
  const int T = latent ? 2048 : 256;
  const int rowbase = latent ? NCTX + b * 2048 : b * 256;
  const bf16_t* VT = (const bf16_t*)(p.ws + WS_VTDF) + (latent ? (size_t)VT_LAT + (size_t)(b * 512 + h * 128) * 2048 : (size_t)(b * 512 + h * 128) * 256);
  const bf16_t* CVT = (const bf16_t*)(p.ws + WS_CVDF) + (size_t)(b * 4 + h) * 65536;
  bf16_t* Y4 = (bf16_t*)(p.ws + WS_Y4);
  const int qrow = rowbase + qb * 64 + wid * 16 + fr;
  float d1 = p.in[20][l * 64 + lane] * p.in[21][l * 64 + lane];
  float d2 = p.in[22][l * 64 + lane] * p.in[23][l * 64 + lane];
  d1 = wave_sum(d1);
  d2 = wave_sum(d2);
  const float lam_init = 0.8f - 0.6f * expf(-0.3f * (float)l);
  const float lam = expf(d1) - expf(d2) + lam_init;
  const int nown = T >> 6;
  const int ntiles = nown + (latent ? 8 : 0);

  f32x4 O1[8];
  f32x4 O[8];
#pragma unroll 1
  for (int comp = 0; comp < 2; ++comp) {
    bf16x8 qf[2];
#pragma unroll
    for (int ks = 0; ks < 2; ++ks) qf[ks] = *(const bf16x8*)(Z + (size_t)qrow * ZLD + ZC_DFQ + comp * 256 + h * 64 + ks * 32 + fq * 8);
#pragma unroll
    for (int dt = 0; dt < 8; ++dt) O[dt] = f32x4{0.f, 0.f, 0.f, 0.f};
    float m = -1e30f, lsum = 0.f;
    const bf16_t* Kb = Z + (size_t)rowbase * ZLD + ZC_DFK + comp * 256 + h * 64;
    const bf16_t* CK = (const bf16_t*)(p.ws + WS_CKDF) + (size_t)((b * 2 + comp) * 4 + h) * 32768;
    attn_loop<128, true>(ntiles,
        [&](int j, const bf16_t*& Kg, int& ldk, const bf16_t*& Vg, int& ldv) {
          if (j < nown) { Kg = Kb + (size_t)j * 64 * ZLD; ldk = ZLD; Vg = VT + j * 64; ldv = T; }
          else { Kg = CK + (size_t)(j - nown) * 64 * 64; ldk = 64; Vg = CVT + (j - nown) * 64; ldv = 512; }
        },
        [&](int, f32x4 (&S)[4]) { scale_scores(S); }, qf, O, m, lsum, (bf16_t*)smem, tid);
    float lt = lsum + __shfl_xor(lsum, 16);
    lt += __shfl_xor(lt, 32);
    const float inv = 1.f / lt;
    if (comp == 0) {
#pragma unroll
      for (int dt = 0; dt < 8; ++dt) { O1[dt][0] = O[dt][0] * inv; O1[dt][1] = O[dt][1] * inv; O1[dt][2] = O[dt][2] * inv; O1[dt][3] = O[dt][3] * inv; }
    } else {
#pragma unroll
      for (int dt = 0; dt < 8; ++dt) {
        O[dt][0] = O1[dt][0] - lam * (O[dt][0] * inv);
        O[dt][1] = O1[dt][1] - lam * (O[dt][1] * inv);
        O[dt][2] = O1[dt][2] - lam * (O[dt][2] * inv);
        O[dt][3] = O1[dt][3] - lam * (O[dt][3] * inv);
      }
    }
  }
  float ss = 0.f;
#pragma unroll
  for (int dt = 0; dt < 8; ++dt) ss += O[dt][0] * O[dt][0] + O[dt][1] * O[dt][1] + O[dt][2] * O[dt][2] + O[dt][3] * O[dt][3];
  ss += __shfl_xor(ss, 16);
  ss += __shfl_xor(ss, 32);
  const float rsn = rsqrtf(ss * (1.f / 128.f) + 1e-6f) * (1.f - lam_init);
  const float* gn = p.in[24] + l * 128;
#pragma unroll
  for (int dt = 0; dt < 8; ++dt) {
    int dv = dt * 16 + fq * 4;
    float4 g = *(const float4*)(gn + dv);
    *(bf16x4*)(Y4 + (size_t)qrow * 2048 + 512 + h * 128 + dv) = pack4(O[dt][0] * rsn * g.x, O[dt][1] * rsn * g.y, O[dt][2] * rsn * g.z, O[dt][3] * rsn * g.w);
  }
}

DI void ret_item(const P& p, int l, bool latent, int b, int h, int qb, char* smem) {
  bf16_t* sV0 = (bf16_t*)smem + 64 * LDT;
  const int tid = otid(), lane = tid & 63, wid = tid >> 6, fr = lane & 15, fq = lane >> 4;
  const bf16_t* Z = (const bf16_t*)(p.ws + WS_Z);
  const int T = latent ? 2048 : 256;
  const int rowbase = latent ? NCTX + b * 2048 : b * 256;
  const bf16_t* VT = (const bf16_t*)(p.ws + WS_VTRT) + (latent ? (size_t)VT_LAT + (size_t)(b * 512 + h * 64) * 2048 : (size_t)(b * 512 + h * 64) * 256);
  bf16_t* Y4 = (bf16_t*)(p.ws + WS_Y4);
  const int tq = qb * 64 + wid * 16 + fr;
  const int qrow = rowbase + tq;
  const float lgf = log1pf(-expf(p.in[25][l * 8 + h]));
  const float lgb = log1pf(-expf(p.in[26][l * 8 + h]));
  bf16x8 qf[2];
#pragma unroll
  for (int ks = 0; ks < 2; ++ks) qf[ks] = *(const bf16x8*)(Z + (size_t)qrow * ZLD + ZC_RTQ + h * 64 + ks * 32 + fq * 8);
  f32x4 O[4];
#pragma unroll
  for (int dt = 0; dt < 4; ++dt) O[dt] = f32x4{0.f, 0.f, 0.f, 0.f};
  float mdummy = 0.f, ldummy = 0.f;
  const bf16_t* Kb = Z + (size_t)rowbase * ZLD + ZC_RTK + h * 64;
  attn_loop<64, false>(T >> 6,
      [&](int j, const bf16_t*& Kg, int& ldk, const bf16_t*& Vg, int& ldv) { Kg = Kb + (size_t)j * 64 * ZLD; ldk = ZLD; Vg = VT + j * 64; ldv = T; },
      [&](int j, f32x4 (&S)[4]) {
#pragma unroll
        for (int s = 0; s < 4; ++s)
#pragma unroll
          for (int i = 0; i < 4; ++i) {
            int tk = j * 64 + s * 16 + fq * 4 + i;
            int dd = tq - tk;
            float w = dd >= 0 ? __expf(lgf * (float)dd) : __expf(lgb * (float)(-dd));
            S[s][i] *= w;
          }
      },
      qf, O, mdummy, ldummy, (bf16_t*)smem, tid);
  if (latent) {
    for (int dir = 0; dir < 2; ++dir) {
      const float* S0 = (dir == 0 ? p.in[6] : p.in[7]) + ((size_t)((b * 4 + l) * 8 + h)) * 4096;
#pragma unroll
      for (int i = 0; i < 4; ++i) {
        int e = (tid + i * 256) * 4;
        float4 v = *(const float4*)(S0 + e);
        int dk = e >> 6, dv = e & 63;
        sV0[(dv + 0) * LDT + dk] = f2bf(v.x);
        sV0[(dv + 1) * LDT + dk] = f2bf(v.y);
        sV0[(dv + 2) * LDT + dk] = f2bf(v.z);
        sV0[(dv + 3) * LDT + dk] = f2bf(v.w);
      }
      __syncthreads();
      const float sc = dir == 0 ? __expf(lgf * (float)(tq + 1)) : __expf(lgb * (float)(T - tq));
      bf16x8 pb[2];
#pragma unroll
      for (int s2 = 0; s2 < 2; ++s2) {
        const bf16_t* qp = Z + (size_t)qrow * ZLD + ZC_RTQ + h * 64 + 32 * s2 + 4 * fq;
        bf16x4 lo = *(const bf16x4*)qp;
        bf16x4 hi = *(const bf16x4*)(qp + 16);
        f32x4 flo = {bfs2f(lo[0]) * sc, bfs2f(lo[1]) * sc, bfs2f(lo[2]) * sc, bfs2f(lo[3]) * sc};
        f32x4 fhi = {bfs2f(hi[0]) * sc, bfs2f(hi[1]) * sc, bfs2f(hi[2]) * sc, bfs2f(hi[3]) * sc};
        pb[s2] = pack8(flo, fhi);
      }
      pv_step<64>(pb, sV0, O, fr, fq);
      __syncthreads();
    }
  }
  float ss = 0.f;
#pragma unroll
  for (int dt = 0; dt < 4; ++dt) ss += O[dt][0] * O[dt][0] + O[dt][1] * O[dt][1] + O[dt][2] * O[dt][2] + O[dt][3] * O[dt][3];
  ss += __shfl_xor(ss, 16);
  ss += __shfl_xor(ss, 32);
  const float rsn = rsqrtf(ss * (1.f / 64.f) + 1e-6f);
  const float* gn = p.in[27] + l * 512 + h * 64;
#pragma unroll
  for (int dt = 0; dt < 4; ++dt) {
    int dv = dt * 16 + fq * 4;
    float4 g = *(const float4*)(gn + dv);
    bf16x4 sg = *(const bf16x4*)(Z + (size_t)qrow * ZLD + ZC_RTG + h * 64 + dv);
    *(bf16x4*)(Y4 + (size_t)qrow * 2048 + 1024 + h * 64 + dv) =
        pack4(O[dt][0] * rsn * g.x * bfs2f(sg[0]), O[dt][1] * rsn * g.y * bfs2f(sg[1]), O[dt][2] * rsn * g.z * bfs2f(sg[2]), O[dt][3] * rsn * g.w * bfs2f(sg[3]));
  }
}

DI void ret_state_item(const P& p, int l, int b, int h) {
  const int tid_ = otid(), lane = tid_ & 63, wid = tid_ >> 6, fr = lane & 15, fq = lane >> 4;
  const bf16_t* KT = (const bf16_t*)(p.ws + WS_KTRT) + (size_t)(b * 512 + h * 64) * 256;
  const bf16_t* VT = (const bf16_t*)(p.ws + WS_VTRT) + (size_t)(b * 512 + h * 64) * 256;
  const float lgf = log1pf(-expf(p.in[25][l * 8 + h]));
  const float lgb = log1pf(-expf(p.in[26][l * 8 + h]));
  f32x4 af[4], ab[4];
#pragma unroll
  for (int nt = 0; nt < 4; ++nt) { af[nt] = f32x4{0.f, 0.f, 0.f, 0.f}; ab[nt] = f32x4{0.f, 0.f, 0.f, 0.f}; }
  for (int ks = 0; ks < 8; ++ks) {
    const int t0 = ks * 32 + fq * 8;
    bf16x8 kraw = *(const bf16x8*)(KT + (size_t)(wid * 16 + fr) * 256 + t0);
    bf16x8 kf, kb;
#pragma unroll
    for (int j = 0; j < 8; ++j) {
      float kv = bfs2f(kraw[j]);
      int t = t0 + j;
      kf[j] = (short)f2bf(kv * __expf(lgf * (float)(255 - t)));
      kb[j] = (short)f2bf(kv * __expf(lgb * (float)t));
    }
#pragma unroll
    for (int nt = 0; nt < 4; ++nt) {
      bf16x8 vb = *(const bf16x8*)(VT + (size_t)(nt * 16 + fr) * 256 + t0);
      af[nt] = MFMA16(kf, vb, af[nt]);
      ab[nt] = MFMA16(kb, vb, ab[nt]);
    }
  }
  float* of = p.out + O_RF + ((size_t)((b * 4 + l) * 8 + h)) * 4096;
  float* ob = p.out + O_RB + ((size_t)((b * 4 + l) * 8 + h)) * 4096;
#pragma unroll
  for (int nt = 0; nt < 4; ++nt)
#pragma unroll
    for (int i = 0; i < 4; ++i) {
      int dk = wid * 16 + fq * 4 + i, dv = nt * 16 + fr;
      of[dk * 64 + dv] = af[nt][i];
      ob[dk * 64 + dv] = ab[nt][i];
    }
}

DI void lru_gates_item(const P& p, int l, int chunk, int n, char* smem) {
  float* XDf = (float*)smem;
  bf16_t* XDb = (bf16_t*)(XDf + 4096);
  const int tid = otid(), lane = tid & 63, wid = tid >> 6, fr = lane & 15, fq = lane >> 4;
  const int row0 = chunk * 64;
  const bool latent = row0 >= NCTX;
  const int T = latent ? 2048 : 256;
  const int tseq0 = latent ? ((row0 - NCTX) & 2047) : (row0 & 255);
  const bf16_t* Z = (const bf16_t*)(p.ws + WS_Z);
  const bf16_t* WL = (const bf16_t*)(p.ws + WS_WLRU);
  bf16_t* LA = (bf16_t*)(p.ws + WS_LA);
  bf16_t* LU = (bf16_t*)(p.ws + WS_LU);
  const int ch0 = n * 64;
  {
    const float cw0 = p.in[28][(l * 4 + 0) * 512 + ch0 + lane];
    const float cw1 = p.in[28][(l * 4 + 1) * 512 + ch0 + lane];
    const float cw2 = p.in[28][(l * 4 + 2) * 512 + ch0 + lane];
    const float cw3 = p.in[28][(l * 4 + 3) * 512 + ch0 + lane];
    const float cb = p.in[29][l * 512 + ch0 + lane];
    const bf16_t* xcol = Z + (size_t)row0 * ZLD + ZC_LRX + ch0 + lane;
    const int t0 = wid * 16;
    auto ld = [&](int tl) -> float {
      int ts = tseq0 + tl;
      return (ts < 0 || ts >= T) ? 0.f : bf2f(xcol[(ptrdiff_t)tl * ZLD]);
    };
    float xm1 = ld(t0 - 1), x0 = ld(t0), x1 = ld(t0 + 1);
#pragma unroll
    for (int i = 0; i < 16; ++i) {
      float x2 = ld(t0 + i + 2);
      float xd = cw0 * xm1 + cw1 * x0 + cw2 * x1 + cw3 * x2 + cb;
      XDf[(t0 + i) * 64 + lane] = xd;
      XDb[(t0 + i) * LDT + lane] = f2bf(xd);
      xm1 = x0; x0 = x1; x1 = x2;
    }
  }
  __syncthreads();
  bf16x8 af[2];
#pragma unroll
  for (int ks = 0; ks < 2; ++ks) af[ks] = *(const bf16x8*)(XDb + (wid * 16 + fr) * LDT + ks * 32 + fq * 8);
#pragma unroll 1
  for (int dir = 0; dir < 2; ++dir) {
    const float* bav = (dir == 0 ? p.in[31] : p.in[36]) + l * 512 + ch0;
    const float* bxv = (dir == 0 ? p.in[33] : p.in[38]) + l * 512 + ch0;
    const float* lamv = (dir == 0 ? p.in[34] : p.in[39]) + l * 512 + ch0;
#pragma unroll
    for (int et = 0; et < 4; ++et) {
      f32x4 da = {0.f, 0.f, 0.f, 0.f}, dx = {0.f, 0.f, 0.f, 0.f};
#pragma unroll
      for (int ks = 0; ks < 2; ++ks) {
        bf16x8 wa = *(const bf16x8*)(WL + (size_t)((dir * 2 + 0) * 8 + n) * 4096 + (et * 16 + fr) * 64 + ks * 32 + fq * 8);
        bf16x8 wx = *(const bf16x8*)(WL + (size_t)((dir * 2 + 1) * 8 + n) * 4096 + (et * 16 + fr) * 64 + ks * 32 + fq * 8);
        da = MFMA16(af[ks], wa, da);
        dx = MFMA16(af[ks], wx, dx);
      }
      const int e = et * 16 + fr;
      const float ba_ = bav[e], bx_ = bxv[e];
      const float sp = log1pf(expf(-lamv[e]));
      float lav[4], uv[4];
#pragma unroll
      for (int i = 0; i < 4; ++i) {
        int tl = wid * 16 + fq * 4 + i;
        float rg = 1.f / (1.f + expf(-(da[i] + ba_)));
        float ig = 1.f / (1.f + expf(-(dx[i] + bx_)));
        float la = -8.f * rg * sp;
        lav[i] = la;
        uv[i] = sqrtf(-expm1f(2.f * la)) * (ig * XDf[tl * 64 + e]);
      }
      const size_t idx = (size_t)dir * 8388608 + ((size_t)chunk * 512 + ch0 + e) * 64 + wid * 16 + fq * 4;
      *(bf16x4*)(LA + idx) = pack4(lav[0], lav[1], lav[2], lav[3]);
      *(bf16x4*)(LU + idx) = pack4(uv[0], uv[1], uv[2], uv[3]);
    }
  }
  __syncthreads();
}

DI void lru_scan_witem(const P& p, int l, int bglob, int g, int lane) {
  const bool latent = bglob >= 32;
  const int T = latent ? 2048 : 256;
  const int rowbase = latent ? NCTX + (bglob - 32) * 2048 : bglob * 256;
  const int chunk0 = rowbase >> 6, nch = T >> 6;
  const int ch = g * 64 + lane;
  const bf16_t* LA = (const bf16_t*)(p.ws + WS_LA);
  const bf16_t* LU = (const bf16_t*)(p.ws + WS_LU);
  bf16_t* HF = (bf16_t*)(p.ws + WS_HF);
  const bf16_t* LG = (const bf16_t*)(p.ws + WS_LG);
  bf16_t* Y4 = (bf16_t*)(p.ws + WS_Y4);
  {
    float h = latent ? p.in[8][((bglob - 32) * 4 + l) * 512 + ch] : 0.f;
    bf16x8 ca[8], cu[8], na[8], nu[8];
    {
      const size_t b0 = ((size_t)chunk0 * 512 + ch) * 64;
#pragma unroll
      for (int q = 0; q < 8; ++q) { ca[q] = *(const bf16x8*)(LA + b0 + q * 8); cu[q] = *(const bf16x8*)(LU + b0 + q * 8); }
    }
    for (int cc = 0; cc < nch; ++cc) {
      const size_t cbase = ((size_t)(chunk0 + cc) * 512 + ch) * 64;
      const int cn = (cc + 1 < nch) ? cc + 1 : cc;
      const size_t nb = ((size_t)(chunk0 + cn) * 512 + ch) * 64;
#pragma unroll
      for (int q = 0; q < 8; ++q) { na[q] = *(const bf16x8*)(LA + nb + q * 8); nu[q] = *(const bf16x8*)(LU + nb + q * 8); }
#pragma unroll
      for (int q = 0; q < 8; ++q) {
        bf16x8 ho;
#pragma unroll
        for (int j = 0; j < 8; ++j) {
          float a = __expf(bfs2f(ca[q][j]));
          h = a * h + bfs2f(cu[q][j]);
          ho[j] = (short)f2bf(h);
        }
        *(bf16x8*)(HF + cbase + q * 8) = ho;
      }
#pragma unroll
      for (int q = 0; q < 8; ++q) { ca[q] = na[q]; cu[q] = nu[q]; }
    }
    if (!latent) p.out[O_LF + (size_t)(bglob * 4 + l) * 512 + ch] = h;
  }
  {
    float h = latent ? p.in[9][((bglob - 32) * 4 + l) * 512 + ch] : 0.f;
    const bf16_t* LAb = LA + 8388608;
    const bf16_t* LUb = LU + 8388608;
    bf16x8 ca[4], cu[4], chf[4], cg_[4], na[4], nu[4], nhf[4], ng[4];
    const int nb_ = 2 * nch;
    {
      const size_t b0 = ((size_t)(chunk0 + nch - 1) * 512 + ch) * 64 + 32;
#pragma unroll
      for (int q = 0; q < 4; ++q) {
        ca[q] = *(const bf16x8*)(LAb + b0 + q * 8); cu[q] = *(const bf16x8*)(LUb + b0 + q * 8);
        chf[q] = *(const bf16x8*)(HF + b0 + q * 8); cg_[q] = *(const bf16x8*)(LG + b0 + q * 8);
      }
    }
    for (int bi = 0; bi < nb_; ++bi) {
      const int chunk = nch - 1 - (bi >> 1), half = 1 - (bi & 1);
      const int bn = (bi + 1 < nb_) ? bi + 1 : bi;
      const int chunkn = nch - 1 - (bn >> 1), halfn = 1 - (bn & 1);
      const size_t nb = ((size_t)(chunk0 + chunkn) * 512 + ch) * 64 + halfn * 32;
#pragma unroll
      for (int q = 0; q < 4; ++q) {
        na[q] = *(const bf16x8*)(LAb + nb + q * 8); nu[q] = *(const bf16x8*)(LUb + nb + q * 8);
        nhf[q] = *(const bf16x8*)(HF + nb + q * 8); ng[q] = *(const bf16x8*)(LG + nb + q * 8);
      }
      bf16_t* yrow = Y4 + (size_t)(rowbase + chunk * 64 + half * 32) * 2048 + 1536 + ch;
#pragma unroll
      for (int q = 3; q >= 0; --q) {
#pragma unroll
        for (int j = 7; j >= 0; --j) {
          float a = __expf(bfs2f(ca[q][j]));
          h = a * h + bfs2f(cu[q][j]);
          float y = (bfs2f(chf[q][j]) + h) * bfs2f(cg_[q][j]);
          yrow[(size_t)(q * 8 + j) * 2048] = f2bf(y);
        }
      }
#pragma unroll
      for (int q = 0; q < 4; ++q) { ca[q] = na[q]; cu[q] = nu[q]; chf[q] = nhf[q]; cg_[q] = ng[q]; }
    }
    if (!latent) p.out[O_LB + (size_t)(bglob * 4 + l) * 512 + ch] = h;
  }
}

DI void phase_mixa(const P& p, int l, char* smem) {
  const int NITEMS = 512 + 2048;
  for (int it = blockIdx.x; it < NITEMS; it += gridDim.x) {
    int q = it;
    if (q < 512) { diff_item(p, l, true, q >> 7, (q >> 5) & 3, q & 31, smem); continue; }
    q -= 512;
    lru_gates_item(p, l, q >> 3, q & 7, smem);
  }
}
DI void phase_mixb(const P& p, int l, char* smem) {
  const int NITEMS = 72 + 4864;
  for (int it = blockIdx.x; it < NITEMS; it += gridDim.x) {
    int q = it;
    if (q < 72) {
      const int tid = otid(), lane = tid & 63, wid = tid >> 6;
      int bglob, g;
      if (q < 32) {
        if (wid == 0) { bglob = 32 + (q >> 3); g = q & 7; }
        else { int ci = q * 3 + wid - 1; bglob = ci >> 3; g = ci & 7; }
      } else {
        int ci = 96 + (q - 32) * 4 + wid;
        bglob = ci >> 3; g = ci & 7;
      }
      lru_scan_witem(p, l, bglob, g, lane);
      continue;
    }
    q -= 72;
    if (q < 1024) { ret_item(p, l, true, q >> 8, (q >> 5) & 7, q & 31, smem); continue; }
    q -= 1024;
    if (q < 1024) { na_item(p, l, q >> 8, (q >> 5) & 7, q & 31, smem); continue; }
    q -= 1024;
    if (q < 1024) { dense_item(p, q >> 5, (q >> 2) & 7, q & 3, smem); continue; }
    q -= 1024;
    if (q < 512) { diff_item(p, l, false, q >> 4, (q >> 2) & 3, q & 3, smem); continue; }
    q -= 512;
    if (q < 1024) { ret_item(p, l, false, q >> 5, (q >> 2) & 7, q & 3, smem); continue; }
    q -= 1024;
    ret_state_item(p, l, q >> 3, q & 7);
  }
}

#define XB_TMO 128
#define XB_XCNT(j) (256 + 64 * (j))
#define XB_XSUB(j) (1280 + 64 * (j))
#define XB_XGEN(j) (2304 + 64 * (j))
#define XB_TOP 3328
#define XB_TOPGEN 3392
#define XCD_BAR_WORDS 3456
#define XB_SPIN_CAP (1u << 18)
#define LAS __attribute__((address_space(3)))
DI unsigned xb_ld(unsigned* p) { return __hip_atomic_load(p, __ATOMIC_RELAXED, __HIP_MEMORY_SCOPE_AGENT); }
DI unsigned xb_add(unsigned* p, unsigned v) { return __hip_atomic_fetch_add(p, v, __ATOMIC_RELAXED, __HIP_MEMORY_SCOPE_AGENT); }
DI unsigned xb_xcc_id() { return (unsigned)__builtin_amdgcn_s_getreg((3 << 11) | 20) & 0xFu; }
#define XB_SPIN(cond, bar) do { unsigned _sp = 0; while (cond) { __builtin_amdgcn_s_sleep(1); \
    if ((++_sp & 255u) == 0u) { if (xb_ld(&(bar)[XB_TMO])) break; if (_sp > XB_SPIN_CAP) { atomicAdd(&(bar)[XB_TMO], 1u); break; } } } } while (0)
struct XcdBarrier { unsigned* bar; unsigned x; volatile LAS unsigned* st; };
DI XcdBarrier xcd_barrier_post(unsigned* bar, volatile LAS unsigned* st) {
  XcdBarrier b; b.bar = bar; b.x = xb_xcc_id(); b.st = st;
  if (threadIdx.x == 0) (void)xb_add(&bar[XB_XCNT(b.x)], 1u);
  return b;
}
DI void xcd_barrier_complete(unsigned* bar, unsigned x, unsigned& nloc, unsigned& nx) {
  const unsigned G = gridDim.x * gridDim.y * gridDim.z;
  unsigned sum, cnt, mine, sp = 0u;
  for (;;) {
    sum = 0u; cnt = 0u; mine = 0u;
#pragma unroll
    for (unsigned j = 0; j < 16; ++j) { const unsigned c = xb_ld(&bar[XB_XCNT(j)]); sum += c; cnt += (c > 0u) ? 1u : 0u; mine = (j == x) ? c : mine; }
    if (sum == G) break;
    __builtin_amdgcn_s_sleep(1);
    if ((++sp & 255u) == 0u) { if (xb_ld(&bar[XB_TMO])) break; if (sp > XB_SPIN_CAP) { atomicAdd(&bar[XB_TMO], 1u); break; } }
  }
  nloc = mine > 0u ? mine : 1u; nx = cnt > 0u ? cnt : 1u;
}
DI void xcd_barrier(const XcdBarrier& b) {
  asm volatile("s_waitcnt vmcnt(0)" ::: "memory");
  __syncthreads();
  if (threadIdx.x == 0) {
    unsigned* bar = b.bar;
    __builtin_amdgcn_s_waitcnt(0);
    unsigned nloc = b.st[0], nx = b.st[1];
    if (nloc == 0u) { xcd_barrier_complete(bar, b.x, nloc, nx); b.st[0] = nloc; b.st[1] = nx; }
    const unsigned old = xb_add(&bar[XB_XSUB(b.x)], 1u);
    const unsigned gen = old / nloc;
    if (old + 1u == (gen + 1u) * nloc) {
      __builtin_amdgcn_fence(__ATOMIC_RELEASE, "agent");
      asm volatile("s_waitcnt vmcnt(0)" ::: "memory");
      const unsigned og = xb_add(&bar[XB_TOP], 1u);
      const unsigned tg = og / nx;
      if (og + 1u == (tg + 1u) * nx) xb_add(&bar[XB_TOPGEN], 1u);
      else XB_SPIN(xb_ld(&bar[XB_TOPGEN]) == tg, bar);
      __builtin_amdgcn_fence(__ATOMIC_ACQUIRE, "agent");
      xb_add(&bar[XB_XGEN(b.x)], 1u);
      asm volatile("s_waitcnt vmcnt(0)" ::: "memory");
    } else {
      XB_SPIN(xb_ld(&bar[XB_XGEN(b.x)]) == gen, bar);
      __builtin_amdgcn_fence(__ATOMIC_ACQUIRE, "agent");
      asm volatile("s_waitcnt vmcnt(0)" ::: "memory");
    }
  }
  __syncthreads();
}

enum { PH_INIT = 0, PH_PRE0, PH_GIN, PH_MIXA, PH_MIXB, PH_MERGE, PH_OUT, PH_POSTMIX, PH_FF1, PH_FF2, PH_POSTFFN };

DI void run_phase(const P& p, int ph, int l, char* smem) {
  switch (ph) {
    case PH_INIT:
      phase_mod(p, smem);
      phase_convert(p, 0, smem);
      break;
    case PH_PRE0: phase_row(p, 0, 0); break;
    case PH_GIN: phase_gin(p, l, smem); break;
    case PH_MIXA: phase_mixa(p, l, smem); break;
    case PH_MIXB: phase_mixb(p, l, smem); break;
    case PH_MERGE: phase_merge(p, smem); break;
    case PH_OUT:
      phase_gemm_plain<0>((const bf16_t*)(p.ws + WS_H), 1024, (const bf16_t*)(p.ws + WS_WOUT), 1024, (bf16_t*)(p.ws + WS_Y), smem);
      break;
    case PH_POSTMIX: phase_row(p, l, 1); break;
    case PH_FF1:
      phase_gemm_plain<1>((const bf16_t*)(p.ws + WS_H), 1024, (const bf16_t*)(p.ws + WS_W1), 4096, (bf16_t*)(p.ws + WS_U), smem);
      break;
    case PH_FF2:
      phase_gemm_plain<0>((const bf16_t*)(p.ws + WS_U), 4096, (const bf16_t*)(p.ws + WS_W2), 1024, (bf16_t*)(p.ws + WS_Y), smem);
      break;
    case PH_POSTFFN:
      phase_row(p, l, 2);
      if (l < 3) phase_convert(p, l + 1, smem);
      break;
    default: break;
  }
}

DI void decode_step(int step, int& ph, int& l) {
  if (step < 2) { ph = step; l = 0; }
  else { int s = step - 2; l = s / 9; ph = PH_GIN + (s % 9); }
}
constexpr int NSTEPS = 38;

__global__ void __launch_bounds__(256, 2) hybrid_flow_mega(P p) {
  __shared__ __attribute__((aligned(16))) char smem[SMEM_BYTES];
  __shared__ uint4 xb_words;
  cg::grid_group grid = cg::this_grid();
  if (threadIdx.x == 0) xb_words = make_uint4(0u, 0u, 0u, 0u);
  __syncthreads();
  XcdBarrier xb = xcd_barrier_post((unsigned*)(p.ws + WS_BAR), (volatile LAS unsigned*)&xb_words);
  for (int step = 0; step < NSTEPS; ++step) {
    int ph, l;
    decode_step(step, ph, l);
#ifdef PROBE_DUP
    const int reps = (ph == PROBE_DUP) ? 2 : 1;
    for (int rep = 0; rep < reps; ++rep)
#endif
    run_phase(p, ph, l, smem);
#ifdef PROBE_CONV
    if (ph == PH_POSTFFN && l < 3) phase_convert(p, l + 1, smem);
#endif
    if (step == 0) grid.sync();
    else if (step + 1 < NSTEPS) xcd_barrier(xb);
#ifdef PROBE_SYNC
    if (step + 1 < NSTEPS) xcd_barrier(xb);
#endif
  }
}

#if !ONE_LAUNCH
__global__ void __launch_bounds__(256, 2) hybrid_flow_phase(P p, int ph, int l) {
  __shared__ __attribute__((aligned(16))) char smem[SMEM_BYTES];
  run_phase(p, ph, l, smem);
}
#endif

extern "C" void kernel_launch(void* const* d_in, const int* in_sizes, int n_in, void* d_out, int out_size, void* d_ws,
                              size_t ws_size, hipStream_t stream) {
  (void)in_sizes; (void)n_in; (void)out_size; (void)ws_size;
  P p{};
  for (int i = 0; i < 44; ++i) p.in[i] = (const float*)d_in[i];
  p.out = (float*)d_out;
  p.ws = (char*)d_ws;
#if ONE_LAUNCH
  static int grid_blocks = 0;
  if (!grid_blocks) {
    int dev = 0, cus = 0, per_cu = 0;
    hipGetDevice(&dev);
    hipDeviceGetAttribute(&cus, hipDeviceAttributeMultiprocessorCount, dev);
    hipOccupancyMaxActiveBlocksPerMultiprocessor(&per_cu, hybrid_flow_mega, 256, 0);
    if (per_cu < 1) per_cu = 1;
    if (per_cu > 2) per_cu = 2;
    grid_blocks = cus * per_cu;
  }
  (void)hipMemsetAsync((char*)d_ws + WS_BAR, 0, 16384, stream);
  void* args[] = {&p};
  hipError_t e = hipLaunchCooperativeKernel((void*)hybrid_flow_mega, dim3(grid_blocks), dim3(256), args, 0, stream);
  if (e != hipSuccess) fprintf(stderr, "cooperative launch failed: %s (grid %d)\n", hipGetErrorString(e), grid_blocks);
#else
  const int grid_blocks = 512;
  for (int step = 0; step < NSTEPS; ++step) {
    int ph, l;
    if (step < 2) { ph = step; l = 0; }
    else { int s = step - 2; l = s / 9; ph = PH_GIN + (s % 9); }
    hipLaunchKernelGGL(hybrid_flow_phase, dim3(grid_blocks), dim3(256), 0, stream, p, ph, l);
  }
#endif
}
```

```cpp
#include <hip/hip_runtime.h>
#include <hip/hip_cooperative_groups.h>
#include <cstdio>
namespace cg = cooperative_groups;

#ifndef ONE_LAUNCH
#define ONE_LAUNCH 1
#endif

typedef unsigned short bf16_t;
using bf16x8 = __attribute__((ext_vector_type(8))) short;
using bf16x4 = __attribute__((ext_vector_type(4))) short;
using f32x4 = __attribute__((ext_vector_type(4))) float;
using u32x4 = __attribute__((ext_vector_type(4))) unsigned;
#define DI __device__ __forceinline__
#define MFMA16(a, b, c) __builtin_amdgcn_mfma_f32_16x16x32_bf16((a), (b), (c), 0, 0, 0)

struct P {
  const float* in[44];
  float* out;
  char* ws;
};

constexpr int D = 1024, NCTX = 8192;
constexpr int ZLD = 4160;
constexpr int ZC_NAQ = 0, ZC_NAK = 512, ZC_DFQ = 1024, ZC_DFK = 1536, ZC_RTQ = 2048, ZC_RTK = 2560, ZC_RTG = 3072,
              ZC_LRX = 3584;
constexpr int LDT = 72;

constexpr size_t WS_WIN = 0;
constexpr size_t WS_WBR = WS_WIN + (size_t)10240 * 1024 * 2;
constexpr size_t WS_WOUT = WS_WBR + (size_t)1024 * 2048 * 2;
constexpr size_t WS_W1 = WS_WOUT + (size_t)1024 * 1024 * 2;
constexpr size_t WS_W2 = WS_W1 + (size_t)4096 * 1024 * 2;
constexpr size_t WS_WLRU = WS_W2 + (size_t)4096 * 1024 * 2;
constexpr size_t WS_CKNA = WS_WLRU + (size_t)32 * 4096 * 2;
constexpr size_t WS_CVNA = WS_CKNA + (size_t)4 * 262144 * 2;
constexpr size_t WS_CKDF = WS_CVNA + (size_t)4 * 262144 * 2;
constexpr size_t WS_CVDF = WS_CKDF + (size_t)4 * 262144 * 2;
constexpr size_t WS_MOD = WS_CVDF + (size_t)4 * 262144 * 2;
constexpr size_t WS_H = WS_MOD + (size_t)4 * 5 * 6144 * 4;
constexpr size_t WS_Y4 = WS_H + (size_t)16384 * 1024 * 2;
constexpr size_t WS_VTNA = WS_Y4 + (size_t)16384 * 2048 * 2;
constexpr size_t WS_VTDF = WS_VTNA + (size_t)16384 * 512 * 2;
constexpr size_t WS_VTRT = WS_VTDF + (size_t)16384 * 512 * 2;
constexpr size_t WS_KTRT = WS_VTRT + (size_t)16384 * 512 * 2;
constexpr size_t WS_Z = WS_KTRT + (size_t)8192 * 512 * 2;
constexpr size_t WS_GF = WS_Z + (size_t)16384 * ZLD * 2;
constexpr size_t WS_Y = WS_Z;
constexpr size_t WS_U = WS_Z + (size_t)16384 * 1024 * 4;
constexpr size_t WS_LA = WS_GF + (size_t)16384 * 4096 * 2;
constexpr size_t WS_LU = WS_LA + (size_t)2 * 16384 * 512 * 2;
constexpr size_t WS_HF = WS_LU + (size_t)2 * 16384 * 512 * 2;
constexpr size_t WS_LG = WS_HF + (size_t)16384 * 512 * 2;
constexpr size_t WS_BAR = WS_LG + (size_t)16384 * 512 * 2;
constexpr size_t WS_END = WS_BAR + 16384;

constexpr size_t O_NAK = 16777216, O_NAV = 33554432, O_DFK = 50331648, O_DFV = 67108864, O_RF = 83886080,
                 O_RB = 88080384, O_LF = 92274688, O_LB = 92340224;
constexpr int VT_LAT = 4194304;

constexpr int SMEM_BYTES = 69632;

DI int otid() {
  int t = threadIdx.x;
  asm volatile("" : "+v"(t));
  return t;
}
typedef __bf16 hwbf2 __attribute__((ext_vector_type(2)));
typedef float f32v2 __attribute__((ext_vector_type(2)));
using u32x2 = __attribute__((ext_vector_type(2))) unsigned;
DI unsigned pk2(float a, float b) {
  f32v2 v = {a, b};
  return __builtin_bit_cast(unsigned, __builtin_convertvector(v, hwbf2));
}
DI bf16_t f2bf(float x) { return (bf16_t)(pk2(x, 0.f) & 0xffffu); }
DI float bf2f(bf16_t b) { return __uint_as_float(((unsigned)b) << 16); }
DI float bfs2f(short b) { return __uint_as_float(((unsigned)(unsigned short)b) << 16); }
DI float wave_sum(float v) {
#pragma unroll
  for (int o = 32; o > 0; o >>= 1) v += __shfl_xor(v, o);
  return v;
}
DI float sigmoidf_(float x) { return 1.f / (1.f + __expf(-x)); }
DI float gelu_tanh(float x) {
  float u = 0.7978845608028654f * (x + 0.044715f * x * x * x);
  return x * sigmoidf_(2.f * u);
}
DI bf16x8 pack8(const f32x4& a, const f32x4& b) {
  u32x4 r = {pk2(a[0], a[1]), pk2(a[2], a[3]), pk2(b[0], b[1]), pk2(b[2], b[3])};
  return __builtin_bit_cast(bf16x8, r);
}
DI bf16x4 pack4(float a, float b, float c, float d) {
  u32x2 r = {pk2(a, b), pk2(c, d)};
  return __builtin_bit_cast(bf16x4, r);
}

constexpr int GEMM_BUF_BYTES = 32768;
DI int swz_off(int rr, int c4) {
  int ob = rr * 64 + c4 * 16;
  return ob ^ (((ob >> 9) & 1) << 5);
}
template <int NI>
DI void gemm_mainloop(const bf16_t* __restrict__ A, int lda, const bf16_t* __restrict__ Bt, int ldb, int K, int row0,
                      int col0, char* smem, f32x4 (&acc)[4][NI]) {
  const int tid = otid(), lane = tid & 63, wid = tid >> 6;
  const int wm = wid >> 1, wn = wid & 1, fr = lane & 15, fq = lane >> 4;
  const int c4 = tid & 3, kh = (tid >> 3) & 1;
  const int srow = ((tid >> 4) << 1) + ((tid >> 2) & 1);
  const int gk = (kh * 4 + c4) * 8;
  const int soff = ((srow >> 4) * 2 + kh) * 1024 + swz_off(srow & 15, c4);
  const bf16_t* Ag = A + (size_t)(row0 + srow) * lda + gk;
  const bf16_t* Bg = Bt + (size_t)(col0 + srow) * ldb + gk;
  const int aoff = wm * 8192 + swz_off(fr, fq);
  const int boff = 16384 + wn * NI * 2048 + swz_off(fr, fq);
  u32x4 ra[4], rb[NI];
#pragma unroll
  for (int i = 0; i < 4; ++i) ra[i] = *(const u32x4*)(Ag + (size_t)(i * 32) * lda);
#pragma unroll
  for (int i = 0; i < NI; ++i) rb[i] = *(const u32x4*)(Bg + (size_t)(i * 32) * ldb);
#pragma unroll
  for (int i = 0; i < 4; ++i) *(u32x4*)(smem + soff + i * 4096) = ra[i];
#pragma unroll
  for (int i = 0; i < NI; ++i) *(u32x4*)(smem + 16384 + soff + i * 4096) = rb[i];
  __syncthreads();
  const int nk = K >> 6;
  for (int kt = 0; kt < nk; ++kt) {
    const bool more = (kt + 1) < nk;
    if (more) {
      const int k1 = (kt + 1) * 64;
#pragma unroll
      for (int i = 0; i < 4; ++i) ra[i] = *(const u32x4*)(Ag + (size_t)(i * 32) * lda + k1);
#pragma unroll
      for (int i = 0; i < NI; ++i) rb[i] = *(const u32x4*)(Bg + (size_t)(i * 32) * ldb + k1);
    }
    asm volatile("" ::: "memory");
    const char* sb = smem + (kt & 1) * GEMM_BUF_BYTES;
#pragma unroll
    for (int ks = 0; ks < 2; ++ks) {
      bf16x8 af[4], bfr[NI];
#pragma unroll
      for (int mi = 0; mi < 4; ++mi) af[mi] = *(const bf16x8*)(sb + aoff + mi * 2048 + ks * 1024);
#pragma unroll
      for (int ni = 0; ni < NI; ++ni) bfr[ni] = *(const bf16x8*)(sb + boff + ni * 2048 + ks * 1024);
#pragma unroll
      for (int mi = 0; mi < 4; ++mi)
#pragma unroll
        for (int ni = 0; ni < NI; ++ni) acc[mi][ni] = MFMA16(bfr[ni], af[mi], acc[mi][ni]);
    }
    __builtin_amdgcn_sched_barrier(0);
    if (more) {
      char* db = smem + ((kt + 1) & 1) * GEMM_BUF_BYTES;
#pragma unroll
      for (int i = 0; i < 4; ++i) *(u32x4*)(db + soff + i * 4096) = ra[i];
#pragma unroll
      for (int i = 0; i < NI; ++i) *(u32x4*)(db + 16384 + soff + i * 4096) = rb[i];
    }
    __syncthreads();
  }
}

DI void zero_acc(f32x4 (&acc)[4][4]) {
#pragma unroll
  for (int mi = 0; mi < 4; ++mi)
#pragma unroll
    for (int ni = 0; ni < 4; ++ni) acc[mi][ni] = f32x4{0.f, 0.f, 0.f, 0.f};
}
DI bool tile_sched(int iter, int tmt, int ntn, int& tm, int& tn) {
  const int G = gridDim.x, b = blockIdx.x;
  if ((G & 63) == 0 && (ntn & 7) == 0 && (tmt & 7) == 0) {
    const int groups = G >> 6, xg = b % groups, j = b / groups;
    const int srows = tmt >> 3;
    const int s = iter * groups + xg, nsuper = srows * (ntn >> 3);
    if (s >= nsuper) return false;
    tm = (s % srows) * 8 + (j & 7);
    tn = (s / srows) * 8 + (j >> 3);
    return true;
  }
  const int id = b + iter * G;
  if (id >= tmt * ntn) return false;
  tm = id % tmt;
  tn = id / tmt;
  return true;
}

constexpr int G2_STAGE = 24576;
DI void zero_acc2(f32x4 (&acc)[8][4]) {
#pragma unroll
  for (int mi = 0; mi < 8; ++mi)
#pragma unroll
    for (int ni = 0; ni < 4; ++ni) acc[mi][ni] = f32x4{0.f, 0.f, 0.f, 0.f};
}
DI void gemm2_mainloop(const bf16_t* __restrict__ A, int lda, const bf16_t* __restrict__ Bt, int ldb, int K, int row0,
                       int col0, char* smem, f32x4 (&acc)[8][4]) {
  const int tid = otid(), lane = tid & 63, wid = tid >> 6;
  const int wm = wid >> 1, wn = wid & 1, fr = lane & 15, fq = lane >> 4;
  const int c4 = tid & 3, srow = tid >> 2;
  const int soff = (srow >> 4) * 1024 + swz_off(srow & 15, c4);
  const bf16_t* Ag = A + (size_t)(row0 + srow) * lda + c4 * 8;
  const bf16_t* Bg = Bt + (size_t)(col0 + srow) * ldb + c4 * 8;
  const int aoff = wm * 8192 + swz_off(fr, fq);
  const int boff = 16384 + wn * 4096 + swz_off(fr, fq);
  u32x4 ra[4], rb[2];
#pragma unroll
  for (int i = 0; i < 4; ++i) ra[i] = *(const u32x4*)(Ag + (size_t)(i * 64) * lda);
#pragma unroll
  for (int i = 0; i < 2; ++i) rb[i] = *(const u32x4*)(Bg + (size_t)(i * 64) * ldb);
#pragma unroll
  for (int i = 0; i < 4; ++i) *(u32x4*)(smem + soff + i * 4096) = ra[i];
#pragma unroll
  for (int i = 0; i < 2; ++i) *(u32x4*)(smem + 16384 + soff + i * 4096) = rb[i];
  __syncthreads();
  const int nk = K >> 5;
  for (int kt = 0; kt < nk; ++kt) {
    const bool more = (kt + 1) < nk;
    if (more) {
      const int k1 = (kt + 1) * 32;
#pragma unroll
      for (int i = 0; i < 4; ++i) ra[i] = *(const u32x4*)(Ag + (size_t)(i * 64) * lda + k1);
#pragma unroll
      for (int i = 0; i < 2; ++i) rb[i] = *(const u32x4*)(Bg + (size_t)(i * 64) * ldb + k1);
    }
    asm volatile("" ::: "memory");
    const char* sb = smem + (kt & 1) * G2_STAGE;
    bf16x8 bfr[4];
#pragma unroll
    for (int ni = 0; ni < 4; ++ni) bfr[ni] = *(const bf16x8*)(sb + boff + ni * 1024);
#pragma unroll
    for (int mi = 0; mi < 8; ++mi) {
      bf16x8 af = *(const bf16x8*)(sb + aoff + mi * 1024);
#pragma unroll
      for (int ni = 0; ni < 4; ++ni) acc[mi][ni] = MFMA16(bfr[ni], af, acc[mi][ni]);
    }
    __builtin_amdgcn_sched_barrier(0);
    if (more) {
      char* db = smem + ((kt + 1) & 1) * G2_STAGE;
#pragma unroll
      for (int i = 0; i < 4; ++i) *(u32x4*)(db + soff + i * 4096) = ra[i];
#pragma unroll
      for (int i = 0; i < 2; ++i) *(u32x4*)(db + 16384 + soff + i * 4096) = rb[i];
    }
    __syncthreads();
  }
}

constexpr int CST_B = 272;
constexpr int CST_T = 528;
template <int MI, int NI, class F>
DI void stage_rowmajor(char* smem, f32x4 (&acc)[MI][NI], int wm, int wn, int fr, int fq, F&& tf) {
#pragma unroll
  for (int mi = 0; mi < MI; ++mi)
#pragma unroll
    for (int ni = 0; ni < NI; ++ni) {
      f32x4 v = tf(acc[mi][ni]);
      *(bf16x4*)(smem + (wm * MI * 16 + mi * 16 + fr) * CST_B + (wn * NI * 16 + ni * 16 + fq * 4) * 2) = pack4(v[0], v[1], v[2], v[3]);
      if (ni == NI - 1) __builtin_amdgcn_sched_barrier(0);
    }
}
template <int MI, int NI, class F>
DI void stage_transposed(char* smem, f32x4 (&acc)[MI][NI], int wm, int wn, int fr, int fq, F&& tf) {
#pragma unroll
  for (int mi = 0; mi < MI; ++mi)
#pragma unroll
    for (int ni = 0; ni < NI; ++ni) {
      f32x4 v = tf(acc[mi][ni]);
      char* base = smem + (wn * NI * 16 + ni * 16 + fq * 4) * CST_T + (wm * MI * 16 + mi * 16 + fr) * 2;
      *(bf16_t*)(base) = f2bf(v[0]);
      *(bf16_t*)(base + CST_T) = f2bf(v[1]);
      *(bf16_t*)(base + 2 * CST_T) = f2bf(v[2]);
      *(bf16_t*)(base + 3 * CST_T) = f2bf(v[3]);
      if (ni == NI - 1) __builtin_amdgcn_sched_barrier(0);
    }
}
template <int LINES, int CPL, int STRIDE, class D>
DI void writeout(const char* smem, int tid, D&& dst) {
#pragma unroll 4
  for (int j = 0; j < LINES * CPL / 256; ++j) {
    const int id = tid + j * 256, line = id / CPL, c = id % CPL;
    u32x4 v = *(const u32x4*)(smem + line * STRIDE + c * 16);
    *(u32x4*)dst(line, c) = v;
  }
}

DI void stage_rowmajor_rope(char* smem, f32x4 (&acc)[8][4], int wm, int wn, int fr, int fq, int rtok) {
  float inv[4];
#pragma unroll
  for (int i = 0; i < 4; ++i) inv[i] = exp2f(-(float)(fq * 4 + i) * 0.8304820237218406f);
#pragma unroll
  for (int mi = 0; mi < 8; ++mi) {
    const int t = (rtok + mi * 16 - NCTX) & 2047;
    const float gr = (float)(t >> 6), gc = (float)(t & 63);
    f32x4 o0, o1, o2, o3;
#pragma unroll
    for (int i = 0; i < 4; ++i) {
      const float sr = __sinf(gr * inv[i]), cr = __cosf(gr * inv[i]);
      const float sc = __sinf(gc * inv[i]), cc = __cosf(gc * inv[i]);
      const float a0 = acc[mi][0][i], a1 = acc[mi][1][i], a2 = acc[mi][2][i], a3 = acc[mi][3][i];
      o0[i] = a0 * cr - a1 * sr;
      o1[i] = a1 * cr + a0 * sr;
      o2[i] = a2 * cc - a3 * sc;
      o3[i] = a3 * cc + a2 * sc;
    }
    char* base = smem + (wm * 128 + mi * 16 + fr) * CST_B + (wn * 64 + fq * 4) * 2;
    *(bf16x4*)(base) = pack4(o0[0], o0[1], o0[2], o0[3]);
    *(bf16x4*)(base + 32) = pack4(o1[0], o1[1], o1[2], o1[3]);
    *(bf16x4*)(base + 64) = pack4(o2[0], o2[1], o2[2], o2[3]);
    *(bf16x4*)(base + 96) = pack4(o3[0], o3[1], o3[2], o3[3]);
    __builtin_amdgcn_sched_barrier(0);
  }
}

DI void epi_in(const P& p, int l, int row0, int col0, f32x4 (&acc)[8][4], char* smem) {
  const int tid_ = otid(), lane = tid_ & 63, wid = tid_ >> 6, wm = wid >> 1, wn = wid & 1, fr = lane & 15, fq = lane >> 4;
  const int seg = col0 >> 9;
  const bool ctx = row0 < NCTX;
  if (seg >= 12) {
    bf16_t* GF = (bf16_t*)(p.ws + WS_GF);
    const int k = (seg - 12) >> 1, tn = ((col0 - 6144) & 1023) >> 7, tm = row0 >> 8;
    bf16_t* dst = GF + (((size_t)k * 64 + tm) * 8 + tn) * 32768 + tid_ * 4;
#pragma unroll
    for (int mi = 0; mi < 8; ++mi)
#pragma unroll
      for (int ni = 0; ni < 4; ++ni)
        *(bf16x4*)(dst + (mi * 4 + ni) * 1024) = pack4(sigmoidf_(acc[mi][ni][0]), sigmoidf_(acc[mi][ni][1]), sigmoidf_(acc[mi][ni][2]), sigmoidf_(acc[mi][ni][3]));
    return;
  }
  const int ctile = col0 & 511;
  const int cseg0 = ctile + wn * 64;
  const int rtok = row0 + wm * 128 + fr;
  if (ctx && (seg == 1 || seg == 2 || seg == 4 || seg == 5)) {
    float* out = p.out;
#pragma unroll
    for (int mi = 0; mi < 8; ++mi) {
      const int r = rtok + mi * 16, b = r >> 8, t = r & 255;
      size_t off;
      if (seg == 1 || seg == 2) {
        const int h = cseg0 >> 6;
        off = (seg == 1 ? O_NAK : O_NAV) + (((size_t)(b * 4 + l) * 8 + h) * 256 + t) * 64;
      } else if (seg == 4) {
        const int comp = cseg0 >> 8, h = (cseg0 >> 6) & 3;
        off = O_DFK + ((((size_t)(b * 4 + l) * 2 + comp) * 4 + h) * 256 + t) * 64;
      } else {
        const int h = cseg0 >> 7;
        off = O_DFV + (((size_t)(b * 4 + l) * 4 + h) * 256 + t) * 128 + (cseg0 & 127);
      }
#pragma unroll
      for (int ni = 0; ni < 4; ++ni) *(f32x4*)(out + off + ni * 16 + fq * 4) = acc[mi][ni];
      __builtin_amdgcn_sched_barrier(0);
    }
  }
  auto tf_none = [](const f32x4& a) -> f32x4 { return a; };
  auto tf_scale = [](const f32x4& a) -> f32x4 { return f32x4{a[0] * 0.125f, a[1] * 0.125f, a[2] * 0.125f, a[3] * 0.125f}; };
  auto tf_silu = [](const f32x4& a) -> f32x4 { return f32x4{a[0] * sigmoidf_(a[0]), a[1] * sigmoidf_(a[1]), a[2] * sigmoidf_(a[2]), a[3] * sigmoidf_(a[3])}; };
  auto tf_gelu = [](const f32x4& a) -> f32x4 { return f32x4{gelu_tanh(a[0]), gelu_tanh(a[1]), gelu_tanh(a[2]), gelu_tanh(a[3])}; };
  const bool rowmajor = !(seg == 2 || seg == 5 || seg == 8 || seg == 11);
  if (rowmajor) {
    int zc;
    switch (seg) {
      case 0: zc = ZC_NAQ; break;
      case 1: zc = ZC_NAK; break;
      case 3: zc = ZC_DFQ; break;
      case 4: zc = ZC_DFK; break;
      case 6: zc = ZC_RTQ; break;
      case 7: zc = ZC_RTK; break;
      case 9: zc = ZC_RTG; break;
      default: zc = ZC_LRX; break;
    }
    if (!ctx && (seg == 3 || seg == 4)) stage_rowmajor_rope(smem, acc, wm, wn, fr, fq, rtok);
    else if (seg == 7) stage_rowmajor<8, 4>(smem, acc, wm, wn, fr, fq, tf_scale);
    else if (seg == 9) stage_rowmajor<8, 4>(smem, acc, wm, wn, fr, fq, tf_silu);
    else stage_rowmajor<8, 4>(smem, acc, wm, wn, fr, fq, tf_none);
    __syncthreads();
    bf16_t* zb = (bf16_t*)(p.ws + WS_Z) + (size_t)row0 * ZLD + zc + ctile;
    writeout<256, 16, CST_B>(smem, tid_, [&](int line, int c) { return zb + (size_t)line * ZLD + c * 8; });
    __syncthreads();
  }
  if (!rowmajor || (seg == 7 && ctx)) {
    if (seg == 7) stage_transposed<8, 4>(smem, acc, wm, wn, fr, fq, tf_scale);
    else if (seg == 11) stage_transposed<8, 4>(smem, acc, wm, wn, fr, fq, tf_gelu);
    else stage_transposed<8, 4>(smem, acc, wm, wn, fr, fq, tf_none);
    __syncthreads();
    if (seg == 11) {
      bf16_t* lg = (bf16_t*)(p.ws + WS_LG) + ((size_t)(row0 >> 6) * 512 + ctile) * 64;
      writeout<128, 32, CST_T>(smem, tid_, [&](int line, int c) { return lg + ((size_t)(c >> 3) * 512 + line) * 64 + (c & 7) * 8; });
    } else {
      bf16_t* tb = (bf16_t*)(p.ws + (seg == 2 ? WS_VTNA : seg == 5 ? WS_VTDF : seg == 8 ? WS_VTRT : WS_KTRT));
      int T;
      if (ctx) { T = 256; tb += ((size_t)((row0 >> 8) * 512 + ctile)) * 256 + (row0 & 255); }
      else { const int rr = row0 - NCTX; T = 2048; tb += (size_t)VT_LAT + ((size_t)((rr >> 11) * 512 + ctile)) * 2048 + (rr & 2047); }
      writeout<128, 32, CST_T>(smem, tid_, [&](int line, int c) { return tb + (size_t)line * T + c * 8; });
    }
    __syncthreads();
  }
}

DI void phase_gin(const P& p, int l, char* smem) {
  const bf16_t* A = (const bf16_t*)(p.ws + WS_H);
  const bf16_t* Bt = (const bf16_t*)(p.ws + WS_WIN);
  for (int it = 0;; ++it) {
    int tm, tn;
    if (!tile_sched(it, 64, 80, tm, tn)) break;
    f32x4 acc[8][4];
    zero_acc2(acc);
    gemm2_mainloop(A, 1024, Bt, 1024, 1024, tm * 256, tn * 128, smem, acc);
    epi_in(p, l, tm * 256, tn * 128, acc, smem);
  }
}

DI void phase_merge(const P& p, char* smem) {
  const bf16_t* Y4 = (const bf16_t*)(p.ws + WS_Y4);
  const bf16_t* WB = (const bf16_t*)(p.ws + WS_WBR);
  const bf16_t* GF = (const bf16_t*)(p.ws + WS_GF);
  bf16_t* G = (bf16_t*)(p.ws + WS_H);
  const int tid_ = otid(), lane = tid_ & 63, wid = tid_ >> 6, wm = wid >> 1, wn = wid & 1, fr = lane & 15, fq = lane >> 4;
  for (int it = 0;; ++it) {
    int tm, t64;
    if (!tile_sched(it, 128, 16, tm, t64)) break;
    const int row0 = tm * 128, col0 = t64 * 64;
    f32x4 o[4][2];
#pragma unroll
    for (int mi = 0; mi < 4; ++mi) { o[mi][0] = f32x4{0.f, 0.f, 0.f, 0.f}; o[mi][1] = f32x4{0.f, 0.f, 0.f, 0.f}; }
#pragma unroll 1
    for (int k = 0; k < 4; ++k) {
      const bf16_t* gsrc = GF + (((size_t)k * 64 + (tm >> 1)) * 8 + (t64 >> 1)) * 32768 + (((tm & 1) * 2 + (t64 & 1)) * 64 + lane) * 4 +
                           ((wm * 4) * 4 + wn * 2) * 1024;
      bf16x4 gq[4][2];
#pragma unroll
      for (int mi = 0; mi < 4; ++mi) { gq[mi][0] = *(const bf16x4*)(gsrc + (mi * 4) * 1024); gq[mi][1] = *(const bf16x4*)(gsrc + (mi * 4 + 1) * 1024); }
      f32x4 acc[4][2];
#pragma unroll
      for (int mi = 0; mi < 4; ++mi) { acc[mi][0] = f32x4{0.f, 0.f, 0.f, 0.f}; acc[mi][1] = f32x4{0.f, 0.f, 0.f, 0.f}; }
      gemm_mainloop<2>(Y4 + k * 512, 2048, WB + k * 512, 2048, 512, row0, col0, smem, acc);
#pragma unroll
      for (int mi = 0; mi < 4; ++mi)
#pragma unroll
        for (int nj = 0; nj < 2; ++nj)
#pragma unroll
          for (int i = 0; i < 4; ++i) o[mi][nj][i] += bfs2f(gq[mi][nj][i]) * acc[mi][nj][i];
    }
    stage_rowmajor<4, 2>(smem, o, wm, wn, fr, fq, [](const f32x4& a) { return a; });
    __syncthreads();
    bf16_t* gb = G + (size_t)row0 * 1024 + col0;
    writeout<128, 8, CST_B>(smem, tid_, [&](int line, int c) { return gb + (size_t)line * 1024 + c * 8; });
    __syncthreads();
  }
}

template <int MODE>
DI void phase_gemm_plain(const bf16_t* A, int K, const bf16_t* Bt, int N, bf16_t* outp, char* smem) {
  const int tid_ = otid(), lane = tid_ & 63, wid = tid_ >> 6, wm = wid >> 1, wn = wid & 1, fr = lane & 15, fq = lane >> 4;
  const int ntn = N / 128;
  for (int it = 0;; ++it) {
    int tm, tn;
    if (!tile_sched(it, 64, ntn, tm, tn)) break;
    const int row0 = tm * 256, col0 = tn * 128;
    f32x4 acc[8][4];
    zero_acc2(acc);
    gemm2_mainloop(A, K, Bt, K, K, row0, col0, smem, acc);
    stage_rowmajor<8, 4>(smem, acc, wm, wn, fr, fq, [](const f32x4& a) {
      f32x4 v = a;
      if (MODE == 1) {
        v[0] = fmaxf(v[0], 0.f); v[1] = fmaxf(v[1], 0.f); v[2] = fmaxf(v[2], 0.f); v[3] = fmaxf(v[3], 0.f);
        v[0] *= v[0]; v[1] *= v[1]; v[2] *= v[2]; v[3] *= v[3];
      }
      return v;
    });
    __syncthreads();
    bf16_t* ob = outp + (size_t)row0 * N + col0;
    writeout<256, 16, CST_B>(smem, tid_, [&](int line, int c) { return ob + (size_t)line * N + c * 8; });
    __syncthreads();
  }
}

DI void phase_mod(const P& p, char* smem) {
  float* ssil = (float*)smem;
  float* red = ssil + 5 * 1024;
  const int tid = otid();
  float* MOD = (float*)(p.ws + WS_MOD);
  for (int idx = tid; idx < 5120; idx += 256) {
    int j = idx >> 10, k = idx & 1023;
    float cv = (j == 0) ? p.in[11][k] : p.in[10][(j - 1) * 1024 + k];
    ssil[idx] = cv / (1.f + expf(-cv));
  }
  __syncthreads();
  const int cl = tid & 63, kg = tid >> 6;
  for (int item = blockIdx.x; item < 384; item += gridDim.x) {
    int l = item / 96, cgp = item % 96;
    int col = cgp * 64 + cl;
    const float* W = p.in[12] + (size_t)l * 1024 * 6144 + col;
    float a0 = 0, a1 = 0, a2 = 0, a3 = 0, a4 = 0;
    for (int k = kg * 256; k < kg * 256 + 256; ++k) {
      float w = W[(size_t)k * 6144];
      a0 += ssil[k] * w;
      a1 += ssil[1024 + k] * w;
      a2 += ssil[2048 + k] * w;
      a3 += ssil[3072 + k] * w;
      a4 += ssil[4096 + k] * w;
    }
    red[(kg * 5 + 0) * 64 + cl] = a0;
    red[(kg * 5 + 1) * 64 + cl] = a1;
    red[(kg * 5 + 2) * 64 + cl] = a2;
    red[(kg * 5 + 3) * 64 + cl] = a3;
    red[(kg * 5 + 4) * 64 + cl] = a4;
    __syncthreads();
    if (kg == 0) {
      float bias = p.in[13][l * 6144 + col];
#pragma unroll
      for (int j = 0; j < 5; ++j) {
        float s = red[(0 * 5 + j) * 64 + cl] + red[(1 * 5 + j) * 64 + cl] + red[(2 * 5 + j) * 64 + cl] + red[(3 * 5 + j) * 64 + cl];
        MOD[(size_t)(l * 5 + j) * 6144 + col] = s + bias;
      }
    }
    __syncthreads();
  }
}

DI void transpose_tile(const float* __restrict__ src, int lds_, bf16_t* __restrict__ dst, int ldd, float* tile) {
  const int tid = otid();
#pragma unroll 4
  for (int i = 0; i < 16; ++i) {
    int idx = tid + i * 256, r = idx >> 6, c = idx & 63;
    tile[r * 65 + c] = src[(size_t)r * lds_ + c];
  }
  __syncthreads();
#pragma unroll 4
  for (int i = 0; i < 16; ++i) {
    int idx = tid + i * 256, c = idx >> 6, r = idx & 63;
    dst[(size_t)c * ldd + r] = f2bf(tile[r * 65 + c]);
  }
  __syncthreads();
}

DI void phase_convert(const P& p, int l, char* smem) {
  float* tile = (float*)smem;
  char* ws = p.ws;
  const int NJ = 6432;
  for (int j = blockIdx.x; j < NJ; j += gridDim.x) {
    int q = j;
    if (q < 2560) {
      int tr = q / 160, tc = q % 160;
      transpose_tile(p.in[18] + (size_t)l * 1024 * 10240 + (size_t)tr * 64 * 10240 + tc * 64, 10240,
                     (bf16_t*)(ws + WS_WIN) + (size_t)tc * 64 * 1024 + tr * 64, 1024, tile);
      continue;
    }
    q -= 2560;
    if (q < 512) {
      int tr = q / 16, tc = q % 16;
      transpose_tile(p.in[40] + (size_t)l * 2048 * 1024 + (size_t)tr * 64 * 1024 + tc * 64, 1024,
                     (bf16_t*)(ws + WS_WBR) + (size_t)tc * 64 * 2048 + tr * 64, 2048, tile);
      continue;
    }
    q -= 512;
    if (q < 256) {
      int tr = q / 16, tc = q % 16;
      transpose_tile(p.in[41] + (size_t)l * 1024 * 1024 + (size_t)tr * 64 * 1024 + tc * 64, 1024,
                     (bf16_t*)(ws + WS_WOUT) + (size_t)tc * 64 * 1024 + tr * 64, 1024, tile);
      continue;
    }
    q -= 256;
    if (q < 1024) {
      int tr = q / 64, tc = q % 64;
      transpose_tile(p.in[42] + (size_t)l * 1024 * 4096 + (size_t)tr * 64 * 4096 + tc * 64, 4096,
                     (bf16_t*)(ws + WS_W1) + (size_t)tc * 64 * 1024 + tr * 64, 1024, tile);
      continue;
    }
    q -= 1024;
    if (q < 1024) {
      int tr = q / 16, tc = q % 16;
      transpose_tile(p.in[43] + (size_t)l * 4096 * 1024 + (size_t)tr * 64 * 1024 + tc * 64, 1024,
                     (bf16_t*)(ws + WS_W2) + (size_t)tc * 64 * 4096 + tr * 64, 4096, tile);
      continue;
    }
    q -= 1024;
    if (q < 32) {
      int type = q >> 3, n = q & 7;
      const float* src = (type == 0 ? p.in[30] : type == 1 ? p.in[32] : type == 2 ? p.in[35] : p.in[37]) + (size_t)(l * 8 + n) * 4096;
      transpose_tile(src, 64, (bf16_t*)(ws + WS_WLRU) + (size_t)(type * 8 + n) * 4096, 64, tile);
      continue;
    }
    q -= 32;
    if (q < 256) {
      int bh = q >> 3, tr = q & 7, b = bh >> 3, h = bh & 7;
      transpose_tile(p.in[3] + ((size_t)((b * 4 + l) * 8 + h)) * 32768 + (size_t)tr * 64 * 64, 64,
                     (bf16_t*)(ws + WS_CVNA) + (size_t)bh * 32768 + tr * 64, 512, tile);
      continue;
    }
    q -= 256;
    if (q < 256) {
      int bh = q >> 4, t2 = q & 15, tr = t2 >> 1, tc = t2 & 1, b = bh >> 2, h = bh & 3;
      transpose_tile(p.in[5] + ((size_t)((b * 4 + l) * 4 + h)) * 65536 + (size_t)tr * 64 * 128 + tc * 64, 128,
                     (bf16_t*)(ws + WS_CVDF) + (size_t)bh * 65536 + (size_t)tc * 64 * 512 + tr * 64, 512, tile);
      continue;
    }
    q -= 256;
    {
      int tensor = q >> 8, b = (q >> 6) & 3, chunk = q & 63;
      const float* src = (tensor == 0 ? p.in[2] : p.in[4]) + (size_t)(b * 4 + l) * 262144 + (size_t)chunk * 4096;
      bf16_t* dst = (bf16_t*)(ws + (tensor == 0 ? WS_CKNA : WS_CKDF)) + (size_t)b * 262144 + (size_t)chunk * 4096;
#pragma unroll
      for (int i = 0; i < 4; ++i) {
        int e = (otid() + i * 256) * 4;
        float4 v = *(const float4*)(src + e);
        *(bf16x4*)(dst + e) = pack4(v.x, v.y, v.z, v.w);
      }
    }
  }
}

DI void phase_row(const P& p, int l, int mode) {
  const int tid_ = otid(), lane = tid_ & 63, wid = tid_ >> 6;
  const float* MOD = (const float*)(p.ws + WS_MOD);
  float* X = p.out;
  bf16_t* H = (bf16_t*)(p.ws + WS_H);
  const bf16_t* Y = (const bf16_t*)(p.ws + WS_Y);
  const bool from_inputs = (mode == 0 || (mode == 1 && l == 0));
  auto xsrc = [&](int r) -> const float* {
    return from_inputs ? ((r < NCTX) ? (p.in[0] + (size_t)r * D) : (p.in[1] + (size_t)(r - NCTX) * D)) : (X + (size_t)r * D);
  };
  int rb = blockIdx.x;
  if (rb >= 4096) return;
  float4 xn[4];
  bf16x4 yn[4];
  {
    const int r = rb * 4 + wid;
    const float* xs = xsrc(r);
#pragma unroll
    for (int j = 0; j < 4; ++j) xn[j] = *(const float4*)(xs + j * 256 + lane * 4);
    if (mode != 0) {
#pragma unroll
      for (int j = 0; j < 4; ++j) yn[j] = *(const bf16x4*)(Y + (size_t)r * D + j * 256 + lane * 4);
    }
  }
  for (; rb < 4096; rb += gridDim.x) {
    const int r = rb * 4 + wid;
    const int mi = r < NCTX ? 0 : 1 + ((r - NCTX) >> 11);
    float4 xv[4], yv[4];
#pragma unroll
    for (int j = 0; j < 4; ++j) { xv[j] = xn[j]; yv[j] = make_float4(bfs2f(yn[j][0]), bfs2f(yn[j][1]), bfs2f(yn[j][2]), bfs2f(yn[j][3])); }
    {
      const int rbn = (rb + (int)gridDim.x < 4096) ? rb + (int)gridDim.x : rb;
      const int rn = rbn * 4 + wid;
      const float* xs = xsrc(rn);
#pragma unroll
      for (int j = 0; j < 4; ++j) xn[j] = *(const float4*)(xs + j * 256 + lane * 4);
      if (mode != 0) {
#pragma unroll
        for (int j = 0; j < 4; ++j) yn[j] = *(const bf16x4*)(Y + (size_t)rn * D + j * 256 + lane * 4);
      }
    }
    if (mode != 0) {
      float ss = 0.f;
#pragma unroll
      for (int j = 0; j < 4; ++j) ss += yv[j].x * yv[j].x + yv[j].y * yv[j].y + yv[j].z * yv[j].z + yv[j].w * yv[j].w;
      ss = wave_sum(ss);
      const float rs = rsqrtf(ss * (1.f / 1024.f) + 1e-6f);
      const float* gpost = (mode == 1 ? p.in[15] : p.in[17]) + l * D;
      const float* gate = MOD + (size_t)(l * 5 + mi) * 6144 + (mode == 1 ? 2048 : 5120);
#pragma unroll
      for (int j = 0; j < 4; ++j) {
        float4 g = *(const float4*)(gpost + j * 256 + lane * 4);
        float4 gt = *(const float4*)(gate + j * 256 + lane * 4);
        xv[j].x += gt.x * (yv[j].x * rs * g.x);
        xv[j].y += gt.y * (yv[j].y * rs * g.y);
        xv[j].z += gt.z * (yv[j].z * rs * g.z);
        xv[j].w += gt.w * (yv[j].w * rs * g.w);
        *(float4*)(X + (size_t)r * D + j * 256 + lane * 4) = xv[j];
      }
    }
    int ln, off_sh, off_sc;
    const float* gpre;
    if (mode == 0) { ln = 0; gpre = p.in[14]; off_sh = 0; off_sc = 1024; }
    else if (mode == 1) { ln = l; gpre = p.in[16] + l * D; off_sh = 3072; off_sc = 4096; }
    else { ln = l + 1; gpre = p.in[14] + (l + 1) * D; off_sh = 0; off_sc = 1024; }
    if (ln < 4) {
      float ss = 0.f;
#pragma unroll
      for (int j = 0; j < 4; ++j) ss += xv[j].x * xv[j].x + xv[j].y * xv[j].y + xv[j].z * xv[j].z + xv[j].w * xv[j].w;
      ss = wave_sum(ss);
      const float rs = rsqrtf(ss * (1.f / 1024.f) + 1e-6f);
      const float* mrow = MOD + (size_t)(ln * 5 + mi) * 6144;
#pragma unroll
      for (int j = 0; j < 4; ++j) {
        int c = j * 256 + lane * 4;
        float4 g = *(const float4*)(gpre + c);
        float4 sc = *(const float4*)(mrow + off_sc + c);
        float4 sh = *(const float4*)(mrow + off_sh + c);
        *(bf16x4*)(H + (size_t)r * D + c) = pack4(xv[j].x * rs * g.x * (1.f + sc.x) + sh.x, xv[j].y * rs * g.y * (1.f + sc.y) + sh.y,
                                                  xv[j].z * rs * g.z * (1.f + sc.z) + sh.z, xv[j].w * rs * g.w * (1.f + sc.w) + sh.w);
      }
    }
  }
}

constexpr int ATT_BUF = 192 * LDT;
DI void qk_scores(const bf16x8 (&qf)[2], const bf16_t* sK, f32x4 (&S)[4], int fr, int fq) {
#pragma unroll
  for (int s = 0; s < 4; ++s) {
    f32x4 z = {0.f, 0.f, 0.f, 0.f};
#pragma unroll
    for (int ks = 0; ks < 2; ++ks) {
      bf16x8 a = *(const bf16x8*)(sK + (16 * s + fr) * LDT + ks * 32 + fq * 8);
      z = MFMA16(a, qf[ks], z);
    }
    S[s] = z;
  }
}
template <int DV>
DI void pv_step(const bf16x8 (&pb)[2], const bf16_t* sV, f32x4 (&O)[DV / 16], int fr, int fq) {
#pragma unroll
  for (int dt = 0; dt < DV / 16; ++dt) {
#pragma unroll
    for (int s2 = 0; s2 < 2; ++s2) {
      const bf16_t* base = sV + (dt * 16 + fr) * LDT + 32 * s2 + 4 * fq;
      bf16x4 lo = *(const bf16x4*)base;
      bf16x4 hi = *(const bf16x4*)(base + 16);
      bf16x8 a = __builtin_shufflevector(lo, hi, 0, 1, 2, 3, 4, 5, 6, 7);
      O[dt] = MFMA16(a, pb[s2], O[dt]);
    }
  }
}
template <int DV>
DI void softmax_pv(f32x4 (&S)[4], const bf16_t* sV, f32x4 (&O)[DV / 16], float& m, float& lsum, int fr, int fq) {
  float tm = -1e30f;
#pragma unroll
  for (int s = 0; s < 4; ++s)
#pragma unroll
    for (int i = 0; i < 4; ++i) tm = fmaxf(tm, S[s][i]);
  tm = fmaxf(tm, __shfl_xor(tm, 16));
  tm = fmaxf(tm, __shfl_xor(tm, 32));
  const float mn = fmaxf(m, tm);
  const float alpha = __expf(m - mn);
  m = mn;
  float ps = 0.f;
#pragma unroll
  for (int s = 0; s < 4; ++s)
#pragma unroll
    for (int i = 0; i < 4; ++i) {
      float pv = __expf(S[s][i] - mn);
      S[s][i] = pv;
      ps += pv;
    }
  lsum = lsum * alpha + ps;
#pragma unroll
  for (int dt = 0; dt < DV / 16; ++dt) {
    O[dt][0] *= alpha; O[dt][1] *= alpha; O[dt][2] *= alpha; O[dt][3] *= alpha;
  }
  bf16x8 pb[2];
  pb[0] = pack8(S[0], S[1]);
  pb[1] = pack8(S[2], S[3]);
  pv_step<DV>(pb, sV, O, fr, fq);
}
template <int DV, bool SOFTMAX, class TileFn, class ScoreFn>
DI void attn_loop(int ntiles, TileFn&& tile, ScoreFn&& score, const bf16x8 (&qf)[2], f32x4 (&O)[DV / 16], float& m, float& lsum,
                  bf16_t* smem, int tid) {
  const int lane = tid & 63, fr = lane & 15, fq = lane >> 4;
  u32x4 rkA[2], rvA[DV / 32], rkB[2], rvB[DV / 32];
  const int sr = tid >> 3, sc = (tid & 7) * 8;
  auto gload = [&](int j, u32x4 (&rk)[2], u32x4 (&rv)[DV / 32]) {
    const bf16_t* Kg; const bf16_t* Vg; int ldk, ldv;
    tile(j, Kg, ldk, Vg, ldv);
#pragma unroll
    for (int i = 0; i < 2; ++i) rk[i] = *(const u32x4*)(Kg + (size_t)(sr + i * 32) * ldk + sc);
#pragma unroll
    for (int i = 0; i < DV / 32; ++i) rv[i] = *(const u32x4*)(Vg + (size_t)(sr + i * 32) * ldv + sc);
  };
  auto sstore = [&](int buf, const u32x4 (&rk)[2], const u32x4 (&rv)[DV / 32]) {
    bf16_t* sK = smem + buf * ATT_BUF;
    bf16_t* sV = sK + 64 * LDT;
#pragma unroll
    for (int i = 0; i < 2; ++i) *(u32x4*)(sK + (sr + i * 32) * LDT + sc) = rk[i];
#pragma unroll
    for (int i = 0; i < DV / 32; ++i) *(u32x4*)(sV + (sr + i * 32) * LDT + sc) = rv[i];
  };
  auto compute = [&](int buf, int j) {
    const bf16_t* sK = smem + buf * ATT_BUF;
    const bf16_t* sV = sK + 64 * LDT;
    f32x4 S[4];
    qk_scores(qf, sK, S, fr, fq);
    score(j, S);
    if (SOFTMAX) {
      softmax_pv<DV>(S, sV, O, m, lsum, fr, fq);
    } else {
      bf16x8 pb[2];
      pb[0] = pack8(S[0], S[1]);
      pb[1] = pack8(S[2], S[3]);
      pv_step<DV>(pb, sV, O, fr, fq);
    }
  };
  const int last = ntiles - 1;
  gload(0, rkA, rvA);
  gload(last < 1 ? last : 1, rkB, rvB);
  sstore(0, rkA, rvA);
  __syncthreads();
  for (int j = 0; j < ntiles; j += 2) {
    gload(j + 2 < last ? j + 2 : last, rkA, rvA);
    asm volatile("" ::: "memory");
    compute(0, j);
    __builtin_amdgcn_sched_barrier(0);
    sstore(1, rkB, rvB);
    __syncthreads();
    if (j + 1 >= ntiles) break;
    gload(j + 3 < last ? j + 3 : last, rkB, rvB);
    asm volatile("" ::: "memory");
    compute(1, j + 1);
    __builtin_amdgcn_sched_barrier(0);
    sstore(0, rkA, rvA);
    __syncthreads();
  }
}
DI void scale_scores(f32x4 (&S)[4]) {
#pragma unroll
  for (int s = 0; s < 4; ++s) { S[s][0] *= 0.125f; S[s][1] *= 0.125f; S[s][2] *= 0.125f; S[s][3] *= 0.125f; }
}

DI void dense_item(const P& p, int b, int h, int qb, char* smem) {
  const int tid = otid(), lane = tid & 63, wid = tid >> 6, fr = lane & 15, fq = lane >> 4;
  const bf16_t* Z = (const bf16_t*)(p.ws + WS_Z);
  const bf16_t* VT = (const bf16_t*)(p.ws + WS_VTNA) + (size_t)(b * 512 + h * 64) * 256;
  bf16_t* Y4 = (bf16_t*)(p.ws + WS_Y4);
  const int rowbase = b * 256;
  const int qrow = rowbase + qb * 64 + wid * 16 + fr;
  bf16x8 qf[2];
#pragma unroll
  for (int ks = 0; ks < 2; ++ks) qf[ks] = *(const bf16x8*)(Z + (size_t)qrow * ZLD + ZC_NAQ + h * 64 + ks * 32 + fq * 8);
  f32x4 O[4];
#pragma unroll
  for (int dt = 0; dt < 4; ++dt) O[dt] = f32x4{0.f, 0.f, 0.f, 0.f};
  float m = -1e30f, lsum = 0.f;
  const bf16_t* Kb = Z + (size_t)rowbase * ZLD + ZC_NAK + h * 64;
  attn_loop<64, true>(4,
      [&](int j, const bf16_t*& Kg, int& ldk, const bf16_t*& Vg, int& ldv) { Kg = Kb + (size_t)j * 64 * ZLD; ldk = ZLD; Vg = VT + j * 64; ldv = 256; },
      [&](int, f32x4 (&S)[4]) { scale_scores(S); }, qf, O, m, lsum, (bf16_t*)smem, tid);
  float lt = lsum + __shfl_xor(lsum, 16);
  lt += __shfl_xor(lt, 32);
  const float inv = 1.f / lt;
#pragma unroll
  for (int dt = 0; dt < 4; ++dt)
    *(bf16x4*)(Y4 + (size_t)qrow * 2048 + h * 64 + dt * 16 + fq * 4) = pack4(O[dt][0] * inv, O[dt][1] * inv, O[dt][2] * inv, O[dt][3] * inv);
}

DI void na_item(const P& p, int l, int b, int h, int r, char* smem) {
  float* srpb = (float*)((bf16_t*)smem + 2 * ATT_BUF);
  const int tid = otid(), lane = tid & 63, wid = tid >> 6, fr = lane & 15, fq = lane >> 4;
  const bf16_t* Z = (const bf16_t*)(p.ws + WS_Z);
  const bf16_t* VT = (const bf16_t*)(p.ws + WS_VTNA) + VT_LAT + (size_t)(b * 512 + h * 64) * 2048;
  const bf16_t* CK = (const bf16_t*)(p.ws + WS_CKNA) + (size_t)(b * 8 + h) * 32768;
  const bf16_t* CVT = (const bf16_t*)(p.ws + WS_CVNA) + (size_t)(b * 8 + h) * 32768;
  bf16_t* Y4 = (bf16_t*)(p.ws + WS_Y4);
  for (int i = tid; i < 465; i += 256) srpb[i] = p.in[19][(size_t)(l * 8 + h) * 465 + i];
  const int rowbase = NCTX + b * 2048;
  const int qcol = wid * 16 + fr;
  const int qrow = rowbase + r * 64 + qcol;
  bf16x8 qf[2];
#pragma unroll
  for (int ks = 0; ks < 2; ++ks) qf[ks] = *(const bf16x8*)(Z + (size_t)qrow * ZLD + ZC_NAQ + h * 64 + ks * 32 + fq * 8);
  f32x4 O[4];
#pragma unroll
  for (int dt = 0; dt < 4; ++dt) O[dt] = f32x4{0.f, 0.f, 0.f, 0.f};
  float m = -1e30f, lsum = 0.f;
  int rs = r - 4;
  rs = rs < 0 ? 0 : (rs > 24 ? 24 : rs);
  int cstart = qcol - 8;
  cstart = cstart < 0 ? 0 : (cstart > 48 ? 48 : cstart);
  const bf16_t* Kb = Z + (size_t)rowbase * ZLD + ZC_NAK + h * 64;
  attn_loop<64, true>(16,
      [&](int j, const bf16_t*& Kg, int& ldk, const bf16_t*& Vg, int& ldv) {
        if (j < 8) { Kg = Kb + (size_t)(rs + j) * 64 * ZLD; ldk = ZLD; Vg = VT + (rs + j) * 64; ldv = 2048; }
        else { Kg = CK + (size_t)(j - 8) * 64 * 64; ldk = 64; Vg = CVT + (j - 8) * 64; ldv = 512; }
      },
      [&](int j, f32x4 (&S)[4]) {
        if (j < 8) {
          const int dr = rs + j - r + 7;
#pragma unroll
          for (int s = 0; s < 4; ++s)
#pragma unroll
            for (int i = 0; i < 4; ++i) {
              int kcol = s * 16 + fq * 4 + i;
              bool ok = (kcol >= cstart) && (kcol < cstart + 16);
              int dc = kcol - qcol + 15;
              dc = dc < 0 ? 0 : (dc > 30 ? 30 : dc);
              float bias = srpb[dr * 31 + dc];
              S[s][i] = ok ? (S[s][i] * 0.125f + bias) : -1e30f;
            }
        } else {
          scale_scores(S);
        }
      },
      qf, O, m, lsum, (bf16_t*)smem, tid);
  float lt = lsum + __shfl_xor(lsum, 16);
  lt += __shfl_xor(lt, 32);
  const float inv = 1.f / lt;
#pragma unroll
  for (int dt = 0; dt < 4; ++dt)
    *(bf16x4*)(Y4 + (size_t)qrow * 2048 + h * 64 + dt * 16 + fq * 4) = pack4(O[dt][0] * inv, O[dt][1] * inv, O[dt][2] * inv, O[dt][3] * inv);
}

DI void diff_item(const P& p, int l, bool latent, int b, int h, int qb, char* smem) {
  const int tid = otid(), lane = tid & 63, wid = tid >> 6, fr = lane & 15, fq = lane >> 4;
  const bf16_t* Z = (const bf16_t*)(p.ws + WS_Z);
  const int T = latent ? 2048 : 256;
  const int rowbase = latent ? NCTX + b * 2048 : b * 256;
  const bf16_t* VT = (const bf16_t*)(p.ws + WS_VTDF) + (latent ? (size_t)VT_LAT + (size_t)(b * 512 + h * 128) * 2048 : (size_t)(b * 512 + h * 128) * 256);
  const bf16_t* CVT = (const bf16_t*)(p.ws + WS_CVDF) + (size_t)(b * 4 + h) * 65536;
  bf16_t* Y4 = (bf16_t*)(p.ws + WS_Y4);
  const int qrow = rowbase + qb * 64 + wid * 16 + fr;
  float d1 = p.in[20][l * 64 + lane] * p.in[21][l * 64 + lane];
  float d2 = p.in[22][l * 64 + lane] * p.in[23][l * 64 + lane];
  d1 = wave_sum(d1);
  d2 = wave_sum(d2);
  const float lam_init = 0.8f - 0.6f * expf(-0.3f * (float)l);
  const float lam = expf(d1) - expf(d2) + lam_init;
  const int nown = T >> 6;
  const int ntiles = nown + (latent ? 8 : 0);

  f32x4 O1[8];
  f32x4 O[8];
#pragma unroll 1
  for (int comp = 0; comp < 2; ++comp) {
    bf16x8 qf[2];
#pragma unroll
    for (int ks = 0; ks < 2; ++ks) qf[ks] = *(const bf16x8*)(Z + (size_t)qrow * ZLD + ZC_DFQ + comp * 256 + h * 64 + ks * 32 + fq * 8);
#pragma unroll
    for (int dt = 0; dt < 8; ++dt) O[dt] = f32x4{0.f, 0.f, 0.f, 0.f};
    float m = -1e30f, lsum = 0.f;
    const bf16_t* Kb = Z + (size_t)rowbase * ZLD + ZC_DFK + comp * 256 + h * 64;
    const bf16_t* CK = (const bf16_t*)(p.ws + WS_CKDF) + (size_t)((b * 2 + comp) * 4 + h) * 32768;
    attn_loop<128, true>(ntiles,
        [&](int j, const bf16_t*& Kg, int& ldk, const bf16_t*& Vg, int& ldv) {
          if (j < nown) { Kg = Kb + (size_t)j * 64 * ZLD; ldk = ZLD; Vg = VT + j * 64; ldv = T; }
          else { Kg = CK + (size_t)(j - nown) * 64 * 64; ldk = 64; Vg = CVT + (j - nown) * 64; ldv = 512; }
        },
        [&](int, f32x4 (&S)[4]) { scale_scores(S); }, qf, O, m, lsum, (bf16_t*)smem, tid);
    float lt = lsum + __shfl_xor(lsum, 16);
    lt += __shfl_xor(lt, 32);
    const float inv = 1.f / lt;
    if (comp == 0) {
#pragma unroll
      for (int dt = 0; dt < 8; ++dt) { O1[dt][0] = O[dt][0] * inv; O1[dt][1] = O[dt][1] * inv; O1[dt][2] = O[dt][2] * inv; O1[dt][3] = O[dt][3] * inv; }
    } else {
#pragma unroll
      for (int dt = 0; dt < 8; ++dt) {
        O[dt][0] = O1[dt][0] - lam * (O[dt][0] * inv);
        O[dt][1] = O1[dt][1] - lam * (O[dt][1] * inv);
        O[dt][2] = O1[dt][2] - lam * (O[dt][2] * inv);
        O[dt][3] = O1[dt][3] - lam * (O[dt][3] * inv);
      }
    }
  }
  float ss = 0.f;
#pragma unroll
  for (int dt = 0; dt < 8; ++dt) ss += O[dt][0] * O[dt][0] + O[dt][1] * O[dt][1] + O[dt][2] * O[dt][2] + O[dt][3] * O[dt][3];
  ss += __shfl_xor(ss, 16);
  ss += __shfl_xor(ss, 32);
  const float rsn = rsqrtf(ss * (1.f / 128.f) + 1e-6f) * (1.f - lam_init);
  const float* gn = p.in[24] + l * 128;
#pragma unroll
  for (int dt = 0; dt < 8; ++dt) {
    int dv = dt * 16 + fq * 4;
    float4 g = *(const float4*)(gn + dv);
    *(bf16x4*)(Y4 + (size_t)qrow * 2048 + 512 + h * 128 + dv) = pack4(O[dt][0] * rsn * g.x, O[dt][1] * rsn * g.y, O[dt][2] * rsn * g.z, O[dt][3] * rsn * g.w);
  }
}

DI void ret_item(const P& p, int l, bool latent, int b, int h, int qb, char* smem) {
  bf16_t* sV0 = (bf16_t*)smem + 64 * LDT;
  const int tid = otid(), lane = tid & 63, wid = tid >> 6, fr = lane & 15, fq = lane >> 4;
  const bf16_t* Z = (const bf16_t*)(p.ws + WS_Z);
  const int T = latent ? 2048 : 256;
  const int rowbase = latent ? NCTX + b * 2048 : b * 256;
  const bf16_t* VT = (const bf16_t*)(p.ws + WS_VTRT) + (latent ? (size_t)VT_LAT + (size_t)(b * 512 + h * 64) * 2048 : (size_t)(b * 512 + h * 64) * 256);
  bf16_t* Y4 = (bf16_t*)(p.ws + WS_Y4);
  const int tq = qb * 64 + wid * 16 + fr;
  const int qrow = rowbase + tq;
  const float lgf = log1pf(-expf(p.in[25][l * 8 + h]));
  const float lgb = log1pf(-expf(p.in[26][l * 8 + h]));
  bf16x8 qf[2];
#pragma unroll
  for (int ks = 0; ks < 2; ++ks) qf[ks] = *(const bf16x8*)(Z + (size_t)qrow * ZLD + ZC_RTQ + h * 64 + ks * 32 + fq * 8);
  f32x4 O[4];
#pragma unroll
  for (int dt = 0; dt < 4; ++dt) O[dt] = f32x4{0.f, 0.f, 0.f, 0.f};
  float mdummy = 0.f, ldummy = 0.f;
  const bf16_t* Kb = Z + (size_t)rowbase * ZLD + ZC_RTK + h * 64;
  attn_loop<64, false>(T >> 6,
      [&](int j, const bf16_t*& Kg, int& ldk, const bf16_t*& Vg, int& ldv) { Kg = Kb + (size_t)j * 64 * ZLD; ldk = ZLD; Vg = VT + j * 64; ldv = T; },
      [&](int j, f32x4 (&S)[4]) {
#pragma unroll
        for (int s = 0; s < 4; ++s)
#pragma unroll
          for (int i = 0; i < 4; ++i) {
            int tk = j * 64 + s * 16 + fq * 4 + i;
            int dd = tq - tk;
            float w = dd >= 0 ? __expf(lgf * (float)dd) : __expf(lgb * (float)(-dd));
            S[s][i] *= w;
          }
      },
      qf, O, mdummy, ldummy, (bf16_t*)smem, tid);
  if (latent) {
    for (int dir = 0; dir < 2; ++dir) {
      const float* S0 = (dir == 0 ? p.in[6] : p.in[7]) + ((size_t)((b * 4 + l) * 8 + h)) * 4096;
#pragma unroll
      for (int i = 0; i < 4; ++i) {
        int e = (tid + i * 256) * 4;
        float4 v = *(const float4*)(S0 + e);
        int dk = e >> 6, dv = e & 63;
        sV0[(dv + 0) * LDT + dk] = f2bf(v.x);
        sV0[(dv + 1) * LDT + dk] = f2bf(v.y);
        sV0[(dv + 2) * LDT + dk] = f2bf(v.z);
        sV0[(dv + 3) * LDT + dk] = f2bf(v.w);
      }
      __syncthreads();
      const float sc = dir == 0 ? __expf(lgf * (float)(tq + 1)) : __expf(lgb * (float)(T - tq));
      bf16x8 pb[2];
#pragma unroll
      for (int s2 = 0; s2 < 2; ++s2) {
        const bf16_t* qp = Z + (size_t)qrow * ZLD + ZC_RTQ + h * 64 + 32 * s2 + 4 * fq;
        bf16x4 lo = *(const bf16x4*)qp;
        bf16x4 hi = *(const bf16x4*)(qp + 16);
        f32x4 flo = {bfs2f(lo[0]) * sc, bfs2f(lo[1]) * sc, bfs2f(lo[2]) * sc, bfs2f(lo[3]) * sc};
        f32x4 fhi = {bfs2f(hi[0]) * sc, bfs2f(hi[1]) * sc, bfs2f(hi[2]) * sc, bfs2f(hi[3]) * sc};
        pb[s2] = pack8(flo, fhi);
      }
      pv_step<64>(pb, sV0, O, fr, fq);
      __syncthreads();
    }
  }
  float ss = 0.f;
#pragma unroll
  for (int dt = 0; dt < 4; ++dt) ss += O[dt][0] * O[dt][0] + O[dt][1] * O[dt][1] + O[dt][2] * O[dt][2] + O[dt][3] * O[dt][3];
  ss += __shfl_xor(ss, 16);
  ss += __shfl_xor(ss, 32);
  const float rsn = rsqrtf(ss * (1.f / 64.f) + 1e-6f);
  const float* gn = p.in[27] + l * 512 + h * 64;
#pragma unroll
  for (int dt = 0; dt < 4; ++dt) {
    int dv = dt * 16 + fq * 4;
    float4 g = *(const float4*)(gn + dv);
    bf16x4 sg = *(const bf16x4*)(Z + (size_t)qrow * ZLD + ZC_RTG + h * 64 + dv);
    *(bf16x4*)(Y4 + (size_t)qrow * 2048 + 1024 + h * 64 + dv) =
        pack4(O[dt][0] * rsn * g.x * bfs2f(sg[0]), O[dt][1] * rsn * g.y * bfs2f(sg[1]), O[dt][2] * rsn * g.z * bfs2f(sg[2]), O[dt][3] * rsn * g.w * bfs2f(sg[3]));
  }
}

DI void ret_state_item(const P& p, int l, int b, int h) {
  const int tid_ = otid(), lane = tid_ & 63, wid = tid_ >> 6, fr = lane & 15, fq = lane >> 4;
  const bf16_t* KT = (const bf16_t*)(p.ws + WS_KTRT) + (size_t)(b * 512 + h * 64) * 256;
  const bf16_t* VT = (const bf16_t*)(p.ws + WS_VTRT) + (size_t)(b * 512 + h * 64) * 256;
  const float lgf = log1pf(-expf(p.in[25][l * 8 + h]));
  const float lgb = log1pf(-expf(p.in[26][l * 8 + h]));
  f32x4 af[4], ab[4];
#pragma unroll
  for (int nt = 0; nt < 4; ++nt) { af[nt] = f32x4{0.f, 0.f, 0.f, 0.f}; ab[nt] = f32x4{0.f, 0.f, 0.f, 0.f}; }
  for (int ks = 0; ks < 8; ++ks) {
    const int t0 = ks * 32 + fq * 8;
    bf16x8 kraw = *(const bf16x8*)(KT + (size_t)(wid * 16 + fr) * 256 + t0);
    bf16x8 kf, kb;
#pragma unroll
    for (int j = 0; j < 8; ++j) {
      float kv = bfs2f(kraw[j]);
      int t = t0 + j;
      kf[j] = (short)f2bf(kv * __expf(lgf * (float)(255 - t)));
      kb[j] = (short)f2bf(kv * __expf(lgb * (float)t));
    }
#pragma unroll
    for (int nt = 0; nt < 4; ++nt) {
      bf16x8 vb = *(const bf16x8*)(VT + (size_t)(nt * 16 + fr) * 256 + t0);
      af[nt] = MFMA16(kf, vb, af[nt]);
      ab[nt] = MFMA16(kb, vb, ab[nt]);
    }
  }
  float* of = p.out + O_RF + ((size_t)((b * 4 + l) * 8 + h)) * 4096;
  float* ob = p.out + O_RB + ((size_t)((b * 4 + l) * 8 + h)) * 4096;
#pragma unroll
  for (int nt = 0; nt < 4; ++nt)
#pragma unroll
    for (int i = 0; i < 4; ++i) {
      int dk = wid * 16 + fq * 4 + i, dv = nt * 16 + fr;
      of[dk * 64 + dv] = af[nt][i];
      ob[dk * 64 + dv] = ab[nt][i];
    }
}

DI void lru_gates_item(const P& p, int l, int chunk, int n, char* smem) {
  float* XDf = (float*)smem;
  bf16_t* XDb = (bf16_t*)(XDf + 4096);
  const int tid = otid(), lane = tid & 63, wid = tid >> 6, fr = lane & 15, fq = lane >> 4;
  const int row0 = chunk * 64;
  const bool latent = row0 >= NCTX;
  const int T = latent ? 2048 : 256;
  const int tseq0 = latent ? ((row0 - NCTX) & 2047) : (row0 & 255);
  const bf16_t* Z = (const bf16_t*)(p.ws + WS_Z);
  const bf16_t* WL = (const bf16_t*)(p.ws + WS_WLRU);
  bf16_t* LA = (bf16_t*)(p.ws + WS_LA);
  bf16_t* LU = (bf16_t*)(p.ws + WS_LU);
  const int ch0 = n * 64;
  {
    const float cw0 = p.in[28][(l * 4 + 0) * 512 + ch0 + lane];
    const float cw1 = p.in[28][(l * 4 + 1) * 512 + ch0 + lane];
    const float cw2 = p.in[28][(l * 4 + 2) * 512 + ch0 + lane];
    const float cw3 = p.in[28][(l * 4 + 3) * 512 + ch0 + lane];
    const float cb = p.in[29][l * 512 + ch0 + lane];
    const bf16_t* xcol = Z + (size_t)row0 * ZLD + ZC_LRX + ch0 + lane;
    const int t0 = wid * 16;
    auto ld = [&](int tl) -> float {
      int ts = tseq0 + tl;
      return (ts < 0 || ts >= T) ? 0.f : bf2f(xcol[(ptrdiff_t)tl * ZLD]);
    };
    float xm1 = ld(t0 - 1), x0 = ld(t0), x1 = ld(t0 + 1);
#pragma unroll
    for (int i = 0; i < 16; ++i) {
      float x2 = ld(t0 + i + 2);
      float xd = cw0 * xm1 + cw1 * x0 + cw2 * x1 + cw3 * x2 + cb;
      XDf[(t0 + i) * 64 + lane] = xd;
      XDb[(t0 + i) * LDT + lane] = f2bf(xd);
      xm1 = x0; x0 = x1; x1 = x2;
    }
  }
  __syncthreads();
  bf16x8 af[2];
#pragma unroll
  for (int ks = 0; ks < 2; ++ks) af[ks] = *(const bf16x8*)(XDb + (wid * 16 + fr) * LDT + ks * 32 + fq * 8);
#pragma unroll 1
  for (int dir = 0; dir < 2; ++dir) {
    const float* bav = (dir == 0 ? p.in[31] : p.in[36]) + l * 512 + ch0;
    const float* bxv = (dir == 0 ? p.in[33] : p.in[38]) + l * 512 + ch0;
    const float* lamv = (dir == 0 ? p.in[34] : p.in[39]) + l * 512 + ch0;
#pragma unroll
    for (int et = 0; et < 4; ++et) {
      f32x4 da = {0.f, 0.f, 0.f, 0.f}, dx = {0.f, 0.f, 0.f, 0.f};
#pragma unroll
      for (int ks = 0; ks < 2; ++ks) {
        bf16x8 wa = *(const bf16x8*)(WL + (size_t)((dir * 2 + 0) * 8 + n) * 4096 + (et * 16 + fr) * 64 + ks * 32 + fq * 8);
        bf16x8 wx = *(const bf16x8*)(WL + (size_t)((dir * 2 + 1) * 8 + n) * 4096 + (et * 16 + fr) * 64 + ks * 32 + fq * 8);
        da = MFMA16(af[ks], wa, da);
        dx = MFMA16(af[ks], wx, dx);
      }
      const int e = et * 16 + fr;
      const float ba_ = bav[e], bx_ = bxv[e];
      const float sp = log1pf(expf(-lamv[e]));
      float lav[4], uv[4];
#pragma unroll
      for (int i = 0; i < 4; ++i) {
        int tl = wid * 16 + fq * 4 + i;
        float rg = sigmoidf_(da[i] + ba_);
        float ig = sigmoidf_(dx[i] + bx_);
        float la = -8.f * rg * sp;
        lav[i] = la;
        uv[i] = sqrtf(1.f - __expf(2.f * la)) * (ig * XDf[tl * 64 + e]);
      }
      const size_t idx = (size_t)dir * 8388608 + ((size_t)chunk * 512 + ch0 + e) * 64 + wid * 16 + fq * 4;
      *(bf16x4*)(LA + idx) = pack4(lav[0], lav[1], lav[2], lav[3]);
      *(bf16x4*)(LU + idx) = pack4(uv[0], uv[1], uv[2], uv[3]);
    }
  }
  __syncthreads();
}

DI void lru_scan_witem(const P& p, int l, int bglob, int g, int lane) {
  const bool latent = bglob >= 32;
  const int T = latent ? 2048 : 256;
  const int rowbase = latent ? NCTX + (bglob - 32) * 2048 : bglob * 256;
  const int chunk0 = rowbase >> 6, nch = T >> 6;
  const int ch = g * 64 + lane;
  const bf16_t* LA = (const bf16_t*)(p.ws + WS_LA);
  const bf16_t* LU = (const bf16_t*)(p.ws + WS_LU);
  bf16_t* HF = (bf16_t*)(p.ws + WS_HF);
  const bf16_t* LG = (const bf16_t*)(p.ws + WS_LG);
  bf16_t* Y4 = (bf16_t*)(p.ws + WS_Y4);
  {
    float h = latent ? p.in[8][((bglob - 32) * 4 + l) * 512 + ch] : 0.f;
    bf16x8 ca[8], cu[8], na[8], nu[8];
    {
      const size_t b0 = ((size_t)chunk0 * 512 + ch) * 64;
#pragma unroll
      for (int q = 0; q < 8; ++q) { ca[q] = *(const bf16x8*)(LA + b0 + q * 8); cu[q] = *(const bf16x8*)(LU + b0 + q * 8); }
    }
    for (int cc = 0; cc < nch; ++cc) {
      const size_t cbase = ((size_t)(chunk0 + cc) * 512 + ch) * 64;
      const int cn = (cc + 1 < nch) ? cc + 1 : cc;
      const size_t nb = ((size_t)(chunk0 + cn) * 512 + ch) * 64;
#pragma unroll
      for (int q = 0; q < 8; ++q) { na[q] = *(const bf16x8*)(LA + nb + q * 8); nu[q] = *(const bf16x8*)(LU + nb + q * 8); }
#pragma unroll
      for (int q = 0; q < 8; ++q) {
        bf16x8 ho;
#pragma unroll
        for (int j = 0; j < 8; ++j) {
          float a = __expf(bfs2f(ca[q][j]));
          h = a * h + bfs2f(cu[q][j]);
          ho[j] = (short)f2bf(h);
        }
        *(bf16x8*)(HF + cbase + q * 8) = ho;
      }
#pragma unroll
      for (int q = 0; q < 8; ++q) { ca[q] = na[q]; cu[q] = nu[q]; }
    }
    if (!latent) p.out[O_LF + (size_t)(bglob * 4 + l) * 512 + ch] = h;
  }
  {
    float h = latent ? p.in[9][((bglob - 32) * 4 + l) * 512 + ch] : 0.f;
    const bf16_t* LAb = LA + 8388608;
    const bf16_t* LUb = LU + 8388608;
    bf16x8 ca[4], cu[4], chf[4], cg_[4], na[4], nu[4], nhf[4], ng[4];
    const int nb_ = 2 * nch;
    {
      const size_t b0 = ((size_t)(chunk0 + nch - 1) * 512 + ch) * 64 + 32;
#pragma unroll
      for (int q = 0; q < 4; ++q) {
        ca[q] = *(const bf16x8*)(LAb + b0 + q * 8); cu[q] = *(const bf16x8*)(LUb + b0 + q * 8);
        chf[q] = *(const bf16x8*)(HF + b0 + q * 8); cg_[q] = *(const bf16x8*)(LG + b0 + q * 8);
      }
    }
    for (int bi = 0; bi < nb_; ++bi) {
      const int chunk = nch - 1 - (bi >> 1), half = 1 - (bi & 1);
      const int bn = (bi + 1 < nb_) ? bi + 1 : bi;
      const int chunkn = nch - 1 - (bn >> 1), halfn = 1 - (bn & 1);
      const size_t nb = ((size_t)(chunk0 + chunkn) * 512 + ch) * 64 + halfn * 32;
#pragma unroll
      for (int q = 0; q < 4; ++q) {
        na[q] = *(const bf16x8*)(LAb + nb + q * 8); nu[q] = *(const bf16x8*)(LUb + nb + q * 8);
        nhf[q] = *(const bf16x8*)(HF + nb + q * 8); ng[q] = *(const bf16x8*)(LG + nb + q * 8);
      }
      bf16_t* yrow = Y4 + (size_t)(rowbase + chunk * 64 + half * 32) * 2048 + 1536 + ch;
#pragma unroll
      for (int q = 3; q >= 0; --q) {
#pragma unroll
        for (int j = 7; j >= 0; --j) {
          float a = __expf(bfs2f(ca[q][j]));
          h = a * h + bfs2f(cu[q][j]);
          float y = (bfs2f(chf[q][j]) + h) * bfs2f(cg_[q][j]);
          yrow[(size_t)(q * 8 + j) * 2048] = f2bf(y);
        }
      }
#pragma unroll
      for (int q = 0; q < 4; ++q) { ca[q] = na[q]; cu[q] = nu[q]; chf[q] = nhf[q]; cg_[q] = ng[q]; }
    }
    if (!latent) p.out[O_LB + (size_t)(bglob * 4 + l) * 512 + ch] = h;
  }
}

DI int next_item(unsigned* ctr, int* s_item) {
  __syncthreads();
  if (threadIdx.x == 0) *s_item = (int)atomicAdd(ctr, 1u);
  __syncthreads();
  return *s_item;
}
DI void phase_mixa(const P& p, int l, char* smem, int* s_item) {
  unsigned* ctr = (unsigned*)(p.ws + WS_BAR + 14336) + l * 2;
  const int NGRAB = 512 + 512;
  for (;;) {
    int q = next_item(ctr, s_item);
    if (q >= NGRAB) break;
    if (q < 512) { diff_item(p, l, true, q >> 7, (q >> 5) & 3, q & 31, smem); continue; }
    q -= 512;
#pragma unroll 1
    for (int u = 0; u < 4; ++u) { const int g = q * 4 + u; lru_gates_item(p, l, g >> 3, g & 7, smem); }
  }
}
DI void phase_mixb(const P& p, int l, char* smem, int* s_item) {
  unsigned* ctr = (unsigned*)(p.ws + WS_BAR + 14336) + l * 2 + 1;
  const int NGRAB = 72 + 1024 + 1024 + 256 + 256 + 256 + 32;
  for (;;) {
    int q = next_item(ctr, s_item);
    if (q >= NGRAB) break;
    if (q < 72) {
      const int tid = otid(), lane = tid & 63, wid = tid >> 6;
      int bglob, g;
      if (q < 32) {
        if (wid == 0) { bglob = 32 + (q >> 3); g = q & 7; }
        else { int ci = q * 3 + wid - 1; bglob = ci >> 3; g = ci & 7; }
      } else {
        int ci = 96 + (q - 32) * 4 + wid;
        bglob = ci >> 3; g = ci & 7;
      }
      lru_scan_witem(p, l, bglob, g, lane);
      continue;
    }
    q -= 72;
    if (q < 1024) { ret_item(p, l, true, q >> 8, (q >> 5) & 7, q & 31, smem); continue; }
    q -= 1024;
    if (q < 1024) { na_item(p, l, q >> 8, (q >> 5) & 7, q & 31, smem); continue; }
    q -= 1024;
    if (q < 256) {
#pragma unroll 1
      for (int u = 0; u < 2; ++u) { const int g = q * 2 + u; diff_item(p, l, false, g >> 4, (g >> 2) & 3, g & 3, smem); }
      continue;
    }
    q -= 256;
    if (q < 256) {
#pragma unroll 1
      for (int u = 0; u < 4; ++u) { const int g = q * 4 + u; dense_item(p, g >> 5, (g >> 2) & 7, g & 3, smem); }
      continue;
    }
    q -= 256;
    if (q < 256) {
#pragma unroll 1
      for (int u = 0; u < 4; ++u) { const int g = q * 4 + u; ret_item(p, l, false, g >> 5, (g >> 2) & 7, g & 3, smem); }
      continue;
    }
    q -= 256;
#pragma unroll 1
    for (int u = 0; u < 8; ++u) { const int g = q * 8 + u; ret_state_item(p, l, g >> 3, g & 7); }
  }
}

#define XB_TMO 128
#define XB_XCNT(j) (256 + 64 * (j))
#define XB_XSUB(j) (1280 + 64 * (j))
#define XB_XGEN(j) (2304 + 64 * (j))
#define XB_TOP 3328
#define XB_TOPGEN 3392
#define XCD_BAR_WORDS 3456
#define XB_SPIN_CAP (1u << 18)
#define LAS __attribute__((address_space(3)))
DI unsigned xb_ld(unsigned* p) { return __hip_atomic_load(p, __ATOMIC_RELAXED, __HIP_MEMORY_SCOPE_AGENT); }
DI unsigned xb_add(unsigned* p, unsigned v) { return __hip_atomic_fetch_add(p, v, __ATOMIC_RELAXED, __HIP_MEMORY_SCOPE_AGENT); }
DI unsigned xb_xcc_id() { return (unsigned)__builtin_amdgcn_s_getreg((3 << 11) | 20) & 0xFu; }
#define XB_SPIN(cond, bar) do { unsigned _sp = 0; while (cond) { __builtin_amdgcn_s_sleep(1); \
    if ((++_sp & 255u) == 0u) { if (xb_ld(&(bar)[XB_TMO])) break; if (_sp > XB_SPIN_CAP) { atomicAdd(&(bar)[XB_TMO], 1u); break; } } } } while (0)
struct XcdBarrier { unsigned* bar; unsigned x; volatile LAS unsigned* st; };
DI XcdBarrier xcd_barrier_post(unsigned* bar, volatile LAS unsigned* st) {
  XcdBarrier b; b.bar = bar; b.x = xb_xcc_id(); b.st = st;
  if (threadIdx.x == 0) (void)xb_add(&bar[XB_XCNT(b.x)], 1u);
  return b;
}
DI void xcd_barrier_complete(unsigned* bar, unsigned x, unsigned& nloc, unsigned& nx) {
  const unsigned G = gridDim.x * gridDim.y * gridDim.z;
  unsigned sum, cnt, mine, sp = 0u;
  for (;;) {
    sum = 0u; cnt = 0u; mine = 0u;
#pragma unroll
    for (unsigned j = 0; j < 16; ++j) { const unsigned c = xb_ld(&bar[XB_XCNT(j)]); sum += c; cnt += (c > 0u) ? 1u : 0u; mine = (j == x) ? c : mine; }
    if (sum == G) break;
    __builtin_amdgcn_s_sleep(1);
    if ((++sp & 255u) == 0u) { if (xb_ld(&bar[XB_TMO])) break; if (sp > XB_SPIN_CAP) { atomicAdd(&bar[XB_TMO], 1u); break; } }
  }
  nloc = mine > 0u ? mine : 1u; nx = cnt > 0u ? cnt : 1u;
}
DI void xcd_barrier(const XcdBarrier& b) {
  asm volatile("s_waitcnt vmcnt(0)" ::: "memory");
  __syncthreads();
  if (threadIdx.x == 0) {
    unsigned* bar = b.bar;
    __builtin_amdgcn_s_waitcnt(0);
    unsigned nloc = b.st[0], nx = b.st[1];
    if (nloc == 0u) { xcd_barrier_complete(bar, b.x, nloc, nx); b.st[0] = nloc; b.st[1] = nx; }
    const unsigned old = xb_add(&bar[XB_XSUB(b.x)], 1u);
    const unsigned gen = old / nloc;
    if (old + 1u == (gen + 1u) * nloc) {
      __builtin_amdgcn_fence(__ATOMIC_RELEASE, "agent");
      asm volatile("s_waitcnt vmcnt(0)" ::: "memory");
      const unsigned og = xb_add(&bar[XB_TOP], 1u);
      const unsigned tg = og / nx;
      if (og + 1u == (tg + 1u) * nx) xb_add(&bar[XB_TOPGEN], 1u);
      else XB_SPIN(xb_ld(&bar[XB_TOPGEN]) == tg, bar);
      __builtin_amdgcn_fence(__ATOMIC_ACQUIRE, "agent");
      xb_add(&bar[XB_XGEN(b.x)], 1u);
      asm volatile("s_waitcnt vmcnt(0)" ::: "memory");
    } else {
      XB_SPIN(xb_ld(&bar[XB_XGEN(b.x)]) == gen, bar);
      __builtin_amdgcn_fence(__ATOMIC_ACQUIRE, "agent");
      asm volatile("s_waitcnt vmcnt(0)" ::: "memory");
    }
  }
  __syncthreads();
}

enum { PH_INIT = 0, PH_PRE0, PH_GIN, PH_MIXA, PH_MIXB, PH_MERGE, PH_OUT, PH_POSTMIX, PH_FF1, PH_FF2, PH_POSTFFN };

DI void run_phase(const P& p, int ph, int l, char* smem, int* s_item) {
  switch (ph) {
    case PH_INIT:
      phase_mod(p, smem);
      phase_convert(p, 0, smem);
      break;
    case PH_PRE0: phase_row(p, 0, 0); break;
    case PH_GIN: phase_gin(p, l, smem); break;
    case PH_MIXA: phase_mixa(p, l, smem, s_item); break;
    case PH_MIXB: phase_mixb(p, l, smem, s_item); break;
    case PH_MERGE: phase_merge(p, smem); break;
    case PH_OUT:
      phase_gemm_plain<0>((const bf16_t*)(p.ws + WS_H), 1024, (const bf16_t*)(p.ws + WS_WOUT), 1024, (bf16_t*)(p.ws + WS_Y), smem);
      break;
    case PH_POSTMIX: phase_row(p, l, 1); break;
    case PH_FF1:
      phase_gemm_plain<1>((const bf16_t*)(p.ws + WS_H), 1024, (const bf16_t*)(p.ws + WS_W1), 4096, (bf16_t*)(p.ws + WS_U), smem);
      break;
    case PH_FF2:
      phase_gemm_plain<0>((const bf16_t*)(p.ws + WS_U), 4096, (const bf16_t*)(p.ws + WS_W2), 1024, (bf16_t*)(p.ws + WS_Y), smem);
      break;
    case PH_POSTFFN:
      phase_row(p, l, 2);
      if (l < 3) phase_convert(p, l + 1, smem);
      break;
    default: break;
  }
}

DI void decode_step(int step, int& ph, int& l) {
  if (step < 2) { ph = step; l = 0; }
  else { int s = step - 2; l = s / 9; ph = PH_GIN + (s % 9); }
}
constexpr int NSTEPS = 38;

__global__ void __launch_bounds__(256, 2) hybrid_flow_mega(P p) {
  __shared__ __attribute__((aligned(16))) char smem[SMEM_BYTES];
  __shared__ uint4 xb_words;
  __shared__ int s_item;
  cg::grid_group grid = cg::this_grid();
  if (threadIdx.x == 0) xb_words = make_uint4(0u, 0u, 0u, 0u);
  __syncthreads();
  XcdBarrier xb = xcd_barrier_post((unsigned*)(p.ws + WS_BAR), (volatile LAS unsigned*)&xb_words);
  for (int step = 0; step < NSTEPS; ++step) {
    int ph, l;
    decode_step(step, ph, l);
#ifdef PROBE_DUP
    const int reps = (ph == PROBE_DUP) ? 2 : 1;
    for (int rep = 0; rep < reps; ++rep)
#endif
    run_phase(p, ph, l, smem, &s_item);
#ifdef PROBE_CONV
    if (ph == PH_POSTFFN && l < 3) phase_convert(p, l + 1, smem);
#endif
    if (step == 0) grid.sync();
    else if (step + 1 < NSTEPS) xcd_barrier(xb);
#ifdef PROBE_SYNC
    if (step + 1 < NSTEPS) xcd_barrier(xb);
#endif
  }
}

#if !ONE_LAUNCH
__global__ void __launch_bounds__(256, 2) hybrid_flow_phase(P p, int ph, int l) {
  __shared__ __attribute__((aligned(16))) char smem[SMEM_BYTES];
  __shared__ int s_item;
  run_phase(p, ph, l, smem, &s_item);
}
#endif

extern "C" void kernel_launch(void* const* d_in, const int* in_sizes, int n_in, void* d_out, int out_size, void* d_ws,
                              size_t ws_size, hipStream_t stream) {
  (void)in_sizes; (void)n_in; (void)out_size; (void)ws_size;
  P p{};
  for (int i = 0; i < 44; ++i) p.in[i] = (const float*)d_in[i];
  p.out = (float*)d_out;
  p.ws = (char*)d_ws;
#if ONE_LAUNCH
  static int grid_blocks = 0;
  if (!grid_blocks) {
    int dev = 0, cus = 0, per_cu = 0;
    hipGetDevice(&dev);
    hipDeviceGetAttribute(&cus, hipDeviceAttributeMultiprocessorCount, dev);
    hipOccupancyMaxActiveBlocksPerMultiprocessor(&per_cu, hybrid_flow_mega, 256, 0);
    if (per_cu < 1) per_cu = 1;
    if (per_cu > 2) per_cu = 2;
    grid_blocks = cus * per_cu;
  }
  (void)hipMemsetAsync((char*)d_ws + WS_BAR, 0, 16384, stream);
  void* args[] = {&p};
  hipError_t e = hipLaunchCooperativeKernel((void*)hybrid_flow_mega, dim3(grid_blocks), dim3(256), args, 0, stream);
  if (e != hipSuccess) fprintf(stderr, "cooperative launch failed: %s (grid %d)\n", hipGetErrorString(e), grid_blocks);
#else
  const int grid_blocks = 512;
  for (int step = 0; step < NSTEPS; ++step) {
    int ph, l;
    if (step < 2) { ph = step; l = 0; }
    else { int s = step - 2; l = s / 9; ph = PH_GIN + (s % 9); }
    hipLaunchKernelGGL(hybrid_flow_phase, dim3(grid_blocks), dim3(256), 0, stream, p, ph, l);
  }
#endif
}
```

```cpp
#include <hip/hip_runtime.h>
#include <hip/hip_cooperative_groups.h>
#include <cstdio>
namespace cg = cooperative_groups;

#ifndef ONE_LAUNCH
#define ONE_LAUNCH 1
#endif

typedef unsigned short bf16_t;
using bf16x8 = __attribute__((ext_vector_type(8))) short;
using bf16x4 = __attribute__((ext_vector_type(4))) short;
using f32x4 = __attribute__((ext_vector_type(4))) float;
using u32x4 = __attribute__((ext_vector_type(4))) unsigned;
#define DI __device__ __forceinline__
#define MFMA16(a, b, c) __builtin_amdgcn_mfma_f32_16x16x32_bf16((a), (b), (c), 0, 0, 0)

struct P {
  const float* in[44];
  float* out;
  char* ws;
};

constexpr int D = 1024, NCTX = 8192;
constexpr int ZLD = 4160;
constexpr int ZC_NAQ = 0, ZC_NAK = 512, ZC_DFQ = 1024, ZC_DFK = 1536, ZC_RTQ = 2048, ZC_RTK = 2560, ZC_RTG = 3072,
              ZC_LRX = 3584;
constexpr int LDT = 72;

constexpr size_t WS_WIN = 0;
constexpr size_t WS_WBR = WS_WIN + (size_t)10240 * 1024 * 2;
constexpr size_t WS_WOUT = WS_WBR + (size_t)1024 * 2048 * 2;
constexpr size_t WS_W1 = WS_WOUT + (size_t)1024 * 1024 * 2;
constexpr size_t WS_W2 = WS_W1 + (size_t)4096 * 1024 * 2;
constexpr size_t WS_WLRU = WS_W2 + (size_t)4096 * 1024 * 2;
constexpr size_t WS_CKNA = WS_WLRU + (size_t)32 * 4096 * 2;
constexpr size_t WS_CVNA = WS_CKNA + (size_t)4 * 262144 * 2;
constexpr size_t WS_CKDF = WS_CVNA + (size_t)4 * 262144 * 2;
constexpr size_t WS_CVDF = WS_CKDF + (size_t)4 * 262144 * 2;
constexpr size_t WS_MOD = WS_CVDF + (size_t)4 * 262144 * 2;
constexpr size_t WS_H = WS_MOD + (size_t)4 * 5 * 6144 * 4;
constexpr size_t WS_Y4 = WS_H + (size_t)16384 * 1024 * 2;
constexpr size_t WS_VTNA = WS_Y4 + (size_t)16384 * 2048 * 2;
constexpr size_t WS_VTDF = WS_VTNA + (size_t)16384 * 512 * 2;
constexpr size_t WS_VTRT = WS_VTDF + (size_t)16384 * 512 * 2;
constexpr size_t WS_KTRT = WS_VTRT + (size_t)16384 * 512 * 2;
constexpr size_t WS_Z = WS_KTRT + (size_t)8192 * 512 * 2;
constexpr size_t WS_GF = WS_Z + (size_t)16384 * ZLD * 2;
constexpr size_t WS_Y = WS_Z;
constexpr size_t WS_U = WS_Z + (size_t)16384 * 1024 * 4;
constexpr size_t WS_LA = WS_GF + (size_t)16384 * 4096 * 2;
constexpr size_t WS_LU = WS_LA + (size_t)2 * 16384 * 512 * 2;
constexpr size_t WS_HF = WS_LU + (size_t)2 * 16384 * 512 * 2;
constexpr size_t WS_LG = WS_HF + (size_t)16384 * 512 * 2;
constexpr size_t WS_BAR = WS_LG + (size_t)16384 * 512 * 2;
constexpr size_t WS_END = WS_BAR + 16384;

constexpr size_t O_NAK = 16777216, O_NAV = 33554432, O_DFK = 50331648, O_DFV = 67108864, O_RF = 83886080,
                 O_RB = 88080384, O_LF = 92274688, O_LB = 92340224;
constexpr int VT_LAT = 4194304;

constexpr int SMEM_BYTES = 69632;

DI int otid() {
  int t = threadIdx.x;
  asm volatile("" : "+v"(t));
  return t;
}
typedef __bf16 hwbf2 __attribute__((ext_vector_type(2)));
typedef float f32v2 __attribute__((ext_vector_type(2)));
using u32x2 = __attribute__((ext_vector_type(2))) unsigned;
DI unsigned pk2(float a, float b) {
  f32v2 v = {a, b};
  return __builtin_bit_cast(unsigned, __builtin_convertvector(v, hwbf2));
}
DI bf16_t f2bf(float x) { return (bf16_t)(pk2(x, 0.f) & 0xffffu); }
DI float bf2f(bf16_t b) { return __uint_as_float(((unsigned)b) << 16); }
DI float bfs2f(short b) { return __uint_as_float(((unsigned)(unsigned short)b) << 16); }
DI float wave_sum(float v) {
#pragma unroll
  for (int o = 32; o > 0; o >>= 1) v += __shfl_xor(v, o);
  return v;
}
DI float sigmoidf_(float x) { return 1.f / (1.f + __expf(-x)); }
DI float gelu_tanh(float x) {
  float u = 0.7978845608028654f * (x + 0.044715f * x * x * x);
  return x * sigmoidf_(2.f * u);
}
DI bf16x8 pack8(const f32x4& a, const f32x4& b) {
  u32x4 r = {pk2(a[0], a[1]), pk2(a[2], a[3]), pk2(b[0], b[1]), pk2(b[2], b[3])};
  return __builtin_bit_cast(bf16x8, r);
}
DI bf16x4 pack4(float a, float b, float c, float d) {
  u32x2 r = {pk2(a, b), pk2(c, d)};
  return __builtin_bit_cast(bf16x4, r);
}

constexpr int GEMM_BUF_BYTES = 32768;
DI int swz_off(int rr, int c4) {
  int ob = rr * 64 + c4 * 16;
  return ob ^ (((ob >> 9) & 1) << 5);
}
template <int NI>
DI void gemm_mainloop(const bf16_t* __restrict__ A, int lda, const bf16_t* __restrict__ Bt, int ldb, int K, int row0,
                      int col0, char* smem, f32x4 (&acc)[4][NI]) {
  const int tid = otid(), lane = tid & 63, wid = tid >> 6;
  const int wm = wid >> 1, wn = wid & 1, fr = lane & 15, fq = lane >> 4;
  const int c4 = tid & 3, kh = (tid >> 3) & 1;
  const int srow = ((tid >> 4) << 1) + ((tid >> 2) & 1);
  const int gk = (kh * 4 + c4) * 8;
  const int soff = ((srow >> 4) * 2 + kh) * 1024 + swz_off(srow & 15, c4);
  const bf16_t* Ag = A + (size_t)(row0 + srow) * lda + gk;
  const bf16_t* Bg = Bt + (size_t)(col0 + srow) * ldb + gk;
  const int aoff = wm * 8192 + swz_off(fr, fq);
  const int boff = 16384 + wn * NI * 2048 + swz_off(fr, fq);
  u32x4 ra[4], rb[NI];
#pragma unroll
  for (int i = 0; i < 4; ++i) ra[i] = *(const u32x4*)(Ag + (size_t)(i * 32) * lda);
#pragma unroll
  for (int i = 0; i < NI; ++i) rb[i] = *(const u32x4*)(Bg + (size_t)(i * 32) * ldb);
#pragma unroll
  for (int i = 0; i < 4; ++i) *(u32x4*)(smem + soff + i * 4096) = ra[i];
#pragma unroll
  for (int i = 0; i < NI; ++i) *(u32x4*)(smem + 16384 + soff + i * 4096) = rb[i];
  __syncthreads();
  const int nk = K >> 6;
  for (int kt = 0; kt < nk; ++kt) {
    const bool more = (kt + 1) < nk;
    if (more) {
      const int k1 = (kt + 1) * 64;
#pragma unroll
      for (int i = 0; i < 4; ++i) ra[i] = *(const u32x4*)(Ag + (size_t)(i * 32) * lda + k1);
#pragma unroll
      for (int i = 0; i < NI; ++i) rb[i] = *(const u32x4*)(Bg + (size_t)(i * 32) * ldb + k1);
    }
    asm volatile("" ::: "memory");
    const char* sb = smem + (kt & 1) * GEMM_BUF_BYTES;
#pragma unroll
    for (int ks = 0; ks < 2; ++ks) {
      bf16x8 af[4], bfr[NI];
#pragma unroll
      for (int mi = 0; mi < 4; ++mi) af[mi] = *(const bf16x8*)(sb + aoff + mi * 2048 + ks * 1024);
#pragma unroll
      for (int ni = 0; ni < NI; ++ni) bfr[ni] = *(const bf16x8*)(sb + boff + ni * 2048 + ks * 1024);
#pragma unroll
      for (int mi = 0; mi < 4; ++mi)
#pragma unroll
        for (int ni = 0; ni < NI; ++ni) acc[mi][ni] = MFMA16(bfr[ni], af[mi], acc[mi][ni]);
    }
    __builtin_amdgcn_sched_barrier(0);
    if (more) {
      char* db = smem + ((kt + 1) & 1) * GEMM_BUF_BYTES;
#pragma unroll
      for (int i = 0; i < 4; ++i) *(u32x4*)(db + soff + i * 4096) = ra[i];
#pragma unroll
      for (int i = 0; i < NI; ++i) *(u32x4*)(db + 16384 + soff + i * 4096) = rb[i];
    }
    __syncthreads();
  }
}

DI void zero_acc(f32x4 (&acc)[4][4]) {
#pragma unroll
  for (int mi = 0; mi < 4; ++mi)
#pragma unroll
    for (int ni = 0; ni < 4; ++ni) acc[mi][ni] = f32x4{0.f, 0.f, 0.f, 0.f};
}
DI bool tile_sched(int iter, int tmt, int ntn, int& tm, int& tn) {
  const int G = gridDim.x, b = blockIdx.x;
  if ((G & 63) == 0 && (ntn & 7) == 0 && (tmt & 7) == 0) {
    const int groups = G >> 6, xg = b % groups, j = b / groups;
    const int srows = tmt >> 3;
    const int s = iter * groups + xg, nsuper = srows * (ntn >> 3);
    if (s >= nsuper) return false;
    tm = (s % srows) * 8 + (j & 7);
    tn = (s / srows) * 8 + (j >> 3);
    return true;
  }
  const int id = b + iter * G;
  if (id >= tmt * ntn) return false;
  tm = id % tmt;
  tn = id / tmt;
  return true;
}

constexpr int G2_STAGE = 24576;
DI void zero_acc2(f32x4 (&acc)[8][4]) {
#pragma unroll
  for (int mi = 0; mi < 8; ++mi)
#pragma unroll
    for (int ni = 0; ni < 4; ++ni) acc[mi][ni] = f32x4{0.f, 0.f, 0.f, 0.f};
}
DI void gemm2_mainloop(const bf16_t* __restrict__ A, int lda, const bf16_t* __restrict__ Bt, int ldb, int K, int row0,
                       int col0, char* smem, f32x4 (&acc)[8][4]) {
  const int tid = otid(), lane = tid & 63, wid = tid >> 6;
  const int wm = wid >> 1, wn = wid & 1, fr = lane & 15, fq = lane >> 4;
  const int c4 = tid & 3, srow = tid >> 2;
  const int soff = (srow >> 4) * 1024 + swz_off(srow & 15, c4);
  const bf16_t* Ag = A + (size_t)(row0 + srow) * lda + c4 * 8;
  const bf16_t* Bg = Bt + (size_t)(col0 + srow) * ldb + c4 * 8;
  const int aoff = wm * 8192 + swz_off(fr, fq);
  const int boff = 16384 + wn * 4096 + swz_off(fr, fq);
  u32x4 ra[4], rb[2];
#pragma unroll
  for (int i = 0; i < 4; ++i) ra[i] = *(const u32x4*)(Ag + (size_t)(i * 64) * lda);
#pragma unroll
  for (int i = 0; i < 2; ++i) rb[i] = *(const u32x4*)(Bg + (size_t)(i * 64) * ldb);
#pragma unroll
  for (int i = 0; i < 4; ++i) *(u32x4*)(smem + soff + i * 4096) = ra[i];
#pragma unroll
  for (int i = 0; i < 2; ++i) *(u32x4*)(smem + 16384 + soff + i * 4096) = rb[i];
  __syncthreads();
  const int nk = K >> 5;
  for (int kt = 0; kt < nk; ++kt) {
    const bool more = (kt + 1) < nk;
    if (more) {
      const int k1 = (kt + 1) * 32;
#pragma unroll
      for (int i = 0; i < 4; ++i) ra[i] = *(const u32x4*)(Ag + (size_t)(i * 64) * lda + k1);
#pragma unroll
      for (int i = 0; i < 2; ++i) rb[i] = *(const u32x4*)(Bg + (size_t)(i * 64) * ldb + k1);
    }
    asm volatile("" ::: "memory");
    const char* sb = smem + (kt & 1) * G2_STAGE;
    bf16x8 bfr[4];
#pragma unroll
    for (int ni = 0; ni < 4; ++ni) bfr[ni] = *(const bf16x8*)(sb + boff + ni * 1024);
    __builtin_amdgcn_s_setprio(1);
#pragma unroll
    for (int mi = 0; mi < 8; ++mi) {
      bf16x8 af = *(const bf16x8*)(sb + aoff + mi * 1024);
#pragma unroll
      for (int ni = 0; ni < 4; ++ni) acc[mi][ni] = MFMA16(bfr[ni], af, acc[mi][ni]);
    }
    __builtin_amdgcn_s_setprio(0);
    __builtin_amdgcn_sched_barrier(0);
    if (more) {
      char* db = smem + ((kt + 1) & 1) * G2_STAGE;
#pragma unroll
      for (int i = 0; i < 4; ++i) *(u32x4*)(db + soff + i * 4096) = ra[i];
#pragma unroll
      for (int i = 0; i < 2; ++i) *(u32x4*)(db + 16384 + soff + i * 4096) = rb[i];
    }
    __syncthreads();
  }
}

constexpr int G3_STAGE = 16384;
DI void gemm3_mainloop(const bf16_t* __restrict__ A, int lda, const bf16_t* __restrict__ Bt, int ldb, int K, int row0,
                       int col0, char* smem, f32x4 (&acc)[4][4]) {
  const int tid = otid(), lane = tid & 63, wid = tid >> 6;
  const int wm = wid >> 1, wn = wid & 1, fr = lane & 15, fq = lane >> 4;
  const int c4 = tid & 3, srow = tid >> 2;
  const int soff = (srow >> 4) * 1024 + swz_off(srow & 15, c4);
  const bf16_t* Ag = A + (size_t)(row0 + srow) * lda + c4 * 8;
  const bf16_t* Bg = Bt + (size_t)(col0 + srow) * ldb + c4 * 8;
  const int aoff = wm * 4096 + swz_off(fr, fq);
  const int boff = 8192 + wn * 4096 + swz_off(fr, fq);
  u32x4 ra[2], rb[2];
#pragma unroll
  for (int i = 0; i < 2; ++i) { ra[i] = *(const u32x4*)(Ag + (size_t)(i * 64) * lda); rb[i] = *(const u32x4*)(Bg + (size_t)(i * 64) * ldb); }
#pragma unroll
  for (int i = 0; i < 2; ++i) { *(u32x4*)(smem + soff + i * 4096) = ra[i]; *(u32x4*)(smem + 8192 + soff + i * 4096) = rb[i]; }
  __syncthreads();
  const int nk = K >> 5;
  for (int kt = 0; kt < nk; ++kt) {
    const bool more = (kt + 1) < nk;
    if (more) {
      const int k1 = (kt + 1) * 32;
#pragma unroll
      for (int i = 0; i < 2; ++i) { ra[i] = *(const u32x4*)(Ag + (size_t)(i * 64) * lda + k1); rb[i] = *(const u32x4*)(Bg + (size_t)(i * 64) * ldb + k1); }
    }
    asm volatile("" ::: "memory");
    const char* sb = smem + (kt & 1) * G3_STAGE;
    bf16x8 bfr[4];
#pragma unroll
    for (int ni = 0; ni < 4; ++ni) bfr[ni] = *(const bf16x8*)(sb + boff + ni * 1024);
    __builtin_amdgcn_s_setprio(1);
#pragma unroll
    for (int mi = 0; mi < 4; ++mi) {
      bf16x8 af = *(const bf16x8*)(sb + aoff + mi * 1024);
#pragma unroll
      for (int ni = 0; ni < 4; ++ni) acc[mi][ni] = MFMA16(bfr[ni], af, acc[mi][ni]);
    }
    __builtin_amdgcn_s_setprio(0);
    __builtin_amdgcn_sched_barrier(0);
    if (more) {
      char* db = smem + ((kt + 1) & 1) * G3_STAGE;
#pragma unroll
      for (int i = 0; i < 2; ++i) { *(u32x4*)(db + soff + i * 4096) = ra[i]; *(u32x4*)(db + 8192 + soff + i * 4096) = rb[i]; }
    }
    __syncthreads();
  }
}

constexpr int CST_B = 272;
constexpr int CST_T = 528;
template <int MI, int NI, class F>
DI void stage_rowmajor(char* smem, f32x4 (&acc)[MI][NI], int wm, int wn, int fr, int fq, F&& tf) {
#pragma unroll
  for (int mi = 0; mi < MI; ++mi)
#pragma unroll
    for (int ni = 0; ni < NI; ++ni) {
      f32x4 v = tf(acc[mi][ni]);
      *(bf16x4*)(smem + (wm * MI * 16 + mi * 16 + fr) * CST_B + (wn * NI * 16 + ni * 16 + fq * 4) * 2) = pack4(v[0], v[1], v[2], v[3]);
      if (ni == NI - 1) __builtin_amdgcn_sched_barrier(0);
    }
}
template <int MI, int NI, class F>
DI void stage_transposed(char* smem, f32x4 (&acc)[MI][NI], int wm, int wn, int fr, int fq, F&& tf) {
#pragma unroll
  for (int mi = 0; mi < MI; ++mi)
#pragma unroll
    for (int ni = 0; ni < NI; ++ni) {
      f32x4 v = tf(acc[mi][ni]);
      char* base = smem + (wn * NI * 16 + ni * 16 + fq * 4) * CST_T + (wm * MI * 16 + mi * 16 + fr) * 2;
      *(bf16_t*)(base) = f2bf(v[0]);
      *(bf16_t*)(base + CST_T) = f2bf(v[1]);
      *(bf16_t*)(base + 2 * CST_T) = f2bf(v[2]);
      *(bf16_t*)(base + 3 * CST_T) = f2bf(v[3]);
      if (ni == NI - 1) __builtin_amdgcn_sched_barrier(0);
    }
}
template <int LINES, int CPL, int STRIDE, class D>
DI void writeout(const char* smem, int tid, D&& dst) {
#pragma unroll 4
  for (int j = 0; j < LINES * CPL / 256; ++j) {
    const int id = tid + j * 256, line = id / CPL, c = id % CPL;
    u32x4 v = *(const u32x4*)(smem + line * STRIDE + c * 16);
    *(u32x4*)dst(line, c) = v;
  }
}

DI void stage_rowmajor_rope(char* smem, f32x4 (&acc)[8][4], int wm, int wn, int fr, int fq, int rtok) {
  float inv[4];
#pragma unroll
  for (int i = 0; i < 4; ++i) inv[i] = exp2f(-(float)(fq * 4 + i) * 0.8304820237218406f);
#pragma unroll
  for (int mi = 0; mi < 8; ++mi) {
    const int t = (rtok + mi * 16 - NCTX) & 2047;
    const float gr = (float)(t >> 6), gc = (float)(t & 63);
    f32x4 o0, o1, o2, o3;
#pragma unroll
    for (int i = 0; i < 4; ++i) {
      const float sr = __sinf(gr * inv[i]), cr = __cosf(gr * inv[i]);
      const float sc = __sinf(gc * inv[i]), cc = __cosf(gc * inv[i]);
      const float a0 = acc[mi][0][i], a1 = acc[mi][1][i], a2 = acc[mi][2][i], a3 = acc[mi][3][i];
      o0[i] = a0 * cr - a1 * sr;
      o1[i] = a1 * cr + a0 * sr;
      o2[i] = a2 * cc - a3 * sc;
      o3[i] = a3 * cc + a2 * sc;
    }
    char* base = smem + (wm * 128 + mi * 16 + fr) * CST_B + (wn * 64 + fq * 4) * 2;
    *(bf16x4*)(base) = pack4(o0[0], o0[1], o0[2], o0[3]);
    *(bf16x4*)(base + 32) = pack4(o1[0], o1[1], o1[2], o1[3]);
    *(bf16x4*)(base + 64) = pack4(o2[0], o2[1], o2[2], o2[3]);
    *(bf16x4*)(base + 96) = pack4(o3[0], o3[1], o3[2], o3[3]);
    __builtin_amdgcn_sched_barrier(0);
  }
}

DI void epi_in(const P& p, int l, int row0, int col0, f32x4 (&acc)[8][4], char* smem) {
  const int tid_ = otid(), lane = tid_ & 63, wid = tid_ >> 6, wm = wid >> 1, wn = wid & 1, fr = lane & 15, fq = lane >> 4;
  const int seg = col0 >> 9;
  const bool ctx = row0 < NCTX;
  if (seg >= 12) {
    bf16_t* GF = (bf16_t*)(p.ws + WS_GF);
    const int k = (seg - 12) >> 1, tn = ((col0 - 6144) & 1023) >> 7, tm = row0 >> 8;
    bf16_t* dst = GF + (((size_t)k * 64 + tm) * 8 + tn) * 32768 + tid_ * 4;
#pragma unroll
    for (int mi = 0; mi < 8; ++mi)
#pragma unroll
      for (int ni = 0; ni < 4; ++ni)
        *(bf16x4*)(dst + (mi * 4 + ni) * 1024) = pack4(sigmoidf_(acc[mi][ni][0]), sigmoidf_(acc[mi][ni][1]), sigmoidf_(acc[mi][ni][2]), sigmoidf_(acc[mi][ni][3]));
    return;
  }
  const int ctile = col0 & 511;
  const int cseg0 = ctile + wn * 64;
  const int rtok = row0 + wm * 128 + fr;
  if (ctx && (seg == 1 || seg == 2 || seg == 4 || seg == 5)) {
    float* out = p.out;
#pragma unroll
    for (int mi = 0; mi < 8; ++mi) {
      const int r = rtok + mi * 16, b = r >> 8, t = r & 255;
      size_t off;
      if (seg == 1 || seg == 2) {
        const int h = cseg0 >> 6;
        off = (seg == 1 ? O_NAK : O_NAV) + (((size_t)(b * 4 + l) * 8 + h) * 256 + t) * 64;
      } else if (seg == 4) {
        const int comp = cseg0 >> 8, h = (cseg0 >> 6) & 3;
        off = O_DFK + ((((size_t)(b * 4 + l) * 2 + comp) * 4 + h) * 256 + t) * 64;
      } else {
        const int h = cseg0 >> 7;
        off = O_DFV + (((size_t)(b * 4 + l) * 4 + h) * 256 + t) * 128 + (cseg0 & 127);
      }
#pragma unroll
      for (int ni = 0; ni < 4; ++ni) *(f32x4*)(out + off + ni * 16 + fq * 4) = acc[mi][ni];
      __builtin_amdgcn_sched_barrier(0);
    }
  }
  auto tf_none = [](const f32x4& a) -> f32x4 { return a; };
  auto tf_scale = [](const f32x4& a) -> f32x4 { return f32x4{a[0] * 0.125f, a[1] * 0.125f, a[2] * 0.125f, a[3] * 0.125f}; };
  auto tf_silu = [](const f32x4& a) -> f32x4 { return f32x4{a[0] * sigmoidf_(a[0]), a[1] * sigmoidf_(a[1]), a[2] * sigmoidf_(a[2]), a[3] * sigmoidf_(a[3])}; };
  auto tf_gelu = [](const f32x4& a) -> f32x4 { return f32x4{gelu_tanh(a[0]), gelu_tanh(a[1]), gelu_tanh(a[2]), gelu_tanh(a[3])}; };
  const bool rowmajor = !(seg == 2 || seg == 5 || seg == 8 || seg == 11);
  if (rowmajor) {
    int zc;
    switch (seg) {
      case 0: zc = ZC_NAQ; break;
      case 1: zc = ZC_NAK; break;
      case 3: zc = ZC_DFQ; break;
      case 4: zc = ZC_DFK; break;
      case 6: zc = ZC_RTQ; break;
      case 7: zc = ZC_RTK; break;
      case 9: zc = ZC_RTG; break;
      default: zc = ZC_LRX; break;
    }
    if (!ctx && (seg == 3 || seg == 4)) stage_rowmajor_rope(smem, acc, wm, wn, fr, fq, rtok);
    else if (seg == 7) stage_rowmajor<8, 4>(smem, acc, wm, wn, fr, fq, tf_scale);
    else if (seg == 9) stage_rowmajor<8, 4>(smem, acc, wm, wn, fr, fq, tf_silu);
    else stage_rowmajor<8, 4>(smem, acc, wm, wn, fr, fq, tf_none);
    __syncthreads();
    bf16_t* zb = (bf16_t*)(p.ws + WS_Z) + (size_t)row0 * ZLD + zc + ctile;
    writeout<256, 16, CST_B>(smem, tid_, [&](int line, int c) { return zb + (size_t)line * ZLD + c * 8; });
    __syncthreads();
  }
  if (!rowmajor || (seg == 7 && ctx)) {
    if (seg == 7) stage_transposed<8, 4>(smem, acc, wm, wn, fr, fq, tf_scale);
    else if (seg == 11) stage_transposed<8, 4>(smem, acc, wm, wn, fr, fq, tf_gelu);
    else stage_transposed<8, 4>(smem, acc, wm, wn, fr, fq, tf_none);
    __syncthreads();
    if (seg == 11) {
      bf16_t* lg = (bf16_t*)(p.ws + WS_LG) + ((size_t)(row0 >> 6) * 512 + ctile) * 64;
      writeout<128, 32, CST_T>(smem, tid_, [&](int line, int c) { return lg + ((size_t)(c >> 3) * 512 + line) * 64 + (c & 7) * 8; });
    } else {
      bf16_t* tb = (bf16_t*)(p.ws + (seg == 2 ? WS_VTNA : seg == 5 ? WS_VTDF : seg == 8 ? WS_VTRT : WS_KTRT));
      int T;
      if (ctx) { T = 256; tb += ((size_t)((row0 >> 8) * 512 + ctile)) * 256 + (row0 & 255); }
      else { const int rr = row0 - NCTX; T = 2048; tb += (size_t)VT_LAT + ((size_t)((rr >> 11) * 512 + ctile)) * 2048 + (rr & 2047); }
      writeout<128, 32, CST_T>(smem, tid_, [&](int line, int c) { return tb + (size_t)line * T + c * 8; });
    }
    __syncthreads();
  }
}

DI void phase_gin(const P& p, int l, char* smem) {
  const bf16_t* A = (const bf16_t*)(p.ws + WS_H);
  const bf16_t* Bt = (const bf16_t*)(p.ws + WS_WIN);
  for (int it = 0;; ++it) {
    int tm, tn;
    if (!tile_sched(it, 64, 80, tm, tn)) break;
    f32x4 acc[8][4];
    zero_acc2(acc);
    gemm2_mainloop(A, 1024, Bt, 1024, 1024, tm * 256, tn * 128, smem, acc);
    epi_in(p, l, tm * 256, tn * 128, acc, smem);
  }
}

DI void phase_merge(const P& p, char* smem) {
  const bf16_t* Y4 = (const bf16_t*)(p.ws + WS_Y4);
  const bf16_t* WB = (const bf16_t*)(p.ws + WS_WBR);
  const bf16_t* GF = (const bf16_t*)(p.ws + WS_GF);
  bf16_t* G = (bf16_t*)(p.ws + WS_H);
  const int tid_ = otid(), lane = tid_ & 63, wid = tid_ >> 6, wm = wid >> 1, wn = wid & 1, fr = lane & 15, fq = lane >> 4;
  for (int it = 0;; ++it) {
    int tm, tn;
    if (!tile_sched(it, 128, 8, tm, tn)) break;
    const int row0 = tm * 128, col0 = tn * 128;
    f32x4 o[4][4];
    zero_acc(o);
#pragma unroll 1
    for (int k = 0; k < 4; ++k) {
      f32x4 acc[4][4];
      zero_acc(acc);
      gemm3_mainloop(Y4 + k * 512, 2048, WB + k * 512, 2048, 512, row0, col0, smem, acc);
      const bf16_t* gsrc = GF + (((size_t)k * 64 + (tm >> 1)) * 8 + tn) * 32768 + (((tm & 1) * 2 + wn) * 64 + lane) * 4 + (wm * 16) * 1024;
#pragma unroll
      for (int mi = 0; mi < 4; ++mi) {
        bf16x4 gq[4];
#pragma unroll
        for (int ni = 0; ni < 4; ++ni) gq[ni] = *(const bf16x4*)(gsrc + (mi * 4 + ni) * 1024);
#pragma unroll
        for (int ni = 0; ni < 4; ++ni)
#pragma unroll
          for (int i = 0; i < 4; ++i) o[mi][ni][i] += bfs2f(gq[ni][i]) * acc[mi][ni][i];
      }
    }
    stage_rowmajor<4, 4>(smem, o, wm, wn, fr, fq, [](const f32x4& a) { return a; });
    __syncthreads();
    bf16_t* gb = G + (size_t)row0 * 1024 + col0;
    writeout<128, 16, CST_B>(smem, tid_, [&](int line, int c) { return gb + (size_t)line * 1024 + c * 8; });
    __syncthreads();
  }
}

template <int MODE>
DI void phase_gemm_plain(const bf16_t* A, int K, const bf16_t* Bt, int N, bf16_t* outp, char* smem) {
  const int tid_ = otid(), lane = tid_ & 63, wid = tid_ >> 6, wm = wid >> 1, wn = wid & 1, fr = lane & 15, fq = lane >> 4;
  const int ntn = N / 128;
  for (int it = 0;; ++it) {
    int tm, tn;
    if (!tile_sched(it, 64, ntn, tm, tn)) break;
    const int row0 = tm * 256, col0 = tn * 128;
    f32x4 acc[8][4];
    zero_acc2(acc);
    gemm2_mainloop(A, K, Bt, K, K, row0, col0, smem, acc);
    stage_rowmajor<8, 4>(smem, acc, wm, wn, fr, fq, [](const f32x4& a) {
      f32x4 v = a;
      if (MODE == 1) {
        v[0] = fmaxf(v[0], 0.f); v[1] = fmaxf(v[1], 0.f); v[2] = fmaxf(v[2], 0.f); v[3] = fmaxf(v[3], 0.f);
        v[0] *= v[0]; v[1] *= v[1]; v[2] *= v[2]; v[3] *= v[3];
      }
      return v;
    });
    __syncthreads();
    bf16_t* ob = outp + (size_t)row0 * N + col0;
    writeout<256, 16, CST_B>(smem, tid_, [&](int line, int c) { return ob + (size_t)line * N + c * 8; });
    __syncthreads();
  }
}

DI void phase_mod(const P& p, char* smem) {
  float* ssil = (float*)smem;
  float* red = ssil + 5 * 1024;
  const int tid = otid();
  float* MOD = (float*)(p.ws + WS_MOD);
  for (int idx = tid; idx < 5120; idx += 256) {
    int j = idx >> 10, k = idx & 1023;
    float cv = (j == 0) ? p.in[11][k] : p.in[10][(j - 1) * 1024 + k];
    ssil[idx] = cv / (1.f + expf(-cv));
  }
  __syncthreads();
  const int cl = tid & 63, kg = tid >> 6;
  for (int item = blockIdx.x; item < 384; item += gridDim.x) {
    int l = item / 96, cgp = item % 96;
    int col = cgp * 64 + cl;
    const float* W = p.in[12] + (size_t)l * 1024 * 6144 + col;
    float a0 = 0, a1 = 0, a2 = 0, a3 = 0, a4 = 0;
    for (int k = kg * 256; k < kg * 256 + 256; ++k) {
      float w = W[(size_t)k * 6144];
      a0 += ssil[k] * w;
      a1 += ssil[1024 + k] * w;
      a2 += ssil[2048 + k] * w;
      a3 += ssil[3072 + k] * w;
      a4 += ssil[4096 + k] * w;
    }
    red[(kg * 5 + 0) * 64 + cl] = a0;
    red[(kg * 5 + 1) * 64 + cl] = a1;
    red[(kg * 5 + 2) * 64 + cl] = a2;
    red[(kg * 5 + 3) * 64 + cl] = a3;
    red[(kg * 5 + 4) * 64 + cl] = a4;
    __syncthreads();
    if (kg == 0) {
      float bias = p.in[13][l * 6144 + col];
#pragma unroll
      for (int j = 0; j < 5; ++j) {
        float s = red[(0 * 5 + j) * 64 + cl] + red[(1 * 5 + j) * 64 + cl] + red[(2 * 5 + j) * 64 + cl] + red[(3 * 5 + j) * 64 + cl];
        MOD[(size_t)(l * 5 + j) * 6144 + col] = s + bias;
      }
    }
    __syncthreads();
  }
}

DI void transpose_tile(const float* __restrict__ src, int lds_, bf16_t* __restrict__ dst, int ldd, float* tile) {
  const int tid = otid();
#pragma unroll 4
  for (int i = 0; i < 16; ++i) {
    int idx = tid + i * 256, r = idx >> 6, c = idx & 63;
    tile[r * 65 + c] = src[(size_t)r * lds_ + c];
  }
  __syncthreads();
#pragma unroll 4
  for (int i = 0; i < 16; ++i) {
    int idx = tid + i * 256, c = idx >> 6, r = idx & 63;
    dst[(size_t)c * ldd + r] = f2bf(tile[r * 65 + c]);
  }
  __syncthreads();
}

DI void phase_convert(const P& p, int l, char* smem) {
  float* tile = (float*)smem;
  char* ws = p.ws;
  const int NJ = 6432;
  for (int j = blockIdx.x; j < NJ; j += gridDim.x) {
    int q = j;
    if (q < 2560) {
      int tr = q / 160, tc = q % 160;
      transpose_tile(p.in[18] + (size_t)l * 1024 * 10240 + (size_t)tr * 64 * 10240 + tc * 64, 10240,
                     (bf16_t*)(ws + WS_WIN) + (size_t)tc * 64 * 1024 + tr * 64, 1024, tile);
      continue;
    }
    q -= 2560;
    if (q < 512) {
      int tr = q / 16, tc = q % 16;
      transpose_tile(p.in[40] + (size_t)l * 2048 * 1024 + (size_t)tr * 64 * 1024 + tc * 64, 1024,
                     (bf16_t*)(ws + WS_WBR) + (size_t)tc * 64 * 2048 + tr * 64, 2048, tile);
      continue;
    }
    q -= 512;
    if (q < 256) {
      int tr = q / 16, tc = q % 16;
      transpose_tile(p.in[41] + (size_t)l * 1024 * 1024 + (size_t)tr * 64 * 1024 + tc * 64, 1024,
                     (bf16_t*)(ws + WS_WOUT) + (size_t)tc * 64 * 1024 + tr * 64, 1024, tile);
      continue;
    }
    q -= 256;
    if (q < 1024) {
      int tr = q / 64, tc = q % 64;
      transpose_tile(p.in[42] + (size_t)l * 1024 * 4096 + (size_t)tr * 64 * 4096 + tc * 64, 4096,
                     (bf16_t*)(ws + WS_W1) + (size_t)tc * 64 * 1024 + tr * 64, 1024, tile);
      continue;
    }
    q -= 1024;
    if (q < 1024) {
      int tr = q / 16, tc = q % 16;
      transpose_tile(p.in[43] + (size_t)l * 4096 * 1024 + (size_t)tr * 64 * 1024 + tc * 64, 1024,
                     (bf16_t*)(ws + WS_W2) + (size_t)tc * 64 * 4096 + tr * 64, 4096, tile);
      continue;
    }
    q -= 1024;
    if (q < 32) {
      int type = q >> 3, n = q & 7;
      const float* src = (type == 0 ? p.in[30] : type == 1 ? p.in[32] : type == 2 ? p.in[35] : p.in[37]) + (size_t)(l * 8 + n) * 4096;
      transpose_tile(src, 64, (bf16_t*)(ws + WS_WLRU) + (size_t)(type * 8 + n) * 4096, 64, tile);
      continue;
    }
    q -= 32;
    if (q < 256) {
      int bh = q >> 3, tr = q & 7, b = bh >> 3, h = bh & 7;
      transpose_tile(p.in[3] + ((size_t)((b * 4 + l) * 8 + h)) * 32768 + (size_t)tr * 64 * 64, 64,
                     (bf16_t*)(ws + WS_CVNA) + (size_t)bh * 32768 + tr * 64, 512, tile);
      continue;
    }
    q -= 256;
    if (q < 256) {
      int bh = q >> 4, t2 = q & 15, tr = t2 >> 1, tc = t2 & 1, b = bh >> 2, h = bh & 3;
      transpose_tile(p.in[5] + ((size_t)((b * 4 + l) * 4 + h)) * 65536 + (size_t)tr * 64 * 128 + tc * 64, 128,
                     (bf16_t*)(ws + WS_CVDF) + (size_t)bh * 65536 + (size_t)tc * 64 * 512 + tr * 64, 512, tile);
      continue;
    }
    q -= 256;
    {
      int tensor = q >> 8, b = (q >> 6) & 3, chunk = q & 63;
      const float* src = (tensor == 0 ? p.in[2] : p.in[4]) + (size_t)(b * 4 + l) * 262144 + (size_t)chunk * 4096;
      bf16_t* dst = (bf16_t*)(ws + (tensor == 0 ? WS_CKNA : WS_CKDF)) + (size_t)b * 262144 + (size_t)chunk * 4096;
#pragma unroll
      for (int i = 0; i < 4; ++i) {
        int e = (otid() + i * 256) * 4;
        float4 v = *(const float4*)(src + e);
        *(bf16x4*)(dst + e) = pack4(v.x, v.y, v.z, v.w);
      }
    }
  }
}

DI void phase_row(const P& p, int l, int mode) {
  const int tid_ = otid(), lane = tid_ & 63, wid = tid_ >> 6;
  const float* MOD = (const float*)(p.ws + WS_MOD);
  float* X = p.out;
  bf16_t* H = (bf16_t*)(p.ws + WS_H);
  const bf16_t* Y = (const bf16_t*)(p.ws + WS_Y);
  const bool from_inputs = (mode == 0 || (mode == 1 && l == 0));
  auto xsrc = [&](int r) -> const float* {
    return from_inputs ? ((r < NCTX) ? (p.in[0] + (size_t)r * D) : (p.in[1] + (size_t)(r - NCTX) * D)) : (X + (size_t)r * D);
  };
  int rb = blockIdx.x;
  if (rb >= 4096) return;
  float4 xn[4];
  bf16x4 yn[4];
  {
    const int r = rb * 4 + wid;
    const float* xs = xsrc(r);
#pragma unroll
    for (int j = 0; j < 4; ++j) xn[j] = *(const float4*)(xs + j * 256 + lane * 4);
    if (mode != 0) {
#pragma unroll
      for (int j = 0; j < 4; ++j) yn[j] = *(const bf16x4*)(Y + (size_t)r * D + j * 256 + lane * 4);
    }
  }
  for (; rb < 4096; rb += gridDim.x) {
    const int r = rb * 4 + wid;
    const int mi = r < NCTX ? 0 : 1 + ((r - NCTX) >> 11);
    float4 xv[4], yv[4];
#pragma unroll
    for (int j = 0; j < 4; ++j) { xv[j] = xn[j]; yv[j] = make_float4(bfs2f(yn[j][0]), bfs2f(yn[j][1]), bfs2f(yn[j][2]), bfs2f(yn[j][3])); }
    {
      const int rbn = (rb + (int)gridDim.x < 4096) ? rb + (int)gridDim.x : rb;
      const int rn = rbn * 4 + wid;
      const float* xs = xsrc(rn);
#pragma unroll
      for (int j = 0; j < 4; ++j) xn[j] = *(const float4*)(xs + j * 256 + lane * 4);
      if (mode != 0) {
#pragma unroll
        for (int j = 0; j < 4; ++j) yn[j] = *(const bf16x4*)(Y + (size_t)rn * D + j * 256 + lane * 4);
      }
    }
    if (mode != 0) {
      float ss = 0.f;
#pragma unroll
      for (int j = 0; j < 4; ++j) ss += yv[j].x * yv[j].x + yv[j].y * yv[j].y + yv[j].z * yv[j].z + yv[j].w * yv[j].w;
      ss = wave_sum(ss);
      const float rs = rsqrtf(ss * (1.f / 1024.f) + 1e-6f);
      const float* gpost = (mode == 1 ? p.in[15] : p.in[17]) + l * D;
      const float* gate = MOD + (size_t)(l * 5 + mi) * 6144 + (mode == 1 ? 2048 : 5120);
#pragma unroll
      for (int j = 0; j < 4; ++j) {
        float4 g = *(const float4*)(gpost + j * 256 + lane * 4);
        float4 gt = *(const float4*)(gate + j * 256 + lane * 4);
        xv[j].x += gt.x * (yv[j].x * rs * g.x);
        xv[j].y += gt.y * (yv[j].y * rs * g.y);
        xv[j].z += gt.z * (yv[j].z * rs * g.z);
        xv[j].w += gt.w * (yv[j].w * rs * g.w);
        *(float4*)(X + (size_t)r * D + j * 256 + lane * 4) = xv[j];
      }
    }
    int ln, off_sh, off_sc;
    const float* gpre;
    if (mode == 0) { ln = 0; gpre = p.in[14]; off_sh = 0; off_sc = 1024; }
    else if (mode == 1) { ln = l; gpre = p.in[16] + l * D; off_sh = 3072; off_sc = 4096; }
    else { ln = l + 1; gpre = p.in[14] + (l + 1) * D; off_sh = 0; off_sc = 1024; }
    if (ln < 4) {
      float ss = 0.f;
#pragma unroll
      for (int j = 0; j < 4; ++j) ss += xv[j].x * xv[j].x + xv[j].y * xv[j].y + xv[j].z * xv[j].z + xv[j].w * xv[j].w;
      ss = wave_sum(ss);
      const float rs = rsqrtf(ss * (1.f / 1024.f) + 1e-6f);
      const float* mrow = MOD + (size_t)(ln * 5 + mi) * 6144;
#pragma unroll
      for (int j = 0; j < 4; ++j) {
        int c = j * 256 + lane * 4;
        float4 g = *(const float4*)(gpre + c);
        float4 sc = *(const float4*)(mrow + off_sc + c);
        float4 sh = *(const float4*)(mrow + off_sh + c);
        *(bf16x4*)(H + (size_t)r * D + c) = pack4(xv[j].x * rs * g.x * (1.f + sc.x) + sh.x, xv[j].y * rs * g.y * (1.f + sc.y) + sh.y,
                                                  xv[j].z * rs * g.z * (1.f + sc.z) + sh.z, xv[j].w * rs * g.w * (1.f + sc.w) + sh.w);
      }
    }
  }
}

constexpr int ATT_BUF = 192 * LDT;
DI void qk_scores(const bf16x8 (&qf)[2], const bf16_t* sK, f32x4 (&S)[4], int fr, int fq) {
  __builtin_amdgcn_s_setprio(1);
#pragma unroll
  for (int s = 0; s < 4; ++s) {
    f32x4 z = {0.f, 0.f, 0.f, 0.f};
#pragma unroll
    for (int ks = 0; ks < 2; ++ks) {
      bf16x8 a = *(const bf16x8*)(sK + (16 * s + fr) * LDT + ks * 32 + fq * 8);
      z = MFMA16(a, qf[ks], z);
    }
    S[s] = z;
  }
  __builtin_amdgcn_s_setprio(0);
}
template <int DV>
DI void pv_step(const bf16x8 (&pb)[2], const bf16_t* sV, f32x4 (&O)[DV / 16], int fr, int fq) {
  __builtin_amdgcn_s_setprio(1);
#pragma unroll
  for (int dt = 0; dt < DV / 16; ++dt) {
#pragma unroll
    for (int s2 = 0; s2 < 2; ++s2) {
      const bf16_t* base = sV + (dt * 16 + fr) * LDT + 32 * s2 + 4 * fq;
      bf16x4 lo = *(const bf16x4*)base;
      bf16x4 hi = *(const bf16x4*)(base + 16);
      bf16x8 a = __builtin_shufflevector(lo, hi, 0, 1, 2, 3, 4, 5, 6, 7);
      O[dt] = MFMA16(a, pb[s2], O[dt]);
    }
  }
  __builtin_amdgcn_s_setprio(0);
}
template <int DV>
DI void softmax_pv(f32x4 (&S)[4], const bf16_t* sV, f32x4 (&O)[DV / 16], float& m, float& lsum, int fr, int fq) {
  float tm = -1e30f;
#pragma unroll
  for (int s = 0; s < 4; ++s)
#pragma unroll
    for (int i = 0; i < 4; ++i) tm = fmaxf(tm, S[s][i]);
  tm = fmaxf(tm, __shfl_xor(tm, 16));
  tm = fmaxf(tm, __shfl_xor(tm, 32));
  const float mn = fmaxf(m, tm);
  const float alpha = __expf(m - mn);
  m = mn;
  float ps = 0.f;
#pragma unroll
  for (int s = 0; s < 4; ++s)
#pragma unroll
    for (int i = 0; i < 4; ++i) {
      float pv = __expf(S[s][i] - mn);
      S[s][i] = pv;
      ps += pv;
    }
  lsum = lsum * alpha + ps;
#pragma unroll
  for (int dt = 0; dt < DV / 16; ++dt) {
    O[dt][0] *= alpha; O[dt][1] *= alpha; O[dt][2] *= alpha; O[dt][3] *= alpha;
  }
  bf16x8 pb[2];
  pb[0] = pack8(S[0], S[1]);
  pb[1] = pack8(S[2], S[3]);
  pv_step<DV>(pb, sV, O, fr, fq);
}
template <int DV, bool SOFTMAX, class TileFn, class ScoreFn>
DI void attn_loop(int ntiles, TileFn&& tile, ScoreFn&& score, const bf16x8 (&qf)[2], f32x4 (&O)[DV / 16], float& m, float& lsum,
                  bf16_t* smem, int tid) {
  const int lane = tid & 63, fr = lane & 15, fq = lane >> 4;
  u32x4 rkA[2], rvA[DV / 32], rkB[2], rvB[DV / 32];
  const int sr = tid >> 3, sc = (tid & 7) * 8;
  auto gload = [&](int j, u32x4 (&rk)[2], u32x4 (&rv)[DV / 32]) {
    const bf16_t* Kg; const bf16_t* Vg; int ldk, ldv;
    tile(j, Kg, ldk, Vg, ldv);
#pragma unroll
    for (int i = 0; i < 2; ++i) rk[i] = *(const u32x4*)(Kg + (size_t)(sr + i * 32) * ldk + sc);
#pragma unroll
    for (int i = 0; i < DV / 32; ++i) rv[i] = *(const u32x4*)(Vg + (size_t)(sr + i * 32) * ldv + sc);
  };
  auto sstore = [&](int buf, const u32x4 (&rk)[2], const u32x4 (&rv)[DV / 32]) {
    bf16_t* sK = smem + buf * ATT_BUF;
    bf16_t* sV = sK + 64 * LDT;
#pragma unroll
    for (int i = 0; i < 2; ++i) *(u32x4*)(sK + (sr + i * 32) * LDT + sc) = rk[i];
#pragma unroll
    for (int i = 0; i < DV / 32; ++i) *(u32x4*)(sV + (sr + i * 32) * LDT + sc) = rv[i];
  };
  auto compute = [&](int buf, int j) {
    const bf16_t* sK = smem + buf * ATT_BUF;
    const bf16_t* sV = sK + 64 * LDT;
    f32x4 S[4];
    qk_scores(qf, sK, S, fr, fq);
    score(j, S);
    if (SOFTMAX) {
      softmax_pv<DV>(S, sV, O, m, lsum, fr, fq);
    } else {
      bf16x8 pb[2];
      pb[0] = pack8(S[0], S[1]);
      pb[1] = pack8(S[2], S[3]);
      pv_step<DV>(pb, sV, O, fr, fq);
    }
  };
  const int last = ntiles - 1;
  gload(0, rkA, rvA);
  gload(last < 1 ? last : 1, rkB, rvB);
  sstore(0, rkA, rvA);
  __syncthreads();
  for (int j = 0; j < ntiles; j += 2) {
    gload(j + 2 < last ? j + 2 : last, rkA, rvA);
    asm volatile("" ::: "memory");
    compute(0, j);
    __builtin_amdgcn_sched_barrier(0);
    sstore(1, rkB, rvB);
    __syncthreads();
    if (j + 1 >= ntiles) break;
    gload(j + 3 < last ? j + 3 : last, rkB, rvB);
    asm volatile("" ::: "memory");
    compute(1, j + 1);
    __builtin_amdgcn_sched_barrier(0);
    sstore(0, rkA, rvA);
    __syncthreads();
  }
}
DI void scale_scores(f32x4 (&S)[4]) {
#pragma unroll
  for (int s = 0; s < 4; ++s) { S[s][0] *= 0.125f; S[s][1] *= 0.125f; S[s][2] *= 0.125f; S[s][3] *= 0.125f; }
}

DI void dense_item(const P& p, int b, int h, int qb, char* smem) {
  const int tid = otid(), lane = tid & 63, wid = tid >> 6, fr = lane & 15, fq = lane >> 4;
  const bf16_t* Z = (const bf16_t*)(p.ws + WS_Z);
  const bf16_t* VT = (const bf16_t*)(p.ws + WS_VTNA) + (size_t)(b * 512 + h * 64) * 256;
  bf16_t* Y4 = (bf16_t*)(p.ws + WS_Y4);
  const int rowbase = b * 256;
  const int qrow = rowbase + qb * 64 + wid * 16 + fr;
  bf16x8 qf[2];
#pragma unroll
  for (int ks = 0; ks < 2; ++ks) qf[ks] = *(const bf16x8*)(Z + (size_t)qrow * ZLD + ZC_NAQ + h * 64 + ks * 32 + fq * 8);
  f32x4 O[4];
#pragma unroll
  for (int dt = 0; dt < 4; ++dt) O[dt] = f32x4{0.f, 0.f, 0.f, 0.f};
  float m = -1e30f, lsum = 0.f;
  const bf16_t* Kb = Z + (size_t)rowbase * ZLD + ZC_NAK + h * 64;
  attn_loop<64, true>(4,
      [&](int j, const bf16_t*& Kg, int& ldk, const bf16_t*& Vg, int& ldv) { Kg = Kb + (size_t)j * 64 * ZLD; ldk = ZLD; Vg = VT + j * 64; ldv = 256; },
      [&](int, f32x4 (&S)[4]) { scale_scores(S); }, qf, O, m, lsum, (bf16_t*)smem, tid);
  float lt = lsum + __shfl_xor(lsum, 16);
  lt += __shfl_xor(lt, 32);
  const float inv = 1.f / lt;
#pragma unroll
  for (int dt = 0; dt < 4; ++dt)
    *(bf16x4*)(Y4 + (size_t)qrow * 2048 + h * 64 + dt * 16 + fq * 4) = pack4(O[dt][0] * inv, O[dt][1] * inv, O[dt][2] * inv, O[dt][3] * inv);
}

DI void na_item(const P& p, int l, int b, int h, int r, char* smem) {
  float* srpb = (float*)((bf16_t*)smem + 2 * ATT_BUF);
  const int tid = otid(), lane = tid & 63, wid = tid >> 6, fr = lane & 15, fq = lane >> 4;
  const bf16_t* Z = (const bf16_t*)(p.ws + WS_Z);
  const bf16_t* VT = (const bf16_t*)(p.ws + WS_VTNA) + VT_LAT + (size_t)(b * 512 + h * 64) * 2048;
  const bf16_t* CK = (const bf16_t*)(p.ws + WS_CKNA) + (size_t)(b * 8 + h) * 32768;
  const bf16_t* CVT = (const bf16_t*)(p.ws + WS_CVNA) + (size_t)(b * 8 + h) * 32768;
  bf16_t* Y4 = (bf16_t*)(p.ws + WS_Y4);
  for (int i = tid; i < 465; i += 256) srpb[i] = p.in[19][(size_t)(l * 8 + h) * 465 + i];
  const int rowbase = NCTX + b * 2048;
  const int qcol = wid * 16 + fr;
  const int qrow = rowbase + r * 64 + qcol;
  bf16x8 qf[2];
#pragma unroll
  for (int ks = 0; ks < 2; ++ks) qf[ks] = *(const bf16x8*)(Z + (size_t)qrow * ZLD + ZC_NAQ + h * 64 + ks * 32 + fq * 8);
  f32x4 O[4];
#pragma unroll
  for (int dt = 0; dt < 4; ++dt) O[dt] = f32x4{0.f, 0.f, 0.f, 0.f};
  float m = -1e30f, lsum = 0.f;
  int rs = r - 4;
  rs = rs < 0 ? 0 : (rs > 24 ? 24 : rs);
  int cstart = qcol - 8;
  cstart = cstart < 0 ? 0 : (cstart > 48 ? 48 : cstart);
  const bf16_t* Kb = Z + (size_t)rowbase * ZLD + ZC_NAK + h * 64;
  attn_loop<64, true>(16,
      [&](int j, const bf16_t*& Kg, int& ldk, const bf16_t*& Vg, int& ldv) {
        if (j < 8) { Kg = Kb + (size_t)(rs + j) * 64 * ZLD; ldk = ZLD; Vg = VT + (rs + j) * 64; ldv = 2048; }
        else { Kg = CK + (size_t)(j - 8) * 64 * 64; ldk = 64; Vg = CVT + (j - 8) * 64; ldv = 512; }
      },
      [&](int j, f32x4 (&S)[4]) {
        if (j < 8) {
          const int dr = rs + j - r + 7;
#pragma unroll
          for (int s = 0; s < 4; ++s)
#pragma unroll
            for (int i = 0; i < 4; ++i) {
              int kcol = s * 16 + fq * 4 + i;
              bool ok = (kcol >= cstart) && (kcol < cstart + 16);
              int dc = kcol - qcol + 15;
              dc = dc < 0 ? 0 : (dc > 30 ? 30 : dc);
              float bias = srpb[dr * 31 + dc];
              S[s][i] = ok ? (S[s][i] * 0.125f + bias) : -1e30f;
            }
        } else {
          scale_scores(S);
        }
      },
      qf, O, m, lsum, (bf16_t*)smem, tid);
  float lt = lsum + __shfl_xor(lsum, 16);
  lt += __shfl_xor(lt, 32);
  const float inv = 1.f / lt;
#pragma unroll
  for (int dt = 0; dt < 4; ++dt)
    *(bf16x4*)(Y4 + (size_t)qrow * 2048 + h * 64 + dt * 16 + fq * 4) = pack4(O[dt][0] * inv, O[dt][1] * inv, O[dt][2] * inv, O[dt][3] * inv);
}

DI void diff_item(const P& p, int l, bool latent, int b, int h, int qb, char* smem) {
  const int tid = otid(), lane = tid & 63, wid = tid >> 6, fr = lane & 15, fq = lane >> 4;
  const bf16_t* Z = (const bf16_t*)(p.ws + WS_Z);
  const int T = latent ? 2048 : 256;
  const int rowbase = latent ? NCTX + b * 2048 : b * 256;
  const bf16_t* VT = (const bf16_t*)(p.ws + WS_VTDF) + (latent ? (size_t)VT_LAT + (size_t)(b * 512 + h * 128) * 2048 : (size_t)(b * 512 + h * 128) * 256);
  const bf16_t* CVT = (const bf16_t*)(p.ws + WS_CVDF) + (size_t)(b * 4 + h) * 65536;
  bf16_t* Y4 = (bf16_t*)(p.ws + WS_Y4);
  const int qrow = rowbase + qb * 64 + wid * 16 + fr;
  float d1 = p.in[20][l * 64 + lane] * p.in[21][l * 64 + lane];
  float d2 = p.in[22][l * 64 + lane] * p.in[23][l * 64 + lane];
  d1 = wave_sum(d1);
  d2 = wave_sum(d2);
  const float lam_init = 0.8f - 0.6f * expf(-0.3f * (float)l);
  const float lam = expf(d1) - expf(d2) + lam_init;
  const int nown = T >> 6;
  const int ntiles = nown + (latent ? 8 : 0);

  f32x4 O1[8];
  f32x4 O[8];
#pragma unroll 1
  for (int comp = 0; comp < 2; ++comp) {
    bf16x8 qf[2];
#pragma unroll
    for (int ks = 0; ks < 2; ++ks) qf[ks] = *(const bf16x8*)(Z + (size_t)qrow * ZLD + ZC_DFQ + comp * 256 + h * 64 + ks * 32 + fq * 8);
#pragma unroll
    for (int dt = 0; dt < 8; ++dt) O[dt] = f32x4{0.f, 0.f, 0.f, 0.f};
    float m = -1e30f, lsum = 0.f;
    const bf16_t* Kb = Z + (size_t)rowbase * ZLD + ZC_DFK + comp * 256 + h * 64;
    const bf16_t* CK = (const bf16_t*)(p.ws + WS_CKDF) + (size_t)((b * 2 + comp) * 4 + h) * 32768;
    attn_loop<128, true>(ntiles,
        [&](int j, const bf16_t*& Kg, int& ldk, const bf16_t*& Vg, int& ldv) {
          if (j < nown) { Kg = Kb + (size_t)j * 64 * ZLD; ldk = ZLD; Vg = VT + j * 64; ldv = T; }
          else { Kg = CK + (size_t)(j - nown) * 64 * 64; ldk = 64; Vg = CVT + (j - nown) * 64; ldv = 512; }
        },
        [&](int, f32x4 (&S)[4]) { scale_scores(S); }, qf, O, m, lsum, (bf16_t*)smem, tid);
    float lt = lsum + __shfl_xor(lsum, 16);
    lt += __shfl_xor(lt, 32);
    const float inv = 1.f / lt;
    if (comp == 0) {
#pragma unroll
      for (int dt = 0; dt < 8; ++dt) { O1[dt][0] = O[dt][0] * inv; O1[dt][1] = O[dt][1] * inv; O1[dt][2] = O[dt][2] * inv; O1[dt][3] = O[dt][3] * inv; }
    } else {
#pragma unroll
      for (int dt = 0; dt < 8; ++dt) {
        O[dt][0] = O1[dt][0] - lam * (O[dt][0] * inv);
        O[dt][1] = O1[dt][1] - lam * (O[dt][1] * inv);
        O[dt][2] = O1[dt][2] - lam * (O[dt][2] * inv);
        O[dt][3] = O1[dt][3] - lam * (O[dt][3] * inv);
      }
    }
  }
  float ss = 0.f;
#pragma unroll
  for (int dt = 0; dt < 8; ++dt) ss += O[dt][0] * O[dt][0] + O[dt][1] * O[dt][1] + O[dt][2] * O[dt][2] + O[dt][3] * O[dt][3];
  ss += __shfl_xor(ss, 16);
  ss += __shfl_xor(ss, 32);
  const float rsn = rsqrtf(ss * (1.f / 128.f) + 1e-6f) * (1.f - lam_init);
  const float* gn = p.in[24] + l * 128;
#pragma unroll
  for (int dt = 0; dt < 8; ++dt) {
    int dv = dt * 16 + fq * 4;
    float4 g = *(const float4*)(gn + dv);
    *(bf16x4*)(Y4 + (size_t)qrow * 2048 + 512 + h * 128 + dv) = pack4(O[dt][0] * rsn * g.x, O[dt][1] * rsn * g.y, O[dt][2] * rsn * g.z, O[dt][3] * rsn * g.w);
  }
}

DI void ret_item(const P& p, int l, bool latent, int b, int h, int qb, char* smem) {
  bf16_t* sV0 = (bf16_t*)smem + 64 * LDT;
  const int tid = otid(), lane = tid & 63, wid = tid >> 6, fr = lane & 15, fq = lane >> 4;
  const bf16_t* Z = (const bf16_t*)(p.ws + WS_Z);
  const int T = latent ? 2048 : 256;
  const int rowbase = latent ? NCTX + b * 2048 : b * 256;
  const bf16_t* VT = (const bf16_t*)(p.ws + WS_VTRT) + (latent ? (size_t)VT_LAT + (size_t)(b * 512 + h * 64) * 2048 : (size_t)(b * 512 + h * 64) * 256);
  bf16_t* Y4 = (bf16_t*)(p.ws + WS_Y4);
  const int tq = qb * 64 + wid * 16 + fr;
  const int qrow = rowbase + tq;
  const float lgf = log1pf(-expf(p.in[25][l * 8 + h]));
  const float lgb = log1pf(-expf(p.in[26][l * 8 + h]));
  bf16x8 qf[2];
#pragma unroll
  for (int ks = 0; ks < 2; ++ks) qf[ks] = *(const bf16x8*)(Z + (size_t)qrow * ZLD + ZC_RTQ + h * 64 + ks * 32 + fq * 8);
  f32x4 O[4];
#pragma unroll
  for (int dt = 0; dt < 4; ++dt) O[dt] = f32x4{0.f, 0.f, 0.f, 0.f};
  float mdummy = 0.f, ldummy = 0.f;
  const int dq = wid * 16 + fr;
  float AF[4], BF[4], AB[4], BB[4];
#pragma unroll
  for (int u = 0; u < 4; ++u) {
    AF[u] = __expf(-lgf * (float)(u * 16));
    AB[u] = __expf(lgb * (float)(u * 16));
    BF[u] = __expf(-lgf * (float)(fq * 4 + u));
    BB[u] = __expf(lgb * (float)(fq * 4 + u));
  }
  const bf16_t* Kb = Z + (size_t)rowbase * ZLD + ZC_RTK + h * 64;
  attn_loop<64, false>(T >> 6,
      [&](int j, const bf16_t*& Kg, int& ldk, const bf16_t*& Vg, int& ldv) { Kg = Kb + (size_t)j * 64 * ZLD; ldk = ZLD; Vg = VT + j * 64; ldv = T; },
      [&](int j, f32x4 (&S)[4]) {
        if (j == qb) {
#pragma unroll
          for (int s = 0; s < 4; ++s)
#pragma unroll
            for (int i = 0; i < 4; ++i) {
              int tk = j * 64 + s * 16 + fq * 4 + i;
              int dd = tq - tk;
              float w = dd >= 0 ? __expf(lgf * (float)dd) : __expf(lgb * (float)(-dd));
              S[s][i] *= w;
            }
        } else if (j < qb) {
          const float qfac = __expf(lgf * (float)((qb - j) * 64 + dq));
#pragma unroll
          for (int s = 0; s < 4; ++s) {
            const float f = qfac * AF[s];
            S[s][0] *= f * BF[0]; S[s][1] *= f * BF[1]; S[s][2] *= f * BF[2]; S[s][3] *= f * BF[3];
          }
        } else {
          const float qfac = __expf(lgb * (float)((j - qb) * 64 - dq));
#pragma unroll
          for (int s = 0; s < 4; ++s) {
            const float f = qfac * AB[s];
            S[s][0] *= f * BB[0]; S[s][1] *= f * BB[1]; S[s][2] *= f * BB[2]; S[s][3] *= f * BB[3];
          }
        }
      },
      qf, O, mdummy, ldummy, (bf16_t*)smem, tid);
  if (latent) {
    for (int dir = 0; dir < 2; ++dir) {
      const float* S0 = (dir == 0 ? p.in[6] : p.in[7]) + ((size_t)((b * 4 + l) * 8 + h)) * 4096;
#pragma unroll
      for (int i = 0; i < 4; ++i) {
        int e = (tid + i * 256) * 4;
        float4 v = *(const float4*)(S0 + e);
        int dk = e >> 6, dv = e & 63;
        sV0[(dv + 0) * LDT + dk] = f2bf(v.x);
        sV0[(dv + 1) * LDT + dk] = f2bf(v.y);
        sV0[(dv + 2) * LDT + dk] = f2bf(v.z);
        sV0[(dv + 3) * LDT + dk] = f2bf(v.w);
      }
      __syncthreads();
      const float sc = dir == 0 ? __expf(lgf * (float)(tq + 1)) : __expf(lgb * (float)(T - tq));
      bf16x8 pb[2];
#pragma unroll
      for (int s2 = 0; s2 < 2; ++s2) {
        const bf16_t* qp = Z + (size_t)qrow * ZLD + ZC_RTQ + h * 64 + 32 * s2 + 4 * fq;
        bf16x4 lo = *(const bf16x4*)qp;
        bf16x4 hi = *(const bf16x4*)(qp + 16);
        f32x4 flo = {bfs2f(lo[0]) * sc, bfs2f(lo[1]) * sc, bfs2f(lo[2]) * sc, bfs2f(lo[3]) * sc};
        f32x4 fhi = {bfs2f(hi[0]) * sc, bfs2f(hi[1]) * sc, bfs2f(hi[2]) * sc, bfs2f(hi[3]) * sc};
        pb[s2] = pack8(flo, fhi);
      }
      pv_step<64>(pb, sV0, O, fr, fq);
      __syncthreads();
    }
  }
  float ss = 0.f;
#pragma unroll
  for (int dt = 0; dt < 4; ++dt) ss += O[dt][0] * O[dt][0] + O[dt][1] * O[dt][1] + O[dt][2] * O[dt][2] + O[dt][3] * O[dt][3];
  ss += __shfl_xor(ss, 16);
  ss += __shfl_xor(ss, 32);
  const float rsn = rsqrtf(ss * (1.f / 64.f) + 1e-6f);
  const float* gn = p.in[27] + l * 512 + h * 64;
#pragma unroll
  for (int dt = 0; dt < 4; ++dt) {
    int dv = dt * 16 + fq * 4;
    float4 g = *(const float4*)(gn + dv);
    bf16x4 sg = *(const bf16x4*)(Z + (size_t)qrow * ZLD + ZC_RTG + h * 64 + dv);
    *(bf16x4*)(Y4 + (size_t)qrow * 2048 + 1024 + h * 64 + dv) =
        pack4(O[dt][0] * rsn * g.x * bfs2f(sg[0]), O[dt][1] * rsn * g.y * bfs2f(sg[1]), O[dt][2] * rsn * g.z * bfs2f(sg[2]), O[dt][3] * rsn * g.w * bfs2f(sg[3]));
  }
}

DI void ret_state_item(const P& p, int l, int b, int h) {
  const int tid_ = otid(), lane = tid_ & 63, wid = tid_ >> 6, fr = lane & 15, fq = lane >> 4;
  const bf16_t* KT = (const bf16_t*)(p.ws + WS_KTRT) + (size_t)(b * 512 + h * 64) * 256;
  const bf16_t* VT = (const bf16_t*)(p.ws + WS_VTRT) + (size_t)(b * 512 + h * 64) * 256;
  const float lgf = log1pf(-expf(p.in[25][l * 8 + h]));
  const float lgb = log1pf(-expf(p.in[26][l * 8 + h]));
  f32x4 af[4], ab[4];
#pragma unroll
  for (int nt = 0; nt < 4; ++nt) { af[nt] = f32x4{0.f, 0.f, 0.f, 0.f}; ab[nt] = f32x4{0.f, 0.f, 0.f, 0.f}; }
  for (int ks = 0; ks < 8; ++ks) {
    const int t0 = ks * 32 + fq * 8;
    bf16x8 kraw = *(const bf16x8*)(KT + (size_t)(wid * 16 + fr) * 256 + t0);
    bf16x8 kf, kb;
#pragma unroll
    for (int j = 0; j < 8; ++j) {
      float kv = bfs2f(kraw[j]);
      int t = t0 + j;
      kf[j] = (short)f2bf(kv * __expf(lgf * (float)(255 - t)));
      kb[j] = (short)f2bf(kv * __expf(lgb * (float)t));
    }
#pragma unroll
    for (int nt = 0; nt < 4; ++nt) {
      bf16x8 vb = *(const bf16x8*)(VT + (size_t)(nt * 16 + fr) * 256 + t0);
      af[nt] = MFMA16(kf, vb, af[nt]);
      ab[nt] = MFMA16(kb, vb, ab[nt]);
    }
  }
  float* of = p.out + O_RF + ((size_t)((b * 4 + l) * 8 + h)) * 4096;
  float* ob = p.out + O_RB + ((size_t)((b * 4 + l) * 8 + h)) * 4096;
#pragma unroll
  for (int nt = 0; nt < 4; ++nt)
#pragma unroll
    for (int i = 0; i < 4; ++i) {
      int dk = wid * 16 + fq * 4 + i, dv = nt * 16 + fr;
      of[dk * 64 + dv] = af[nt][i];
      ob[dk * 64 + dv] = ab[nt][i];
    }
}

DI void lru_gates_item(const P& p, int l, int chunk, int n, char* smem) {
  float* XDf = (float*)smem;
  bf16_t* XDb = (bf16_t*)(XDf + 4096);
  const int tid = otid(), lane = tid & 63, wid = tid >> 6, fr = lane & 15, fq = lane >> 4;
  const int row0 = chunk * 64;
  const bool latent = row0 >= NCTX;
  const int T = latent ? 2048 : 256;
  const int tseq0 = latent ? ((row0 - NCTX) & 2047) : (row0 & 255);
  const bf16_t* Z = (const bf16_t*)(p.ws + WS_Z);
  const bf16_t* WL = (const bf16_t*)(p.ws + WS_WLRU);
  bf16_t* LA = (bf16_t*)(p.ws + WS_LA);
  bf16_t* LU = (bf16_t*)(p.ws + WS_LU);
  const int ch0 = n * 64;
  {
    const float cw0 = p.in[28][(l * 4 + 0) * 512 + ch0 + lane];
    const float cw1 = p.in[28][(l * 4 + 1) * 512 + ch0 + lane];
    const float cw2 = p.in[28][(l * 4 + 2) * 512 + ch0 + lane];
    const float cw3 = p.in[28][(l * 4 + 3) * 512 + ch0 + lane];
    const float cb = p.in[29][l * 512 + ch0 + lane];
    const bf16_t* xcol = Z + (size_t)row0 * ZLD + ZC_LRX + ch0 + lane;
    const int t0 = wid * 16;
    auto ld = [&](int tl) -> float {
      int ts = tseq0 + tl;
      return (ts < 0 || ts >= T) ? 0.f : bf2f(xcol[(ptrdiff_t)tl * ZLD]);
    };
    float xm1 = ld(t0 - 1), x0 = ld(t0), x1 = ld(t0 + 1);
#pragma unroll
    for (int i = 0; i < 16; ++i) {
      float x2 = ld(t0 + i + 2);
      float xd = cw0 * xm1 + cw1 * x0 + cw2 * x1 + cw3 * x2 + cb;
      XDf[(t0 + i) * 64 + lane] = xd;
      XDb[(t0 + i) * LDT + lane] = f2bf(xd);
      xm1 = x0; x0 = x1; x1 = x2;
    }
  }
  __syncthreads();
  bf16x8 af[2];
#pragma unroll
  for (int ks = 0; ks < 2; ++ks) af[ks] = *(const bf16x8*)(XDb + (wid * 16 + fr) * LDT + ks * 32 + fq * 8);
#pragma unroll 1
  for (int dir = 0; dir < 2; ++dir) {
    const float* bav = (dir == 0 ? p.in[31] : p.in[36]) + l * 512 + ch0;
    const float* bxv = (dir == 0 ? p.in[33] : p.in[38]) + l * 512 + ch0;
    const float* lamv = (dir == 0 ? p.in[34] : p.in[39]) + l * 512 + ch0;
#pragma unroll
    for (int et = 0; et < 4; ++et) {
      f32x4 da = {0.f, 0.f, 0.f, 0.f}, dx = {0.f, 0.f, 0.f, 0.f};
#pragma unroll
      for (int ks = 0; ks < 2; ++ks) {
        bf16x8 wa = *(const bf16x8*)(WL + (size_t)((dir * 2 + 0) * 8 + n) * 4096 + (et * 16 + fr) * 64 + ks * 32 + fq * 8);
        bf16x8 wx = *(const bf16x8*)(WL + (size_t)((dir * 2 + 1) * 8 + n) * 4096 + (et * 16 + fr) * 64 + ks * 32 + fq * 8);
        da = MFMA16(af[ks], wa, da);
        dx = MFMA16(af[ks], wx, dx);
      }
      const int e = et * 16 + fr;
      const float ba_ = bav[e], bx_ = bxv[e];
      const float sp = log1pf(expf(-lamv[e]));
      float lav[4], uv[4];
#pragma unroll
      for (int i = 0; i < 4; ++i) {
        int tl = wid * 16 + fq * 4 + i;
        float rg = sigmoidf_(da[i] + ba_);
        float ig = sigmoidf_(dx[i] + bx_);
        float la = -8.f * rg * sp;
        lav[i] = la;
        uv[i] = sqrtf(1.f - __expf(2.f * la)) * (ig * XDf[tl * 64 + e]);
      }
      const size_t idx = (size_t)dir * 8388608 + ((size_t)chunk * 512 + ch0 + e) * 64 + wid * 16 + fq * 4;
      *(bf16x4*)(LA + idx) = pack4(lav[0], lav[1], lav[2], lav[3]);
      *(bf16x4*)(LU + idx) = pack4(uv[0], uv[1], uv[2], uv[3]);
    }
  }
  __syncthreads();
}

DI void lru_scan_witem(const P& p, int l, int bglob, int g, int lane) {
  const bool latent = bglob >= 32;
  const int T = latent ? 2048 : 256;
  const int rowbase = latent ? NCTX + (bglob - 32) * 2048 : bglob * 256;
  const int chunk0 = rowbase >> 6, nch = T >> 6;
  const int ch = g * 64 + lane;
  const bf16_t* LA = (const bf16_t*)(p.ws + WS_LA);
  const bf16_t* LU = (const bf16_t*)(p.ws + WS_LU);
  bf16_t* HF = (bf16_t*)(p.ws + WS_HF);
  const bf16_t* LG = (const bf16_t*)(p.ws + WS_LG);
  bf16_t* Y4 = (bf16_t*)(p.ws + WS_Y4);
  {
    float h = latent ? p.in[8][((bglob - 32) * 4 + l) * 512 + ch] : 0.f;
    bf16x8 ca[8], cu[8], na[8], nu[8];
    {
      const size_t b0 = ((size_t)chunk0 * 512 + ch) * 64;
#pragma unroll
      for (int q = 0; q < 8; ++q) { ca[q] = *(const bf16x8*)(LA + b0 + q * 8); cu[q] = *(const bf16x8*)(LU + b0 + q * 8); }
    }
    for (int cc = 0; cc < nch; ++cc) {
      const size_t cbase = ((size_t)(chunk0 + cc) * 512 + ch) * 64;
      const int cn = (cc + 1 < nch) ? cc + 1 : cc;
      const size_t nb = ((size_t)(chunk0 + cn) * 512 + ch) * 64;
#pragma unroll
      for (int q = 0; q < 8; ++q) { na[q] = *(const bf16x8*)(LA + nb + q * 8); nu[q] = *(const bf16x8*)(LU + nb + q * 8); }
#pragma unroll
      for (int q = 0; q < 8; ++q) {
        bf16x8 ho;
#pragma unroll
        for (int j = 0; j < 8; ++j) {
          float a = __expf(bfs2f(ca[q][j]));
          h = a * h + bfs2f(cu[q][j]);
          ho[j] = (short)f2bf(h);
        }
        *(bf16x8*)(HF + cbase + q * 8) = ho;
      }
#pragma unroll
      for (int q = 0; q < 8; ++q) { ca[q] = na[q]; cu[q] = nu[q]; }
    }
    if (!latent) p.out[O_LF + (size_t)(bglob * 4 + l) * 512 + ch] = h;
  }
  {
    float h = latent ? p.in[9][((bglob - 32) * 4 + l) * 512 + ch] : 0.f;
    const bf16_t* LAb = LA + 8388608;
    const bf16_t* LUb = LU + 8388608;
    bf16x8 ca[4], cu[4], chf[4], cg_[4], na[4], nu[4], nhf[4], ng[4];
    const int nb_ = 2 * nch;
    {
      const size_t b0 = ((size_t)(chunk0 + nch - 1) * 512 + ch) * 64 + 32;
#pragma unroll
      for (int q = 0; q < 4; ++q) {
        ca[q] = *(const bf16x8*)(LAb + b0 + q * 8); cu[q] = *(const bf16x8*)(LUb + b0 + q * 8);
        chf[q] = *(const bf16x8*)(HF + b0 + q * 8); cg_[q] = *(const bf16x8*)(LG + b0 + q * 8);
      }
    }
    for (int bi = 0; bi < nb_; ++bi) {
      const int chunk = nch - 1 - (bi >> 1), half = 1 - (bi & 1);
      const int bn = (bi + 1 < nb_) ? bi + 1 : bi;
      const int chunkn = nch - 1 - (bn >> 1), halfn = 1 - (bn & 1);
      const size_t nb = ((size_t)(chunk0 + chunkn) * 512 + ch) * 64 + halfn * 32;
#pragma unroll
      for (int q = 0; q < 4; ++q) {
        na[q] = *(const bf16x8*)(LAb + nb + q * 8); nu[q] = *(const bf16x8*)(LUb + nb + q * 8);
        nhf[q] = *(const bf16x8*)(HF + nb + q * 8); ng[q] = *(const bf16x8*)(LG + nb + q * 8);
      }
      bf16_t* yrow = Y4 + (size_t)(rowbase + chunk * 64 + half * 32) * 2048 + 1536 + ch;
#pragma unroll
      for (int q = 3; q >= 0; --q) {
#pragma unroll
        for (int j = 7; j >= 0; --j) {
          float a = __expf(bfs2f(ca[q][j]));
          h = a * h + bfs2f(cu[q][j]);
          float y = (bfs2f(chf[q][j]) + h) * bfs2f(cg_[q][j]);
          yrow[(size_t)(q * 8 + j) * 2048] = f2bf(y);
        }
      }
#pragma unroll
      for (int q = 0; q < 4; ++q) { ca[q] = na[q]; cu[q] = nu[q]; chf[q] = nhf[q]; cg_[q] = ng[q]; }
    }
    if (!latent) p.out[O_LB + (size_t)(bglob * 4 + l) * 512 + ch] = h;
  }
}

DI int next_item(unsigned* ctr, int* s_item) {
  __syncthreads();
  if (threadIdx.x == 0) *s_item = (int)atomicAdd(ctr, 1u);
  __syncthreads();
  return *s_item;
}
DI void phase_mixa(const P& p, int l, char* smem, int* s_item) {
  unsigned* ctr = (unsigned*)(p.ws + WS_BAR + 14336) + l * 2;
  const int NGRAB = 512 + 512;
  for (;;) {
    int q = next_item(ctr, s_item);
    if (q >= NGRAB) break;
    if (q < 512) { diff_item(p, l, true, q >> 7, (q >> 5) & 3, q & 31, smem); continue; }
    q -= 512;
#pragma unroll 1
    for (int u = 0; u < 4; ++u) { const int g = q * 4 + u; lru_gates_item(p, l, g >> 3, g & 7, smem); }
  }
}
DI void phase_mixb(const P& p, int l, char* smem, int* s_item) {
  unsigned* ctr = (unsigned*)(p.ws + WS_BAR + 14336) + l * 2 + 1;
  const int NGRAB = 72 + 1024 + 1024 + 256 + 256 + 256 + 32;
  for (;;) {
    int q = next_item(ctr, s_item);
    if (q >= NGRAB) break;
    if (q < 72) {
      const int tid = otid(), lane = tid & 63, wid = tid >> 6;
      int bglob, g;
      if (q < 32) {
        if (wid == 0) { bglob = 32 + (q >> 3); g = q & 7; }
        else { int ci = q * 3 + wid - 1; bglob = ci >> 3; g = ci & 7; }
      } else {
        int ci = 96 + (q - 32) * 4 + wid;
        bglob = ci >> 3; g = ci & 7;
      }
      lru_scan_witem(p, l, bglob, g, lane);
      continue;
    }
    q -= 72;
    if (q < 1024) { ret_item(p, l, true, q >> 8, (q >> 5) & 7, q & 31, smem); continue; }
    q -= 1024;
    if (q < 1024) { na_item(p, l, q >> 8, (q >> 5) & 7, q & 31, smem); continue; }
    q -= 1024;
    if (q < 256) {
#pragma unroll 1
      for (int u = 0; u < 2; ++u) { const int g = q * 2 + u; diff_item(p, l, false, g >> 4, (g >> 2) & 3, g & 3, smem); }
      continue;
    }
    q -= 256;
    if (q < 256) {
#pragma unroll 1
      for (int u = 0; u < 4; ++u) { const int g = q * 4 + u; dense_item(p, g >> 5, (g >> 2) & 7, g & 3, smem); }
      continue;
    }
    q -= 256;
    if (q < 256) {
#pragma unroll 1
      for (int u = 0; u < 4; ++u) { const int g = q * 4 + u; ret_item(p, l, false, g >> 5, (g >> 2) & 7, g & 3, smem); }
      continue;
    }
    q -= 256;
#pragma unroll 1
    for (int u = 0; u < 8; ++u) { const int g = q * 8 + u; ret_state_item(p, l, g >> 3, g & 7); }
  }
}

#define XB_TMO 128
#define XB_XCNT(j) (256 + 64 * (j))
#define XB_XSUB(j) (1280 + 64 * (j))
#define XB_XGEN(j) (2304 + 64 * (j))
#define XB_TOP 3328
#define XB_TOPGEN 3392
#define XCD_BAR_WORDS 3456
#define XB_SPIN_CAP (1u << 18)
#define LAS __attribute__((address_space(3)))
DI unsigned xb_ld(unsigned* p) { return __hip_atomic_load(p, __ATOMIC_RELAXED, __HIP_MEMORY_SCOPE_AGENT); }
DI unsigned xb_add(unsigned* p, unsigned v) { return __hip_atomic_fetch_add(p, v, __ATOMIC_RELAXED, __HIP_MEMORY_SCOPE_AGENT); }
DI unsigned xb_xcc_id() { return (unsigned)__builtin_amdgcn_s_getreg((3 << 11) | 20) & 0xFu; }
#define XB_SPIN(cond, bar) do { unsigned _sp = 0; while (cond) { __builtin_amdgcn_s_sleep(1); \
    if ((++_sp & 255u) == 0u) { if (xb_ld(&(bar)[XB_TMO])) break; if (_sp > XB_SPIN_CAP) { atomicAdd(&(bar)[XB_TMO], 1u); break; } } } } while (0)
struct XcdBarrier { unsigned* bar; unsigned x; volatile LAS unsigned* st; };
DI XcdBarrier xcd_barrier_post(unsigned* bar, volatile LAS unsigned* st) {
  XcdBarrier b; b.bar = bar; b.x = xb_xcc_id(); b.st = st;
  if (threadIdx.x == 0) (void)xb_add(&bar[XB_XCNT(b.x)], 1u);
  return b;
}
DI void xcd_barrier_complete(unsigned* bar, unsigned x, unsigned& nloc, unsigned& nx) {
  const unsigned G = gridDim.x * gridDim.y * gridDim.z;
  unsigned sum, cnt, mine, sp = 0u;
  for (;;) {
    sum = 0u; cnt = 0u; mine = 0u;
#pragma unroll
    for (unsigned j = 0; j < 16; ++j) { const unsigned c = xb_ld(&bar[XB_XCNT(j)]); sum += c; cnt += (c > 0u) ? 1u : 0u; mine = (j == x) ? c : mine; }
    if (sum == G) break;
    __builtin_amdgcn_s_sleep(1);
    if ((++sp & 255u) == 0u) { if (xb_ld(&bar[XB_TMO])) break; if (sp > XB_SPIN_CAP) { atomicAdd(&bar[XB_TMO], 1u); break; } }
  }
  nloc = mine > 0u ? mine : 1u; nx = cnt > 0u ? cnt : 1u;
}
DI void xcd_barrier(const XcdBarrier& b) {
  asm volatile("s_waitcnt vmcnt(0)" ::: "memory");
  __syncthreads();
  if (threadIdx.x == 0) {
    unsigned* bar = b.bar;
    __builtin_amdgcn_s_waitcnt(0);
    unsigned nloc = b.st[0], nx = b.st[1];
    if (nloc == 0u) { xcd_barrier_complete(bar, b.x, nloc, nx); b.st[0] = nloc; b.st[1] = nx; }
    const unsigned old = xb_add(&bar[XB_XSUB(b.x)], 1u);
    const unsigned gen = old / nloc;
    if (old + 1u == (gen + 1u) * nloc) {
      __builtin_amdgcn_fence(__ATOMIC_RELEASE, "agent");
      asm volatile("s_waitcnt vmcnt(0)" ::: "memory");
      const unsigned og = xb_add(&bar[XB_TOP], 1u);
      const unsigned tg = og / nx;
      if (og + 1u == (tg + 1u) * nx) xb_add(&bar[XB_TOPGEN], 1u);
      else XB_SPIN(xb_ld(&bar[XB_TOPGEN]) == tg, bar);
      __builtin_amdgcn_fence(__ATOMIC_ACQUIRE, "agent");
      xb_add(&bar[XB_XGEN(b.x)], 1u);
      asm volatile("s_waitcnt vmcnt(0)" ::: "memory");
    } else {
      XB_SPIN(xb_ld(&bar[XB_XGEN(b.x)]) == gen, bar);
      __builtin_amdgcn_fence(__ATOMIC_ACQUIRE, "agent");
      asm volatile("s_waitcnt vmcnt(0)" ::: "memory");
    }
  }
  __syncthreads();
}

enum { PH_INIT = 0, PH_PRE0, PH_GIN, PH_MIXA, PH_MIXB, PH_MERGE, PH_OUT, PH_POSTMIX, PH_FF1, PH_FF2, PH_POSTFFN };

DI void run_phase(const P& p, int ph, int l, char* smem, int* s_item) {
  switch (ph) {
    case PH_INIT:
      phase_mod(p, smem);
      phase_convert(p, 0, smem);
      break;
    case PH_PRE0: phase_row(p, 0, 0); break;
    case PH_GIN: phase_gin(p, l, smem); break;
    case PH_MIXA: phase_mixa(p, l, smem, s_item); break;
    case PH_MIXB: phase_mixb(p, l, smem, s_item); break;
    case PH_MERGE: phase_merge(p, smem); break;
    case PH_OUT:
      phase_gemm_plain<0>((const bf16_t*)(p.ws + WS_H), 1024, (const bf16_t*)(p.ws + WS_WOUT), 1024, (bf16_t*)(p.ws + WS_Y), smem);
      break;
    case PH_POSTMIX: phase_row(p, l, 1); break;
    case PH_FF1:
      phase_gemm_plain<1>((const bf16_t*)(p.ws + WS_H), 1024, (const bf16_t*)(p.ws + WS_W1), 4096, (bf16_t*)(p.ws + WS_U), smem);
      break;
    case PH_FF2:
      phase_gemm_plain<0>((const bf16_t*)(p.ws + WS_U), 4096, (const bf16_t*)(p.ws + WS_W2), 1024, (bf16_t*)(p.ws + WS_Y), smem);
      break;
    case PH_POSTFFN:
      phase_row(p, l, 2);
      if (l < 3) phase_convert(p, l + 1, smem);
      break;
    default: break;
  }
}

DI void decode_step(int step, int& ph, int& l) {
  if (step < 2) { ph = step; l = 0; }
  else { int s = step - 2; l = s / 9; ph = PH_GIN + (s % 9); }
}
constexpr int NSTEPS = 38;

__global__ void __launch_bounds__(256, 2) hybrid_flow_mega(P p) {
  __shared__ __attribute__((aligned(16))) char smem[SMEM_BYTES];
  __shared__ uint4 xb_words;
  __shared__ int s_item;
  cg::grid_group grid = cg::this_grid();
  if (threadIdx.x == 0) xb_words = make_uint4(0u, 0u, 0u, 0u);
  __syncthreads();
  XcdBarrier xb = xcd_barrier_post((unsigned*)(p.ws + WS_BAR), (volatile LAS unsigned*)&xb_words);
  for (int step = 0; step < NSTEPS; ++step) {
    int ph, l;
    decode_step(step, ph, l);
#ifdef PROBE_DUP
    const int reps = (ph == PROBE_DUP) ? 2 : 1;
    for (int rep = 0; rep < reps; ++rep)
#endif
    run_phase(p, ph, l, smem, &s_item);
#ifdef PROBE_CONV
    if (ph == PH_POSTFFN && l < 3) phase_convert(p, l + 1, smem);
#endif
    if (step == 0) grid.sync();
    else if (step + 1 < NSTEPS) xcd_barrier(xb);
#ifdef PROBE_SYNC
    if (step + 1 < NSTEPS) xcd_barrier(xb);
#endif
  }
}

#if !ONE_LAUNCH
__global__ void __launch_bounds__(256, 2) hybrid_flow_phase(P p, int ph, int l) {
  __shared__ __attribute__((aligned(16))) char smem[SMEM_BYTES];
  __shared__ int s_item;
  run_phase(p, ph, l, smem, &s_item);
}
#endif

extern "C" void kernel_launch(void* const* d_in, const int* in_sizes, int n_in, void* d_out, int out_size, void* d_ws,
                              size_t ws_size, hipStream_t stream) {
  (void)in_sizes; (void)n_in; (void)out_size; (void)ws_size;
  P p{};
  for (int i = 0; i < 44; ++i) p.in[i] = (const float*)d_in[i];
  p.out = (float*)d_out;
  p.ws = (char*)d_ws;
#if ONE_LAUNCH
  static int grid_blocks = 0;
  if (!grid_blocks) {
    int dev = 0, cus = 0, per_cu = 0;
    hipGetDevice(&dev);
    hipDeviceGetAttribute(&cus, hipDeviceAttributeMultiprocessorCount, dev);
    hipOccupancyMaxActiveBlocksPerMultiprocessor(&per_cu, hybrid_flow_mega, 256, 0);
    if (per_cu < 1) per_cu = 1;
    if (per_cu > 2) per_cu = 2;
    grid_blocks = cus * per_cu;
  }
  (void)hipMemsetAsync((char*)d_ws + WS_BAR, 0, 16384, stream);
  void* args[] = {&p};
  hipError_t e = hipLaunchCooperativeKernel((void*)hybrid_flow_mega, dim3(grid_blocks), dim3(256), args, 0, stream);
  if (e != hipSuccess) fprintf(stderr, "cooperative launch failed: %s (grid %d)\n", hipGetErrorString(e), grid_blocks);
#else
  const int grid_blocks = 512;
  for (int step = 0; step < NSTEPS; ++step) {
    int ph, l;
    if (step < 2) { ph = step; l = 0; }
    else { int s = step - 2; l = s / 9; ph = PH_GIN + (s % 9); }
    hipLaunchKernelGGL(hybrid_flow_phase, dim3(grid_blocks), dim3(256), 0, stream, p, ph, l);
  }
#endif
}
```

```cpp
#include <hip/hip_runtime.h>
#include <hip/hip_cooperative_groups.h>
#include <cstdio>
namespace cg = cooperative_groups;

#ifndef ONE_LAUNCH
#define ONE_LAUNCH 1
#endif

typedef unsigned short bf16_t;
using bf16x8 = __attribute__((ext_vector_type(8))) short;
using bf16x4 = __attribute__((ext_vector_type(4))) short;
using f32x4 = __attribute__((ext_vector_type(4))) float;
using u32x4 = __attribute__((ext_vector_type(4))) unsigned;
#define DI __device__ __forceinline__
#define MFMA16(a, b, c) __builtin_amdgcn_mfma_f32_16x16x32_bf16((a), (b), (c), 0, 0, 0)

struct P {
  const float* in[44];
  float* out;
  char* ws;
};

constexpr int D = 1024, NCTX = 8192;
constexpr int ZLD = 4160;
constexpr int ZC_NAQ = 0, ZC_NAK = 512, ZC_DFQ = 1024, ZC_DFK = 1536, ZC_RTQ = 2048, ZC_RTK = 2560, ZC_RTG = 3072,
              ZC_LRX = 3584;
constexpr int LDT = 72;

constexpr size_t WS_WIN = 0;
constexpr size_t WS_WBR = WS_WIN + (size_t)10240 * 1024 * 2;
constexpr size_t WS_WOUT = WS_WBR + (size_t)1024 * 2048 * 2;
constexpr size_t WS_W1 = WS_WOUT + (size_t)1024 * 1024 * 2;
constexpr size_t WS_W2 = WS_W1 + (size_t)4096 * 1024 * 2;
constexpr size_t WS_WLRU = WS_W2 + (size_t)4096 * 1024 * 2;
constexpr size_t WS_CKNA = WS_WLRU + (size_t)32 * 4096 * 2;
constexpr size_t WS_CVNA = WS_CKNA + (size_t)4 * 262144 * 2;
constexpr size_t WS_CKDF = WS_CVNA + (size_t)4 * 262144 * 2;
constexpr size_t WS_CVDF = WS_CKDF + (size_t)4 * 262144 * 2;
constexpr size_t WS_MOD = WS_CVDF + (size_t)4 * 262144 * 2;
constexpr size_t WS_H = WS_MOD + (size_t)4 * 5 * 6144 * 4;
constexpr size_t WS_Y4 = WS_H + (size_t)16384 * 1024 * 2;
constexpr size_t WS_VTNA = WS_Y4 + (size_t)16384 * 2048 * 2;
constexpr size_t WS_VTDF = WS_VTNA + (size_t)16384 * 512 * 2;
constexpr size_t WS_VTRT = WS_VTDF + (size_t)16384 * 512 * 2;
constexpr size_t WS_KTRT = WS_VTRT + (size_t)16384 * 512 * 2;
constexpr size_t WS_Z = WS_KTRT + (size_t)8192 * 512 * 2;
constexpr size_t WS_GF = WS_Z + (size_t)16384 * ZLD * 2;
constexpr size_t WS_Y = WS_Z;
constexpr size_t WS_U = WS_Z + (size_t)16384 * 1024 * 4;
constexpr size_t WS_LA = WS_GF + (size_t)16384 * 4096 * 2;
constexpr size_t WS_LU = WS_LA + (size_t)2 * 16384 * 512 * 2;
constexpr size_t WS_HF = WS_LU + (size_t)2 * 16384 * 512 * 2;
constexpr size_t WS_LG = WS_HF + (size_t)16384 * 512 * 2;
constexpr size_t WS_BAR = WS_LG + (size_t)16384 * 512 * 2;
constexpr size_t WS_END = WS_BAR + 16384;

constexpr size_t O_NAK = 16777216, O_NAV = 33554432, O_DFK = 50331648, O_DFV = 67108864, O_RF = 83886080,
                 O_RB = 88080384, O_LF = 92274688, O_LB = 92340224;
constexpr int VT_LAT = 4194304;

constexpr int SMEM_BYTES = 75776;

DI int otid() {
  int t = threadIdx.x;
  asm volatile("" : "+v"(t));
  return t;
}
typedef __bf16 hwbf2 __attribute__((ext_vector_type(2)));
typedef float f32v2 __attribute__((ext_vector_type(2)));
using u32x2 = __attribute__((ext_vector_type(2))) unsigned;
DI unsigned pk2(float a, float b) {
  f32v2 v = {a, b};
  return __builtin_bit_cast(unsigned, __builtin_convertvector(v, hwbf2));
}
DI bf16_t f2bf(float x) { return (bf16_t)(pk2(x, 0.f) & 0xffffu); }
DI float bf2f(bf16_t b) { return __uint_as_float(((unsigned)b) << 16); }
DI float bfs2f(short b) { return __uint_as_float(((unsigned)(unsigned short)b) << 16); }
DI float wave_sum(float v) {
#pragma unroll
  for (int o = 32; o > 0; o >>= 1) v += __shfl_xor(v, o);
  return v;
}
DI float xmax16(float v) {
  unsigned u = __float_as_uint(v);
  auto r = __builtin_amdgcn_permlane16_swap(u, u, false, false);
  return fmaxf(__uint_as_float(r[0]), __uint_as_float(r[1]));
}
DI float xmax32(float v) {
  unsigned u = __float_as_uint(v);
  auto r = __builtin_amdgcn_permlane32_swap(u, u, false, false);
  return fmaxf(__uint_as_float(r[0]), __uint_as_float(r[1]));
}
DI float xsum16(float v) {
  unsigned u = __float_as_uint(v);
  auto r = __builtin_amdgcn_permlane16_swap(u, u, false, false);
  return __uint_as_float(r[0]) + __uint_as_float(r[1]);
}
DI float xsum32(float v) {
  unsigned u = __float_as_uint(v);
  auto r = __builtin_amdgcn_permlane32_swap(u, u, false, false);
  return __uint_as_float(r[0]) + __uint_as_float(r[1]);
}
DI float sigmoidf_(float x) { return 1.f / (1.f + __expf(-x)); }
DI float gelu_tanh(float x) {
  float u = 0.7978845608028654f * (x + 0.044715f * x * x * x);
  return x * sigmoidf_(2.f * u);
}
DI bf16x8 pack8(const f32x4& a, const f32x4& b) {
  u32x4 r = {pk2(a[0], a[1]), pk2(a[2], a[3]), pk2(b[0], b[1]), pk2(b[2], b[3])};
  return __builtin_bit_cast(bf16x8, r);
}
DI bf16x4 pack4(float a, float b, float c, float d) {
  u32x2 r = {pk2(a, b), pk2(c, d)};
  return __builtin_bit_cast(bf16x4, r);
}

constexpr int GEMM_BUF_BYTES = 32768;
DI int swz_off(int rr, int c4) {
  int ob = rr * 64 + c4 * 16;
  return ob ^ (((ob >> 9) & 1) << 5);
}
template <int NI>
DI void gemm_mainloop(const bf16_t* __restrict__ A, int lda, const bf16_t* __restrict__ Bt, int ldb, int K, int row0,
                      int col0, char* smem, f32x4 (&acc)[4][NI]) {
  const int tid = otid(), lane = tid & 63, wid = tid >> 6;
  const int wm = wid >> 1, wn = wid & 1, fr = lane & 15, fq = lane >> 4;
  const int c4 = tid & 3, kh = (tid >> 3) & 1;
  const int srow = ((tid >> 4) << 1) + ((tid >> 2) & 1);
  const int gk = (kh * 4 + c4) * 8;
  const int soff = ((srow >> 4) * 2 + kh) * 1024 + swz_off(srow & 15, c4);
  const bf16_t* Ag = A + (size_t)(row0 + srow) * lda + gk;
  const bf16_t* Bg = Bt + (size_t)(col0 + srow) * ldb + gk;
  const int aoff = wm * 8192 + swz_off(fr, fq);
  const int boff = 16384 + wn * NI * 2048 + swz_off(fr, fq);
  u32x4 ra[4], rb[NI];
#pragma unroll
  for (int i = 0; i < 4; ++i) ra[i] = *(const u32x4*)(Ag + (size_t)(i * 32) * lda);
#pragma unroll
  for (int i = 0; i < NI; ++i) rb[i] = *(const u32x4*)(Bg + (size_t)(i * 32) * ldb);
#pragma unroll
  for (int i = 0; i < 4; ++i) *(u32x4*)(smem + soff + i * 4096) = ra[i];
#pragma unroll
  for (int i = 0; i < NI; ++i) *(u32x4*)(smem + 16384 + soff + i * 4096) = rb[i];
  __syncthreads();
  const int nk = K >> 6;
  for (int kt = 0; kt < nk; ++kt) {
    const bool more = (kt + 1) < nk;
    if (more) {
      const int k1 = (kt + 1) * 64;
#pragma unroll
      for (int i = 0; i < 4; ++i) ra[i] = *(const u32x4*)(Ag + (size_t)(i * 32) * lda + k1);
#pragma unroll
      for (int i = 0; i < NI; ++i) rb[i] = *(const u32x4*)(Bg + (size_t)(i * 32) * ldb + k1);
    }
    asm volatile("" ::: "memory");
    const char* sb = smem + (kt & 1) * GEMM_BUF_BYTES;
#pragma unroll
    for (int ks = 0; ks < 2; ++ks) {
      bf16x8 af[4], bfr[NI];
#pragma unroll
      for (int mi = 0; mi < 4; ++mi) af[mi] = *(const bf16x8*)(sb + aoff + mi * 2048 + ks * 1024);
#pragma unroll
      for (int ni = 0; ni < NI; ++ni) bfr[ni] = *(const bf16x8*)(sb + boff + ni * 2048 + ks * 1024);
#pragma unroll
      for (int mi = 0; mi < 4; ++mi)
#pragma unroll
        for (int ni = 0; ni < NI; ++ni) acc[mi][ni] = MFMA16(bfr[ni], af[mi], acc[mi][ni]);
    }
    __builtin_amdgcn_sched_barrier(0);
    if (more) {
      char* db = smem + ((kt + 1) & 1) * GEMM_BUF_BYTES;
#pragma unroll
      for (int i = 0; i < 4; ++i) *(u32x4*)(db + soff + i * 4096) = ra[i];
#pragma unroll
      for (int i = 0; i < NI; ++i) *(u32x4*)(db + 16384 + soff + i * 4096) = rb[i];
    }
    __syncthreads();
  }
}

DI void zero_acc(f32x4 (&acc)[4][4]) {
#pragma unroll
  for (int mi = 0; mi < 4; ++mi)
#pragma unroll
    for (int ni = 0; ni < 4; ++ni) acc[mi][ni] = f32x4{0.f, 0.f, 0.f, 0.f};
}
DI bool tile_sched(int iter, int tmt, int ntn, int& tm, int& tn) {
  const int G = gridDim.x, b = blockIdx.x;
  if ((G & 63) == 0 && (ntn & 7) == 0 && (tmt & 7) == 0) {
    const int groups = G >> 6, xg = b % groups, j = b / groups;
    const int srows = tmt >> 3;
    const int s = iter * groups + xg, nsuper = srows * (ntn >> 3);
    if (s >= nsuper) return false;
    tm = (s % srows) * 8 + (j & 7);
    tn = (s / srows) * 8 + (j >> 3);
    return true;
  }
  const int id = b + iter * G;
  if (id >= tmt * ntn) return false;
  tm = id % tmt;
  tn = id / tmt;
  return true;
}

constexpr int G2_STAGE = 24576;
DI void zero_acc2(f32x4 (&acc)[8][4]) {
#pragma unroll
  for (int mi = 0; mi < 8; ++mi)
#pragma unroll
    for (int ni = 0; ni < 4; ++ni) acc[mi][ni] = f32x4{0.f, 0.f, 0.f, 0.f};
}
DI void gemm2_mainloop(const bf16_t* __restrict__ A, int lda, const bf16_t* __restrict__ Bt, int ldb, int K, int row0,
                       int col0, char* smem, f32x4 (&acc)[8][4]) {
  const int tid = otid(), lane = tid & 63, wid = tid >> 6;
  const int wm = wid >> 1, wn = wid & 1, fr = lane & 15, fq = lane >> 4;
  const int c4 = tid & 3, srow = tid >> 2;
  const int soff = (srow >> 4) * 1024 + swz_off(srow & 15, c4);
  const bf16_t* Ag = A + (size_t)(row0 + srow) * lda + c4 * 8;
  const bf16_t* Bg = Bt + (size_t)(col0 + srow) * ldb + c4 * 8;
  const int aoff = wm * 8192 + swz_off(fr, fq);
  const int boff = 16384 + wn * 4096 + swz_off(fr, fq);
  u32x4 raA[4], rbA[2], raB[4], rbB[2];
  const int nk = K >> 5;
  auto gload = [&](int kt, u32x4 (&ra)[4], u32x4 (&rb)[2]) __attribute__((always_inline)) {
    const int k1 = kt * 32;
#pragma unroll
    for (int i = 0; i < 4; ++i) ra[i] = *(const u32x4*)(Ag + (size_t)(i * 64) * lda + k1);
#pragma unroll
    for (int i = 0; i < 2; ++i) rb[i] = *(const u32x4*)(Bg + (size_t)(i * 64) * ldb + k1);
  };
  auto sstore = [&](int st, const u32x4 (&ra)[4], const u32x4 (&rb)[2]) __attribute__((always_inline)) {
    char* db = smem + st * G2_STAGE;
#pragma unroll
    for (int i = 0; i < 4; ++i) *(u32x4*)(db + soff + i * 4096) = ra[i];
#pragma unroll
    for (int i = 0; i < 2; ++i) *(u32x4*)(db + 16384 + soff + i * 4096) = rb[i];
  };
  auto compute = [&](int st) __attribute__((always_inline)) {
    const char* sb = smem + st * G2_STAGE;
    bf16x8 bfr[4];
#pragma unroll
    for (int ni = 0; ni < 4; ++ni) bfr[ni] = *(const bf16x8*)(sb + boff + ni * 1024);
    __builtin_amdgcn_s_setprio(1);
#pragma unroll
    for (int mi = 0; mi < 8; ++mi) {
      bf16x8 af = *(const bf16x8*)(sb + aoff + mi * 1024);
#pragma unroll
      for (int ni = 0; ni < 4; ++ni) acc[mi][ni] = MFMA16(bfr[ni], af, acc[mi][ni]);
    }
    __builtin_amdgcn_s_setprio(0);
  };
  gload(0, raA, rbA);
  gload(1, raB, rbB);
  sstore(0, raA, rbA);
  __syncthreads();
  for (int kt = 0; kt < nk; kt += 2) {
    gload(kt + 2 < nk ? kt + 2 : nk - 1, raA, rbA);
    asm volatile("" ::: "memory");
    compute(0);
    __builtin_amdgcn_sched_barrier(0);
    sstore(1, raB, rbB);
    __syncthreads();
    gload(kt + 3 < nk ? kt + 3 : nk - 1, raB, rbB);
    asm volatile("" ::: "memory");
    compute(1);
    __builtin_amdgcn_sched_barrier(0);
    sstore(0, raA, rbA);
    __syncthreads();
  }
}

constexpr int G3_STAGE = 16384;
DI void gemm3_mainloop(const bf16_t* __restrict__ A, int lda, const bf16_t* __restrict__ Bt, int ldb, int K, int row0,
                       int col0, char* smem, f32x4 (&acc)[4][4]) {
  const int tid = otid(), lane = tid & 63, wid = tid >> 6;
  const int wm = wid >> 1, wn = wid & 1, fr = lane & 15, fq = lane >> 4;
  const int c4 = tid & 3, srow = tid >> 2;
  const int soff = (srow >> 4) * 1024 + swz_off(srow & 15, c4);
  const bf16_t* Ag = A + (size_t)(row0 + srow) * lda + c4 * 8;
  const bf16_t* Bg = Bt + (size_t)(col0 + srow) * ldb + c4 * 8;
  const int aoff = wm * 4096 + swz_off(fr, fq);
  const int boff = 8192 + wn * 4096 + swz_off(fr, fq);
  u32x4 ra[2], rb[2];
#pragma unroll
  for (int i = 0; i < 2; ++i) { ra[i] = *(const u32x4*)(Ag + (size_t)(i * 64) * lda); rb[i] = *(const u32x4*)(Bg + (size_t)(i * 64) * ldb); }
#pragma unroll
  for (int i = 0; i < 2; ++i) { *(u32x4*)(smem + soff + i * 4096) = ra[i]; *(u32x4*)(smem + 8192 + soff + i * 4096) = rb[i]; }
  __syncthreads();
  const int nk = K >> 5;
  for (int kt = 0; kt < nk; ++kt) {
    const bool more = (kt + 1) < nk;
    if (more) {
      const int k1 = (kt + 1) * 32;
#pragma unroll
      for (int i = 0; i < 2; ++i) { ra[i] = *(const u32x4*)(Ag + (size_t)(i * 64) * lda + k1); rb[i] = *(const u32x4*)(Bg + (size_t)(i * 64) * ldb + k1); }
    }
    asm volatile("" ::: "memory");
    const char* sb = smem + (kt & 1) * G3_STAGE;
    bf16x8 bfr[4];
#pragma unroll
    for (int ni = 0; ni < 4; ++ni) bfr[ni] = *(const bf16x8*)(sb + boff + ni * 1024);
    __builtin_amdgcn_s_setprio(1);
#pragma unroll
    for (int mi = 0; mi < 4; ++mi) {
      bf16x8 af = *(const bf16x8*)(sb + aoff + mi * 1024);
#pragma unroll
      for (int ni = 0; ni < 4; ++ni) acc[mi][ni] = MFMA16(bfr[ni], af, acc[mi][ni]);
    }
    __builtin_amdgcn_s_setprio(0);
    __builtin_amdgcn_sched_barrier(0);
    if (more) {
      char* db = smem + ((kt + 1) & 1) * G3_STAGE;
#pragma unroll
      for (int i = 0; i < 2; ++i) { *(u32x4*)(db + soff + i * 4096) = ra[i]; *(u32x4*)(db + 8192 + soff + i * 4096) = rb[i]; }
    }
    __syncthreads();
  }
}

constexpr int CST_B = 272;
constexpr int CST_T = 528;
template <int MI, int NI, class F>
DI void stage_rowmajor(char* smem, f32x4 (&acc)[MI][NI], int wm, int wn, int fr, int fq, F&& tf) {
#pragma unroll
  for (int mi = 0; mi < MI; ++mi)
#pragma unroll
    for (int ni = 0; ni < NI; ++ni) {
      f32x4 v = tf(acc[mi][ni]);
      *(bf16x4*)(smem + (wm * MI * 16 + mi * 16 + fr) * CST_B + (wn * NI * 16 + ni * 16 + fq * 4) * 2) = pack4(v[0], v[1], v[2], v[3]);
      if (ni == NI - 1) __builtin_amdgcn_sched_barrier(0);
    }
}
template <int MI, int NI, class F>
DI void stage_transposed(char* smem, f32x4 (&acc)[MI][NI], int wm, int wn, int fr, int fq, F&& tf) {
#pragma unroll
  for (int mi = 0; mi < MI; ++mi)
#pragma unroll
    for (int ni = 0; ni < NI; ++ni) {
      f32x4 v = tf(acc[mi][ni]);
      char* base = smem + (wn * NI * 16 + ni * 16 + fq * 4) * CST_T + (wm * MI * 16 + mi * 16 + fr) * 2;
      *(bf16_t*)(base) = f2bf(v[0]);
      *(bf16_t*)(base + CST_T) = f2bf(v[1]);
      *(bf16_t*)(base + 2 * CST_T) = f2bf(v[2]);
      *(bf16_t*)(base + 3 * CST_T) = f2bf(v[3]);
      if (ni == NI - 1) __builtin_amdgcn_sched_barrier(0);
    }
}
template <int LINES, int CPL, int STRIDE, class D>
DI void writeout(const char* smem, int tid, D&& dst) {
#pragma unroll 4
  for (int j = 0; j < LINES * CPL / 256; ++j) {
    const int id = tid + j * 256, line = id / CPL, c = id % CPL;
    u32x4 v = *(const u32x4*)(smem + line * STRIDE + c * 16);
    *(u32x4*)dst(line, c) = v;
  }
}

DI void stage_rowmajor_rope(char* smem, f32x4 (&acc)[8][4], int wm, int wn, int fr, int fq, int rtok) {
  float inv[4];
#pragma unroll
  for (int i = 0; i < 4; ++i) inv[i] = exp2f(-(float)(fq * 4 + i) * 0.8304820237218406f);
#pragma unroll
  for (int mi = 0; mi < 8; ++mi) {
    const int t = (rtok + mi * 16 - NCTX) & 2047;
    const float gr = (float)(t >> 6), gc = (float)(t & 63);
    f32x4 o0, o1, o2, o3;
#pragma unroll
    for (int i = 0; i < 4; ++i) {
      const float sr = __sinf(gr * inv[i]), cr = __cosf(gr * inv[i]);
      const float sc = __sinf(gc * inv[i]), cc = __cosf(gc * inv[i]);
      const float a0 = acc[mi][0][i], a1 = acc[mi][1][i], a2 = acc[mi][2][i], a3 = acc[mi][3][i];
      o0[i] = a0 * cr - a1 * sr;
      o1[i] = a1 * cr + a0 * sr;
      o2[i] = a2 * cc - a3 * sc;
      o3[i] = a3 * cc + a2 * sc;
    }
    char* base = smem + (wm * 128 + mi * 16 + fr) * CST_B + (wn * 64 + fq * 4) * 2;
    *(bf16x4*)(base) = pack4(o0[0], o0[1], o0[2], o0[3]);
    *(bf16x4*)(base + 32) = pack4(o1[0], o1[1], o1[2], o1[3]);
    *(bf16x4*)(base + 64) = pack4(o2[0], o2[1], o2[2], o2[3]);
    *(bf16x4*)(base + 96) = pack4(o3[0], o3[1], o3[2], o3[3]);
    __builtin_amdgcn_sched_barrier(0);
  }
}

DI void epi_in(const P& p, int l, int row0, int col0, f32x4 (&acc)[8][4], char* smem) {
  const int tid_ = otid(), lane = tid_ & 63, wid = tid_ >> 6, wm = wid >> 1, wn = wid & 1, fr = lane & 15, fq = lane >> 4;
  const int seg = col0 >> 9;
  const bool ctx = row0 < NCTX;
  if (seg >= 12) {
    bf16_t* GF = (bf16_t*)(p.ws + WS_GF);
    const int k = (seg - 12) >> 1, tn = ((col0 - 6144) & 1023) >> 7, tm = row0 >> 8;
    bf16_t* dst = GF + (((size_t)k * 64 + tm) * 8 + tn) * 32768 + tid_ * 4;
#pragma unroll
    for (int mi = 0; mi < 8; ++mi)
#pragma unroll
      for (int ni = 0; ni < 4; ++ni)
        *(bf16x4*)(dst + (mi * 4 + ni) * 1024) = pack4(sigmoidf_(acc[mi][ni][0]), sigmoidf_(acc[mi][ni][1]), sigmoidf_(acc[mi][ni][2]), sigmoidf_(acc[mi][ni][3]));
    return;
  }
  const int ctile = col0 & 511;
  const int cseg0 = ctile + wn * 64;
  const int rtok = row0 + wm * 128 + fr;
  if (ctx && (seg == 1 || seg == 2 || seg == 4 || seg == 5)) {
    float* out = p.out;
#pragma unroll
    for (int mi = 0; mi < 8; ++mi) {
      const int r = rtok + mi * 16, b = r >> 8, t = r & 255;
      size_t off;
      if (seg == 1 || seg == 2) {
        const int h = cseg0 >> 6;
        off = (seg == 1 ? O_NAK : O_NAV) + (((size_t)(b * 4 + l) * 8 + h) * 256 + t) * 64;
      } else if (seg == 4) {
        const int comp = cseg0 >> 8, h = (cseg0 >> 6) & 3;
        off = O_DFK + ((((size_t)(b * 4 + l) * 2 + comp) * 4 + h) * 256 + t) * 64;
      } else {
        const int h = cseg0 >> 7;
        off = O_DFV + (((size_t)(b * 4 + l) * 4 + h) * 256 + t) * 128 + (cseg0 & 127);
      }
#pragma unroll
      for (int ni = 0; ni < 4; ++ni) *(f32x4*)(out + off + ni * 16 + fq * 4) = acc[mi][ni];
      __builtin_amdgcn_sched_barrier(0);
    }
  }
  auto tf_none = [](const f32x4& a) -> f32x4 { return a; };
  auto tf_scale = [](const f32x4& a) -> f32x4 { return f32x4{a[0] * 0.125f, a[1] * 0.125f, a[2] * 0.125f, a[3] * 0.125f}; };
  auto tf_silu = [](const f32x4& a) -> f32x4 { return f32x4{a[0] * sigmoidf_(a[0]), a[1] * sigmoidf_(a[1]), a[2] * sigmoidf_(a[2]), a[3] * sigmoidf_(a[3])}; };
  auto tf_gelu = [](const f32x4& a) -> f32x4 { return f32x4{gelu_tanh(a[0]), gelu_tanh(a[1]), gelu_tanh(a[2]), gelu_tanh(a[3])}; };
  const bool rowmajor = !(seg == 2 || seg == 5 || seg == 8 || seg == 11);
  if (rowmajor) {
    int zc;
    switch (seg) {
      case 0: zc = ZC_NAQ; break;
      case 1: zc = ZC_NAK; break;
      case 3: zc = ZC_DFQ; break;
      case 4: zc = ZC_DFK; break;
      case 6: zc = ZC_RTQ; break;
      case 7: zc = ZC_RTK; break;
      case 9: zc = ZC_RTG; break;
      default: zc = ZC_LRX; break;
    }
    if (!ctx && (seg == 3 || seg == 4)) stage_rowmajor_rope(smem, acc, wm, wn, fr, fq, rtok);
    else if (seg == 7) stage_rowmajor<8, 4>(smem, acc, wm, wn, fr, fq, tf_scale);
    else if (seg == 9) stage_rowmajor<8, 4>(smem, acc, wm, wn, fr, fq, tf_silu);
    else stage_rowmajor<8, 4>(smem, acc, wm, wn, fr, fq, tf_none);
    __syncthreads();
    bf16_t* zb = (bf16_t*)(p.ws + WS_Z) + (size_t)row0 * ZLD + zc + ctile;
    writeout<256, 16, CST_B>(smem, tid_, [&](int line, int c) { return zb + (size_t)line * ZLD + c * 8; });
    __syncthreads();
  }
  if (!rowmajor || (seg == 7 && ctx)) {
    if (seg == 7) stage_transposed<8, 4>(smem, acc, wm, wn, fr, fq, tf_scale);
    else if (seg == 11) stage_transposed<8, 4>(smem, acc, wm, wn, fr, fq, tf_gelu);
    else stage_transposed<8, 4>(smem, acc, wm, wn, fr, fq, tf_none);
    __syncthreads();
    if (seg == 11) {
      bf16_t* lg = (bf16_t*)(p.ws + WS_LG) + ((size_t)(row0 >> 6) * 512 + ctile) * 64;
      writeout<128, 32, CST_T>(smem, tid_, [&](int line, int c) { return lg + ((size_t)(c >> 3) * 512 + line) * 64 + (c & 7) * 8; });
    } else {
      bf16_t* tb = (bf16_t*)(p.ws + (seg == 2 ? WS_VTNA : seg == 5 ? WS_VTDF : seg == 8 ? WS_VTRT : WS_KTRT));
      int T;
      if (ctx) { T = 256; tb += ((size_t)((row0 >> 8) * 512 + ctile)) * 256 + (row0 & 255); }
      else { const int rr = row0 - NCTX; T = 2048; tb += (size_t)VT_LAT + ((size_t)((rr >> 11) * 512 + ctile)) * 2048 + (rr & 2047); }
      writeout<128, 32, CST_T>(smem, tid_, [&](int line, int c) { return tb + (size_t)line * T + c * 8; });
    }
    __syncthreads();
  }
}

DI void phase_gin(const P& p, int l, char* smem) {
  const bf16_t* A = (const bf16_t*)(p.ws + WS_H);
  const bf16_t* Bt = (const bf16_t*)(p.ws + WS_WIN);
  for (int it = 0;; ++it) {
    int tm, tn;
    if (!tile_sched(it, 64, 80, tm, tn)) break;
    f32x4 acc[8][4];
    zero_acc2(acc);
    gemm2_mainloop(A, 1024, Bt, 1024, 1024, tm * 256, tn * 128, smem, acc);
    epi_in(p, l, tm * 256, tn * 128, acc, smem);
  }
}

DI void phase_merge(const P& p, char* smem) {
  const bf16_t* Y4 = (const bf16_t*)(p.ws + WS_Y4);
  const bf16_t* WB = (const bf16_t*)(p.ws + WS_WBR);
  const bf16_t* GF = (const bf16_t*)(p.ws + WS_GF);
  bf16_t* G = (bf16_t*)(p.ws + WS_H);
  const int tid_ = otid(), lane = tid_ & 63, wid = tid_ >> 6, wm = wid >> 1, wn = wid & 1, fr = lane & 15, fq = lane >> 4;
  for (int it = 0;; ++it) {
    int tm, tn;
    if (!tile_sched(it, 128, 8, tm, tn)) break;
    const int row0 = tm * 128, col0 = tn * 128;
    f32x4 o[4][4];
    zero_acc(o);
#pragma unroll 1
    for (int k = 0; k < 4; ++k) {
      f32x4 acc[4][4];
      zero_acc(acc);
      gemm3_mainloop(Y4 + k * 512, 2048, WB + k * 512, 2048, 512, row0, col0, smem, acc);
      const bf16_t* gsrc = GF + (((size_t)k * 64 + (tm >> 1)) * 8 + tn) * 32768 + (((tm & 1) * 2 + wn) * 64 + lane) * 4 + (wm * 16) * 1024;
#pragma unroll
      for (int mi = 0; mi < 4; ++mi) {
        bf16x4 gq[4];
#pragma unroll
        for (int ni = 0; ni < 4; ++ni) gq[ni] = *(const bf16x4*)(gsrc + (mi * 4 + ni) * 1024);
#pragma unroll
        for (int ni = 0; ni < 4; ++ni)
#pragma unroll
          for (int i = 0; i < 4; ++i) o[mi][ni][i] += bfs2f(gq[ni][i]) * acc[mi][ni][i];
      }
    }
    stage_rowmajor<4, 4>(smem, o, wm, wn, fr, fq, [](const f32x4& a) { return a; });
    __syncthreads();
    bf16_t* gb = G + (size_t)row0 * 1024 + col0;
    writeout<128, 16, CST_B>(smem, tid_, [&](int line, int c) { return gb + (size_t)line * 1024 + c * 8; });
    __syncthreads();
  }
}

template <int MODE>
DI void phase_gemm_plain(const bf16_t* A, int K, const bf16_t* Bt, int N, bf16_t* outp, char* smem) {
  const int tid_ = otid(), lane = tid_ & 63, wid = tid_ >> 6, wm = wid >> 1, wn = wid & 1, fr = lane & 15, fq = lane >> 4;
  const int ntn = N / 128;
  for (int it = 0;; ++it) {
    int tm, tn;
    if (!tile_sched(it, 64, ntn, tm, tn)) break;
    const int row0 = tm * 256, col0 = tn * 128;
    f32x4 acc[8][4];
    zero_acc2(acc);
    gemm2_mainloop(A, K, Bt, K, K, row0, col0, smem, acc);
    stage_rowmajor<8, 4>(smem, acc, wm, wn, fr, fq, [](const f32x4& a) {
      f32x4 v = a;
      if (MODE == 1) {
        v[0] = fmaxf(v[0], 0.f); v[1] = fmaxf(v[1], 0.f); v[2] = fmaxf(v[2], 0.f); v[3] = fmaxf(v[3], 0.f);
        v[0] *= v[0]; v[1] *= v[1]; v[2] *= v[2]; v[3] *= v[3];
      }
      return v;
    });
    __syncthreads();
    bf16_t* ob = outp + (size_t)row0 * N + col0;
    writeout<256, 16, CST_B>(smem, tid_, [&](int line, int c) { return ob + (size_t)line * N + c * 8; });
    __syncthreads();
  }
}

DI void phase_mod(const P& p, char* smem) {
  float* ssil = (float*)smem;
  float* red = ssil + 5 * 1024;
  const int tid = otid();
  float* MOD = (float*)(p.ws + WS_MOD);
  for (int idx = tid; idx < 5120; idx += 256) {
    int j = idx >> 10, k = idx & 1023;
    float cv = (j == 0) ? p.in[11][k] : p.in[10][(j - 1) * 1024 + k];
    ssil[idx] = cv / (1.f + expf(-cv));
  }
  __syncthreads();
  const int cl = tid & 63, kg = tid >> 6;
  for (int item = blockIdx.x; item < 384; item += gridDim.x) {
    int l = item / 96, cgp = item % 96;
    int col = cgp * 64 + cl;
    const float* W = p.in[12] + (size_t)l * 1024 * 6144 + col;
    float a0 = 0, a1 = 0, a2 = 0, a3 = 0, a4 = 0;
    for (int k = kg * 256; k < kg * 256 + 256; ++k) {
      float w = W[(size_t)k * 6144];
      a0 += ssil[k] * w;
      a1 += ssil[1024 + k] * w;
      a2 += ssil[2048 + k] * w;
      a3 += ssil[3072 + k] * w;
      a4 += ssil[4096 + k] * w;
    }
    red[(kg * 5 + 0) * 64 + cl] = a0;
    red[(kg * 5 + 1) * 64 + cl] = a1;
    red[(kg * 5 + 2) * 64 + cl] = a2;
    red[(kg * 5 + 3) * 64 + cl] = a3;
    red[(kg * 5 + 4) * 64 + cl] = a4;
    __syncthreads();
    if (kg == 0) {
      float bias = p.in[13][l * 6144 + col];
#pragma unroll
      for (int j = 0; j < 5; ++j) {
        float s = red[(0 * 5 + j) * 64 + cl] + red[(1 * 5 + j) * 64 + cl] + red[(2 * 5 + j) * 64 + cl] + red[(3 * 5 + j) * 64 + cl];
        MOD[(size_t)(l * 5 + j) * 6144 + col] = s + bias;
      }
    }
    __syncthreads();
  }
}

DI void transpose_tile(const float* __restrict__ src, int lds_, bf16_t* __restrict__ dst, int ldd, float* tile) {
  const int tid = otid();
#pragma unroll 4
  for (int i = 0; i < 16; ++i) {
    int idx = tid + i * 256, r = idx >> 6, c = idx & 63;
    tile[r * 65 + c] = src[(size_t)r * lds_ + c];
  }
  __syncthreads();
#pragma unroll 4
  for (int i = 0; i < 16; ++i) {
    int idx = tid + i * 256, c = idx >> 6, r = idx & 63;
    dst[(size_t)c * ldd + r] = f2bf(tile[r * 65 + c]);
  }
  __syncthreads();
}

DI void phase_convert(const P& p, int l, char* smem) {
  float* tile = (float*)smem;
  char* ws = p.ws;
  const int NJ = 6432;
  for (int j = blockIdx.x; j < NJ; j += gridDim.x) {
    int q = j;
    if (q < 2560) {
      int tr = q / 160, tc = q % 160;
      transpose_tile(p.in[18] + (size_t)l * 1024 * 10240 + (size_t)tr * 64 * 10240 + tc * 64, 10240,
                     (bf16_t*)(ws + WS_WIN) + (size_t)tc * 64 * 1024 + tr * 64, 1024, tile);
      continue;
    }
    q -= 2560;
    if (q < 512) {
      int tr = q / 16, tc = q % 16;
      transpose_tile(p.in[40] + (size_t)l * 2048 * 1024 + (size_t)tr * 64 * 1024 + tc * 64, 1024,
                     (bf16_t*)(ws + WS_WBR) + (size_t)tc * 64 * 2048 + tr * 64, 2048, tile);
      continue;
    }
    q -= 512;
    if (q < 256) {
      int tr = q / 16, tc = q % 16;
      transpose_tile(p.in[41] + (size_t)l * 1024 * 1024 + (size_t)tr * 64 * 1024 + tc * 64, 1024,
                     (bf16_t*)(ws + WS_WOUT) + (size_t)tc * 64 * 1024 + tr * 64, 1024, tile);
      continue;
    }
    q -= 256;
    if (q < 1024) {
      int tr = q / 64, tc = q % 64;
      transpose_tile(p.in[42] + (size_t)l * 1024 * 4096 + (size_t)tr * 64 * 4096 + tc * 64, 4096,
                     (bf16_t*)(ws + WS_W1) + (size_t)tc * 64 * 1024 + tr * 64, 1024, tile);
      continue;
    }
    q -= 1024;
    if (q < 1024) {
      int tr = q / 16, tc = q % 16;
      transpose_tile(p.in[43] + (size_t)l * 4096 * 1024 + (size_t)tr * 64 * 1024 + tc * 64, 1024,
                     (bf16_t*)(ws + WS_W2) + (size_t)tc * 64 * 4096 + tr * 64, 4096, tile);
      continue;
    }
    q -= 1024;
    if (q < 32) {
      int type = q >> 3, n = q & 7;
      const float* src = (type == 0 ? p.in[30] : type == 1 ? p.in[32] : type == 2 ? p.in[35] : p.in[37]) + (size_t)(l * 8 + n) * 4096;
      transpose_tile(src, 64, (bf16_t*)(ws + WS_WLRU) + (size_t)(type * 8 + n) * 4096, 64, tile);
      continue;
    }
    q -= 32;
    if (q < 256) {
      int bh = q >> 3, tr = q & 7, b = bh >> 3, h = bh & 7;
      transpose_tile(p.in[3] + ((size_t)((b * 4 + l) * 8 + h)) * 32768 + (size_t)tr * 64 * 64, 64,
                     (bf16_t*)(ws + WS_CVNA) + (size_t)bh * 32768 + tr * 64, 512, tile);
      continue;
    }
    q -= 256;
    if (q < 256) {
      int bh = q >> 4, t2 = q & 15, tr = t2 >> 1, tc = t2 & 1, b = bh >> 2, h = bh & 3;
      transpose_tile(p.in[5] + ((size_t)((b * 4 + l) * 4 + h)) * 65536 + (size_t)tr * 64 * 128 + tc * 64, 128,
                     (bf16_t*)(ws + WS_CVDF) + (size_t)bh * 65536 + (size_t)tc * 64 * 512 + tr * 64, 512, tile);
      continue;
    }
    q -= 256;
    {
      int tensor = q >> 8, b = (q >> 6) & 3, chunk = q & 63;
      const float* src = (tensor == 0 ? p.in[2] : p.in[4]) + (size_t)(b * 4 + l) * 262144 + (size_t)chunk * 4096;
      bf16_t* dst = (bf16_t*)(ws + (tensor == 0 ? WS_CKNA : WS_CKDF)) + (size_t)b * 262144 + (size_t)chunk * 4096;
#pragma unroll
      for (int i = 0; i < 4; ++i) {
        int e = (otid() + i * 256) * 4;
        float4 v = *(const float4*)(src + e);
        *(bf16x4*)(dst + e) = pack4(v.x, v.y, v.z, v.w);
      }
    }
  }
}

DI void phase_row(const P& p, int l, int mode) {
  const int tid_ = otid(), lane = tid_ & 63, wid = tid_ >> 6;
  const float* MOD = (const float*)(p.ws + WS_MOD);
  float* X = p.out;
  bf16_t* H = (bf16_t*)(p.ws + WS_H);
  const bf16_t* Y = (const bf16_t*)(p.ws + WS_Y);
  const bool from_inputs = (mode == 0 || (mode == 1 && l == 0));
  auto xsrc = [&](int r) -> const float* {
    return from_inputs ? ((r < NCTX) ? (p.in[0] + (size_t)r * D) : (p.in[1] + (size_t)(r - NCTX) * D)) : (X + (size_t)r * D);
  };
  int rb = blockIdx.x;
  if (rb >= 4096) return;
  float4 xn[4];
  bf16x4 yn[4];
  {
    const int r = rb * 4 + wid;
    const float* xs = xsrc(r);
#pragma unroll
    for (int j = 0; j < 4; ++j) xn[j] = *(const float4*)(xs + j * 256 + lane * 4);
    if (mode != 0) {
#pragma unroll
      for (int j = 0; j < 4; ++j) yn[j] = *(const bf16x4*)(Y + (size_t)r * D + j * 256 + lane * 4);
    }
  }
  for (; rb < 4096; rb += gridDim.x) {
    const int r = rb * 4 + wid;
    const int mi = r < NCTX ? 0 : 1 + ((r - NCTX) >> 11);
    float4 xv[4], yv[4];
#pragma unroll
    for (int j = 0; j < 4; ++j) { xv[j] = xn[j]; yv[j] = make_float4(bfs2f(yn[j][0]), bfs2f(yn[j][1]), bfs2f(yn[j][2]), bfs2f(yn[j][3])); }
    {
      const int rbn = (rb + (int)gridDim.x < 4096) ? rb + (int)gridDim.x : rb;
      const int rn = rbn * 4 + wid;
      const float* xs = xsrc(rn);
#pragma unroll
      for (int j = 0; j < 4; ++j) xn[j] = *(const float4*)(xs + j * 256 + lane * 4);
      if (mode != 0) {
#pragma unroll
        for (int j = 0; j < 4; ++j) yn[j] = *(const bf16x4*)(Y + (size_t)rn * D + j * 256 + lane * 4);
      }
    }
    if (mode != 0) {
      float ss = 0.f;
#pragma unroll
      for (int j = 0; j < 4; ++j) ss += yv[j].x * yv[j].x + yv[j].y * yv[j].y + yv[j].z * yv[j].z + yv[j].w * yv[j].w;
      ss = wave_sum(ss);
      const float rs = rsqrtf(ss * (1.f / 1024.f) + 1e-6f);
      const float* gpost = (mode == 1 ? p.in[15] : p.in[17]) + l * D;
      const float* gate = MOD + (size_t)(l * 5 + mi) * 6144 + (mode == 1 ? 2048 : 5120);
#pragma unroll
      for (int j = 0; j < 4; ++j) {
        float4 g = *(const float4*)(gpost + j * 256 + lane * 4);
        float4 gt = *(const float4*)(gate + j * 256 + lane * 4);
        xv[j].x += gt.x * (yv[j].x * rs * g.x);
        xv[j].y += gt.y * (yv[j].y * rs * g.y);
        xv[j].z += gt.z * (yv[j].z * rs * g.z);
        xv[j].w += gt.w * (yv[j].w * rs * g.w);
        *(float4*)(X + (size_t)r * D + j * 256 + lane * 4) = xv[j];
      }
    }
    int ln, off_sh, off_sc;
    const float* gpre;
    if (mode == 0) { ln = 0; gpre = p.in[14]; off_sh = 0; off_sc = 1024; }
    else if (mode == 1) { ln = l; gpre = p.in[16] + l * D; off_sh = 3072; off_sc = 4096; }
    else { ln = l + 1; gpre = p.in[14] + (l + 1) * D; off_sh = 0; off_sc = 1024; }
    if (ln < 4) {
      float ss = 0.f;
#pragma unroll
      for (int j = 0; j < 4; ++j) ss += xv[j].x * xv[j].x + xv[j].y * xv[j].y + xv[j].z * xv[j].z + xv[j].w * xv[j].w;
      ss = wave_sum(ss);
      const float rs = rsqrtf(ss * (1.f / 1024.f) + 1e-6f);
      const float* mrow = MOD + (size_t)(ln * 5 + mi) * 6144;
#pragma unroll
      for (int j = 0; j < 4; ++j) {
        int c = j * 256 + lane * 4;
        float4 g = *(const float4*)(gpre + c);
        float4 sc = *(const float4*)(mrow + off_sc + c);
        float4 sh = *(const float4*)(mrow + off_sh + c);
        *(bf16x4*)(H + (size_t)r * D + c) = pack4(xv[j].x * rs * g.x * (1.f + sc.x) + sh.x, xv[j].y * rs * g.y * (1.f + sc.y) + sh.y,
                                                  xv[j].z * rs * g.z * (1.f + sc.z) + sh.z, xv[j].w * rs * g.w * (1.f + sc.w) + sh.w);
      }
    }
  }
}

constexpr int ATT_BUF = 192 * LDT;
DI void qk_scores(const bf16x8 (&qf)[2], const bf16_t* sK, f32x4 (&S)[4], int fr, int fq) {
  __builtin_amdgcn_s_setprio(1);
#pragma unroll
  for (int s = 0; s < 4; ++s) {
    f32x4 z = {0.f, 0.f, 0.f, 0.f};
#pragma unroll
    for (int ks = 0; ks < 2; ++ks) {
      bf16x8 a = *(const bf16x8*)(sK + (16 * s + fr) * LDT + ks * 32 + fq * 8);
      z = MFMA16(a, qf[ks], z);
    }
    S[s] = z;
  }
  __builtin_amdgcn_s_setprio(0);
}
template <int DV>
DI void pv_step(const bf16x8 (&pb)[2], const bf16_t* sV, f32x4 (&O)[DV / 16], int fr, int fq) {
  __builtin_amdgcn_s_setprio(1);
#pragma unroll
  for (int dt = 0; dt < DV / 16; ++dt) {
#pragma unroll
    for (int s2 = 0; s2 < 2; ++s2) {
      const bf16_t* base = sV + (dt * 16 + fr) * LDT + 32 * s2 + 4 * fq;
      bf16x4 lo = *(const bf16x4*)base;
      bf16x4 hi = *(const bf16x4*)(base + 16);
      bf16x8 a = __builtin_shufflevector(lo, hi, 0, 1, 2, 3, 4, 5, 6, 7);
      O[dt] = MFMA16(a, pb[s2], O[dt]);
    }
  }
  __builtin_amdgcn_s_setprio(0);
}
template <int DV>
DI void softmax_pv(f32x4 (&S)[4], const bf16_t* sV, f32x4 (&O)[DV / 16], float& m, float& lsum, int fr, int fq) {
  float tm = -1e30f;
#pragma unroll
  for (int s = 0; s < 4; ++s)
#pragma unroll
    for (int i = 0; i < 4; ++i) tm = fmaxf(tm, S[s][i]);
  tm = xmax32(xmax16(tm));
  const float mn = fmaxf(m, tm);
  const float alpha = __builtin_amdgcn_exp2f(m - mn);
  const bool grew = mn != m;
  m = mn;
  float ps = 0.f;
#pragma unroll
  for (int s = 0; s < 4; ++s)
#pragma unroll
    for (int i = 0; i < 4; ++i) {
      float pv = __builtin_amdgcn_exp2f(S[s][i] - mn);
      S[s][i] = pv;
      ps += pv;
    }
  lsum = lsum * alpha + ps;
  if (__any(grew)) {
#pragma unroll
    for (int dt = 0; dt < DV / 16; ++dt) {
      O[dt][0] *= alpha; O[dt][1] *= alpha; O[dt][2] *= alpha; O[dt][3] *= alpha;
    }
  }
  bf16x8 pb[2];
  pb[0] = pack8(S[0], S[1]);
  pb[1] = pack8(S[2], S[3]);
  pv_step<DV>(pb, sV, O, fr, fq);
}
template <int DV, bool SOFTMAX, int TPS, class TileFn, class ScoreFn>
DI void attn_loop(int ntiles, TileFn&& tile, ScoreFn&& score, const bf16x8 (&qf)[2], f32x4 (&O)[DV / 16], float& m, float& lsum,
                  bf16_t* smem, int tid) {
  const int lane = tid & 63, fr = lane & 15, fq = lane >> 4;
  constexpr int TILE_EL = (64 + DV) * LDT, STAGE_EL = TPS * TILE_EL;
  u32x4 rkA[TPS][2], rvA[TPS][DV / 32], rkB[TPS][2], rvB[TPS][DV / 32];
  const int sr = tid >> 3, sc = (tid & 7) * 8;
  auto gload = [&](int step, u32x4 (&rk)[TPS][2], u32x4 (&rv)[TPS][DV / 32]) __attribute__((always_inline)) {
#pragma unroll
    for (int u = 0; u < TPS; ++u) {
      const bf16_t* Kg; const bf16_t* Vg; int ldk, ldv;
      tile(step * TPS + u, Kg, ldk, Vg, ldv);
#pragma unroll
      for (int i = 0; i < 2; ++i) rk[u][i] = *(const u32x4*)(Kg + (size_t)(sr + i * 32) * ldk + sc);
#pragma unroll
      for (int i = 0; i < DV / 32; ++i) rv[u][i] = *(const u32x4*)(Vg + (size_t)(sr + i * 32) * ldv + sc);
    }
  };
  auto sstore = [&](int buf, const u32x4 (&rk)[TPS][2], const u32x4 (&rv)[TPS][DV / 32]) __attribute__((always_inline)) {
#pragma unroll
    for (int u = 0; u < TPS; ++u) {
      bf16_t* sK = smem + buf * STAGE_EL + u * TILE_EL;
      bf16_t* sV = sK + 64 * LDT;
#pragma unroll
      for (int i = 0; i < 2; ++i) *(u32x4*)(sK + (sr + i * 32) * LDT + sc) = rk[u][i];
#pragma unroll
      for (int i = 0; i < DV / 32; ++i) *(u32x4*)(sV + (sr + i * 32) * LDT + sc) = rv[u][i];
    }
  };
  auto compute = [&](int buf, int step) __attribute__((always_inline)) {
#pragma unroll
    for (int u = 0; u < TPS; ++u) {
      const bf16_t* sK = smem + buf * STAGE_EL + u * TILE_EL;
      const bf16_t* sV = sK + 64 * LDT;
      f32x4 S[4];
      qk_scores(qf, sK, S, fr, fq);
      score(step * TPS + u, S);
      if (SOFTMAX) {
        softmax_pv<DV>(S, sV, O, m, lsum, fr, fq);
      } else {
        bf16x8 pb[2];
        pb[0] = pack8(S[0], S[1]);
        pb[1] = pack8(S[2], S[3]);
        pv_step<DV>(pb, sV, O, fr, fq);
      }
    }
  };
  const int nsteps = ntiles / TPS, last = nsteps - 1;
  if (TPS > 1) {
    gload(0, rkA, rvA);
    sstore(0, rkA, rvA);
    __syncthreads();
    for (int j = 0; j < nsteps; ++j) {
      gload(j + 1 < last ? j + 1 : last, rkA, rvA);
      asm volatile("" ::: "memory");
      compute(j & 1, j);
      __builtin_amdgcn_sched_barrier(0);
      sstore((j + 1) & 1, rkA, rvA);
      __syncthreads();
    }
    return;
  }
  gload(0, rkA, rvA);
  gload(last < 1 ? last : 1, rkB, rvB);
  sstore(0, rkA, rvA);
  __syncthreads();
  for (int j = 0; j < nsteps; j += 2) {
    gload(j + 2 < last ? j + 2 : last, rkA, rvA);
    asm volatile("" ::: "memory");
    compute(0, j);
    __builtin_amdgcn_sched_barrier(0);
    sstore(1, rkB, rvB);
    __syncthreads();
    if (j + 1 >= nsteps) break;
    gload(j + 3 < last ? j + 3 : last, rkB, rvB);
    asm volatile("" ::: "memory");
    compute(1, j + 1);
    __builtin_amdgcn_sched_barrier(0);
    sstore(0, rkA, rvA);
    __syncthreads();
  }
}
DI void scale_scores(f32x4 (&S)[4]) {
#pragma unroll
  for (int s = 0; s < 4; ++s) { S[s][0] *= 0.18033688f; S[s][1] *= 0.18033688f; S[s][2] *= 0.18033688f; S[s][3] *= 0.18033688f; }
}

DI void dense_item(const P& p, int b, int h, int qb, char* smem) {
  const int tid = otid(), lane = tid & 63, wid = tid >> 6, fr = lane & 15, fq = lane >> 4;
  const bf16_t* Z = (const bf16_t*)(p.ws + WS_Z);
  const bf16_t* VT = (const bf16_t*)(p.ws + WS_VTNA) + (size_t)(b * 512 + h * 64) * 256;
  bf16_t* Y4 = (bf16_t*)(p.ws + WS_Y4);
  const int rowbase = b * 256;
  const int qrow = rowbase + qb * 64 + wid * 16 + fr;
  bf16x8 qf[2];
#pragma unroll
  for (int ks = 0; ks < 2; ++ks) qf[ks] = *(const bf16x8*)(Z + (size_t)qrow * ZLD + ZC_NAQ + h * 64 + ks * 32 + fq * 8);
  f32x4 O[4];
#pragma unroll
  for (int dt = 0; dt < 4; ++dt) O[dt] = f32x4{0.f, 0.f, 0.f, 0.f};
  float m = -1e30f, lsum = 0.f;
  const bf16_t* Kb = Z + (size_t)rowbase * ZLD + ZC_NAK + h * 64;
  attn_loop<64, true, 2>(4,
      [&](int j, const bf16_t*& Kg, int& ldk, const bf16_t*& Vg, int& ldv) __attribute__((always_inline)) { Kg = Kb + (size_t)j * 64 * ZLD; ldk = ZLD; Vg = VT + j * 64; ldv = 256; },
      [&](int, f32x4 (&S)[4]) __attribute__((always_inline)) { scale_scores(S); }, qf, O, m, lsum, (bf16_t*)smem, tid);
  const float lt = xsum32(xsum16(lsum));
  const float inv = 1.f / lt;
#pragma unroll
  for (int dt = 0; dt < 4; ++dt)
    *(bf16x4*)(Y4 + (size_t)qrow * 2048 + h * 64 + dt * 16 + fq * 4) = pack4(O[dt][0] * inv, O[dt][1] * inv, O[dt][2] * inv, O[dt][3] * inv);
}

DI void na_item(const P& p, int l, int b, int h, int r, char* smem) {
  float* srpb = (float*)(smem + 73728);
  const int tid = otid(), lane = tid & 63, wid = tid >> 6, fr = lane & 15, fq = lane >> 4;
  const bf16_t* Z = (const bf16_t*)(p.ws + WS_Z);
  const bf16_t* VT = (const bf16_t*)(p.ws + WS_VTNA) + VT_LAT + (size_t)(b * 512 + h * 64) * 2048;
  const bf16_t* CK = (const bf16_t*)(p.ws + WS_CKNA) + (size_t)(b * 8 + h) * 32768;
  const bf16_t* CVT = (const bf16_t*)(p.ws + WS_CVNA) + (size_t)(b * 8 + h) * 32768;
  bf16_t* Y4 = (bf16_t*)(p.ws + WS_Y4);
  for (int i = tid; i < 465; i += 256) srpb[i] = p.in[19][(size_t)(l * 8 + h) * 465 + i];
  const int rowbase = NCTX + b * 2048;
  const int qcol = wid * 16 + fr;
  const int qrow = rowbase + r * 64 + qcol;
  bf16x8 qf[2];
#pragma unroll
  for (int ks = 0; ks < 2; ++ks) qf[ks] = *(const bf16x8*)(Z + (size_t)qrow * ZLD + ZC_NAQ + h * 64 + ks * 32 + fq * 8);
  f32x4 O[4];
#pragma unroll
  for (int dt = 0; dt < 4; ++dt) O[dt] = f32x4{0.f, 0.f, 0.f, 0.f};
  float m = -1e30f, lsum = 0.f;
  int rs = r - 4;
  rs = rs < 0 ? 0 : (rs > 24 ? 24 : rs);
  int cstart = qcol - 8;
  cstart = cstart < 0 ? 0 : (cstart > 48 ? 48 : cstart);
  const bf16_t* Kb = Z + (size_t)rowbase * ZLD + ZC_NAK + h * 64;
  attn_loop<64, true, 2>(16,
      [&](int j, const bf16_t*& Kg, int& ldk, const bf16_t*& Vg, int& ldv) __attribute__((always_inline)) {
        if (j < 8) { Kg = Kb + (size_t)(rs + j) * 64 * ZLD; ldk = ZLD; Vg = VT + (rs + j) * 64; ldv = 2048; }
        else { Kg = CK + (size_t)(j - 8) * 64 * 64; ldk = 64; Vg = CVT + (j - 8) * 64; ldv = 512; }
      },
      [&](int j, f32x4 (&S)[4]) __attribute__((always_inline)) {
        if (j < 8) {
          const int dr = rs + j - r + 7;
#pragma unroll
          for (int s = 0; s < 4; ++s)
#pragma unroll
            for (int i = 0; i < 4; ++i) {
              int kcol = s * 16 + fq * 4 + i;
              bool ok = (kcol >= cstart) && (kcol < cstart + 16);
              int dc = kcol - qcol + 15;
              dc = dc < 0 ? 0 : (dc > 30 ? 30 : dc);
              float bias = srpb[dr * 31 + dc];
              S[s][i] = ok ? (S[s][i] * 0.18033688f + bias * 1.44269504f) : -1e30f;
            }
        } else {
          scale_scores(S);
        }
      },
      qf, O, m, lsum, (bf16_t*)smem, tid);
  const float lt = xsum32(xsum16(lsum));
  const float inv = 1.f / lt;
#pragma unroll
  for (int dt = 0; dt < 4; ++dt)
    *(bf16x4*)(Y4 + (size_t)qrow * 2048 + h * 64 + dt * 16 + fq * 4) = pack4(O[dt][0] * inv, O[dt][1] * inv, O[dt][2] * inv, O[dt][3] * inv);
}

DI void diff_item(const P& p, int l, bool latent, int b, int h, int qb, char* smem) {
  const int tid = otid(), lane = tid & 63, wid = tid >> 6, fr = lane & 15, fq = lane >> 4;
  const bf16_t* Z = (const bf16_t*)(p.ws + WS_Z);
  const int T = latent ? 2048 : 256;
  const int rowbase = latent ? NCTX + b * 2048 : b * 256;
  const bf16_t* VT = (const bf16_t*)(p.ws + WS_VTDF) + (latent ? (size_t)VT_LAT + (size_t)(b * 512 + h * 128) * 2048 : (size_t)(b * 512 + h * 128) * 256);
  const bf16_t* CVT = (const bf16_t*)(p.ws + WS_CVDF) + (size_t)(b * 4 + h) * 65536;
  bf16_t* Y4 = (bf16_t*)(p.ws + WS_Y4);
  const int qrow = rowbase + qb * 64 + wid * 16 + fr;
  float d1 = p.in[20][l * 64 + lane] * p.in[21][l * 64 + lane];
  float d2 = p.in[22][l * 64 + lane] * p.in[23][l * 64 + lane];
  d1 = wave_sum(d1);
  d2 = wave_sum(d2);
  const float lam_init = 0.8f - 0.6f * expf(-0.3f * (float)l);
  const float lam = expf(d1) - expf(d2) + lam_init;
  const int nown = T >> 6;
  const int ntiles = nown + (latent ? 8 : 0);

  f32x4 O1[8];
  f32x4 O[8];
#pragma unroll 1
  for (int comp = 0; comp < 2; ++comp) {
    bf16x8 qf[2];
#pragma unroll
    for (int ks = 0; ks < 2; ++ks) qf[ks] = *(const bf16x8*)(Z + (size_t)qrow * ZLD + ZC_DFQ + comp * 256 + h * 64 + ks * 32 + fq * 8);
#pragma unroll
    for (int dt = 0; dt < 8; ++dt) O[dt] = f32x4{0.f, 0.f, 0.f, 0.f};
    float m = -1e30f, lsum = 0.f;
    const bf16_t* Kb = Z + (size_t)rowbase * ZLD + ZC_DFK + comp * 256 + h * 64;
    const bf16_t* CK = (const bf16_t*)(p.ws + WS_CKDF) + (size_t)((b * 2 + comp) * 4 + h) * 32768;
    attn_loop<128, true, 1>(ntiles,
        [&](int j, const bf16_t*& Kg, int& ldk, const bf16_t*& Vg, int& ldv) __attribute__((always_inline)) {
          if (j < nown) { Kg = Kb + (size_t)j * 64 * ZLD; ldk = ZLD; Vg = VT + j * 64; ldv = T; }
          else { Kg = CK + (size_t)(j - nown) * 64 * 64; ldk = 64; Vg = CVT + (j - nown) * 64; ldv = 512; }
        },
        [&](int, f32x4 (&S)[4]) __attribute__((always_inline)) { scale_scores(S); }, qf, O, m, lsum, (bf16_t*)smem, tid);
    const float lt = xsum32(xsum16(lsum));
    const float inv = 1.f / lt;
    if (comp == 0) {
#pragma unroll
      for (int dt = 0; dt < 8; ++dt) { O1[dt][0] = O[dt][0] * inv; O1[dt][1] = O[dt][1] * inv; O1[dt][2] = O[dt][2] * inv; O1[dt][3] = O[dt][3] * inv; }
    } else {
#pragma unroll
      for (int dt = 0; dt < 8; ++dt) {
        O[dt][0] = O1[dt][0] - lam * (O[dt][0] * inv);
        O[dt][1] = O1[dt][1] - lam * (O[dt][1] * inv);
        O[dt][2] = O1[dt][2] - lam * (O[dt][2] * inv);
        O[dt][3] = O1[dt][3] - lam * (O[dt][3] * inv);
      }
    }
  }
  float ss = 0.f;
#pragma unroll
  for (int dt = 0; dt < 8; ++dt) ss += O[dt][0] * O[dt][0] + O[dt][1] * O[dt][1] + O[dt][2] * O[dt][2] + O[dt][3] * O[dt][3];
  ss = xsum32(xsum16(ss));
  const float rsn = rsqrtf(ss * (1.f / 128.f) + 1e-6f) * (1.f - lam_init);
  const float* gn = p.in[24] + l * 128;
#pragma unroll
  for (int dt = 0; dt < 8; ++dt) {
    int dv = dt * 16 + fq * 4;
    float4 g = *(const float4*)(gn + dv);
    *(bf16x4*)(Y4 + (size_t)qrow * 2048 + 512 + h * 128 + dv) = pack4(O[dt][0] * rsn * g.x, O[dt][1] * rsn * g.y, O[dt][2] * rsn * g.z, O[dt][3] * rsn * g.w);
  }
}

DI void ret_item(const P& p, int l, bool latent, int b, int h, int qb, char* smem) {
  bf16_t* sV0 = (bf16_t*)smem + 64 * LDT;
  const int tid = otid(), lane = tid & 63, wid = tid >> 6, fr = lane & 15, fq = lane >> 4;
  const bf16_t* Z = (const bf16_t*)(p.ws + WS_Z);
  const int T = latent ? 2048 : 256;
  const int rowbase = latent ? NCTX + b * 2048 : b * 256;
  const bf16_t* VT = (const bf16_t*)(p.ws + WS_VTRT) + (latent ? (size_t)VT_LAT + (size_t)(b * 512 + h * 64) * 2048 : (size_t)(b * 512 + h * 64) * 256);
  bf16_t* Y4 = (bf16_t*)(p.ws + WS_Y4);
  const int tq = qb * 64 + wid * 16 + fr;
  const int qrow = rowbase + tq;
  const float lgf = log1pf(-expf(p.in[25][l * 8 + h]));
  const float lgb = log1pf(-expf(p.in[26][l * 8 + h]));
  bf16x8 qf[2];
#pragma unroll
  for (int ks = 0; ks < 2; ++ks) qf[ks] = *(const bf16x8*)(Z + (size_t)qrow * ZLD + ZC_RTQ + h * 64 + ks * 32 + fq * 8);
  f32x4 O[4];
#pragma unroll
  for (int dt = 0; dt < 4; ++dt) O[dt] = f32x4{0.f, 0.f, 0.f, 0.f};
  float mdummy = 0.f, ldummy = 0.f;
  const int dq = wid * 16 + fr;
  float AF[4], BF[4], AB[4], BB[4];
#pragma unroll
  for (int u = 0; u < 4; ++u) {
    AF[u] = __expf(-lgf * (float)(u * 16));
    AB[u] = __expf(lgb * (float)(u * 16));
    BF[u] = __expf(-lgf * (float)(fq * 4 + u));
    BB[u] = __expf(lgb * (float)(fq * 4 + u));
  }
  const bf16_t* Kb = Z + (size_t)rowbase * ZLD + ZC_RTK + h * 64;
  attn_loop<64, false, 2>(T >> 6,
      [&](int j, const bf16_t*& Kg, int& ldk, const bf16_t*& Vg, int& ldv) __attribute__((always_inline)) { Kg = Kb + (size_t)j * 64 * ZLD; ldk = ZLD; Vg = VT + j * 64; ldv = T; },
      [&](int j, f32x4 (&S)[4]) __attribute__((always_inline)) {
        if (j == qb) {
#pragma unroll
          for (int s = 0; s < 4; ++s)
#pragma unroll
            for (int i = 0; i < 4; ++i) {
              int tk = j * 64 + s * 16 + fq * 4 + i;
              int dd = tq - tk;
              float w = dd >= 0 ? __expf(lgf * (float)dd) : __expf(lgb * (float)(-dd));
              S[s][i] *= w;
            }
        } else if (j < qb) {
          const float qfac = __expf(lgf * (float)((qb - j) * 64 + dq));
#pragma unroll
          for (int s = 0; s < 4; ++s) {
            const float f = qfac * AF[s];
            S[s][0] *= f * BF[0]; S[s][1] *= f * BF[1]; S[s][2] *= f * BF[2]; S[s][3] *= f * BF[3];
          }
        } else {
          const float qfac = __expf(lgb * (float)((j - qb) * 64 - dq));
#pragma unroll
          for (int s = 0; s < 4; ++s) {
            const float f = qfac * AB[s];
            S[s][0] *= f * BB[0]; S[s][1] *= f * BB[1]; S[s][2] *= f * BB[2]; S[s][3] *= f * BB[3];
          }
        }
      },
      qf, O, mdummy, ldummy, (bf16_t*)smem, tid);
  if (latent) {
    for (int dir = 0; dir < 2; ++dir) {
      const float* S0 = (dir == 0 ? p.in[6] : p.in[7]) + ((size_t)((b * 4 + l) * 8 + h)) * 4096;
#pragma unroll
      for (int i = 0; i < 4; ++i) {
        int e = (tid + i * 256) * 4;
        float4 v = *(const float4*)(S0 + e);
        int dk = e >> 6, dv = e & 63;
        sV0[(dv + 0) * LDT + dk] = f2bf(v.x);
        sV0[(dv + 1) * LDT + dk] = f2bf(v.y);
        sV0[(dv + 2) * LDT + dk] = f2bf(v.z);
        sV0[(dv + 3) * LDT + dk] = f2bf(v.w);
      }
      __syncthreads();
      const float sc = dir == 0 ? __expf(lgf * (float)(tq + 1)) : __expf(lgb * (float)(T - tq));
      bf16x8 pb[2];
#pragma unroll
      for (int s2 = 0; s2 < 2; ++s2) {
        const bf16_t* qp = Z + (size_t)qrow * ZLD + ZC_RTQ + h * 64 + 32 * s2 + 4 * fq;
        bf16x4 lo = *(const bf16x4*)qp;
        bf16x4 hi = *(const bf16x4*)(qp + 16);
        f32x4 flo = {bfs2f(lo[0]) * sc, bfs2f(lo[1]) * sc, bfs2f(lo[2]) * sc, bfs2f(lo[3]) * sc};
        f32x4 fhi = {bfs2f(hi[0]) * sc, bfs2f(hi[1]) * sc, bfs2f(hi[2]) * sc, bfs2f(hi[3]) * sc};
        pb[s2] = pack8(flo, fhi);
      }
      pv_step<64>(pb, sV0, O, fr, fq);
      __syncthreads();
    }
  }
  float ss = 0.f;
#pragma unroll
  for (int dt = 0; dt < 4; ++dt) ss += O[dt][0] * O[dt][0] + O[dt][1] * O[dt][1] + O[dt][2] * O[dt][2] + O[dt][3] * O[dt][3];
  ss = xsum32(xsum16(ss));
  const float rsn = rsqrtf(ss * (1.f / 64.f) + 1e-6f);
  const float* gn = p.in[27] + l * 512 + h * 64;
#pragma unroll
  for (int dt = 0; dt < 4; ++dt) {
    int dv = dt * 16 + fq * 4;
    float4 g = *(const float4*)(gn + dv);
    bf16x4 sg = *(const bf16x4*)(Z + (size_t)qrow * ZLD + ZC_RTG + h * 64 + dv);
    *(bf16x4*)(Y4 + (size_t)qrow * 2048 + 1024 + h * 64 + dv) =
        pack4(O[dt][0] * rsn * g.x * bfs2f(sg[0]), O[dt][1] * rsn * g.y * bfs2f(sg[1]), O[dt][2] * rsn * g.z * bfs2f(sg[2]), O[dt][3] * rsn * g.w * bfs2f(sg[3]));
  }
}

DI void ret_state_item(const P& p, int l, int b, int h) {
  const int tid_ = otid(), lane = tid_ & 63, wid = tid_ >> 6, fr = lane & 15, fq = lane >> 4;
  const bf16_t* KT = (const bf16_t*)(p.ws + WS_KTRT) + (size_t)(b * 512 + h * 64) * 256;
  const bf16_t* VT = (const bf16_t*)(p.ws + WS_VTRT) + (size_t)(b * 512 + h * 64) * 256;
  const float lgf = log1pf(-expf(p.in[25][l * 8 + h]));
  const float lgb = log1pf(-expf(p.in[26][l * 8 + h]));
  f32x4 af[4], ab[4];
#pragma unroll
  for (int nt = 0; nt < 4; ++nt) { af[nt] = f32x4{0.f, 0.f, 0.f, 0.f}; ab[nt] = f32x4{0.f, 0.f, 0.f, 0.f}; }
  for (int ks = 0; ks < 8; ++ks) {
    const int t0 = ks * 32 + fq * 8;
    bf16x8 kraw = *(const bf16x8*)(KT + (size_t)(wid * 16 + fr) * 256 + t0);
    bf16x8 kf, kb;
#pragma unroll
    for (int j = 0; j < 8; ++j) {
      float kv = bfs2f(kraw[j]);
      int t = t0 + j;
      kf[j] = (short)f2bf(kv * __expf(lgf * (float)(255 - t)));
      kb[j] = (short)f2bf(kv * __expf(lgb * (float)t));
    }
#pragma unroll
    for (int nt = 0; nt < 4; ++nt) {
      bf16x8 vb = *(const bf16x8*)(VT + (size_t)(nt * 16 + fr) * 256 + t0);
      af[nt] = MFMA16(kf, vb, af[nt]);
      ab[nt] = MFMA16(kb, vb, ab[nt]);
    }
  }
  float* of = p.out + O_RF + ((size_t)((b * 4 + l) * 8 + h)) * 4096;
  float* ob = p.out + O_RB + ((size_t)((b * 4 + l) * 8 + h)) * 4096;
#pragma unroll
  for (int nt = 0; nt < 4; ++nt)
#pragma unroll
    for (int i = 0; i < 4; ++i) {
      int dk = wid * 16 + fq * 4 + i, dv = nt * 16 + fr;
      of[dk * 64 + dv] = af[nt][i];
      ob[dk * 64 + dv] = ab[nt][i];
    }
}

DI void lru_gates_item(const P& p, int l, int chunk, int n, char* smem) {
  float* XDf = (float*)smem;
  bf16_t* XDb = (bf16_t*)(XDf + 4096);
  const int tid = otid(), lane = tid & 63, wid = tid >> 6, fr = lane & 15, fq = lane >> 4;
  const int row0 = chunk * 64;
  const bool latent = row0 >= NCTX;
  const int T = latent ? 2048 : 256;
  const int tseq0 = latent ? ((row0 - NCTX) & 2047) : (row0 & 255);
  const bf16_t* Z = (const bf16_t*)(p.ws + WS_Z);
  const bf16_t* WL = (const bf16_t*)(p.ws + WS_WLRU);
  bf16_t* LA = (bf16_t*)(p.ws + WS_LA);
  bf16_t* LU = (bf16_t*)(p.ws + WS_LU);
  const int ch0 = n * 64;
  {
    const float cw0 = p.in[28][(l * 4 + 0) * 512 + ch0 + lane];
    const float cw1 = p.in[28][(l * 4 + 1) * 512 + ch0 + lane];
    const float cw2 = p.in[28][(l * 4 + 2) * 512 + ch0 + lane];
    const float cw3 = p.in[28][(l * 4 + 3) * 512 + ch0 + lane];
    const float cb = p.in[29][l * 512 + ch0 + lane];
    const bf16_t* xcol = Z + (size_t)row0 * ZLD + ZC_LRX + ch0 + lane;
    const int t0 = wid * 16;
    auto ld = [&](int tl) -> float {
      int ts = tseq0 + tl;
      return (ts < 0 || ts >= T) ? 0.f : bf2f(xcol[(ptrdiff_t)tl * ZLD]);
    };
    float xm1 = ld(t0 - 1), x0 = ld(t0), x1 = ld(t0 + 1);
#pragma unroll
    for (int i = 0; i < 16; ++i) {
      float x2 = ld(t0 + i + 2);
      float xd = cw0 * xm1 + cw1 * x0 + cw2 * x1 + cw3 * x2 + cb;
      XDf[(t0 + i) * 64 + lane] = xd;
      XDb[(t0 + i) * LDT + lane] = f2bf(xd);
      xm1 = x0; x0 = x1; x1 = x2;
    }
  }
  __syncthreads();
  bf16x8 af[2];
#pragma unroll
  for (int ks = 0; ks < 2; ++ks) af[ks] = *(const bf16x8*)(XDb + (wid * 16 + fr) * LDT + ks * 32 + fq * 8);
#pragma unroll 1
  for (int dir = 0; dir < 2; ++dir) {
    const float* bav = (dir == 0 ? p.in[31] : p.in[36]) + l * 512 + ch0;
    const float* bxv = (dir == 0 ? p.in[33] : p.in[38]) + l * 512 + ch0;
    const float* lamv = (dir == 0 ? p.in[34] : p.in[39]) + l * 512 + ch0;
#pragma unroll
    for (int et = 0; et < 4; ++et) {
      f32x4 da = {0.f, 0.f, 0.f, 0.f}, dx = {0.f, 0.f, 0.f, 0.f};
#pragma unroll
      for (int ks = 0; ks < 2; ++ks) {
        bf16x8 wa = *(const bf16x8*)(WL + (size_t)((dir * 2 + 0) * 8 + n) * 4096 + (et * 16 + fr) * 64 + ks * 32 + fq * 8);
        bf16x8 wx = *(const bf16x8*)(WL + (size_t)((dir * 2 + 1) * 8 + n) * 4096 + (et * 16 + fr) * 64 + ks * 32 + fq * 8);
        da = MFMA16(af[ks], wa, da);
        dx = MFMA16(af[ks], wx, dx);
      }
      const int e = et * 16 + fr;
      const float ba_ = bav[e], bx_ = bxv[e];
      const float sp = log1pf(expf(-lamv[e]));
      float lav[4], uv[4];
#pragma unroll
      for (int i = 0; i < 4; ++i) {
        int tl = wid * 16 + fq * 4 + i;
        float rg = sigmoidf_(da[i] + ba_);
        float ig = sigmoidf_(dx[i] + bx_);
        float la = -8.f * rg * sp;
        lav[i] = la;
        uv[i] = sqrtf(1.f - __expf(2.f * la)) * (ig * XDf[tl * 64 + e]);
      }
      const size_t idx = (size_t)dir * 8388608 + ((size_t)chunk * 512 + ch0 + e) * 64 + wid * 16 + fq * 4;
      *(bf16x4*)(LA + idx) = pack4(lav[0], lav[1], lav[2], lav[3]);
      *(bf16x4*)(LU + idx) = pack4(uv[0], uv[1], uv[2], uv[3]);
    }
  }
  __syncthreads();
}

DI void lru_scan_witem(const P& p, int l, int bglob, int g, int lane) {
  const bool latent = bglob >= 32;
  const int T = latent ? 2048 : 256;
  const int rowbase = latent ? NCTX + (bglob - 32) * 2048 : bglob * 256;
  const int chunk0 = rowbase >> 6, nch = T >> 6;
  const int ch = g * 64 + lane;
  const bf16_t* LA = (const bf16_t*)(p.ws + WS_LA);
  const bf16_t* LU = (const bf16_t*)(p.ws + WS_LU);
  bf16_t* HF = (bf16_t*)(p.ws + WS_HF);
  const bf16_t* LG = (const bf16_t*)(p.ws + WS_LG);
  bf16_t* Y4 = (bf16_t*)(p.ws + WS_Y4);
  {
    float h = latent ? p.in[8][((bglob - 32) * 4 + l) * 512 + ch] : 0.f;
    bf16x8 ca[8], cu[8], na[8], nu[8];
    {
      const size_t b0 = ((size_t)chunk0 * 512 + ch) * 64;
#pragma unroll
      for (int q = 0; q < 8; ++q) { ca[q] = *(const bf16x8*)(LA + b0 + q * 8); cu[q] = *(const bf16x8*)(LU + b0 + q * 8); }
    }
    for (int cc = 0; cc < nch; ++cc) {
      const size_t cbase = ((size_t)(chunk0 + cc) * 512 + ch) * 64;
      const int cn = (cc + 1 < nch) ? cc + 1 : cc;
      const size_t nb = ((size_t)(chunk0 + cn) * 512 + ch) * 64;
#pragma unroll
      for (int q = 0; q < 8; ++q) { na[q] = *(const bf16x8*)(LA + nb + q * 8); nu[q] = *(const bf16x8*)(LU + nb + q * 8); }
#pragma unroll
      for (int q = 0; q < 8; ++q) {
        bf16x8 ho;
#pragma unroll
        for (int j = 0; j < 8; ++j) {
          float a = __expf(bfs2f(ca[q][j]));
          h = a * h + bfs2f(cu[q][j]);
          ho[j] = (short)f2bf(h);
        }
        *(bf16x8*)(HF + cbase + q * 8) = ho;
      }
#pragma unroll
      for (int q = 0; q < 8; ++q) { ca[q] = na[q]; cu[q] = nu[q]; }
    }
    if (!latent) p.out[O_LF + (size_t)(bglob * 4 + l) * 512 + ch] = h;
  }
  {
    float h = latent ? p.in[9][((bglob - 32) * 4 + l) * 512 + ch] : 0.f;
    const bf16_t* LAb = LA + 8388608;
    const bf16_t* LUb = LU + 8388608;
    bf16x8 ca[4], cu[4], chf[4], cg_[4], na[4], nu[4], nhf[4], ng[4];
    const int nb_ = 2 * nch;
    {
      const size_t b0 = ((size_t)(chunk0 + nch - 1) * 512 + ch) * 64 + 32;
#pragma unroll
      for (int q = 0; q < 4; ++q) {
        ca[q] = *(const bf16x8*)(LAb + b0 + q * 8); cu[q] = *(const bf16x8*)(LUb + b0 + q * 8);
        chf[q] = *(const bf16x8*)(HF + b0 + q * 8); cg_[q] = *(const bf16x8*)(LG + b0 + q * 8);
      }
    }
    for (int bi = 0; bi < nb_; ++bi) {
      const int chunk = nch - 1 - (bi >> 1), half = 1 - (bi & 1);
      const int bn = (bi + 1 < nb_) ? bi + 1 : bi;
      const int chunkn = nch - 1 - (bn >> 1), halfn = 1 - (bn & 1);
      const size_t nb = ((size_t)(chunk0 + chunkn) * 512 + ch) * 64 + halfn * 32;
#pragma unroll
      for (int q = 0; q < 4; ++q) {
        na[q] = *(const bf16x8*)(LAb + nb + q * 8); nu[q] = *(const bf16x8*)(LUb + nb + q * 8);
        nhf[q] = *(const bf16x8*)(HF + nb + q * 8); ng[q] = *(const bf16x8*)(LG + nb + q * 8);
      }
      bf16_t* yrow = Y4 + (size_t)(rowbase + chunk * 64 + half * 32) * 2048 + 1536 + ch;
#pragma unroll
      for (int q = 3; q >= 0; --q) {
#pragma unroll
        for (int j = 7; j >= 0; --j) {
          float a = __expf(bfs2f(ca[q][j]));
          h = a * h + bfs2f(cu[q][j]);
          float y = (bfs2f(chf[q][j]) + h) * bfs2f(cg_[q][j]);
          yrow[(size_t)(q * 8 + j) * 2048] = f2bf(y);
        }
      }
#pragma unroll
      for (int q = 0; q < 4; ++q) { ca[q] = na[q]; cu[q] = nu[q]; chf[q] = nhf[q]; cg_[q] = ng[q]; }
    }
    if (!latent) p.out[O_LB + (size_t)(bglob * 4 + l) * 512 + ch] = h;
  }
}

DI int next_item(unsigned* ctr, int* s_item) {
  __syncthreads();
  if (threadIdx.x == 0) *s_item = (int)atomicAdd(ctr, 1u);
  __syncthreads();
  return *s_item;
}
DI void phase_mixa(const P& p, int l, char* smem, int* s_item) {
  unsigned* ctr = (unsigned*)(p.ws + WS_BAR + 14336) + l * 2;
  const int NGRAB = 512 + 512;
  for (;;) {
    int q = next_item(ctr, s_item);
    if (q >= NGRAB) break;
    if (q < 512) { diff_item(p, l, true, q >> 7, (q >> 5) & 3, q & 31, smem); continue; }
    q -= 512;
#pragma unroll 1
    for (int u = 0; u < 4; ++u) { const int g = q * 4 + u; lru_gates_item(p, l, g >> 3, g & 7, smem); }
  }
}
DI void phase_mixb(const P& p, int l, char* smem, int* s_item) {
  unsigned* ctr = (unsigned*)(p.ws + WS_BAR + 14336) + l * 2 + 1;
  const int NGRAB = 72 + 1024 + 1024 + 256 + 256 + 256 + 32;
  for (;;) {
    int q = next_item(ctr, s_item);
    if (q >= NGRAB) break;
    if (q < 72) {
      const int tid = otid(), lane = tid & 63, wid = tid >> 6;
      int bglob, g;
      if (q < 32) {
        if (wid == 0) { bglob = 32 + (q >> 3); g = q & 7; }
        else { int ci = q * 3 + wid - 1; bglob = ci >> 3; g = ci & 7; }
      } else {
        int ci = 96 + (q - 32) * 4 + wid;
        bglob = ci >> 3; g = ci & 7;
      }
      lru_scan_witem(p, l, bglob, g, lane);
      continue;
    }
    q -= 72;
    if (q < 1024) { ret_item(p, l, true, q >> 8, (q >> 5) & 7, q & 31, smem); continue; }
    q -= 1024;
    if (q < 1024) { na_item(p, l, q >> 8, (q >> 5) & 7, q & 31, smem); continue; }
    q -= 1024;
    if (q < 256) {
#pragma unroll 1
      for (int u = 0; u < 2; ++u) { const int g = q * 2 + u; diff_item(p, l, false, g >> 4, (g >> 2) & 3, g & 3, smem); }
      continue;
    }
    q -= 256;
    if (q < 256) {
#pragma unroll 1
      for (int u = 0; u < 4; ++u) { const int g = q * 4 + u; dense_item(p, g >> 5, (g >> 2) & 7, g & 3, smem); }
      continue;
    }
    q -= 256;
    if (q < 256) {
#pragma unroll 1
      for (int u = 0; u < 4; ++u) { const int g = q * 4 + u; ret_item(p, l, false, g >> 5, (g >> 2) & 7, g & 3, smem); }
      continue;
    }
    q -= 256;
#pragma unroll 1
    for (int u = 0; u < 8; ++u) { const int g = q * 8 + u; ret_state_item(p, l, g >> 3, g & 7); }
  }
}

#define XB_TMO 128
#define XB_XCNT(j) (256 + 64 * (j))
#define XB_XSUB(j) (1280 + 64 * (j))
#define XB_XGEN(j) (2304 + 64 * (j))
#define XB_TOP 3328
#define XB_TOPGEN 3392
#define XCD_BAR_WORDS 3456
#define XB_SPIN_CAP (1u << 18)
#define LAS __attribute__((address_space(3)))
DI unsigned xb_ld(unsigned* p) { return __hip_atomic_load(p, __ATOMIC_RELAXED, __HIP_MEMORY_SCOPE_AGENT); }
DI unsigned xb_add(unsigned* p, unsigned v) { return __hip_atomic_fetch_add(p, v, __ATOMIC_RELAXED, __HIP_MEMORY_SCOPE_AGENT); }
DI unsigned xb_xcc_id() { return (unsigned)__builtin_amdgcn_s_getreg((3 << 11) | 20) & 0xFu; }
#define XB_SPIN(cond, bar) do { unsigned _sp = 0; while (cond) { __builtin_amdgcn_s_sleep(1); \
    if ((++_sp & 255u) == 0u) { if (xb_ld(&(bar)[XB_TMO])) break; if (_sp > XB_SPIN_CAP) { atomicAdd(&(bar)[XB_TMO], 1u); break; } } } } while (0)
struct XcdBarrier { unsigned* bar; unsigned x; volatile LAS unsigned* st; };
DI XcdBarrier xcd_barrier_post(unsigned* bar, volatile LAS unsigned* st) {
  XcdBarrier b; b.bar = bar; b.x = xb_xcc_id(); b.st = st;
  if (threadIdx.x == 0) (void)xb_add(&bar[XB_XCNT(b.x)], 1u);
  return b;
}
DI void xcd_barrier_complete(unsigned* bar, unsigned x, unsigned& nloc, unsigned& nx) {
  const unsigned G = gridDim.x * gridDim.y * gridDim.z;
  unsigned sum, cnt, mine, sp = 0u;
  for (;;) {
    sum = 0u; cnt = 0u; mine = 0u;
#pragma unroll
    for (unsigned j = 0; j < 16; ++j) { const unsigned c = xb_ld(&bar[XB_XCNT(j)]); sum += c; cnt += (c > 0u) ? 1u : 0u; mine = (j == x) ? c : mine; }
    if (sum == G) break;
    __builtin_amdgcn_s_sleep(1);
    if ((++sp & 255u) == 0u) { if (xb_ld(&bar[XB_TMO])) break; if (sp > XB_SPIN_CAP) { atomicAdd(&bar[XB_TMO], 1u); break; } }
  }
  nloc = mine > 0u ? mine : 1u; nx = cnt > 0u ? cnt : 1u;
}
DI void xcd_barrier(const XcdBarrier& b) {
  asm volatile("s_waitcnt vmcnt(0)" ::: "memory");
  __syncthreads();
  if (threadIdx.x == 0) {
    unsigned* bar = b.bar;
    __builtin_amdgcn_s_waitcnt(0);
    unsigned nloc = b.st[0], nx = b.st[1];
    if (nloc == 0u) { xcd_barrier_complete(bar, b.x, nloc, nx); b.st[0] = nloc; b.st[1] = nx; }
    const unsigned old = xb_add(&bar[XB_XSUB(b.x)], 1u);
    const unsigned gen = old / nloc;
    if (old + 1u == (gen + 1u) * nloc) {
      __builtin_amdgcn_fence(__ATOMIC_RELEASE, "agent");
      asm volatile("s_waitcnt vmcnt(0)" ::: "memory");
      const unsigned og = xb_add(&bar[XB_TOP], 1u);
      const unsigned tg = og / nx;
      if (og + 1u == (tg + 1u) * nx) xb_add(&bar[XB_TOPGEN], 1u);
      else XB_SPIN(xb_ld(&bar[XB_TOPGEN]) == tg, bar);
      __builtin_amdgcn_fence(__ATOMIC_ACQUIRE, "agent");
      xb_add(&bar[XB_XGEN(b.x)], 1u);
      asm volatile("s_waitcnt vmcnt(0)" ::: "memory");
    } else {
      XB_SPIN(xb_ld(&bar[XB_XGEN(b.x)]) == gen, bar);
      __builtin_amdgcn_fence(__ATOMIC_ACQUIRE, "agent");
      asm volatile("s_waitcnt vmcnt(0)" ::: "memory");
    }
  }
  __syncthreads();
}

enum { PH_INIT = 0, PH_PRE0, PH_GIN, PH_MIXA, PH_MIXB, PH_MERGE, PH_OUT, PH_POSTMIX, PH_FF1, PH_FF2, PH_POSTFFN };

DI void run_phase(const P& p, int ph, int l, char* smem, int* s_item) {
  switch (ph) {
    case PH_INIT:
      phase_mod(p, smem);
      phase_convert(p, 0, smem);
      break;
    case PH_PRE0: phase_row(p, 0, 0); break;
    case PH_GIN: phase_gin(p, l, smem); break;
    case PH_MIXA: phase_mixa(p, l, smem, s_item); break;
    case PH_MIXB: phase_mixb(p, l, smem, s_item); break;
    case PH_MERGE: phase_merge(p, smem); break;
    case PH_OUT:
      phase_gemm_plain<0>((const bf16_t*)(p.ws + WS_H), 1024, (const bf16_t*)(p.ws + WS_WOUT), 1024, (bf16_t*)(p.ws + WS_Y), smem);
      break;
    case PH_POSTMIX: phase_row(p, l, 1); break;
    case PH_FF1:
      phase_gemm_plain<1>((const bf16_t*)(p.ws + WS_H), 1024, (const bf16_t*)(p.ws + WS_W1), 4096, (bf16_t*)(p.ws + WS_U), smem);
      break;
    case PH_FF2:
      phase_gemm_plain<0>((const bf16_t*)(p.ws + WS_U), 4096, (const bf16_t*)(p.ws + WS_W2), 1024, (bf16_t*)(p.ws + WS_Y), smem);
      break;
    case PH_POSTFFN:
      phase_row(p, l, 2);
      if (l < 3) phase_convert(p, l + 1, smem);
      break;
    default: break;
  }
}

DI void decode_step(int step, int& ph, int& l) {
  if (step < 2) { ph = step; l = 0; }
  else { int s = step - 2; l = s / 9; ph = PH_GIN + (s % 9); }
}
constexpr int NSTEPS = 38;

__global__ void __launch_bounds__(256, 2) hybrid_flow_mega(P p) {
  __shared__ __attribute__((aligned(16))) char smem[SMEM_BYTES];
  __shared__ uint4 xb_words;
  __shared__ int s_item;
  cg::grid_group grid = cg::this_grid();
  if (threadIdx.x == 0) xb_words = make_uint4(0u, 0u, 0u, 0u);
  __syncthreads();
  XcdBarrier xb = xcd_barrier_post((unsigned*)(p.ws + WS_BAR), (volatile LAS unsigned*)&xb_words);
  for (int step = 0; step < NSTEPS; ++step) {
    int ph, l;
    decode_step(step, ph, l);
#ifdef PROBE_DUP
    const int reps = (ph == PROBE_DUP) ? 2 : 1;
    for (int rep = 0; rep < reps; ++rep)
#endif
    run_phase(p, ph, l, smem, &s_item);
#ifdef PROBE_CONV
    if (ph == PH_POSTFFN && l < 3) phase_convert(p, l + 1, smem);
#endif
    if (step == 0) grid.sync();
    else if (step + 1 < NSTEPS) xcd_barrier(xb);
#ifdef PROBE_SYNC
    if (step + 1 < NSTEPS) xcd_barrier(xb);
#endif
  }
}

#if !ONE_LAUNCH
__global__ void __launch_bounds__(256, 2) hybrid_flow_phase(P p, int ph, int l) {
  __shared__ __attribute__((aligned(16))) char smem[SMEM_BYTES];
  __shared__ int s_item;
  run_phase(p, ph, l, smem, &s_item);
}
#endif

extern "C" void kernel_launch(void* const* d_in, const int* in_sizes, int n_in, void* d_out, int out_size, void* d_ws,
                              size_t ws_size, hipStream_t stream) {
  (void)in_sizes; (void)n_in; (void)out_size; (void)ws_size;
  P p{};
  for (int i = 0; i < 44; ++i) p.in[i] = (const float*)d_in[i];
  p.out = (float*)d_out;
  p.ws = (char*)d_ws;
#if ONE_LAUNCH
  static int grid_blocks = 0;
  if (!grid_blocks) {
    int dev = 0, cus = 0, per_cu = 0;
    hipGetDevice(&dev);
    hipDeviceGetAttribute(&cus, hipDeviceAttributeMultiprocessorCount, dev);
    hipOccupancyMaxActiveBlocksPerMultiprocessor(&per_cu, hybrid_flow_mega, 256, 0);
    if (per_cu < 1) per_cu = 1;
    if (per_cu > 2) per_cu = 2;
    grid_blocks = cus * per_cu;
  }
  (void)hipMemsetAsync((char*)d_ws + WS_BAR, 0, 16384, stream);
  void* args[] = {&p};
  hipError_t e = hipLaunchCooperativeKernel((void*)hybrid_flow_mega, dim3(grid_blocks), dim3(256), args, 0, stream);
  if (e != hipSuccess) fprintf(stderr, "cooperative launch failed: %s (grid %d)\n", hipGetErrorString(e), grid_blocks);
#else
  const int grid_blocks = 512;
  for (int step = 0; step < NSTEPS; ++step) {
    int ph, l;
    if (step < 2) { ph = step; l = 0; }
    else { int s = step - 2; l = s / 9; ph = PH_GIN + (s % 9); }
    hipLaunchKernelGGL(hybrid_flow_phase, dim3(grid_blocks), dim3(256), 0, stream, p, ph, l);
  }
#endif
}
```

```cpp
#include <hip/hip_runtime.h>
#include <hip/hip_cooperative_groups.h>
#include <cstdio>
namespace cg = cooperative_groups;

#ifndef ONE_LAUNCH
#define ONE_LAUNCH 1
#endif

typedef unsigned short bf16_t;
using bf16x8 = __attribute__((ext_vector_type(8))) short;
using bf16x4 = __attribute__((ext_vector_type(4))) short;
using f32x4 = __attribute__((ext_vector_type(4))) float;
using u32x4 = __attribute__((ext_vector_type(4))) unsigned;
#define DI __device__ __forceinline__
#define MFMA16(a, b, c) __builtin_amdgcn_mfma_f32_16x16x32_bf16((a), (b), (c), 0, 0, 0)

struct P {
  const float* in[44];
  float* out;
  char* ws;
};

constexpr int D = 1024, NCTX = 8192;
constexpr int ZLD = 4160;
constexpr int ZC_NAQ = 0, ZC_NAK = 512, ZC_DFQ = 1024, ZC_DFK = 1536, ZC_RTQ = 2048, ZC_RTK = 2560, ZC_RTG = 3072,
              ZC_LRX = 3584;
constexpr int LDT = 72;

constexpr size_t WS_WIN = 0;
constexpr size_t WS_WBR = WS_WIN + (size_t)10240 * 1024 * 2;
constexpr size_t WS_WOUT = WS_WBR + (size_t)1024 * 2048 * 2;
constexpr size_t WS_W1 = WS_WOUT + (size_t)1024 * 1024 * 2;
constexpr size_t WS_W2 = WS_W1 + (size_t)4096 * 1024 * 2;
constexpr size_t WS_WLRU = WS_W2 + (size_t)4096 * 1024 * 2;
constexpr size_t WS_CKNA = WS_WLRU + (size_t)32 * 4096 * 2;
constexpr size_t WS_CVNA = WS_CKNA + (size_t)4 * 262144 * 2;
constexpr size_t WS_CKDF = WS_CVNA + (size_t)4 * 262144 * 2;
constexpr size_t WS_CVDF = WS_CKDF + (size_t)4 * 262144 * 2;
constexpr size_t WS_MOD = WS_CVDF + (size_t)4 * 262144 * 2;
constexpr size_t WS_H = WS_MOD + (size_t)4 * 5 * 6144 * 4;
constexpr size_t WS_Y4 = WS_H + (size_t)16384 * 1024 * 2;
constexpr size_t WS_VTNA = WS_Y4 + (size_t)16384 * 2048 * 2;
constexpr size_t WS_VTDF = WS_VTNA + (size_t)16384 * 512 * 2;
constexpr size_t WS_VTRT = WS_VTDF + (size_t)16384 * 512 * 2;
constexpr size_t WS_KTRT = WS_VTRT + (size_t)16384 * 512 * 2;
constexpr size_t WS_Z = WS_KTRT + (size_t)8192 * 512 * 2;
constexpr size_t WS_GF = WS_Z + (size_t)16384 * ZLD * 2;
constexpr size_t WS_Y = WS_Z;
constexpr size_t WS_U = WS_Z + (size_t)16384 * 1024 * 4;
constexpr size_t WS_LA = WS_GF + (size_t)16384 * 4096 * 2;
constexpr size_t WS_LU = WS_LA + (size_t)2 * 16384 * 512 * 2;
constexpr size_t WS_HF = WS_LU + (size_t)2 * 16384 * 512 * 2;
constexpr size_t WS_LG = WS_HF + (size_t)16384 * 512 * 2;
constexpr size_t WS_BAR = WS_LG + (size_t)16384 * 512 * 2;
constexpr size_t WS_END = WS_BAR + 16384;

constexpr size_t O_NAK = 16777216, O_NAV = 33554432, O_DFK = 50331648, O_DFV = 67108864, O_RF = 83886080,
                 O_RB = 88080384, O_LF = 92274688, O_LB = 92340224;
constexpr int VT_LAT = 4194304;

constexpr int SMEM_BYTES = 75776;

DI int otid() {
  int t = threadIdx.x;
  asm volatile("" : "+v"(t));
  return t;
}
typedef __bf16 hwbf2 __attribute__((ext_vector_type(2)));
typedef float f32v2 __attribute__((ext_vector_type(2)));
using u32x2 = __attribute__((ext_vector_type(2))) unsigned;
DI unsigned pk2(float a, float b) {
  f32v2 v = {a, b};
  return __builtin_bit_cast(unsigned, __builtin_convertvector(v, hwbf2));
}
DI bf16_t f2bf(float x) { return (bf16_t)(pk2(x, 0.f) & 0xffffu); }
DI float bf2f(bf16_t b) { return __uint_as_float(((unsigned)b) << 16); }
DI float bfs2f(short b) { return __uint_as_float(((unsigned)(unsigned short)b) << 16); }
DI float wave_sum(float v) {
#pragma unroll
  for (int o = 32; o > 0; o >>= 1) v += __shfl_xor(v, o);
  return v;
}
DI float xmax16(float v) {
  unsigned u = __float_as_uint(v);
  auto r = __builtin_amdgcn_permlane16_swap(u, u, false, false);
  return fmaxf(__uint_as_float(r[0]), __uint_as_float(r[1]));
}
DI float xmax32(float v) {
  unsigned u = __float_as_uint(v);
  auto r = __builtin_amdgcn_permlane32_swap(u, u, false, false);
  return fmaxf(__uint_as_float(r[0]), __uint_as_float(r[1]));
}
DI float xsum16(float v) {
  unsigned u = __float_as_uint(v);
  auto r = __builtin_amdgcn_permlane16_swap(u, u, false, false);
  return __uint_as_float(r[0]) + __uint_as_float(r[1]);
}
DI float xsum32(float v) {
  unsigned u = __float_as_uint(v);
  auto r = __builtin_amdgcn_permlane32_swap(u, u, false, false);
  return __uint_as_float(r[0]) + __uint_as_float(r[1]);
}
DI float sigmoidf_(float x) { return 1.f / (1.f + __expf(-x)); }
DI float gelu_tanh(float x) {
  float u = 0.7978845608028654f * (x + 0.044715f * x * x * x);
  return x * sigmoidf_(2.f * u);
}
DI bf16x8 pack8(const f32x4& a, const f32x4& b) {
  u32x4 r = {pk2(a[0], a[1]), pk2(a[2], a[3]), pk2(b[0], b[1]), pk2(b[2], b[3])};
  return __builtin_bit_cast(bf16x8, r);
}
DI bf16x4 pack4(float a, float b, float c, float d) {
  u32x2 r = {pk2(a, b), pk2(c, d)};
  return __builtin_bit_cast(bf16x4, r);
}

constexpr int GEMM_BUF_BYTES = 32768;
DI int swz_off(int rr, int c4) {
  int ob = rr * 64 + c4 * 16;
  return ob ^ (((ob >> 9) & 1) << 5);
}
template <int NI>
DI void gemm_mainloop(const bf16_t* __restrict__ A, int lda, const bf16_t* __restrict__ Bt, int ldb, int K, int row0,
                      int col0, char* smem, f32x4 (&acc)[4][NI]) {
  const int tid = otid(), lane = tid & 63, wid = tid >> 6;
  const int wm = wid >> 1, wn = wid & 1, fr = lane & 15, fq = lane >> 4;
  const int c4 = tid & 3, kh = (tid >> 3) & 1;
  const int srow = ((tid >> 4) << 1) + ((tid >> 2) & 1);
  const int gk = (kh * 4 + c4) * 8;
  const int soff = ((srow >> 4) * 2 + kh) * 1024 + swz_off(srow & 15, c4);
  const bf16_t* Ag = A + (size_t)(row0 + srow) * lda + gk;
  const bf16_t* Bg = Bt + (size_t)(col0 + srow) * ldb + gk;
  const int aoff = wm * 8192 + swz_off(fr, fq);
  const int boff = 16384 + wn * NI * 2048 + swz_off(fr, fq);
  u32x4 ra[4], rb[NI];
#pragma unroll
  for (int i = 0; i < 4; ++i) ra[i] = *(const u32x4*)(Ag + (size_t)(i * 32) * lda);
#pragma unroll
  for (int i = 0; i < NI; ++i) rb[i] = *(const u32x4*)(Bg + (size_t)(i * 32) * ldb);
#pragma unroll
  for (int i = 0; i < 4; ++i) *(u32x4*)(smem + soff + i * 4096) = ra[i];
#pragma unroll
  for (int i = 0; i < NI; ++i) *(u32x4*)(smem + 16384 + soff + i * 4096) = rb[i];
  __syncthreads();
  const int nk = K >> 6;
  for (int kt = 0; kt < nk; ++kt) {
    const bool more = (kt + 1) < nk;
    if (more) {
      const int k1 = (kt + 1) * 64;
#pragma unroll
      for (int i = 0; i < 4; ++i) ra[i] = *(const u32x4*)(Ag + (size_t)(i * 32) * lda + k1);
#pragma unroll
      for (int i = 0; i < NI; ++i) rb[i] = *(const u32x4*)(Bg + (size_t)(i * 32) * ldb + k1);
    }
    asm volatile("" ::: "memory");
    const char* sb = smem + (kt & 1) * GEMM_BUF_BYTES;
#pragma unroll
    for (int ks = 0; ks < 2; ++ks) {
      bf16x8 af[4], bfr[NI];
#pragma unroll
      for (int mi = 0; mi < 4; ++mi) af[mi] = *(const bf16x8*)(sb + aoff + mi * 2048 + ks * 1024);
#pragma unroll
      for (int ni = 0; ni < NI; ++ni) bfr[ni] = *(const bf16x8*)(sb + boff + ni * 2048 + ks * 1024);
#pragma unroll
      for (int mi = 0; mi < 4; ++mi)
#pragma unroll
        for (int ni = 0; ni < NI; ++ni) acc[mi][ni] = MFMA16(bfr[ni], af[mi], acc[mi][ni]);
    }
    __builtin_amdgcn_sched_barrier(0);
    if (more) {
      char* db = smem + ((kt + 1) & 1) * GEMM_BUF_BYTES;
#pragma unroll
      for (int i = 0; i < 4; ++i) *(u32x4*)(db + soff + i * 4096) = ra[i];
#pragma unroll
      for (int i = 0; i < NI; ++i) *(u32x4*)(db + 16384 + soff + i * 4096) = rb[i];
    }
    __syncthreads();
  }
}

DI void zero_acc(f32x4 (&acc)[4][4]) {
#pragma unroll
  for (int mi = 0; mi < 4; ++mi)
#pragma unroll
    for (int ni = 0; ni < 4; ++ni) acc[mi][ni] = f32x4{0.f, 0.f, 0.f, 0.f};
}
DI bool tile_sched(int iter, int tmt, int ntn, int& tm, int& tn) {
  const int G = gridDim.x, b = blockIdx.x;
  if ((G & 63) == 0 && (ntn & 7) == 0 && (tmt & 7) == 0) {
    const int groups = G >> 6, xg = b % groups, j = b / groups;
    const int srows = tmt >> 3;
    const int s = iter * groups + xg, nsuper = srows * (ntn >> 3);
    if (s >= nsuper) return false;
    tm = (s % srows) * 8 + (j & 7);
    tn = (s / srows) * 8 + (j >> 3);
    return true;
  }
  const int id = b + iter * G;
  if (id >= tmt * ntn) return false;
  tm = id % tmt;
  tn = id / tmt;
  return true;
}

constexpr int G2_STAGE = 24576;
DI void zero_acc2(f32x4 (&acc)[8][4]) {
#pragma unroll
  for (int mi = 0; mi < 8; ++mi)
#pragma unroll
    for (int ni = 0; ni < 4; ++ni) acc[mi][ni] = f32x4{0.f, 0.f, 0.f, 0.f};
}
DI void gemm2_mainloop(const bf16_t* __restrict__ A, int lda, const bf16_t* __restrict__ Bt, int ldb, int K, int row0,
                       int col0, char* smem, f32x4 (&acc)[8][4]) {
  const int tid = otid(), lane = tid & 63, wid = tid >> 6;
  const int wm = wid >> 1, wn = wid & 1, fr = lane & 15, fq = lane >> 4;
  const int c4 = tid & 3, srow = tid >> 2;
  const int soff = (srow >> 4) * 1024 + swz_off(srow & 15, c4);
  const bf16_t* Ag = A + (size_t)(row0 + srow) * lda + c4 * 8;
  const bf16_t* Bg = Bt + (size_t)(col0 + srow) * ldb + c4 * 8;
  const int aoff = wm * 8192 + swz_off(fr, fq);
  const int boff = 16384 + wn * 4096 + swz_off(fr, fq);
  u32x4 raA[4], rbA[2], raB[4], rbB[2];
  const int nk = K >> 5;
  auto gload = [&](int kt, u32x4 (&ra)[4], u32x4 (&rb)[2]) __attribute__((always_inline)) {
    const int k1 = kt * 32;
#pragma unroll
    for (int i = 0; i < 4; ++i) ra[i] = *(const u32x4*)(Ag + (size_t)(i * 64) * lda + k1);
#pragma unroll
    for (int i = 0; i < 2; ++i) rb[i] = *(const u32x4*)(Bg + (size_t)(i * 64) * ldb + k1);
  };
  auto sstore = [&](int st, const u32x4 (&ra)[4], const u32x4 (&rb)[2]) __attribute__((always_inline)) {
    char* db = smem + st * G2_STAGE;
#pragma unroll
    for (int i = 0; i < 4; ++i) *(u32x4*)(db + soff + i * 4096) = ra[i];
#pragma unroll
    for (int i = 0; i < 2; ++i) *(u32x4*)(db + 16384 + soff + i * 4096) = rb[i];
  };
  auto compute = [&](int st) __attribute__((always_inline)) {
    const char* sb = smem + st * G2_STAGE;
    bf16x8 bfr[4];
#pragma unroll
    for (int ni = 0; ni < 4; ++ni) bfr[ni] = *(const bf16x8*)(sb + boff + ni * 1024);
    __builtin_amdgcn_s_setprio(1);
#pragma unroll
    for (int mi = 0; mi < 8; ++mi) {
      bf16x8 af = *(const bf16x8*)(sb + aoff + mi * 1024);
#pragma unroll
      for (int ni = 0; ni < 4; ++ni) acc[mi][ni] = MFMA16(bfr[ni], af, acc[mi][ni]);
    }
    __builtin_amdgcn_s_setprio(0);
  };
  gload(0, raA, rbA);
  gload(1, raB, rbB);
  sstore(0, raA, rbA);
  __syncthreads();
  for (int kt = 0; kt < nk; kt += 2) {
    gload(kt + 2 < nk ? kt + 2 : nk - 1, raA, rbA);
    asm volatile("" ::: "memory");
    compute(0);
    __builtin_amdgcn_sched_barrier(0);
    sstore(1, raB, rbB);
    __syncthreads();
    gload(kt + 3 < nk ? kt + 3 : nk - 1, raB, rbB);
    asm volatile("" ::: "memory");
    compute(1);
    __builtin_amdgcn_sched_barrier(0);
    sstore(0, raA, rbA);
    __syncthreads();
  }
}

constexpr int G3_STAGE = 16384;
DI void gemm3_mainloop(const bf16_t* __restrict__ A, int lda, const bf16_t* __restrict__ Bt, int ldb, int K, int row0,
                       int col0, char* smem, f32x4 (&acc)[4][4]) {
  const int tid = otid(), lane = tid & 63, wid = tid >> 6;
  const int wm = wid >> 1, wn = wid & 1, fr = lane & 15, fq = lane >> 4;
  const int c4 = tid & 3, srow = tid >> 2;
  const int soff = (srow >> 4) * 1024 + swz_off(srow & 15, c4);
  const bf16_t* Ag = A + (size_t)(row0 + srow) * lda + c4 * 8;
  const bf16_t* Bg = Bt + (size_t)(col0 + srow) * ldb + c4 * 8;
  const int aoff = wm * 4096 + swz_off(fr, fq);
  const int boff = 8192 + wn * 4096 + swz_off(fr, fq);
  u32x4 ra[2], rb[2];
#pragma unroll
  for (int i = 0; i < 2; ++i) { ra[i] = *(const u32x4*)(Ag + (size_t)(i * 64) * lda); rb[i] = *(const u32x4*)(Bg + (size_t)(i * 64) * ldb); }
#pragma unroll
  for (int i = 0; i < 2; ++i) { *(u32x4*)(smem + soff + i * 4096) = ra[i]; *(u32x4*)(smem + 8192 + soff + i * 4096) = rb[i]; }
  __syncthreads();
  const int nk = K >> 5;
  for (int kt = 0; kt < nk; ++kt) {
    const bool more = (kt + 1) < nk;
    if (more) {
      const int k1 = (kt + 1) * 32;
#pragma unroll
      for (int i = 0; i < 2; ++i) { ra[i] = *(const u32x4*)(Ag + (size_t)(i * 64) * lda + k1); rb[i] = *(const u32x4*)(Bg + (size_t)(i * 64) * ldb + k1); }
    }
    asm volatile("" ::: "memory");
    const char* sb = smem + (kt & 1) * G3_STAGE;
    bf16x8 bfr[4];
#pragma unroll
    for (int ni = 0; ni < 4; ++ni) bfr[ni] = *(const bf16x8*)(sb + boff + ni * 1024);
    __builtin_amdgcn_s_setprio(1);
#pragma unroll
    for (int mi = 0; mi < 4; ++mi) {
      bf16x8 af = *(const bf16x8*)(sb + aoff + mi * 1024);
#pragma unroll
      for (int ni = 0; ni < 4; ++ni) acc[mi][ni] = MFMA16(bfr[ni], af, acc[mi][ni]);
    }
    __builtin_amdgcn_s_setprio(0);
    __builtin_amdgcn_sched_barrier(0);
    if (more) {
      char* db = smem + ((kt + 1) & 1) * G3_STAGE;
#pragma unroll
      for (int i = 0; i < 2; ++i) { *(u32x4*)(db + soff + i * 4096) = ra[i]; *(u32x4*)(db + 8192 + soff + i * 4096) = rb[i]; }
    }
    __syncthreads();
  }
}

constexpr int CST_B = 272;
constexpr int CST_T = 528;
template <int MI, int NI, class F>
DI void stage_rowmajor(char* smem, f32x4 (&acc)[MI][NI], int wm, int wn, int fr, int fq, F&& tf) {
#pragma unroll
  for (int mi = 0; mi < MI; ++mi)
#pragma unroll
    for (int ni = 0; ni < NI; ++ni) {
      f32x4 v = tf(acc[mi][ni]);
      *(bf16x4*)(smem + (wm * MI * 16 + mi * 16 + fr) * CST_B + (wn * NI * 16 + ni * 16 + fq * 4) * 2) = pack4(v[0], v[1], v[2], v[3]);
      if (ni == NI - 1) __builtin_amdgcn_sched_barrier(0);
    }
}
template <int MI, int NI, class F>
DI void stage_transposed(char* smem, f32x4 (&acc)[MI][NI], int wm, int wn, int fr, int fq, F&& tf) {
#pragma unroll
  for (int mi = 0; mi < MI; ++mi)
#pragma unroll
    for (int ni = 0; ni < NI; ++ni) {
      f32x4 v = tf(acc[mi][ni]);
      char* base = smem + (wn * NI * 16 + ni * 16 + fq * 4) * CST_T + (wm * MI * 16 + mi * 16 + fr) * 2;
      *(bf16_t*)(base) = f2bf(v[0]);
      *(bf16_t*)(base + CST_T) = f2bf(v[1]);
      *(bf16_t*)(base + 2 * CST_T) = f2bf(v[2]);
      *(bf16_t*)(base + 3 * CST_T) = f2bf(v[3]);
      if (ni == NI - 1) __builtin_amdgcn_sched_barrier(0);
    }
}
template <int LINES, int CPL, int STRIDE, class D>
DI void writeout(const char* smem, int tid, D&& dst) {
#pragma unroll 4
  for (int j = 0; j < LINES * CPL / 256; ++j) {
    const int id = tid + j * 256, line = id / CPL, c = id % CPL;
    u32x4 v = *(const u32x4*)(smem + line * STRIDE + c * 16);
    *(u32x4*)dst(line, c) = v;
  }
}

DI void stage_rowmajor_rope(char* smem, f32x4 (&acc)[8][4], int wm, int wn, int fr, int fq, int rtok) {
  float inv[4];
#pragma unroll
  for (int i = 0; i < 4; ++i) inv[i] = exp2f(-(float)(fq * 4 + i) * 0.8304820237218406f);
#pragma unroll
  for (int mi = 0; mi < 8; ++mi) {
    const int t = (rtok + mi * 16 - NCTX) & 2047;
    const float gr = (float)(t >> 6), gc = (float)(t & 63);
    f32x4 o0, o1, o2, o3;
#pragma unroll
    for (int i = 0; i < 4; ++i) {
      const float sr = __sinf(gr * inv[i]), cr = __cosf(gr * inv[i]);
      const float sc = __sinf(gc * inv[i]), cc = __cosf(gc * inv[i]);
      const float a0 = acc[mi][0][i], a1 = acc[mi][1][i], a2 = acc[mi][2][i], a3 = acc[mi][3][i];
      o0[i] = a0 * cr - a1 * sr;
      o1[i] = a1 * cr + a0 * sr;
      o2[i] = a2 * cc - a3 * sc;
      o3[i] = a3 * cc + a2 * sc;
    }
    char* base = smem + (wm * 128 + mi * 16 + fr) * CST_B + (wn * 64 + fq * 4) * 2;
    *(bf16x4*)(base) = pack4(o0[0], o0[1], o0[2], o0[3]);
    *(bf16x4*)(base + 32) = pack4(o1[0], o1[1], o1[2], o1[3]);
    *(bf16x4*)(base + 64) = pack4(o2[0], o2[1], o2[2], o2[3]);
    *(bf16x4*)(base + 96) = pack4(o3[0], o3[1], o3[2], o3[3]);
    __builtin_amdgcn_sched_barrier(0);
  }
}

DI void epi_in(const P& p, int l, int row0, int col0, f32x4 (&acc)[8][4], char* smem) {
  const int tid_ = otid(), lane = tid_ & 63, wid = tid_ >> 6, wm = wid >> 1, wn = wid & 1, fr = lane & 15, fq = lane >> 4;
  const int seg = col0 >> 9;
  const bool ctx = row0 < NCTX;
  if (seg >= 12) {
    bf16_t* GF = (bf16_t*)(p.ws + WS_GF);
    const int k = (seg - 12) >> 1, tn = ((col0 - 6144) & 1023) >> 7, tm = row0 >> 8;
    bf16_t* dst = GF + (((size_t)k * 64 + tm) * 8 + tn) * 32768 + tid_ * 4;
#pragma unroll
    for (int mi = 0; mi < 8; ++mi)
#pragma unroll
      for (int ni = 0; ni < 4; ++ni)
        *(bf16x4*)(dst + (mi * 4 + ni) * 1024) = pack4(sigmoidf_(acc[mi][ni][0]), sigmoidf_(acc[mi][ni][1]), sigmoidf_(acc[mi][ni][2]), sigmoidf_(acc[mi][ni][3]));
    return;
  }
  const int ctile = col0 & 511;
  const int cseg0 = ctile + wn * 64;
  const int rtok = row0 + wm * 128 + fr;
  if (ctx && (seg == 1 || seg == 2 || seg == 4 || seg == 5)) {
    float* out = p.out;
#pragma unroll
    for (int mi = 0; mi < 8; ++mi) {
      const int r = rtok + mi * 16, b = r >> 8, t = r & 255;
      size_t off;
      if (seg == 1 || seg == 2) {
        const int h = cseg0 >> 6;
        off = (seg == 1 ? O_NAK : O_NAV) + (((size_t)(b * 4 + l) * 8 + h) * 256 + t) * 64;
      } else if (seg == 4) {
        const int comp = cseg0 >> 8, h = (cseg0 >> 6) & 3;
        off = O_DFK + ((((size_t)(b * 4 + l) * 2 + comp) * 4 + h) * 256 + t) * 64;
      } else {
        const int h = cseg0 >> 7;
        off = O_DFV + (((size_t)(b * 4 + l) * 4 + h) * 256 + t) * 128 + (cseg0 & 127);
      }
#pragma unroll
      for (int ni = 0; ni < 4; ++ni) *(f32x4*)(out + off + ni * 16 + fq * 4) = acc[mi][ni];
      __builtin_amdgcn_sched_barrier(0);
    }
  }
  auto tf_none = [](const f32x4& a) -> f32x4 { return a; };
  auto tf_scale = [](const f32x4& a) -> f32x4 { return f32x4{a[0] * 0.125f, a[1] * 0.125f, a[2] * 0.125f, a[3] * 0.125f}; };
  auto tf_silu = [](const f32x4& a) -> f32x4 { return f32x4{a[0] * sigmoidf_(a[0]), a[1] * sigmoidf_(a[1]), a[2] * sigmoidf_(a[2]), a[3] * sigmoidf_(a[3])}; };
  auto tf_gelu = [](const f32x4& a) -> f32x4 { return f32x4{gelu_tanh(a[0]), gelu_tanh(a[1]), gelu_tanh(a[2]), gelu_tanh(a[3])}; };
  const bool rowmajor = !(seg == 2 || seg == 5 || seg == 8 || seg == 11);
  if (rowmajor) {
    int zc;
    switch (seg) {
      case 0: zc = ZC_NAQ; break;
      case 1: zc = ZC_NAK; break;
      case 3: zc = ZC_DFQ; break;
      case 4: zc = ZC_DFK; break;
      case 6: zc = ZC_RTQ; break;
      case 7: zc = ZC_RTK; break;
      case 9: zc = ZC_RTG; break;
      default: zc = ZC_LRX; break;
    }
    if (!ctx && (seg == 3 || seg == 4)) stage_rowmajor_rope(smem, acc, wm, wn, fr, fq, rtok);
    else if (seg == 7) stage_rowmajor<8, 4>(smem, acc, wm, wn, fr, fq, tf_scale);
    else if (seg == 9) stage_rowmajor<8, 4>(smem, acc, wm, wn, fr, fq, tf_silu);
    else stage_rowmajor<8, 4>(smem, acc, wm, wn, fr, fq, tf_none);
    __syncthreads();
    bf16_t* zb = (bf16_t*)(p.ws + WS_Z) + (size_t)row0 * ZLD + zc + ctile;
    writeout<256, 16, CST_B>(smem, tid_, [&](int line, int c) { return zb + (size_t)line * ZLD + c * 8; });
    __syncthreads();
  }
  if (!rowmajor || (seg == 7 && ctx)) {
    if (seg == 7) stage_transposed<8, 4>(smem, acc, wm, wn, fr, fq, tf_scale);
    else if (seg == 11) stage_transposed<8, 4>(smem, acc, wm, wn, fr, fq, tf_gelu);
    else stage_transposed<8, 4>(smem, acc, wm, wn, fr, fq, tf_none);
    __syncthreads();
    if (seg == 11) {
      bf16_t* lg = (bf16_t*)(p.ws + WS_LG) + ((size_t)(row0 >> 6) * 512 + ctile) * 64;
      writeout<128, 32, CST_T>(smem, tid_, [&](int line, int c) { return lg + ((size_t)(c >> 3) * 512 + line) * 64 + (c & 7) * 8; });
    } else {
      bf16_t* tb = (bf16_t*)(p.ws + (seg == 2 ? WS_VTNA : seg == 5 ? WS_VTDF : seg == 8 ? WS_VTRT : WS_KTRT));
      int T;
      if (ctx) { T = 256; tb += ((size_t)((row0 >> 8) * 512 + ctile)) * 256 + (row0 & 255); }
      else { const int rr = row0 - NCTX; T = 2048; tb += (size_t)VT_LAT + ((size_t)((rr >> 11) * 512 + ctile)) * 2048 + (rr & 2047); }
      writeout<128, 32, CST_T>(smem, tid_, [&](int line, int c) { return tb + (size_t)line * T + c * 8; });
    }
    __syncthreads();
  }
}

DI void phase_gin(const P& p, int l, char* smem) {
  const bf16_t* A = (const bf16_t*)(p.ws + WS_H);
  const bf16_t* Bt = (const bf16_t*)(p.ws + WS_WIN);
  for (int it = 0;; ++it) {
    int tm, tn;
    if (!tile_sched(it, 64, 80, tm, tn)) break;
    f32x4 acc[8][4];
    zero_acc2(acc);
    gemm2_mainloop(A, 1024, Bt, 1024, 1024, tm * 256, tn * 128, smem, acc);
    epi_in(p, l, tm * 256, tn * 128, acc, smem);
  }
}

DI void phase_merge(const P& p, char* smem) {
  const bf16_t* Y4 = (const bf16_t*)(p.ws + WS_Y4);
  const bf16_t* WB = (const bf16_t*)(p.ws + WS_WBR);
  const bf16_t* GF = (const bf16_t*)(p.ws + WS_GF);
  bf16_t* G = (bf16_t*)(p.ws + WS_H);
  const int tid_ = otid(), lane = tid_ & 63, wid = tid_ >> 6, wm = wid >> 1, wn = wid & 1, fr = lane & 15, fq = lane >> 4;
  for (int it = 0;; ++it) {
    int tm, tn;
    if (!tile_sched(it, 128, 8, tm, tn)) break;
    const int row0 = tm * 128, col0 = tn * 128;
    f32x4 o[4][4];
    zero_acc(o);
#pragma unroll 1
    for (int k = 0; k < 4; ++k) {
      f32x4 acc[4][4];
      zero_acc(acc);
      gemm3_mainloop(Y4 + k * 512, 2048, WB + k * 512, 2048, 512, row0, col0, smem, acc);
      const bf16_t* gsrc = GF + (((size_t)k * 64 + (tm >> 1)) * 8 + tn) * 32768 + (((tm & 1) * 2 + wn) * 64 + lane) * 4 + (wm * 16) * 1024;
#pragma unroll
      for (int mi = 0; mi < 4; ++mi) {
        bf16x4 gq[4];
#pragma unroll
        for (int ni = 0; ni < 4; ++ni) gq[ni] = *(const bf16x4*)(gsrc + (mi * 4 + ni) * 1024);
#pragma unroll
        for (int ni = 0; ni < 4; ++ni)
#pragma unroll
          for (int i = 0; i < 4; ++i) o[mi][ni][i] += bfs2f(gq[ni][i]) * acc[mi][ni][i];
      }
    }
    stage_rowmajor<4, 4>(smem, o, wm, wn, fr, fq, [](const f32x4& a) { return a; });
    __syncthreads();
    bf16_t* gb = G + (size_t)row0 * 1024 + col0;
    writeout<128, 16, CST_B>(smem, tid_, [&](int line, int c) { return gb + (size_t)line * 1024 + c * 8; });
    __syncthreads();
  }
}

template <int MODE>
DI void phase_gemm_plain(const bf16_t* A, int K, const bf16_t* Bt, int N, bf16_t* outp, char* smem) {
  const int tid_ = otid(), lane = tid_ & 63, wid = tid_ >> 6, wm = wid >> 1, wn = wid & 1, fr = lane & 15, fq = lane >> 4;
  const int ntn = N / 128;
  for (int it = 0;; ++it) {
    int tm, tn;
    if (!tile_sched(it, 64, ntn, tm, tn)) break;
    const int row0 = tm * 256, col0 = tn * 128;
    f32x4 acc[8][4];
    zero_acc2(acc);
    gemm2_mainloop(A, K, Bt, K, K, row0, col0, smem, acc);
    stage_rowmajor<8, 4>(smem, acc, wm, wn, fr, fq, [](const f32x4& a) {
      f32x4 v = a;
      if (MODE == 1) {
        v[0] = fmaxf(v[0], 0.f); v[1] = fmaxf(v[1], 0.f); v[2] = fmaxf(v[2], 0.f); v[3] = fmaxf(v[3], 0.f);
        v[0] *= v[0]; v[1] *= v[1]; v[2] *= v[2]; v[3] *= v[3];
      }
      return v;
    });
    __syncthreads();
    bf16_t* ob = outp + (size_t)row0 * N + col0;
    writeout<256, 16, CST_B>(smem, tid_, [&](int line, int c) { return ob + (size_t)line * N + c * 8; });
    __syncthreads();
  }
}

DI void phase_mod(const P& p, char* smem) {
  float* ssil = (float*)smem;
  float* red = ssil + 5 * 1024;
  const int tid = otid();
  float* MOD = (float*)(p.ws + WS_MOD);
  for (int idx = tid; idx < 5120; idx += 256) {
    int j = idx >> 10, k = idx & 1023;
    float cv = (j == 0) ? p.in[11][k] : p.in[10][(j - 1) * 1024 + k];
    ssil[idx] = cv / (1.f + expf(-cv));
  }
  __syncthreads();
  const int cl = tid & 63, kg = tid >> 6;
  for (int item = blockIdx.x; item < 384; item += gridDim.x) {
    int l = item / 96, cgp = item % 96;
    int col = cgp * 64 + cl;
    const float* W = p.in[12] + (size_t)l * 1024 * 6144 + col;
    float a0 = 0, a1 = 0, a2 = 0, a3 = 0, a4 = 0;
#pragma unroll 8
    for (int k = kg * 256; k < kg * 256 + 256; ++k) {
      float w = W[(size_t)k * 6144];
      a0 += ssil[k] * w;
      a1 += ssil[1024 + k] * w;
      a2 += ssil[2048 + k] * w;
      a3 += ssil[3072 + k] * w;
      a4 += ssil[4096 + k] * w;
    }
    red[(kg * 5 + 0) * 64 + cl] = a0;
    red[(kg * 5 + 1) * 64 + cl] = a1;
    red[(kg * 5 + 2) * 64 + cl] = a2;
    red[(kg * 5 + 3) * 64 + cl] = a3;
    red[(kg * 5 + 4) * 64 + cl] = a4;
    __syncthreads();
    if (kg == 0) {
      float bias = p.in[13][l * 6144 + col];
#pragma unroll
      for (int j = 0; j < 5; ++j) {
        float s = red[(0 * 5 + j) * 64 + cl] + red[(1 * 5 + j) * 64 + cl] + red[(2 * 5 + j) * 64 + cl] + red[(3 * 5 + j) * 64 + cl];
        MOD[(size_t)(l * 5 + j) * 6144 + col] = s + bias;
      }
    }
    __syncthreads();
  }
}

DI void transpose_tile(const float* __restrict__ src, int lds_, bf16_t* __restrict__ dst, int ldd, float* tile) {
  const int tid = otid();
#pragma unroll 4
  for (int i = 0; i < 16; ++i) {
    int idx = tid + i * 256, r = idx >> 6, c = idx & 63;
    tile[r * 65 + c] = src[(size_t)r * lds_ + c];
  }
  __syncthreads();
#pragma unroll 4
  for (int i = 0; i < 16; ++i) {
    int idx = tid + i * 256, c = idx >> 6, r = idx & 63;
    dst[(size_t)c * ldd + r] = f2bf(tile[r * 65 + c]);
  }
  __syncthreads();
}

DI void phase_convert(const P& p, int l, char* smem) {
  float* tile = (float*)smem;
  char* ws = p.ws;
  const int NJ = 6432;
  for (int j = blockIdx.x; j < NJ; j += gridDim.x) {
    int q = j;
    if (q < 2560) {
      int tr = q / 160, tc = q % 160;
      transpose_tile(p.in[18] + (size_t)l * 1024 * 10240 + (size_t)tr * 64 * 10240 + tc * 64, 10240,
                     (bf16_t*)(ws + WS_WIN) + (size_t)tc * 64 * 1024 + tr * 64, 1024, tile);
      continue;
    }
    q -= 2560;
    if (q < 512) {
      int tr = q / 16, tc = q % 16;
      transpose_tile(p.in[40] + (size_t)l * 2048 * 1024 + (size_t)tr * 64 * 1024 + tc * 64, 1024,
                     (bf16_t*)(ws + WS_WBR) + (size_t)tc * 64 * 2048 + tr * 64, 2048, tile);
      continue;
    }
    q -= 512;
    if (q < 256) {
      int tr = q / 16, tc = q % 16;
      transpose_tile(p.in[41] + (size_t)l * 1024 * 1024 + (size_t)tr * 64 * 1024 + tc * 64, 1024,
                     (bf16_t*)(ws + WS_WOUT) + (size_t)tc * 64 * 1024 + tr * 64, 1024, tile);
      continue;
    }
    q -= 256;
    if (q < 1024) {
      int tr = q / 64, tc = q % 64;
      transpose_tile(p.in[42] + (size_t)l * 1024 * 4096 + (size_t)tr * 64 * 4096 + tc * 64, 4096,
                     (bf16_t*)(ws + WS_W1) + (size_t)tc * 64 * 1024 + tr * 64, 1024, tile);
      continue;
    }
    q -= 1024;
    if (q < 1024) {
      int tr = q / 16, tc = q % 16;
      transpose_tile(p.in[43] + (size_t)l * 4096 * 1024 + (size_t)tr * 64 * 1024 + tc * 64, 1024,
                     (bf16_t*)(ws + WS_W2) + (size_t)tc * 64 * 4096 + tr * 64, 4096, tile);
      continue;
    }
    q -= 1024;
    if (q < 32) {
      int type = q >> 3, n = q & 7;
      const float* src = (type == 0 ? p.in[30] : type == 1 ? p.in[32] : type == 2 ? p.in[35] : p.in[37]) + (size_t)(l * 8 + n) * 4096;
      transpose_tile(src, 64, (bf16_t*)(ws + WS_WLRU) + (size_t)(type * 8 + n) * 4096, 64, tile);
      continue;
    }
    q -= 32;
    if (q < 256) {
      int bh = q >> 3, tr = q & 7, b = bh >> 3, h = bh & 7;
      transpose_tile(p.in[3] + ((size_t)((b * 4 + l) * 8 + h)) * 32768 + (size_t)tr * 64 * 64, 64,
                     (bf16_t*)(ws + WS_CVNA) + (size_t)bh * 32768 + tr * 64, 512, tile);
      continue;
    }
    q -= 256;
    if (q < 256) {
      int bh = q >> 4, t2 = q & 15, tr = t2 >> 1, tc = t2 & 1, b = bh >> 2, h = bh & 3;
      transpose_tile(p.in[5] + ((size_t)((b * 4 + l) * 4 + h)) * 65536 + (size_t)tr * 64 * 128 + tc * 64, 128,
                     (bf16_t*)(ws + WS_CVDF) + (size_t)bh * 65536 + (size_t)tc * 64 * 512 + tr * 64, 512, tile);
      continue;
    }
    q -= 256;
    {
      int tensor = q >> 8, b = (q >> 6) & 3, chunk = q & 63;
      const float* src = (tensor == 0 ? p.in[2] : p.in[4]) + (size_t)(b * 4 + l) * 262144 + (size_t)chunk * 4096;
      bf16_t* dst = (bf16_t*)(ws + (tensor == 0 ? WS_CKNA : WS_CKDF)) + (size_t)b * 262144 + (size_t)chunk * 4096;
#pragma unroll
      for (int i = 0; i < 4; ++i) {
        int e = (otid() + i * 256) * 4;
        float4 v = *(const float4*)(src + e);
        *(bf16x4*)(dst + e) = pack4(v.x, v.y, v.z, v.w);
      }
    }
  }
}

DI void phase_row(const P& p, int l, int mode) {
  const int tid_ = otid(), lane = tid_ & 63, wid = tid_ >> 6;
  const float* MOD = (const float*)(p.ws + WS_MOD);
  float* X = p.out;
  bf16_t* H = (bf16_t*)(p.ws + WS_H);
  const bf16_t* Y = (const bf16_t*)(p.ws + WS_Y);
  const bool from_inputs = (mode == 0 || (mode == 1 && l == 0));
  auto xsrc = [&](int r) -> const float* {
    return from_inputs ? ((r < NCTX) ? (p.in[0] + (size_t)r * D) : (p.in[1] + (size_t)(r - NCTX) * D)) : (X + (size_t)r * D);
  };
  int rb = blockIdx.x;
  if (rb >= 4096) return;
  float4 xn[4];
  bf16x4 yn[4];
  {
    const int r = rb * 4 + wid;
    const float* xs = xsrc(r);
#pragma unroll
    for (int j = 0; j < 4; ++j) xn[j] = *(const float4*)(xs + j * 256 + lane * 4);
    if (mode != 0) {
#pragma unroll
      for (int j = 0; j < 4; ++j) yn[j] = *(const bf16x4*)(Y + (size_t)r * D + j * 256 + lane * 4);
    }
  }
  for (; rb < 4096; rb += gridDim.x) {
    const int r = rb * 4 + wid;
    const int mi = r < NCTX ? 0 : 1 + ((r - NCTX) >> 11);
    float4 xv[4], yv[4];
#pragma unroll
    for (int j = 0; j < 4; ++j) { xv[j] = xn[j]; yv[j] = make_float4(bfs2f(yn[j][0]), bfs2f(yn[j][1]), bfs2f(yn[j][2]), bfs2f(yn[j][3])); }
    {
      const int rbn = (rb + (int)gridDim.x < 4096) ? rb + (int)gridDim.x : rb;
      const int rn = rbn * 4 + wid;
      const float* xs = xsrc(rn);
#pragma unroll
      for (int j = 0; j < 4; ++j) xn[j] = *(const float4*)(xs + j * 256 + lane * 4);
      if (mode != 0) {
#pragma unroll
        for (int j = 0; j < 4; ++j) yn[j] = *(const bf16x4*)(Y + (size_t)rn * D + j * 256 + lane * 4);
      }
    }
    if (mode != 0) {
      float ss = 0.f;
#pragma unroll
      for (int j = 0; j < 4; ++j) ss += yv[j].x * yv[j].x + yv[j].y * yv[j].y + yv[j].z * yv[j].z + yv[j].w * yv[j].w;
      ss = wave_sum(ss);
      const float rs = rsqrtf(ss * (1.f / 1024.f) + 1e-6f);
      const float* gpost = (mode == 1 ? p.in[15] : p.in[17]) + l * D;
      const float* gate = MOD + (size_t)(l * 5 + mi) * 6144 + (mode == 1 ? 2048 : 5120);
#pragma unroll
      for (int j = 0; j < 4; ++j) {
        float4 g = *(const float4*)(gpost + j * 256 + lane * 4);
        float4 gt = *(const float4*)(gate + j * 256 + lane * 4);
        xv[j].x += gt.x * (yv[j].x * rs * g.x);
        xv[j].y += gt.y * (yv[j].y * rs * g.y);
        xv[j].z += gt.z * (yv[j].z * rs * g.z);
        xv[j].w += gt.w * (yv[j].w * rs * g.w);
        *(float4*)(X + (size_t)r * D + j * 256 + lane * 4) = xv[j];
      }
    }
    int ln, off_sh, off_sc;
    const float* gpre;
    if (mode == 0) { ln = 0; gpre = p.in[14]; off_sh = 0; off_sc = 1024; }
    else if (mode == 1) { ln = l; gpre = p.in[16] + l * D; off_sh = 3072; off_sc = 4096; }
    else { ln = l + 1; gpre = p.in[14] + (l + 1) * D; off_sh = 0; off_sc = 1024; }
    if (ln < 4) {
      float ss = 0.f;
#pragma unroll
      for (int j = 0; j < 4; ++j) ss += xv[j].x * xv[j].x + xv[j].y * xv[j].y + xv[j].z * xv[j].z + xv[j].w * xv[j].w;
      ss = wave_sum(ss);
      const float rs = rsqrtf(ss * (1.f / 1024.f) + 1e-6f);
      const float* mrow = MOD + (size_t)(ln * 5 + mi) * 6144;
#pragma unroll
      for (int j = 0; j < 4; ++j) {
        int c = j * 256 + lane * 4;
        float4 g = *(const float4*)(gpre + c);
        float4 sc = *(const float4*)(mrow + off_sc + c);
        float4 sh = *(const float4*)(mrow + off_sh + c);
        *(bf16x4*)(H + (size_t)r * D + c) = pack4(xv[j].x * rs * g.x * (1.f + sc.x) + sh.x, xv[j].y * rs * g.y * (1.f + sc.y) + sh.y,
                                                  xv[j].z * rs * g.z * (1.f + sc.z) + sh.z, xv[j].w * rs * g.w * (1.f + sc.w) + sh.w);
      }
    }
  }
}

constexpr int ATT_BUF = 192 * LDT;
DI void qk_scores(const bf16x8 (&qf)[2], const bf16_t* sK, f32x4 (&S)[4], int fr, int fq) {
  __builtin_amdgcn_s_setprio(1);
#pragma unroll
  for (int s = 0; s < 4; ++s) {
    f32x4 z = {0.f, 0.f, 0.f, 0.f};
#pragma unroll
    for (int ks = 0; ks < 2; ++ks) {
      bf16x8 a = *(const bf16x8*)(sK + (16 * s + fr) * LDT + ks * 32 + fq * 8);
      z = MFMA16(a, qf[ks], z);
    }
    S[s] = z;
  }
  __builtin_amdgcn_s_setprio(0);
}
template <int DV>
DI void pv_step(const bf16x8 (&pb)[2], const bf16_t* sV, f32x4 (&O)[DV / 16], int fr, int fq) {
  __builtin_amdgcn_s_setprio(1);
#pragma unroll
  for (int dt = 0; dt < DV / 16; ++dt) {
#pragma unroll
    for (int s2 = 0; s2 < 2; ++s2) {
      const bf16_t* base = sV + (dt * 16 + fr) * LDT + 32 * s2 + 4 * fq;
      bf16x4 lo = *(const bf16x4*)base;
      bf16x4 hi = *(const bf16x4*)(base + 16);
      bf16x8 a = __builtin_shufflevector(lo, hi, 0, 1, 2, 3, 4, 5, 6, 7);
      O[dt] = MFMA16(a, pb[s2], O[dt]);
    }
  }
  __builtin_amdgcn_s_setprio(0);
}
template <int DV>
DI void softmax_pv(f32x4 (&S)[4], const bf16_t* sV, f32x4 (&O)[DV / 16], float& m, float& lsum, int fr, int fq) {
  float tm = -1e30f;
#pragma unroll
  for (int s = 0; s < 4; ++s)
#pragma unroll
    for (int i = 0; i < 4; ++i) tm = fmaxf(tm, S[s][i]);
  tm = xmax32(xmax16(tm));
  const float mn = fmaxf(m, tm);
  const float alpha = __builtin_amdgcn_exp2f(m - mn);
  const bool grew = mn != m;
  m = mn;
  float ps = 0.f;
#pragma unroll
  for (int s = 0; s < 4; ++s)
#pragma unroll
    for (int i = 0; i < 4; ++i) {
      float pv = __builtin_amdgcn_exp2f(S[s][i] - mn);
      S[s][i] = pv;
      ps += pv;
    }
  lsum = lsum * alpha + ps;
  if (__any(grew)) {
#pragma unroll
    for (int dt = 0; dt < DV / 16; ++dt) {
      O[dt][0] *= alpha; O[dt][1] *= alpha; O[dt][2] *= alpha; O[dt][3] *= alpha;
    }
  }
  bf16x8 pb[2];
  pb[0] = pack8(S[0], S[1]);
  pb[1] = pack8(S[2], S[3]);
  pv_step<DV>(pb, sV, O, fr, fq);
}
template <int DV, bool SOFTMAX, int TPS, class TileFn, class ScoreFn>
DI void attn_loop(int ntiles, TileFn&& tile, ScoreFn&& score, const bf16x8 (&qf)[2], f32x4 (&O)[DV / 16], float& m, float& lsum,
                  bf16_t* smem, int tid) {
  const int lane = tid & 63, fr = lane & 15, fq = lane >> 4;
  constexpr int TILE_EL = (64 + DV) * LDT, STAGE_EL = TPS * TILE_EL;
  u32x4 rkA[TPS][2], rvA[TPS][DV / 32], rkB[TPS][2], rvB[TPS][DV / 32];
  const int sr = tid >> 3, sc = (tid & 7) * 8;
  auto gload = [&](int step, u32x4 (&rk)[TPS][2], u32x4 (&rv)[TPS][DV / 32]) __attribute__((always_inline)) {
#pragma unroll
    for (int u = 0; u < TPS; ++u) {
      const bf16_t* Kg; const bf16_t* Vg; int ldk, ldv;
      tile(step * TPS + u, Kg, ldk, Vg, ldv);
#pragma unroll
      for (int i = 0; i < 2; ++i) rk[u][i] = *(const u32x4*)(Kg + (size_t)(sr + i * 32) * ldk + sc);
#pragma unroll
      for (int i = 0; i < DV / 32; ++i) rv[u][i] = *(const u32x4*)(Vg + (size_t)(sr + i * 32) * ldv + sc);
    }
  };
  auto sstore = [&](int buf, const u32x4 (&rk)[TPS][2], const u32x4 (&rv)[TPS][DV / 32]) __attribute__((always_inline)) {
#pragma unroll
    for (int u = 0; u < TPS; ++u) {
      bf16_t* sK = smem + buf * STAGE_EL + u * TILE_EL;
      bf16_t* sV = sK + 64 * LDT;
#pragma unroll
      for (int i = 0; i < 2; ++i) *(u32x4*)(sK + (sr + i * 32) * LDT + sc) = rk[u][i];
#pragma unroll
      for (int i = 0; i < DV / 32; ++i) *(u32x4*)(sV + (sr + i * 32) * LDT + sc) = rv[u][i];
    }
  };
  auto compute = [&](int buf, int step) __attribute__((always_inline)) {
#pragma unroll
    for (int u = 0; u < TPS; ++u) {
      const bf16_t* sK = smem + buf * STAGE_EL + u * TILE_EL;
      const bf16_t* sV = sK + 64 * LDT;
      f32x4 S[4];
      qk_scores(qf, sK, S, fr, fq);
      score(step * TPS + u, S);
      if (SOFTMAX) {
        softmax_pv<DV>(S, sV, O, m, lsum, fr, fq);
      } else {
        bf16x8 pb[2];
        pb[0] = pack8(S[0], S[1]);
        pb[1] = pack8(S[2], S[3]);
        pv_step<DV>(pb, sV, O, fr, fq);
      }
    }
  };
  const int nsteps = ntiles / TPS, last = nsteps - 1;
  if (TPS > 1) {
    gload(0, rkA, rvA);
    sstore(0, rkA, rvA);
    __syncthreads();
    for (int j = 0; j < nsteps; ++j) {
      gload(j + 1 < last ? j + 1 : last, rkA, rvA);
      asm volatile("" ::: "memory");
      compute(j & 1, j);
      __builtin_amdgcn_sched_barrier(0);
      sstore((j + 1) & 1, rkA, rvA);
      __syncthreads();
    }
    return;
  }
  gload(0, rkA, rvA);
  gload(last < 1 ? last : 1, rkB, rvB);
  sstore(0, rkA, rvA);
  __syncthreads();
  for (int j = 0; j < nsteps; j += 2) {
    gload(j + 2 < last ? j + 2 : last, rkA, rvA);
    asm volatile("" ::: "memory");
    compute(0, j);
    __builtin_amdgcn_sched_barrier(0);
    sstore(1, rkB, rvB);
    __syncthreads();
    if (j + 1 >= nsteps) break;
    gload(j + 3 < last ? j + 3 : last, rkB, rvB);
    asm volatile("" ::: "memory");
    compute(1, j + 1);
    __builtin_amdgcn_sched_barrier(0);
    sstore(0, rkA, rvA);
    __syncthreads();
  }
}
DI void scale_scores(f32x4 (&S)[4]) {
#pragma unroll
  for (int s = 0; s < 4; ++s) { S[s][0] *= 0.18033688f; S[s][1] *= 0.18033688f; S[s][2] *= 0.18033688f; S[s][3] *= 0.18033688f; }
}

DI void dense_item(const P& p, int b, int h, int qb, char* smem) {
  const int tid = otid(), lane = tid & 63, wid = tid >> 6, fr = lane & 15, fq = lane >> 4;
  const bf16_t* Z = (const bf16_t*)(p.ws + WS_Z);
  const bf16_t* VT = (const bf16_t*)(p.ws + WS_VTNA) + (size_t)(b * 512 + h * 64) * 256;
  bf16_t* Y4 = (bf16_t*)(p.ws + WS_Y4);
  const int rowbase = b * 256;
  const int qrow = rowbase + qb * 64 + wid * 16 + fr;
  bf16x8 qf[2];
#pragma unroll
  for (int ks = 0; ks < 2; ++ks) qf[ks] = *(const bf16x8*)(Z + (size_t)qrow * ZLD + ZC_NAQ + h * 64 + ks * 32 + fq * 8);
  f32x4 O[4];
#pragma unroll
  for (int dt = 0; dt < 4; ++dt) O[dt] = f32x4{0.f, 0.f, 0.f, 0.f};
  float m = -1e30f, lsum = 0.f;
  const bf16_t* Kb = Z + (size_t)rowbase * ZLD + ZC_NAK + h * 64;
  attn_loop<64, true, 2>(4,
      [&](int j, const bf16_t*& Kg, int& ldk, const bf16_t*& Vg, int& ldv) __attribute__((always_inline)) { Kg = Kb + (size_t)j * 64 * ZLD; ldk = ZLD; Vg = VT + j * 64; ldv = 256; },
      [&](int, f32x4 (&S)[4]) __attribute__((always_inline)) { scale_scores(S); }, qf, O, m, lsum, (bf16_t*)smem, tid);
  const float lt = xsum32(xsum16(lsum));
  const float inv = 1.f / lt;
#pragma unroll
  for (int dt = 0; dt < 4; ++dt)
    *(bf16x4*)(Y4 + (size_t)qrow * 2048 + h * 64 + dt * 16 + fq * 4) = pack4(O[dt][0] * inv, O[dt][1] * inv, O[dt][2] * inv, O[dt][3] * inv);
}

DI void na_item(const P& p, int l, int b, int h, int r, char* smem) {
  float* srpb = (float*)(smem + 73728);
  const int tid = otid(), lane = tid & 63, wid = tid >> 6, fr = lane & 15, fq = lane >> 4;
  const bf16_t* Z = (const bf16_t*)(p.ws + WS_Z);
  const bf16_t* VT = (const bf16_t*)(p.ws + WS_VTNA) + VT_LAT + (size_t)(b * 512 + h * 64) * 2048;
  const bf16_t* CK = (const bf16_t*)(p.ws + WS_CKNA) + (size_t)(b * 8 + h) * 32768;
  const bf16_t* CVT = (const bf16_t*)(p.ws + WS_CVNA) + (size_t)(b * 8 + h) * 32768;
  bf16_t* Y4 = (bf16_t*)(p.ws + WS_Y4);
  for (int i = tid; i < 465; i += 256) srpb[i] = p.in[19][(size_t)(l * 8 + h) * 465 + i];
  const int rowbase = NCTX + b * 2048;
  const int qcol = wid * 16 + fr;
  const int qrow = rowbase + r * 64 + qcol;
  bf16x8 qf[2];
#pragma unroll
  for (int ks = 0; ks < 2; ++ks) qf[ks] = *(const bf16x8*)(Z + (size_t)qrow * ZLD + ZC_NAQ + h * 64 + ks * 32 + fq * 8);
  f32x4 O[4];
#pragma unroll
  for (int dt = 0; dt < 4; ++dt) O[dt] = f32x4{0.f, 0.f, 0.f, 0.f};
  float m = -1e30f, lsum = 0.f;
  int rs = r - 4;
  rs = rs < 0 ? 0 : (rs > 24 ? 24 : rs);
  int cstart = qcol - 8;
  cstart = cstart < 0 ? 0 : (cstart > 48 ? 48 : cstart);
  const bf16_t* Kb = Z + (size_t)rowbase * ZLD + ZC_NAK + h * 64;
  attn_loop<64, true, 2>(16,
      [&](int j, const bf16_t*& Kg, int& ldk, const bf16_t*& Vg, int& ldv) __attribute__((always_inline)) {
        if (j < 8) { Kg = Kb + (size_t)(rs + j) * 64 * ZLD; ldk = ZLD; Vg = VT + (rs + j) * 64; ldv = 2048; }
        else { Kg = CK + (size_t)(j - 8) * 64 * 64; ldk = 64; Vg = CVT + (j - 8) * 64; ldv = 512; }
      },
      [&](int j, f32x4 (&S)[4]) __attribute__((always_inline)) {
        if (j < 8) {
          const int dr = rs + j - r + 7;
#pragma unroll
          for (int s = 0; s < 4; ++s)
#pragma unroll
            for (int i = 0; i < 4; ++i) {
              int kcol = s * 16 + fq * 4 + i;
              bool ok = (kcol >= cstart) && (kcol < cstart + 16);
              int dc = kcol - qcol + 15;
              dc = dc < 0 ? 0 : (dc > 30 ? 30 : dc);
              float bias = srpb[dr * 31 + dc];
              S[s][i] = ok ? (S[s][i] * 0.18033688f + bias * 1.44269504f) : -1e30f;
            }
        } else {
          scale_scores(S);
        }
      },
      qf, O, m, lsum, (bf16_t*)smem, tid);
  const float lt = xsum32(xsum16(lsum));
  const float inv = 1.f / lt;
#pragma unroll
  for (int dt = 0; dt < 4; ++dt)
    *(bf16x4*)(Y4 + (size_t)qrow * 2048 + h * 64 + dt * 16 + fq * 4) = pack4(O[dt][0] * inv, O[dt][1] * inv, O[dt][2] * inv, O[dt][3] * inv);
}

DI void diff_item(const P& p, int l, bool latent, int b, int h, int qb, char* smem) {
  const int tid = otid(), lane = tid & 63, wid = tid >> 6, fr = lane & 15, fq = lane >> 4;
  const bf16_t* Z = (const bf16_t*)(p.ws + WS_Z);
  const int T = latent ? 2048 : 256;
  const int rowbase = latent ? NCTX + b * 2048 : b * 256;
  const bf16_t* VT = (const bf16_t*)(p.ws + WS_VTDF) + (latent ? (size_t)VT_LAT + (size_t)(b * 512 + h * 128) * 2048 : (size_t)(b * 512 + h * 128) * 256);
  const bf16_t* CVT = (const bf16_t*)(p.ws + WS_CVDF) + (size_t)(b * 4 + h) * 65536;
  bf16_t* Y4 = (bf16_t*)(p.ws + WS_Y4);
  const int qrow = rowbase + qb * 64 + wid * 16 + fr;
  float d1 = p.in[20][l * 64 + lane] * p.in[21][l * 64 + lane];
  float d2 = p.in[22][l * 64 + lane] * p.in[23][l * 64 + lane];
  d1 = wave_sum(d1);
  d2 = wave_sum(d2);
  const float lam_init = 0.8f - 0.6f * expf(-0.3f * (float)l);
  const float lam = expf(d1) - expf(d2) + lam_init;
  const int nown = T >> 6;
  const int ntiles = nown + (latent ? 8 : 0);

  f32x4 O1[8];
  f32x4 O[8];
#pragma unroll 1
  for (int comp = 0; comp < 2; ++comp) {
    bf16x8 qf[2];
#pragma unroll
    for (int ks = 0; ks < 2; ++ks) qf[ks] = *(const bf16x8*)(Z + (size_t)qrow * ZLD + ZC_DFQ + comp * 256 + h * 64 + ks * 32 + fq * 8);
#pragma unroll
    for (int dt = 0; dt < 8; ++dt) O[dt] = f32x4{0.f, 0.f, 0.f, 0.f};
    float m = -1e30f, lsum = 0.f;
    const bf16_t* Kb = Z + (size_t)rowbase * ZLD + ZC_DFK + comp * 256 + h * 64;
    const bf16_t* CK = (const bf16_t*)(p.ws + WS_CKDF) + (size_t)((b * 2 + comp) * 4 + h) * 32768;
    attn_loop<128, true, 1>(ntiles,
        [&](int j, const bf16_t*& Kg, int& ldk, const bf16_t*& Vg, int& ldv) __attribute__((always_inline)) {
          if (j < nown) { Kg = Kb + (size_t)j * 64 * ZLD; ldk = ZLD; Vg = VT + j * 64; ldv = T; }
          else { Kg = CK + (size_t)(j - nown) * 64 * 64; ldk = 64; Vg = CVT + (j - nown) * 64; ldv = 512; }
        },
        [&](int, f32x4 (&S)[4]) __attribute__((always_inline)) { scale_scores(S); }, qf, O, m, lsum, (bf16_t*)smem, tid);
    const float lt = xsum32(xsum16(lsum));
    const float inv = 1.f / lt;
    if (comp == 0) {
#pragma unroll
      for (int dt = 0; dt < 8; ++dt) { O1[dt][0] = O[dt][0] * inv; O1[dt][1] = O[dt][1] * inv; O1[dt][2] = O[dt][2] * inv; O1[dt][3] = O[dt][3] * inv; }
    } else {
#pragma unroll
      for (int dt = 0; dt < 8; ++dt) {
        O[dt][0] = O1[dt][0] - lam * (O[dt][0] * inv);
        O[dt][1] = O1[dt][1] - lam * (O[dt][1] * inv);
        O[dt][2] = O1[dt][2] - lam * (O[dt][2] * inv);
        O[dt][3] = O1[dt][3] - lam * (O[dt][3] * inv);
      }
    }
  }
  float ss = 0.f;
#pragma unroll
  for (int dt = 0; dt < 8; ++dt) ss += O[dt][0] * O[dt][0] + O[dt][1] * O[dt][1] + O[dt][2] * O[dt][2] + O[dt][3] * O[dt][3];
  ss = xsum32(xsum16(ss));
  const float rsn = rsqrtf(ss * (1.f / 128.f) + 1e-6f) * (1.f - lam_init);
  const float* gn = p.in[24] + l * 128;
#pragma unroll
  for (int dt = 0; dt < 8; ++dt) {
    int dv = dt * 16 + fq * 4;
    float4 g = *(const float4*)(gn + dv);
    *(bf16x4*)(Y4 + (size_t)qrow * 2048 + 512 + h * 128 + dv) = pack4(O[dt][0] * rsn * g.x, O[dt][1] * rsn * g.y, O[dt][2] * rsn * g.z, O[dt][3] * rsn * g.w);
  }
}

DI void ret_item(const P& p, int l, bool latent, int b, int h, int qb, char* smem) {
  bf16_t* sV0 = (bf16_t*)smem + 64 * LDT;
  const int tid = otid(), lane = tid & 63, wid = tid >> 6, fr = lane & 15, fq = lane >> 4;
  const bf16_t* Z = (const bf16_t*)(p.ws + WS_Z);
  const int T = latent ? 2048 : 256;
  const int rowbase = latent ? NCTX + b * 2048 : b * 256;
  const bf16_t* VT = (const bf16_t*)(p.ws + WS_VTRT) + (latent ? (size_t)VT_LAT + (size_t)(b * 512 + h * 64) * 2048 : (size_t)(b * 512 + h * 64) * 256);
  bf16_t* Y4 = (bf16_t*)(p.ws + WS_Y4);
  const int tq = qb * 64 + wid * 16 + fr;
  const int qrow = rowbase + tq;
  const float lgf = log1pf(-expf(p.in[25][l * 8 + h]));
  const float lgb = log1pf(-expf(p.in[26][l * 8 + h]));
  bf16x8 qf[2];
#pragma unroll
  for (int ks = 0; ks < 2; ++ks) qf[ks] = *(const bf16x8*)(Z + (size_t)qrow * ZLD + ZC_RTQ + h * 64 + ks * 32 + fq * 8);
  f32x4 O[4];
#pragma unroll
  for (int dt = 0; dt < 4; ++dt) O[dt] = f32x4{0.f, 0.f, 0.f, 0.f};
  float mdummy = 0.f, ldummy = 0.f;
  const int dq = wid * 16 + fr;
  float AF[4], BF[4], AB[4], BB[4];
#pragma unroll
  for (int u = 0; u < 4; ++u) {
    AF[u] = __expf(-lgf * (float)(u * 16));
    AB[u] = __expf(lgb * (float)(u * 16));
    BF[u] = __expf(-lgf * (float)(fq * 4 + u));
    BB[u] = __expf(lgb * (float)(fq * 4 + u));
  }
  const bf16_t* Kb = Z + (size_t)rowbase * ZLD + ZC_RTK + h * 64;
  attn_loop<64, false, 2>(T >> 6,
      [&](int j, const bf16_t*& Kg, int& ldk, const bf16_t*& Vg, int& ldv) __attribute__((always_inline)) { Kg = Kb + (size_t)j * 64 * ZLD; ldk = ZLD; Vg = VT + j * 64; ldv = T; },
      [&](int j, f32x4 (&S)[4]) __attribute__((always_inline)) {
        if (j == qb) {
#pragma unroll
          for (int s = 0; s < 4; ++s)
#pragma unroll
            for (int i = 0; i < 4; ++i) {
              int tk = j * 64 + s * 16 + fq * 4 + i;
              int dd = tq - tk;
              float w = dd >= 0 ? __expf(lgf * (float)dd) : __expf(lgb * (float)(-dd));
              S[s][i] *= w;
            }
        } else if (j < qb) {
          const float qfac = __expf(lgf * (float)((qb - j) * 64 + dq));
#pragma unroll
          for (int s = 0; s < 4; ++s) {
            const float f = qfac * AF[s];
            S[s][0] *= f * BF[0]; S[s][1] *= f * BF[1]; S[s][2] *= f * BF[2]; S[s][3] *= f * BF[3];
          }
        } else {
          const float qfac = __expf(lgb * (float)((j - qb) * 64 - dq));
#pragma unroll
          for (int s = 0; s < 4; ++s) {
            const float f = qfac * AB[s];
            S[s][0] *= f * BB[0]; S[s][1] *= f * BB[1]; S[s][2] *= f * BB[2]; S[s][3] *= f * BB[3];
          }
        }
      },
      qf, O, mdummy, ldummy, (bf16_t*)smem, tid);
  if (latent) {
    for (int dir = 0; dir < 2; ++dir) {
      const float* S0 = (dir == 0 ? p.in[6] : p.in[7]) + ((size_t)((b * 4 + l) * 8 + h)) * 4096;
#pragma unroll
      for (int i = 0; i < 4; ++i) {
        int e = (tid + i * 256) * 4;
        float4 v = *(const float4*)(S0 + e);
        int dk = e >> 6, dv = e & 63;
        sV0[(dv + 0) * LDT + dk] = f2bf(v.x);
        sV0[(dv + 1) * LDT + dk] = f2bf(v.y);
        sV0[(dv + 2) * LDT + dk] = f2bf(v.z);
        sV0[(dv + 3) * LDT + dk] = f2bf(v.w);
      }
      __syncthreads();
      const float sc = dir == 0 ? __expf(lgf * (float)(tq + 1)) : __expf(lgb * (float)(T - tq));
      bf16x8 pb[2];
#pragma unroll
      for (int s2 = 0; s2 < 2; ++s2) {
        const bf16_t* qp = Z + (size_t)qrow * ZLD + ZC_RTQ + h * 64 + 32 * s2 + 4 * fq;
        bf16x4 lo = *(const bf16x4*)qp;
        bf16x4 hi = *(const bf16x4*)(qp + 16);
        f32x4 flo = {bfs2f(lo[0]) * sc, bfs2f(lo[1]) * sc, bfs2f(lo[2]) * sc, bfs2f(lo[3]) * sc};
        f32x4 fhi = {bfs2f(hi[0]) * sc, bfs2f(hi[1]) * sc, bfs2f(hi[2]) * sc, bfs2f(hi[3]) * sc};
        pb[s2] = pack8(flo, fhi);
      }
      pv_step<64>(pb, sV0, O, fr, fq);
      __syncthreads();
    }
  }
  float ss = 0.f;
#pragma unroll
  for (int dt = 0; dt < 4; ++dt) ss += O[dt][0] * O[dt][0] + O[dt][1] * O[dt][1] + O[dt][2] * O[dt][2] + O[dt][3] * O[dt][3];
  ss = xsum32(xsum16(ss));
  const float rsn = rsqrtf(ss * (1.f / 64.f) + 1e-6f);
  const float* gn = p.in[27] + l * 512 + h * 64;
#pragma unroll
  for (int dt = 0; dt < 4; ++dt) {
    int dv = dt * 16 + fq * 4;
    float4 g = *(const float4*)(gn + dv);
    bf16x4 sg = *(const bf16x4*)(Z + (size_t)qrow * ZLD + ZC_RTG + h * 64 + dv);
    *(bf16x4*)(Y4 + (size_t)qrow * 2048 + 1024 + h * 64 + dv) =
        pack4(O[dt][0] * rsn * g.x * bfs2f(sg[0]), O[dt][1] * rsn * g.y * bfs2f(sg[1]), O[dt][2] * rsn * g.z * bfs2f(sg[2]), O[dt][3] * rsn * g.w * bfs2f(sg[3]));
  }
}

DI void ret_state_item(const P& p, int l, int b, int h) {
  const int tid_ = otid(), lane = tid_ & 63, wid = tid_ >> 6, fr = lane & 15, fq = lane >> 4;
  const bf16_t* KT = (const bf16_t*)(p.ws + WS_KTRT) + (size_t)(b * 512 + h * 64) * 256;
  const bf16_t* VT = (const bf16_t*)(p.ws + WS_VTRT) + (size_t)(b * 512 + h * 64) * 256;
  const float lgf = log1pf(-expf(p.in[25][l * 8 + h]));
  const float lgb = log1pf(-expf(p.in[26][l * 8 + h]));
  f32x4 af[4], ab[4];
#pragma unroll
  for (int nt = 0; nt < 4; ++nt) { af[nt] = f32x4{0.f, 0.f, 0.f, 0.f}; ab[nt] = f32x4{0.f, 0.f, 0.f, 0.f}; }
  for (int ks = 0; ks < 8; ++ks) {
    const int t0 = ks * 32 + fq * 8;
    bf16x8 kraw = *(const bf16x8*)(KT + (size_t)(wid * 16 + fr) * 256 + t0);
    bf16x8 kf, kb;
#pragma unroll
    for (int j = 0; j < 8; ++j) {
      float kv = bfs2f(kraw[j]);
      int t = t0 + j;
      kf[j] = (short)f2bf(kv * __expf(lgf * (float)(255 - t)));
      kb[j] = (short)f2bf(kv * __expf(lgb * (float)t));
    }
#pragma unroll
    for (int nt = 0; nt < 4; ++nt) {
      bf16x8 vb = *(const bf16x8*)(VT + (size_t)(nt * 16 + fr) * 256 + t0);
      af[nt] = MFMA16(kf, vb, af[nt]);
      ab[nt] = MFMA16(kb, vb, ab[nt]);
    }
  }
  float* of = p.out + O_RF + ((size_t)((b * 4 + l) * 8 + h)) * 4096;
  float* ob = p.out + O_RB + ((size_t)((b * 4 + l) * 8 + h)) * 4096;
#pragma unroll
  for (int nt = 0; nt < 4; ++nt)
#pragma unroll
    for (int i = 0; i < 4; ++i) {
      int dk = wid * 16 + fq * 4 + i, dv = nt * 16 + fr;
      of[dk * 64 + dv] = af[nt][i];
      ob[dk * 64 + dv] = ab[nt][i];
    }
}

DI void lru_gates_item(const P& p, int l, int chunk, int n, char* smem) {
  float* XDf = (float*)smem;
  bf16_t* XDb = (bf16_t*)(XDf + 4096);
  const int tid = otid(), lane = tid & 63, wid = tid >> 6, fr = lane & 15, fq = lane >> 4;
  const int row0 = chunk * 64;
  const bool latent = row0 >= NCTX;
  const int T = latent ? 2048 : 256;
  const int tseq0 = latent ? ((row0 - NCTX) & 2047) : (row0 & 255);
  const bf16_t* Z = (const bf16_t*)(p.ws + WS_Z);
  const bf16_t* WL = (const bf16_t*)(p.ws + WS_WLRU);
  bf16_t* LA = (bf16_t*)(p.ws + WS_LA);
  bf16_t* LU = (bf16_t*)(p.ws + WS_LU);
  const int ch0 = n * 64;
  {
    const float cw0 = p.in[28][(l * 4 + 0) * 512 + ch0 + lane];
    const float cw1 = p.in[28][(l * 4 + 1) * 512 + ch0 + lane];
    const float cw2 = p.in[28][(l * 4 + 2) * 512 + ch0 + lane];
    const float cw3 = p.in[28][(l * 4 + 3) * 512 + ch0 + lane];
    const float cb = p.in[29][l * 512 + ch0 + lane];
    const bf16_t* xcol = Z + (size_t)row0 * ZLD + ZC_LRX + ch0 + lane;
    const int t0 = wid * 16;
    auto ld = [&](int tl) -> float {
      int ts = tseq0 + tl;
      return (ts < 0 || ts >= T) ? 0.f : bf2f(xcol[(ptrdiff_t)tl * ZLD]);
    };
    float xm1 = ld(t0 - 1), x0 = ld(t0), x1 = ld(t0 + 1);
#pragma unroll
    for (int i = 0; i < 16; ++i) {
      float x2 = ld(t0 + i + 2);
      float xd = cw0 * xm1 + cw1 * x0 + cw2 * x1 + cw3 * x2 + cb;
      XDf[(t0 + i) * 64 + lane] = xd;
      XDb[(t0 + i) * LDT + lane] = f2bf(xd);
      xm1 = x0; x0 = x1; x1 = x2;
    }
  }
  __syncthreads();
  bf16x8 af[2];
#pragma unroll
  for (int ks = 0; ks < 2; ++ks) af[ks] = *(const bf16x8*)(XDb + (wid * 16 + fr) * LDT + ks * 32 + fq * 8);
#pragma unroll 1
  for (int dir = 0; dir < 2; ++dir) {
    const float* bav = (dir == 0 ? p.in[31] : p.in[36]) + l * 512 + ch0;
    const float* bxv = (dir == 0 ? p.in[33] : p.in[38]) + l * 512 + ch0;
    const float* lamv = (dir == 0 ? p.in[34] : p.in[39]) + l * 512 + ch0;
#pragma unroll
    for (int et = 0; et < 4; ++et) {
      f32x4 da = {0.f, 0.f, 0.f, 0.f}, dx = {0.f, 0.f, 0.f, 0.f};
#pragma unroll
      for (int ks = 0; ks < 2; ++ks) {
        bf16x8 wa = *(const bf16x8*)(WL + (size_t)((dir * 2 + 0) * 8 + n) * 4096 + (et * 16 + fr) * 64 + ks * 32 + fq * 8);
        bf16x8 wx = *(const bf16x8*)(WL + (size_t)((dir * 2 + 1) * 8 + n) * 4096 + (et * 16 + fr) * 64 + ks * 32 + fq * 8);
        da = MFMA16(af[ks], wa, da);
        dx = MFMA16(af[ks], wx, dx);
      }
      const int e = et * 16 + fr;
      const float ba_ = bav[e], bx_ = bxv[e];
      const float sp = log1pf(expf(-lamv[e]));
      float lav[4], uv[4];
#pragma unroll
      for (int i = 0; i < 4; ++i) {
        int tl = wid * 16 + fq * 4 + i;
        float rg = sigmoidf_(da[i] + ba_);
        float ig = sigmoidf_(dx[i] + bx_);
        float la = -8.f * rg * sp;
        lav[i] = la;
        uv[i] = sqrtf(1.f - __expf(2.f * la)) * (ig * XDf[tl * 64 + e]);
      }
      const size_t idx = (size_t)dir * 8388608 + ((size_t)chunk * 512 + ch0 + e) * 64 + wid * 16 + fq * 4;
      *(bf16x4*)(LA + idx) = pack4(lav[0], lav[1], lav[2], lav[3]);
      *(bf16x4*)(LU + idx) = pack4(uv[0], uv[1], uv[2], uv[3]);
    }
  }
  __syncthreads();
}

DI void lru_scan_witem(const P& p, int l, int bglob, int g, int lane) {
  const bool latent = bglob >= 32;
  const int T = latent ? 2048 : 256;
  const int rowbase = latent ? NCTX + (bglob - 32) * 2048 : bglob * 256;
  const int chunk0 = rowbase >> 6, nch = T >> 6;
  const int ch = g * 64 + lane;
  const bf16_t* LA = (const bf16_t*)(p.ws + WS_LA);
  const bf16_t* LU = (const bf16_t*)(p.ws + WS_LU);
  bf16_t* HF = (bf16_t*)(p.ws + WS_HF);
  const bf16_t* LG = (const bf16_t*)(p.ws + WS_LG);
  bf16_t* Y4 = (bf16_t*)(p.ws + WS_Y4);
  {
    float h = latent ? p.in[8][((bglob - 32) * 4 + l) * 512 + ch] : 0.f;
    bf16x8 ca[8], cu[8], na[8], nu[8];
    {
      const size_t b0 = ((size_t)chunk0 * 512 + ch) * 64;
#pragma unroll
      for (int q = 0; q < 8; ++q) { ca[q] = *(const bf16x8*)(LA + b0 + q * 8); cu[q] = *(const bf16x8*)(LU + b0 + q * 8); }
    }
    for (int cc = 0; cc < nch; ++cc) {
      const size_t cbase = ((size_t)(chunk0 + cc) * 512 + ch) * 64;
      const int cn = (cc + 1 < nch) ? cc + 1 : cc;
      const size_t nb = ((size_t)(chunk0 + cn) * 512 + ch) * 64;
#pragma unroll
      for (int q = 0; q < 8; ++q) { na[q] = *(const bf16x8*)(LA + nb + q * 8); nu[q] = *(const bf16x8*)(LU + nb + q * 8); }
#pragma unroll
      for (int q = 0; q < 8; ++q) {
        bf16x8 ho;
#pragma unroll
        for (int j = 0; j < 8; ++j) {
          float a = __expf(bfs2f(ca[q][j]));
          h = a * h + bfs2f(cu[q][j]);
          ho[j] = (short)f2bf(h);
        }
        *(bf16x8*)(HF + cbase + q * 8) = ho;
      }
#pragma unroll
      for (int q = 0; q < 8; ++q) { ca[q] = na[q]; cu[q] = nu[q]; }
    }
    if (!latent) p.out[O_LF + (size_t)(bglob * 4 + l) * 512 + ch] = h;
  }
  {
    float h = latent ? p.in[9][((bglob - 32) * 4 + l) * 512 + ch] : 0.f;
    const bf16_t* LAb = LA + 8388608;
    const bf16_t* LUb = LU + 8388608;
    bf16x8 ca[4], cu[4], chf[4], cg_[4], na[4], nu[4], nhf[4], ng[4];
    const int nb_ = 2 * nch;
    {
      const size_t b0 = ((size_t)(chunk0 + nch - 1) * 512 + ch) * 64 + 32;
#pragma unroll
      for (int q = 0; q < 4; ++q) {
        ca[q] = *(const bf16x8*)(LAb + b0 + q * 8); cu[q] = *(const bf16x8*)(LUb + b0 + q * 8);
        chf[q] = *(const bf16x8*)(HF + b0 + q * 8); cg_[q] = *(const bf16x8*)(LG + b0 + q * 8);
      }
    }
    for (int bi = 0; bi < nb_; ++bi) {
      const int chunk = nch - 1 - (bi >> 1), half = 1 - (bi & 1);
      const int bn = (bi + 1 < nb_) ? bi + 1 : bi;
      const int chunkn = nch - 1 - (bn >> 1), halfn = 1 - (bn & 1);
      const size_t nb = ((size_t)(chunk0 + chunkn) * 512 + ch) * 64 + halfn * 32;
#pragma unroll
      for (int q = 0; q < 4; ++q) {
        na[q] = *(const bf16x8*)(LAb + nb + q * 8); nu[q] = *(const bf16x8*)(LUb + nb + q * 8);
        nhf[q] = *(const bf16x8*)(HF + nb + q * 8); ng[q] = *(const bf16x8*)(LG + nb + q * 8);
      }
      bf16_t* yrow = Y4 + (size_t)(rowbase + chunk * 64 + half * 32) * 2048 + 1536 + ch;
#pragma unroll
      for (int q = 3; q >= 0; --q) {
#pragma unroll
        for (int j = 7; j >= 0; --j) {
          float a = __expf(bfs2f(ca[q][j]));
          h = a * h + bfs2f(cu[q][j]);
          float y = (bfs2f(chf[q][j]) + h) * bfs2f(cg_[q][j]);
          yrow[(size_t)(q * 8 + j) * 2048] = f2bf(y);
        }
      }
#pragma unroll
      for (int q = 0; q < 4; ++q) { ca[q] = na[q]; cu[q] = nu[q]; chf[q] = nhf[q]; cg_[q] = ng[q]; }
    }
    if (!latent) p.out[O_LB + (size_t)(bglob * 4 + l) * 512 + ch] = h;
  }
}

DI int next_item(unsigned* ctr, int* s_item) {
  __syncthreads();
  if (threadIdx.x == 0) *s_item = (int)atomicAdd(ctr, 1u);
  __syncthreads();
  return *s_item;
}
DI void phase_mixa(const P& p, int l, char* smem, int* s_item) {
  unsigned* ctr = (unsigned*)(p.ws + WS_BAR + 14336) + l * 2;
  const int NGRAB = 512 + 512;
  for (;;) {
    int q = next_item(ctr, s_item);
    if (q >= NGRAB) break;
    if (q < 512) { diff_item(p, l, true, q >> 7, (q >> 5) & 3, q & 31, smem); continue; }
    q -= 512;
#pragma unroll 1
    for (int u = 0; u < 4; ++u) { const int g = q * 4 + u; lru_gates_item(p, l, g >> 3, g & 7, smem); }
  }
}
DI void phase_mixb(const P& p, int l, char* smem, int* s_item) {
  unsigned* ctr = (unsigned*)(p.ws + WS_BAR + 14336) + l * 2 + 1;
  const int NGRAB = 72 + 1024 + 1024 + 256 + 256 + 256 + 32;
  for (;;) {
    int q = next_item(ctr, s_item);
    if (q >= NGRAB) break;
    if (q < 72) {
      const int tid = otid(), lane = tid & 63, wid = tid >> 6;
      int bglob, g;
      if (q < 32) {
        if (wid == 0) { bglob = 32 + (q >> 3); g = q & 7; }
        else { int ci = q * 3 + wid - 1; bglob = ci >> 3; g = ci & 7; }
      } else {
        int ci = 96 + (q - 32) * 4 + wid;
        bglob = ci >> 3; g = ci & 7;
      }
      lru_scan_witem(p, l, bglob, g, lane);
      continue;
    }
    q -= 72;
    if (q < 1024) { ret_item(p, l, true, q >> 8, (q >> 5) & 7, q & 31, smem); continue; }
    q -= 1024;
    if (q < 1024) { na_item(p, l, q >> 8, (q >> 5) & 7, q & 31, smem); continue; }
    q -= 1024;
    if (q < 256) {
#pragma unroll 1
      for (int u = 0; u < 2; ++u) { const int g = q * 2 + u; diff_item(p, l, false, g >> 4, (g >> 2) & 3, g & 3, smem); }
      continue;
    }
    q -= 256;
    if (q < 256) {
#pragma unroll 1
      for (int u = 0; u < 4; ++u) { const int g = q * 4 + u; dense_item(p, g >> 5, (g >> 2) & 7, g & 3, smem); }
      continue;
    }
    q -= 256;
    if (q < 256) {
#pragma unroll 1
      for (int u = 0; u < 4; ++u) { const int g = q * 4 + u; ret_item(p, l, false, g >> 5, (g >> 2) & 7, g & 3, smem); }
      continue;
    }
    q -= 256;
#pragma unroll 1
    for (int u = 0; u < 8; ++u) { const int g = q * 8 + u; ret_state_item(p, l, g >> 3, g & 7); }
  }
}

#define XB_TMO 128
#define XB_XCNT(j) (256 + 64 * (j))
#define XB_XSUB(j) (1280 + 64 * (j))
#define XB_XGEN(j) (2304 + 64 * (j))
#define XB_TOP 3328
#define XB_TOPGEN 3392
#define XCD_BAR_WORDS 3456
#define XB_SPIN_CAP (1u << 18)
#define LAS __attribute__((address_space(3)))
DI unsigned xb_ld(unsigned* p) { return __hip_atomic_load(p, __ATOMIC_RELAXED, __HIP_MEMORY_SCOPE_AGENT); }
DI unsigned xb_add(unsigned* p, unsigned v) { return __hip_atomic_fetch_add(p, v, __ATOMIC_RELAXED, __HIP_MEMORY_SCOPE_AGENT); }
DI unsigned xb_xcc_id() { return (unsigned)__builtin_amdgcn_s_getreg((3 << 11) | 20) & 0xFu; }
#define XB_SPIN(cond, bar) do { unsigned _sp = 0; while (cond) { __builtin_amdgcn_s_sleep(1); \
    if ((++_sp & 255u) == 0u) { if (xb_ld(&(bar)[XB_TMO])) break; if (_sp > XB_SPIN_CAP) { atomicAdd(&(bar)[XB_TMO], 1u); break; } } } } while (0)
struct XcdBarrier { unsigned* bar; unsigned x; volatile LAS unsigned* st; };
DI XcdBarrier xcd_barrier_post(unsigned* bar, volatile LAS unsigned* st) {
  XcdBarrier b; b.bar = bar; b.x = xb_xcc_id(); b.st = st;
  if (threadIdx.x == 0) (void)xb_add(&bar[XB_XCNT(b.x)], 1u);
  return b;
}
DI void xcd_barrier_complete(unsigned* bar, unsigned x, unsigned& nloc, unsigned& nx) {
  const unsigned G = gridDim.x * gridDim.y * gridDim.z;
  unsigned sum, cnt, mine, sp = 0u;
  for (;;) {
    sum = 0u; cnt = 0u; mine = 0u;
#pragma unroll
    for (unsigned j = 0; j < 16; ++j) { const unsigned c = xb_ld(&bar[XB_XCNT(j)]); sum += c; cnt += (c > 0u) ? 1u : 0u; mine = (j == x) ? c : mine; }
    if (sum == G) break;
    __builtin_amdgcn_s_sleep(1);
    if ((++sp & 255u) == 0u) { if (xb_ld(&bar[XB_TMO])) break; if (sp > XB_SPIN_CAP) { atomicAdd(&bar[XB_TMO], 1u); break; } }
  }
  nloc = mine > 0u ? mine : 1u; nx = cnt > 0u ? cnt : 1u;
}
DI void xcd_barrier(const XcdBarrier& b) {
  asm volatile("s_waitcnt vmcnt(0)" ::: "memory");
  __syncthreads();
  if (threadIdx.x == 0) {
    unsigned* bar = b.bar;
    __builtin_amdgcn_s_waitcnt(0);
    unsigned nloc = b.st[0], nx = b.st[1];
    if (nloc == 0u) { xcd_barrier_complete(bar, b.x, nloc, nx); b.st[0] = nloc; b.st[1] = nx; }
    const unsigned old = xb_add(&bar[XB_XSUB(b.x)], 1u);
    const unsigned gen = old / nloc;
    if (old + 1u == (gen + 1u) * nloc) {
      __builtin_amdgcn_fence(__ATOMIC_RELEASE, "agent");
      asm volatile("s_waitcnt vmcnt(0)" ::: "memory");
      const unsigned og = xb_add(&bar[XB_TOP], 1u);
      const unsigned tg = og / nx;
      if (og + 1u == (tg + 1u) * nx) xb_add(&bar[XB_TOPGEN], 1u);
      else XB_SPIN(xb_ld(&bar[XB_TOPGEN]) == tg, bar);
      __builtin_amdgcn_fence(__ATOMIC_ACQUIRE, "agent");
      xb_add(&bar[XB_XGEN(b.x)], 1u);
      asm volatile("s_waitcnt vmcnt(0)" ::: "memory");
    } else {
      XB_SPIN(xb_ld(&bar[XB_XGEN(b.x)]) == gen, bar);
      __builtin_amdgcn_fence(__ATOMIC_ACQUIRE, "agent");
      asm volatile("s_waitcnt vmcnt(0)" ::: "memory");
    }
  }
  __syncthreads();
}

enum { PH_INIT = 0, PH_PRE0, PH_GIN, PH_MIXA, PH_MIXB, PH_MERGE, PH_OUT, PH_POSTMIX, PH_FF1, PH_FF2, PH_POSTFFN };

DI void run_phase(const P& p, int ph, int l, char* smem, int* s_item) {
  switch (ph) {
    case PH_INIT:
      phase_mod(p, smem);
      phase_convert(p, 0, smem);
      break;
    case PH_PRE0: phase_row(p, 0, 0); break;
    case PH_GIN: phase_gin(p, l, smem); break;
    case PH_MIXA: phase_mixa(p, l, smem, s_item); break;
    case PH_MIXB: phase_mixb(p, l, smem, s_item); break;
    case PH_MERGE: phase_merge(p, smem); break;
    case PH_OUT:
      phase_gemm_plain<0>((const bf16_t*)(p.ws + WS_H), 1024, (const bf16_t*)(p.ws + WS_WOUT), 1024, (bf16_t*)(p.ws + WS_Y), smem);
      break;
    case PH_POSTMIX: phase_row(p, l, 1); break;
    case PH_FF1:
      phase_gemm_plain<1>((const bf16_t*)(p.ws + WS_H), 1024, (const bf16_t*)(p.ws + WS_W1), 4096, (bf16_t*)(p.ws + WS_U), smem);
      break;
    case PH_FF2:
      phase_gemm_plain<0>((const bf16_t*)(p.ws + WS_U), 4096, (const bf16_t*)(p.ws + WS_W2), 1024, (bf16_t*)(p.ws + WS_Y), smem);
      break;
    case PH_POSTFFN:
      phase_row(p, l, 2);
      if (l < 3) phase_convert(p, l + 1, smem);
      break;
    default: break;
  }
}

DI void decode_step(int step, int& ph, int& l) {
  if (step < 2) { ph = step; l = 0; }
  else { int s = step - 2; l = s / 9; ph = PH_GIN + (s % 9); }
}
constexpr int NSTEPS = 38;

__global__ void __launch_bounds__(256, 2) hybrid_flow_mega(P p) {
  __shared__ __attribute__((aligned(16))) char smem[SMEM_BYTES];
  __shared__ uint4 xb_words;
  __shared__ int s_item;
  cg::grid_group grid = cg::this_grid();
  if (threadIdx.x == 0) xb_words = make_uint4(0u, 0u, 0u, 0u);
  __syncthreads();
  XcdBarrier xb = xcd_barrier_post((unsigned*)(p.ws + WS_BAR), (volatile LAS unsigned*)&xb_words);
  for (int step = 0; step < NSTEPS; ++step) {
    int ph, l;
    decode_step(step, ph, l);
#ifdef PROBE_DUP
    const int reps = (ph == PROBE_DUP) ? 2 : 1;
    for (int rep = 0; rep < reps; ++rep)
#endif
    run_phase(p, ph, l, smem, &s_item);
#ifdef PROBE_CONV
    if (ph == PH_POSTFFN && l < 3) phase_convert(p, l + 1, smem);
#endif
    if (p.ws == nullptr) grid.sync();
    if (step + 1 < NSTEPS) xcd_barrier(xb);
#ifdef PROBE_SYNC
    if (step + 1 < NSTEPS) xcd_barrier(xb);
#endif
  }
}

#if !ONE_LAUNCH
__global__ void __launch_bounds__(256, 2) hybrid_flow_phase(P p, int ph, int l) {
  __shared__ __attribute__((aligned(16))) char smem[SMEM_BYTES];
  __shared__ int s_item;
  run_phase(p, ph, l, smem, &s_item);
}
#endif

extern "C" void kernel_launch(void* const* d_in, const int* in_sizes, int n_in, void* d_out, int out_size, void* d_ws,
                              size_t ws_size, hipStream_t stream) {
  (void)in_sizes; (void)n_in; (void)out_size; (void)ws_size;
  P p{};
  for (int i = 0; i < 44; ++i) p.in[i] = (const float*)d_in[i];
  p.out = (float*)d_out;
  p.ws = (char*)d_ws;
#if ONE_LAUNCH
  static int grid_blocks = 0;
  if (!grid_blocks) {
    int dev = 0, cus = 0, per_cu = 0;
    hipGetDevice(&dev);
    hipDeviceGetAttribute(&cus, hipDeviceAttributeMultiprocessorCount, dev);
    hipOccupancyMaxActiveBlocksPerMultiprocessor(&per_cu, hybrid_flow_mega, 256, 0);
    if (per_cu < 1) per_cu = 1;
    if (per_cu > 2) per_cu = 2;
    grid_blocks = cus * per_cu;
  }
  (void)hipMemsetAsync((char*)d_ws + WS_BAR, 0, 16384, stream);
  void* args[] = {&p};
  hipError_t e = hipLaunchCooperativeKernel((void*)hybrid_flow_mega, dim3(grid_blocks), dim3(256), args, 0, stream);
  if (e != hipSuccess) fprintf(stderr, "cooperative launch failed: %s (grid %d)\n", hipGetErrorString(e), grid_blocks);
#else
  const int grid_blocks = 512;
  for (int step = 0; step < NSTEPS; ++step) {
    int ph, l;
    if (step < 2) { ph = step; l = 0; }
    else { int s = step - 2; l = s / 9; ph = PH_GIN + (s % 9); }
    hipLaunchKernelGGL(hybrid_flow_phase, dim3(grid_blocks), dim3(256), 0, stream, p, ph, l);
  }
#endif
}
```

```cpp
#include <hip/hip_runtime.h>
#include <hip/hip_cooperative_groups.h>
#include <cstdio>
namespace cg = cooperative_groups;

#ifndef ONE_LAUNCH
#define ONE_LAUNCH 1
#endif

typedef unsigned short bf16_t;
using bf16x8 = __attribute__((ext_vector_type(8))) short;
using bf16x4 = __attribute__((ext_vector_type(4))) short;
using f32x4 = __attribute__((ext_vector_type(4))) float;
using u32x4 = __attribute__((ext_vector_type(4))) unsigned;
#define DI __device__ __forceinline__
#define MFMA16(a, b, c) __builtin_amdgcn_mfma_f32_16x16x32_bf16((a), (b), (c), 0, 0, 0)

struct P {
  const float* in[44];
  float* out;
  char* ws;
};

constexpr int D = 1024, NCTX = 8192;
constexpr int ZLD = 4160;
constexpr int ZC_NAQ = 0, ZC_NAK = 512, ZC_DFQ = 1024, ZC_DFK = 1536, ZC_RTQ = 2048, ZC_RTK = 2560, ZC_RTG = 3072,
              ZC_LRX = 3584;
constexpr int LDT = 72;

constexpr size_t WS_WIN = 0;
constexpr size_t WS_WBR = WS_WIN + (size_t)10240 * 1024 * 2;
constexpr size_t WS_WOUT = WS_WBR + (size_t)1024 * 2048 * 2;
constexpr size_t WS_W1 = WS_WOUT + (size_t)1024 * 1024 * 2;
constexpr size_t WS_W2 = WS_W1 + (size_t)4096 * 1024 * 2;
constexpr size_t WS_WLRU = WS_W2 + (size_t)4096 * 1024 * 2;
constexpr size_t WS_CKNA = WS_WLRU + (size_t)32 * 4096 * 2;
constexpr size_t WS_CVNA = WS_CKNA + (size_t)4 * 262144 * 2;
constexpr size_t WS_CKDF = WS_CVNA + (size_t)4 * 262144 * 2;
constexpr size_t WS_CVDF = WS_CKDF + (size_t)4 * 262144 * 2;
constexpr size_t WS_MOD = WS_CVDF + (size_t)4 * 262144 * 2;
constexpr size_t WS_H = WS_MOD + (size_t)4 * 5 * 6144 * 4;
constexpr size_t WS_Y4 = WS_H + (size_t)16384 * 1024 * 2;
constexpr size_t WS_VTNA = WS_Y4 + (size_t)16384 * 2048 * 2;
constexpr size_t WS_VTDF = WS_VTNA + (size_t)16384 * 512 * 2;
constexpr size_t WS_VTRT = WS_VTDF + (size_t)16384 * 512 * 2;
constexpr size_t WS_KTRT = WS_VTRT + (size_t)16384 * 512 * 2;
constexpr size_t WS_Z = WS_KTRT + (size_t)8192 * 512 * 2;
constexpr size_t WS_GF = WS_Z + (size_t)16384 * ZLD * 2;
constexpr size_t WS_Y = WS_Z;
constexpr size_t WS_U = WS_Z + (size_t)16384 * 1024 * 4;
constexpr size_t WS_LA = WS_GF + (size_t)16384 * 4096 * 2;
constexpr size_t WS_LU = WS_LA + (size_t)2 * 16384 * 512 * 2;
constexpr size_t WS_HF = WS_LU + (size_t)2 * 16384 * 512 * 2;
constexpr size_t WS_LG = WS_HF + (size_t)16384 * 512 * 2;
constexpr size_t WS_BAR = WS_LG + (size_t)16384 * 512 * 2;
constexpr size_t WS_END = WS_BAR + 16384;

constexpr size_t O_NAK = 16777216, O_NAV = 33554432, O_DFK = 50331648, O_DFV = 67108864, O_RF = 83886080,
                 O_RB = 88080384, O_LF = 92274688, O_LB = 92340224;
constexpr int VT_LAT = 4194304;

constexpr int SMEM_BYTES = 75776;

DI int otid() {
  int t = threadIdx.x;
  asm volatile("" : "+v"(t));
  return t;
}
typedef __bf16 hwbf2 __attribute__((ext_vector_type(2)));
typedef float f32v2 __attribute__((ext_vector_type(2)));
using u32x2 = __attribute__((ext_vector_type(2))) unsigned;
DI unsigned pk2(float a, float b) {
  f32v2 v = {a, b};
  return __builtin_bit_cast(unsigned, __builtin_convertvector(v, hwbf2));
}
DI bf16_t f2bf(float x) { return (bf16_t)(pk2(x, 0.f) & 0xffffu); }
DI float bf2f(bf16_t b) { return __uint_as_float(((unsigned)b) << 16); }
DI float bfs2f(short b) { return __uint_as_float(((unsigned)(unsigned short)b) << 16); }
DI float wave_sum(float v) {
#pragma unroll
  for (int o = 32; o > 0; o >>= 1) v += __shfl_xor(v, o);
  return v;
}
DI float xmax16(float v) {
  unsigned u = __float_as_uint(v);
  auto r = __builtin_amdgcn_permlane16_swap(u, u, false, false);
  return fmaxf(__uint_as_float(r[0]), __uint_as_float(r[1]));
}
DI float xmax32(float v) {
  unsigned u = __float_as_uint(v);
  auto r = __builtin_amdgcn_permlane32_swap(u, u, false, false);
  return fmaxf(__uint_as_float(r[0]), __uint_as_float(r[1]));
}
DI float xsum16(float v) {
  unsigned u = __float_as_uint(v);
  auto r = __builtin_amdgcn_permlane16_swap(u, u, false, false);
  return __uint_as_float(r[0]) + __uint_as_float(r[1]);
}
DI float xsum32(float v) {
  unsigned u = __float_as_uint(v);
  auto r = __builtin_amdgcn_permlane32_swap(u, u, false, false);
  return __uint_as_float(r[0]) + __uint_as_float(r[1]);
}
DI float sigmoidf_(float x) { return 1.f / (1.f + __expf(-x)); }
DI float gelu_tanh(float x) {
  float u = 0.7978845608028654f * (x + 0.044715f * x * x * x);
  return x * sigmoidf_(2.f * u);
}
DI bf16x8 pack8(const f32x4& a, const f32x4& b) {
  u32x4 r = {pk2(a[0], a[1]), pk2(a[2], a[3]), pk2(b[0], b[1]), pk2(b[2], b[3])};
  return __builtin_bit_cast(bf16x8, r);
}
DI bf16x4 pack4(float a, float b, float c, float d) {
  u32x2 r = {pk2(a, b), pk2(c, d)};
  return __builtin_bit_cast(bf16x4, r);
}

constexpr int GEMM_BUF_BYTES = 32768;
DI int swz_off(int rr, int c4) {
  int ob = rr * 64 + c4 * 16;
  return ob ^ (((ob >> 9) & 1) << 5);
}
template <int NI>
DI void gemm_mainloop(const bf16_t* __restrict__ A, int lda, const bf16_t* __restrict__ Bt, int ldb, int K, int row0,
                      int col0, char* smem, f32x4 (&acc)[4][NI]) {
  const int tid = otid(), lane = tid & 63, wid = tid >> 6;
  const int wm = wid >> 1, wn = wid & 1, fr = lane & 15, fq = lane >> 4;
  const int c4 = tid & 3, kh = (tid >> 3) & 1;
  const int srow = ((tid >> 4) << 1) + ((tid >> 2) & 1);
  const int gk = (kh * 4 + c4) * 8;
  const int soff = ((srow >> 4) * 2 + kh) * 1024 + swz_off(srow & 15, c4);
  const bf16_t* Ag = A + (size_t)(row0 + srow) * lda + gk;
  const bf16_t* Bg = Bt + (size_t)(col0 + srow) * ldb + gk;
  const int aoff = wm * 8192 + swz_off(fr, fq);
  const int boff = 16384 + wn * NI * 2048 + swz_off(fr, fq);
  u32x4 ra[4], rb[NI];
#pragma unroll
  for (int i = 0; i < 4; ++i) ra[i] = *(const u32x4*)(Ag + (size_t)(i * 32) * lda);
#pragma unroll
  for (int i = 0; i < NI; ++i) rb[i] = *(const u32x4*)(Bg + (size_t)(i * 32) * ldb);
#pragma unroll
  for (int i = 0; i < 4; ++i) *(u32x4*)(smem + soff + i * 4096) = ra[i];
#pragma unroll
  for (int i = 0; i < NI; ++i) *(u32x4*)(smem + 16384 + soff + i * 4096) = rb[i];
  __syncthreads();
  const int nk = K >> 6;
  for (int kt = 0; kt < nk; ++kt) {
    const bool more = (kt + 1) < nk;
    if (more) {
      const int k1 = (kt + 1) * 64;
#pragma unroll
      for (int i = 0; i < 4; ++i) ra[i] = *(const u32x4*)(Ag + (size_t)(i * 32) * lda + k1);
#pragma unroll
      for (int i = 0; i < NI; ++i) rb[i] = *(const u32x4*)(Bg + (size_t)(i * 32) * ldb + k1);
    }
    asm volatile("" ::: "memory");
    const char* sb = smem + (kt & 1) * GEMM_BUF_BYTES;
#pragma unroll
    for (int ks = 0; ks < 2; ++ks) {
      bf16x8 af[4], bfr[NI];
#pragma unroll
      for (int mi = 0; mi < 4; ++mi) af[mi] = *(const bf16x8*)(sb + aoff + mi * 2048 + ks * 1024);
#pragma unroll
      for (int ni = 0; ni < NI; ++ni) bfr[ni] = *(const bf16x8*)(sb + boff + ni * 2048 + ks * 1024);
#pragma unroll
      for (int mi = 0; mi < 4; ++mi)
#pragma unroll
        for (int ni = 0; ni < NI; ++ni) acc[mi][ni] = MFMA16(bfr[ni], af[mi], acc[mi][ni]);
    }
    __builtin_amdgcn_sched_barrier(0);
    if (more) {
      char* db = smem + ((kt + 1) & 1) * GEMM_BUF_BYTES;
#pragma unroll
      for (int i = 0; i < 4; ++i) *(u32x4*)(db + soff + i * 4096) = ra[i];
#pragma unroll
      for (int i = 0; i < NI; ++i) *(u32x4*)(db + 16384 + soff + i * 4096) = rb[i];
    }
    __syncthreads();
  }
}

DI void zero_acc(f32x4 (&acc)[4][4]) {
#pragma unroll
  for (int mi = 0; mi < 4; ++mi)
#pragma unroll
    for (int ni = 0; ni < 4; ++ni) acc[mi][ni] = f32x4{0.f, 0.f, 0.f, 0.f};
}
DI bool tile_sched(int iter, int tmt, int ntn, int& tm, int& tn) {
  const int G = gridDim.x, b = blockIdx.x;
  if ((G & 63) == 0 && (ntn & 7) == 0 && (tmt & 7) == 0) {
    const int groups = G >> 6, xg = b % groups, j = b / groups;
    const int srows = tmt >> 3;
    const int s = iter * groups + xg, nsuper = srows * (ntn >> 3);
    if (s >= nsuper) return false;
    tm = (s % srows) * 8 + (j & 7);
    tn = (s / srows) * 8 + (j >> 3);
    return true;
  }
  const int id = b + iter * G;
  if (id >= tmt * ntn) return false;
  tm = id % tmt;
  tn = id / tmt;
  return true;
}

constexpr int G2_STAGE = 24576;
DI void zero_acc2(f32x4 (&acc)[8][4]) {
#pragma unroll
  for (int mi = 0; mi < 8; ++mi)
#pragma unroll
    for (int ni = 0; ni < 4; ++ni) acc[mi][ni] = f32x4{0.f, 0.f, 0.f, 0.f};
}
DI void gemm2_mainloop(const bf16_t* __restrict__ A, int lda, const bf16_t* __restrict__ Bt, int ldb, int K, int row0,
                       int col0, char* smem, f32x4 (&acc)[8][4]) {
  const int tid = otid(), lane = tid & 63, wid = tid >> 6;
  const int wm = wid >> 1, wn = wid & 1, fr = lane & 15, fq = lane >> 4;
  const int c4 = tid & 3, srow = tid >> 2;
  const int soff = (srow >> 4) * 1024 + swz_off(srow & 15, c4);
  const bf16_t* Ag = A + (size_t)(row0 + srow) * lda + c4 * 8;
  const bf16_t* Bg = Bt + (size_t)(col0 + srow) * ldb + c4 * 8;
  const int aoff = wm * 8192 + swz_off(fr, fq);
  const int boff = 16384 + wn * 4096 + swz_off(fr, fq);
  u32x4 raA[4], rbA[2], raB[4], rbB[2];
  const int nk = K >> 5;
  auto gload = [&](int kt, u32x4 (&ra)[4], u32x4 (&rb)[2]) __attribute__((always_inline)) {
    const int k1 = kt * 32;
#pragma unroll
    for (int i = 0; i < 4; ++i) ra[i] = *(const u32x4*)(Ag + (size_t)(i * 64) * lda + k1);
#pragma unroll
    for (int i = 0; i < 2; ++i) rb[i] = *(const u32x4*)(Bg + (size_t)(i * 64) * ldb + k1);
  };
  auto sstore = [&](int st, const u32x4 (&ra)[4], const u32x4 (&rb)[2]) __attribute__((always_inline)) {
    char* db = smem + st * G2_STAGE;
#pragma unroll
    for (int i = 0; i < 4; ++i) *(u32x4*)(db + soff + i * 4096) = ra[i];
#pragma unroll
    for (int i = 0; i < 2; ++i) *(u32x4*)(db + 16384 + soff + i * 4096) = rb[i];
  };
  auto step = [&](int st, int ktn, u32x4 (&ra)[4], u32x4 (&rb)[2], const u32x4 (&wa)[4], const u32x4 (&wb)[2]) __attribute__((always_inline)) {
    const char* sb = smem + st * G2_STAGE;
    bf16x8 bfr[4];
#pragma unroll
    for (int ni = 0; ni < 4; ++ni) bfr[ni] = *(const bf16x8*)(sb + boff + ni * 1024);
    bf16x8 af0 = *(const bf16x8*)(sb + aoff);
    asm volatile("" ::: "memory");
    gload(ktn, ra, rb);
    asm volatile("" ::: "memory");
    __builtin_amdgcn_s_setprio(1);
#pragma unroll
    for (int mi = 0; mi < 4; ++mi) {
      bf16x8 af = af0;
      if (mi > 0) af = *(const bf16x8*)(sb + aoff + mi * 1024);
#pragma unroll
      for (int ni = 0; ni < 4; ++ni) acc[mi][ni] = MFMA16(bfr[ni], af, acc[mi][ni]);
    }
    __builtin_amdgcn_s_setprio(0);
    __builtin_amdgcn_sched_barrier(0);
    sstore(st ^ 1, wa, wb);
    __builtin_amdgcn_sched_barrier(0);
    __builtin_amdgcn_s_setprio(1);
#pragma unroll
    for (int mi = 4; mi < 8; ++mi) {
      bf16x8 af = *(const bf16x8*)(sb + aoff + mi * 1024);
#pragma unroll
      for (int ni = 0; ni < 4; ++ni) acc[mi][ni] = MFMA16(bfr[ni], af, acc[mi][ni]);
    }
    __builtin_amdgcn_s_setprio(0);
  };
  gload(0, raA, rbA);
  gload(1, raB, rbB);
  sstore(0, raA, rbA);
  __syncthreads();
  for (int kt = 0; kt < nk; kt += 2) {
    step(0, kt + 2 < nk ? kt + 2 : nk - 1, raA, rbA, raB, rbB);
    __syncthreads();
    step(1, kt + 3 < nk ? kt + 3 : nk - 1, raB, rbB, raA, rbA);
    __syncthreads();
  }
}

constexpr int G3_STAGE = 16384;
DI void gemm3_mainloop(const bf16_t* __restrict__ A, int lda, const bf16_t* __restrict__ Bt, int ldb, int K, int row0,
                       int col0, char* smem, f32x4 (&acc)[4][4]) {
  const int tid = otid(), lane = tid & 63, wid = tid >> 6;
  const int wm = wid >> 1, wn = wid & 1, fr = lane & 15, fq = lane >> 4;
  const int c4 = tid & 3, srow = tid >> 2;
  const int soff = (srow >> 4) * 1024 + swz_off(srow & 15, c4);
  const bf16_t* Ag = A + (size_t)(row0 + srow) * lda + c4 * 8;
  const bf16_t* Bg = Bt + (size_t)(col0 + srow) * ldb + c4 * 8;
  const int aoff = wm * 4096 + swz_off(fr, fq);
  const int boff = 8192 + wn * 4096 + swz_off(fr, fq);
  u32x4 ra[2], rb[2];
#pragma unroll
  for (int i = 0; i < 2; ++i) { ra[i] = *(const u32x4*)(Ag + (size_t)(i * 64) * lda); rb[i] = *(const u32x4*)(Bg + (size_t)(i * 64) * ldb); }
#pragma unroll
  for (int i = 0; i < 2; ++i) { *(u32x4*)(smem + soff + i * 4096) = ra[i]; *(u32x4*)(smem + 8192 + soff + i * 4096) = rb[i]; }
  __syncthreads();
  const int nk = K >> 5;
  for (int kt = 0; kt < nk; ++kt) {
    const bool more = (kt + 1) < nk;
    if (more) {
      const int k1 = (kt + 1) * 32;
#pragma unroll
      for (int i = 0; i < 2; ++i) { ra[i] = *(const u32x4*)(Ag + (size_t)(i * 64) * lda + k1); rb[i] = *(const u32x4*)(Bg + (size_t)(i * 64) * ldb + k1); }
    }
    asm volatile("" ::: "memory");
    const char* sb = smem + (kt & 1) * G3_STAGE;
    bf16x8 bfr[4];
#pragma unroll
    for (int ni = 0; ni < 4; ++ni) bfr[ni] = *(const bf16x8*)(sb + boff + ni * 1024);
    __builtin_amdgcn_s_setprio(1);
#pragma unroll
    for (int mi = 0; mi < 4; ++mi) {
      bf16x8 af = *(const bf16x8*)(sb + aoff + mi * 1024);
#pragma unroll
      for (int ni = 0; ni < 4; ++ni) acc[mi][ni] = MFMA16(bfr[ni], af, acc[mi][ni]);
    }
    __builtin_amdgcn_s_setprio(0);
    __builtin_amdgcn_sched_barrier(0);
    if (more) {
      char* db = smem + ((kt + 1) & 1) * G3_STAGE;
#pragma unroll
      for (int i = 0; i < 2; ++i) { *(u32x4*)(db + soff + i * 4096) = ra[i]; *(u32x4*)(db + 8192 + soff + i * 4096) = rb[i]; }
    }
    __syncthreads();
  }
}

constexpr int CST_B = 272;
constexpr int CST_T = 528;
template <int MI, int NI, class F>
DI void stage_rowmajor(char* smem, f32x4 (&acc)[MI][NI], int wm, int wn, int fr, int fq, F&& tf) {
#pragma unroll
  for (int mi = 0; mi < MI; ++mi)
#pragma unroll
    for (int ni = 0; ni < NI; ++ni) {
      f32x4 v = tf(acc[mi][ni]);
      *(bf16x4*)(smem + (wm * MI * 16 + mi * 16 + fr) * CST_B + (wn * NI * 16 + ni * 16 + fq * 4) * 2) = pack4(v[0], v[1], v[2], v[3]);
      if (ni == NI - 1) __builtin_amdgcn_sched_barrier(0);
    }
}
template <int MI, int NI, class F>
DI void stage_transposed(char* smem, f32x4 (&acc)[MI][NI], int wm, int wn, int fr, int fq, F&& tf) {
#pragma unroll
  for (int mi = 0; mi < MI; ++mi)
#pragma unroll
    for (int ni = 0; ni < NI; ++ni) {
      f32x4 v = tf(acc[mi][ni]);
      char* base = smem + (wn * NI * 16 + ni * 16 + fq * 4) * CST_T + (wm * MI * 16 + mi * 16 + fr) * 2;
      *(bf16_t*)(base) = f2bf(v[0]);
      *(bf16_t*)(base + CST_T) = f2bf(v[1]);
      *(bf16_t*)(base + 2 * CST_T) = f2bf(v[2]);
      *(bf16_t*)(base + 3 * CST_T) = f2bf(v[3]);
      if (ni == NI - 1) __builtin_amdgcn_sched_barrier(0);
    }
}
template <int LINES, int CPL, int STRIDE, class D>
DI void writeout(const char* smem, int tid, D&& dst) {
#pragma unroll 4
  for (int j = 0; j < LINES * CPL / 256; ++j) {
    const int id = tid + j * 256, line = id / CPL, c = id % CPL;
    u32x4 v = *(const u32x4*)(smem + line * STRIDE + c * 16);
    *(u32x4*)dst(line, c) = v;
  }
}

DI void stage_rowmajor_rope(char* smem, f32x4 (&acc)[8][4], int wm, int wn, int fr, int fq, int rtok) {
  float inv[4];
#pragma unroll
  for (int i = 0; i < 4; ++i) inv[i] = exp2f(-(float)(fq * 4 + i) * 0.8304820237218406f);
#pragma unroll
  for (int mi = 0; mi < 8; ++mi) {
    const int t = (rtok + mi * 16 - NCTX) & 2047;
    const float gr = (float)(t >> 6), gc = (float)(t & 63);
    f32x4 o0, o1, o2, o3;
#pragma unroll
    for (int i = 0; i < 4; ++i) {
      const float sr = __sinf(gr * inv[i]), cr = __cosf(gr * inv[i]);
      const float sc = __sinf(gc * inv[i]), cc = __cosf(gc * inv[i]);
      const float a0 = acc[mi][0][i], a1 = acc[mi][1][i], a2 = acc[mi][2][i], a3 = acc[mi][3][i];
      o0[i] = a0 * cr - a1 * sr;
      o1[i] = a1 * cr + a0 * sr;
      o2[i] = a2 * cc - a3 * sc;
      o3[i] = a3 * cc + a2 * sc;
    }
    char* base = smem + (wm * 128 + mi * 16 + fr) * CST_B + (wn * 64 + fq * 4) * 2;
    *(bf16x4*)(base) = pack4(o0[0], o0[1], o0[2], o0[3]);
    *(bf16x4*)(base + 32) = pack4(o1[0], o1[1], o1[2], o1[3]);
    *(bf16x4*)(base + 64) = pack4(o2[0], o2[1], o2[2], o2[3]);
    *(bf16x4*)(base + 96) = pack4(o3[0], o3[1], o3[2], o3[3]);
    __builtin_amdgcn_sched_barrier(0);
  }
}

DI void epi_in(const P& p, int l, int row0, int col0, f32x4 (&acc)[8][4], char* smem) {
  const int tid_ = otid(), lane = tid_ & 63, wid = tid_ >> 6, wm = wid >> 1, wn = wid & 1, fr = lane & 15, fq = lane >> 4;
  const int seg = col0 >> 9;
  const bool ctx = row0 < NCTX;
  if (seg >= 12) {
    bf16_t* GF = (bf16_t*)(p.ws + WS_GF);
    const int k = (seg - 12) >> 1, tn = ((col0 - 6144) & 1023) >> 7, tm = row0 >> 8;
    bf16_t* dst = GF + (((size_t)k * 64 + tm) * 8 + tn) * 32768 + tid_ * 4;
#pragma unroll
    for (int mi = 0; mi < 8; ++mi)
#pragma unroll
      for (int ni = 0; ni < 4; ++ni)
        *(bf16x4*)(dst + (mi * 4 + ni) * 1024) = pack4(sigmoidf_(acc[mi][ni][0]), sigmoidf_(acc[mi][ni][1]), sigmoidf_(acc[mi][ni][2]), sigmoidf_(acc[mi][ni][3]));
    return;
  }
  const int ctile = col0 & 511;
  const int cseg0 = ctile + wn * 64;
  const int rtok = row0 + wm * 128 + fr;
  if (ctx && (seg == 1 || seg == 2 || seg == 4 || seg == 5)) {
    float* out = p.out;
#pragma unroll
    for (int mi = 0; mi < 8; ++mi) {
      const int r = rtok + mi * 16, b = r >> 8, t = r & 255;
      size_t off;
      if (seg == 1 || seg == 2) {
        const int h = cseg0 >> 6;
        off = (seg == 1 ? O_NAK : O_NAV) + (((size_t)(b * 4 + l) * 8 + h) * 256 + t) * 64;
      } else if (seg == 4) {
        const int comp = cseg0 >> 8, h = (cseg0 >> 6) & 3;
        off = O_DFK + ((((size_t)(b * 4 + l) * 2 + comp) * 4 + h) * 256 + t) * 64;
      } else {
        const int h = cseg0 >> 7;
        off = O_DFV + (((size_t)(b * 4 + l) * 4 + h) * 256 + t) * 128 + (cseg0 & 127);
      }
#pragma unroll
      for (int ni = 0; ni < 4; ++ni) *(f32x4*)(out + off + ni * 16 + fq * 4) = acc[mi][ni];
      __builtin_amdgcn_sched_barrier(0);
    }
  }
  auto tf_none = [](const f32x4& a) -> f32x4 { return a; };
  auto tf_scale = [](const f32x4& a) -> f32x4 { return f32x4{a[0] * 0.125f, a[1] * 0.125f, a[2] * 0.125f, a[3] * 0.125f}; };
  auto tf_silu = [](const f32x4& a) -> f32x4 { return f32x4{a[0] * sigmoidf_(a[0]), a[1] * sigmoidf_(a[1]), a[2] * sigmoidf_(a[2]), a[3] * sigmoidf_(a[3])}; };
  auto tf_gelu = [](const f32x4& a) -> f32x4 { return f32x4{gelu_tanh(a[0]), gelu_tanh(a[1]), gelu_tanh(a[2]), gelu_tanh(a[3])}; };
  const bool rowmajor = !(seg == 2 || seg == 5 || seg == 8 || seg == 11);
  if (rowmajor) {
    int zc;
    switch (seg) {
      case 0: zc = ZC_NAQ; break;
      case 1: zc = ZC_NAK; break;
      case 3: zc = ZC_DFQ; break;
      case 4: zc = ZC_DFK; break;
      case 6: zc = ZC_RTQ; break;
      case 7: zc = ZC_RTK; break;
      case 9: zc = ZC_RTG; break;
      default: zc = ZC_LRX; break;
    }
    if (!ctx && (seg == 3 || seg == 4)) stage_rowmajor_rope(smem, acc, wm, wn, fr, fq, rtok);
    else if (seg == 7) stage_rowmajor<8, 4>(smem, acc, wm, wn, fr, fq, tf_scale);
    else if (seg == 9) stage_rowmajor<8, 4>(smem, acc, wm, wn, fr, fq, tf_silu);
    else stage_rowmajor<8, 4>(smem, acc, wm, wn, fr, fq, tf_none);
    __syncthreads();
    bf16_t* zb = (bf16_t*)(p.ws + WS_Z) + (size_t)row0 * ZLD + zc + ctile;
    writeout<256, 16, CST_B>(smem, tid_, [&](int line, int c) { return zb + (size_t)line * ZLD + c * 8; });
    __syncthreads();
  }
  if (!rowmajor || (seg == 7 && ctx)) {
    if (seg == 7) stage_transposed<8, 4>(smem, acc, wm, wn, fr, fq, tf_scale);
    else if (seg == 11) stage_transposed<8, 4>(smem, acc, wm, wn, fr, fq, tf_gelu);
    else stage_transposed<8, 4>(smem, acc, wm, wn, fr, fq, tf_none);
    __syncthreads();
    if (seg == 11) {
      bf16_t* lg = (bf16_t*)(p.ws + WS_LG) + ((size_t)(row0 >> 6) * 512 + ctile) * 64;
      writeout<128, 32, CST_T>(smem, tid_, [&](int line, int c) { return lg + ((size_t)(c >> 3) * 512 + line) * 64 + (c & 7) * 8; });
    } else {
      bf16_t* tb = (bf16_t*)(p.ws + (seg == 2 ? WS_VTNA : seg == 5 ? WS_VTDF : seg == 8 ? WS_VTRT : WS_KTRT));
      int T;
      if (ctx) { T = 256; tb += ((size_t)((row0 >> 8) * 512 + ctile)) * 256 + (row0 & 255); }
      else { const int rr = row0 - NCTX; T = 2048; tb += (size_t)VT_LAT + ((size_t)((rr >> 11) * 512 + ctile)) * 2048 + (rr & 2047); }
      writeout<128, 32, CST_T>(smem, tid_, [&](int line, int c) { return tb + (size_t)line * T + c * 8; });
    }
    __syncthreads();
  }
}

DI void phase_gin(const P& p, int l, char* smem) {
  const bf16_t* A = (const bf16_t*)(p.ws + WS_H);
  const bf16_t* Bt = (const bf16_t*)(p.ws + WS_WIN);
  for (int it = 0;; ++it) {
    int tm, tn;
    if (!tile_sched(it, 64, 80, tm, tn)) break;
    f32x4 acc[8][4];
    zero_acc2(acc);
    gemm2_mainloop(A, 1024, Bt, 1024, 1024, tm * 256, tn * 128, smem, acc);
    epi_in(p, l, tm * 256, tn * 128, acc, smem);
  }
}

DI void phase_merge(const P& p, char* smem) {
  const bf16_t* Y4 = (const bf16_t*)(p.ws + WS_Y4);
  const bf16_t* WB = (const bf16_t*)(p.ws + WS_WBR);
  const bf16_t* GF = (const bf16_t*)(p.ws + WS_GF);
  bf16_t* G = (bf16_t*)(p.ws + WS_H);
  const int tid_ = otid(), lane = tid_ & 63, wid = tid_ >> 6, wm = wid >> 1, wn = wid & 1, fr = lane & 15, fq = lane >> 4;
  for (int it = 0;; ++it) {
    int tm, tn;
    if (!tile_sched(it, 128, 8, tm, tn)) break;
    const int row0 = tm * 128, col0 = tn * 128;
    f32x4 o[4][4];
    zero_acc(o);
#pragma unroll 1
    for (int k = 0; k < 4; ++k) {
      f32x4 acc[4][4];
      zero_acc(acc);
      gemm3_mainloop(Y4 + k * 512, 2048, WB + k * 512, 2048, 512, row0, col0, smem, acc);
      const bf16_t* gsrc = GF + (((size_t)k * 64 + (tm >> 1)) * 8 + tn) * 32768 + (((tm & 1) * 2 + wn) * 64 + lane) * 4 + (wm * 16) * 1024;
#pragma unroll
      for (int mi = 0; mi < 4; ++mi) {
        bf16x4 gq[4];
#pragma unroll
        for (int ni = 0; ni < 4; ++ni) gq[ni] = *(const bf16x4*)(gsrc + (mi * 4 + ni) * 1024);
#pragma unroll
        for (int ni = 0; ni < 4; ++ni)
#pragma unroll
          for (int i = 0; i < 4; ++i) o[mi][ni][i] += bfs2f(gq[ni][i]) * acc[mi][ni][i];
      }
    }
    stage_rowmajor<4, 4>(smem, o, wm, wn, fr, fq, [](const f32x4& a) { return a; });
    __syncthreads();
    bf16_t* gb = G + (size_t)row0 * 1024 + col0;
    writeout<128, 16, CST_B>(smem, tid_, [&](int line, int c) { return gb + (size_t)line * 1024 + c * 8; });
    __syncthreads();
  }
}

template <int MODE>
DI void phase_gemm_plain(const bf16_t* A, int K, const bf16_t* Bt, int N, bf16_t* outp, char* smem) {
  const int tid_ = otid(), lane = tid_ & 63, wid = tid_ >> 6, wm = wid >> 1, wn = wid & 1, fr = lane & 15, fq = lane >> 4;
  const int ntn = N / 128;
  for (int it = 0;; ++it) {
    int tm, tn;
    if (!tile_sched(it, 64, ntn, tm, tn)) break;
    const int row0 = tm * 256, col0 = tn * 128;
    f32x4 acc[8][4];
    zero_acc2(acc);
    gemm2_mainloop(A, K, Bt, K, K, row0, col0, smem, acc);
    stage_rowmajor<8, 4>(smem, acc, wm, wn, fr, fq, [](const f32x4& a) {
      f32x4 v = a;
      if (MODE == 1) {
        v[0] = fmaxf(v[0], 0.f); v[1] = fmaxf(v[1], 0.f); v[2] = fmaxf(v[2], 0.f); v[3] = fmaxf(v[3], 0.f);
        v[0] *= v[0]; v[1] *= v[1]; v[2] *= v[2]; v[3] *= v[3];
      }
      return v;
    });
    __syncthreads();
    bf16_t* ob = outp + (size_t)row0 * N + col0;
    writeout<256, 16, CST_B>(smem, tid_, [&](int line, int c) { return ob + (size_t)line * N + c * 8; });
    __syncthreads();
  }
}

DI void phase_mod(const P& p, char* smem) {
  float* ssil = (float*)smem;
  float* red = ssil + 5 * 1024;
  const int tid = otid();
  float* MOD = (float*)(p.ws + WS_MOD);
  for (int idx = tid; idx < 5120; idx += 256) {
    int j = idx >> 10, k = idx & 1023;
    float cv = (j == 0) ? p.in[11][k] : p.in[10][(j - 1) * 1024 + k];
    ssil[idx] = cv / (1.f + expf(-cv));
  }
  __syncthreads();
  const int cl = tid & 63, kg = tid >> 6;
  for (int item = blockIdx.x; item < 384; item += gridDim.x) {
    int l = item / 96, cgp = item % 96;
    int col = cgp * 64 + cl;
    const float* W = p.in[12] + (size_t)l * 1024 * 6144 + col;
    float a0 = 0, a1 = 0, a2 = 0, a3 = 0, a4 = 0;
#pragma unroll 8
    for (int k = kg * 256; k < kg * 256 + 256; ++k) {
      float w = W[(size_t)k * 6144];
      a0 += ssil[k] * w;
      a1 += ssil[1024 + k] * w;
      a2 += ssil[2048 + k] * w;
      a3 += ssil[3072 + k] * w;
      a4 += ssil[4096 + k] * w;
    }
    red[(kg * 5 + 0) * 64 + cl] = a0;
    red[(kg * 5 + 1) * 64 + cl] = a1;
    red[(kg * 5 + 2) * 64 + cl] = a2;
    red[(kg * 5 + 3) * 64 + cl] = a3;
    red[(kg * 5 + 4) * 64 + cl] = a4;
    __syncthreads();
    if (kg == 0) {
      float bias = p.in[13][l * 6144 + col];
#pragma unroll
      for (int j = 0; j < 5; ++j) {
        float s = red[(0 * 5 + j) * 64 + cl] + red[(1 * 5 + j) * 64 + cl] + red[(2 * 5 + j) * 64 + cl] + red[(3 * 5 + j) * 64 + cl];
        MOD[(size_t)(l * 5 + j) * 6144 + col] = s + bias;
      }
    }
    __syncthreads();
  }
}

DI void transpose_tile(const float* __restrict__ src, int lds_, bf16_t* __restrict__ dst, int ldd, float* tile) {
  const int tid = otid();
#pragma unroll 4
  for (int i = 0; i < 16; ++i) {
    int idx = tid + i * 256, r = idx >> 6, c = idx & 63;
    tile[r * 65 + c] = src[(size_t)r * lds_ + c];
  }
  __syncthreads();
#pragma unroll 4
  for (int i = 0; i < 16; ++i) {
    int idx = tid + i * 256, c = idx >> 6, r = idx & 63;
    dst[(size_t)c * ldd + r] = f2bf(tile[r * 65 + c]);
  }
  __syncthreads();
}

DI void phase_convert(const P& p, int l, char* smem) {
  float* tile = (float*)smem;
  char* ws = p.ws;
  const int NJ = 6432;
  for (int j = blockIdx.x; j < NJ; j += gridDim.x) {
    int q = j;
    if (q < 2560) {
      int tr = q / 160, tc = q % 160;
      transpose_tile(p.in[18] + (size_t)l * 1024 * 10240 + (size_t)tr * 64 * 10240 + tc * 64, 10240,
                     (bf16_t*)(ws + WS_WIN) + (size_t)tc * 64 * 1024 + tr * 64, 1024, tile);
      continue;
    }
    q -= 2560;
    if (q < 512) {
      int tr = q / 16, tc = q % 16;
      transpose_tile(p.in[40] + (size_t)l * 2048 * 1024 + (size_t)tr * 64 * 1024 + tc * 64, 1024,
                     (bf16_t*)(ws + WS_WBR) + (size_t)tc * 64 * 2048 + tr * 64, 2048, tile);
      continue;
    }
    q -= 512;
    if (q < 256) {
      int tr = q / 16, tc = q % 16;
      transpose_tile(p.in[41] + (size_t)l * 1024 * 1024 + (size_t)tr * 64 * 1024 + tc * 64, 1024,
                     (bf16_t*)(ws + WS_WOUT) + (size_t)tc * 64 * 1024 + tr * 64, 1024, tile);
      continue;
    }
    q -= 256;
    if (q < 1024) {
      int tr = q / 64, tc = q % 64;
      transpose_tile(p.in[42] + (size_t)l * 1024 * 4096 + (size_t)tr * 64 * 4096 + tc * 64, 4096,
                     (bf16_t*)(ws + WS_W1) + (size_t)tc * 64 * 1024 + tr * 64, 1024, tile);
      continue;
    }
    q -= 1024;
    if (q < 1024) {
      int tr = q / 16, tc = q % 16;
      transpose_tile(p.in[43] + (size_t)l * 4096 * 1024 + (size_t)tr * 64 * 1024 + tc * 64, 1024,
                     (bf16_t*)(ws + WS_W2) + (size_t)tc * 64 * 4096 + tr * 64, 4096, tile);
      continue;
    }
    q -= 1024;
    if (q < 32) {
      int type = q >> 3, n = q & 7;
      const float* src = (type == 0 ? p.in[30] : type == 1 ? p.in[32] : type == 2 ? p.in[35] : p.in[37]) + (size_t)(l * 8 + n) * 4096;
      transpose_tile(src, 64, (bf16_t*)(ws + WS_WLRU) + (size_t)(type * 8 + n) * 4096, 64, tile);
      continue;
    }
    q -= 32;
    if (q < 256) {
      int bh = q >> 3, tr = q & 7, b = bh >> 3, h = bh & 7;
      transpose_tile(p.in[3] + ((size_t)((b * 4 + l) * 8 + h)) * 32768 + (size_t)tr * 64 * 64, 64,
                     (bf16_t*)(ws + WS_CVNA) + (size_t)bh * 32768 + tr * 64, 512, tile);
      continue;
    }
    q -= 256;
    if (q < 256) {
      int bh = q >> 4, t2 = q & 15, tr = t2 >> 1, tc = t2 & 1, b = bh >> 2, h = bh & 3;
      transpose_tile(p.in[5] + ((size_t)((b * 4 + l) * 4 + h)) * 65536 + (size_t)tr * 64 * 128 + tc * 64, 128,
                     (bf16_t*)(ws + WS_CVDF) + (size_t)bh * 65536 + (size_t)tc * 64 * 512 + tr * 64, 512, tile);
      continue;
    }
    q -= 256;
    {
      int tensor = q >> 8, b = (q >> 6) & 3, chunk = q & 63;
      const float* src = (tensor == 0 ? p.in[2] : p.in[4]) + (size_t)(b * 4 + l) * 262144 + (size_t)chunk * 4096;
      bf16_t* dst = (bf16_t*)(ws + (tensor == 0 ? WS_CKNA : WS_CKDF)) + (size_t)b * 262144 + (size_t)chunk * 4096;
#pragma unroll
      for (int i = 0; i < 4; ++i) {
        int e = (otid() + i * 256) * 4;
        float4 v = *(const float4*)(src + e);
        *(bf16x4*)(dst + e) = pack4(v.x, v.y, v.z, v.w);
      }
    }
  }
}

DI void phase_row(const P& p, int l, int mode) {
  const int tid_ = otid(), lane = tid_ & 63, wid = tid_ >> 6;
  const float* MOD = (const float*)(p.ws + WS_MOD);
  float* X = p.out;
  bf16_t* H = (bf16_t*)(p.ws + WS_H);
  const bf16_t* Y = (const bf16_t*)(p.ws + WS_Y);
  const bool from_inputs = (mode == 0 || (mode == 1 && l == 0));
  auto xsrc = [&](int r) -> const float* {
    return from_inputs ? ((r < NCTX) ? (p.in[0] + (size_t)r * D) : (p.in[1] + (size_t)(r - NCTX) * D)) : (X + (size_t)r * D);
  };
  int rb = blockIdx.x;
  if (rb >= 4096) return;
  float4 xn[4];
  bf16x4 yn[4];
  {
    const int r = rb * 4 + wid;
    const float* xs = xsrc(r);
#pragma unroll
    for (int j = 0; j < 4; ++j) xn[j] = *(const float4*)(xs + j * 256 + lane * 4);
    if (mode != 0) {
#pragma unroll
      for (int j = 0; j < 4; ++j) yn[j] = *(const bf16x4*)(Y + (size_t)r * D + j * 256 + lane * 4);
    }
  }
  for (; rb < 4096; rb += gridDim.x) {
    const int r = rb * 4 + wid;
    const int mi = r < NCTX ? 0 : 1 + ((r - NCTX) >> 11);
    float4 xv[4], yv[4];
#pragma unroll
    for (int j = 0; j < 4; ++j) { xv[j] = xn[j]; yv[j] = make_float4(bfs2f(yn[j][0]), bfs2f(yn[j][1]), bfs2f(yn[j][2]), bfs2f(yn[j][3])); }
    {
      const int rbn = (rb + (int)gridDim.x < 4096) ? rb + (int)gridDim.x : rb;
      const int rn = rbn * 4 + wid;
      const float* xs = xsrc(rn);
#pragma unroll
      for (int j = 0; j < 4; ++j) xn[j] = *(const float4*)(xs + j * 256 + lane * 4);
      if (mode != 0) {
#pragma unroll
        for (int j = 0; j < 4; ++j) yn[j] = *(const bf16x4*)(Y + (size_t)rn * D + j * 256 + lane * 4);
      }
    }
    if (mode != 0) {
      float ss = 0.f;
#pragma unroll
      for (int j = 0; j < 4; ++j) ss += yv[j].x * yv[j].x + yv[j].y * yv[j].y + yv[j].z * yv[j].z + yv[j].w * yv[j].w;
      ss = wave_sum(ss);
      const float rs = rsqrtf(ss * (1.f / 1024.f) + 1e-6f);
      const float* gpost = (mode == 1 ? p.in[15] : p.in[17]) + l * D;
      const float* gate = MOD + (size_t)(l * 5 + mi) * 6144 + (mode == 1 ? 2048 : 5120);
#pragma unroll
      for (int j = 0; j < 4; ++j) {
        float4 g = *(const float4*)(gpost + j * 256 + lane * 4);
        float4 gt = *(const float4*)(gate + j * 256 + lane * 4);
        xv[j].x += gt.x * (yv[j].x * rs * g.x);
        xv[j].y += gt.y * (yv[j].y * rs * g.y);
        xv[j].z += gt.z * (yv[j].z * rs * g.z);
        xv[j].w += gt.w * (yv[j].w * rs * g.w);
        *(float4*)(X + (size_t)r * D + j * 256 + lane * 4) = xv[j];
      }
    }
    int ln, off_sh, off_sc;
    const float* gpre;
    if (mode == 0) { ln = 0; gpre = p.in[14]; off_sh = 0; off_sc = 1024; }
    else if (mode == 1) { ln = l; gpre = p.in[16] + l * D; off_sh = 3072; off_sc = 4096; }
    else { ln = l + 1; gpre = p.in[14] + (l + 1) * D; off_sh = 0; off_sc = 1024; }
    if (ln < 4) {
      float ss = 0.f;
#pragma unroll
      for (int j = 0; j < 4; ++j) ss += xv[j].x * xv[j].x + xv[j].y * xv[j].y + xv[j].z * xv[j].z + xv[j].w * xv[j].w;
      ss = wave_sum(ss);
      const float rs = rsqrtf(ss * (1.f / 1024.f) + 1e-6f);
      const float* mrow = MOD + (size_t)(ln * 5 + mi) * 6144;
#pragma unroll
      for (int j = 0; j < 4; ++j) {
        int c = j * 256 + lane * 4;
        float4 g = *(const float4*)(gpre + c);
        float4 sc = *(const float4*)(mrow + off_sc + c);
        float4 sh = *(const float4*)(mrow + off_sh + c);
        *(bf16x4*)(H + (size_t)r * D + c) = pack4(xv[j].x * rs * g.x * (1.f + sc.x) + sh.x, xv[j].y * rs * g.y * (1.f + sc.y) + sh.y,
                                                  xv[j].z * rs * g.z * (1.f + sc.z) + sh.z, xv[j].w * rs * g.w * (1.f + sc.w) + sh.w);
      }
    }
  }
}

constexpr int ATT_BUF = 192 * LDT;
DI void qk_scores(const bf16x8 (&qf)[2], const bf16_t* sK, f32x4 (&S)[4], int fr, int fq) {
  __builtin_amdgcn_s_setprio(1);
#pragma unroll
  for (int s = 0; s < 4; ++s) {
    f32x4 z = {0.f, 0.f, 0.f, 0.f};
#pragma unroll
    for (int ks = 0; ks < 2; ++ks) {
      bf16x8 a = *(const bf16x8*)(sK + (16 * s + fr) * LDT + ks * 32 + fq * 8);
      z = MFMA16(a, qf[ks], z);
    }
    S[s] = z;
  }
  __builtin_amdgcn_s_setprio(0);
}
template <int DV>
DI void pv_step(const bf16x8 (&pb)[2], const bf16_t* sV, f32x4 (&O)[DV / 16], int fr, int fq) {
  __builtin_amdgcn_s_setprio(1);
#pragma unroll
  for (int dt = 0; dt < DV / 16; ++dt) {
#pragma unroll
    for (int s2 = 0; s2 < 2; ++s2) {
      const bf16_t* base = sV + (dt * 16 + fr) * LDT + 32 * s2 + 4 * fq;
      bf16x4 lo = *(const bf16x4*)base;
      bf16x4 hi = *(const bf16x4*)(base + 16);
      bf16x8 a = __builtin_shufflevector(lo, hi, 0, 1, 2, 3, 4, 5, 6, 7);
      O[dt] = MFMA16(a, pb[s2], O[dt]);
    }
  }
  __builtin_amdgcn_s_setprio(0);
}
template <int DV>
DI void softmax_pv(f32x4 (&S)[4], const bf16_t* sV, f32x4 (&O)[DV / 16], float& m, float& lsum, int fr, int fq) {
  float tm = -1e30f;
#pragma unroll
  for (int s = 0; s < 4; ++s)
#pragma unroll
    for (int i = 0; i < 4; ++i) tm = fmaxf(tm, S[s][i]);
  tm = xmax32(xmax16(tm));
  const float mn = fmaxf(m, tm);
  const float alpha = __builtin_amdgcn_exp2f(m - mn);
  const bool grew = mn != m;
  m = mn;
  float ps = 0.f;
#pragma unroll
  for (int s = 0; s < 4; ++s)
#pragma unroll
    for (int i = 0; i < 4; ++i) {
      float pv = __builtin_amdgcn_exp2f(S[s][i] - mn);
      S[s][i] = pv;
      ps += pv;
    }
  lsum = lsum * alpha + ps;
  if (__any(grew)) {
#pragma unroll
    for (int dt = 0; dt < DV / 16; ++dt) {
      O[dt][0] *= alpha; O[dt][1] *= alpha; O[dt][2] *= alpha; O[dt][3] *= alpha;
    }
  }
  bf16x8 pb[2];
  pb[0] = pack8(S[0], S[1]);
  pb[1] = pack8(S[2], S[3]);
  pv_step<DV>(pb, sV, O, fr, fq);
}
template <int DV, bool SOFTMAX, int TPS, class TileFn, class ScoreFn>
DI void attn_loop(int ntiles, TileFn&& tile, ScoreFn&& score, const bf16x8 (&qf)[2], f32x4 (&O)[DV / 16], float& m, float& lsum,
                  bf16_t* smem, int tid) {
  const int lane = tid & 63, fr = lane & 15, fq = lane >> 4;
  constexpr int TILE_EL = (64 + DV) * LDT, STAGE_EL = TPS * TILE_EL;
  u32x4 rkA[TPS][2], rvA[TPS][DV / 32], rkB[TPS][2], rvB[TPS][DV / 32];
  const int sr = tid >> 3, sc = (tid & 7) * 8;
  auto gload = [&](int step, u32x4 (&rk)[TPS][2], u32x4 (&rv)[TPS][DV / 32]) __attribute__((always_inline)) {
#pragma unroll
    for (int u = 0; u < TPS; ++u) {
      const bf16_t* Kg; const bf16_t* Vg; int ldk, ldv;
      tile(step * TPS + u, Kg, ldk, Vg, ldv);
#pragma unroll
      for (int i = 0; i < 2; ++i) rk[u][i] = *(const u32x4*)(Kg + (size_t)(sr + i * 32) * ldk + sc);
#pragma unroll
      for (int i = 0; i < DV / 32; ++i) rv[u][i] = *(const u32x4*)(Vg + (size_t)(sr + i * 32) * ldv + sc);
    }
  };
  auto sstore = [&](int buf, const u32x4 (&rk)[TPS][2], const u32x4 (&rv)[TPS][DV / 32]) __attribute__((always_inline)) {
#pragma unroll
    for (int u = 0; u < TPS; ++u) {
      bf16_t* sK = smem + buf * STAGE_EL + u * TILE_EL;
      bf16_t* sV = sK + 64 * LDT;
#pragma unroll
      for (int i = 0; i < 2; ++i) *(u32x4*)(sK + (sr + i * 32) * LDT + sc) = rk[u][i];
#pragma unroll
      for (int i = 0; i < DV / 32; ++i) *(u32x4*)(sV + (sr + i * 32) * LDT + sc) = rv[u][i];
    }
  };
  auto compute = [&](int buf, int step) __attribute__((always_inline)) {
#pragma unroll
    for (int u = 0; u < TPS; ++u) {
      const bf16_t* sK = smem + buf * STAGE_EL + u * TILE_EL;
      const bf16_t* sV = sK + 64 * LDT;
      f32x4 S[4];
      qk_scores(qf, sK, S, fr, fq);
      score(step * TPS + u, S);
      if (SOFTMAX) {
        softmax_pv<DV>(S, sV, O, m, lsum, fr, fq);
      } else {
        bf16x8 pb[2];
        pb[0] = pack8(S[0], S[1]);
        pb[1] = pack8(S[2], S[3]);
        pv_step<DV>(pb, sV, O, fr, fq);
      }
    }
  };
  const int nsteps = ntiles / TPS, last = nsteps - 1;
  if (TPS > 1) {
    gload(0, rkA, rvA);
    sstore(0, rkA, rvA);
    __syncthreads();
    for (int j = 0; j < nsteps; ++j) {
      gload(j + 1 < last ? j + 1 : last, rkA, rvA);
      asm volatile("" ::: "memory");
      compute(j & 1, j);
      __builtin_amdgcn_sched_barrier(0);
      sstore((j + 1) & 1, rkA, rvA);
      __syncthreads();
    }
    return;
  }
  gload(0, rkA, rvA);
  gload(last < 1 ? last : 1, rkB, rvB);
  sstore(0, rkA, rvA);
  __syncthreads();
  for (int j = 0; j < nsteps; j += 2) {
    gload(j + 2 < last ? j + 2 : last, rkA, rvA);
    asm volatile("" ::: "memory");
    compute(0, j);
    __builtin_amdgcn_sched_barrier(0);
    sstore(1, rkB, rvB);
    __syncthreads();
    if (j + 1 >= nsteps) break;
    gload(j + 3 < last ? j + 3 : last, rkB, rvB);
    asm volatile("" ::: "memory");
    compute(1, j + 1);
    __builtin_amdgcn_sched_barrier(0);
    sstore(0, rkA, rvA);
    __syncthreads();
  }
}
DI void scale_scores(f32x4 (&S)[4]) {
#pragma unroll
  for (int s = 0; s < 4; ++s) { S[s][0] *= 0.18033688f; S[s][1] *= 0.18033688f; S[s][2] *= 0.18033688f; S[s][3] *= 0.18033688f; }
}

DI void dense_item(const P& p, int b, int h, int qb, char* smem) {
  const int tid = otid(), lane = tid & 63, wid = tid >> 6, fr = lane & 15, fq = lane >> 4;
  const bf16_t* Z = (const bf16_t*)(p.ws + WS_Z);
  const bf16_t* VT = (const bf16_t*)(p.ws + WS_VTNA) + (size_t)(b * 512 + h * 64) * 256;
  bf16_t* Y4 = (bf16_t*)(p.ws + WS_Y4);
  const int rowbase = b * 256;
  const int qrow = rowbase + qb * 64 + wid * 16 + fr;
  bf16x8 qf[2];
#pragma unroll
  for (int ks = 0; ks < 2; ++ks) qf[ks] = *(const bf16x8*)(Z + (size_t)qrow * ZLD + ZC_NAQ + h * 64 + ks * 32 + fq * 8);
  f32x4 O[4];
#pragma unroll
  for (int dt = 0; dt < 4; ++dt) O[dt] = f32x4{0.f, 0.f, 0.f, 0.f};
  float m = -1e30f, lsum = 0.f;
  const bf16_t* Kb = Z + (size_t)rowbase * ZLD + ZC_NAK + h * 64;
  attn_loop<64, true, 2>(4,
      [&](int j, const bf16_t*& Kg, int& ldk, const bf16_t*& Vg, int& ldv) __attribute__((always_inline)) { Kg = Kb + (size_t)j * 64 * ZLD; ldk = ZLD; Vg = VT + j * 64; ldv = 256; },
      [&](int, f32x4 (&S)[4]) __attribute__((always_inline)) { scale_scores(S); }, qf, O, m, lsum, (bf16_t*)smem, tid);
  const float lt = xsum32(xsum16(lsum));
  const float inv = 1.f / lt;
#pragma unroll
  for (int dt = 0; dt < 4; ++dt)
    *(bf16x4*)(Y4 + (size_t)qrow * 2048 + h * 64 + dt * 16 + fq * 4) = pack4(O[dt][0] * inv, O[dt][1] * inv, O[dt][2] * inv, O[dt][3] * inv);
}

DI void na_item(const P& p, int l, int b, int h, int r, char* smem) {
  float* srpb = (float*)(smem + 73728);
  const int tid = otid(), lane = tid & 63, wid = tid >> 6, fr = lane & 15, fq = lane >> 4;
  const bf16_t* Z = (const bf16_t*)(p.ws + WS_Z);
  const bf16_t* VT = (const bf16_t*)(p.ws + WS_VTNA) + VT_LAT + (size_t)(b * 512 + h * 64) * 2048;
  const bf16_t* CK = (const bf16_t*)(p.ws + WS_CKNA) + (size_t)(b * 8 + h) * 32768;
  const bf16_t* CVT = (const bf16_t*)(p.ws + WS_CVNA) + (size_t)(b * 8 + h) * 32768;
  bf16_t* Y4 = (bf16_t*)(p.ws + WS_Y4);
  for (int i = tid; i < 465; i += 256) srpb[i] = p.in[19][(size_t)(l * 8 + h) * 465 + i];
  const int rowbase = NCTX + b * 2048;
  const int qcol = wid * 16 + fr;
  const int qrow = rowbase + r * 64 + qcol;
  bf16x8 qf[2];
#pragma unroll
  for (int ks = 0; ks < 2; ++ks) qf[ks] = *(const bf16x8*)(Z + (size_t)qrow * ZLD + ZC_NAQ + h * 64 + ks * 32 + fq * 8);
  f32x4 O[4];
#pragma unroll
  for (int dt = 0; dt < 4; ++dt) O[dt] = f32x4{0.f, 0.f, 0.f, 0.f};
  float m = -1e30f, lsum = 0.f;
  int rs = r - 4;
  rs = rs < 0 ? 0 : (rs > 24 ? 24 : rs);
  int cstart = qcol - 8;
  cstart = cstart < 0 ? 0 : (cstart > 48 ? 48 : cstart);
  const bf16_t* Kb = Z + (size_t)rowbase * ZLD + ZC_NAK + h * 64;
  attn_loop<64, true, 2>(16,
      [&](int j, const bf16_t*& Kg, int& ldk, const bf16_t*& Vg, int& ldv) __attribute__((always_inline)) {
        if (j < 8) { Kg = Kb + (size_t)(rs + j) * 64 * ZLD; ldk = ZLD; Vg = VT + (rs + j) * 64; ldv = 2048; }
        else { Kg = CK + (size_t)(j - 8) * 64 * 64; ldk = 64; Vg = CVT + (j - 8) * 64; ldv = 512; }
      },
      [&](int j, f32x4 (&S)[4]) __attribute__((always_inline)) {
        if (j < 8) {
          const int dr = rs + j - r + 7;
#pragma unroll
          for (int s = 0; s < 4; ++s)
#pragma unroll
            for (int i = 0; i < 4; ++i) {
              int kcol = s * 16 + fq * 4 + i;
              bool ok = (kcol >= cstart) && (kcol < cstart + 16);
              int dc = kcol - qcol + 15;
              dc = dc < 0 ? 0 : (dc > 30 ? 30 : dc);
              float bias = srpb[dr * 31 + dc];
              S[s][i] = ok ? (S[s][i] * 0.18033688f + bias * 1.44269504f) : -1e30f;
            }
        } else {
          scale_scores(S);
        }
      },
      qf, O, m, lsum, (bf16_t*)smem, tid);
  const float lt = xsum32(xsum16(lsum));
  const float inv = 1.f / lt;
#pragma unroll
  for (int dt = 0; dt < 4; ++dt)
    *(bf16x4*)(Y4 + (size_t)qrow * 2048 + h * 64 + dt * 16 + fq * 4) = pack4(O[dt][0] * inv, O[dt][1] * inv, O[dt][2] * inv, O[dt][3] * inv);
}

DI void diff_item(const P& p, int l, bool latent, int b, int h, int qb, char* smem) {
  const int tid = otid(), lane = tid & 63, wid = tid >> 6, fr = lane & 15, fq = lane >> 4;
  const bf16_t* Z = (const bf16_t*)(p.ws + WS_Z);
  const int T = latent ? 2048 : 256;
  const int rowbase = latent ? NCTX + b * 2048 : b * 256;
  const bf16_t* VT = (const bf16_t*)(p.ws + WS_VTDF) + (latent ? (size_t)VT_LAT + (size_t)(b * 512 + h * 128) * 2048 : (size_t)(b * 512 + h * 128) * 256);
  const bf16_t* CVT = (const bf16_t*)(p.ws + WS_CVDF) + (size_t)(b * 4 + h) * 65536;
  bf16_t* Y4 = (bf16_t*)(p.ws + WS_Y4);
  const int qrow = rowbase + qb * 64 + wid * 16 + fr;
  float d1 = p.in[20][l * 64 + lane] * p.in[21][l * 64 + lane];
  float d2 = p.in[22][l * 64 + lane] * p.in[23][l * 64 + lane];
  d1 = wave_sum(d1);
  d2 = wave_sum(d2);
  const float lam_init = 0.8f - 0.6f * expf(-0.3f * (float)l);
  const float lam = expf(d1) - expf(d2) + lam_init;
  const int nown = T >> 6;
  const int ntiles = nown + (latent ? 8 : 0);

  f32x4 O1[8];
  f32x4 O[8];
#pragma unroll 1
  for (int comp = 0; comp < 2; ++comp) {
    bf16x8 qf[2];
#pragma unroll
    for (int ks = 0; ks < 2; ++ks) qf[ks] = *(const bf16x8*)(Z + (size_t)qrow * ZLD + ZC_DFQ + comp * 256 + h * 64 + ks * 32 + fq * 8);
#pragma unroll
    for (int dt = 0; dt < 8; ++dt) O[dt] = f32x4{0.f, 0.f, 0.f, 0.f};
    float m = -1e30f, lsum = 0.f;
    const bf16_t* Kb = Z + (size_t)rowbase * ZLD + ZC_DFK + comp * 256 + h * 64;
    const bf16_t* CK = (const bf16_t*)(p.ws + WS_CKDF) + (size_t)((b * 2 + comp) * 4 + h) * 32768;
    attn_loop<128, true, 1>(ntiles,
        [&](int j, const bf16_t*& Kg, int& ldk, const bf16_t*& Vg, int& ldv) __attribute__((always_inline)) {
          if (j < nown) { Kg = Kb + (size_t)j * 64 * ZLD; ldk = ZLD; Vg = VT + j * 64; ldv = T; }
          else { Kg = CK + (size_t)(j - nown) * 64 * 64; ldk = 64; Vg = CVT + (j - nown) * 64; ldv = 512; }
        },
        [&](int, f32x4 (&S)[4]) __attribute__((always_inline)) { scale_scores(S); }, qf, O, m, lsum, (bf16_t*)smem, tid);
    const float lt = xsum32(xsum16(lsum));
    const float inv = 1.f / lt;
    if (comp == 0) {
#pragma unroll
      for (int dt = 0; dt < 8; ++dt) { O1[dt][0] = O[dt][0] * inv; O1[dt][1] = O[dt][1] * inv; O1[dt][2] = O[dt][2] * inv; O1[dt][3] = O[dt][3] * inv; }
    } else {
#pragma unroll
      for (int dt = 0; dt < 8; ++dt) {
        O[dt][0] = O1[dt][0] - lam * (O[dt][0] * inv);
        O[dt][1] = O1[dt][1] - lam * (O[dt][1] * inv);
        O[dt][2] = O1[dt][2] - lam * (O[dt][2] * inv);
        O[dt][3] = O1[dt][3] - lam * (O[dt][3] * inv);
      }
    }
  }
  float ss = 0.f;
#pragma unroll
  for (int dt = 0; dt < 8; ++dt) ss += O[dt][0] * O[dt][0] + O[dt][1] * O[dt][1] + O[dt][2] * O[dt][2] + O[dt][3] * O[dt][3];
  ss = xsum32(xsum16(ss));
  const float rsn = rsqrtf(ss * (1.f / 128.f) + 1e-6f) * (1.f - lam_init);
  const float* gn = p.in[24] + l * 128;
#pragma unroll
  for (int dt = 0; dt < 8; ++dt) {
    int dv = dt * 16 + fq * 4;
    float4 g = *(const float4*)(gn + dv);
    *(bf16x4*)(Y4 + (size_t)qrow * 2048 + 512 + h * 128 + dv) = pack4(O[dt][0] * rsn * g.x, O[dt][1] * rsn * g.y, O[dt][2] * rsn * g.z, O[dt][3] * rsn * g.w);
  }
}

DI void ret_item(const P& p, int l, bool latent, int b, int h, int qb, char* smem) {
  bf16_t* sV0 = (bf16_t*)smem + 64 * LDT;
  const int tid = otid(), lane = tid & 63, wid = tid >> 6, fr = lane & 15, fq = lane >> 4;
  const bf16_t* Z = (const bf16_t*)(p.ws + WS_Z);
  const int T = latent ? 2048 : 256;
  const int rowbase = latent ? NCTX + b * 2048 : b * 256;
  const bf16_t* VT = (const bf16_t*)(p.ws + WS_VTRT) + (latent ? (size_t)VT_LAT + (size_t)(b * 512 + h * 64) * 2048 : (size_t)(b * 512 + h * 64) * 256);
  bf16_t* Y4 = (bf16_t*)(p.ws + WS_Y4);
  const int tq = qb * 64 + wid * 16 + fr;
  const int qrow = rowbase + tq;
  const float lgf = log1pf(-expf(p.in[25][l * 8 + h]));
  const float lgb = log1pf(-expf(p.in[26][l * 8 + h]));
  bf16x8 qf[2];
#pragma unroll
  for (int ks = 0; ks < 2; ++ks) qf[ks] = *(const bf16x8*)(Z + (size_t)qrow * ZLD + ZC_RTQ + h * 64 + ks * 32 + fq * 8);
  f32x4 O[4];
#pragma unroll
  for (int dt = 0; dt < 4; ++dt) O[dt] = f32x4{0.f, 0.f, 0.f, 0.f};
  float mdummy = 0.f, ldummy = 0.f;
  const int dq = wid * 16 + fr;
  float AF[4], BF[4], AB[4], BB[4];
#pragma unroll
  for (int u = 0; u < 4; ++u) {
    AF[u] = __expf(-lgf * (float)(u * 16));
    AB[u] = __expf(lgb * (float)(u * 16));
    BF[u] = __expf(-lgf * (float)(fq * 4 + u));
    BB[u] = __expf(lgb * (float)(fq * 4 + u));
  }
  const bf16_t* Kb = Z + (size_t)rowbase * ZLD + ZC_RTK + h * 64;
  attn_loop<64, false, 2>(T >> 6,
      [&](int j, const bf16_t*& Kg, int& ldk, const bf16_t*& Vg, int& ldv) __attribute__((always_inline)) { Kg = Kb + (size_t)j * 64 * ZLD; ldk = ZLD; Vg = VT + j * 64; ldv = T; },
      [&](int j, f32x4 (&S)[4]) __attribute__((always_inline)) {
        if (j == qb) {
#pragma unroll
          for (int s = 0; s < 4; ++s)
#pragma unroll
            for (int i = 0; i < 4; ++i) {
              int tk = j * 64 + s * 16 + fq * 4 + i;
              int dd = tq - tk;
              float w = dd >= 0 ? __expf(lgf * (float)dd) : __expf(lgb * (float)(-dd));
              S[s][i] *= w;
            }
        } else if (j < qb) {
          const float qfac = __expf(lgf * (float)((qb - j) * 64 + dq));
#pragma unroll
          for (int s = 0; s < 4; ++s) {
            const float f = qfac * AF[s];
            S[s][0] *= f * BF[0]; S[s][1] *= f * BF[1]; S[s][2] *= f * BF[2]; S[s][3] *= f * BF[3];
          }
        } else {
          const float qfac = __expf(lgb * (float)((j - qb) * 64 - dq));
#pragma unroll
          for (int s = 0; s < 4; ++s) {
            const float f = qfac * AB[s];
            S[s][0] *= f * BB[0]; S[s][1] *= f * BB[1]; S[s][2] *= f * BB[2]; S[s][3] *= f * BB[3];
          }
        }
      },
      qf, O, mdummy, ldummy, (bf16_t*)smem, tid);
  if (latent) {
    for (int dir = 0; dir < 2; ++dir) {
      const float* S0 = (dir == 0 ? p.in[6] : p.in[7]) + ((size_t)((b * 4 + l) * 8 + h)) * 4096;
#pragma unroll
      for (int i = 0; i < 4; ++i) {
        int e = (tid + i * 256) * 4;
        float4 v = *(const float4*)(S0 + e);
        int dk = e >> 6, dv = e & 63;
        sV0[(dv + 0) * LDT + dk] = f2bf(v.x);
        sV0[(dv + 1) * LDT + dk] = f2bf(v.y);
        sV0[(dv + 2) * LDT + dk] = f2bf(v.z);
        sV0[(dv + 3) * LDT + dk] = f2bf(v.w);
      }
      __syncthreads();
      const float sc = dir == 0 ? __expf(lgf * (float)(tq + 1)) : __expf(lgb * (float)(T - tq));
      bf16x8 pb[2];
#pragma unroll
      for (int s2 = 0; s2 < 2; ++s2) {
        const bf16_t* qp = Z + (size_t)qrow * ZLD + ZC_RTQ + h * 64 + 32 * s2 + 4 * fq;
        bf16x4 lo = *(const bf16x4*)qp;
        bf16x4 hi = *(const bf16x4*)(qp + 16);
        f32x4 flo = {bfs2f(lo[0]) * sc, bfs2f(lo[1]) * sc, bfs2f(lo[2]) * sc, bfs2f(lo[3]) * sc};
        f32x4 fhi = {bfs2f(hi[0]) * sc, bfs2f(hi[1]) * sc, bfs2f(hi[2]) * sc, bfs2f(hi[3]) * sc};
        pb[s2] = pack8(flo, fhi);
      }
      pv_step<64>(pb, sV0, O, fr, fq);
      __syncthreads();
    }
  }
  float ss = 0.f;
#pragma unroll
  for (int dt = 0; dt < 4; ++dt) ss += O[dt][0] * O[dt][0] + O[dt][1] * O[dt][1] + O[dt][2] * O[dt][2] + O[dt][3] * O[dt][3];
  ss = xsum32(xsum16(ss));
  const float rsn = rsqrtf(ss * (1.f / 64.f) + 1e-6f);
  const float* gn = p.in[27] + l * 512 + h * 64;
#pragma unroll
  for (int dt = 0; dt < 4; ++dt) {
    int dv = dt * 16 + fq * 4;
    float4 g = *(const float4*)(gn + dv);
    bf16x4 sg = *(const bf16x4*)(Z + (size_t)qrow * ZLD + ZC_RTG + h * 64 + dv);
    *(bf16x4*)(Y4 + (size_t)qrow * 2048 + 1024 + h * 64 + dv) =
        pack4(O[dt][0] * rsn * g.x * bfs2f(sg[0]), O[dt][1] * rsn * g.y * bfs2f(sg[1]), O[dt][2] * rsn * g.z * bfs2f(sg[2]), O[dt][3] * rsn * g.w * bfs2f(sg[3]));
  }
}

DI void ret_state_item(const P& p, int l, int b, int h) {
  const int tid_ = otid(), lane = tid_ & 63, wid = tid_ >> 6, fr = lane & 15, fq = lane >> 4;
  const bf16_t* KT = (const bf16_t*)(p.ws + WS_KTRT) + (size_t)(b * 512 + h * 64) * 256;
  const bf16_t* VT = (const bf16_t*)(p.ws + WS_VTRT) + (size_t)(b * 512 + h * 64) * 256;
  const float lgf = log1pf(-expf(p.in[25][l * 8 + h]));
  const float lgb = log1pf(-expf(p.in[26][l * 8 + h]));
  f32x4 af[4], ab[4];
#pragma unroll
  for (int nt = 0; nt < 4; ++nt) { af[nt] = f32x4{0.f, 0.f, 0.f, 0.f}; ab[nt] = f32x4{0.f, 0.f, 0.f, 0.f}; }
  for (int ks = 0; ks < 8; ++ks) {
    const int t0 = ks * 32 + fq * 8;
    bf16x8 kraw = *(const bf16x8*)(KT + (size_t)(wid * 16 + fr) * 256 + t0);
    bf16x8 kf, kb;
#pragma unroll
    for (int j = 0; j < 8; ++j) {
      float kv = bfs2f(kraw[j]);
      int t = t0 + j;
      kf[j] = (short)f2bf(kv * __expf(lgf * (float)(255 - t)));
      kb[j] = (short)f2bf(kv * __expf(lgb * (float)t));
    }
#pragma unroll
    for (int nt = 0; nt < 4; ++nt) {
      bf16x8 vb = *(const bf16x8*)(VT + (size_t)(nt * 16 + fr) * 256 + t0);
      af[nt] = MFMA16(kf, vb, af[nt]);
      ab[nt] = MFMA16(kb, vb, ab[nt]);
    }
  }
  float* of = p.out + O_RF + ((size_t)((b * 4 + l) * 8 + h)) * 4096;
  float* ob = p.out + O_RB + ((size_t)((b * 4 + l) * 8 + h)) * 4096;
#pragma unroll
  for (int nt = 0; nt < 4; ++nt)
#pragma unroll
    for (int i = 0; i < 4; ++i) {
      int dk = wid * 16 + fq * 4 + i, dv = nt * 16 + fr;
      of[dk * 64 + dv] = af[nt][i];
      ob[dk * 64 + dv] = ab[nt][i];
    }
}

DI void lru_gates_item(const P& p, int l, int chunk, int n, char* smem) {
  float* XDf = (float*)smem;
  bf16_t* XDb = (bf16_t*)(XDf + 4096);
  const int tid = otid(), lane = tid & 63, wid = tid >> 6, fr = lane & 15, fq = lane >> 4;
  const int row0 = chunk * 64;
  const bool latent = row0 >= NCTX;
  const int T = latent ? 2048 : 256;
  const int tseq0 = latent ? ((row0 - NCTX) & 2047) : (row0 & 255);
  const bf16_t* Z = (const bf16_t*)(p.ws + WS_Z);
  const bf16_t* WL = (const bf16_t*)(p.ws + WS_WLRU);
  bf16_t* LA = (bf16_t*)(p.ws + WS_LA);
  bf16_t* LU = (bf16_t*)(p.ws + WS_LU);
  const int ch0 = n * 64;
  {
    const float cw0 = p.in[28][(l * 4 + 0) * 512 + ch0 + lane];
    const float cw1 = p.in[28][(l * 4 + 1) * 512 + ch0 + lane];
    const float cw2 = p.in[28][(l * 4 + 2) * 512 + ch0 + lane];
    const float cw3 = p.in[28][(l * 4 + 3) * 512 + ch0 + lane];
    const float cb = p.in[29][l * 512 + ch0 + lane];
    const bf16_t* xcol = Z + (size_t)row0 * ZLD + ZC_LRX + ch0 + lane;
    const int t0 = wid * 16;
    auto ld = [&](int tl) -> float {
      int ts = tseq0 + tl;
      return (ts < 0 || ts >= T) ? 0.f : bf2f(xcol[(ptrdiff_t)tl * ZLD]);
    };
    float xm1 = ld(t0 - 1), x0 = ld(t0), x1 = ld(t0 + 1);
#pragma unroll
    for (int i = 0; i < 16; ++i) {
      float x2 = ld(t0 + i + 2);
      float xd = cw0 * xm1 + cw1 * x0 + cw2 * x1 + cw3 * x2 + cb;
      XDf[(t0 + i) * 64 + lane] = xd;
      XDb[(t0 + i) * LDT + lane] = f2bf(xd);
      xm1 = x0; x0 = x1; x1 = x2;
    }
  }
  __syncthreads();
  bf16x8 af[2];
#pragma unroll
  for (int ks = 0; ks < 2; ++ks) af[ks] = *(const bf16x8*)(XDb + (wid * 16 + fr) * LDT + ks * 32 + fq * 8);
#pragma unroll 1
  for (int dir = 0; dir < 2; ++dir) {
    const float* bav = (dir == 0 ? p.in[31] : p.in[36]) + l * 512 + ch0;
    const float* bxv = (dir == 0 ? p.in[33] : p.in[38]) + l * 512 + ch0;
    const float* lamv = (dir == 0 ? p.in[34] : p.in[39]) + l * 512 + ch0;
#pragma unroll
    for (int et = 0; et < 4; ++et) {
      f32x4 da = {0.f, 0.f, 0.f, 0.f}, dx = {0.f, 0.f, 0.f, 0.f};
#pragma unroll
      for (int ks = 0; ks < 2; ++ks) {
        bf16x8 wa = *(const bf16x8*)(WL + (size_t)((dir * 2 + 0) * 8 + n) * 4096 + (et * 16 + fr) * 64 + ks * 32 + fq * 8);
        bf16x8 wx = *(const bf16x8*)(WL + (size_t)((dir * 2 + 1) * 8 + n) * 4096 + (et * 16 + fr) * 64 + ks * 32 + fq * 8);
        da = MFMA16(af[ks], wa, da);
        dx = MFMA16(af[ks], wx, dx);
      }
      const int e = et * 16 + fr;
      const float ba_ = bav[e], bx_ = bxv[e];
      const float sp = log1pf(expf(-lamv[e]));
      float lav[4], uv[4];
#pragma unroll
      for (int i = 0; i < 4; ++i) {
        int tl = wid * 16 + fq * 4 + i;
        float rg = sigmoidf_(da[i] + ba_);
        float ig = sigmoidf_(dx[i] + bx_);
        float la = -8.f * rg * sp;
        lav[i] = la;
        uv[i] = sqrtf(1.f - __expf(2.f * la)) * (ig * XDf[tl * 64 + e]);
      }
      const size_t idx = (size_t)dir * 8388608 + ((size_t)chunk * 512 + ch0 + e) * 64 + wid * 16 + fq * 4;
      *(bf16x4*)(LA + idx) = pack4(lav[0], lav[1], lav[2], lav[3]);
      *(bf16x4*)(LU + idx) = pack4(uv[0], uv[1], uv[2], uv[3]);
    }
  }
  __syncthreads();
}

DI void lru_scan_witem(const P& p, int l, int bglob, int g, int lane) {
  const bool latent = bglob >= 32;
  const int T = latent ? 2048 : 256;
  const int rowbase = latent ? NCTX + (bglob - 32) * 2048 : bglob * 256;
  const int chunk0 = rowbase >> 6, nch = T >> 6;
  const int ch = g * 64 + lane;
  const bf16_t* LA = (const bf16_t*)(p.ws + WS_LA);
  const bf16_t* LU = (const bf16_t*)(p.ws + WS_LU);
  bf16_t* HF = (bf16_t*)(p.ws + WS_HF);
  const bf16_t* LG = (const bf16_t*)(p.ws + WS_LG);
  bf16_t* Y4 = (bf16_t*)(p.ws + WS_Y4);
  {
    float h = latent ? p.in[8][((bglob - 32) * 4 + l) * 512 + ch] : 0.f;
    bf16x8 ca[8], cu[8], na[8], nu[8];
    {
      const size_t b0 = ((size_t)chunk0 * 512 + ch) * 64;
#pragma unroll
      for (int q = 0; q < 8; ++q) { ca[q] = *(const bf16x8*)(LA + b0 + q * 8); cu[q] = *(const bf16x8*)(LU + b0 + q * 8); }
    }
    for (int cc = 0; cc < nch; ++cc) {
      const size_t cbase = ((size_t)(chunk0 + cc) * 512 + ch) * 64;
      const int cn = (cc + 1 < nch) ? cc + 1 : cc;
      const size_t nb = ((size_t)(chunk0 + cn) * 512 + ch) * 64;
#pragma unroll
      for (int q = 0; q < 8; ++q) { na[q] = *(const bf16x8*)(LA + nb + q * 8); nu[q] = *(const bf16x8*)(LU + nb + q * 8); }
#pragma unroll
      for (int q = 0; q < 8; ++q) {
        bf16x8 ho;
#pragma unroll
        for (int j = 0; j < 8; ++j) {
          float a = __expf(bfs2f(ca[q][j]));
          h = a * h + bfs2f(cu[q][j]);
          ho[j] = (short)f2bf(h);
        }
        *(bf16x8*)(HF + cbase + q * 8) = ho;
      }
#pragma unroll
      for (int q = 0; q < 8; ++q) { ca[q] = na[q]; cu[q] = nu[q]; }
    }
    if (!latent) p.out[O_LF + (size_t)(bglob * 4 + l) * 512 + ch] = h;
  }
  {
    float h = latent ? p.in[9][((bglob - 32) * 4 + l) * 512 + ch] : 0.f;
    const bf16_t* LAb = LA + 8388608;
    const bf16_t* LUb = LU + 8388608;
    bf16x8 ca[4], cu[4], chf[4], cg_[4], na[4], nu[4], nhf[4], ng[4];
    const int nb_ = 2 * nch;
    {
      const size_t b0 = ((size_t)(chunk0 + nch - 1) * 512 + ch) * 64 + 32;
#pragma unroll
      for (int q = 0; q < 4; ++q) {
        ca[q] = *(const bf16x8*)(LAb + b0 + q * 8); cu[q] = *(const bf16x8*)(LUb + b0 + q * 8);
        chf[q] = *(const bf16x8*)(HF + b0 + q * 8); cg_[q] = *(const bf16x8*)(LG + b0 + q * 8);
      }
    }
    for (int bi = 0; bi < nb_; ++bi) {
      const int chunk = nch - 1 - (bi >> 1), half = 1 - (bi & 1);
      const int bn = (bi + 1 < nb_) ? bi + 1 : bi;
      const int chunkn = nch - 1 - (bn >> 1), halfn = 1 - (bn & 1);
      const size_t nb = ((size_t)(chunk0 + chunkn) * 512 + ch) * 64 + halfn * 32;
#pragma unroll
      for (int q = 0; q < 4; ++q) {
        na[q] = *(const bf16x8*)(LAb + nb + q * 8); nu[q] = *(const bf16x8*)(LUb + nb + q * 8);
        nhf[q] = *(const bf16x8*)(HF + nb + q * 8); ng[q] = *(const bf16x8*)(LG + nb + q * 8);
      }
      bf16_t* yrow = Y4 + (size_t)(rowbase + chunk * 64 + half * 32) * 2048 + 1536 + ch;
#pragma unroll
      for (int q = 3; q >= 0; --q) {
#pragma unroll
        for (int j = 7; j >= 0; --j) {
          float a = __expf(bfs2f(ca[q][j]));
          h = a * h + bfs2f(cu[q][j]);
          float y = (bfs2f(chf[q][j]) + h) * bfs2f(cg_[q][j]);
          yrow[(size_t)(q * 8 + j) * 2048] = f2bf(y);
        }
      }
#pragma unroll
      for (int q = 0; q < 4; ++q) { ca[q] = na[q]; cu[q] = nu[q]; chf[q] = nhf[q]; cg_[q] = ng[q]; }
    }
    if (!latent) p.out[O_LB + (size_t)(bglob * 4 + l) * 512 + ch] = h;
  }
}

DI int next_item(unsigned* ctr, int* s_item) {
  __syncthreads();
  if (threadIdx.x == 0) *s_item = (int)atomicAdd(ctr, 1u);
  __syncthreads();
  return *s_item;
}
DI void phase_mixa(const P& p, int l, char* smem, int* s_item) {
  unsigned* ctr = (unsigned*)(p.ws + WS_BAR + 14336) + l * 2;
  const int NGRAB = 512 + 512;
  for (;;) {
    int q = next_item(ctr, s_item);
    if (q >= NGRAB) break;
    if (q < 512) { diff_item(p, l, true, q >> 7, (q >> 5) & 3, q & 31, smem); continue; }
    q -= 512;
#pragma unroll 1
    for (int u = 0; u < 4; ++u) { const int g = q * 4 + u; lru_gates_item(p, l, g >> 3, g & 7, smem); }
  }
}
DI void phase_mixb(const P& p, int l, char* smem, int* s_item) {
  unsigned* ctr = (unsigned*)(p.ws + WS_BAR + 14336) + l * 2 + 1;
  const int NGRAB = 72 + 1024 + 1024 + 256 + 256 + 256 + 32;
  for (;;) {
    int q = next_item(ctr, s_item);
    if (q >= NGRAB) break;
    if (q < 72) {
      const int tid = otid(), lane = tid & 63, wid = tid >> 6;
      int bglob, g;
      if (q < 32) {
        if (wid == 0) { bglob = 32 + (q >> 3); g = q & 7; }
        else { int ci = q * 3 + wid - 1; bglob = ci >> 3; g = ci & 7; }
      } else {
        int ci = 96 + (q - 32) * 4 + wid;
        bglob = ci >> 3; g = ci & 7;
      }
      lru_scan_witem(p, l, bglob, g, lane);
      continue;
    }
    q -= 72;
    if (q < 1024) { ret_item(p, l, true, q >> 8, (q >> 5) & 7, q & 31, smem); continue; }
    q -= 1024;
    if (q < 1024) { na_item(p, l, q >> 8, (q >> 5) & 7, q & 31, smem); continue; }
    q -= 1024;
    if (q < 256) {
#pragma unroll 1
      for (int u = 0; u < 2; ++u) { const int g = q * 2 + u; diff_item(p, l, false, g >> 4, (g >> 2) & 3, g & 3, smem); }
      continue;
    }
    q -= 256;
    if (q < 256) {
#pragma unroll 1
      for (int u = 0; u < 4; ++u) { const int g = q * 4 + u; dense_item(p, g >> 5, (g >> 2) & 7, g & 3, smem); }
      continue;
    }
    q -= 256;
    if (q < 256) {
#pragma unroll 1
      for (int u = 0; u < 4; ++u) { const int g = q * 4 + u; ret_item(p, l, false, g >> 5, (g >> 2) & 7, g & 3, smem); }
      continue;
    }
    q -= 256;
#pragma unroll 1
    for (int u = 0; u < 8; ++u) { const int g = q * 8 + u; ret_state_item(p, l, g >> 3, g & 7); }
  }
}

#define XB_TMO 128
#define XB_XCNT(j) (256 + 64 * (j))
#define XB_XSUB(j) (1280 + 64 * (j))
#define XB_XGEN(j) (2304 + 64 * (j))
#define XB_TOP 3328
#define XB_TOPGEN 3392
#define XCD_BAR_WORDS 3456
#define XB_SPIN_CAP (1u << 18)
#define LAS __attribute__((address_space(3)))
DI unsigned xb_ld(unsigned* p) { return __hip_atomic_load(p, __ATOMIC_RELAXED, __HIP_MEMORY_SCOPE_AGENT); }
DI unsigned xb_add(unsigned* p, unsigned v) { return __hip_atomic_fetch_add(p, v, __ATOMIC_RELAXED, __HIP_MEMORY_SCOPE_AGENT); }
DI unsigned xb_xcc_id() { return (unsigned)__builtin_amdgcn_s_getreg((3 << 11) | 20) & 0xFu; }
#define XB_SPIN(cond, bar) do { unsigned _sp = 0; while (cond) { __builtin_amdgcn_s_sleep(1); \
    if ((++_sp & 255u) == 0u) { if (xb_ld(&(bar)[XB_TMO])) break; if (_sp > XB_SPIN_CAP) { atomicAdd(&(bar)[XB_TMO], 1u); break; } } } } while (0)
struct XcdBarrier { unsigned* bar; unsigned x; volatile LAS unsigned* st; };
DI XcdBarrier xcd_barrier_post(unsigned* bar, volatile LAS unsigned* st) {
  XcdBarrier b; b.bar = bar; b.x = xb_xcc_id(); b.st = st;
  if (threadIdx.x == 0) (void)xb_add(&bar[XB_XCNT(b.x)], 1u);
  return b;
}
DI void xcd_barrier_complete(unsigned* bar, unsigned x, unsigned& nloc, unsigned& nx) {
  const unsigned G = gridDim.x * gridDim.y * gridDim.z;
  unsigned sum, cnt, mine, sp = 0u;
  for (;;) {
    sum = 0u; cnt = 0u; mine = 0u;
#pragma unroll
    for (unsigned j = 0; j < 16; ++j) { const unsigned c = xb_ld(&bar[XB_XCNT(j)]); sum += c; cnt += (c > 0u) ? 1u : 0u; mine = (j == x) ? c : mine; }
    if (sum == G) break;
    __builtin_amdgcn_s_sleep(1);
    if ((++sp & 255u) == 0u) { if (xb_ld(&bar[XB_TMO])) break; if (sp > XB_SPIN_CAP) { atomicAdd(&bar[XB_TMO], 1u); break; } }
  }
  nloc = mine > 0u ? mine : 1u; nx = cnt > 0u ? cnt : 1u;
}
DI void xcd_barrier(const XcdBarrier& b) {
  asm volatile("s_waitcnt vmcnt(0)" ::: "memory");
  __syncthreads();
  if (threadIdx.x == 0) {
    unsigned* bar = b.bar;
    __builtin_amdgcn_s_waitcnt(0);
    unsigned nloc = b.st[0], nx = b.st[1];
    if (nloc == 0u) { xcd_barrier_complete(bar, b.x, nloc, nx); b.st[0] = nloc; b.st[1] = nx; }
    const unsigned old = xb_add(&bar[XB_XSUB(b.x)], 1u);
    const unsigned gen = old / nloc;
    if (old + 1u == (gen + 1u) * nloc) {
      __builtin_amdgcn_fence(__ATOMIC_RELEASE, "agent");
      asm volatile("s_waitcnt vmcnt(0)" ::: "memory");
      const unsigned og = xb_add(&bar[XB_TOP], 1u);
      const unsigned tg = og / nx;
      if (og + 1u == (tg + 1u) * nx) xb_add(&bar[XB_TOPGEN], 1u);
      else XB_SPIN(xb_ld(&bar[XB_TOPGEN]) == tg, bar);
      __builtin_amdgcn_fence(__ATOMIC_ACQUIRE, "agent");
      xb_add(&bar[XB_XGEN(b.x)], 1u);
      asm volatile("s_waitcnt vmcnt(0)" ::: "memory");
    } else {
      XB_SPIN(xb_ld(&bar[XB_XGEN(b.x)]) == gen, bar);
      __builtin_amdgcn_fence(__ATOMIC_ACQUIRE, "agent");
      asm volatile("s_waitcnt vmcnt(0)" ::: "memory");
    }
  }
  __syncthreads();
}

enum { PH_INIT = 0, PH_PRE0, PH_GIN, PH_MIXA, PH_MIXB, PH_MERGE, PH_OUT, PH_POSTMIX, PH_FF1, PH_FF2, PH_POSTFFN };

DI void run_phase(const P& p, int ph, int l, char* smem, int* s_item) {
  switch (ph) {
    case PH_INIT:
      phase_mod(p, smem);
      phase_convert(p, 0, smem);
      break;
    case PH_PRE0: phase_row(p, 0, 0); break;
    case PH_GIN: phase_gin(p, l, smem); break;
    case PH_MIXA: phase_mixa(p, l, smem, s_item); break;
    case PH_MIXB: phase_mixb(p, l, smem, s_item); break;
    case PH_MERGE: phase_merge(p, smem); break;
    case PH_OUT:
      phase_gemm_plain<0>((const bf16_t*)(p.ws + WS_H), 1024, (const bf16_t*)(p.ws + WS_WOUT), 1024, (bf16_t*)(p.ws + WS_Y), smem);
      break;
    case PH_POSTMIX: phase_row(p, l, 1); break;
    case PH_FF1:
      phase_gemm_plain<1>((const bf16_t*)(p.ws + WS_H), 1024, (const bf16_t*)(p.ws + WS_W1), 4096, (bf16_t*)(p.ws + WS_U), smem);
      break;
    case PH_FF2:
      phase_gemm_plain<0>((const bf16_t*)(p.ws + WS_U), 4096, (const bf16_t*)(p.ws + WS_W2), 1024, (bf16_t*)(p.ws + WS_Y), smem);
      break;
    case PH_POSTFFN:
      phase_row(p, l, 2);
      if (l < 3) phase_convert(p, l + 1, smem);
      break;
    default: break;
  }
}

DI void decode_step(int step, int& ph, int& l) {
  if (step < 2) { ph = step; l = 0; }
  else { int s = step - 2; l = s / 9; ph = PH_GIN + (s % 9); }
}
constexpr int NSTEPS = 38;

__global__ void __launch_bounds__(256, 2) hybrid_flow_mega(P p) {
  __shared__ __attribute__((aligned(16))) char smem[SMEM_BYTES];
  __shared__ uint4 xb_words;
  __shared__ int s_item;
  cg::grid_group grid = cg::this_grid();
  if (threadIdx.x == 0) xb_words = make_uint4(0u, 0u, 0u, 0u);
  __syncthreads();
  XcdBarrier xb = xcd_barrier_post((unsigned*)(p.ws + WS_BAR), (volatile LAS unsigned*)&xb_words);
  for (int step = 0; step < NSTEPS; ++step) {
    int ph, l;
    decode_step(step, ph, l);
#ifdef PROBE_DUP
    const int reps = (ph == PROBE_DUP) ? 2 : 1;
    for (int rep = 0; rep < reps; ++rep)
#endif
    run_phase(p, ph, l, smem, &s_item);
#ifdef PROBE_CONV
    if (ph == PH_POSTFFN && l < 3) phase_convert(p, l + 1, smem);
#endif
    if (p.ws == nullptr) grid.sync();
    if (step + 1 < NSTEPS) xcd_barrier(xb);
#ifdef PROBE_SYNC
    if (step + 1 < NSTEPS) xcd_barrier(xb);
#endif
  }
}

#if !ONE_LAUNCH
__global__ void __launch_bounds__(256, 2) hybrid_flow_phase(P p, int ph, int l) {
  __shared__ __attribute__((aligned(16))) char smem[SMEM_BYTES];
  __shared__ int s_item;
  run_phase(p, ph, l, smem, &s_item);
}
#endif

extern "C" void kernel_launch(void* const* d_in, const int* in_sizes, int n_in, void* d_out, int out_size, void* d_ws,
                              size_t ws_size, hipStream_t stream) {
  (void)in_sizes; (void)n_in; (void)out_size; (void)ws_size;
  P p{};
  for (int i = 0; i < 44; ++i) p.in[i] = (const float*)d_in[i];
  p.out = (float*)d_out;
  p.ws = (char*)d_ws;
#if ONE_LAUNCH
  static int grid_blocks = 0;
  if (!grid_blocks) {
    int dev = 0, cus = 0, per_cu = 0;
    hipGetDevice(&dev);
    hipDeviceGetAttribute(&cus, hipDeviceAttributeMultiprocessorCount, dev);
    hipOccupancyMaxActiveBlocksPerMultiprocessor(&per_cu, hybrid_flow_mega, 256, 0);
    if (per_cu < 1) per_cu = 1;
    if (per_cu > 2) per_cu = 2;
    grid_blocks = cus * per_cu;
  }
  (void)hipMemsetAsync((char*)d_ws + WS_BAR, 0, 16384, stream);
  void* args[] = {&p};
  hipError_t e = hipLaunchCooperativeKernel((void*)hybrid_flow_mega, dim3(grid_blocks), dim3(256), args, 0, stream);
  if (e != hipSuccess) fprintf(stderr, "cooperative launch failed: %s (grid %d)\n", hipGetErrorString(e), grid_blocks);
#else
  const int grid_blocks = 512;
  for (int step = 0; step < NSTEPS; ++step) {
    int ph, l;
    if (step < 2) { ph = step; l = 0; }
    else { int s = step - 2; l = s / 9; ph = PH_GIN + (s % 9); }
    hipLaunchKernelGGL(hybrid_flow_phase, dim3(grid_blocks), dim3(256), 0, stream, p, ph, l);
  }
#endif
}
```

```cpp
#include <hip/hip_runtime.h>
#include <hip/hip_cooperative_groups.h>
#include <cstdio>
namespace cg = cooperative_groups;

#ifndef ONE_LAUNCH
#define ONE_LAUNCH 1
#endif

typedef unsigned short bf16_t;
using bf16x8 = __attribute__((ext_vector_type(8))) short;
using bf16x4 = __attribute__((ext_vector_type(4))) short;
using f32x4 = __attribute__((ext_vector_type(4))) float;
using u32x4 = __attribute__((ext_vector_type(4))) unsigned;
#define DI __device__ __forceinline__
#define MFMA16(a, b, c) __builtin_amdgcn_mfma_f32_16x16x32_bf16((a), (b), (c), 0, 0, 0)

struct P {
  const float* in[44];
  float* out;
  char* ws;
};

constexpr int D = 1024, NCTX = 8192;
constexpr int ZLD = 4160;
constexpr int ZC_NAQ = 0, ZC_NAK = 512, ZC_DFQ = 1024, ZC_DFK = 1536, ZC_RTQ = 2048, ZC_RTK = 2560, ZC_RTG = 3072,
              ZC_LRX = 3584;
constexpr int LDT = 72;

constexpr size_t WS_WIN = 0;
constexpr size_t WS_WBR = WS_WIN + (size_t)10240 * 1024 * 2;
constexpr size_t WS_WOUT = WS_WBR + (size_t)1024 * 2048 * 2;
constexpr size_t WS_W1 = WS_WOUT + (size_t)1024 * 1024 * 2;
constexpr size_t WS_W2 = WS_W1 + (size_t)4096 * 1024 * 2;
constexpr size_t WS_WLRU = WS_W2 + (size_t)4096 * 1024 * 2;
constexpr size_t WS_CKNA = WS_WLRU + (size_t)32 * 4096 * 2;
constexpr size_t WS_CVNA = WS_CKNA + (size_t)4 * 262144 * 2;
constexpr size_t WS_CKDF = WS_CVNA + (size_t)4 * 262144 * 2;
constexpr size_t WS_CVDF = WS_CKDF + (size_t)4 * 262144 * 2;
constexpr size_t WS_MOD = WS_CVDF + (size_t)4 * 262144 * 2;
constexpr size_t WS_H = WS_MOD + (size_t)4 * 5 * 6144 * 4;
constexpr size_t WS_Y4 = WS_H + (size_t)16384 * 1024 * 2;
constexpr size_t WS_VTNA = WS_Y4 + (size_t)16384 * 2048 * 2;
constexpr size_t WS_VTDF = WS_VTNA + (size_t)16384 * 512 * 2;
constexpr size_t WS_VTRT = WS_VTDF + (size_t)16384 * 512 * 2;
constexpr size_t WS_KTRT = WS_VTRT + (size_t)16384 * 512 * 2;
constexpr size_t WS_Z = WS_KTRT + (size_t)8192 * 512 * 2;
constexpr size_t WS_GF = WS_Z + (size_t)16384 * ZLD * 2;
constexpr size_t WS_Y = WS_Z;
constexpr size_t WS_U = WS_Z + (size_t)16384 * 1024 * 4;
constexpr size_t WS_LA = WS_GF + (size_t)16384 * 4096 * 2;
constexpr size_t WS_LU = WS_LA + (size_t)2 * 16384 * 512 * 2;
constexpr size_t WS_HF = WS_LU + (size_t)2 * 16384 * 512 * 2;
constexpr size_t WS_LG = WS_HF + (size_t)16384 * 512 * 2;
constexpr size_t WS_BAR = WS_LG + (size_t)16384 * 512 * 2;
constexpr size_t WS_END = WS_BAR + 16384;

constexpr size_t O_NAK = 16777216, O_NAV = 33554432, O_DFK = 50331648, O_DFV = 67108864, O_RF = 83886080,
                 O_RB = 88080384, O_LF = 92274688, O_LB = 92340224;
constexpr int VT_LAT = 4194304;

constexpr int SMEM_BYTES = 75776;

DI int otid() {
  int t = threadIdx.x;
  asm volatile("" : "+v"(t));
  return t;
}
typedef __bf16 hwbf2 __attribute__((ext_vector_type(2)));
typedef float f32v2 __attribute__((ext_vector_type(2)));
using u32x2 = __attribute__((ext_vector_type(2))) unsigned;
DI unsigned pk2(float a, float b) {
  f32v2 v = {a, b};
  return __builtin_bit_cast(unsigned, __builtin_convertvector(v, hwbf2));
}
DI bf16_t f2bf(float x) { return (bf16_t)(pk2(x, 0.f) & 0xffffu); }
DI float bf2f(bf16_t b) { return __uint_as_float(((unsigned)b) << 16); }
DI float bfs2f(short b) { return __uint_as_float(((unsigned)(unsigned short)b) << 16); }
DI float wave_sum(float v) {
#pragma unroll
  for (int o = 32; o > 0; o >>= 1) v += __shfl_xor(v, o);
  return v;
}
DI float xmax16(float v) {
  unsigned u = __float_as_uint(v);
  auto r = __builtin_amdgcn_permlane16_swap(u, u, false, false);
  return fmaxf(__uint_as_float(r[0]), __uint_as_float(r[1]));
}
DI float xmax32(float v) {
  unsigned u = __float_as_uint(v);
  auto r = __builtin_amdgcn_permlane32_swap(u, u, false, false);
  return fmaxf(__uint_as_float(r[0]), __uint_as_float(r[1]));
}
DI float xsum16(float v) {
  unsigned u = __float_as_uint(v);
  auto r = __builtin_amdgcn_permlane16_swap(u, u, false, false);
  return __uint_as_float(r[0]) + __uint_as_float(r[1]);
}
DI float xsum32(float v) {
  unsigned u = __float_as_uint(v);
  auto r = __builtin_amdgcn_permlane32_swap(u, u, false, false);
  return __uint_as_float(r[0]) + __uint_as_float(r[1]);
}
DI float sigmoidf_(float x) { return 1.f / (1.f + __expf(-x)); }
DI float gelu_tanh(float x) {
  float u = 0.7978845608028654f * (x + 0.044715f * x * x * x);
  return x * sigmoidf_(2.f * u);
}
DI bf16x8 pack8(const f32x4& a, const f32x4& b) {
  u32x4 r = {pk2(a[0], a[1]), pk2(a[2], a[3]), pk2(b[0], b[1]), pk2(b[2], b[3])};
  return __builtin_bit_cast(bf16x8, r);
}
DI bf16x4 pack4(float a, float b, float c, float d) {
  u32x2 r = {pk2(a, b), pk2(c, d)};
  return __builtin_bit_cast(bf16x4, r);
}

constexpr int GEMM_BUF_BYTES = 32768;
DI int swz_off(int rr, int c4) {
  int ob = rr * 64 + c4 * 16;
  return ob ^ (((ob >> 9) & 1) << 5);
}
template <int NI>
DI void gemm_mainloop(const bf16_t* __restrict__ A, int lda, const bf16_t* __restrict__ Bt, int ldb, int K, int row0,
                      int col0, char* smem, f32x4 (&acc)[4][NI]) {
  const int tid = otid(), lane = tid & 63, wid = tid >> 6;
  const int wm = wid >> 1, wn = wid & 1, fr = lane & 15, fq = lane >> 4;
  const int c4 = tid & 3, kh = (tid >> 3) & 1;
  const int srow = ((tid >> 4) << 1) + ((tid >> 2) & 1);
  const int gk = (kh * 4 + c4) * 8;
  const int soff = ((srow >> 4) * 2 + kh) * 1024 + swz_off(srow & 15, c4);
  const bf16_t* Ag = A + (size_t)(row0 + srow) * lda + gk;
  const bf16_t* Bg = Bt + (size_t)(col0 + srow) * ldb + gk;
  const int aoff = wm * 8192 + swz_off(fr, fq);
  const int boff = 16384 + wn * NI * 2048 + swz_off(fr, fq);
  u32x4 ra[4], rb[NI];
#pragma unroll
  for (int i = 0; i < 4; ++i) ra[i] = *(const u32x4*)(Ag + (size_t)(i * 32) * lda);
#pragma unroll
  for (int i = 0; i < NI; ++i) rb[i] = *(const u32x4*)(Bg + (size_t)(i * 32) * ldb);
#pragma unroll
  for (int i = 0; i < 4; ++i) *(u32x4*)(smem + soff + i * 4096) = ra[i];
#pragma unroll
  for (int i = 0; i < NI; ++i) *(u32x4*)(smem + 16384 + soff + i * 4096) = rb[i];
  __syncthreads();
  const int nk = K >> 6;
  for (int kt = 0; kt < nk; ++kt) {
    const bool more = (kt + 1) < nk;
    if (more) {
      const int k1 = (kt + 1) * 64;
#pragma unroll
      for (int i = 0; i < 4; ++i) ra[i] = *(const u32x4*)(Ag + (size_t)(i * 32) * lda + k1);
#pragma unroll
      for (int i = 0; i < NI; ++i) rb[i] = *(const u32x4*)(Bg + (size_t)(i * 32) * ldb + k1);
    }
    asm volatile("" ::: "memory");
    const char* sb = smem + (kt & 1) * GEMM_BUF_BYTES;
#pragma unroll
    for (int ks = 0; ks < 2; ++ks) {
      bf16x8 af[4], bfr[NI];
#pragma unroll
      for (int mi = 0; mi < 4; ++mi) af[mi] = *(const bf16x8*)(sb + aoff + mi * 2048 + ks * 1024);
#pragma unroll
      for (int ni = 0; ni < NI; ++ni) bfr[ni] = *(const bf16x8*)(sb + boff + ni * 2048 + ks * 1024);
#pragma unroll
      for (int mi = 0; mi < 4; ++mi)
#pragma unroll
        for (int ni = 0; ni < NI; ++ni) acc[mi][ni] = MFMA16(bfr[ni], af[mi], acc[mi][ni]);
    }
    __builtin_amdgcn_sched_barrier(0);
    if (more) {
      char* db = smem + ((kt + 1) & 1) * GEMM_BUF_BYTES;
#pragma unroll
      for (int i = 0; i < 4; ++i) *(u32x4*)(db + soff + i * 4096) = ra[i];
#pragma unroll
      for (int i = 0; i < NI; ++i) *(u32x4*)(db + 16384 + soff + i * 4096) = rb[i];
    }
    __syncthreads();
  }
}

DI void zero_acc(f32x4 (&acc)[4][4]) {
#pragma unroll
  for (int mi = 0; mi < 4; ++mi)
#pragma unroll
    for (int ni = 0; ni < 4; ++ni) acc[mi][ni] = f32x4{0.f, 0.f, 0.f, 0.f};
}
DI bool tile_sched(int iter, int tmt, int ntn, int& tm, int& tn) {
  const int G = gridDim.x, b = blockIdx.x;
  if ((G & 63) == 0 && (ntn & 7) == 0 && (tmt & 7) == 0) {
    const int groups = G >> 6, xg = b % groups, j = b / groups;
    const int srows = tmt >> 3;
    const int s = iter * groups + xg, nsuper = srows * (ntn >> 3);
    if (s >= nsuper) return false;
    tm = (s % srows) * 8 + (j & 7);
    tn = (s / srows) * 8 + (j >> 3);
    return true;
  }
  const int id = b + iter * G;
  if (id >= tmt * ntn) return false;
  tm = id % tmt;
  tn = id / tmt;
  return true;
}

constexpr int G2_STAGE = 24576;
DI void zero_acc2(f32x4 (&acc)[8][4]) {
#pragma unroll
  for (int mi = 0; mi < 8; ++mi)
#pragma unroll
    for (int ni = 0; ni < 4; ++ni) acc[mi][ni] = f32x4{0.f, 0.f, 0.f, 0.f};
}
DI void gemm2_mainloop(const bf16_t* __restrict__ A, int lda, const bf16_t* __restrict__ Bt, int ldb, int K, int row0,
                       int col0, char* smem, f32x4 (&acc)[8][4]) {
  const int tid = otid(), lane = tid & 63, wid = tid >> 6;
  const int wm = wid >> 1, wn = wid & 1, fr = lane & 15, fq = lane >> 4;
  const int c4 = tid & 3, srow = tid >> 2;
  const int soff = (srow >> 4) * 1024 + swz_off(srow & 15, c4);
  const bf16_t* Ag = A + (size_t)(row0 + srow) * lda + c4 * 8;
  const bf16_t* Bg = Bt + (size_t)(col0 + srow) * ldb + c4 * 8;
  const int aoff = wm * 8192 + swz_off(fr, fq);
  const int boff = 16384 + wn * 4096 + swz_off(fr, fq);
  u32x4 raA[4], rbA[2], raB[4], rbB[2];
  const int nk = K >> 5;
  auto gload = [&](int kt, u32x4 (&ra)[4], u32x4 (&rb)[2]) __attribute__((always_inline)) {
    const int k1 = kt * 32;
#pragma unroll
    for (int i = 0; i < 4; ++i) ra[i] = *(const u32x4*)(Ag + (size_t)(i * 64) * lda + k1);
#pragma unroll
    for (int i = 0; i < 2; ++i) rb[i] = *(const u32x4*)(Bg + (size_t)(i * 64) * ldb + k1);
  };
  auto sstore = [&](int st, const u32x4 (&ra)[4], const u32x4 (&rb)[2]) __attribute__((always_inline)) {
    char* db = smem + st * G2_STAGE;
#pragma unroll
    for (int i = 0; i < 4; ++i) *(u32x4*)(db + soff + i * 4096) = ra[i];
#pragma unroll
    for (int i = 0; i < 2; ++i) *(u32x4*)(db + 16384 + soff + i * 4096) = rb[i];
  };
  auto step = [&](int st, int ktn, u32x4 (&ra)[4], u32x4 (&rb)[2], const u32x4 (&wa)[4], const u32x4 (&wb)[2]) __attribute__((always_inline)) {
    const char* sb = smem + st * G2_STAGE;
    bf16x8 bfr[4];
#pragma unroll
    for (int ni = 0; ni < 4; ++ni) bfr[ni] = *(const bf16x8*)(sb + boff + ni * 1024);
    bf16x8 af0 = *(const bf16x8*)(sb + aoff);
    asm volatile("" ::: "memory");
    gload(ktn, ra, rb);
    asm volatile("" ::: "memory");
    __builtin_amdgcn_s_setprio(1);
#pragma unroll
    for (int mi = 0; mi < 4; ++mi) {
      bf16x8 af = af0;
      if (mi > 0) af = *(const bf16x8*)(sb + aoff + mi * 1024);
#pragma unroll
      for (int ni = 0; ni < 4; ++ni) acc[mi][ni] = MFMA16(bfr[ni], af, acc[mi][ni]);
    }
    __builtin_amdgcn_s_setprio(0);
    __builtin_amdgcn_sched_barrier(0);
    sstore(st ^ 1, wa, wb);
    __builtin_amdgcn_sched_barrier(0);
    __builtin_amdgcn_s_setprio(1);
#pragma unroll
    for (int mi = 4; mi < 8; ++mi) {
      bf16x8 af = *(const bf16x8*)(sb + aoff + mi * 1024);
#pragma unroll
      for (int ni = 0; ni < 4; ++ni) acc[mi][ni] = MFMA16(bfr[ni], af, acc[mi][ni]);
    }
    __builtin_amdgcn_s_setprio(0);
  };
  gload(0, raA, rbA);
  gload(1, raB, rbB);
  sstore(0, raA, rbA);
  __syncthreads();
  for (int kt = 0; kt < nk; kt += 2) {
    step(0, kt + 2 < nk ? kt + 2 : nk - 1, raA, rbA, raB, rbB);
    __syncthreads();
    step(1, kt + 3 < nk ? kt + 3 : nk - 1, raB, rbB, raA, rbA);
    __syncthreads();
  }
}

constexpr int G3_STAGE = 16384;
DI void gemm3_mainloop(const bf16_t* __restrict__ A, int lda, const bf16_t* __restrict__ Bt, int ldb, int K, int row0,
                       int col0, char* smem, f32x4 (&acc)[4][4]) {
  const int tid = otid(), lane = tid & 63, wid = tid >> 6;
  const int wm = wid >> 1, wn = wid & 1, fr = lane & 15, fq = lane >> 4;
  const int c4 = tid & 3, srow = tid >> 2;
  const int soff = (srow >> 4) * 1024 + swz_off(srow & 15, c4);
  const bf16_t* Ag = A + (size_t)(row0 + srow) * lda + c4 * 8;
  const bf16_t* Bg = Bt + (size_t)(col0 + srow) * ldb + c4 * 8;
  const int aoff = wm * 4096 + swz_off(fr, fq);
  const int boff = 8192 + wn * 4096 + swz_off(fr, fq);
  u32x4 ra[2], rb[2];
#pragma unroll
  for (int i = 0; i < 2; ++i) { ra[i] = *(const u32x4*)(Ag + (size_t)(i * 64) * lda); rb[i] = *(const u32x4*)(Bg + (size_t)(i * 64) * ldb); }
#pragma unroll
  for (int i = 0; i < 2; ++i) { *(u32x4*)(smem + soff + i * 4096) = ra[i]; *(u32x4*)(smem + 8192 + soff + i * 4096) = rb[i]; }
  __syncthreads();
  const int nk = K >> 5;
  for (int kt = 0; kt < nk; ++kt) {
    const bool more = (kt + 1) < nk;
    if (more) {
      const int k1 = (kt + 1) * 32;
#pragma unroll
      for (int i = 0; i < 2; ++i) { ra[i] = *(const u32x4*)(Ag + (size_t)(i * 64) * lda + k1); rb[i] = *(const u32x4*)(Bg + (size_t)(i * 64) * ldb + k1); }
    }
    asm volatile("" ::: "memory");
    const char* sb = smem + (kt & 1) * G3_STAGE;
    bf16x8 bfr[4];
#pragma unroll
    for (int ni = 0; ni < 4; ++ni) bfr[ni] = *(const bf16x8*)(sb + boff + ni * 1024);
    __builtin_amdgcn_s_setprio(1);
#pragma unroll
    for (int mi = 0; mi < 4; ++mi) {
      bf16x8 af = *(const bf16x8*)(sb + aoff + mi * 1024);
#pragma unroll
      for (int ni = 0; ni < 4; ++ni) acc[mi][ni] = MFMA16(bfr[ni], af, acc[mi][ni]);
    }
    __builtin_amdgcn_s_setprio(0);
    __builtin_amdgcn_sched_barrier(0);
    if (more) {
      char* db = smem + ((kt + 1) & 1) * G3_STAGE;
#pragma unroll
      for (int i = 0; i < 2; ++i) { *(u32x4*)(db + soff + i * 4096) = ra[i]; *(u32x4*)(db + 8192 + soff + i * 4096) = rb[i]; }
    }
    __syncthreads();
  }
}

constexpr int CST_B = 272;
constexpr int CST_T = 528;
template <int MI, int NI, class F>
DI void stage_rowmajor(char* smem, f32x4 (&acc)[MI][NI], int wm, int wn, int fr, int fq, F&& tf) {
#pragma unroll
  for (int mi = 0; mi < MI; ++mi)
#pragma unroll
    for (int ni = 0; ni < NI; ++ni) {
      f32x4 v = tf(acc[mi][ni]);
      *(bf16x4*)(smem + (wm * MI * 16 + mi * 16 + fr) * CST_B + (wn * NI * 16 + ni * 16 + fq * 4) * 2) = pack4(v[0], v[1], v[2], v[3]);
      if (ni == NI - 1) __builtin_amdgcn_sched_barrier(0);
    }
}
template <int MI, int NI, class F>
DI void stage_transposed(char* smem, f32x4 (&acc)[MI][NI], int wm, int wn, int fr, int fq, F&& tf) {
#pragma unroll
  for (int mi = 0; mi < MI; ++mi)
#pragma unroll
    for (int ni = 0; ni < NI; ++ni) {
      f32x4 v = tf(acc[mi][ni]);
      char* base = smem + (wn * NI * 16 + ni * 16 + fq * 4) * CST_T + (wm * MI * 16 + mi * 16 + fr) * 2;
      *(bf16_t*)(base) = f2bf(v[0]);
      *(bf16_t*)(base + CST_T) = f2bf(v[1]);
      *(bf16_t*)(base + 2 * CST_T) = f2bf(v[2]);
      *(bf16_t*)(base + 3 * CST_T) = f2bf(v[3]);
      if (ni == NI - 1) __builtin_amdgcn_sched_barrier(0);
    }
}
template <int LINES, int CPL, int STRIDE, class D>
DI void writeout(const char* smem, int tid, D&& dst) {
#pragma unroll 4
  for (int j = 0; j < LINES * CPL / 256; ++j) {
    const int id = tid + j * 256, line = id / CPL, c = id % CPL;
    u32x4 v = *(const u32x4*)(smem + line * STRIDE + c * 16);
    *(u32x4*)dst(line, c) = v;
  }
}

DI void stage_rowmajor_rope(char* smem, f32x4 (&acc)[8][4], int wm, int wn, int fr, int fq, int rtok) {
  float inv[4];
#pragma unroll
  for (int i = 0; i < 4; ++i) inv[i] = exp2f(-(float)(fq * 4 + i) * 0.8304820237218406f);
#pragma unroll
  for (int mi = 0; mi < 8; ++mi) {
    const int t = (rtok + mi * 16 - NCTX) & 2047;
    const float gr = (float)(t >> 6), gc = (float)(t & 63);
    f32x4 o0, o1, o2, o3;
#pragma unroll
    for (int i = 0; i < 4; ++i) {
      const float sr = __sinf(gr * inv[i]), cr = __cosf(gr * inv[i]);
      const float sc = __sinf(gc * inv[i]), cc = __cosf(gc * inv[i]);
      const float a0 = acc[mi][0][i], a1 = acc[mi][1][i], a2 = acc[mi][2][i], a3 = acc[mi][3][i];
      o0[i] = a0 * cr - a1 * sr;
      o1[i] = a1 * cr + a0 * sr;
      o2[i] = a2 * cc - a3 * sc;
      o3[i] = a3 * cc + a2 * sc;
    }
    char* base = smem + (wm * 128 + mi * 16 + fr) * CST_B + (wn * 64 + fq * 4) * 2;
    *(bf16x4*)(base) = pack4(o0[0], o0[1], o0[2], o0[3]);
    *(bf16x4*)(base + 32) = pack4(o1[0], o1[1], o1[2], o1[3]);
    *(bf16x4*)(base + 64) = pack4(o2[0], o2[1], o2[2], o2[3]);
    *(bf16x4*)(base + 96) = pack4(o3[0], o3[1], o3[2], o3[3]);
    __builtin_amdgcn_sched_barrier(0);
  }
}

DI void epi_in(const P& p, int l, int row0, int col0, f32x4 (&acc)[8][4], char* smem) {
  const int tid_ = otid(), lane = tid_ & 63, wid = tid_ >> 6, wm = wid >> 1, wn = wid & 1, fr = lane & 15, fq = lane >> 4;
  const int seg = col0 >> 9;
  const bool ctx = row0 < NCTX;
  if (seg >= 12) {
    bf16_t* GF = (bf16_t*)(p.ws + WS_GF);
    const int k = (seg - 12) >> 1, tn = ((col0 - 6144) & 1023) >> 7, tm = row0 >> 8;
    bf16_t* dst = GF + (((size_t)k * 64 + tm) * 8 + tn) * 32768 + tid_ * 4;
#pragma unroll
    for (int mi = 0; mi < 8; ++mi)
#pragma unroll
      for (int ni = 0; ni < 4; ++ni)
        *(bf16x4*)(dst + (mi * 4 + ni) * 1024) = pack4(sigmoidf_(acc[mi][ni][0]), sigmoidf_(acc[mi][ni][1]), sigmoidf_(acc[mi][ni][2]), sigmoidf_(acc[mi][ni][3]));
    return;
  }
  const int ctile = col0 & 511;
  const int cseg0 = ctile + wn * 64;
  const int rtok = row0 + wm * 128 + fr;
  if (ctx && (seg == 1 || seg == 2 || seg == 4 || seg == 5)) {
    float* out = p.out;
#pragma unroll
    for (int mi = 0; mi < 8; ++mi) {
      const int r = rtok + mi * 16, b = r >> 8, t = r & 255;
      size_t off;
      if (seg == 1 || seg == 2) {
        const int h = cseg0 >> 6;
        off = (seg == 1 ? O_NAK : O_NAV) + (((size_t)(b * 4 + l) * 8 + h) * 256 + t) * 64;
      } else if (seg == 4) {
        const int comp = cseg0 >> 8, h = (cseg0 >> 6) & 3;
        off = O_DFK + ((((size_t)(b * 4 + l) * 2 + comp) * 4 + h) * 256 + t) * 64;
      } else {
        const int h = cseg0 >> 7;
        off = O_DFV + (((size_t)(b * 4 + l) * 4 + h) * 256 + t) * 128 + (cseg0 & 127);
      }
#pragma unroll
      for (int ni = 0; ni < 4; ++ni) *(f32x4*)(out + off + ni * 16 + fq * 4) = acc[mi][ni];
      __builtin_amdgcn_sched_barrier(0);
    }
  }
  auto tf_none = [](const f32x4& a) -> f32x4 { return a; };
  auto tf_scale = [](const f32x4& a) -> f32x4 { return f32x4{a[0] * 0.125f, a[1] * 0.125f, a[2] * 0.125f, a[3] * 0.125f}; };
  auto tf_silu = [](const f32x4& a) -> f32x4 { return f32x4{a[0] * sigmoidf_(a[0]), a[1] * sigmoidf_(a[1]), a[2] * sigmoidf_(a[2]), a[3] * sigmoidf_(a[3])}; };
  auto tf_gelu = [](const f32x4& a) -> f32x4 { return f32x4{gelu_tanh(a[0]), gelu_tanh(a[1]), gelu_tanh(a[2]), gelu_tanh(a[3])}; };
  const bool rowmajor = !(seg == 2 || seg == 5 || seg == 8 || seg == 11);
  if (rowmajor) {
    int zc;
    switch (seg) {
      case 0: zc = ZC_NAQ; break;
      case 1: zc = ZC_NAK; break;
      case 3: zc = ZC_DFQ; break;
      case 4: zc = ZC_DFK; break;
      case 6: zc = ZC_RTQ; break;
      case 7: zc = ZC_RTK; break;
      case 9: zc = ZC_RTG; break;
      default: zc = ZC_LRX; break;
    }
    if (!ctx && (seg == 3 || seg == 4)) stage_rowmajor_rope(smem, acc, wm, wn, fr, fq, rtok);
    else if (seg == 7) stage_rowmajor<8, 4>(smem, acc, wm, wn, fr, fq, tf_scale);
    else if (seg == 9) stage_rowmajor<8, 4>(smem, acc, wm, wn, fr, fq, tf_silu);
    else stage_rowmajor<8, 4>(smem, acc, wm, wn, fr, fq, tf_none);
    __syncthreads();
    bf16_t* zb = (bf16_t*)(p.ws + WS_Z) + (size_t)row0 * ZLD + zc + ctile;
    writeout<256, 16, CST_B>(smem, tid_, [&](int line, int c) { return zb + (size_t)line * ZLD + c * 8; });
    __syncthreads();
  }
  if (!rowmajor || (seg == 7 && ctx)) {
    if (seg == 7) stage_transposed<8, 4>(smem, acc, wm, wn, fr, fq, tf_scale);
    else if (seg == 11) stage_transposed<8, 4>(smem, acc, wm, wn, fr, fq, tf_gelu);
    else stage_transposed<8, 4>(smem, acc, wm, wn, fr, fq, tf_none);
    __syncthreads();
    if (seg == 11) {
      bf16_t* lg = (bf16_t*)(p.ws + WS_LG) + ((size_t)(row0 >> 6) * 512 + ctile) * 64;
      writeout<128, 32, CST_T>(smem, tid_, [&](int line, int c) { return lg + ((size_t)(c >> 3) * 512 + line) * 64 + (c & 7) * 8; });
    } else {
      bf16_t* tb = (bf16_t*)(p.ws + (seg == 2 ? WS_VTNA : seg == 5 ? WS_VTDF : seg == 8 ? WS_VTRT : WS_KTRT));
      int T;
      if (ctx) { T = 256; tb += ((size_t)((row0 >> 8) * 512 + ctile)) * 256 + (row0 & 255); }
      else { const int rr = row0 - NCTX; T = 2048; tb += (size_t)VT_LAT + ((size_t)((rr >> 11) * 512 + ctile)) * 2048 + (rr & 2047); }
      writeout<128, 32, CST_T>(smem, tid_, [&](int line, int c) { return tb + (size_t)line * T + c * 8; });
    }
    __syncthreads();
  }
}

DI void phase_gin(const P& p, int l, char* smem) {
  const bf16_t* A = (const bf16_t*)(p.ws + WS_H);
  const bf16_t* Bt = (const bf16_t*)(p.ws + WS_WIN);
  for (int it = 0;; ++it) {
    int tm, tn;
    if (!tile_sched(it, 64, 80, tm, tn)) break;
    f32x4 acc[8][4];
    zero_acc2(acc);
    gemm2_mainloop(A, 1024, Bt, 1024, 1024, tm * 256, tn * 128, smem, acc);
    epi_in(p, l, tm * 256, tn * 128, acc, smem);
  }
}

DI void phase_merge(const P& p, char* smem) {
  const bf16_t* Y4 = (const bf16_t*)(p.ws + WS_Y4);
  const bf16_t* WB = (const bf16_t*)(p.ws + WS_WBR);
  const bf16_t* GF = (const bf16_t*)(p.ws + WS_GF);
  bf16_t* G = (bf16_t*)(p.ws + WS_H);
  const int tid_ = otid(), lane = tid_ & 63, wid = tid_ >> 6, wm = wid >> 1, wn = wid & 1, fr = lane & 15, fq = lane >> 4;
  for (int it = 0;; ++it) {
    int tm, tn;
    if (!tile_sched(it, 128, 8, tm, tn)) break;
    const int row0 = tm * 128, col0 = tn * 128;
    f32x4 o[4][4];
    zero_acc(o);
#pragma unroll 1
    for (int k = 0; k < 4; ++k) {
      f32x4 acc[4][4];
      zero_acc(acc);
      gemm3_mainloop(Y4 + k * 512, 2048, WB + k * 512, 2048, 512, row0, col0, smem, acc);
      const bf16_t* gsrc = GF + (((size_t)k * 64 + (tm >> 1)) * 8 + tn) * 32768 + (((tm & 1) * 2 + wn) * 64 + lane) * 4 + (wm * 16) * 1024;
#pragma unroll
      for (int mi = 0; mi < 4; ++mi) {
        bf16x4 gq[4];
#pragma unroll
        for (int ni = 0; ni < 4; ++ni) gq[ni] = *(const bf16x4*)(gsrc + (mi * 4 + ni) * 1024);
#pragma unroll
        for (int ni = 0; ni < 4; ++ni)
#pragma unroll
          for (int i = 0; i < 4; ++i) o[mi][ni][i] += bfs2f(gq[ni][i]) * acc[mi][ni][i];
      }
    }
    stage_rowmajor<4, 4>(smem, o, wm, wn, fr, fq, [](const f32x4& a) { return a; });
    __syncthreads();
    bf16_t* gb = G + (size_t)row0 * 1024 + col0;
    writeout<128, 16, CST_B>(smem, tid_, [&](int line, int c) { return gb + (size_t)line * 1024 + c * 8; });
    __syncthreads();
  }
}

template <int MODE>
DI void phase_gemm_plain(const bf16_t* A, int K, const bf16_t* Bt, int N, bf16_t* outp, char* smem) {
  const int tid_ = otid(), lane = tid_ & 63, wid = tid_ >> 6, wm = wid >> 1, wn = wid & 1, fr = lane & 15, fq = lane >> 4;
  const int ntn = N / 128;
  for (int it = 0;; ++it) {
    int tm, tn;
    if (!tile_sched(it, 64, ntn, tm, tn)) break;
    const int row0 = tm * 256, col0 = tn * 128;
    f32x4 acc[8][4];
    zero_acc2(acc);
    gemm2_mainloop(A, K, Bt, K, K, row0, col0, smem, acc);
    stage_rowmajor<8, 4>(smem, acc, wm, wn, fr, fq, [](const f32x4& a) {
      f32x4 v = a;
      if (MODE == 1) {
        v[0] = fmaxf(v[0], 0.f); v[1] = fmaxf(v[1], 0.f); v[2] = fmaxf(v[2], 0.f); v[3] = fmaxf(v[3], 0.f);
        v[0] *= v[0]; v[1] *= v[1]; v[2] *= v[2]; v[3] *= v[3];
      }
      return v;
    });
    __syncthreads();
    bf16_t* ob = outp + (size_t)row0 * N + col0;
    writeout<256, 16, CST_B>(smem, tid_, [&](int line, int c) { return ob + (size_t)line * N + c * 8; });
    __syncthreads();
  }
}

DI void phase_mod(const P& p, char* smem) {
  float* ssil = (float*)smem;
  float* red = ssil + 5 * 1024;
  const int tid = otid();
  float* MOD = (float*)(p.ws + WS_MOD);
  for (int idx = tid; idx < 5120; idx += 256) {
    int j = idx >> 10, k = idx & 1023;
    float cv = (j == 0) ? p.in[11][k] : p.in[10][(j - 1) * 1024 + k];
    ssil[idx] = cv / (1.f + expf(-cv));
  }
  __syncthreads();
  const int cl = tid & 63, kg = tid >> 6;
  for (int item = blockIdx.x; item < 384; item += gridDim.x) {
    int l = item / 96, cgp = item % 96;
    int col = cgp * 64 + cl;
    const float* W = p.in[12] + (size_t)l * 1024 * 6144 + col;
    float a0 = 0, a1 = 0, a2 = 0, a3 = 0, a4 = 0;
#pragma unroll 8
    for (int k = kg * 256; k < kg * 256 + 256; ++k) {
      float w = W[(size_t)k * 6144];
      a0 += ssil[k] * w;
      a1 += ssil[1024 + k] * w;
      a2 += ssil[2048 + k] * w;
      a3 += ssil[3072 + k] * w;
      a4 += ssil[4096 + k] * w;
    }
    red[(kg * 5 + 0) * 64 + cl] = a0;
    red[(kg * 5 + 1) * 64 + cl] = a1;
    red[(kg * 5 + 2) * 64 + cl] = a2;
    red[(kg * 5 + 3) * 64 + cl] = a3;
    red[(kg * 5 + 4) * 64 + cl] = a4;
    __syncthreads();
    if (kg == 0) {
      float bias = p.in[13][l * 6144 + col];
#pragma unroll
      for (int j = 0; j < 5; ++j) {
        float s = red[(0 * 5 + j) * 64 + cl] + red[(1 * 5 + j) * 64 + cl] + red[(2 * 5 + j) * 64 + cl] + red[(3 * 5 + j) * 64 + cl];
        MOD[(size_t)(l * 5 + j) * 6144 + col] = s + bias;
      }
    }
    __syncthreads();
  }
}

DI void transpose_tile(const float* __restrict__ src, int lds_, bf16_t* __restrict__ dst, int ldd, float* tile) {
  const int tid = otid();
#pragma unroll 4
  for (int i = 0; i < 16; ++i) {
    int idx = tid + i * 256, r = idx >> 6, c = idx & 63;
    tile[r * 65 + c] = src[(size_t)r * lds_ + c];
  }
  __syncthreads();
#pragma unroll 4
  for (int i = 0; i < 16; ++i) {
    int idx = tid + i * 256, c = idx >> 6, r = idx & 63;
    dst[(size_t)c * ldd + r] = f2bf(tile[r * 65 + c]);
  }
  __syncthreads();
}

DI void phase_convert(const P& p, int l, char* smem) {
  float* tile = (float*)smem;
  char* ws = p.ws;
  const int NJ = 6432;
  for (int j = blockIdx.x; j < NJ; j += gridDim.x) {
    int q = j;
    if (q < 2560) {
      int tr = q / 160, tc = q % 160;
      transpose_tile(p.in[18] + (size_t)l * 1024 * 10240 + (size_t)tr * 64 * 10240 + tc * 64, 10240,
                     (bf16_t*)(ws + WS_WIN) + (size_t)tc * 64 * 1024 + tr * 64, 1024, tile);
      continue;
    }
    q -= 2560;
    if (q < 512) {
      int tr = q / 16, tc = q % 16;
      transpose_tile(p.in[40] + (size_t)l * 2048 * 1024 + (size_t)tr * 64 * 1024 + tc * 64, 1024,
                     (bf16_t*)(ws + WS_WBR) + (size_t)tc * 64 * 2048 + tr * 64, 2048, tile);
      continue;
    }
    q -= 512;
    if (q < 256) {
      int tr = q / 16, tc = q % 16;
      transpose_tile(p.in[41] + (size_t)l * 1024 * 1024 + (size_t)tr * 64 * 1024 + tc * 64, 1024,
                     (bf16_t*)(ws + WS_WOUT) + (size_t)tc * 64 * 1024 + tr * 64, 1024, tile);
      continue;
    }
    q -= 256;
    if (q < 1024) {
      int tr = q / 64, tc = q % 64;
      transpose_tile(p.in[42] + (size_t)l * 1024 * 4096 + (size_t)tr * 64 * 4096 + tc * 64, 4096,
                     (bf16_t*)(ws + WS_W1) + (size_t)tc * 64 * 1024 + tr * 64, 1024, tile);
      continue;
    }
    q -= 1024;
    if (q < 1024) {
      int tr = q / 16, tc = q % 16;
      transpose_tile(p.in[43] + (size_t)l * 4096 * 1024 + (size_t)tr * 64 * 1024 + tc * 64, 1024,
                     (bf16_t*)(ws + WS_W2) + (size_t)tc * 64 * 4096 + tr * 64, 4096, tile);
      continue;
    }
    q -= 1024;
    if (q < 32) {
      int type = q >> 3, n = q & 7;
      const float* src = (type == 0 ? p.in[30] : type == 1 ? p.in[32] : type == 2 ? p.in[35] : p.in[37]) + (size_t)(l * 8 + n) * 4096;
      transpose_tile(src, 64, (bf16_t*)(ws + WS_WLRU) + (size_t)(type * 8 + n) * 4096, 64, tile);
      continue;
    }
    q -= 32;
    if (q < 256) {
      int bh = q >> 3, tr = q & 7, b = bh >> 3, h = bh & 7;
      transpose_tile(p.in[3] + ((size_t)((b * 4 + l) * 8 + h)) * 32768 + (size_t)tr * 64 * 64, 64,
                     (bf16_t*)(ws + WS_CVNA) + (size_t)bh * 32768 + tr * 64, 512, tile);
      continue;
    }
    q -= 256;
    if (q < 256) {
      int bh = q >> 4, t2 = q & 15, tr = t2 >> 1, tc = t2 & 1, b = bh >> 2, h = bh & 3;
      transpose_tile(p.in[5] + ((size_t)((b * 4 + l) * 4 + h)) * 65536 + (size_t)tr * 64 * 128 + tc * 64, 128,
                     (bf16_t*)(ws + WS_CVDF) + (size_t)bh * 65536 + (size_t)tc * 64 * 512 + tr * 64, 512, tile);
      continue;
    }
    q -= 256;
    {
      int tensor = q >> 8, b = (q >> 6) & 3, chunk = q & 63;
      const float* src = (tensor == 0 ? p.in[2] : p.in[4]) + (size_t)(b * 4 + l) * 262144 + (size_t)chunk * 4096;
      bf16_t* dst = (bf16_t*)(ws + (tensor == 0 ? WS_CKNA : WS_CKDF)) + (size_t)b * 262144 + (size_t)chunk * 4096;
#pragma unroll
      for (int i = 0; i < 4; ++i) {
        int e = (otid() + i * 256) * 4;
        float4 v = *(const float4*)(src + e);
        *(bf16x4*)(dst + e) = pack4(v.x, v.y, v.z, v.w);
      }
    }
  }
}

DI void phase_row(const P& p, int l, int mode) {
  const int tid_ = otid(), lane = tid_ & 63, wid = tid_ >> 6;
  const float* MOD = (const float*)(p.ws + WS_MOD);
  float* X = p.out;
  bf16_t* H = (bf16_t*)(p.ws + WS_H);
  const bf16_t* Y = (const bf16_t*)(p.ws + WS_Y);
  const bool from_inputs = (mode == 0 || (mode == 1 && l == 0));
  auto xsrc = [&](int r) -> const float* {
    return from_inputs ? ((r < NCTX) ? (p.in[0] + (size_t)r * D) : (p.in[1] + (size_t)(r - NCTX) * D)) : (X + (size_t)r * D);
  };
  int rb = blockIdx.x;
  if (rb >= 4096) return;
  float4 xn[4];
  bf16x4 yn[4];
  {
    const int r = rb * 4 + wid;
    const float* xs = xsrc(r);
#pragma unroll
    for (int j = 0; j < 4; ++j) xn[j] = *(const float4*)(xs + j * 256 + lane * 4);
    if (mode != 0) {
#pragma unroll
      for (int j = 0; j < 4; ++j) yn[j] = *(const bf16x4*)(Y + (size_t)r * D + j * 256 + lane * 4);
    }
  }
  for (; rb < 4096; rb += gridDim.x) {
    const int r = rb * 4 + wid;
    const int mi = r < NCTX ? 0 : 1 + ((r - NCTX) >> 11);
    float4 xv[4], yv[4];
#pragma unroll
    for (int j = 0; j < 4; ++j) { xv[j] = xn[j]; yv[j] = make_float4(bfs2f(yn[j][0]), bfs2f(yn[j][1]), bfs2f(yn[j][2]), bfs2f(yn[j][3])); }
    {
      const int rbn = (rb + (int)gridDim.x < 4096) ? rb + (int)gridDim.x : rb;
      const int rn = rbn * 4 + wid;
      const float* xs = xsrc(rn);
#pragma unroll
      for (int j = 0; j < 4; ++j) xn[j] = *(const float4*)(xs + j * 256 + lane * 4);
      if (mode != 0) {
#pragma unroll
        for (int j = 0; j < 4; ++j) yn[j] = *(const bf16x4*)(Y + (size_t)rn * D + j * 256 + lane * 4);
      }
    }
    if (mode != 0) {
      float ss = 0.f;
#pragma unroll
      for (int j = 0; j < 4; ++j) ss += yv[j].x * yv[j].x + yv[j].y * yv[j].y + yv[j].z * yv[j].z + yv[j].w * yv[j].w;
      ss = wave_sum(ss);
      const float rs = rsqrtf(ss * (1.f / 1024.f) + 1e-6f);
      const float* gpost = (mode == 1 ? p.in[15] : p.in[17]) + l * D;
      const float* gate = MOD + (size_t)(l * 5 + mi) * 6144 + (mode == 1 ? 2048 : 5120);
#pragma unroll
      for (int j = 0; j < 4; ++j) {
        float4 g = *(const float4*)(gpost + j * 256 + lane * 4);
        float4 gt = *(const float4*)(gate + j * 256 + lane * 4);
        xv[j].x += gt.x * (yv[j].x * rs * g.x);
        xv[j].y += gt.y * (yv[j].y * rs * g.y);
        xv[j].z += gt.z * (yv[j].z * rs * g.z);
        xv[j].w += gt.w * (yv[j].w * rs * g.w);
        *(float4*)(X + (size_t)r * D + j * 256 + lane * 4) = xv[j];
      }
    }
    int ln, off_sh, off_sc;
    const float* gpre;
    if (mode == 0) { ln = 0; gpre = p.in[14]; off_sh = 0; off_sc = 1024; }
    else if (mode == 1) { ln = l; gpre = p.in[16] + l * D; off_sh = 3072; off_sc = 4096; }
    else { ln = l + 1; gpre = p.in[14] + (l + 1) * D; off_sh = 0; off_sc = 1024; }
    if (ln < 4) {
      float ss = 0.f;
#pragma unroll
      for (int j = 0; j < 4; ++j) ss += xv[j].x * xv[j].x + xv[j].y * xv[j].y + xv[j].z * xv[j].z + xv[j].w * xv[j].w;
      ss = wave_sum(ss);
      const float rs = rsqrtf(ss * (1.f / 1024.f) + 1e-6f);
      const float* mrow = MOD + (size_t)(ln * 5 + mi) * 6144;
#pragma unroll
      for (int j = 0; j < 4; ++j) {
        int c = j * 256 + lane * 4;
        float4 g = *(const float4*)(gpre + c);
        float4 sc = *(const float4*)(mrow + off_sc + c);
        float4 sh = *(const float4*)(mrow + off_sh + c);
        *(bf16x4*)(H + (size_t)r * D + c) = pack4(xv[j].x * rs * g.x * (1.f + sc.x) + sh.x, xv[j].y * rs * g.y * (1.f + sc.y) + sh.y,
                                                  xv[j].z * rs * g.z * (1.f + sc.z) + sh.z, xv[j].w * rs * g.w * (1.f + sc.w) + sh.w);
      }
    }
  }
}

constexpr int ATT_BUF = 192 * LDT;
DI void qk_scores(const bf16x8 (&qf)[2], const bf16_t* sK, f32x4 (&S)[4], int fr, int fq) {
  __builtin_amdgcn_s_setprio(1);
#pragma unroll
  for (int s = 0; s < 4; ++s) {
    f32x4 z = {0.f, 0.f, 0.f, 0.f};
#pragma unroll
    for (int ks = 0; ks < 2; ++ks) {
      bf16x8 a = *(const bf16x8*)(sK + (16 * s + fr) * LDT + ks * 32 + fq * 8);
      z = MFMA16(a, qf[ks], z);
    }
    S[s] = z;
  }
  __builtin_amdgcn_s_setprio(0);
}
template <int DV>
DI void pv_step(const bf16x8 (&pb)[2], const bf16_t* sV, f32x4 (&O)[DV / 16], int fr, int fq) {
  __builtin_amdgcn_s_setprio(1);
#pragma unroll
  for (int dt = 0; dt < DV / 16; ++dt) {
#pragma unroll
    for (int s2 = 0; s2 < 2; ++s2) {
      const bf16_t* base = sV + (dt * 16 + fr) * LDT + 32 * s2 + 4 * fq;
      bf16x4 lo = *(const bf16x4*)base;
      bf16x4 hi = *(const bf16x4*)(base + 16);
      bf16x8 a = __builtin_shufflevector(lo, hi, 0, 1, 2, 3, 4, 5, 6, 7);
      O[dt] = MFMA16(a, pb[s2], O[dt]);
    }
  }
  __builtin_amdgcn_s_setprio(0);
}
template <int DV>
DI void softmax_pv(f32x4 (&S)[4], const bf16_t* sV, f32x4 (&O)[DV / 16], float& m, float& lsum, int fr, int fq) {
  float tm = -1e30f;
#pragma unroll
  for (int s = 0; s < 4; ++s)
#pragma unroll
    for (int i = 0; i < 4; ++i) tm = fmaxf(tm, S[s][i]);
  tm = xmax32(xmax16(tm));
  const float mn = fmaxf(m, tm);
  const float alpha = __builtin_amdgcn_exp2f(m - mn);
  const bool grew = mn != m;
  m = mn;
  float ps = 0.f;
#pragma unroll
  for (int s = 0; s < 4; ++s)
#pragma unroll
    for (int i = 0; i < 4; ++i) {
      float pv = __builtin_amdgcn_exp2f(S[s][i] - mn);
      S[s][i] = pv;
      ps += pv;
    }
  lsum = lsum * alpha + ps;
  if (__any(grew)) {
#pragma unroll
    for (int dt = 0; dt < DV / 16; ++dt) {
      O[dt][0] *= alpha; O[dt][1] *= alpha; O[dt][2] *= alpha; O[dt][3] *= alpha;
    }
  }
  bf16x8 pb[2];
  pb[0] = pack8(S[0], S[1]);
  pb[1] = pack8(S[2], S[3]);
  pv_step<DV>(pb, sV, O, fr, fq);
}
template <int DV, bool SOFTMAX, int TPS, class TileFn, class ScoreFn>
DI void attn_loop(int ntiles, TileFn&& tile, ScoreFn&& score, const bf16x8 (&qf)[2], f32x4 (&O)[DV / 16], float& m, float& lsum,
                  bf16_t* smem, int tid) {
  const int lane = tid & 63, fr = lane & 15, fq = lane >> 4;
  constexpr int TILE_EL = (64 + DV) * LDT, STAGE_EL = TPS * TILE_EL;
  u32x4 rkA[TPS][2], rvA[TPS][DV / 32], rkB[TPS][2], rvB[TPS][DV / 32];
  const int sr = tid >> 3, sc = (tid & 7) * 8;
  auto gload = [&](int step, u32x4 (&rk)[TPS][2], u32x4 (&rv)[TPS][DV / 32]) __attribute__((always_inline)) {
#pragma unroll
    for (int u = 0; u < TPS; ++u) {
      const bf16_t* Kg; const bf16_t* Vg; int ldk, ldv;
      tile(step * TPS + u, Kg, ldk, Vg, ldv);
#pragma unroll
      for (int i = 0; i < 2; ++i) rk[u][i] = *(const u32x4*)(Kg + (size_t)(sr + i * 32) * ldk + sc);
#pragma unroll
      for (int i = 0; i < DV / 32; ++i) rv[u][i] = *(const u32x4*)(Vg + (size_t)(sr + i * 32) * ldv + sc);
    }
  };
  auto sstore = [&](int buf, const u32x4 (&rk)[TPS][2], const u32x4 (&rv)[TPS][DV / 32]) __attribute__((always_inline)) {
#pragma unroll
    for (int u = 0; u < TPS; ++u) {
      bf16_t* sK = smem + buf * STAGE_EL + u * TILE_EL;
      bf16_t* sV = sK + 64 * LDT;
#pragma unroll
      for (int i = 0; i < 2; ++i) *(u32x4*)(sK + (sr + i * 32) * LDT + sc) = rk[u][i];
#pragma unroll
      for (int i = 0; i < DV / 32; ++i) *(u32x4*)(sV + (sr + i * 32) * LDT + sc) = rv[u][i];
    }
  };
  auto compute = [&](int buf, int step) __attribute__((always_inline)) {
#pragma unroll
    for (int u = 0; u < TPS; ++u) {
      const bf16_t* sK = smem + buf * STAGE_EL + u * TILE_EL;
      const bf16_t* sV = sK + 64 * LDT;
      f32x4 S[4];
      qk_scores(qf, sK, S, fr, fq);
      score(step * TPS + u, S);
      if (SOFTMAX) {
        softmax_pv<DV>(S, sV, O, m, lsum, fr, fq);
      } else {
        bf16x8 pb[2];
        pb[0] = pack8(S[0], S[1]);
        pb[1] = pack8(S[2], S[3]);
        pv_step<DV>(pb, sV, O, fr, fq);
      }
    }
  };
  const int nsteps = ntiles / TPS, last = nsteps - 1;
  if (TPS > 1) {
    gload(0, rkA, rvA);
    sstore(0, rkA, rvA);
    __syncthreads();
    for (int j = 0; j < nsteps; ++j) {
      gload(j + 1 < last ? j + 1 : last, rkA, rvA);
      asm volatile("" ::: "memory");
      compute(j & 1, j);
      __builtin_amdgcn_sched_barrier(0);
      sstore((j + 1) & 1, rkA, rvA);
      __syncthreads();
    }
    return;
  }
  gload(0, rkA, rvA);
  gload(last < 1 ? last : 1, rkB, rvB);
  sstore(0, rkA, rvA);
  __syncthreads();
  for (int j = 0; j < nsteps; j += 2) {
    gload(j + 2 < last ? j + 2 : last, rkA, rvA);
    asm volatile("" ::: "memory");
    compute(0, j);
    __builtin_amdgcn_sched_barrier(0);
    sstore(1, rkB, rvB);
    __syncthreads();
    if (j + 1 >= nsteps) break;
    gload(j + 3 < last ? j + 3 : last, rkB, rvB);
    asm volatile("" ::: "memory");
    compute(1, j + 1);
    __builtin_amdgcn_sched_barrier(0);
    sstore(0, rkA, rvA);
    __syncthreads();
  }
}
DI void scale_scores(f32x4 (&S)[4]) {
#pragma unroll
  for (int s = 0; s < 4; ++s) { S[s][0] *= 0.18033688f; S[s][1] *= 0.18033688f; S[s][2] *= 0.18033688f; S[s][3] *= 0.18033688f; }
}

DI void softmax_only(f32x4 (&S)[4], f32x4 (&O)[8], float& m, float& lsum, bf16x8 (&pb)[2]) {
  float tm = -1e30f;
#pragma unroll
  for (int s = 0; s < 4; ++s)
#pragma unroll
    for (int i = 0; i < 4; ++i) tm = fmaxf(tm, S[s][i]);
  tm = xmax32(xmax16(tm));
  const float mn = fmaxf(m, tm);
  const float alpha = __builtin_amdgcn_exp2f(m - mn);
  const bool grew = mn != m;
  m = mn;
  float ps = 0.f;
#pragma unroll
  for (int s = 0; s < 4; ++s)
#pragma unroll
    for (int i = 0; i < 4; ++i) {
      float pv = __builtin_amdgcn_exp2f(S[s][i] - mn);
      S[s][i] = pv;
      ps += pv;
    }
  lsum = lsum * alpha + ps;
  if (__any(grew)) {
#pragma unroll
    for (int dt = 0; dt < 8; ++dt) { O[dt][0] *= alpha; O[dt][1] *= alpha; O[dt][2] *= alpha; O[dt][3] *= alpha; }
  }
  pb[0] = pack8(S[0], S[1]);
  pb[1] = pack8(S[2], S[3]);
}
template <class TileFn>
DI void diff_loop(int ntiles, TileFn&& tile, const bf16x8 (&q1)[2], const bf16x8 (&q2)[2], f32x4 (&O1)[8], f32x4 (&O2)[8],
                  float& m1, float& l1, float& m2, float& l2, bf16_t* smem, int tid) {
  const int lane = tid & 63, fr = lane & 15, fq = lane >> 4;
  constexpr int STAGE_EL = 256 * LDT;
  u32x4 rk1[2], rk2[2], rv[4];
  const int sr = tid >> 3, sc = (tid & 7) * 8;
  auto gload = [&](int j) __attribute__((always_inline)) {
    const bf16_t* K1g; const bf16_t* K2g; const bf16_t* Vg; int ldk, ldv;
    tile(j, K1g, K2g, ldk, Vg, ldv);
#pragma unroll
    for (int i = 0; i < 2; ++i) {
      rk1[i] = *(const u32x4*)(K1g + (size_t)(sr + i * 32) * ldk + sc);
      rk2[i] = *(const u32x4*)(K2g + (size_t)(sr + i * 32) * ldk + sc);
    }
#pragma unroll
    for (int i = 0; i < 4; ++i) rv[i] = *(const u32x4*)(Vg + (size_t)(sr + i * 32) * ldv + sc);
  };
  auto sstore = [&](int buf) __attribute__((always_inline)) {
    bf16_t* sb = smem + buf * STAGE_EL;
#pragma unroll
    for (int i = 0; i < 2; ++i) {
      *(u32x4*)(sb + (sr + i * 32) * LDT + sc) = rk1[i];
      *(u32x4*)(sb + (64 + sr + i * 32) * LDT + sc) = rk2[i];
    }
#pragma unroll
    for (int i = 0; i < 4; ++i) *(u32x4*)(sb + (128 + sr + i * 32) * LDT + sc) = rv[i];
  };
  const int last = ntiles - 1;
  gload(0);
  sstore(0);
  __syncthreads();
  for (int j = 0; j < ntiles; ++j) {
    gload(j + 1 < last ? j + 1 : last);
    asm volatile("" ::: "memory");
    {
      const bf16_t* sb = smem + (j & 1) * STAGE_EL;
      const bf16_t* sV = sb + 128 * LDT;
      f32x4 S1[4], S2[4];
      qk_scores(q1, sb, S1, fr, fq);
      qk_scores(q2, sb + 64 * LDT, S2, fr, fq);
      scale_scores(S1);
      scale_scores(S2);
      bf16x8 pb1[2], pb2[2];
      softmax_only(S1, O1, m1, l1, pb1);
      softmax_only(S2, O2, m2, l2, pb2);
      __builtin_amdgcn_s_setprio(1);
#pragma unroll
      for (int dt = 0; dt < 8; ++dt) {
#pragma unroll
        for (int s2 = 0; s2 < 2; ++s2) {
          const bf16_t* base = sV + (dt * 16 + fr) * LDT + 32 * s2 + 4 * fq;
          bf16x4 lo = *(const bf16x4*)base;
          bf16x4 hi = *(const bf16x4*)(base + 16);
          bf16x8 a = __builtin_shufflevector(lo, hi, 0, 1, 2, 3, 4, 5, 6, 7);
          O1[dt] = MFMA16(a, pb1[s2], O1[dt]);
          O2[dt] = MFMA16(a, pb2[s2], O2[dt]);
        }
      }
      __builtin_amdgcn_s_setprio(0);
    }
    __builtin_amdgcn_sched_barrier(0);
    sstore((j + 1) & 1);
    __syncthreads();
  }
}


DI void dense_item(const P& p, int b, int h, int qb, char* smem) {
  const int tid = otid(), lane = tid & 63, wid = tid >> 6, fr = lane & 15, fq = lane >> 4;
  const bf16_t* Z = (const bf16_t*)(p.ws + WS_Z);
  const bf16_t* VT = (const bf16_t*)(p.ws + WS_VTNA) + (size_t)(b * 512 + h * 64) * 256;
  bf16_t* Y4 = (bf16_t*)(p.ws + WS_Y4);
  const int rowbase = b * 256;
  const int qrow = rowbase + qb * 64 + wid * 16 + fr;
  bf16x8 qf[2];
#pragma unroll
  for (int ks = 0; ks < 2; ++ks) qf[ks] = *(const bf16x8*)(Z + (size_t)qrow * ZLD + ZC_NAQ + h * 64 + ks * 32 + fq * 8);
  f32x4 O[4];
#pragma unroll
  for (int dt = 0; dt < 4; ++dt) O[dt] = f32x4{0.f, 0.f, 0.f, 0.f};
  float m = -1e30f, lsum = 0.f;
  const bf16_t* Kb = Z + (size_t)rowbase * ZLD + ZC_NAK + h * 64;
  attn_loop<64, true, 2>(4,
      [&](int j, const bf16_t*& Kg, int& ldk, const bf16_t*& Vg, int& ldv) __attribute__((always_inline)) { Kg = Kb + (size_t)j * 64 * ZLD; ldk = ZLD; Vg = VT + j * 64; ldv = 256; },
      [&](int, f32x4 (&S)[4]) __attribute__((always_inline)) { scale_scores(S); }, qf, O, m, lsum, (bf16_t*)smem, tid);
  const float lt = xsum32(xsum16(lsum));
  const float inv = 1.f / lt;
#pragma unroll
  for (int dt = 0; dt < 4; ++dt)
    *(bf16x4*)(Y4 + (size_t)qrow * 2048 + h * 64 + dt * 16 + fq * 4) = pack4(O[dt][0] * inv, O[dt][1] * inv, O[dt][2] * inv, O[dt][3] * inv);
}

DI void na_item(const P& p, int l, int b, int h, int r, char* smem) {
  float* srpb = (float*)(smem + 73728);
  const int tid = otid(), lane = tid & 63, wid = tid >> 6, fr = lane & 15, fq = lane >> 4;
  const bf16_t* Z = (const bf16_t*)(p.ws + WS_Z);
  const bf16_t* VT = (const bf16_t*)(p.ws + WS_VTNA) + VT_LAT + (size_t)(b * 512 + h * 64) * 2048;
  const bf16_t* CK = (const bf16_t*)(p.ws + WS_CKNA) + (size_t)(b * 8 + h) * 32768;
  const bf16_t* CVT = (const bf16_t*)(p.ws + WS_CVNA) + (size_t)(b * 8 + h) * 32768;
  bf16_t* Y4 = (bf16_t*)(p.ws + WS_Y4);
  for (int i = tid; i < 465; i += 256) srpb[i] = p.in[19][(size_t)(l * 8 + h) * 465 + i];
  const int rowbase = NCTX + b * 2048;
  const int qcol = wid * 16 + fr;
  const int qrow = rowbase + r * 64 + qcol;
  bf16x8 qf[2];
#pragma unroll
  for (int ks = 0; ks < 2; ++ks) qf[ks] = *(const bf16x8*)(Z + (size_t)qrow * ZLD + ZC_NAQ + h * 64 + ks * 32 + fq * 8);
  f32x4 O[4];
#pragma unroll
  for (int dt = 0; dt < 4; ++dt) O[dt] = f32x4{0.f, 0.f, 0.f, 0.f};
  float m = -1e30f, lsum = 0.f;
  int rs = r - 4;
  rs = rs < 0 ? 0 : (rs > 24 ? 24 : rs);
  int cstart = qcol - 8;
  cstart = cstart < 0 ? 0 : (cstart > 48 ? 48 : cstart);
  const bf16_t* Kb = Z + (size_t)rowbase * ZLD + ZC_NAK + h * 64;
  attn_loop<64, true, 2>(16,
      [&](int j, const bf16_t*& Kg, int& ldk, const bf16_t*& Vg, int& ldv) __attribute__((always_inline)) {
        if (j < 8) { Kg = Kb + (size_t)(rs + j) * 64 * ZLD; ldk = ZLD; Vg = VT + (rs + j) * 64; ldv = 2048; }
        else { Kg = CK + (size_t)(j - 8) * 64 * 64; ldk = 64; Vg = CVT + (j - 8) * 64; ldv = 512; }
      },
      [&](int j, f32x4 (&S)[4]) __attribute__((always_inline)) {
        if (j < 8) {
          const int dr = rs + j - r + 7;
#pragma unroll
          for (int s = 0; s < 4; ++s)
#pragma unroll
            for (int i = 0; i < 4; ++i) {
              int kcol = s * 16 + fq * 4 + i;
              bool ok = (kcol >= cstart) && (kcol < cstart + 16);
              int dc = kcol - qcol + 15;
              dc = dc < 0 ? 0 : (dc > 30 ? 30 : dc);
              float bias = srpb[dr * 31 + dc];
              S[s][i] = ok ? (S[s][i] * 0.18033688f + bias * 1.44269504f) : -1e30f;
            }
        } else {
          scale_scores(S);
        }
      },
      qf, O, m, lsum, (bf16_t*)smem, tid);
  const float lt = xsum32(xsum16(lsum));
  const float inv = 1.f / lt;
#pragma unroll
  for (int dt = 0; dt < 4; ++dt)
    *(bf16x4*)(Y4 + (size_t)qrow * 2048 + h * 64 + dt * 16 + fq * 4) = pack4(O[dt][0] * inv, O[dt][1] * inv, O[dt][2] * inv, O[dt][3] * inv);
}

DI void diff_item(const P& p, int l, bool latent, int b, int h, int qb, char* smem) {
  const int tid = otid(), lane = tid & 63, wid = tid >> 6, fr = lane & 15, fq = lane >> 4;
  const bf16_t* Z = (const bf16_t*)(p.ws + WS_Z);
  const int T = latent ? 2048 : 256;
  const int rowbase = latent ? NCTX + b * 2048 : b * 256;
  const bf16_t* VT = (const bf16_t*)(p.ws + WS_VTDF) + (latent ? (size_t)VT_LAT + (size_t)(b * 512 + h * 128) * 2048 : (size_t)(b * 512 + h * 128) * 256);
  const bf16_t* CVT = (const bf16_t*)(p.ws + WS_CVDF) + (size_t)(b * 4 + h) * 65536;
  bf16_t* Y4 = (bf16_t*)(p.ws + WS_Y4);
  const int qrow = rowbase + qb * 64 + wid * 16 + fr;
  float d1 = p.in[20][l * 64 + lane] * p.in[21][l * 64 + lane];
  float d2 = p.in[22][l * 64 + lane] * p.in[23][l * 64 + lane];
  d1 = wave_sum(d1);
  d2 = wave_sum(d2);
  const float lam_init = 0.8f - 0.6f * expf(-0.3f * (float)l);
  const float lam = expf(d1) - expf(d2) + lam_init;
  const int nown = T >> 6;
  const int ntiles = nown + (latent ? 8 : 0);

  f32x4 O1[8];
  f32x4 O[8];
  {
    bf16x8 q1[2], q2[2];
#pragma unroll
    for (int ks = 0; ks < 2; ++ks) {
      q1[ks] = *(const bf16x8*)(Z + (size_t)qrow * ZLD + ZC_DFQ + h * 64 + ks * 32 + fq * 8);
      q2[ks] = *(const bf16x8*)(Z + (size_t)qrow * ZLD + ZC_DFQ + 256 + h * 64 + ks * 32 + fq * 8);
    }
#pragma unroll
    for (int dt = 0; dt < 8; ++dt) { O1[dt] = f32x4{0.f, 0.f, 0.f, 0.f}; O[dt] = f32x4{0.f, 0.f, 0.f, 0.f}; }
    float m1 = -1e30f, l1 = 0.f, m2 = -1e30f, l2 = 0.f;
    const bf16_t* Kb = Z + (size_t)rowbase * ZLD + ZC_DFK + h * 64;
    const bf16_t* CK = (const bf16_t*)(p.ws + WS_CKDF) + (size_t)((b * 2) * 4 + h) * 32768;
    diff_loop(ntiles,
        [&](int j, const bf16_t*& K1g, const bf16_t*& K2g, int& ldk, const bf16_t*& Vg, int& ldv) __attribute__((always_inline)) {
          if (j < nown) { K1g = Kb + (size_t)j * 64 * ZLD; K2g = K1g + 256; ldk = ZLD; Vg = VT + j * 64; ldv = T; }
          else { K1g = CK + (size_t)(j - nown) * 64 * 64; K2g = K1g + 4 * 32768; ldk = 64; Vg = CVT + (j - nown) * 64; ldv = 512; }
        },
        q1, q2, O1, O, m1, l1, m2, l2, (bf16_t*)smem, tid);
    const float inv1 = 1.f / xsum32(xsum16(l1));
    const float inv2 = lam / xsum32(xsum16(l2));
#pragma unroll
    for (int dt = 0; dt < 8; ++dt) {
      O[dt][0] = O1[dt][0] * inv1 - O[dt][0] * inv2;
      O[dt][1] = O1[dt][1] * inv1 - O[dt][1] * inv2;
      O[dt][2] = O1[dt][2] * inv1 - O[dt][2] * inv2;
      O[dt][3] = O1[dt][3] * inv1 - O[dt][3] * inv2;
    }
  }
  float ss = 0.f;
#pragma unroll
  for (int dt = 0; dt < 8; ++dt) ss += O[dt][0] * O[dt][0] + O[dt][1] * O[dt][1] + O[dt][2] * O[dt][2] + O[dt][3] * O[dt][3];
  ss = xsum32(xsum16(ss));
  const float rsn = rsqrtf(ss * (1.f / 128.f) + 1e-6f) * (1.f - lam_init);
  const float* gn = p.in[24] + l * 128;
#pragma unroll
  for (int dt = 0; dt < 8; ++dt) {
    int dv = dt * 16 + fq * 4;
    float4 g = *(const float4*)(gn + dv);
    *(bf16x4*)(Y4 + (size_t)qrow * 2048 + 512 + h * 128 + dv) = pack4(O[dt][0] * rsn * g.x, O[dt][1] * rsn * g.y, O[dt][2] * rsn * g.z, O[dt][3] * rsn * g.w);
  }
}

DI void ret_item(const P& p, int l, bool latent, int b, int h, int qb, char* smem) {
  bf16_t* sV0 = (bf16_t*)smem + 64 * LDT;
  const int tid = otid(), lane = tid & 63, wid = tid >> 6, fr = lane & 15, fq = lane >> 4;
  const bf16_t* Z = (const bf16_t*)(p.ws + WS_Z);
  const int T = latent ? 2048 : 256;
  const int rowbase = latent ? NCTX + b * 2048 : b * 256;
  const bf16_t* VT = (const bf16_t*)(p.ws + WS_VTRT) + (latent ? (size_t)VT_LAT + (size_t)(b * 512 + h * 64) * 2048 : (size_t)(b * 512 + h * 64) * 256);
  bf16_t* Y4 = (bf16_t*)(p.ws + WS_Y4);
  const int tq = qb * 64 + wid * 16 + fr;
  const int qrow = rowbase + tq;
  const float lgf = log1pf(-expf(p.in[25][l * 8 + h]));
  const float lgb = log1pf(-expf(p.in[26][l * 8 + h]));
  bf16x8 qf[2];
#pragma unroll
  for (int ks = 0; ks < 2; ++ks) qf[ks] = *(const bf16x8*)(Z + (size_t)qrow * ZLD + ZC_RTQ + h * 64 + ks * 32 + fq * 8);
  f32x4 O[4];
#pragma unroll
  for (int dt = 0; dt < 4; ++dt) O[dt] = f32x4{0.f, 0.f, 0.f, 0.f};
  float mdummy = 0.f, ldummy = 0.f;
  const int dq = wid * 16 + fr;
  float AF[4], BF[4], AB[4], BB[4];
#pragma unroll
  for (int u = 0; u < 4; ++u) {
    AF[u] = __expf(-lgf * (float)(u * 16));
    AB[u] = __expf(lgb * (float)(u * 16));
    BF[u] = __expf(-lgf * (float)(fq * 4 + u));
    BB[u] = __expf(lgb * (float)(fq * 4 + u));
  }
  const bf16_t* Kb = Z + (size_t)rowbase * ZLD + ZC_RTK + h * 64;
  attn_loop<64, false, 2>(T >> 6,
      [&](int j, const bf16_t*& Kg, int& ldk, const bf16_t*& Vg, int& ldv) __attribute__((always_inline)) { Kg = Kb + (size_t)j * 64 * ZLD; ldk = ZLD; Vg = VT + j * 64; ldv = T; },
      [&](int j, f32x4 (&S)[4]) __attribute__((always_inline)) {
        if (j == qb) {
#pragma unroll
          for (int s = 0; s < 4; ++s)
#pragma unroll
            for (int i = 0; i < 4; ++i) {
              int tk = j * 64 + s * 16 + fq * 4 + i;
              int dd = tq - tk;
              float w = dd >= 0 ? __expf(lgf * (float)dd) : __expf(lgb * (float)(-dd));
              S[s][i] *= w;
            }
        } else if (j < qb) {
          const float qfac = __expf(lgf * (float)((qb - j) * 64 + dq));
#pragma unroll
          for (int s = 0; s < 4; ++s) {
            const float f = qfac * AF[s];
            S[s][0] *= f * BF[0]; S[s][1] *= f * BF[1]; S[s][2] *= f * BF[2]; S[s][3] *= f * BF[3];
          }
        } else {
          const float qfac = __expf(lgb * (float)((j - qb) * 64 - dq));
#pragma unroll
          for (int s = 0; s < 4; ++s) {
            const float f = qfac * AB[s];
            S[s][0] *= f * BB[0]; S[s][1] *= f * BB[1]; S[s][2] *= f * BB[2]; S[s][3] *= f * BB[3];
          }
        }
      },
      qf, O, mdummy, ldummy, (bf16_t*)smem, tid);
  if (latent) {
    for (int dir = 0; dir < 2; ++dir) {
      const float* S0 = (dir == 0 ? p.in[6] : p.in[7]) + ((size_t)((b * 4 + l) * 8 + h)) * 4096;
#pragma unroll
      for (int i = 0; i < 4; ++i) {
        int e = (tid + i * 256) * 4;
        float4 v = *(const float4*)(S0 + e);
        int dk = e >> 6, dv = e & 63;
        sV0[(dv + 0) * LDT + dk] = f2bf(v.x);
        sV0[(dv + 1) * LDT + dk] = f2bf(v.y);
        sV0[(dv + 2) * LDT + dk] = f2bf(v.z);
        sV0[(dv + 3) * LDT + dk] = f2bf(v.w);
      }
      __syncthreads();
      const float sc = dir == 0 ? __expf(lgf * (float)(tq + 1)) : __expf(lgb * (float)(T - tq));
      bf16x8 pb[2];
#pragma unroll
      for (int s2 = 0; s2 < 2; ++s2) {
        const bf16_t* qp = Z + (size_t)qrow * ZLD + ZC_RTQ + h * 64 + 32 * s2 + 4 * fq;
        bf16x4 lo = *(const bf16x4*)qp;
        bf16x4 hi = *(const bf16x4*)(qp + 16);
        f32x4 flo = {bfs2f(lo[0]) * sc, bfs2f(lo[1]) * sc, bfs2f(lo[2]) * sc, bfs2f(lo[3]) * sc};
        f32x4 fhi = {bfs2f(hi[0]) * sc, bfs2f(hi[1]) * sc, bfs2f(hi[2]) * sc, bfs2f(hi[3]) * sc};
        pb[s2] = pack8(flo, fhi);
      }
      pv_step<64>(pb, sV0, O, fr, fq);
      __syncthreads();
    }
  }
  float ss = 0.f;
#pragma unroll
  for (int dt = 0; dt < 4; ++dt) ss += O[dt][0] * O[dt][0] + O[dt][1] * O[dt][1] + O[dt][2] * O[dt][2] + O[dt][3] * O[dt][3];
  ss = xsum32(xsum16(ss));
  const float rsn = rsqrtf(ss * (1.f / 64.f) + 1e-6f);
  const float* gn = p.in[27] + l * 512 + h * 64;
#pragma unroll
  for (int dt = 0; dt < 4; ++dt) {
    int dv = dt * 16 + fq * 4;
    float4 g = *(const float4*)(gn + dv);
    bf16x4 sg = *(const bf16x4*)(Z + (size_t)qrow * ZLD + ZC_RTG + h * 64 + dv);
    *(bf16x4*)(Y4 + (size_t)qrow * 2048 + 1024 + h * 64 + dv) =
        pack4(O[dt][0] * rsn * g.x * bfs2f(sg[0]), O[dt][1] * rsn * g.y * bfs2f(sg[1]), O[dt][2] * rsn * g.z * bfs2f(sg[2]), O[dt][3] * rsn * g.w * bfs2f(sg[3]));
  }
}

DI void ret_state_item(const P& p, int l, int b, int h) {
  const int tid_ = otid(), lane = tid_ & 63, wid = tid_ >> 6, fr = lane & 15, fq = lane >> 4;
  const bf16_t* KT = (const bf16_t*)(p.ws + WS_KTRT) + (size_t)(b * 512 + h * 64) * 256;
  const bf16_t* VT = (const bf16_t*)(p.ws + WS_VTRT) + (size_t)(b * 512 + h * 64) * 256;
  const float lgf = log1pf(-expf(p.in[25][l * 8 + h]));
  const float lgb = log1pf(-expf(p.in[26][l * 8 + h]));
  f32x4 af[4], ab[4];
#pragma unroll
  for (int nt = 0; nt < 4; ++nt) { af[nt] = f32x4{0.f, 0.f, 0.f, 0.f}; ab[nt] = f32x4{0.f, 0.f, 0.f, 0.f}; }
  for (int ks = 0; ks < 8; ++ks) {
    const int t0 = ks * 32 + fq * 8;
    bf16x8 kraw = *(const bf16x8*)(KT + (size_t)(wid * 16 + fr) * 256 + t0);
    bf16x8 kf, kb;
#pragma unroll
    for (int j = 0; j < 8; ++j) {
      float kv = bfs2f(kraw[j]);
      int t = t0 + j;
      kf[j] = (short)f2bf(kv * __expf(lgf * (float)(255 - t)));
      kb[j] = (short)f2bf(kv * __expf(lgb * (float)t));
    }
#pragma unroll
    for (int nt = 0; nt < 4; ++nt) {
      bf16x8 vb = *(const bf16x8*)(VT + (size_t)(nt * 16 + fr) * 256 + t0);
      af[nt] = MFMA16(kf, vb, af[nt]);
      ab[nt] = MFMA16(kb, vb, ab[nt]);
    }
  }
  float* of = p.out + O_RF + ((size_t)((b * 4 + l) * 8 + h)) * 4096;
  float* ob = p.out + O_RB + ((size_t)((b * 4 + l) * 8 + h)) * 4096;
#pragma unroll
  for (int nt = 0; nt < 4; ++nt)
#pragma unroll
    for (int i = 0; i < 4; ++i) {
      int dk = wid * 16 + fq * 4 + i, dv = nt * 16 + fr;
      of[dk * 64 + dv] = af[nt][i];
      ob[dk * 64 + dv] = ab[nt][i];
    }
}

DI void lru_gates_item(const P& p, int l, int chunk, int n, char* smem) {
  float* XDf = (float*)smem;
  bf16_t* XDb = (bf16_t*)(XDf + 4096);
  const int tid = otid(), lane = tid & 63, wid = tid >> 6, fr = lane & 15, fq = lane >> 4;
  const int row0 = chunk * 64;
  const bool latent = row0 >= NCTX;
  const int T = latent ? 2048 : 256;
  const int tseq0 = latent ? ((row0 - NCTX) & 2047) : (row0 & 255);
  const bf16_t* Z = (const bf16_t*)(p.ws + WS_Z);
  const bf16_t* WL = (const bf16_t*)(p.ws + WS_WLRU);
  bf16_t* LA = (bf16_t*)(p.ws + WS_LA);
  bf16_t* LU = (bf16_t*)(p.ws + WS_LU);
  const int ch0 = n * 64;
  {
    const float cw0 = p.in[28][(l * 4 + 0) * 512 + ch0 + lane];
    const float cw1 = p.in[28][(l * 4 + 1) * 512 + ch0 + lane];
    const float cw2 = p.in[28][(l * 4 + 2) * 512 + ch0 + lane];
    const float cw3 = p.in[28][(l * 4 + 3) * 512 + ch0 + lane];
    const float cb = p.in[29][l * 512 + ch0 + lane];
    const bf16_t* xcol = Z + (size_t)row0 * ZLD + ZC_LRX + ch0 + lane;
    const int t0 = wid * 16;
    auto ld = [&](int tl) -> float {
      int ts = tseq0 + tl;
      return (ts < 0 || ts >= T) ? 0.f : bf2f(xcol[(ptrdiff_t)tl * ZLD]);
    };
    float xm1 = ld(t0 - 1), x0 = ld(t0), x1 = ld(t0 + 1);
#pragma unroll
    for (int i = 0; i < 16; ++i) {
      float x2 = ld(t0 + i + 2);
      float xd = cw0 * xm1 + cw1 * x0 + cw2 * x1 + cw3 * x2 + cb;
      XDf[(t0 + i) * 64 + lane] = xd;
      XDb[(t0 + i) * LDT + lane] = f2bf(xd);
      xm1 = x0; x0 = x1; x1 = x2;
    }
  }
  __syncthreads();
  bf16x8 af[2];
#pragma unroll
  for (int ks = 0; ks < 2; ++ks) af[ks] = *(const bf16x8*)(XDb + (wid * 16 + fr) * LDT + ks * 32 + fq * 8);
#pragma unroll 1
  for (int dir = 0; dir < 2; ++dir) {
    const float* bav = (dir == 0 ? p.in[31] : p.in[36]) + l * 512 + ch0;
    const float* bxv = (dir == 0 ? p.in[33] : p.in[38]) + l * 512 + ch0;
    const float* lamv = (dir == 0 ? p.in[34] : p.in[39]) + l * 512 + ch0;
#pragma unroll
    for (int et = 0; et < 4; ++et) {
      f32x4 da = {0.f, 0.f, 0.f, 0.f}, dx = {0.f, 0.f, 0.f, 0.f};
#pragma unroll
      for (int ks = 0; ks < 2; ++ks) {
        bf16x8 wa = *(const bf16x8*)(WL + (size_t)((dir * 2 + 0) * 8 + n) * 4096 + (et * 16 + fr) * 64 + ks * 32 + fq * 8);
        bf16x8 wx = *(const bf16x8*)(WL + (size_t)((dir * 2 + 1) * 8 + n) * 4096 + (et * 16 + fr) * 64 + ks * 32 + fq * 8);
        da = MFMA16(af[ks], wa, da);
        dx = MFMA16(af[ks], wx, dx);
      }
      const int e = et * 16 + fr;
      const float ba_ = bav[e], bx_ = bxv[e];
      const float sp = log1pf(expf(-lamv[e]));
      float lav[4], uv[4];
#pragma unroll
      for (int i = 0; i < 4; ++i) {
        int tl = wid * 16 + fq * 4 + i;
        float rg = sigmoidf_(da[i] + ba_);
        float ig = sigmoidf_(dx[i] + bx_);
        float la = -8.f * rg * sp;
        lav[i] = la;
        uv[i] = sqrtf(1.f - __expf(2.f * la)) * (ig * XDf[tl * 64 + e]);
      }
      const size_t idx = (size_t)dir * 8388608 + ((size_t)chunk * 512 + ch0 + e) * 64 + wid * 16 + fq * 4;
      *(bf16x4*)(LA + idx) = pack4(lav[0], lav[1], lav[2], lav[3]);
      *(bf16x4*)(LU + idx) = pack4(uv[0], uv[1], uv[2], uv[3]);
    }
  }
  __syncthreads();
}

DI void lru_scan_witem(const P& p, int l, int bglob, int g, int lane) {
  const bool latent = bglob >= 32;
  const int T = latent ? 2048 : 256;
  const int rowbase = latent ? NCTX + (bglob - 32) * 2048 : bglob * 256;
  const int chunk0 = rowbase >> 6, nch = T >> 6;
  const int ch = g * 64 + lane;
  const bf16_t* LA = (const bf16_t*)(p.ws + WS_LA);
  const bf16_t* LU = (const bf16_t*)(p.ws + WS_LU);
  bf16_t* HF = (bf16_t*)(p.ws + WS_HF);
  const bf16_t* LG = (const bf16_t*)(p.ws + WS_LG);
  bf16_t* Y4 = (bf16_t*)(p.ws + WS_Y4);
  {
    float h = latent ? p.in[8][((bglob - 32) * 4 + l) * 512 + ch] : 0.f;
    bf16x8 ca[8], cu[8], na[8], nu[8];
    {
      const size_t b0 = ((size_t)chunk0 * 512 + ch) * 64;
#pragma unroll
      for (int q = 0; q < 8; ++q) { ca[q] = *(const bf16x8*)(LA + b0 + q * 8); cu[q] = *(const bf16x8*)(LU + b0 + q * 8); }
    }
    for (int cc = 0; cc < nch; ++cc) {
      const size_t cbase = ((size_t)(chunk0 + cc) * 512 + ch) * 64;
      const int cn = (cc + 1 < nch) ? cc + 1 : cc;
      const size_t nb = ((size_t)(chunk0 + cn) * 512 + ch) * 64;
#pragma unroll
      for (int q = 0; q < 8; ++q) { na[q] = *(const bf16x8*)(LA + nb + q * 8); nu[q] = *(const bf16x8*)(LU + nb + q * 8); }
#pragma unroll
      for (int q = 0; q < 8; ++q) {
        bf16x8 ho;
#pragma unroll
        for (int j = 0; j < 8; ++j) {
          float a = __expf(bfs2f(ca[q][j]));
          h = a * h + bfs2f(cu[q][j]);
          ho[j] = (short)f2bf(h);
        }
        *(bf16x8*)(HF + cbase + q * 8) = ho;
      }
#pragma unroll
      for (int q = 0; q < 8; ++q) { ca[q] = na[q]; cu[q] = nu[q]; }
    }
    if (!latent) p.out[O_LF + (size_t)(bglob * 4 + l) * 512 + ch] = h;
  }
  {
    float h = latent ? p.in[9][((bglob - 32) * 4 + l) * 512 + ch] : 0.f;
    const bf16_t* LAb = LA + 8388608;
    const bf16_t* LUb = LU + 8388608;
    bf16x8 ca[4], cu[4], chf[4], cg_[4], na[4], nu[4], nhf[4], ng[4];
    const int nb_ = 2 * nch;
    {
      const size_t b0 = ((size_t)(chunk0 + nch - 1) * 512 + ch) * 64 + 32;
#pragma unroll
      for (int q = 0; q < 4; ++q) {
        ca[q] = *(const bf16x8*)(LAb + b0 + q * 8); cu[q] = *(const bf16x8*)(LUb + b0 + q * 8);
        chf[q] = *(const bf16x8*)(HF + b0 + q * 8); cg_[q] = *(const bf16x8*)(LG + b0 + q * 8);
      }
    }
    for (int bi = 0; bi < nb_; ++bi) {
      const int chunk = nch - 1 - (bi >> 1), half = 1 - (bi & 1);
      const int bn = (bi + 1 < nb_) ? bi + 1 : bi;
      const int chunkn = nch - 1 - (bn >> 1), halfn = 1 - (bn & 1);
      const size_t nb = ((size_t)(chunk0 + chunkn) * 512 + ch) * 64 + halfn * 32;
#pragma unroll
      for (int q = 0; q < 4; ++q) {
        na[q] = *(const bf16x8*)(LAb + nb + q * 8); nu[q] = *(const bf16x8*)(LUb + nb + q * 8);
        nhf[q] = *(const bf16x8*)(HF + nb + q * 8); ng[q] = *(const bf16x8*)(LG + nb + q * 8);
      }
      bf16_t* yrow = Y4 + (size_t)(rowbase + chunk * 64 + half * 32) * 2048 + 1536 + ch;
#pragma unroll
      for (int q = 3; q >= 0; --q) {
#pragma unroll
        for (int j = 7; j >= 0; --j) {
          float a = __expf(bfs2f(ca[q][j]));
          h = a * h + bfs2f(cu[q][j]);
          float y = (bfs2f(chf[q][j]) + h) * bfs2f(cg_[q][j]);
          yrow[(size_t)(q * 8 + j) * 2048] = f2bf(y);
        }
      }
#pragma unroll
      for (int q = 0; q < 4; ++q) { ca[q] = na[q]; cu[q] = nu[q]; chf[q] = nhf[q]; cg_[q] = ng[q]; }
    }
    if (!latent) p.out[O_LB + (size_t)(bglob * 4 + l) * 512 + ch] = h;
  }
}

DI int next_item(unsigned* ctr, int* s_item) {
  __syncthreads();
  if (threadIdx.x == 0) *s_item = (int)atomicAdd(ctr, 1u);
  __syncthreads();
  return *s_item;
}
DI void phase_mixa(const P& p, int l, char* smem, int* s_item) {
  unsigned* ctr = (unsigned*)(p.ws + WS_BAR + 14336) + l * 2;
  const int NGRAB = 512 + 512;
  for (;;) {
    int q = next_item(ctr, s_item);
    if (q >= NGRAB) break;
    if (q < 512) { diff_item(p, l, true, q >> 7, (q >> 5) & 3, q & 31, smem); continue; }
    q -= 512;
#pragma unroll 1
    for (int u = 0; u < 4; ++u) { const int g = q * 4 + u; lru_gates_item(p, l, g >> 3, g & 7, smem); }
  }
}
DI void phase_mixb(const P& p, int l, char* smem, int* s_item) {
  unsigned* ctr = (unsigned*)(p.ws + WS_BAR + 14336) + l * 2 + 1;
  const int NGRAB = 72 + 1024 + 1024 + 256 + 256 + 256 + 32;
  for (;;) {
    int q = next_item(ctr, s_item);
    if (q >= NGRAB) break;
    if (q < 72) {
      const int tid = otid(), lane = tid & 63, wid = tid >> 6;
      int bglob, g;
      if (q < 32) {
        if (wid == 0) { bglob = 32 + (q >> 3); g = q & 7; }
        else { int ci = q * 3 + wid - 1; bglob = ci >> 3; g = ci & 7; }
      } else {
        int ci = 96 + (q - 32) * 4 + wid;
        bglob = ci >> 3; g = ci & 7;
      }
      lru_scan_witem(p, l, bglob, g, lane);
      continue;
    }
    q -= 72;
    if (q < 1024) { ret_item(p, l, true, q >> 8, (q >> 5) & 7, q & 31, smem); continue; }
    q -= 1024;
    if (q < 1024) { na_item(p, l, q >> 8, (q >> 5) & 7, q & 31, smem); continue; }
    q -= 1024;
    if (q < 256) {
#pragma unroll 1
      for (int u = 0; u < 2; ++u) { const int g = q * 2 + u; diff_item(p, l, false, g >> 4, (g >> 2) & 3, g & 3, smem); }
      continue;
    }
    q -= 256;
    if (q < 256) {
#pragma unroll 1
      for (int u = 0; u < 4; ++u) { const int g = q * 4 + u; dense_item(p, g >> 5, (g >> 2) & 7, g & 3, smem); }
      continue;
    }
    q -= 256;
    if (q < 256) {
#pragma unroll 1
      for (int u = 0; u < 4; ++u) { const int g = q * 4 + u; ret_item(p, l, false, g >> 5, (g >> 2) & 7, g & 3, smem); }
      continue;
    }
    q -= 256;
#pragma unroll 1
    for (int u = 0; u < 8; ++u) { const int g = q * 8 + u; ret_state_item(p, l, g >> 3, g & 7); }
  }
}

#define XB_TMO 128
#define XB_XCNT(j) (256 + 64 * (j))
#define XB_XSUB(j) (1280 + 64 * (j))
#define XB_XGEN(j) (2304 + 64 * (j))
#define XB_TOP 3328
#define XB_TOPGEN 3392
#define XCD_BAR_WORDS 3456
#define XB_SPIN_CAP (1u << 18)
#define LAS __attribute__((address_space(3)))
DI unsigned xb_ld(unsigned* p) { return __hip_atomic_load(p, __ATOMIC_RELAXED, __HIP_MEMORY_SCOPE_AGENT); }
DI unsigned xb_add(unsigned* p, unsigned v) { return __hip_atomic_fetch_add(p, v, __ATOMIC_RELAXED, __HIP_MEMORY_SCOPE_AGENT); }
DI unsigned xb_xcc_id() { return (unsigned)__builtin_amdgcn_s_getreg((3 << 11) | 20) & 0xFu; }
#define XB_SPIN(cond, bar) do { unsigned _sp = 0; while (cond) { __builtin_amdgcn_s_sleep(1); \
    if ((++_sp & 255u) == 0u) { if (xb_ld(&(bar)[XB_TMO])) break; if (_sp > XB_SPIN_CAP) { atomicAdd(&(bar)[XB_TMO], 1u); break; } } } } while (0)
struct XcdBarrier { unsigned* bar; unsigned x; volatile LAS unsigned* st; };
DI XcdBarrier xcd_barrier_post(unsigned* bar, volatile LAS unsigned* st) {
  XcdBarrier b; b.bar = bar; b.x = xb_xcc_id(); b.st = st;
  if (threadIdx.x == 0) (void)xb_add(&bar[XB_XCNT(b.x)], 1u);
  return b;
}
DI void xcd_barrier_complete(unsigned* bar, unsigned x, unsigned& nloc, unsigned& nx) {
  const unsigned G = gridDim.x * gridDim.y * gridDim.z;
  unsigned sum, cnt, mine, sp = 0u;
  for (;;) {
    sum = 0u; cnt = 0u; mine = 0u;
#pragma unroll
    for (unsigned j = 0; j < 16; ++j) { const unsigned c = xb_ld(&bar[XB_XCNT(j)]); sum += c; cnt += (c > 0u) ? 1u : 0u; mine = (j == x) ? c : mine; }
    if (sum == G) break;
    __builtin_amdgcn_s_sleep(1);
    if ((++sp & 255u) == 0u) { if (xb_ld(&bar[XB_TMO])) break; if (sp > XB_SPIN_CAP) { atomicAdd(&bar[XB_TMO], 1u); break; } }
  }
  nloc = mine > 0u ? mine : 1u; nx = cnt > 0u ? cnt : 1u;
}
DI void xcd_barrier(const XcdBarrier& b) {
  asm volatile("s_waitcnt vmcnt(0)" ::: "memory");
  __syncthreads();
  if (threadIdx.x == 0) {
    unsigned* bar = b.bar;
    __builtin_amdgcn_s_waitcnt(0);
    unsigned nloc = b.st[0], nx = b.st[1];
    if (nloc == 0u) { xcd_barrier_complete(bar, b.x, nloc, nx); b.st[0] = nloc; b.st[1] = nx; }
    const unsigned old = xb_add(&bar[XB_XSUB(b.x)], 1u);
    const unsigned gen = old / nloc;
    if (old + 1u == (gen + 1u) * nloc) {
      __builtin_amdgcn_fence(__ATOMIC_RELEASE, "agent");
      asm volatile("s_waitcnt vmcnt(0)" ::: "memory");
      const unsigned og = xb_add(&bar[XB_TOP], 1u);
      const unsigned tg = og / nx;
      if (og + 1u == (tg + 1u) * nx) xb_add(&bar[XB_TOPGEN], 1u);
      else XB_SPIN(xb_ld(&bar[XB_TOPGEN]) == tg, bar);
      __builtin_amdgcn_fence(__ATOMIC_ACQUIRE, "agent");
      xb_add(&bar[XB_XGEN(b.x)], 1u);
      asm volatile("s_waitcnt vmcnt(0)" ::: "memory");
    } else {
      XB_SPIN(xb_ld(&bar[XB_XGEN(b.x)]) == gen, bar);
      __builtin_amdgcn_fence(__ATOMIC_ACQUIRE, "agent");
      asm volatile("s_waitcnt vmcnt(0)" ::: "memory");
    }
  }
  __syncthreads();
}

enum { PH_INIT = 0, PH_PRE0, PH_GIN, PH_MIXA, PH_MIXB, PH_MERGE, PH_OUT, PH_POSTMIX, PH_FF1, PH_FF2, PH_POSTFFN };

DI void run_phase(const P& p, int ph, int l, char* smem, int* s_item) {
  switch (ph) {
    case PH_INIT:
      phase_mod(p, smem);
      phase_convert(p, 0, smem);
      break;
    case PH_PRE0: phase_row(p, 0, 0); break;
    case PH_GIN: phase_gin(p, l, smem); break;
    case PH_MIXA: phase_mixa(p, l, smem, s_item); break;
    case PH_MIXB: phase_mixb(p, l, smem, s_item); break;
    case PH_MERGE: phase_merge(p, smem); break;
    case PH_OUT:
      phase_gemm_plain<0>((const bf16_t*)(p.ws + WS_H), 1024, (const bf16_t*)(p.ws + WS_WOUT), 1024, (bf16_t*)(p.ws + WS_Y), smem);
      break;
    case PH_POSTMIX: phase_row(p, l, 1); break;
    case PH_FF1:
      phase_gemm_plain<1>((const bf16_t*)(p.ws + WS_H), 1024, (const bf16_t*)(p.ws + WS_W1), 4096, (bf16_t*)(p.ws + WS_U), smem);
      break;
    case PH_FF2:
      phase_gemm_plain<0>((const bf16_t*)(p.ws + WS_U), 4096, (const bf16_t*)(p.ws + WS_W2), 1024, (bf16_t*)(p.ws + WS_Y), smem);
      break;
    case PH_POSTFFN:
      phase_row(p, l, 2);
      if (l < 3) phase_convert(p, l + 1, smem);
      break;
    default: break;
  }
}

DI void decode_step(int step, int& ph, int& l) {
  if (step < 2) { ph = step; l = 0; }
  else { int s = step - 2; l = s / 9; ph = PH_GIN + (s % 9); }
}
constexpr int NSTEPS = 38;

__global__ void __launch_bounds__(256, 2) hybrid_flow_mega(P p) {
  __shared__ __attribute__((aligned(16))) char smem[SMEM_BYTES];
  __shared__ uint4 xb_words;
  __shared__ int s_item;
  cg::grid_group grid = cg::this_grid();
  if (threadIdx.x == 0) xb_words = make_uint4(0u, 0u, 0u, 0u);
  __syncthreads();
  XcdBarrier xb = xcd_barrier_post((unsigned*)(p.ws + WS_BAR), (volatile LAS unsigned*)&xb_words);
  for (int step = 0; step < NSTEPS; ++step) {
    int ph, l;
    decode_step(step, ph, l);
#ifdef PROBE_DUP
    const int reps = (ph == PROBE_DUP) ? 2 : 1;
    for (int rep = 0; rep < reps; ++rep)
#endif
    run_phase(p, ph, l, smem, &s_item);
#ifdef PROBE_CONV
    if (ph == PH_POSTFFN && l < 3) phase_convert(p, l + 1, smem);
#endif
    if (p.ws == nullptr) grid.sync();
    if (step + 1 < NSTEPS) xcd_barrier(xb);
#ifdef PROBE_SYNC
    if (step + 1 < NSTEPS) xcd_barrier(xb);
#endif
  }
}

#if !ONE_LAUNCH
__global__ void __launch_bounds__(256, 2) hybrid_flow_phase(P p, int ph, int l) {
  __shared__ __attribute__((aligned(16))) char smem[SMEM_BYTES];
  __shared__ int s_item;
  run_phase(p, ph, l, smem, &s_item);
}
#endif

extern "C" void kernel_launch(void* const* d_in, const int* in_sizes, int n_in, void* d_out, int out_size, void* d_ws,
                              size_t ws_size, hipStream_t stream) {
  (void)in_sizes; (void)n_in; (void)out_size; (void)ws_size;
  P p{};
  for (int i = 0; i < 44; ++i) p.in[i] = (const float*)d_in[i];
  p.out = (float*)d_out;
  p.ws = (char*)d_ws;
#if ONE_LAUNCH
  static int grid_blocks = 0;
  if (!grid_blocks) {
    int dev = 0, cus = 0, per_cu = 0;
    hipGetDevice(&dev);
    hipDeviceGetAttribute(&cus, hipDeviceAttributeMultiprocessorCount, dev);
    hipOccupancyMaxActiveBlocksPerMultiprocessor(&per_cu, hybrid_flow_mega, 256, 0);
    if (per_cu < 1) per_cu = 1;
    if (per_cu > 2) per_cu = 2;
    grid_blocks = cus * per_cu;
  }
  (void)hipMemsetAsync((char*)d_ws + WS_BAR, 0, 16384, stream);
  void* args[] = {&p};
  hipError_t e = hipLaunchCooperativeKernel((void*)hybrid_flow_mega, dim3(grid_blocks), dim3(256), args, 0, stream);
  if (e != hipSuccess) fprintf(stderr, "cooperative launch failed: %s (grid %d)\n", hipGetErrorString(e), grid_blocks);
#else
  const int grid_blocks = 512;
  for (int step = 0; step < NSTEPS; ++step) {
    int ph, l;
    if (step < 2) { ph = step; l = 0; }
    else { int s = step - 2; l = s / 9; ph = PH_GIN + (s % 9); }
    hipLaunchKernelGGL(hybrid_flow_phase, dim3(grid_blocks), dim3(256), 0, stream, p, ph, l);
  }
#endif
}
```

```cpp
#include <hip/hip_runtime.h>
#include <hip/hip_cooperative_groups.h>
#include <cstdio>
namespace cg = cooperative_groups;

#ifndef ONE_LAUNCH
#define ONE_LAUNCH 1
#endif

typedef unsigned short bf16_t;
using bf16x8 = __attribute__((ext_vector_type(8))) short;
using bf16x4 = __attribute__((ext_vector_type(4))) short;
using f32x4 = __attribute__((ext_vector_type(4))) float;
using u32x4 = __attribute__((ext_vector_type(4))) unsigned;
#define DI __device__ __forceinline__
#define MFMA16(a, b, c) __builtin_amdgcn_mfma_f32_16x16x32_bf16((a), (b), (c), 0, 0, 0)

struct P {
  const float* in[44];
  float* out;
  char* ws;
};

constexpr int D = 1024, NCTX = 8192;
constexpr int ZLD = 4160;
constexpr int ZC_NAQ = 0, ZC_NAK = 512, ZC_DFQ = 1024, ZC_DFK = 1536, ZC_RTQ = 2048, ZC_RTK = 2560, ZC_RTG = 3072,
              ZC_LRX = 3584;
constexpr int LDT = 72;

constexpr size_t WS_WIN = 0;
constexpr size_t WS_WBR = WS_WIN + (size_t)10240 * 1024 * 2;
constexpr size_t WS_WOUT = WS_WBR + (size_t)1024 * 2048 * 2;
constexpr size_t WS_W1 = WS_WOUT + (size_t)1024 * 1024 * 2;
constexpr size_t WS_W2 = WS_W1 + (size_t)4096 * 1024 * 2;
constexpr size_t WS_WLRU = WS_W2 + (size_t)4096 * 1024 * 2;
constexpr size_t WS_CKNA = WS_WLRU + (size_t)32 * 4096 * 2;
constexpr size_t WS_CVNA = WS_CKNA + (size_t)4 * 262144 * 2;
constexpr size_t WS_CKDF = WS_CVNA + (size_t)4 * 262144 * 2;
constexpr size_t WS_CVDF = WS_CKDF + (size_t)4 * 262144 * 2;
constexpr size_t WS_MOD = WS_CVDF + (size_t)4 * 262144 * 2;
constexpr size_t WS_H = WS_MOD + (size_t)4 * 5 * 6144 * 4;
constexpr size_t WS_Y4 = WS_H + (size_t)16384 * 1024 * 2;
constexpr size_t WS_VTNA = WS_Y4 + (size_t)16384 * 2048 * 2;
constexpr size_t WS_VTDF = WS_VTNA + (size_t)16384 * 512 * 2;
constexpr size_t WS_VTRT = WS_VTDF + (size_t)16384 * 512 * 2;
constexpr size_t WS_KTRT = WS_VTRT + (size_t)16384 * 512 * 2;
constexpr size_t WS_Z = WS_KTRT + (size_t)8192 * 512 * 2;
constexpr size_t WS_GF = WS_Z + (size_t)16384 * ZLD * 2;
constexpr size_t WS_Y = WS_Z;
constexpr size_t WS_U = WS_Z + (size_t)16384 * 1024 * 4;
constexpr size_t WS_LA = WS_GF + (size_t)16384 * 4096 * 2;
constexpr size_t WS_LU = WS_LA + (size_t)2 * 16384 * 512 * 2;
constexpr size_t WS_HF = WS_LU + (size_t)2 * 16384 * 512 * 2;
constexpr size_t WS_LG = WS_HF + (size_t)16384 * 512 * 2;
constexpr size_t WS_BAR = WS_LG + (size_t)16384 * 512 * 2;
constexpr size_t WS_END = WS_BAR + 16384;

constexpr size_t O_NAK = 16777216, O_NAV = 33554432, O_DFK = 50331648, O_DFV = 67108864, O_RF = 83886080,
                 O_RB = 88080384, O_LF = 92274688, O_LB = 92340224;
constexpr int VT_LAT = 4194304;

constexpr int SMEM_BYTES = 75776;

DI int otid() {
  int t = threadIdx.x;
  asm volatile("" : "+v"(t));
  return t;
}
typedef __bf16 hwbf2 __attribute__((ext_vector_type(2)));
typedef float f32v2 __attribute__((ext_vector_type(2)));
using u32x2 = __attribute__((ext_vector_type(2))) unsigned;
DI unsigned pk2(float a, float b) {
  f32v2 v = {a, b};
  return __builtin_bit_cast(unsigned, __builtin_convertvector(v, hwbf2));
}
DI bf16_t f2bf(float x) { return (bf16_t)(pk2(x, 0.f) & 0xffffu); }
DI float bf2f(bf16_t b) { return __uint_as_float(((unsigned)b) << 16); }
DI float bfs2f(short b) { return __uint_as_float(((unsigned)(unsigned short)b) << 16); }
DI float wave_sum(float v) {
#pragma unroll
  for (int o = 32; o > 0; o >>= 1) v += __shfl_xor(v, o);
  return v;
}
DI float xmax16(float v) {
  unsigned u = __float_as_uint(v);
  auto r = __builtin_amdgcn_permlane16_swap(u, u, false, false);
  return fmaxf(__uint_as_float(r[0]), __uint_as_float(r[1]));
}
DI float xmax32(float v) {
  unsigned u = __float_as_uint(v);
  auto r = __builtin_amdgcn_permlane32_swap(u, u, false, false);
  return fmaxf(__uint_as_float(r[0]), __uint_as_float(r[1]));
}
DI float xsum16(float v) {
  unsigned u = __float_as_uint(v);
  auto r = __builtin_amdgcn_permlane16_swap(u, u, false, false);
  return __uint_as_float(r[0]) + __uint_as_float(r[1]);
}
DI float xsum32(float v) {
  unsigned u = __float_as_uint(v);
  auto r = __builtin_amdgcn_permlane32_swap(u, u, false, false);
  return __uint_as_float(r[0]) + __uint_as_float(r[1]);
}
DI float sigmoidf_(float x) { return 1.f / (1.f + __expf(-x)); }
DI float gelu_tanh(float x) {
  float u = 0.7978845608028654f * (x + 0.044715f * x * x * x);
  return x * sigmoidf_(2.f * u);
}
DI bf16x8 pack8(const f32x4& a, const f32x4& b) {
  u32x4 r = {pk2(a[0], a[1]), pk2(a[2], a[3]), pk2(b[0], b[1]), pk2(b[2], b[3])};
  return __builtin_bit_cast(bf16x8, r);
}
DI bf16x4 pack4(float a, float b, float c, float d) {
  u32x2 r = {pk2(a, b), pk2(c, d)};
  return __builtin_bit_cast(bf16x4, r);
}

constexpr int GEMM_BUF_BYTES = 32768;
DI int swz_off(int rr, int c4) {
  int ob = rr * 64 + c4 * 16;
  return ob ^ (((ob >> 9) & 1) << 5);
}
template <int NI>
DI void gemm_mainloop(const bf16_t* __restrict__ A, int lda, const bf16_t* __restrict__ Bt, int ldb, int K, int row0,
                      int col0, char* smem, f32x4 (&acc)[4][NI]) {
  const int tid = otid(), lane = tid & 63, wid = tid >> 6;
  const int wm = wid >> 1, wn = wid & 1, fr = lane & 15, fq = lane >> 4;
  const int c4 = tid & 3, kh = (tid >> 3) & 1;
  const int srow = ((tid >> 4) << 1) + ((tid >> 2) & 1);
  const int gk = (kh * 4 + c4) * 8;
  const int soff = ((srow >> 4) * 2 + kh) * 1024 + swz_off(srow & 15, c4);
  const bf16_t* Ag = A + (size_t)(row0 + srow) * lda + gk;
  const bf16_t* Bg = Bt + (size_t)(col0 + srow) * ldb + gk;
  const int aoff = wm * 8192 + swz_off(fr, fq);
  const int boff = 16384 + wn * NI * 2048 + swz_off(fr, fq);
  u32x4 ra[4], rb[NI];
#pragma unroll
  for (int i = 0; i < 4; ++i) ra[i] = *(const u32x4*)(Ag + (size_t)(i * 32) * lda);
#pragma unroll
  for (int i = 0; i < NI; ++i) rb[i] = *(const u32x4*)(Bg + (size_t)(i * 32) * ldb);
#pragma unroll
  for (int i = 0; i < 4; ++i) *(u32x4*)(smem + soff + i * 4096) = ra[i];
#pragma unroll
  for (int i = 0; i < NI; ++i) *(u32x4*)(smem + 16384 + soff + i * 4096) = rb[i];
  __syncthreads();
  const int nk = K >> 6;
  for (int kt = 0; kt < nk; ++kt) {
    const bool more = (kt + 1) < nk;
    if (more) {
      const int k1 = (kt + 1) * 64;
#pragma unroll
      for (int i = 0; i < 4; ++i) ra[i] = *(const u32x4*)(Ag + (size_t)(i * 32) * lda + k1);
#pragma unroll
      for (int i = 0; i < NI; ++i) rb[i] = *(const u32x4*)(Bg + (size_t)(i * 32) * ldb + k1);
    }
    asm volatile("" ::: "memory");
    const char* sb = smem + (kt & 1) * GEMM_BUF_BYTES;
#pragma unroll
    for (int ks = 0; ks < 2; ++ks) {
      bf16x8 af[4], bfr[NI];
#pragma unroll
      for (int mi = 0; mi < 4; ++mi) af[mi] = *(const bf16x8*)(sb + aoff + mi * 2048 + ks * 1024);
#pragma unroll
      for (int ni = 0; ni < NI; ++ni) bfr[ni] = *(const bf16x8*)(sb + boff + ni * 2048 + ks * 1024);
#pragma unroll
      for (int mi = 0; mi < 4; ++mi)
#pragma unroll
        for (int ni = 0; ni < NI; ++ni) acc[mi][ni] = MFMA16(bfr[ni], af[mi], acc[mi][ni]);
    }
    __builtin_amdgcn_sched_barrier(0);
    if (more) {
      char* db = smem + ((kt + 1) & 1) * GEMM_BUF_BYTES;
#pragma unroll
      for (int i = 0; i < 4; ++i) *(u32x4*)(db + soff + i * 4096) = ra[i];
#pragma unroll
      for (int i = 0; i < NI; ++i) *(u32x4*)(db + 16384 + soff + i * 4096) = rb[i];
    }
    __syncthreads();
  }
}

DI void zero_acc(f32x4 (&acc)[4][4]) {
#pragma unroll
  for (int mi = 0; mi < 4; ++mi)
#pragma unroll
    for (int ni = 0; ni < 4; ++ni) acc[mi][ni] = f32x4{0.f, 0.f, 0.f, 0.f};
}
DI bool tile_sched(int iter, int tmt, int ntn, int& tm, int& tn) {
  const int G = gridDim.x, b = blockIdx.x;
  if ((G & 63) == 0 && (ntn & 7) == 0 && (tmt & 7) == 0) {
    const int groups = G >> 6, xg = b % groups, j = b / groups;
    const int srows = tmt >> 3;
    const int s = iter * groups + xg, nsuper = srows * (ntn >> 3);
    if (s >= nsuper) return false;
    tm = (s % srows) * 8 + (j & 7);
    tn = (s / srows) * 8 + (j >> 3);
    return true;
  }
  const int id = b + iter * G;
  if (id >= tmt * ntn) return false;
  tm = id % tmt;
  tn = id / tmt;
  return true;
}

constexpr int G2_STAGE = 24576;
DI void zero_acc2(f32x4 (&acc)[8][4]) {
#pragma unroll
  for (int mi = 0; mi < 8; ++mi)
#pragma unroll
    for (int ni = 0; ni < 4; ++ni) acc[mi][ni] = f32x4{0.f, 0.f, 0.f, 0.f};
}
DI void gemm2_mainloop(const bf16_t* __restrict__ A, int lda, const bf16_t* __restrict__ Bt, int ldb, int K, int row0,
                       int col0, char* smem, f32x4 (&acc)[8][4]) {
  const int tid = otid(), lane = tid & 63, wid = tid >> 6;
  const int wm = wid >> 1, wn = wid & 1, fr = lane & 15, fq = lane >> 4;
  const int c4 = tid & 3, srow = tid >> 2;
  const int soff = (srow >> 4) * 1024 + swz_off(srow & 15, c4);
  const bf16_t* Ag = A + (size_t)(row0 + srow) * lda + c4 * 8;
  const bf16_t* Bg = Bt + (size_t)(col0 + srow) * ldb + c4 * 8;
  const int aoff = wm * 8192 + swz_off(fr, fq);
  const int boff = 16384 + wn * 4096 + swz_off(fr, fq);
  u32x4 raA[4], rbA[2], raB[4], rbB[2];
  const int nk = K >> 5;
  auto gload = [&](int kt, u32x4 (&ra)[4], u32x4 (&rb)[2]) __attribute__((always_inline)) {
    const int k1 = kt * 32;
#pragma unroll
    for (int i = 0; i < 4; ++i) ra[i] = *(const u32x4*)(Ag + (size_t)(i * 64) * lda + k1);
#pragma unroll
    for (int i = 0; i < 2; ++i) rb[i] = *(const u32x4*)(Bg + (size_t)(i * 64) * ldb + k1);
  };
  auto sstore = [&](int st, const u32x4 (&ra)[4], const u32x4 (&rb)[2]) __attribute__((always_inline)) {
    char* db = smem + st * G2_STAGE;
#pragma unroll
    for (int i = 0; i < 4; ++i) *(u32x4*)(db + soff + i * 4096) = ra[i];
#pragma unroll
    for (int i = 0; i < 2; ++i) *(u32x4*)(db + 16384 + soff + i * 4096) = rb[i];
  };
  auto step = [&](int st, int ktn, u32x4 (&ra)[4], u32x4 (&rb)[2], const u32x4 (&wa)[4], const u32x4 (&wb)[2]) __attribute__((always_inline)) {
    const char* sb = smem + st * G2_STAGE;
    bf16x8 bfr[4];
#pragma unroll
    for (int ni = 0; ni < 4; ++ni) bfr[ni] = *(const bf16x8*)(sb + boff + ni * 1024);
    bf16x8 af0 = *(const bf16x8*)(sb + aoff);
    asm volatile("" ::: "memory");
    gload(ktn, ra, rb);
    asm volatile("" ::: "memory");
    __builtin_amdgcn_s_setprio(1);
#pragma unroll
    for (int mi = 0; mi < 4; ++mi) {
      bf16x8 af = af0;
      if (mi > 0) af = *(const bf16x8*)(sb + aoff + mi * 1024);
#pragma unroll
      for (int ni = 0; ni < 4; ++ni) acc[mi][ni] = MFMA16(bfr[ni], af, acc[mi][ni]);
    }
    __builtin_amdgcn_s_setprio(0);
    __builtin_amdgcn_sched_barrier(0);
    sstore(st ^ 1, wa, wb);
    __builtin_amdgcn_sched_barrier(0);
    __builtin_amdgcn_s_setprio(1);
#pragma unroll
    for (int mi = 4; mi < 8; ++mi) {
      bf16x8 af = *(const bf16x8*)(sb + aoff + mi * 1024);
#pragma unroll
      for (int ni = 0; ni < 4; ++ni) acc[mi][ni] = MFMA16(bfr[ni], af, acc[mi][ni]);
    }
    __builtin_amdgcn_s_setprio(0);
  };
  gload(0, raA, rbA);
  gload(1, raB, rbB);
  sstore(0, raA, rbA);
  __syncthreads();
  for (int kt = 0; kt < nk; kt += 2) {
    step(0, kt + 2 < nk ? kt + 2 : nk - 1, raA, rbA, raB, rbB);
    __syncthreads();
    step(1, kt + 3 < nk ? kt + 3 : nk - 1, raB, rbB, raA, rbA);
    __syncthreads();
  }
}

constexpr int G3_STAGE = 16384;
DI void gemm3_mainloop(const bf16_t* __restrict__ A, int lda, const bf16_t* __restrict__ Bt, int ldb, int K, int row0,
                       int col0, char* smem, f32x4 (&acc)[4][4]) {
  const int tid = otid(), lane = tid & 63, wid = tid >> 6;
  const int wm = wid >> 1, wn = wid & 1, fr = lane & 15, fq = lane >> 4;
  const int c4 = tid & 3, srow = tid >> 2;
  const int soff = (srow >> 4) * 1024 + swz_off(srow & 15, c4);
  const bf16_t* Ag = A + (size_t)(row0 + srow) * lda + c4 * 8;
  const bf16_t* Bg = Bt + (size_t)(col0 + srow) * ldb + c4 * 8;
  const int aoff = wm * 4096 + swz_off(fr, fq);
  const int boff = 8192 + wn * 4096 + swz_off(fr, fq);
  u32x4 ra[2], rb[2];
#pragma unroll
  for (int i = 0; i < 2; ++i) { ra[i] = *(const u32x4*)(Ag + (size_t)(i * 64) * lda); rb[i] = *(const u32x4*)(Bg + (size_t)(i * 64) * ldb); }
#pragma unroll
  for (int i = 0; i < 2; ++i) { *(u32x4*)(smem + soff + i * 4096) = ra[i]; *(u32x4*)(smem + 8192 + soff + i * 4096) = rb[i]; }
  __syncthreads();
  const int nk = K >> 5;
  for (int kt = 0; kt < nk; ++kt) {
    const bool more = (kt + 1) < nk;
    if (more) {
      const int k1 = (kt + 1) * 32;
#pragma unroll
      for (int i = 0; i < 2; ++i) { ra[i] = *(const u32x4*)(Ag + (size_t)(i * 64) * lda + k1); rb[i] = *(const u32x4*)(Bg + (size_t)(i * 64) * ldb + k1); }
    }
    asm volatile("" ::: "memory");
    const char* sb = smem + (kt & 1) * G3_STAGE;
    bf16x8 bfr[4];
#pragma unroll
    for (int ni = 0; ni < 4; ++ni) bfr[ni] = *(const bf16x8*)(sb + boff + ni * 1024);
    __builtin_amdgcn_s_setprio(1);
#pragma unroll
    for (int mi = 0; mi < 4; ++mi) {
      bf16x8 af = *(const bf16x8*)(sb + aoff + mi * 1024);
#pragma unroll
      for (int ni = 0; ni < 4; ++ni) acc[mi][ni] = MFMA16(bfr[ni], af, acc[mi][ni]);
    }
    __builtin_amdgcn_s_setprio(0);
    __builtin_amdgcn_sched_barrier(0);
    if (more) {
      char* db = smem + ((kt + 1) & 1) * G3_STAGE;
#pragma unroll
      for (int i = 0; i < 2; ++i) { *(u32x4*)(db + soff + i * 4096) = ra[i]; *(u32x4*)(db + 8192 + soff + i * 4096) = rb[i]; }
    }
    __syncthreads();
  }
}

constexpr int CST_B = 272;
constexpr int CST_T = 528;
template <int MI, int NI, class F>
DI void stage_rowmajor(char* smem, f32x4 (&acc)[MI][NI], int wm, int wn, int fr, int fq, F&& tf) {
#pragma unroll
  for (int mi = 0; mi < MI; ++mi)
#pragma unroll
    for (int ni = 0; ni < NI; ++ni) {
      f32x4 v = tf(acc[mi][ni]);
      *(bf16x4*)(smem + (wm * MI * 16 + mi * 16 + fr) * CST_B + (wn * NI * 16 + ni * 16 + fq * 4) * 2) = pack4(v[0], v[1], v[2], v[3]);
      if (ni == NI - 1) __builtin_amdgcn_sched_barrier(0);
    }
}
template <int MI, int NI, class F>
DI void stage_transposed(char* smem, f32x4 (&acc)[MI][NI], int wm, int wn, int fr, int fq, F&& tf) {
#pragma unroll
  for (int mi = 0; mi < MI; ++mi)
#pragma unroll
    for (int ni = 0; ni < NI; ++ni) {
      f32x4 v = tf(acc[mi][ni]);
      char* base = smem + (wn * NI * 16 + ni * 16 + fq * 4) * CST_T + (wm * MI * 16 + mi * 16 + fr) * 2;
      *(bf16_t*)(base) = f2bf(v[0]);
      *(bf16_t*)(base + CST_T) = f2bf(v[1]);
      *(bf16_t*)(base + 2 * CST_T) = f2bf(v[2]);
      *(bf16_t*)(base + 3 * CST_T) = f2bf(v[3]);
      if (ni == NI - 1) __builtin_amdgcn_sched_barrier(0);
    }
}
template <int LINES, int CPL, int STRIDE, class D>
DI void writeout(const char* smem, int tid, D&& dst) {
#pragma unroll 4
  for (int j = 0; j < LINES * CPL / 256; ++j) {
    const int id = tid + j * 256, line = id / CPL, c = id % CPL;
    u32x4 v = *(const u32x4*)(smem + line * STRIDE + c * 16);
    *(u32x4*)dst(line, c) = v;
  }
}

DI void stage_rowmajor_rope(char* smem, f32x4 (&acc)[8][4], int wm, int wn, int fr, int fq, int rtok) {
  float inv[4];
#pragma unroll
  for (int i = 0; i < 4; ++i) inv[i] = exp2f(-(float)(fq * 4 + i) * 0.8304820237218406f);
#pragma unroll
  for (int mi = 0; mi < 8; ++mi) {
    const int t = (rtok + mi * 16 - NCTX) & 2047;
    const float gr = (float)(t >> 6), gc = (float)(t & 63);
    f32x4 o0, o1, o2, o3;
#pragma unroll
    for (int i = 0; i < 4; ++i) {
      const float sr = __sinf(gr * inv[i]), cr = __cosf(gr * inv[i]);
      const float sc = __sinf(gc * inv[i]), cc = __cosf(gc * inv[i]);
      const float a0 = acc[mi][0][i], a1 = acc[mi][1][i], a2 = acc[mi][2][i], a3 = acc[mi][3][i];
      o0[i] = a0 * cr - a1 * sr;
      o1[i] = a1 * cr + a0 * sr;
      o2[i] = a2 * cc - a3 * sc;
      o3[i] = a3 * cc + a2 * sc;
    }
    char* base = smem + (wm * 128 + mi * 16 + fr) * CST_B + (wn * 64 + fq * 4) * 2;
    *(bf16x4*)(base) = pack4(o0[0], o0[1], o0[2], o0[3]);
    *(bf16x4*)(base + 32) = pack4(o1[0], o1[1], o1[2], o1[3]);
    *(bf16x4*)(base + 64) = pack4(o2[0], o2[1], o2[2], o2[3]);
    *(bf16x4*)(base + 96) = pack4(o3[0], o3[1], o3[2], o3[3]);
    __builtin_amdgcn_sched_barrier(0);
  }
}

DI void epi_in(const P& p, int l, int row0, int col0, f32x4 (&acc)[8][4], char* smem) {
  const int tid_ = otid(), lane = tid_ & 63, wid = tid_ >> 6, wm = wid >> 1, wn = wid & 1, fr = lane & 15, fq = lane >> 4;
  const int seg = col0 >> 9;
  const bool ctx = row0 < NCTX;
  if (seg >= 12) {
    bf16_t* GF = (bf16_t*)(p.ws + WS_GF);
    const int k = (seg - 12) >> 1, tn = ((col0 - 6144) & 1023) >> 7, tm = row0 >> 8;
    bf16_t* dst = GF + (((size_t)k * 64 + tm) * 8 + tn) * 32768 + tid_ * 4;
#pragma unroll
    for (int mi = 0; mi < 8; ++mi)
#pragma unroll
      for (int ni = 0; ni < 4; ++ni)
        *(bf16x4*)(dst + (mi * 4 + ni) * 1024) = pack4(sigmoidf_(acc[mi][ni][0]), sigmoidf_(acc[mi][ni][1]), sigmoidf_(acc[mi][ni][2]), sigmoidf_(acc[mi][ni][3]));
    return;
  }
  const int ctile = col0 & 511;
  const int cseg0 = ctile + wn * 64;
  const int rtok = row0 + wm * 128 + fr;
  if (ctx && (seg == 1 || seg == 2 || seg == 4 || seg == 5)) {
    float* out = p.out;
#pragma unroll
    for (int mi = 0; mi < 8; ++mi) {
      const int r = rtok + mi * 16, b = r >> 8, t = r & 255;
      size_t off;
      if (seg == 1 || seg == 2) {
        const int h = cseg0 >> 6;
        off = (seg == 1 ? O_NAK : O_NAV) + (((size_t)(b * 4 + l) * 8 + h) * 256 + t) * 64;
      } else if (seg == 4) {
        const int comp = cseg0 >> 8, h = (cseg0 >> 6) & 3;
        off = O_DFK + ((((size_t)(b * 4 + l) * 2 + comp) * 4 + h) * 256 + t) * 64;
      } else {
        const int h = cseg0 >> 7;
        off = O_DFV + (((size_t)(b * 4 + l) * 4 + h) * 256 + t) * 128 + (cseg0 & 127);
      }
#pragma unroll
      for (int ni = 0; ni < 4; ++ni) *(f32x4*)(out + off + ni * 16 + fq * 4) = acc[mi][ni];
      __builtin_amdgcn_sched_barrier(0);
    }
  }
  auto tf_none = [](const f32x4& a) -> f32x4 { return a; };
  auto tf_scale = [](const f32x4& a) -> f32x4 { return f32x4{a[0] * 0.125f, a[1] * 0.125f, a[2] * 0.125f, a[3] * 0.125f}; };
  auto tf_silu = [](const f32x4& a) -> f32x4 { return f32x4{a[0] * sigmoidf_(a[0]), a[1] * sigmoidf_(a[1]), a[2] * sigmoidf_(a[2]), a[3] * sigmoidf_(a[3])}; };
  auto tf_gelu = [](const f32x4& a) -> f32x4 { return f32x4{gelu_tanh(a[0]), gelu_tanh(a[1]), gelu_tanh(a[2]), gelu_tanh(a[3])}; };
  const bool rowmajor = !(seg == 2 || seg == 5 || seg == 8 || seg == 11);
  if (rowmajor) {
    int zc;
    switch (seg) {
      case 0: zc = ZC_NAQ; break;
      case 1: zc = ZC_NAK; break;
      case 3: zc = ZC_DFQ; break;
      case 4: zc = ZC_DFK; break;
      case 6: zc = ZC_RTQ; break;
      case 7: zc = ZC_RTK; break;
      case 9: zc = ZC_RTG; break;
      default: zc = ZC_LRX; break;
    }
    if (!ctx && (seg == 3 || seg == 4)) stage_rowmajor_rope(smem, acc, wm, wn, fr, fq, rtok);
    else if (seg == 7) stage_rowmajor<8, 4>(smem, acc, wm, wn, fr, fq, tf_scale);
    else if (seg == 9) stage_rowmajor<8, 4>(smem, acc, wm, wn, fr, fq, tf_silu);
    else stage_rowmajor<8, 4>(smem, acc, wm, wn, fr, fq, tf_none);
    __syncthreads();
    bf16_t* zb = (bf16_t*)(p.ws + WS_Z) + (size_t)row0 * ZLD + zc + ctile;
    writeout<256, 16, CST_B>(smem, tid_, [&](int line, int c) { return zb + (size_t)line * ZLD + c * 8; });
    __syncthreads();
  }
  if (!rowmajor || (seg == 7 && ctx)) {
    if (seg == 7) stage_transposed<8, 4>(smem, acc, wm, wn, fr, fq, tf_scale);
    else if (seg == 11) stage_transposed<8, 4>(smem, acc, wm, wn, fr, fq, tf_gelu);
    else stage_transposed<8, 4>(smem, acc, wm, wn, fr, fq, tf_none);
    __syncthreads();
    if (seg == 11) {
      bf16_t* lg = (bf16_t*)(p.ws + WS_LG) + ((size_t)(row0 >> 6) * 512 + ctile) * 64;
      writeout<128, 32, CST_T>(smem, tid_, [&](int line, int c) { return lg + ((size_t)(c >> 3) * 512 + line) * 64 + (c & 7) * 8; });
    } else {
      bf16_t* tb = (bf16_t*)(p.ws + (seg == 2 ? WS_VTNA : seg == 5 ? WS_VTDF : seg == 8 ? WS_VTRT : WS_KTRT));
      int T;
      if (ctx) { T = 256; tb += ((size_t)((row0 >> 8) * 512 + ctile)) * 256 + (row0 & 255); }
      else { const int rr = row0 - NCTX; T = 2048; tb += (size_t)VT_LAT + ((size_t)((rr >> 11) * 512 + ctile)) * 2048 + (rr & 2047); }
      writeout<128, 32, CST_T>(smem, tid_, [&](int line, int c) { return tb + (size_t)line * T + c * 8; });
    }
    __syncthreads();
  }
}

DI void phase_gin(const P& p, int l, char* smem) {
  const bf16_t* A = (const bf16_t*)(p.ws + WS_H);
  const bf16_t* Bt = (const bf16_t*)(p.ws + WS_WIN);
  for (int it = 0;; ++it) {
    int tm, tn;
    if (!tile_sched(it, 64, 80, tm, tn)) break;
    f32x4 acc[8][4];
    zero_acc2(acc);
    gemm2_mainloop(A, 1024, Bt, 1024, 1024, tm * 256, tn * 128, smem, acc);
    epi_in(p, l, tm * 256, tn * 128, acc, smem);
  }
}

DI void phase_merge(const P& p, char* smem) {
  const bf16_t* Y4 = (const bf16_t*)(p.ws + WS_Y4);
  const bf16_t* WB = (const bf16_t*)(p.ws + WS_WBR);
  const bf16_t* GF = (const bf16_t*)(p.ws + WS_GF);
  bf16_t* G = (bf16_t*)(p.ws + WS_H);
  const int tid_ = otid(), lane = tid_ & 63, wid = tid_ >> 6, wm = wid >> 1, wn = wid & 1, fr = lane & 15, fq = lane >> 4;
  for (int it = 0;; ++it) {
    int tm, tn;
    if (!tile_sched(it, 128, 8, tm, tn)) break;
    const int row0 = tm * 128, col0 = tn * 128;
    f32x4 o[4][4];
    zero_acc(o);
#pragma unroll 1
    for (int k = 0; k < 4; ++k) {
      f32x4 acc[4][4];
      zero_acc(acc);
      gemm3_mainloop(Y4 + k * 512, 2048, WB + k * 512, 2048, 512, row0, col0, smem, acc);
      const bf16_t* gsrc = GF + (((size_t)k * 64 + (tm >> 1)) * 8 + tn) * 32768 + (((tm & 1) * 2 + wn) * 64 + lane) * 4 + (wm * 16) * 1024;
#pragma unroll
      for (int mi = 0; mi < 4; ++mi) {
        bf16x4 gq[4];
#pragma unroll
        for (int ni = 0; ni < 4; ++ni) gq[ni] = *(const bf16x4*)(gsrc + (mi * 4 + ni) * 1024);
#pragma unroll
        for (int ni = 0; ni < 4; ++ni)
#pragma unroll
          for (int i = 0; i < 4; ++i) o[mi][ni][i] += bfs2f(gq[ni][i]) * acc[mi][ni][i];
      }
    }
    stage_rowmajor<4, 4>(smem, o, wm, wn, fr, fq, [](const f32x4& a) { return a; });
    __syncthreads();
    bf16_t* gb = G + (size_t)row0 * 1024 + col0;
    writeout<128, 16, CST_B>(smem, tid_, [&](int line, int c) { return gb + (size_t)line * 1024 + c * 8; });
    __syncthreads();
  }
}

template <int MODE>
DI void phase_gemm_plain(const bf16_t* A, int K, const bf16_t* Bt, int N, bf16_t* outp, char* smem) {
  const int tid_ = otid(), lane = tid_ & 63, wid = tid_ >> 6, wm = wid >> 1, wn = wid & 1, fr = lane & 15, fq = lane >> 4;
  const int ntn = N / 128;
  for (int it = 0;; ++it) {
    int tm, tn;
    if (!tile_sched(it, 64, ntn, tm, tn)) break;
    const int row0 = tm * 256, col0 = tn * 128;
    f32x4 acc[8][4];
    zero_acc2(acc);
    gemm2_mainloop(A, K, Bt, K, K, row0, col0, smem, acc);
    stage_rowmajor<8, 4>(smem, acc, wm, wn, fr, fq, [](const f32x4& a) {
      f32x4 v = a;
      if (MODE == 1) {
        v[0] = fmaxf(v[0], 0.f); v[1] = fmaxf(v[1], 0.f); v[2] = fmaxf(v[2], 0.f); v[3] = fmaxf(v[3], 0.f);
        v[0] *= v[0]; v[1] *= v[1]; v[2] *= v[2]; v[3] *= v[3];
      }
      return v;
    });
    __syncthreads();
    bf16_t* ob = outp + (size_t)row0 * N + col0;
    writeout<256, 16, CST_B>(smem, tid_, [&](int line, int c) { return ob + (size_t)line * N + c * 8; });
    __syncthreads();
  }
}

DI void phase_mod(const P& p, char* smem) {
  float* ssil = (float*)smem;
  float* red = ssil + 5 * 1024;
  const int tid = otid();
  float* MOD = (float*)(p.ws + WS_MOD);
  for (int idx = tid; idx < 5120; idx += 256) {
    int j = idx >> 10, k = idx & 1023;
    float cv = (j == 0) ? p.in[11][k] : p.in[10][(j - 1) * 1024 + k];
    ssil[idx] = cv / (1.f + expf(-cv));
  }
  __syncthreads();
  const int cl = tid & 63, kg = tid >> 6;
  for (int item = blockIdx.x; item < 384; item += gridDim.x) {
    int l = item / 96, cgp = item % 96;
    int col = cgp * 64 + cl;
    const float* W = p.in[12] + (size_t)l * 1024 * 6144 + col;
    float a0 = 0, a1 = 0, a2 = 0, a3 = 0, a4 = 0;
#pragma unroll 8
    for (int k = kg * 256; k < kg * 256 + 256; ++k) {
      float w = W[(size_t)k * 6144];
      a0 += ssil[k] * w;
      a1 += ssil[1024 + k] * w;
      a2 += ssil[2048 + k] * w;
      a3 += ssil[3072 + k] * w;
      a4 += ssil[4096 + k] * w;
    }
    red[(kg * 5 + 0) * 64 + cl] = a0;
    red[(kg * 5 + 1) * 64 + cl] = a1;
    red[(kg * 5 + 2) * 64 + cl] = a2;
    red[(kg * 5 + 3) * 64 + cl] = a3;
    red[(kg * 5 + 4) * 64 + cl] = a4;
    __syncthreads();
    if (kg == 0) {
      float bias = p.in[13][l * 6144 + col];
#pragma unroll
      for (int j = 0; j < 5; ++j) {
        float s = red[(0 * 5 + j) * 64 + cl] + red[(1 * 5 + j) * 64 + cl] + red[(2 * 5 + j) * 64 + cl] + red[(3 * 5 + j) * 64 + cl];
        MOD[(size_t)(l * 5 + j) * 6144 + col] = s + bias;
      }
    }
    __syncthreads();
  }
}

DI void transpose_tile(const float* __restrict__ src, int lds_, bf16_t* __restrict__ dst, int ldd, float* tile) {
  const int tid = otid();
#pragma unroll 4
  for (int i = 0; i < 16; ++i) {
    int idx = tid + i * 256, r = idx >> 6, c = idx & 63;
    tile[r * 65 + c] = src[(size_t)r * lds_ + c];
  }
  __syncthreads();
#pragma unroll 4
  for (int i = 0; i < 16; ++i) {
    int idx = tid + i * 256, c = idx >> 6, r = idx & 63;
    dst[(size_t)c * ldd + r] = f2bf(tile[r * 65 + c]);
  }
  __syncthreads();
}

DI void phase_convert(const P& p, int l, char* smem) {
  float* tile = (float*)smem;
  char* ws = p.ws;
  const int NJ = 6432;
  for (int j = blockIdx.x; j < NJ; j += gridDim.x) {
    int q = j;
    if (q < 2560) {
      int tr = q / 160, tc = q % 160;
      transpose_tile(p.in[18] + (size_t)l * 1024 * 10240 + (size_t)tr * 64 * 10240 + tc * 64, 10240,
                     (bf16_t*)(ws + WS_WIN) + (size_t)tc * 64 * 1024 + tr * 64, 1024, tile);
      continue;
    }
    q -= 2560;
    if (q < 512) {
      int tr = q / 16, tc = q % 16;
      transpose_tile(p.in[40] + (size_t)l * 2048 * 1024 + (size_t)tr * 64 * 1024 + tc * 64, 1024,
                     (bf16_t*)(ws + WS_WBR) + (size_t)tc * 64 * 2048 + tr * 64, 2048, tile);
      continue;
    }
    q -= 512;
    if (q < 256) {
      int tr = q / 16, tc = q % 16;
      transpose_tile(p.in[41] + (size_t)l * 1024 * 1024 + (size_t)tr * 64 * 1024 + tc * 64, 1024,
                     (bf16_t*)(ws + WS_WOUT) + (size_t)tc * 64 * 1024 + tr * 64, 1024, tile);
      continue;
    }
    q -= 256;
    if (q < 1024) {
      int tr = q / 64, tc = q % 64;
      transpose_tile(p.in[42] + (size_t)l * 1024 * 4096 + (size_t)tr * 64 * 4096 + tc * 64, 4096,
                     (bf16_t*)(ws + WS_W1) + (size_t)tc * 64 * 1024 + tr * 64, 1024, tile);
      continue;
    }
    q -= 1024;
    if (q < 1024) {
      int tr = q / 16, tc = q % 16;
      transpose_tile(p.in[43] + (size_t)l * 4096 * 1024 + (size_t)tr * 64 * 1024 + tc * 64, 1024,
                     (bf16_t*)(ws + WS_W2) + (size_t)tc * 64 * 4096 + tr * 64, 4096, tile);
      continue;
    }
    q -= 1024;
    if (q < 32) {
      int type = q >> 3, n = q & 7;
      const float* src = (type == 0 ? p.in[30] : type == 1 ? p.in[32] : type == 2 ? p.in[35] : p.in[37]) + (size_t)(l * 8 + n) * 4096;
      transpose_tile(src, 64, (bf16_t*)(ws + WS_WLRU) + (size_t)(type * 8 + n) * 4096, 64, tile);
      continue;
    }
    q -= 32;
    if (q < 256) {
      int bh = q >> 3, tr = q & 7, b = bh >> 3, h = bh & 7;
      transpose_tile(p.in[3] + ((size_t)((b * 4 + l) * 8 + h)) * 32768 + (size_t)tr * 64 * 64, 64,
                     (bf16_t*)(ws + WS_CVNA) + (size_t)bh * 32768 + tr * 64, 512, tile);
      continue;
    }
    q -= 256;
    if (q < 256) {
      int bh = q >> 4, t2 = q & 15, tr = t2 >> 1, tc = t2 & 1, b = bh >> 2, h = bh & 3;
      transpose_tile(p.in[5] + ((size_t)((b * 4 + l) * 4 + h)) * 65536 + (size_t)tr * 64 * 128 + tc * 64, 128,
                     (bf16_t*)(ws + WS_CVDF) + (size_t)bh * 65536 + (size_t)tc * 64 * 512 + tr * 64, 512, tile);
      continue;
    }
    q -= 256;
    {
      int tensor = q >> 8, b = (q >> 6) & 3, chunk = q & 63;
      const float* src = (tensor == 0 ? p.in[2] : p.in[4]) + (size_t)(b * 4 + l) * 262144 + (size_t)chunk * 4096;
      bf16_t* dst = (bf16_t*)(ws + (tensor == 0 ? WS_CKNA : WS_CKDF)) + (size_t)b * 262144 + (size_t)chunk * 4096;
#pragma unroll
      for (int i = 0; i < 4; ++i) {
        int e = (otid() + i * 256) * 4;
        float4 v = *(const float4*)(src + e);
        *(bf16x4*)(dst + e) = pack4(v.x, v.y, v.z, v.w);
      }
    }
  }
}

DI void phase_row(const P& p, int l, int mode) {
  const int tid_ = otid(), lane = tid_ & 63, wid = tid_ >> 6;
  const float* MOD = (const float*)(p.ws + WS_MOD);
  float* X = p.out;
  bf16_t* H = (bf16_t*)(p.ws + WS_H);
  const bf16_t* Y = (const bf16_t*)(p.ws + WS_Y);
  const bool from_inputs = (mode == 0 || (mode == 1 && l == 0));
  auto xsrc = [&](int r) -> const float* {
    return from_inputs ? ((r < NCTX) ? (p.in[0] + (size_t)r * D) : (p.in[1] + (size_t)(r - NCTX) * D)) : (X + (size_t)r * D);
  };
  int rb = blockIdx.x;
  if (rb >= 4096) return;
  float4 xn[4];
  bf16x4 yn[4];
  {
    const int r = rb * 4 + wid;
    const float* xs = xsrc(r);
#pragma unroll
    for (int j = 0; j < 4; ++j) xn[j] = *(const float4*)(xs + j * 256 + lane * 4);
    if (mode != 0) {
#pragma unroll
      for (int j = 0; j < 4; ++j) yn[j] = *(const bf16x4*)(Y + (size_t)r * D + j * 256 + lane * 4);
    }
  }
  for (; rb < 4096; rb += gridDim.x) {
    const int r = rb * 4 + wid;
    const int mi = r < NCTX ? 0 : 1 + ((r - NCTX) >> 11);
    float4 xv[4], yv[4];
#pragma unroll
    for (int j = 0; j < 4; ++j) { xv[j] = xn[j]; yv[j] = make_float4(bfs2f(yn[j][0]), bfs2f(yn[j][1]), bfs2f(yn[j][2]), bfs2f(yn[j][3])); }
    {
      const int rbn = (rb + (int)gridDim.x < 4096) ? rb + (int)gridDim.x : rb;
      const int rn = rbn * 4 + wid;
      const float* xs = xsrc(rn);
#pragma unroll
      for (int j = 0; j < 4; ++j) xn[j] = *(const float4*)(xs + j * 256 + lane * 4);
      if (mode != 0) {
#pragma unroll
        for (int j = 0; j < 4; ++j) yn[j] = *(const bf16x4*)(Y + (size_t)rn * D + j * 256 + lane * 4);
      }
    }
    if (mode != 0) {
      float ss = 0.f;
#pragma unroll
      for (int j = 0; j < 4; ++j) ss += yv[j].x * yv[j].x + yv[j].y * yv[j].y + yv[j].z * yv[j].z + yv[j].w * yv[j].w;
      ss = wave_sum(ss);
      const float rs = rsqrtf(ss * (1.f / 1024.f) + 1e-6f);
      const float* gpost = (mode == 1 ? p.in[15] : p.in[17]) + l * D;
      const float* gate = MOD + (size_t)(l * 5 + mi) * 6144 + (mode == 1 ? 2048 : 5120);
#pragma unroll
      for (int j = 0; j < 4; ++j) {
        float4 g = *(const float4*)(gpost + j * 256 + lane * 4);
        float4 gt = *(const float4*)(gate + j * 256 + lane * 4);
        xv[j].x += gt.x * (yv[j].x * rs * g.x);
        xv[j].y += gt.y * (yv[j].y * rs * g.y);
        xv[j].z += gt.z * (yv[j].z * rs * g.z);
        xv[j].w += gt.w * (yv[j].w * rs * g.w);
        *(float4*)(X + (size_t)r * D + j * 256 + lane * 4) = xv[j];
      }
    }
    int ln, off_sh, off_sc;
    const float* gpre;
    if (mode == 0) { ln = 0; gpre = p.in[14]; off_sh = 0; off_sc = 1024; }
    else if (mode == 1) { ln = l; gpre = p.in[16] + l * D; off_sh = 3072; off_sc = 4096; }
    else { ln = l + 1; gpre = p.in[14] + (l + 1) * D; off_sh = 0; off_sc = 1024; }
    if (ln < 4) {
      float ss = 0.f;
#pragma unroll
      for (int j = 0; j < 4; ++j) ss += xv[j].x * xv[j].x + xv[j].y * xv[j].y + xv[j].z * xv[j].z + xv[j].w * xv[j].w;
      ss = wave_sum(ss);
      const float rs = rsqrtf(ss * (1.f / 1024.f) + 1e-6f);
      const float* mrow = MOD + (size_t)(ln * 5 + mi) * 6144;
#pragma unroll
      for (int j = 0; j < 4; ++j) {
        int c = j * 256 + lane * 4;
        float4 g = *(const float4*)(gpre + c);
        float4 sc = *(const float4*)(mrow + off_sc + c);
        float4 sh = *(const float4*)(mrow + off_sh + c);
        *(bf16x4*)(H + (size_t)r * D + c) = pack4(xv[j].x * rs * g.x * (1.f + sc.x) + sh.x, xv[j].y * rs * g.y * (1.f + sc.y) + sh.y,
                                                  xv[j].z * rs * g.z * (1.f + sc.z) + sh.z, xv[j].w * rs * g.w * (1.f + sc.w) + sh.w);
      }
    }
  }
}

constexpr int ATT_BUF = 192 * LDT;
DI void qk_scores(const bf16x8 (&qf)[2], const bf16_t* sK, f32x4 (&S)[4], int fr, int fq) {
  __builtin_amdgcn_s_setprio(1);
#pragma unroll
  for (int s = 0; s < 4; ++s) {
    f32x4 z = {0.f, 0.f, 0.f, 0.f};
#pragma unroll
    for (int ks = 0; ks < 2; ++ks) {
      bf16x8 a = *(const bf16x8*)(sK + (16 * s + fr) * LDT + ks * 32 + fq * 8);
      z = MFMA16(a, qf[ks], z);
    }
    S[s] = z;
  }
  __builtin_amdgcn_s_setprio(0);
}
template <int DV>
DI void pv_step(const bf16x8 (&pb)[2], const bf16_t* sV, f32x4 (&O)[DV / 16], int fr, int fq) {
  __builtin_amdgcn_s_setprio(1);
#pragma unroll
  for (int dt = 0; dt < DV / 16; ++dt) {
#pragma unroll
    for (int s2 = 0; s2 < 2; ++s2) {
      const bf16_t* base = sV + (dt * 16 + fr) * LDT + 32 * s2 + 4 * fq;
      bf16x4 lo = *(const bf16x4*)base;
      bf16x4 hi = *(const bf16x4*)(base + 16);
      bf16x8 a = __builtin_shufflevector(lo, hi, 0, 1, 2, 3, 4, 5, 6, 7);
      O[dt] = MFMA16(a, pb[s2], O[dt]);
    }
  }
  __builtin_amdgcn_s_setprio(0);
}
template <int DV>
DI void softmax_pv(f32x4 (&S)[4], const bf16_t* sV, f32x4 (&O)[DV / 16], float& m, float& lsum, int fr, int fq) {
  float tm = -1e30f;
#pragma unroll
  for (int s = 0; s < 4; ++s)
#pragma unroll
    for (int i = 0; i < 4; ++i) tm = fmaxf(tm, S[s][i]);
  tm = xmax32(xmax16(tm));
  const float mn = fmaxf(m, tm);
  const float alpha = __builtin_amdgcn_exp2f(m - mn);
  const bool grew = mn != m;
  m = mn;
  float ps = 0.f;
#pragma unroll
  for (int s = 0; s < 4; ++s)
#pragma unroll
    for (int i = 0; i < 4; ++i) {
      float pv = __builtin_amdgcn_exp2f(S[s][i] - mn);
      S[s][i] = pv;
      ps += pv;
    }
  lsum = lsum * alpha + ps;
  if (__any(grew)) {
#pragma unroll
    for (int dt = 0; dt < DV / 16; ++dt) {
      O[dt][0] *= alpha; O[dt][1] *= alpha; O[dt][2] *= alpha; O[dt][3] *= alpha;
    }
  }
  bf16x8 pb[2];
  pb[0] = pack8(S[0], S[1]);
  pb[1] = pack8(S[2], S[3]);
  pv_step<DV>(pb, sV, O, fr, fq);
}
template <int DV, bool SOFTMAX, int TPS, class TileFn, class ScoreFn>
DI void attn_loop(int ntiles, TileFn&& tile, ScoreFn&& score, const bf16x8 (&qf)[2], f32x4 (&O)[DV / 16], float& m, float& lsum,
                  bf16_t* smem, int tid) {
  const int lane = tid & 63, fr = lane & 15, fq = lane >> 4;
  constexpr int TILE_EL = (64 + DV) * LDT, STAGE_EL = TPS * TILE_EL;
  u32x4 rkA[TPS][2], rvA[TPS][DV / 32], rkB[TPS][2], rvB[TPS][DV / 32];
  const int sr = tid >> 3, sc = (tid & 7) * 8;
  auto gload = [&](int step, u32x4 (&rk)[TPS][2], u32x4 (&rv)[TPS][DV / 32]) __attribute__((always_inline)) {
#pragma unroll
    for (int u = 0; u < TPS; ++u) {
      const bf16_t* Kg; const bf16_t* Vg; int ldk, ldv;
      tile(step * TPS + u, Kg, ldk, Vg, ldv);
#pragma unroll
      for (int i = 0; i < 2; ++i) rk[u][i] = *(const u32x4*)(Kg + (size_t)(sr + i * 32) * ldk + sc);
#pragma unroll
      for (int i = 0; i < DV / 32; ++i) rv[u][i] = *(const u32x4*)(Vg + (size_t)(sr + i * 32) * ldv + sc);
    }
  };
  auto sstore = [&](int buf, const u32x4 (&rk)[TPS][2], const u32x4 (&rv)[TPS][DV / 32]) __attribute__((always_inline)) {
#pragma unroll
    for (int u = 0; u < TPS; ++u) {
      bf16_t* sK = smem + buf * STAGE_EL + u * TILE_EL;
      bf16_t* sV = sK + 64 * LDT;
#pragma unroll
      for (int i = 0; i < 2; ++i) *(u32x4*)(sK + (sr + i * 32) * LDT + sc) = rk[u][i];
#pragma unroll
      for (int i = 0; i < DV / 32; ++i) *(u32x4*)(sV + (sr + i * 32) * LDT + sc) = rv[u][i];
    }
  };
  auto compute = [&](int buf, int step) __attribute__((always_inline)) {
#pragma unroll
    for (int u = 0; u < TPS; ++u) {
      const bf16_t* sK = smem + buf * STAGE_EL + u * TILE_EL;
      const bf16_t* sV = sK + 64 * LDT;
      f32x4 S[4];
      qk_scores(qf, sK, S, fr, fq);
      score(step * TPS + u, S);
      if (SOFTMAX) {
        softmax_pv<DV>(S, sV, O, m, lsum, fr, fq);
      } else {
        bf16x8 pb[2];
        pb[0] = pack8(S[0], S[1]);
        pb[1] = pack8(S[2], S[3]);
        pv_step<DV>(pb, sV, O, fr, fq);
      }
    }
  };
  const int nsteps = ntiles / TPS, last = nsteps - 1;
  if (TPS > 1) {
    gload(0, rkA, rvA);
    sstore(0, rkA, rvA);
    __syncthreads();
    for (int j = 0; j < nsteps; ++j) {
      gload(j + 1 < last ? j + 1 : last, rkA, rvA);
      asm volatile("" ::: "memory");
      compute(j & 1, j);
      __builtin_amdgcn_sched_barrier(0);
      sstore((j + 1) & 1, rkA, rvA);
      __syncthreads();
    }
    return;
  }
  gload(0, rkA, rvA);
  gload(last < 1 ? last : 1, rkB, rvB);
  sstore(0, rkA, rvA);
  __syncthreads();
  for (int j = 0; j < nsteps; j += 2) {
    gload(j + 2 < last ? j + 2 : last, rkA, rvA);
    asm volatile("" ::: "memory");
    compute(0, j);
    __builtin_amdgcn_sched_barrier(0);
    sstore(1, rkB, rvB);
    __syncthreads();
    if (j + 1 >= nsteps) break;
    gload(j + 3 < last ? j + 3 : last, rkB, rvB);
    asm volatile("" ::: "memory");
    compute(1, j + 1);
    __builtin_amdgcn_sched_barrier(0);
    sstore(0, rkA, rvA);
    __syncthreads();
  }
}
DI void scale_scores(f32x4 (&S)[4]) {
#pragma unroll
  for (int s = 0; s < 4; ++s) { S[s][0] *= 0.18033688f; S[s][1] *= 0.18033688f; S[s][2] *= 0.18033688f; S[s][3] *= 0.18033688f; }
}

DI void softmax_only(f32x4 (&S)[4], f32x4 (&O)[8], float& m, float& lsum, bf16x8 (&pb)[2]) {
  float tm = -1e30f;
#pragma unroll
  for (int s = 0; s < 4; ++s)
#pragma unroll
    for (int i = 0; i < 4; ++i) tm = fmaxf(tm, S[s][i]);
  tm = xmax32(xmax16(tm));
  const float mn = fmaxf(m, tm);
  const float alpha = __builtin_amdgcn_exp2f(m - mn);
  const bool grew = mn != m;
  m = mn;
  float ps = 0.f;
#pragma unroll
  for (int s = 0; s < 4; ++s)
#pragma unroll
    for (int i = 0; i < 4; ++i) {
      float pv = __builtin_amdgcn_exp2f(S[s][i] - mn);
      S[s][i] = pv;
      ps += pv;
    }
  lsum = lsum * alpha + ps;
  if (__any(grew)) {
#pragma unroll
    for (int dt = 0; dt < 8; ++dt) { O[dt][0] *= alpha; O[dt][1] *= alpha; O[dt][2] *= alpha; O[dt][3] *= alpha; }
  }
  pb[0] = pack8(S[0], S[1]);
  pb[1] = pack8(S[2], S[3]);
}
template <class TileFn>
DI void diff_loop(int ntiles, TileFn&& tile, const bf16x8 (&q1)[2], const bf16x8 (&q2)[2], f32x4 (&O1)[8], f32x4 (&O2)[8],
                  float& m1, float& l1, float& m2, float& l2, bf16_t* smem, int tid) {
  const int lane = tid & 63, fr = lane & 15, fq = lane >> 4;
  constexpr int STAGE_EL = 256 * LDT;
  u32x4 rk1[2], rk2[2], rv[4];
  const int sr = tid >> 3, sc = (tid & 7) * 8;
  auto gload = [&](int j) __attribute__((always_inline)) {
    const bf16_t* K1g; const bf16_t* K2g; const bf16_t* Vg; int ldk, ldv;
    tile(j, K1g, K2g, ldk, Vg, ldv);
#pragma unroll
    for (int i = 0; i < 2; ++i) {
      rk1[i] = *(const u32x4*)(K1g + (size_t)(sr + i * 32) * ldk + sc);
      rk2[i] = *(const u32x4*)(K2g + (size_t)(sr + i * 32) * ldk + sc);
    }
#pragma unroll
    for (int i = 0; i < 4; ++i) rv[i] = *(const u32x4*)(Vg + (size_t)(sr + i * 32) * ldv + sc);
  };
  auto sstore = [&](int buf) __attribute__((always_inline)) {
    bf16_t* sb = smem + buf * STAGE_EL;
#pragma unroll
    for (int i = 0; i < 2; ++i) {
      *(u32x4*)(sb + (sr + i * 32) * LDT + sc) = rk1[i];
      *(u32x4*)(sb + (64 + sr + i * 32) * LDT + sc) = rk2[i];
    }
#pragma unroll
    for (int i = 0; i < 4; ++i) *(u32x4*)(sb + (128 + sr + i * 32) * LDT + sc) = rv[i];
  };
  const int last = ntiles - 1;
  gload(0);
  sstore(0);
  __syncthreads();
  for (int j = 0; j < ntiles; ++j) {
    gload(j + 1 < last ? j + 1 : last);
    asm volatile("" ::: "memory");
    {
      const bf16_t* sb = smem + (j & 1) * STAGE_EL;
      const bf16_t* sV = sb + 128 * LDT;
      f32x4 S1[4], S2[4];
      qk_scores(q1, sb, S1, fr, fq);
      qk_scores(q2, sb + 64 * LDT, S2, fr, fq);
      scale_scores(S1);
      scale_scores(S2);
      bf16x8 pb1[2], pb2[2];
      softmax_only(S1, O1, m1, l1, pb1);
      softmax_only(S2, O2, m2, l2, pb2);
      __builtin_amdgcn_s_setprio(1);
#pragma unroll
      for (int dt = 0; dt < 8; ++dt) {
#pragma unroll
        for (int s2 = 0; s2 < 2; ++s2) {
          const bf16_t* base = sV + (dt * 16 + fr) * LDT + 32 * s2 + 4 * fq;
          bf16x4 lo = *(const bf16x4*)base;
          bf16x4 hi = *(const bf16x4*)(base + 16);
          bf16x8 a = __builtin_shufflevector(lo, hi, 0, 1, 2, 3, 4, 5, 6, 7);
          O1[dt] = MFMA16(a, pb1[s2], O1[dt]);
          O2[dt] = MFMA16(a, pb2[s2], O2[dt]);
        }
      }
      __builtin_amdgcn_s_setprio(0);
    }
    __builtin_amdgcn_sched_barrier(0);
    sstore((j + 1) & 1);
    __syncthreads();
  }
}


DI void dense_item(const P& p, int b, int h, int qb, char* smem) {
  const int tid = otid(), lane = tid & 63, wid = tid >> 6, fr = lane & 15, fq = lane >> 4;
  const bf16_t* Z = (const bf16_t*)(p.ws + WS_Z);
  const bf16_t* VT = (const bf16_t*)(p.ws + WS_VTNA) + (size_t)(b * 512 + h * 64) * 256;
  bf16_t* Y4 = (bf16_t*)(p.ws + WS_Y4);
  const int rowbase = b * 256;
  const int qrow = rowbase + qb * 64 + wid * 16 + fr;
  bf16x8 qf[2];
#pragma unroll
  for (int ks = 0; ks < 2; ++ks) qf[ks] = *(const bf16x8*)(Z + (size_t)qrow * ZLD + ZC_NAQ + h * 64 + ks * 32 + fq * 8);
  f32x4 O[4];
#pragma unroll
  for (int dt = 0; dt < 4; ++dt) O[dt] = f32x4{0.f, 0.f, 0.f, 0.f};
  float m = -1e30f, lsum = 0.f;
  const bf16_t* Kb = Z + (size_t)rowbase * ZLD + ZC_NAK + h * 64;
  attn_loop<64, true, 2>(4,
      [&](int j, const bf16_t*& Kg, int& ldk, const bf16_t*& Vg, int& ldv) __attribute__((always_inline)) { Kg = Kb + (size_t)j * 64 * ZLD; ldk = ZLD; Vg = VT + j * 64; ldv = 256; },
      [&](int, f32x4 (&S)[4]) __attribute__((always_inline)) { scale_scores(S); }, qf, O, m, lsum, (bf16_t*)smem, tid);
  const float lt = xsum32(xsum16(lsum));
  const float inv = 1.f / lt;
#pragma unroll
  for (int dt = 0; dt < 4; ++dt)
    *(bf16x4*)(Y4 + (size_t)qrow * 2048 + h * 64 + dt * 16 + fq * 4) = pack4(O[dt][0] * inv, O[dt][1] * inv, O[dt][2] * inv, O[dt][3] * inv);
}

DI void na_item(const P& p, int l, int b, int h, int r, char* smem) {
  float* srpb = (float*)(smem + 73728);
  const int tid = otid(), lane = tid & 63, wid = tid >> 6, fr = lane & 15, fq = lane >> 4;
  const bf16_t* Z = (const bf16_t*)(p.ws + WS_Z);
  const bf16_t* VT = (const bf16_t*)(p.ws + WS_VTNA) + VT_LAT + (size_t)(b * 512 + h * 64) * 2048;
  const bf16_t* CK = (const bf16_t*)(p.ws + WS_CKNA) + (size_t)(b * 8 + h) * 32768;
  const bf16_t* CVT = (const bf16_t*)(p.ws + WS_CVNA) + (size_t)(b * 8 + h) * 32768;
  bf16_t* Y4 = (bf16_t*)(p.ws + WS_Y4);
  for (int i = tid; i < 465; i += 256) srpb[i] = p.in[19][(size_t)(l * 8 + h) * 465 + i];
  const int rowbase = NCTX + b * 2048;
  const int qcol = wid * 16 + fr;
  const int qrow = rowbase + r * 64 + qcol;
  bf16x8 qf[2];
#pragma unroll
  for (int ks = 0; ks < 2; ++ks) qf[ks] = *(const bf16x8*)(Z + (size_t)qrow * ZLD + ZC_NAQ + h * 64 + ks * 32 + fq * 8);
  f32x4 O[4];
#pragma unroll
  for (int dt = 0; dt < 4; ++dt) O[dt] = f32x4{0.f, 0.f, 0.f, 0.f};
  float m = -1e30f, lsum = 0.f;
  int rs = r - 4;
  rs = rs < 0 ? 0 : (rs > 24 ? 24 : rs);
  int cstart = qcol - 8;
  cstart = cstart < 0 ? 0 : (cstart > 48 ? 48 : cstart);
  const bf16_t* Kb = Z + (size_t)rowbase * ZLD + ZC_NAK + h * 64;
  attn_loop<64, true, 2>(16,
      [&](int j, const bf16_t*& Kg, int& ldk, const bf16_t*& Vg, int& ldv) __attribute__((always_inline)) {
        if (j < 8) { Kg = Kb + (size_t)(rs + j) * 64 * ZLD; ldk = ZLD; Vg = VT + (rs + j) * 64; ldv = 2048; }
        else { Kg = CK + (size_t)(j - 8) * 64 * 64; ldk = 64; Vg = CVT + (j - 8) * 64; ldv = 512; }
      },
      [&](int j, f32x4 (&S)[4]) __attribute__((always_inline)) {
        if (j < 8) {
          const int dr = rs + j - r + 7;
#pragma unroll
          for (int s = 0; s < 4; ++s)
#pragma unroll
            for (int i = 0; i < 4; ++i) {
              int kcol = s * 16 + fq * 4 + i;
              bool ok = (kcol >= cstart) && (kcol < cstart + 16);
              int dc = kcol - qcol + 15;
              dc = dc < 0 ? 0 : (dc > 30 ? 30 : dc);
              float bias = srpb[dr * 31 + dc];
              S[s][i] = ok ? (S[s][i] * 0.18033688f + bias * 1.44269504f) : -1e30f;
            }
        } else {
          scale_scores(S);
        }
      },
      qf, O, m, lsum, (bf16_t*)smem, tid);
  const float lt = xsum32(xsum16(lsum));
  const float inv = 1.f / lt;
#pragma unroll
  for (int dt = 0; dt < 4; ++dt)
    *(bf16x4*)(Y4 + (size_t)qrow * 2048 + h * 64 + dt * 16 + fq * 4) = pack4(O[dt][0] * inv, O[dt][1] * inv, O[dt][2] * inv, O[dt][3] * inv);
}

DI void diff_item(const P& p, int l, bool latent, int b, int h, int qb, char* smem) {
  const int tid = otid(), lane = tid & 63, wid = tid >> 6, fr = lane & 15, fq = lane >> 4;
  const bf16_t* Z = (const bf16_t*)(p.ws + WS_Z);
  const int T = latent ? 2048 : 256;
  const int rowbase = latent ? NCTX + b * 2048 : b * 256;
  const bf16_t* VT = (const bf16_t*)(p.ws + WS_VTDF) + (latent ? (size_t)VT_LAT + (size_t)(b * 512 + h * 128) * 2048 : (size_t)(b * 512 + h * 128) * 256);
  const bf16_t* CVT = (const bf16_t*)(p.ws + WS_CVDF) + (size_t)(b * 4 + h) * 65536;
  bf16_t* Y4 = (bf16_t*)(p.ws + WS_Y4);
  const int qrow = rowbase + qb * 64 + wid * 16 + fr;
  float d1 = p.in[20][l * 64 + lane] * p.in[21][l * 64 + lane];
  float d2 = p.in[22][l * 64 + lane] * p.in[23][l * 64 + lane];
  d1 = wave_sum(d1);
  d2 = wave_sum(d2);
  const float lam_init = 0.8f - 0.6f * expf(-0.3f * (float)l);
  const float lam = expf(d1) - expf(d2) + lam_init;
  const int nown = T >> 6;
  const int ntiles = nown + (latent ? 8 : 0);

  f32x4 O1[8];
  f32x4 O[8];
  {
    bf16x8 q1[2], q2[2];
#pragma unroll
    for (int ks = 0; ks < 2; ++ks) {
      q1[ks] = *(const bf16x8*)(Z + (size_t)qrow * ZLD + ZC_DFQ + h * 64 + ks * 32 + fq * 8);
      q2[ks] = *(const bf16x8*)(Z + (size_t)qrow * ZLD + ZC_DFQ + 256 + h * 64 + ks * 32 + fq * 8);
    }
#pragma unroll
    for (int dt = 0; dt < 8; ++dt) { O1[dt] = f32x4{0.f, 0.f, 0.f, 0.f}; O[dt] = f32x4{0.f, 0.f, 0.f, 0.f}; }
    float m1 = -1e30f, l1 = 0.f, m2 = -1e30f, l2 = 0.f;
    const bf16_t* Kb = Z + (size_t)rowbase * ZLD + ZC_DFK + h * 64;
    const bf16_t* CK = (const bf16_t*)(p.ws + WS_CKDF) + (size_t)((b * 2) * 4 + h) * 32768;
    diff_loop(ntiles,
        [&](int j, const bf16_t*& K1g, const bf16_t*& K2g, int& ldk, const bf16_t*& Vg, int& ldv) __attribute__((always_inline)) {
          if (j < nown) { K1g = Kb + (size_t)j * 64 * ZLD; K2g = K1g + 256; ldk = ZLD; Vg = VT + j * 64; ldv = T; }
          else { K1g = CK + (size_t)(j - nown) * 64 * 64; K2g = K1g + 4 * 32768; ldk = 64; Vg = CVT + (j - nown) * 64; ldv = 512; }
        },
        q1, q2, O1, O, m1, l1, m2, l2, (bf16_t*)smem, tid);
    const float inv1 = 1.f / xsum32(xsum16(l1));
    const float inv2 = lam / xsum32(xsum16(l2));
#pragma unroll
    for (int dt = 0; dt < 8; ++dt) {
      O[dt][0] = O1[dt][0] * inv1 - O[dt][0] * inv2;
      O[dt][1] = O1[dt][1] * inv1 - O[dt][1] * inv2;
      O[dt][2] = O1[dt][2] * inv1 - O[dt][2] * inv2;
      O[dt][3] = O1[dt][3] * inv1 - O[dt][3] * inv2;
    }
  }
  float ss = 0.f;
#pragma unroll
  for (int dt = 0; dt < 8; ++dt) ss += O[dt][0] * O[dt][0] + O[dt][1] * O[dt][1] + O[dt][2] * O[dt][2] + O[dt][3] * O[dt][3];
  ss = xsum32(xsum16(ss));
  const float rsn = rsqrtf(ss * (1.f / 128.f) + 1e-6f) * (1.f - lam_init);
  const float* gn = p.in[24] + l * 128;
#pragma unroll
  for (int dt = 0; dt < 8; ++dt) {
    int dv = dt * 16 + fq * 4;
    float4 g = *(const float4*)(gn + dv);
    *(bf16x4*)(Y4 + (size_t)qrow * 2048 + 512 + h * 128 + dv) = pack4(O[dt][0] * rsn * g.x, O[dt][1] * rsn * g.y, O[dt][2] * rsn * g.z, O[dt][3] * rsn * g.w);
  }
}

DI void ret_item(const P& p, int l, bool latent, int b, int h, int qb, char* smem) {
  bf16_t* sV0 = (bf16_t*)smem + 64 * LDT;
  const int tid = otid(), lane = tid & 63, wid = tid >> 6, fr = lane & 15, fq = lane >> 4;
  const bf16_t* Z = (const bf16_t*)(p.ws + WS_Z);
  const int T = latent ? 2048 : 256;
  const int rowbase = latent ? NCTX + b * 2048 : b * 256;
  const bf16_t* VT = (const bf16_t*)(p.ws + WS_VTRT) + (latent ? (size_t)VT_LAT + (size_t)(b * 512 + h * 64) * 2048 : (size_t)(b * 512 + h * 64) * 256);
  bf16_t* Y4 = (bf16_t*)(p.ws + WS_Y4);
  const int tq = qb * 64 + wid * 16 + fr;
  const int qrow = rowbase + tq;
  const float lgf = log1pf(-expf(p.in[25][l * 8 + h]));
  const float lgb = log1pf(-expf(p.in[26][l * 8 + h]));
  bf16x8 qf[2];
#pragma unroll
  for (int ks = 0; ks < 2; ++ks) qf[ks] = *(const bf16x8*)(Z + (size_t)qrow * ZLD + ZC_RTQ + h * 64 + ks * 32 + fq * 8);
  f32x4 O[4];
#pragma unroll
  for (int dt = 0; dt < 4; ++dt) O[dt] = f32x4{0.f, 0.f, 0.f, 0.f};
  float mdummy = 0.f, ldummy = 0.f;
  const int dq = wid * 16 + fr;
  float AF[4], BF[4], AB[4], BB[4];
#pragma unroll
  for (int u = 0; u < 4; ++u) {
    AF[u] = __expf(-lgf * (float)(u * 16));
    AB[u] = __expf(lgb * (float)(u * 16));
    BF[u] = __expf(-lgf * (float)(fq * 4 + u));
    BB[u] = __expf(lgb * (float)(fq * 4 + u));
  }
  const bf16_t* Kb = Z + (size_t)rowbase * ZLD + ZC_RTK + h * 64;
  attn_loop<64, false, 2>(T >> 6,
      [&](int j, const bf16_t*& Kg, int& ldk, const bf16_t*& Vg, int& ldv) __attribute__((always_inline)) { Kg = Kb + (size_t)j * 64 * ZLD; ldk = ZLD; Vg = VT + j * 64; ldv = T; },
      [&](int j, f32x4 (&S)[4]) __attribute__((always_inline)) {
        if (j == qb) {
#pragma unroll
          for (int s = 0; s < 4; ++s)
#pragma unroll
            for (int i = 0; i < 4; ++i) {
              int tk = j * 64 + s * 16 + fq * 4 + i;
              int dd = tq - tk;
              float w = dd >= 0 ? __expf(lgf * (float)dd) : __expf(lgb * (float)(-dd));
              S[s][i] *= w;
            }
        } else if (j < qb) {
          const float qfac = __expf(lgf * (float)((qb - j) * 64 + dq));
#pragma unroll
          for (int s = 0; s < 4; ++s) {
            const float f = qfac * AF[s];
            S[s][0] *= f * BF[0]; S[s][1] *= f * BF[1]; S[s][2] *= f * BF[2]; S[s][3] *= f * BF[3];
          }
        } else {
          const float qfac = __expf(lgb * (float)((j - qb) * 64 - dq));
#pragma unroll
          for (int s = 0; s < 4; ++s) {
            const float f = qfac * AB[s];
            S[s][0] *= f * BB[0]; S[s][1] *= f * BB[1]; S[s][2] *= f * BB[2]; S[s][3] *= f * BB[3];
          }
        }
      },
      qf, O, mdummy, ldummy, (bf16_t*)smem, tid);
  if (latent) {
    for (int dir = 0; dir < 2; ++dir) {
      const float* S0 = (dir == 0 ? p.in[6] : p.in[7]) + ((size_t)((b * 4 + l) * 8 + h)) * 4096;
#pragma unroll
      for (int i = 0; i < 4; ++i) {
        int e = (tid + i * 256) * 4;
        float4 v = *(const float4*)(S0 + e);
        int dk = e >> 6, dv = e & 63;
        sV0[(dv + 0) * LDT + dk] = f2bf(v.x);
        sV0[(dv + 1) * LDT + dk] = f2bf(v.y);
        sV0[(dv + 2) * LDT + dk] = f2bf(v.z);
        sV0[(dv + 3) * LDT + dk] = f2bf(v.w);
      }
      __syncthreads();
      const float sc = dir == 0 ? __expf(lgf * (float)(tq + 1)) : __expf(lgb * (float)(T - tq));
      bf16x8 pb[2];
#pragma unroll
      for (int s2 = 0; s2 < 2; ++s2) {
        const bf16_t* qp = Z + (size_t)qrow * ZLD + ZC_RTQ + h * 64 + 32 * s2 + 4 * fq;
        bf16x4 lo = *(const bf16x4*)qp;
        bf16x4 hi = *(const bf16x4*)(qp + 16);
        f32x4 flo = {bfs2f(lo[0]) * sc, bfs2f(lo[1]) * sc, bfs2f(lo[2]) * sc, bfs2f(lo[3]) * sc};
        f32x4 fhi = {bfs2f(hi[0]) * sc, bfs2f(hi[1]) * sc, bfs2f(hi[2]) * sc, bfs2f(hi[3]) * sc};
        pb[s2] = pack8(flo, fhi);
      }
      pv_step<64>(pb, sV0, O, fr, fq);
      __syncthreads();
    }
  }
  float ss = 0.f;
#pragma unroll
  for (int dt = 0; dt < 4; ++dt) ss += O[dt][0] * O[dt][0] + O[dt][1] * O[dt][1] + O[dt][2] * O[dt][2] + O[dt][3] * O[dt][3];
  ss = xsum32(xsum16(ss));
  const float rsn = rsqrtf(ss * (1.f / 64.f) + 1e-6f);
  const float* gn = p.in[27] + l * 512 + h * 64;
#pragma unroll
  for (int dt = 0; dt < 4; ++dt) {
    int dv = dt * 16 + fq * 4;
    float4 g = *(const float4*)(gn + dv);
    bf16x4 sg = *(const bf16x4*)(Z + (size_t)qrow * ZLD + ZC_RTG + h * 64 + dv);
    *(bf16x4*)(Y4 + (size_t)qrow * 2048 + 1024 + h * 64 + dv) =
        pack4(O[dt][0] * rsn * g.x * bfs2f(sg[0]), O[dt][1] * rsn * g.y * bfs2f(sg[1]), O[dt][2] * rsn * g.z * bfs2f(sg[2]), O[dt][3] * rsn * g.w * bfs2f(sg[3]));
  }
}

DI void ret_decay(f32x4 (&S)[4], int j, int qbk, int tq, int dq, int fq, float lgf, float lgb, const float (&AF)[4], const float (&BF)[4],
                  const float (&AB)[4], const float (&BB)[4]) {
  if (j == qbk) {
#pragma unroll
    for (int s = 0; s < 4; ++s)
#pragma unroll
      for (int i = 0; i < 4; ++i) {
        int tk = j * 64 + s * 16 + fq * 4 + i;
        int dd = tq - tk;
        float w = dd >= 0 ? __expf(lgf * (float)dd) : __expf(lgb * (float)(-dd));
        S[s][i] *= w;
      }
  } else if (j < qbk) {
    const float qfac = __expf(lgf * (float)((qbk - j) * 64 + dq));
#pragma unroll
    for (int s = 0; s < 4; ++s) {
      const float f = qfac * AF[s];
      S[s][0] *= f * BF[0]; S[s][1] *= f * BF[1]; S[s][2] *= f * BF[2]; S[s][3] *= f * BF[3];
    }
  } else {
    const float qfac = __expf(lgb * (float)((j - qbk) * 64 - dq));
#pragma unroll
    for (int s = 0; s < 4; ++s) {
      const float f = qfac * AB[s];
      S[s][0] *= f * BB[0]; S[s][1] *= f * BB[1]; S[s][2] *= f * BB[2]; S[s][3] *= f * BB[3];
    }
  }
}
DI void ret_item2(const P& p, int l, bool latent, int b, int h, int qp, char* smem_) {
  bf16_t* smem = (bf16_t*)smem_;
  constexpr int STAGE_EL = 128 * LDT;
  bf16_t* sV0 = smem + 64 * LDT;
  const int tid = otid(), lane = tid & 63, wid = tid >> 6, fr = lane & 15, fq = lane >> 4;
  const bf16_t* Z = (const bf16_t*)(p.ws + WS_Z);
  const int T = latent ? 2048 : 256;
  const int rowbase = latent ? NCTX + b * 2048 : b * 256;
  const bf16_t* VT = (const bf16_t*)(p.ws + WS_VTRT) + (latent ? (size_t)VT_LAT + (size_t)(b * 512 + h * 64) * 2048 : (size_t)(b * 512 + h * 64) * 256);
  bf16_t* Y4 = (bf16_t*)(p.ws + WS_Y4);
  const int qbA = 2 * qp, qbB = 2 * qp + 1;
  const int dq = wid * 16 + fr;
  const int tqA = qbA * 64 + dq, tqB = tqA + 64;
  const int qrowA = rowbase + tqA, qrowB = qrowA + 64;
  const float lgf = log1pf(-expf(p.in[25][l * 8 + h]));
  const float lgb = log1pf(-expf(p.in[26][l * 8 + h]));
  bf16x8 qA[2], qB[2];
#pragma unroll
  for (int ks = 0; ks < 2; ++ks) {
    qA[ks] = *(const bf16x8*)(Z + (size_t)qrowA * ZLD + ZC_RTQ + h * 64 + ks * 32 + fq * 8);
    qB[ks] = *(const bf16x8*)(Z + (size_t)qrowB * ZLD + ZC_RTQ + h * 64 + ks * 32 + fq * 8);
  }
  f32x4 OA[4], OB[4];
#pragma unroll
  for (int dt = 0; dt < 4; ++dt) { OA[dt] = f32x4{0.f, 0.f, 0.f, 0.f}; OB[dt] = f32x4{0.f, 0.f, 0.f, 0.f}; }
  float AF[4], BF[4], AB[4], BB[4];
#pragma unroll
  for (int u = 0; u < 4; ++u) {
    AF[u] = __expf(-lgf * (float)(u * 16));
    AB[u] = __expf(lgb * (float)(u * 16));
    BF[u] = __expf(-lgf * (float)(fq * 4 + u));
    BB[u] = __expf(lgb * (float)(fq * 4 + u));
  }
  const bf16_t* Kb = Z + (size_t)rowbase * ZLD + ZC_RTK + h * 64;
  u32x4 rk[2], rv[2];
  const int sr = tid >> 3, sc = (tid & 7) * 8;
  auto gload = [&](int j) __attribute__((always_inline)) {
#pragma unroll
    for (int i = 0; i < 2; ++i) {
      rk[i] = *(const u32x4*)(Kb + ((size_t)j * 64 + sr + i * 32) * ZLD + sc);
      rv[i] = *(const u32x4*)(VT + (size_t)(sr + i * 32) * T + j * 64 + sc);
    }
  };
  auto sstore = [&](int buf) __attribute__((always_inline)) {
    bf16_t* sb = smem + buf * STAGE_EL;
#pragma unroll
    for (int i = 0; i < 2; ++i) {
      *(u32x4*)(sb + (sr + i * 32) * LDT + sc) = rk[i];
      *(u32x4*)(sb + (64 + sr + i * 32) * LDT + sc) = rv[i];
    }
  };
  const int ntiles = T >> 6, last = ntiles - 1;
  gload(0);
  sstore(0);
  __syncthreads();
  for (int j = 0; j < ntiles; ++j) {
    gload(j + 1 < last ? j + 1 : last);
    asm volatile("" ::: "memory");
    {
      const bf16_t* sK = smem + (j & 1) * STAGE_EL;
      const bf16_t* sV = sK + 64 * LDT;
      f32x4 SA[4], SB[4];
      qk_scores(qA, sK, SA, fr, fq);
      qk_scores(qB, sK, SB, fr, fq);
      ret_decay(SA, j, qbA, tqA, dq, fq, lgf, lgb, AF, BF, AB, BB);
      ret_decay(SB, j, qbB, tqB, dq, fq, lgf, lgb, AF, BF, AB, BB);
      bf16x8 pA[2], pB[2];
      pA[0] = pack8(SA[0], SA[1]); pA[1] = pack8(SA[2], SA[3]);
      pB[0] = pack8(SB[0], SB[1]); pB[1] = pack8(SB[2], SB[3]);
      __builtin_amdgcn_s_setprio(1);
#pragma unroll
      for (int dt = 0; dt < 4; ++dt) {
#pragma unroll
        for (int s2 = 0; s2 < 2; ++s2) {
          const bf16_t* base = sV + (dt * 16 + fr) * LDT + 32 * s2 + 4 * fq;
          bf16x4 lo = *(const bf16x4*)base;
          bf16x4 hi = *(const bf16x4*)(base + 16);
          bf16x8 a = __builtin_shufflevector(lo, hi, 0, 1, 2, 3, 4, 5, 6, 7);
          OA[dt] = MFMA16(a, pA[s2], OA[dt]);
          OB[dt] = MFMA16(a, pB[s2], OB[dt]);
        }
      }
      __builtin_amdgcn_s_setprio(0);
    }
    __builtin_amdgcn_sched_barrier(0);
    sstore((j + 1) & 1);
    __syncthreads();
  }
  if (latent) {
    for (int dir = 0; dir < 2; ++dir) {
      const float* S0 = (dir == 0 ? p.in[6] : p.in[7]) + ((size_t)((b * 4 + l) * 8 + h)) * 4096;
#pragma unroll
      for (int i = 0; i < 4; ++i) {
        int e = (tid + i * 256) * 4;
        float4 v = *(const float4*)(S0 + e);
        int dk = e >> 6, dv = e & 63;
        sV0[(dv + 0) * LDT + dk] = f2bf(v.x);
        sV0[(dv + 1) * LDT + dk] = f2bf(v.y);
        sV0[(dv + 2) * LDT + dk] = f2bf(v.z);
        sV0[(dv + 3) * LDT + dk] = f2bf(v.w);
      }
      __syncthreads();
#pragma unroll
      for (int blk = 0; blk < 2; ++blk) {
        const int tq = blk == 0 ? tqA : tqB;
        const int qrow = blk == 0 ? qrowA : qrowB;
        const float scl = dir == 0 ? __expf(lgf * (float)(tq + 1)) : __expf(lgb * (float)(T - tq));
        bf16x8 pb[2];
#pragma unroll
        for (int s2 = 0; s2 < 2; ++s2) {
          const bf16_t* qp_ = Z + (size_t)qrow * ZLD + ZC_RTQ + h * 64 + 32 * s2 + 4 * fq;
          bf16x4 lo = *(const bf16x4*)qp_;
          bf16x4 hi = *(const bf16x4*)(qp_ + 16);
          f32x4 flo = {bfs2f(lo[0]) * scl, bfs2f(lo[1]) * scl, bfs2f(lo[2]) * scl, bfs2f(lo[3]) * scl};
          f32x4 fhi = {bfs2f(hi[0]) * scl, bfs2f(hi[1]) * scl, bfs2f(hi[2]) * scl, bfs2f(hi[3]) * scl};
          pb[s2] = pack8(flo, fhi);
        }
        if (blk == 0) pv_step<64>(pb, sV0, OA, fr, fq);
        else pv_step<64>(pb, sV0, OB, fr, fq);
      }
      __syncthreads();
    }
  }
  const float* gn = p.in[27] + l * 512 + h * 64;
#pragma unroll
  for (int blk = 0; blk < 2; ++blk) {
    f32x4 (&O)[4] = blk == 0 ? OA : OB;
    const int qrow = blk == 0 ? qrowA : qrowB;
    float ss = 0.f;
#pragma unroll
    for (int dt = 0; dt < 4; ++dt) ss += O[dt][0] * O[dt][0] + O[dt][1] * O[dt][1] + O[dt][2] * O[dt][2] + O[dt][3] * O[dt][3];
    ss = xsum32(xsum16(ss));
    const float rsn = rsqrtf(ss * (1.f / 64.f) + 1e-6f);
#pragma unroll
    for (int dt = 0; dt < 4; ++dt) {
      int dv = dt * 16 + fq * 4;
      float4 g = *(const float4*)(gn + dv);
      bf16x4 sg = *(const bf16x4*)(Z + (size_t)qrow * ZLD + ZC_RTG + h * 64 + dv);
      *(bf16x4*)(Y4 + (size_t)qrow * 2048 + 1024 + h * 64 + dv) =
          pack4(O[dt][0] * rsn * g.x * bfs2f(sg[0]), O[dt][1] * rsn * g.y * bfs2f(sg[1]), O[dt][2] * rsn * g.z * bfs2f(sg[2]), O[dt][3] * rsn * g.w * bfs2f(sg[3]));
    }
  }
}

DI void ret_state_item(const P& p, int l, int b, int h) {
  const int tid_ = otid(), lane = tid_ & 63, wid = tid_ >> 6, fr = lane & 15, fq = lane >> 4;
  const bf16_t* KT = (const bf16_t*)(p.ws + WS_KTRT) + (size_t)(b * 512 + h * 64) * 256;
  const bf16_t* VT = (const bf16_t*)(p.ws + WS_VTRT) + (size_t)(b * 512 + h * 64) * 256;
  const float lgf = log1pf(-expf(p.in[25][l * 8 + h]));
  const float lgb = log1pf(-expf(p.in[26][l * 8 + h]));
  f32x4 af[4], ab[4];
#pragma unroll
  for (int nt = 0; nt < 4; ++nt) { af[nt] = f32x4{0.f, 0.f, 0.f, 0.f}; ab[nt] = f32x4{0.f, 0.f, 0.f, 0.f}; }
  for (int ks = 0; ks < 8; ++ks) {
    const int t0 = ks * 32 + fq * 8;
    bf16x8 kraw = *(const bf16x8*)(KT + (size_t)(wid * 16 + fr) * 256 + t0);
    bf16x8 kf, kb;
#pragma unroll
    for (int j = 0; j < 8; ++j) {
      float kv = bfs2f(kraw[j]);
      int t = t0 + j;
      kf[j] = (short)f2bf(kv * __expf(lgf * (float)(255 - t)));
      kb[j] = (short)f2bf(kv * __expf(lgb * (float)t));
    }
#pragma unroll
    for (int nt = 0; nt < 4; ++nt) {
      bf16x8 vb = *(const bf16x8*)(VT + (size_t)(nt * 16 + fr) * 256 + t0);
      af[nt] = MFMA16(kf, vb, af[nt]);
      ab[nt] = MFMA16(kb, vb, ab[nt]);
    }
  }
  float* of = p.out + O_RF + ((size_t)((b * 4 + l) * 8 + h)) * 4096;
  float* ob = p.out + O_RB + ((size_t)((b * 4 + l) * 8 + h)) * 4096;
#pragma unroll
  for (int nt = 0; nt < 4; ++nt)
#pragma unroll
    for (int i = 0; i < 4; ++i) {
      int dk = wid * 16 + fq * 4 + i, dv = nt * 16 + fr;
      of[dk * 64 + dv] = af[nt][i];
      ob[dk * 64 + dv] = ab[nt][i];
    }
}

DI void lru_gates_item(const P& p, int l, int chunk, int n, char* smem) {
  float* XDf = (float*)smem;
  bf16_t* XDb = (bf16_t*)(XDf + 4096);
  const int tid = otid(), lane = tid & 63, wid = tid >> 6, fr = lane & 15, fq = lane >> 4;
  const int row0 = chunk * 64;
  const bool latent = row0 >= NCTX;
  const int T = latent ? 2048 : 256;
  const int tseq0 = latent ? ((row0 - NCTX) & 2047) : (row0 & 255);
  const bf16_t* Z = (const bf16_t*)(p.ws + WS_Z);
  const bf16_t* WL = (const bf16_t*)(p.ws + WS_WLRU);
  bf16_t* LA = (bf16_t*)(p.ws + WS_LA);
  bf16_t* LU = (bf16_t*)(p.ws + WS_LU);
  const int ch0 = n * 64;
  {
    const float cw0 = p.in[28][(l * 4 + 0) * 512 + ch0 + lane];
    const float cw1 = p.in[28][(l * 4 + 1) * 512 + ch0 + lane];
    const float cw2 = p.in[28][(l * 4 + 2) * 512 + ch0 + lane];
    const float cw3 = p.in[28][(l * 4 + 3) * 512 + ch0 + lane];
    const float cb = p.in[29][l * 512 + ch0 + lane];
    const bf16_t* xcol = Z + (size_t)row0 * ZLD + ZC_LRX + ch0 + lane;
    const int t0 = wid * 16;
    auto ld = [&](int tl) -> float {
      int ts = tseq0 + tl;
      return (ts < 0 || ts >= T) ? 0.f : bf2f(xcol[(ptrdiff_t)tl * ZLD]);
    };
    float xm1 = ld(t0 - 1), x0 = ld(t0), x1 = ld(t0 + 1);
#pragma unroll
    for (int i = 0; i < 16; ++i) {
      float x2 = ld(t0 + i + 2);
      float xd = cw0 * xm1 + cw1 * x0 + cw2 * x1 + cw3 * x2 + cb;
      XDf[(t0 + i) * 64 + lane] = xd;
      XDb[(t0 + i) * LDT + lane] = f2bf(xd);
      xm1 = x0; x0 = x1; x1 = x2;
    }
  }
  __syncthreads();
  bf16x8 af[2];
#pragma unroll
  for (int ks = 0; ks < 2; ++ks) af[ks] = *(const bf16x8*)(XDb + (wid * 16 + fr) * LDT + ks * 32 + fq * 8);
#pragma unroll 1
  for (int dir = 0; dir < 2; ++dir) {
    const float* bav = (dir == 0 ? p.in[31] : p.in[36]) + l * 512 + ch0;
    const float* bxv = (dir == 0 ? p.in[33] : p.in[38]) + l * 512 + ch0;
    const float* lamv = (dir == 0 ? p.in[34] : p.in[39]) + l * 512 + ch0;
#pragma unroll
    for (int et = 0; et < 4; ++et) {
      f32x4 da = {0.f, 0.f, 0.f, 0.f}, dx = {0.f, 0.f, 0.f, 0.f};
#pragma unroll
      for (int ks = 0; ks < 2; ++ks) {
        bf16x8 wa = *(const bf16x8*)(WL + (size_t)((dir * 2 + 0) * 8 + n) * 4096 + (et * 16 + fr) * 64 + ks * 32 + fq * 8);
        bf16x8 wx = *(const bf16x8*)(WL + (size_t)((dir * 2 + 1) * 8 + n) * 4096 + (et * 16 + fr) * 64 + ks * 32 + fq * 8);
        da = MFMA16(af[ks], wa, da);
        dx = MFMA16(af[ks], wx, dx);
      }
      const int e = et * 16 + fr;
      const float ba_ = bav[e], bx_ = bxv[e];
      const float sp = log1pf(expf(-lamv[e]));
      float lav[4], uv[4];
#pragma unroll
      for (int i = 0; i < 4; ++i) {
        int tl = wid * 16 + fq * 4 + i;
        float rg = sigmoidf_(da[i] + ba_);
        float ig = sigmoidf_(dx[i] + bx_);
        float la = -8.f * rg * sp;
        lav[i] = la;
        uv[i] = sqrtf(1.f - __expf(2.f * la)) * (ig * XDf[tl * 64 + e]);
      }
      const size_t idx = (size_t)dir * 8388608 + ((size_t)chunk * 512 + ch0 + e) * 64 + wid * 16 + fq * 4;
      *(bf16x4*)(LA + idx) = pack4(lav[0], lav[1], lav[2], lav[3]);
      *(bf16x4*)(LU + idx) = pack4(uv[0], uv[1], uv[2], uv[3]);
    }
  }
  __syncthreads();
}

DI void lru_scan_witem(const P& p, int l, int bglob, int g, int lane) {
  const bool latent = bglob >= 32;
  const int T = latent ? 2048 : 256;
  const int rowbase = latent ? NCTX + (bglob - 32) * 2048 : bglob * 256;
  const int chunk0 = rowbase >> 6, nch = T >> 6;
  const int ch = g * 64 + lane;
  const bf16_t* LA = (const bf16_t*)(p.ws + WS_LA);
  const bf16_t* LU = (const bf16_t*)(p.ws + WS_LU);
  bf16_t* HF = (bf16_t*)(p.ws + WS_HF);
  const bf16_t* LG = (const bf16_t*)(p.ws + WS_LG);
  bf16_t* Y4 = (bf16_t*)(p.ws + WS_Y4);
  {
    float h = latent ? p.in[8][((bglob - 32) * 4 + l) * 512 + ch] : 0.f;
    bf16x8 ca[8], cu[8], na[8], nu[8];
    {
      const size_t b0 = ((size_t)chunk0 * 512 + ch) * 64;
#pragma unroll
      for (int q = 0; q < 8; ++q) { ca[q] = *(const bf16x8*)(LA + b0 + q * 8); cu[q] = *(const bf16x8*)(LU + b0 + q * 8); }
    }
    for (int cc = 0; cc < nch; ++cc) {
      const size_t cbase = ((size_t)(chunk0 + cc) * 512 + ch) * 64;
      const int cn = (cc + 1 < nch) ? cc + 1 : cc;
      const size_t nb = ((size_t)(chunk0 + cn) * 512 + ch) * 64;
#pragma unroll
      for (int q = 0; q < 8; ++q) { na[q] = *(const bf16x8*)(LA + nb + q * 8); nu[q] = *(const bf16x8*)(LU + nb + q * 8); }
#pragma unroll
      for (int q = 0; q < 8; ++q) {
        bf16x8 ho;
#pragma unroll
        for (int j = 0; j < 8; ++j) {
          float a = __expf(bfs2f(ca[q][j]));
          h = a * h + bfs2f(cu[q][j]);
          ho[j] = (short)f2bf(h);
        }
        *(bf16x8*)(HF + cbase + q * 8) = ho;
      }
#pragma unroll
      for (int q = 0; q < 8; ++q) { ca[q] = na[q]; cu[q] = nu[q]; }
    }
    if (!latent) p.out[O_LF + (size_t)(bglob * 4 + l) * 512 + ch] = h;
  }
  {
    float h = latent ? p.in[9][((bglob - 32) * 4 + l) * 512 + ch] : 0.f;
    const bf16_t* LAb = LA + 8388608;
    const bf16_t* LUb = LU + 8388608;
    bf16x8 ca[4], cu[4], chf[4], cg_[4], na[4], nu[4], nhf[4], ng[4];
    const int nb_ = 2 * nch;
    {
      const size_t b0 = ((size_t)(chunk0 + nch - 1) * 512 + ch) * 64 + 32;
#pragma unroll
      for (int q = 0; q < 4; ++q) {
        ca[q] = *(const bf16x8*)(LAb + b0 + q * 8); cu[q] = *(const bf16x8*)(LUb + b0 + q * 8);
        chf[q] = *(const bf16x8*)(HF + b0 + q * 8); cg_[q] = *(const bf16x8*)(LG + b0 + q * 8);
      }
    }
    for (int bi = 0; bi < nb_; ++bi) {
      const int chunk = nch - 1 - (bi >> 1), half = 1 - (bi & 1);
      const int bn = (bi + 1 < nb_) ? bi + 1 : bi;
      const int chunkn = nch - 1 - (bn >> 1), halfn = 1 - (bn & 1);
      const size_t nb = ((size_t)(chunk0 + chunkn) * 512 + ch) * 64 + halfn * 32;
#pragma unroll
      for (int q = 0; q < 4; ++q) {
        na[q] = *(const bf16x8*)(LAb + nb + q * 8); nu[q] = *(const bf16x8*)(LUb + nb + q * 8);
        nhf[q] = *(const bf16x8*)(HF + nb + q * 8); ng[q] = *(const bf16x8*)(LG + nb + q * 8);
      }
      bf16_t* yrow = Y4 + (size_t)(rowbase + chunk * 64 + half * 32) * 2048 + 1536 + ch;
#pragma unroll
      for (int q = 3; q >= 0; --q) {
#pragma unroll
        for (int j = 7; j >= 0; --j) {
          float a = __expf(bfs2f(ca[q][j]));
          h = a * h + bfs2f(cu[q][j]);
          float y = (bfs2f(chf[q][j]) + h) * bfs2f(cg_[q][j]);
          yrow[(size_t)(q * 8 + j) * 2048] = f2bf(y);
        }
      }
#pragma unroll
      for (int q = 0; q < 4; ++q) { ca[q] = na[q]; cu[q] = nu[q]; chf[q] = nhf[q]; cg_[q] = ng[q]; }
    }
    if (!latent) p.out[O_LB + (size_t)(bglob * 4 + l) * 512 + ch] = h;
  }
}

DI int next_item(unsigned* ctr, int* s_item) {
  __syncthreads();
  if (threadIdx.x == 0) *s_item = (int)atomicAdd(ctr, 1u);
  __syncthreads();
  return *s_item;
}
DI void phase_mixa(const P& p, int l, char* smem, int* s_item) {
  unsigned* ctr = (unsigned*)(p.ws + WS_BAR + 14336) + l * 2;
  const int NGRAB = 512 + 512;
  for (;;) {
    int q = next_item(ctr, s_item);
    if (q >= NGRAB) break;
    if (q < 512) { diff_item(p, l, true, q >> 7, (q >> 5) & 3, q & 31, smem); continue; }
    q -= 512;
#pragma unroll 1
    for (int u = 0; u < 4; ++u) { const int g = q * 4 + u; lru_gates_item(p, l, g >> 3, g & 7, smem); }
  }
}
DI void phase_mixb(const P& p, int l, char* smem, int* s_item) {
  unsigned* ctr = (unsigned*)(p.ws + WS_BAR + 14336) + l * 2 + 1;
  const int NGRAB = 72 + 512 + 1024 + 256 + 256 + 256 + 32;
  for (;;) {
    int q = next_item(ctr, s_item);
    if (q >= NGRAB) break;
    if (q < 72) {
      const int tid = otid(), lane = tid & 63, wid = tid >> 6;
      int bglob, g;
      if (q < 32) {
        if (wid == 0) { bglob = 32 + (q >> 3); g = q & 7; }
        else { int ci = q * 3 + wid - 1; bglob = ci >> 3; g = ci & 7; }
      } else {
        int ci = 96 + (q - 32) * 4 + wid;
        bglob = ci >> 3; g = ci & 7;
      }
      lru_scan_witem(p, l, bglob, g, lane);
      continue;
    }
    q -= 72;
    if (q < 512) { ret_item2(p, l, true, q >> 7, (q >> 4) & 7, q & 15, smem); continue; }
    q -= 512;
    if (q < 1024) { na_item(p, l, q >> 8, (q >> 5) & 7, q & 31, smem); continue; }
    q -= 1024;
    if (q < 256) {
#pragma unroll 1
      for (int u = 0; u < 2; ++u) { const int g = q * 2 + u; diff_item(p, l, false, g >> 4, (g >> 2) & 3, g & 3, smem); }
      continue;
    }
    q -= 256;
    if (q < 256) {
#pragma unroll 1
      for (int u = 0; u < 4; ++u) { const int g = q * 4 + u; dense_item(p, g >> 5, (g >> 2) & 7, g & 3, smem); }
      continue;
    }
    q -= 256;
    if (q < 256) {
#pragma unroll 1
      for (int u = 0; u < 2; ++u) { const int g = q * 2 + u; ret_item2(p, l, false, g >> 4, (g >> 1) & 7, g & 1, smem); }
      continue;
    }
    q -= 256;
#pragma unroll 1
    for (int u = 0; u < 8; ++u) { const int g = q * 8 + u; ret_state_item(p, l, g >> 3, g & 7); }
  }
}

#define XB_TMO 128
#define XB_XCNT(j) (256 + 64 * (j))
#define XB_XSUB(j) (1280 + 64 * (j))
#define XB_XGEN(j) (2304 + 64 * (j))
#define XB_TOP 3328
#define XB_TOPGEN 3392
#define XCD_BAR_WORDS 3456
#define XB_SPIN_CAP (1u << 18)
#define LAS __attribute__((address_space(3)))
DI unsigned xb_ld(unsigned* p) { return __hip_atomic_load(p, __ATOMIC_RELAXED, __HIP_MEMORY_SCOPE_AGENT); }
DI unsigned xb_add(unsigned* p, unsigned v) { return __hip_atomic_fetch_add(p, v, __ATOMIC_RELAXED, __HIP_MEMORY_SCOPE_AGENT); }
DI unsigned xb_xcc_id() { return (unsigned)__builtin_amdgcn_s_getreg((3 << 11) | 20) & 0xFu; }
#define XB_SPIN(cond, bar) do { unsigned _sp = 0; while (cond) { __builtin_amdgcn_s_sleep(1); \
    if ((++_sp & 255u) == 0u) { if (xb_ld(&(bar)[XB_TMO])) break; if (_sp > XB_SPIN_CAP) { atomicAdd(&(bar)[XB_TMO], 1u); break; } } } } while (0)
struct XcdBarrier { unsigned* bar; unsigned x; volatile LAS unsigned* st; };
DI XcdBarrier xcd_barrier_post(unsigned* bar, volatile LAS unsigned* st) {
  XcdBarrier b; b.bar = bar; b.x = xb_xcc_id(); b.st = st;
  if (threadIdx.x == 0) (void)xb_add(&bar[XB_XCNT(b.x)], 1u);
  return b;
}
DI void xcd_barrier_complete(unsigned* bar, unsigned x, unsigned& nloc, unsigned& nx) {
  const unsigned G = gridDim.x * gridDim.y * gridDim.z;
  unsigned sum, cnt, mine, sp = 0u;
  for (;;) {
    sum = 0u; cnt = 0u; mine = 0u;
#pragma unroll
    for (unsigned j = 0; j < 16; ++j) { const unsigned c = xb_ld(&bar[XB_XCNT(j)]); sum += c; cnt += (c > 0u) ? 1u : 0u; mine = (j == x) ? c : mine; }
    if (sum == G) break;
    __builtin_amdgcn_s_sleep(1);
    if ((++sp & 255u) == 0u) { if (xb_ld(&bar[XB_TMO])) break; if (sp > XB_SPIN_CAP) { atomicAdd(&bar[XB_TMO], 1u); break; } }
  }
  nloc = mine > 0u ? mine : 1u; nx = cnt > 0u ? cnt : 1u;
}
DI void xcd_barrier(const XcdBarrier& b) {
  asm volatile("s_waitcnt vmcnt(0)" ::: "memory");
  __syncthreads();
  if (threadIdx.x == 0) {
    unsigned* bar = b.bar;
    __builtin_amdgcn_s_waitcnt(0);
    unsigned nloc = b.st[0], nx = b.st[1];
    if (nloc == 0u) { xcd_barrier_complete(bar, b.x, nloc, nx); b.st[0] = nloc; b.st[1] = nx; }
    const unsigned old = xb_add(&bar[XB_XSUB(b.x)], 1u);
    const unsigned gen = old / nloc;
    if (old + 1u == (gen + 1u) * nloc) {
      __builtin_amdgcn_fence(__ATOMIC_RELEASE, "agent");
      asm volatile("s_waitcnt vmcnt(0)" ::: "memory");
      const unsigned og = xb_add(&bar[XB_TOP], 1u);
      const unsigned tg = og / nx;
      if (og + 1u == (tg + 1u) * nx) xb_add(&bar[XB_TOPGEN], 1u);
      else XB_SPIN(xb_ld(&bar[XB_TOPGEN]) == tg, bar);
      __builtin_amdgcn_fence(__ATOMIC_ACQUIRE, "agent");
      xb_add(&bar[XB_XGEN(b.x)], 1u);
      asm volatile("s_waitcnt vmcnt(0)" ::: "memory");
    } else {
      XB_SPIN(xb_ld(&bar[XB_XGEN(b.x)]) == gen, bar);
      __builtin_amdgcn_fence(__ATOMIC_ACQUIRE, "agent");
      asm volatile("s_waitcnt vmcnt(0)" ::: "memory");
    }
  }
  __syncthreads();
}

enum { PH_INIT = 0, PH_PRE0, PH_GIN, PH_MIXA, PH_MIXB, PH_MERGE, PH_OUT, PH_POSTMIX, PH_FF1, PH_FF2, PH_POSTFFN };

DI void run_phase(const P& p, int ph, int l, char* smem, int* s_item) {
  switch (ph) {
    case PH_INIT:
      phase_mod(p, smem);
      phase_convert(p, 0, smem);
      break;
    case PH_PRE0: phase_row(p, 0, 0); break;
    case PH_GIN: phase_gin(p, l, smem); break;
    case PH_MIXA: phase_mixa(p, l, smem, s_item); break;
    case PH_MIXB: phase_mixb(p, l, smem, s_item); break;
    case PH_MERGE: phase_merge(p, smem); break;
    case PH_OUT:
      phase_gemm_plain<0>((const bf16_t*)(p.ws + WS_H), 1024, (const bf16_t*)(p.ws + WS_WOUT), 1024, (bf16_t*)(p.ws + WS_Y), smem);
      break;
    case PH_POSTMIX: phase_row(p, l, 1); break;
    case PH_FF1:
      phase_gemm_plain<1>((const bf16_t*)(p.ws + WS_H), 1024, (const bf16_t*)(p.ws + WS_W1), 4096, (bf16_t*)(p.ws + WS_U), smem);
      break;
    case PH_FF2:
      phase_gemm_plain<0>((const bf16_t*)(p.ws + WS_U), 4096, (const bf16_t*)(p.ws + WS_W2), 1024, (bf16_t*)(p.ws + WS_Y), smem);
      break;
    case PH_POSTFFN:
      phase_row(p, l, 2);
      if (l < 3) phase_convert(p, l + 1, smem);
      break;
    default: break;
  }
}

DI void decode_step(int step, int& ph, int& l) {
  if (step < 2) { ph = step; l = 0; }
  else { int s = step - 2; l = s / 9; ph = PH_GIN + (s % 9); }
}
constexpr int NSTEPS = 38;

__global__ void __launch_bounds__(256, 2) hybrid_flow_mega(P p) {
  __shared__ __attribute__((aligned(16))) char smem[SMEM_BYTES];
  __shared__ uint4 xb_words;
  __shared__ int s_item;
  cg::grid_group grid = cg::this_grid();
  if (threadIdx.x == 0) xb_words = make_uint4(0u, 0u, 0u, 0u);
  __syncthreads();
  XcdBarrier xb = xcd_barrier_post((unsigned*)(p.ws + WS_BAR), (volatile LAS unsigned*)&xb_words);
  for (int step = 0; step < NSTEPS; ++step) {
    int ph, l;
    decode_step(step, ph, l);
#ifdef PROBE_DUP
    const int reps = (ph == PROBE_DUP) ? 2 : 1;
    for (int rep = 0; rep < reps; ++rep)
#endif
    run_phase(p, ph, l, smem, &s_item);
#ifdef PROBE_CONV
    if (ph == PH_POSTFFN && l < 3) phase_convert(p, l + 1, smem);
#endif
    if (p.ws == nullptr) grid.sync();
    if (step + 1 < NSTEPS) xcd_barrier(xb);
#ifdef PROBE_SYNC
    if (step + 1 < NSTEPS) xcd_barrier(xb);
#endif
  }
}

#if !ONE_LAUNCH
__global__ void __launch_bounds__(256, 2) hybrid_flow_phase(P p, int ph, int l) {
  __shared__ __attribute__((aligned(16))) char smem[SMEM_BYTES];
  __shared__ int s_item;
  run_phase(p, ph, l, smem, &s_item);
}
#endif

extern "C" void kernel_launch(void* const* d_in, const int* in_sizes, int n_in, void* d_out, int out_size, void* d_ws,
                              size_t ws_size, hipStream_t stream) {
  (void)in_sizes; (void)n_in; (void)out_size; (void)ws_size;
  P p{};
  for (int i = 0; i < 44; ++i) p.in[i] = (const float*)d_in[i];
  p.out = (float*)d_out;
  p.ws = (char*)d_ws;
#if ONE_LAUNCH
  static int grid_blocks = 0;
  if (!grid_blocks) {
    int dev = 0, cus = 0, per_cu = 0;
    hipGetDevice(&dev);
    hipDeviceGetAttribute(&cus, hipDeviceAttributeMultiprocessorCount, dev);
    hipOccupancyMaxActiveBlocksPerMultiprocessor(&per_cu, hybrid_flow_mega, 256, 0);
    if (per_cu < 1) per_cu = 1;
    if (per_cu > 2) per_cu = 2;
    grid_blocks = cus * per_cu;
  }
  (void)hipMemsetAsync((char*)d_ws + WS_BAR, 0, 16384, stream);
  void* args[] = {&p};
  hipError_t e = hipLaunchCooperativeKernel((void*)hybrid_flow_mega, dim3(grid_blocks), dim3(256), args, 0, stream);
  if (e != hipSuccess) fprintf(stderr, "cooperative launch failed: %s (grid %d)\n", hipGetErrorString(e), grid_blocks);
#else
  const int grid_blocks = 512;
  for (int step = 0; step < NSTEPS; ++step) {
    int ph, l;
    if (step < 2) { ph = step; l = 0; }
    else { int s = step - 2; l = s / 9; ph = PH_GIN + (s % 9); }
    hipLaunchKernelGGL(hybrid_flow_phase, dim3(grid_blocks), dim3(256), 0, stream, p, ph, l);
  }
#endif
}
```

```cpp
#include <hip/hip_runtime.h>
#include <hip/hip_cooperative_groups.h>
#include <cstdio>
namespace cg = cooperative_groups;

#ifndef ONE_LAUNCH
#define ONE_LAUNCH 1
#endif

typedef unsigned short bf16_t;
using bf16x8 = __attribute__((ext_vector_type(8))) short;
using bf16x4 = __attribute__((ext_vector_type(4))) short;
using f32x4 = __attribute__((ext_vector_type(4))) float;
using u32x4 = __attribute__((ext_vector_type(4))) unsigned;
#define DI __device__ __forceinline__
#define MFMA16(a, b, c) __builtin_amdgcn_mfma_f32_16x16x32_bf16((a), (b), (c), 0, 0, 0)

struct P {
  const float* in[44];
  float* out;
  char* ws;
};

constexpr int D = 1024, NCTX = 8192;
constexpr int ZLD = 4160;
constexpr int ZC_NAQ = 0, ZC_NAK = 512, ZC_DFQ = 1024, ZC_DFK = 1536, ZC_RTQ = 2048, ZC_RTK = 2560, ZC_RTG = 3072,
              ZC_LRX = 3584;
constexpr int LDT = 72;

constexpr size_t WS_WIN = 0;
constexpr size_t WS_WBR = WS_WIN + (size_t)10240 * 1024 * 2;
constexpr size_t WS_WOUT = WS_WBR + (size_t)1024 * 2048 * 2;
constexpr size_t WS_W1 = WS_WOUT + (size_t)1024 * 1024 * 2;
constexpr size_t WS_W2 = WS_W1 + (size_t)4096 * 1024 * 2;
constexpr size_t WS_WLRU = WS_W2 + (size_t)4096 * 1024 * 2;
constexpr size_t WS_CKNA = WS_WLRU + (size_t)32 * 4096 * 2;
constexpr size_t WS_CVNA = WS_CKNA + (size_t)4 * 262144 * 2;
constexpr size_t WS_CKDF = WS_CVNA + (size_t)4 * 262144 * 2;
constexpr size_t WS_CVDF = WS_CKDF + (size_t)4 * 262144 * 2;
constexpr size_t WS_MOD = WS_CVDF + (size_t)4 * 262144 * 2;
constexpr size_t WS_H = WS_MOD + (size_t)4 * 5 * 6144 * 4;
constexpr size_t WS_Y4 = WS_H + (size_t)16384 * 1024 * 2;
constexpr size_t WS_VTNA = WS_Y4 + (size_t)16384 * 2048 * 2;
constexpr size_t WS_VTDF = WS_VTNA + (size_t)16384 * 512 * 2;
constexpr size_t WS_VTRT = WS_VTDF + (size_t)16384 * 512 * 2;
constexpr size_t WS_KTRT = WS_VTRT + (size_t)16384 * 512 * 2;
constexpr size_t WS_Z = WS_KTRT + (size_t)8192 * 512 * 2;
constexpr size_t WS_GF = WS_Z + (size_t)16384 * ZLD * 2;
constexpr size_t WS_Y = WS_Z;
constexpr size_t WS_U = WS_Z + (size_t)16384 * 1024 * 4;
constexpr size_t WS_LA = WS_GF + (size_t)16384 * 4096 * 2;
constexpr size_t WS_LU = WS_LA + (size_t)2 * 16384 * 512 * 2;
constexpr size_t WS_HF = WS_LU + (size_t)2 * 16384 * 512 * 2;
constexpr size_t WS_LG = WS_HF + (size_t)16384 * 512 * 2;
constexpr size_t WS_BAR = WS_LG + (size_t)16384 * 512 * 2;
constexpr size_t WS_END = WS_BAR + 16384;

constexpr size_t O_NAK = 16777216, O_NAV = 33554432, O_DFK = 50331648, O_DFV = 67108864, O_RF = 83886080,
                 O_RB = 88080384, O_LF = 92274688, O_LB = 92340224;
constexpr int VT_LAT = 4194304;

constexpr int SMEM_BYTES = 75776;

DI int otid() {
  int t = threadIdx.x;
  asm volatile("" : "+v"(t));
  return t;
}
typedef __bf16 hwbf2 __attribute__((ext_vector_type(2)));
typedef float f32v2 __attribute__((ext_vector_type(2)));
using u32x2 = __attribute__((ext_vector_type(2))) unsigned;
DI unsigned pk2(float a, float b) {
  f32v2 v = {a, b};
  return __builtin_bit_cast(unsigned, __builtin_convertvector(v, hwbf2));
}
DI bf16_t f2bf(float x) { return (bf16_t)(pk2(x, 0.f) & 0xffffu); }
DI float bf2f(bf16_t b) { return __uint_as_float(((unsigned)b) << 16); }
DI float bfs2f(short b) { return __uint_as_float(((unsigned)(unsigned short)b) << 16); }
DI float wave_sum(float v) {
#pragma unroll
  for (int o = 32; o > 0; o >>= 1) v += __shfl_xor(v, o);
  return v;
}
DI float xmax16(float v) {
  unsigned u = __float_as_uint(v);
  auto r = __builtin_amdgcn_permlane16_swap(u, u, false, false);
  return fmaxf(__uint_as_float(r[0]), __uint_as_float(r[1]));
}
DI float xmax32(float v) {
  unsigned u = __float_as_uint(v);
  auto r = __builtin_amdgcn_permlane32_swap(u, u, false, false);
  return fmaxf(__uint_as_float(r[0]), __uint_as_float(r[1]));
}
DI float xsum16(float v) {
  unsigned u = __float_as_uint(v);
  auto r = __builtin_amdgcn_permlane16_swap(u, u, false, false);
  return __uint_as_float(r[0]) + __uint_as_float(r[1]);
}
DI float xsum32(float v) {
  unsigned u = __float_as_uint(v);
  auto r = __builtin_amdgcn_permlane32_swap(u, u, false, false);
  return __uint_as_float(r[0]) + __uint_as_float(r[1]);
}
DI float sigmoidf_(float x) { return 1.f / (1.f + __expf(-x)); }
DI float gelu_tanh(float x) {
  float u = 0.7978845608028654f * (x + 0.044715f * x * x * x);
  return x * sigmoidf_(2.f * u);
}
DI bf16x8 pack8(const f32x4& a, const f32x4& b) {
  u32x4 r = {pk2(a[0], a[1]), pk2(a[2], a[3]), pk2(b[0], b[1]), pk2(b[2], b[3])};
  return __builtin_bit_cast(bf16x8, r);
}
DI bf16x4 pack4(float a, float b, float c, float d) {
  u32x2 r = {pk2(a, b), pk2(c, d)};
  return __builtin_bit_cast(bf16x4, r);
}

constexpr int GEMM_BUF_BYTES = 32768;
DI int swz_off(int rr, int c4) {
  int ob = rr * 64 + c4 * 16;
  return ob ^ (((ob >> 9) & 1) << 5);
}
template <int NI>
DI void gemm_mainloop(const bf16_t* __restrict__ A, int lda, const bf16_t* __restrict__ Bt, int ldb, int K, int row0,
                      int col0, char* smem, f32x4 (&acc)[4][NI]) {
  const int tid = otid(), lane = tid & 63, wid = tid >> 6;
  const int wm = wid >> 1, wn = wid & 1, fr = lane & 15, fq = lane >> 4;
  const int c4 = tid & 3, kh = (tid >> 3) & 1;
  const int srow = ((tid >> 4) << 1) + ((tid >> 2) & 1);
  const int gk = (kh * 4 + c4) * 8;
  const int soff = ((srow >> 4) * 2 + kh) * 1024 + swz_off(srow & 15, c4);
  const bf16_t* Ag = A + (size_t)(row0 + srow) * lda + gk;
  const bf16_t* Bg = Bt + (size_t)(col0 + srow) * ldb + gk;
  const int aoff = wm * 8192 + swz_off(fr, fq);
  const int boff = 16384 + wn * NI * 2048 + swz_off(fr, fq);
  u32x4 ra[4], rb[NI];
#pragma unroll
  for (int i = 0; i < 4; ++i) ra[i] = *(const u32x4*)(Ag + (size_t)(i * 32) * lda);
#pragma unroll
  for (int i = 0; i < NI; ++i) rb[i] = *(const u32x4*)(Bg + (size_t)(i * 32) * ldb);
#pragma unroll
  for (int i = 0; i < 4; ++i) *(u32x4*)(smem + soff + i * 4096) = ra[i];
#pragma unroll
  for (int i = 0; i < NI; ++i) *(u32x4*)(smem + 16384 + soff + i * 4096) = rb[i];
  __syncthreads();
  const int nk = K >> 6;
  for (int kt = 0; kt < nk; ++kt) {
    const bool more = (kt + 1) < nk;
    if (more) {
      const int k1 = (kt + 1) * 64;
#pragma unroll
      for (int i = 0; i < 4; ++i) ra[i] = *(const u32x4*)(Ag + (size_t)(i * 32) * lda + k1);
#pragma unroll
      for (int i = 0; i < NI; ++i) rb[i] = *(const u32x4*)(Bg + (size_t)(i * 32) * ldb + k1);
    }
    asm volatile("" ::: "memory");
    const char* sb = smem + (kt & 1) * GEMM_BUF_BYTES;
#pragma unroll
    for (int ks = 0; ks < 2; ++ks) {
      bf16x8 af[4], bfr[NI];
#pragma unroll
      for (int mi = 0; mi < 4; ++mi) af[mi] = *(const bf16x8*)(sb + aoff + mi * 2048 + ks * 1024);
#pragma unroll
      for (int ni = 0; ni < NI; ++ni) bfr[ni] = *(const bf16x8*)(sb + boff + ni * 2048 + ks * 1024);
#pragma unroll
      for (int mi = 0; mi < 4; ++mi)
#pragma unroll
        for (int ni = 0; ni < NI; ++ni) acc[mi][ni] = MFMA16(bfr[ni], af[mi], acc[mi][ni]);
    }
    __builtin_amdgcn_sched_barrier(0);
    if (more) {
      char* db = smem + ((kt + 1) & 1) * GEMM_BUF_BYTES;
#pragma unroll
      for (int i = 0; i < 4; ++i) *(u32x4*)(db + soff + i * 4096) = ra[i];
#pragma unroll
      for (int i = 0; i < NI; ++i) *(u32x4*)(db + 16384 + soff + i * 4096) = rb[i];
    }
    __syncthreads();
  }
}

DI void zero_acc(f32x4 (&acc)[4][4]) {
#pragma unroll
  for (int mi = 0; mi < 4; ++mi)
#pragma unroll
    for (int ni = 0; ni < 4; ++ni) acc[mi][ni] = f32x4{0.f, 0.f, 0.f, 0.f};
}
DI bool tile_sched(int iter, int tmt, int ntn, int& tm, int& tn) {
  const int G = gridDim.x, b = blockIdx.x;
  if ((G & 63) == 0 && (ntn & 7) == 0 && (tmt & 7) == 0) {
    const int groups = G >> 6, xg = b % groups, j = b / groups;
    const int srows = tmt >> 3;
    const int s = iter * groups + xg, nsuper = srows * (ntn >> 3);
    if (s >= nsuper) return false;
    tm = (s % srows) * 8 + (j & 7);
    tn = (s / srows) * 8 + (j >> 3);
    return true;
  }
  const int id = b + iter * G;
  if (id >= tmt * ntn) return false;
  tm = id % tmt;
  tn = id / tmt;
  return true;
}

constexpr int G2_STAGE = 24576;
DI void zero_acc2(f32x4 (&acc)[8][4]) {
#pragma unroll
  for (int mi = 0; mi < 8; ++mi)
#pragma unroll
    for (int ni = 0; ni < 4; ++ni) acc[mi][ni] = f32x4{0.f, 0.f, 0.f, 0.f};
}
DI void gemm2_mainloop(const bf16_t* __restrict__ A, int lda, const bf16_t* __restrict__ Bt, int ldb, int K, int row0,
                       int col0, char* smem, f32x4 (&acc)[8][4]) {
  const int tid = otid(), lane = tid & 63, wid = tid >> 6;
  const int wm = wid >> 1, wn = wid & 1, fr = lane & 15, fq = lane >> 4;
  const int c4 = tid & 3, srow = tid >> 2;
  const int soff = (srow >> 4) * 1024 + swz_off(srow & 15, c4);
  const bf16_t* Ag = A + (size_t)(row0 + srow) * lda + c4 * 8;
  const bf16_t* Bg = Bt + (size_t)(col0 + srow) * ldb + c4 * 8;
  const int aoff = wm * 8192 + swz_off(fr, fq);
  const int boff = 16384 + wn * 4096 + swz_off(fr, fq);
  u32x4 raA[4], rbA[2], raB[4], rbB[2];
  const int nk = K >> 5;
  auto gload = [&](int kt, u32x4 (&ra)[4], u32x4 (&rb)[2]) __attribute__((always_inline)) {
    const int k1 = kt * 32;
#pragma unroll
    for (int i = 0; i < 4; ++i) ra[i] = *(const u32x4*)(Ag + (size_t)(i * 64) * lda + k1);
#pragma unroll
    for (int i = 0; i < 2; ++i) rb[i] = *(const u32x4*)(Bg + (size_t)(i * 64) * ldb + k1);
  };
  auto sstore = [&](int st, const u32x4 (&ra)[4], const u32x4 (&rb)[2]) __attribute__((always_inline)) {
    char* db = smem + st * G2_STAGE;
#pragma unroll
    for (int i = 0; i < 4; ++i) *(u32x4*)(db + soff + i * 4096) = ra[i];
#pragma unroll
    for (int i = 0; i < 2; ++i) *(u32x4*)(db + 16384 + soff + i * 4096) = rb[i];
  };
  auto step = [&](int st, int ktn, u32x4 (&ra)[4], u32x4 (&rb)[2], const u32x4 (&wa)[4], const u32x4 (&wb)[2]) __attribute__((always_inline)) {
    const char* sb = smem + st * G2_STAGE;
    bf16x8 bfr[4];
#pragma unroll
    for (int ni = 0; ni < 4; ++ni) bfr[ni] = *(const bf16x8*)(sb + boff + ni * 1024);
    bf16x8 af0 = *(const bf16x8*)(sb + aoff);
    asm volatile("" ::: "memory");
    gload(ktn, ra, rb);
    asm volatile("" ::: "memory");
    __builtin_amdgcn_s_setprio(1);
#pragma unroll
    for (int mi = 0; mi < 4; ++mi) {
      bf16x8 af = af0;
      if (mi > 0) af = *(const bf16x8*)(sb + aoff + mi * 1024);
#pragma unroll
      for (int ni = 0; ni < 4; ++ni) acc[mi][ni] = MFMA16(bfr[ni], af, acc[mi][ni]);
    }
    __builtin_amdgcn_s_setprio(0);
    __builtin_amdgcn_sched_barrier(0);
    sstore(st ^ 1, wa, wb);
    __builtin_amdgcn_sched_barrier(0);
    __builtin_amdgcn_s_setprio(1);
#pragma unroll
    for (int mi = 4; mi < 8; ++mi) {
      bf16x8 af = *(const bf16x8*)(sb + aoff + mi * 1024);
#pragma unroll
      for (int ni = 0; ni < 4; ++ni) acc[mi][ni] = MFMA16(bfr[ni], af, acc[mi][ni]);
    }
    __builtin_amdgcn_s_setprio(0);
  };
  gload(0, raA, rbA);
  gload(1, raB, rbB);
  sstore(0, raA, rbA);
  __syncthreads();
  for (int kt = 0; kt < nk; kt += 2) {
    step(0, kt + 2 < nk ? kt + 2 : nk - 1, raA, rbA, raB, rbB);
    __syncthreads();
    step(1, kt + 3 < nk ? kt + 3 : nk - 1, raB, rbB, raA, rbA);
    __syncthreads();
  }
}

constexpr int G3_STAGE = 16384;
DI void gemm3_mainloop(const bf16_t* __restrict__ A, int lda, const bf16_t* __restrict__ Bt, int ldb, int K, int row0,
                       int col0, char* smem, f32x4 (&acc)[4][4]) {
  const int tid = otid(), lane = tid & 63, wid = tid >> 6;
  const int wm = wid >> 1, wn = wid & 1, fr = lane & 15, fq = lane >> 4;
  const int c4 = tid & 3, srow = tid >> 2;
  const int soff = (srow >> 4) * 1024 + swz_off(srow & 15, c4);
  const bf16_t* Ag = A + (size_t)(row0 + srow) * lda + c4 * 8;
  const bf16_t* Bg = Bt + (size_t)(col0 + srow) * ldb + c4 * 8;
  const int aoff = wm * 4096 + swz_off(fr, fq);
  const int boff = 8192 + wn * 4096 + swz_off(fr, fq);
  u32x4 raA[2], rbA[2], raB[2], rbB[2];
  const int nk = K >> 5;
  auto gload = [&](int kt, u32x4 (&ra)[2], u32x4 (&rb)[2]) __attribute__((always_inline)) {
    const int k1 = kt * 32;
#pragma unroll
    for (int i = 0; i < 2; ++i) { ra[i] = *(const u32x4*)(Ag + (size_t)(i * 64) * lda + k1); rb[i] = *(const u32x4*)(Bg + (size_t)(i * 64) * ldb + k1); }
  };
  auto sstore = [&](int st, const u32x4 (&ra)[2], const u32x4 (&rb)[2]) __attribute__((always_inline)) {
    char* db = smem + st * G3_STAGE;
#pragma unroll
    for (int i = 0; i < 2; ++i) { *(u32x4*)(db + soff + i * 4096) = ra[i]; *(u32x4*)(db + 8192 + soff + i * 4096) = rb[i]; }
  };
  auto step = [&](int st, int ktn, u32x4 (&ra)[2], u32x4 (&rb)[2], const u32x4 (&wa)[2], const u32x4 (&wb)[2]) __attribute__((always_inline)) {
    const char* sb = smem + st * G3_STAGE;
    bf16x8 bfr[4];
#pragma unroll
    for (int ni = 0; ni < 4; ++ni) bfr[ni] = *(const bf16x8*)(sb + boff + ni * 1024);
    bf16x8 af0 = *(const bf16x8*)(sb + aoff);
    asm volatile("" ::: "memory");
    gload(ktn, ra, rb);
    asm volatile("" ::: "memory");
    __builtin_amdgcn_s_setprio(1);
#pragma unroll
    for (int mi = 0; mi < 2; ++mi) {
      bf16x8 af = af0;
      if (mi > 0) af = *(const bf16x8*)(sb + aoff + mi * 1024);
#pragma unroll
      for (int ni = 0; ni < 4; ++ni) acc[mi][ni] = MFMA16(bfr[ni], af, acc[mi][ni]);
    }
    __builtin_amdgcn_s_setprio(0);
    __builtin_amdgcn_sched_barrier(0);
    sstore(st ^ 1, wa, wb);
    __builtin_amdgcn_sched_barrier(0);
    __builtin_amdgcn_s_setprio(1);
#pragma unroll
    for (int mi = 2; mi < 4; ++mi) {
      bf16x8 af = *(const bf16x8*)(sb + aoff + mi * 1024);
#pragma unroll
      for (int ni = 0; ni < 4; ++ni) acc[mi][ni] = MFMA16(bfr[ni], af, acc[mi][ni]);
    }
    __builtin_amdgcn_s_setprio(0);
  };
  gload(0, raA, rbA);
  gload(1, raB, rbB);
  sstore(0, raA, rbA);
  __syncthreads();
  for (int kt = 0; kt < nk; kt += 2) {
    step(0, kt + 2 < nk ? kt + 2 : nk - 1, raA, rbA, raB, rbB);
    __syncthreads();
    step(1, kt + 3 < nk ? kt + 3 : nk - 1, raB, rbB, raA, rbA);
    __syncthreads();
  }
}

constexpr int CST_B = 272;
constexpr int CST_T = 528;
template <int MI, int NI, class F>
DI void stage_rowmajor(char* smem, f32x4 (&acc)[MI][NI], int wm, int wn, int fr, int fq, F&& tf) {
#pragma unroll
  for (int mi = 0; mi < MI; ++mi)
#pragma unroll
    for (int ni = 0; ni < NI; ++ni) {
      f32x4 v = tf(acc[mi][ni]);
      *(bf16x4*)(smem + (wm * MI * 16 + mi * 16 + fr) * CST_B + (wn * NI * 16 + ni * 16 + fq * 4) * 2) = pack4(v[0], v[1], v[2], v[3]);
      if (ni == NI - 1) __builtin_amdgcn_sched_barrier(0);
    }
}
template <int MI, int NI, class F>
DI void stage_transposed(char* smem, f32x4 (&acc)[MI][NI], int wm, int wn, int fr, int fq, F&& tf) {
#pragma unroll
  for (int mi = 0; mi < MI; ++mi)
#pragma unroll
    for (int ni = 0; ni < NI; ++ni) {
      f32x4 v = tf(acc[mi][ni]);
      char* base = smem + (wn * NI * 16 + ni * 16 + fq * 4) * CST_T + (wm * MI * 16 + mi * 16 + fr) * 2;
      *(bf16_t*)(base) = f2bf(v[0]);
      *(bf16_t*)(base + CST_T) = f2bf(v[1]);
      *(bf16_t*)(base + 2 * CST_T) = f2bf(v[2]);
      *(bf16_t*)(base + 3 * CST_T) = f2bf(v[3]);
      if (ni == NI - 1) __builtin_amdgcn_sched_barrier(0);
    }
}
template <int LINES, int CPL, int STRIDE, class D>
DI void writeout(const char* smem, int tid, D&& dst) {
#pragma unroll 4
  for (int j = 0; j < LINES * CPL / 256; ++j) {
    const int id = tid + j * 256, line = id / CPL, c = id % CPL;
    u32x4 v = *(const u32x4*)(smem + line * STRIDE + c * 16);
    *(u32x4*)dst(line, c) = v;
  }
}

DI void stage_rowmajor_rope(char* smem, f32x4 (&acc)[8][4], int wm, int wn, int fr, int fq, int rtok) {
  float inv[4];
#pragma unroll
  for (int i = 0; i < 4; ++i) inv[i] = exp2f(-(float)(fq * 4 + i) * 0.8304820237218406f);
#pragma unroll
  for (int mi = 0; mi < 8; ++mi) {
    const int t = (rtok + mi * 16 - NCTX) & 2047;
    const float gr = (float)(t >> 6), gc = (float)(t & 63);
    f32x4 o0, o1, o2, o3;
#pragma unroll
    for (int i = 0; i < 4; ++i) {
      const float sr = __sinf(gr * inv[i]), cr = __cosf(gr * inv[i]);
      const float sc = __sinf(gc * inv[i]), cc = __cosf(gc * inv[i]);
      const float a0 = acc[mi][0][i], a1 = acc[mi][1][i], a2 = acc[mi][2][i], a3 = acc[mi][3][i];
      o0[i] = a0 * cr - a1 * sr;
      o1[i] = a1 * cr + a0 * sr;
      o2[i] = a2 * cc - a3 * sc;
      o3[i] = a3 * cc + a2 * sc;
    }
    char* base = smem + (wm * 128 + mi * 16 + fr) * CST_B + (wn * 64 + fq * 4) * 2;
    *(bf16x4*)(base) = pack4(o0[0], o0[1], o0[2], o0[3]);
    *(bf16x4*)(base + 32) = pack4(o1[0], o1[1], o1[2], o1[3]);
    *(bf16x4*)(base + 64) = pack4(o2[0], o2[1], o2[2], o2[3]);
    *(bf16x4*)(base + 96) = pack4(o3[0], o3[1], o3[2], o3[3]);
    __builtin_amdgcn_sched_barrier(0);
  }
}

DI void epi_in(const P& p, int l, int row0, int col0, f32x4 (&acc)[8][4], char* smem) {
  const int tid_ = otid(), lane = tid_ & 63, wid = tid_ >> 6, wm = wid >> 1, wn = wid & 1, fr = lane & 15, fq = lane >> 4;
  const int seg = col0 >> 9;
  const bool ctx = row0 < NCTX;
  if (seg >= 12) {
    bf16_t* GF = (bf16_t*)(p.ws + WS_GF);
    const int k = (seg - 12) >> 1, tn = ((col0 - 6144) & 1023) >> 7, tm = row0 >> 8;
    bf16_t* dst = GF + (((size_t)k * 64 + tm) * 8 + tn) * 32768 + tid_ * 4;
#pragma unroll
    for (int mi = 0; mi < 8; ++mi)
#pragma unroll
      for (int ni = 0; ni < 4; ++ni)
        *(bf16x4*)(dst + (mi * 4 + ni) * 1024) = pack4(sigmoidf_(acc[mi][ni][0]), sigmoidf_(acc[mi][ni][1]), sigmoidf_(acc[mi][ni][2]), sigmoidf_(acc[mi][ni][3]));
    return;
  }
  const int ctile = col0 & 511;
  const int cseg0 = ctile + wn * 64;
  const int rtok = row0 + wm * 128 + fr;
  if (ctx && (seg == 1 || seg == 2 || seg == 4 || seg == 5)) {
    float* out = p.out;
#pragma unroll
    for (int mi = 0; mi < 8; ++mi) {
      const int r = rtok + mi * 16, b = r >> 8, t = r & 255;
      size_t off;
      if (seg == 1 || seg == 2) {
        const int h = cseg0 >> 6;
        off = (seg == 1 ? O_NAK : O_NAV) + (((size_t)(b * 4 + l) * 8 + h) * 256 + t) * 64;
      } else if (seg == 4) {
        const int comp = cseg0 >> 8, h = (cseg0 >> 6) & 3;
        off = O_DFK + ((((size_t)(b * 4 + l) * 2 + comp) * 4 + h) * 256 + t) * 64;
      } else {
        const int h = cseg0 >> 7;
        off = O_DFV + (((size_t)(b * 4 + l) * 4 + h) * 256 + t) * 128 + (cseg0 & 127);
      }
#pragma unroll
      for (int ni = 0; ni < 4; ++ni) *(f32x4*)(out + off + ni * 16 + fq * 4) = acc[mi][ni];
      __builtin_amdgcn_sched_barrier(0);
    }
  }
  auto tf_none = [](const f32x4& a) -> f32x4 { return a; };
  auto tf_scale = [](const f32x4& a) -> f32x4 { return f32x4{a[0] * 0.125f, a[1] * 0.125f, a[2] * 0.125f, a[3] * 0.125f}; };
  auto tf_silu = [](const f32x4& a) -> f32x4 { return f32x4{a[0] * sigmoidf_(a[0]), a[1] * sigmoidf_(a[1]), a[2] * sigmoidf_(a[2]), a[3] * sigmoidf_(a[3])}; };
  auto tf_gelu = [](const f32x4& a) -> f32x4 { return f32x4{gelu_tanh(a[0]), gelu_tanh(a[1]), gelu_tanh(a[2]), gelu_tanh(a[3])}; };
  const bool rowmajor = !(seg == 2 || seg == 5 || seg == 8 || seg == 11);
  if (rowmajor) {
    int zc;
    switch (seg) {
      case 0: zc = ZC_NAQ; break;
      case 1: zc = ZC_NAK; break;
      case 3: zc = ZC_DFQ; break;
      case 4: zc = ZC_DFK; break;
      case 6: zc = ZC_RTQ; break;
      case 7: zc = ZC_RTK; break;
      case 9: zc = ZC_RTG; break;
      default: zc = ZC_LRX; break;
    }
    if (!ctx && (seg == 3 || seg == 4)) stage_rowmajor_rope(smem, acc, wm, wn, fr, fq, rtok);
    else if (seg == 7) stage_rowmajor<8, 4>(smem, acc, wm, wn, fr, fq, tf_scale);
    else if (seg == 9) stage_rowmajor<8, 4>(smem, acc, wm, wn, fr, fq, tf_silu);
    else stage_rowmajor<8, 4>(smem, acc, wm, wn, fr, fq, tf_none);
    __syncthreads();
    bf16_t* zb = (bf16_t*)(p.ws + WS_Z) + (size_t)row0 * ZLD + zc + ctile;
    writeout<256, 16, CST_B>(smem, tid_, [&](int line, int c) { return zb + (size_t)line * ZLD + c * 8; });
    __syncthreads();
  }
  if (!rowmajor || (seg == 7 && ctx)) {
    if (seg == 7) stage_transposed<8, 4>(smem, acc, wm, wn, fr, fq, tf_scale);
    else if (seg == 11) stage_transposed<8, 4>(smem, acc, wm, wn, fr, fq, tf_gelu);
    else stage_transposed<8, 4>(smem, acc, wm, wn, fr, fq, tf_none);
    __syncthreads();
    if (seg == 11) {
      bf16_t* lg = (bf16_t*)(p.ws + WS_LG) + ((size_t)(row0 >> 6) * 512 + ctile) * 64;
      writeout<128, 32, CST_T>(smem, tid_, [&](int line, int c) { return lg + ((size_t)(c >> 3) * 512 + line) * 64 + (c & 7) * 8; });
    } else {
      bf16_t* tb = (bf16_t*)(p.ws + (seg == 2 ? WS_VTNA : seg == 5 ? WS_VTDF : seg == 8 ? WS_VTRT : WS_KTRT));
      int T;
      if (ctx) { T = 256; tb += ((size_t)((row0 >> 8) * 512 + ctile)) * 256 + (row0 & 255); }
      else { const int rr = row0 - NCTX; T = 2048; tb += (size_t)VT_LAT + ((size_t)((rr >> 11) * 512 + ctile)) * 2048 + (rr & 2047); }
      writeout<128, 32, CST_T>(smem, tid_, [&](int line, int c) { return tb + (size_t)line * T + c * 8; });
    }
    __syncthreads();
  }
}

DI void phase_gin(const P& p, int l, char* smem) {
  const bf16_t* A = (const bf16_t*)(p.ws + WS_H);
  const bf16_t* Bt = (const bf16_t*)(p.ws + WS_WIN);
  for (int it = 0;; ++it) {
    int tm, tn;
    if (!tile_sched(it, 64, 80, tm, tn)) break;
    f32x4 acc[8][4];
    zero_acc2(acc);
    gemm2_mainloop(A, 1024, Bt, 1024, 1024, tm * 256, tn * 128, smem, acc);
    epi_in(p, l, tm * 256, tn * 128, acc, smem);
  }
}

DI void phase_merge(const P& p, char* smem) {
  const bf16_t* Y4 = (const bf16_t*)(p.ws + WS_Y4);
  const bf16_t* WB = (const bf16_t*)(p.ws + WS_WBR);
  const bf16_t* GF = (const bf16_t*)(p.ws + WS_GF);
  bf16_t* G = (bf16_t*)(p.ws + WS_H);
  const int tid_ = otid(), lane = tid_ & 63, wid = tid_ >> 6, wm = wid >> 1, wn = wid & 1, fr = lane & 15, fq = lane >> 4;
  for (int it = 0;; ++it) {
    int tm, tn;
    if (!tile_sched(it, 128, 8, tm, tn)) break;
    const int row0 = tm * 128, col0 = tn * 128;
    f32x4 o[4][4];
    zero_acc(o);
#pragma unroll 1
    for (int k = 0; k < 4; ++k) {
      f32x4 acc[4][4];
      zero_acc(acc);
      gemm3_mainloop(Y4 + k * 512, 2048, WB + k * 512, 2048, 512, row0, col0, smem, acc);
      const bf16_t* gsrc = GF + (((size_t)k * 64 + (tm >> 1)) * 8 + tn) * 32768 + (((tm & 1) * 2 + wn) * 64 + lane) * 4 + (wm * 16) * 1024;
#pragma unroll
      for (int mi = 0; mi < 4; ++mi) {
        bf16x4 gq[4];
#pragma unroll
        for (int ni = 0; ni < 4; ++ni) gq[ni] = *(const bf16x4*)(gsrc + (mi * 4 + ni) * 1024);
#pragma unroll
        for (int ni = 0; ni < 4; ++ni)
#pragma unroll
          for (int i = 0; i < 4; ++i) o[mi][ni][i] += bfs2f(gq[ni][i]) * acc[mi][ni][i];
      }
    }
    stage_rowmajor<4, 4>(smem, o, wm, wn, fr, fq, [](const f32x4& a) { return a; });
    __syncthreads();
    bf16_t* gb = G + (size_t)row0 * 1024 + col0;
    writeout<128, 16, CST_B>(smem, tid_, [&](int line, int c) { return gb + (size_t)line * 1024 + c * 8; });
    __syncthreads();
  }
}

template <int MODE>
DI void phase_gemm_plain(const bf16_t* A, int K, const bf16_t* Bt, int N, bf16_t* outp, char* smem) {
  const int tid_ = otid(), lane = tid_ & 63, wid = tid_ >> 6, wm = wid >> 1, wn = wid & 1, fr = lane & 15, fq = lane >> 4;
  const int ntn = N / 128;
  for (int it = 0;; ++it) {
    int tm, tn;
    if (!tile_sched(it, 64, ntn, tm, tn)) break;
    const int row0 = tm * 256, col0 = tn * 128;
    f32x4 acc[8][4];
    zero_acc2(acc);
    gemm2_mainloop(A, K, Bt, K, K, row0, col0, smem, acc);
    stage_rowmajor<8, 4>(smem, acc, wm, wn, fr, fq, [](const f32x4& a) {
      f32x4 v = a;
      if (MODE == 1) {
        v[0] = fmaxf(v[0], 0.f); v[1] = fmaxf(v[1], 0.f); v[2] = fmaxf(v[2], 0.f); v[3] = fmaxf(v[3], 0.f);
        v[0] *= v[0]; v[1] *= v[1]; v[2] *= v[2]; v[3] *= v[3];
      }
      return v;
    });
    __syncthreads();
    bf16_t* ob = outp + (size_t)row0 * N + col0;
    writeout<256, 16, CST_B>(smem, tid_, [&](int line, int c) { return ob + (size_t)line * N + c * 8; });
    __syncthreads();
  }
}

DI void phase_mod(const P& p, char* smem) {
  float* ssil = (float*)smem;
  float* red = ssil + 5 * 1024;
  const int tid = otid();
  float* MOD = (float*)(p.ws + WS_MOD);
  for (int idx = tid; idx < 5120; idx += 256) {
    int j = idx >> 10, k = idx & 1023;
    float cv = (j == 0) ? p.in[11][k] : p.in[10][(j - 1) * 1024 + k];
    ssil[idx] = cv / (1.f + expf(-cv));
  }
  __syncthreads();
  const int cl = tid & 63, kg = tid >> 6;
  for (int item = blockIdx.x; item < 384; item += gridDim.x) {
    int l = item / 96, cgp = item % 96;
    int col = cgp * 64 + cl;
    const float* W = p.in[12] + (size_t)l * 1024 * 6144 + col;
    float a0 = 0, a1 = 0, a2 = 0, a3 = 0, a4 = 0;
#pragma unroll 8
    for (int k = kg * 256; k < kg * 256 + 256; ++k) {
      float w = W[(size_t)k * 6144];
      a0 += ssil[k] * w;
      a1 += ssil[1024 + k] * w;
      a2 += ssil[2048 + k] * w;
      a3 += ssil[3072 + k] * w;
      a4 += ssil[4096 + k] * w;
    }
    red[(kg * 5 + 0) * 64 + cl] = a0;
    red[(kg * 5 + 1) * 64 + cl] = a1;
    red[(kg * 5 + 2) * 64 + cl] = a2;
    red[(kg * 5 + 3) * 64 + cl] = a3;
    red[(kg * 5 + 4) * 64 + cl] = a4;
    __syncthreads();
    if (kg == 0) {
      float bias = p.in[13][l * 6144 + col];
#pragma unroll
      for (int j = 0; j < 5; ++j) {
        float s = red[(0 * 5 + j) * 64 + cl] + red[(1 * 5 + j) * 64 + cl] + red[(2 * 5 + j) * 64 + cl] + red[(3 * 5 + j) * 64 + cl];
        MOD[(size_t)(l * 5 + j) * 6144 + col] = s + bias;
      }
    }
    __syncthreads();
  }
}

DI void transpose_tile(const float* __restrict__ src, int lds_, bf16_t* __restrict__ dst, int ldd, float* tile) {
  const int tid = otid();
#pragma unroll 4
  for (int i = 0; i < 16; ++i) {
    int idx = tid + i * 256, r = idx >> 6, c = idx & 63;
    tile[r * 65 + c] = src[(size_t)r * lds_ + c];
  }
  __syncthreads();
#pragma unroll 4
  for (int i = 0; i < 16; ++i) {
    int idx = tid + i * 256, c = idx >> 6, r = idx & 63;
    dst[(size_t)c * ldd + r] = f2bf(tile[r * 65 + c]);
  }
  __syncthreads();
}

DI void phase_convert(const P& p, int l, char* smem) {
  float* tile = (float*)smem;
  char* ws = p.ws;
  const int NJ = 6432;
  for (int j = blockIdx.x; j < NJ; j += gridDim.x) {
    int q = j;
    if (q < 2560) {
      int tr = q / 160, tc = q % 160;
      transpose_tile(p.in[18] + (size_t)l * 1024 * 10240 + (size_t)tr * 64 * 10240 + tc * 64, 10240,
                     (bf16_t*)(ws + WS_WIN) + (size_t)tc * 64 * 1024 + tr * 64, 1024, tile);
      continue;
    }
    q -= 2560;
    if (q < 512) {
      int tr = q / 16, tc = q % 16;
      transpose_tile(p.in[40] + (size_t)l * 2048 * 1024 + (size_t)tr * 64 * 1024 + tc * 64, 1024,
                     (bf16_t*)(ws + WS_WBR) + (size_t)tc * 64 * 2048 + tr * 64, 2048, tile);
      continue;
    }
    q -= 512;
    if (q < 256) {
      int tr = q / 16, tc = q % 16;
      transpose_tile(p.in[41] + (size_t)l * 1024 * 1024 + (size_t)tr * 64 * 1024 + tc * 64, 1024,
                     (bf16_t*)(ws + WS_WOUT) + (size_t)tc * 64 * 1024 + tr * 64, 1024, tile);
      continue;
    }
    q -= 256;
    if (q < 1024) {
      int tr = q / 64, tc = q % 64;
      transpose_tile(p.in[42] + (size_t)l * 1024 * 4096 + (size_t)tr * 64 * 4096 + tc * 64, 4096,
                     (bf16_t*)(ws + WS_W1) + (size_t)tc * 64 * 1024 + tr * 64, 1024, tile);
      continue;
    }
    q -= 1024;
    if (q < 1024) {
      int tr = q / 16, tc = q % 16;
      transpose_tile(p.in[43] + (size_t)l * 4096 * 1024 + (size_t)tr * 64 * 1024 + tc * 64, 1024,
                     (bf16_t*)(ws + WS_W2) + (size_t)tc * 64 * 4096 + tr * 64, 4096, tile);
      continue;
    }
    q -= 1024;
    if (q < 32) {
      int type = q >> 3, n = q & 7;
      const float* src = (type == 0 ? p.in[30] : type == 1 ? p.in[32] : type == 2 ? p.in[35] : p.in[37]) + (size_t)(l * 8 + n) * 4096;
      transpose_tile(src, 64, (bf16_t*)(ws + WS_WLRU) + (size_t)(type * 8 + n) * 4096, 64, tile);
      continue;
    }
    q -= 32;
    if (q < 256) {
      int bh = q >> 3, tr = q & 7, b = bh >> 3, h = bh & 7;
      transpose_tile(p.in[3] + ((size_t)((b * 4 + l) * 8 + h)) * 32768 + (size_t)tr * 64 * 64, 64,
                     (bf16_t*)(ws + WS_CVNA) + (size_t)bh * 32768 + tr * 64, 512, tile);
      continue;
    }
    q -= 256;
    if (q < 256) {
      int bh = q >> 4, t2 = q & 15, tr = t2 >> 1, tc = t2 & 1, b = bh >> 2, h = bh & 3;
      transpose_tile(p.in[5] + ((size_t)((b * 4 + l) * 4 + h)) * 65536 + (size_t)tr * 64 * 128 + tc * 64, 128,
                     (bf16_t*)(ws + WS_CVDF) + (size_t)bh * 65536 + (size_t)tc * 64 * 512 + tr * 64, 512, tile);
      continue;
    }
    q -= 256;
    {
      int tensor = q >> 8, b = (q >> 6) & 3, chunk = q & 63;
      const float* src = (tensor == 0 ? p.in[2] : p.in[4]) + (size_t)(b * 4 + l) * 262144 + (size_t)chunk * 4096;
      bf16_t* dst = (bf16_t*)(ws + (tensor == 0 ? WS_CKNA : WS_CKDF)) + (size_t)b * 262144 + (size_t)chunk * 4096;
#pragma unroll
      for (int i = 0; i < 4; ++i) {
        int e = (otid() + i * 256) * 4;
        float4 v = *(const float4*)(src + e);
        *(bf16x4*)(dst + e) = pack4(v.x, v.y, v.z, v.w);
      }
    }
  }
}

DI void phase_row(const P& p, int l, int mode) {
  const int tid_ = otid(), lane = tid_ & 63, wid = tid_ >> 6;
  const float* MOD = (const float*)(p.ws + WS_MOD);
  float* X = p.out;
  bf16_t* H = (bf16_t*)(p.ws + WS_H);
  const bf16_t* Y = (const bf16_t*)(p.ws + WS_Y);
  const bool from_inputs = (mode == 0 || (mode == 1 && l == 0));
  auto xsrc = [&](int r) -> const float* {
    return from_inputs ? ((r < NCTX) ? (p.in[0] + (size_t)r * D) : (p.in[1] + (size_t)(r - NCTX) * D)) : (X + (size_t)r * D);
  };
  int rb = blockIdx.x;
  if (rb >= 4096) return;
  float4 xn[4];
  bf16x4 yn[4];
  {
    const int r = rb * 4 + wid;
    const float* xs = xsrc(r);
#pragma unroll
    for (int j = 0; j < 4; ++j) xn[j] = *(const float4*)(xs + j * 256 + lane * 4);
    if (mode != 0) {
#pragma unroll
      for (int j = 0; j < 4; ++j) yn[j] = *(const bf16x4*)(Y + (size_t)r * D + j * 256 + lane * 4);
    }
  }
  for (; rb < 4096; rb += gridDim.x) {
    const int r = rb * 4 + wid;
    const int mi = r < NCTX ? 0 : 1 + ((r - NCTX) >> 11);
    float4 xv[4], yv[4];
#pragma unroll
    for (int j = 0; j < 4; ++j) { xv[j] = xn[j]; yv[j] = make_float4(bfs2f(yn[j][0]), bfs2f(yn[j][1]), bfs2f(yn[j][2]), bfs2f(yn[j][3])); }
    {
      const int rbn = (rb + (int)gridDim.x < 4096) ? rb + (int)gridDim.x : rb;
      const int rn = rbn * 4 + wid;
      const float* xs = xsrc(rn);
#pragma unroll
      for (int j = 0; j < 4; ++j) xn[j] = *(const float4*)(xs + j * 256 + lane * 4);
      if (mode != 0) {
#pragma unroll
        for (int j = 0; j < 4; ++j) yn[j] = *(const bf16x4*)(Y + (size_t)rn * D + j * 256 + lane * 4);
      }
    }
    if (mode != 0) {
      float ss = 0.f;
#pragma unroll
      for (int j = 0; j < 4; ++j) ss += yv[j].x * yv[j].x + yv[j].y * yv[j].y + yv[j].z * yv[j].z + yv[j].w * yv[j].w;
      ss = wave_sum(ss);
      const float rs = rsqrtf(ss * (1.f / 1024.f) + 1e-6f);
      const float* gpost = (mode == 1 ? p.in[15] : p.in[17]) + l * D;
      const float* gate = MOD + (size_t)(l * 5 + mi) * 6144 + (mode == 1 ? 2048 : 5120);
#pragma unroll
      for (int j = 0; j < 4; ++j) {
        float4 g = *(const float4*)(gpost + j * 256 + lane * 4);
        float4 gt = *(const float4*)(gate + j * 256 + lane * 4);
        xv[j].x += gt.x * (yv[j].x * rs * g.x);
        xv[j].y += gt.y * (yv[j].y * rs * g.y);
        xv[j].z += gt.z * (yv[j].z * rs * g.z);
        xv[j].w += gt.w * (yv[j].w * rs * g.w);
        *(float4*)(X + (size_t)r * D + j * 256 + lane * 4) = xv[j];
      }
    }
    int ln, off_sh, off_sc;
    const float* gpre;
    if (mode == 0) { ln = 0; gpre = p.in[14]; off_sh = 0; off_sc = 1024; }
    else if (mode == 1) { ln = l; gpre = p.in[16] + l * D; off_sh = 3072; off_sc = 4096; }
    else { ln = l + 1; gpre = p.in[14] + (l + 1) * D; off_sh = 0; off_sc = 1024; }
    if (ln < 4) {
      float ss = 0.f;
#pragma unroll
      for (int j = 0; j < 4; ++j) ss += xv[j].x * xv[j].x + xv[j].y * xv[j].y + xv[j].z * xv[j].z + xv[j].w * xv[j].w;
      ss = wave_sum(ss);
      const float rs = rsqrtf(ss * (1.f / 1024.f) + 1e-6f);
      const float* mrow = MOD + (size_t)(ln * 5 + mi) * 6144;
#pragma unroll
      for (int j = 0; j < 4; ++j) {
        int c = j * 256 + lane * 4;
        float4 g = *(const float4*)(gpre + c);
        float4 sc = *(const float4*)(mrow + off_sc + c);
        float4 sh = *(const float4*)(mrow + off_sh + c);
        *(bf16x4*)(H + (size_t)r * D + c) = pack4(xv[j].x * rs * g.x * (1.f + sc.x) + sh.x, xv[j].y * rs * g.y * (1.f + sc.y) + sh.y,
                                                  xv[j].z * rs * g.z * (1.f + sc.z) + sh.z, xv[j].w * rs * g.w * (1.f + sc.w) + sh.w);
      }
    }
  }
}

constexpr int ATT_BUF = 192 * LDT;
DI void qk_scores(const bf16x8 (&qf)[2], const bf16_t* sK, f32x4 (&S)[4], int fr, int fq) {
  __builtin_amdgcn_s_setprio(1);
#pragma unroll
  for (int s = 0; s < 4; ++s) {
    f32x4 z = {0.f, 0.f, 0.f, 0.f};
#pragma unroll
    for (int ks = 0; ks < 2; ++ks) {
      bf16x8 a = *(const bf16x8*)(sK + (16 * s + fr) * LDT + ks * 32 + fq * 8);
      z = MFMA16(a, qf[ks], z);
    }
    S[s] = z;
  }
  __builtin_amdgcn_s_setprio(0);
}
template <int DV>
DI void pv_step(const bf16x8 (&pb)[2], const bf16_t* sV, f32x4 (&O)[DV / 16], int fr, int fq) {
  __builtin_amdgcn_s_setprio(1);
#pragma unroll
  for (int dt = 0; dt < DV / 16; ++dt) {
#pragma unroll
    for (int s2 = 0; s2 < 2; ++s2) {
      const bf16_t* base = sV + (dt * 16 + fr) * LDT + 32 * s2 + 4 * fq;
      bf16x4 lo = *(const bf16x4*)base;
      bf16x4 hi = *(const bf16x4*)(base + 16);
      bf16x8 a = __builtin_shufflevector(lo, hi, 0, 1, 2, 3, 4, 5, 6, 7);
      O[dt] = MFMA16(a, pb[s2], O[dt]);
    }
  }
  __builtin_amdgcn_s_setprio(0);
}
template <int DV>
DI void softmax_pv(f32x4 (&S)[4], const bf16_t* sV, f32x4 (&O)[DV / 16], float& m, float& lsum, int fr, int fq) {
  float tm = -1e30f;
#pragma unroll
  for (int s = 0; s < 4; ++s)
#pragma unroll
    for (int i = 0; i < 4; ++i) tm = fmaxf(tm, S[s][i]);
  tm = xmax32(xmax16(tm));
  const float mn = fmaxf(m, tm);
  const float alpha = __builtin_amdgcn_exp2f(m - mn);
  const bool grew = mn != m;
  m = mn;
  float ps = 0.f;
#pragma unroll
  for (int s = 0; s < 4; ++s)
#pragma unroll
    for (int i = 0; i < 4; ++i) {
      float pv = __builtin_amdgcn_exp2f(S[s][i] - mn);
      S[s][i] = pv;
      ps += pv;
    }
  lsum = lsum * alpha + ps;
  if (__any(grew)) {
#pragma unroll
    for (int dt = 0; dt < DV / 16; ++dt) {
      O[dt][0] *= alpha; O[dt][1] *= alpha; O[dt][2] *= alpha; O[dt][3] *= alpha;
    }
  }
  bf16x8 pb[2];
  pb[0] = pack8(S[0], S[1]);
  pb[1] = pack8(S[2], S[3]);
  pv_step<DV>(pb, sV, O, fr, fq);
}
template <int DV, bool SOFTMAX, int TPS, class TileFn, class ScoreFn>
DI void attn_loop(int ntiles, TileFn&& tile, ScoreFn&& score, const bf16x8 (&qf)[2], f32x4 (&O)[DV / 16], float& m, float& lsum,
                  bf16_t* smem, int tid) {
  const int lane = tid & 63, fr = lane & 15, fq = lane >> 4;
  constexpr int TILE_EL = (64 + DV) * LDT, STAGE_EL = TPS * TILE_EL;
  u32x4 rkA[TPS][2], rvA[TPS][DV / 32], rkB[TPS][2], rvB[TPS][DV / 32];
  const int sr = tid >> 3, sc = (tid & 7) * 8;
  auto gload = [&](int step, u32x4 (&rk)[TPS][2], u32x4 (&rv)[TPS][DV / 32]) __attribute__((always_inline)) {
#pragma unroll
    for (int u = 0; u < TPS; ++u) {
      const bf16_t* Kg; const bf16_t* Vg; int ldk, ldv;
      tile(step * TPS + u, Kg, ldk, Vg, ldv);
#pragma unroll
      for (int i = 0; i < 2; ++i) rk[u][i] = *(const u32x4*)(Kg + (size_t)(sr + i * 32) * ldk + sc);
#pragma unroll
      for (int i = 0; i < DV / 32; ++i) rv[u][i] = *(const u32x4*)(Vg + (size_t)(sr + i * 32) * ldv + sc);
    }
  };
  auto sstore = [&](int buf, const u32x4 (&rk)[TPS][2], const u32x4 (&rv)[TPS][DV / 32]) __attribute__((always_inline)) {
#pragma unroll
    for (int u = 0; u < TPS; ++u) {
      bf16_t* sK = smem + buf * STAGE_EL + u * TILE_EL;
      bf16_t* sV = sK + 64 * LDT;
#pragma unroll
      for (int i = 0; i < 2; ++i) *(u32x4*)(sK + (sr + i * 32) * LDT + sc) = rk[u][i];
#pragma unroll
      for (int i = 0; i < DV / 32; ++i) *(u32x4*)(sV + (sr + i * 32) * LDT + sc) = rv[u][i];
    }
  };
  auto compute = [&](int buf, int step) __attribute__((always_inline)) {
#pragma unroll
    for (int u = 0; u < TPS; ++u) {
      const bf16_t* sK = smem + buf * STAGE_EL + u * TILE_EL;
      const bf16_t* sV = sK + 64 * LDT;
      f32x4 S[4];
      qk_scores(qf, sK, S, fr, fq);
      score(step * TPS + u, S);
      if (SOFTMAX) {
        softmax_pv<DV>(S, sV, O, m, lsum, fr, fq);
      } else {
        bf16x8 pb[2];
        pb[0] = pack8(S[0], S[1]);
        pb[1] = pack8(S[2], S[3]);
        pv_step<DV>(pb, sV, O, fr, fq);
      }
    }
  };
  const int nsteps = ntiles / TPS, last = nsteps - 1;
  if (TPS > 1) {
    gload(0, rkA, rvA);
    sstore(0, rkA, rvA);
    __syncthreads();
    for (int j = 0; j < nsteps; ++j) {
      gload(j + 1 < last ? j + 1 : last, rkA, rvA);
      asm volatile("" ::: "memory");
      compute(j & 1, j);
      __builtin_amdgcn_sched_barrier(0);
      sstore((j + 1) & 1, rkA, rvA);
      __syncthreads();
    }
    return;
  }
  gload(0, rkA, rvA);
  gload(last < 1 ? last : 1, rkB, rvB);
  sstore(0, rkA, rvA);
  __syncthreads();
  for (int j = 0; j < nsteps; j += 2) {
    gload(j + 2 < last ? j + 2 : last, rkA, rvA);
    asm volatile("" ::: "memory");
    compute(0, j);
    __builtin_amdgcn_sched_barrier(0);
    sstore(1, rkB, rvB);
    __syncthreads();
    if (j + 1 >= nsteps) break;
    gload(j + 3 < last ? j + 3 : last, rkB, rvB);
    asm volatile("" ::: "memory");
    compute(1, j + 1);
    __builtin_amdgcn_sched_barrier(0);
    sstore(0, rkA, rvA);
    __syncthreads();
  }
}
DI void scale_scores(f32x4 (&S)[4]) {
#pragma unroll
  for (int s = 0; s < 4; ++s) { S[s][0] *= 0.18033688f; S[s][1] *= 0.18033688f; S[s][2] *= 0.18033688f; S[s][3] *= 0.18033688f; }
}

DI void softmax_only(f32x4 (&S)[4], f32x4 (&O)[8], float& m, float& lsum, bf16x8 (&pb)[2]) {
  float tm = -1e30f;
#pragma unroll
  for (int s = 0; s < 4; ++s)
#pragma unroll
    for (int i = 0; i < 4; ++i) tm = fmaxf(tm, S[s][i]);
  tm = xmax32(xmax16(tm));
  const float mn = fmaxf(m, tm);
  const float alpha = __builtin_amdgcn_exp2f(m - mn);
  const bool grew = mn != m;
  m = mn;
  float ps = 0.f;
#pragma unroll
  for (int s = 0; s < 4; ++s)
#pragma unroll
    for (int i = 0; i < 4; ++i) {
      float pv = __builtin_amdgcn_exp2f(S[s][i] - mn);
      S[s][i] = pv;
      ps += pv;
    }
  lsum = lsum * alpha + ps;
  if (__any(grew)) {
#pragma unroll
    for (int dt = 0; dt < 8; ++dt) { O[dt][0] *= alpha; O[dt][1] *= alpha; O[dt][2] *= alpha; O[dt][3] *= alpha; }
  }
  pb[0] = pack8(S[0], S[1]);
  pb[1] = pack8(S[2], S[3]);
}
template <class TileFn>
DI void diff_loop(int ntiles, TileFn&& tile, const bf16x8 (&q1)[2], const bf16x8 (&q2)[2], f32x4 (&O1)[8], f32x4 (&O2)[8],
                  float& m1, float& l1, float& m2, float& l2, bf16_t* smem, int tid) {
  const int lane = tid & 63, fr = lane & 15, fq = lane >> 4;
  constexpr int STAGE_EL = 256 * LDT;
  u32x4 rk1[2], rk2[2], rv[4];
  const int sr = tid >> 3, sc = (tid & 7) * 8;
  auto gload = [&](int j) __attribute__((always_inline)) {
    const bf16_t* K1g; const bf16_t* K2g; const bf16_t* Vg; int ldk, ldv;
    tile(j, K1g, K2g, ldk, Vg, ldv);
#pragma unroll
    for (int i = 0; i < 2; ++i) {
      rk1[i] = *(const u32x4*)(K1g + (size_t)(sr + i * 32) * ldk + sc);
      rk2[i] = *(const u32x4*)(K2g + (size_t)(sr + i * 32) * ldk + sc);
    }
#pragma unroll
    for (int i = 0; i < 4; ++i) rv[i] = *(const u32x4*)(Vg + (size_t)(sr + i * 32) * ldv + sc);
  };
  auto sstore = [&](int buf) __attribute__((always_inline)) {
    bf16_t* sb = smem + buf * STAGE_EL;
#pragma unroll
    for (int i = 0; i < 2; ++i) {
      *(u32x4*)(sb + (sr + i * 32) * LDT + sc) = rk1[i];
      *(u32x4*)(sb + (64 + sr + i * 32) * LDT + sc) = rk2[i];
    }
#pragma unroll
    for (int i = 0; i < 4; ++i) *(u32x4*)(sb + (128 + sr + i * 32) * LDT + sc) = rv[i];
  };
  const int last = ntiles - 1;
  gload(0);
  sstore(0);
  __syncthreads();
  for (int j = 0; j < ntiles; ++j) {
    gload(j + 1 < last ? j + 1 : last);
    asm volatile("" ::: "memory");
    {
      const bf16_t* sb = smem + (j & 1) * STAGE_EL;
      const bf16_t* sV = sb + 128 * LDT;
      f32x4 S1[4], S2[4];
      qk_scores(q1, sb, S1, fr, fq);
      qk_scores(q2, sb + 64 * LDT, S2, fr, fq);
      scale_scores(S1);
      scale_scores(S2);
      bf16x8 pb1[2], pb2[2];
      softmax_only(S1, O1, m1, l1, pb1);
      softmax_only(S2, O2, m2, l2, pb2);
      __builtin_amdgcn_s_setprio(1);
#pragma unroll
      for (int dt = 0; dt < 8; ++dt) {
#pragma unroll
        for (int s2 = 0; s2 < 2; ++s2) {
          const bf16_t* base = sV + (dt * 16 + fr) * LDT + 32 * s2 + 4 * fq;
          bf16x4 lo = *(const bf16x4*)base;
          bf16x4 hi = *(const bf16x4*)(base + 16);
          bf16x8 a = __builtin_shufflevector(lo, hi, 0, 1, 2, 3, 4, 5, 6, 7);
          O1[dt] = MFMA16(a, pb1[s2], O1[dt]);
          O2[dt] = MFMA16(a, pb2[s2], O2[dt]);
        }
      }
      __builtin_amdgcn_s_setprio(0);
    }
    __builtin_amdgcn_sched_barrier(0);
    sstore((j + 1) & 1);
    __syncthreads();
  }
}


DI void dense_item(const P& p, int b, int h, int qb, char* smem) {
  const int tid = otid(), lane = tid & 63, wid = tid >> 6, fr = lane & 15, fq = lane >> 4;
  const bf16_t* Z = (const bf16_t*)(p.ws + WS_Z);
  const bf16_t* VT = (const bf16_t*)(p.ws + WS_VTNA) + (size_t)(b * 512 + h * 64) * 256;
  bf16_t* Y4 = (bf16_t*)(p.ws + WS_Y4);
  const int rowbase = b * 256;
  const int qrow = rowbase + qb * 64 + wid * 16 + fr;
  bf16x8 qf[2];
#pragma unroll
  for (int ks = 0; ks < 2; ++ks) qf[ks] = *(const bf16x8*)(Z + (size_t)qrow * ZLD + ZC_NAQ + h * 64 + ks * 32 + fq * 8);
  f32x4 O[4];
#pragma unroll
  for (int dt = 0; dt < 4; ++dt) O[dt] = f32x4{0.f, 0.f, 0.f, 0.f};
  float m = -1e30f, lsum = 0.f;
  const bf16_t* Kb = Z + (size_t)rowbase * ZLD + ZC_NAK + h * 64;
  attn_loop<64, true, 2>(4,
      [&](int j, const bf16_t*& Kg, int& ldk, const bf16_t*& Vg, int& ldv) __attribute__((always_inline)) { Kg = Kb + (size_t)j * 64 * ZLD; ldk = ZLD; Vg = VT + j * 64; ldv = 256; },
      [&](int, f32x4 (&S)[4]) __attribute__((always_inline)) { scale_scores(S); }, qf, O, m, lsum, (bf16_t*)smem, tid);
  const float lt = xsum32(xsum16(lsum));
  const float inv = 1.f / lt;
#pragma unroll
  for (int dt = 0; dt < 4; ++dt)
    *(bf16x4*)(Y4 + (size_t)qrow * 2048 + h * 64 + dt * 16 + fq * 4) = pack4(O[dt][0] * inv, O[dt][1] * inv, O[dt][2] * inv, O[dt][3] * inv);
}

DI void na_item(const P& p, int l, int b, int h, int r, char* smem) {
  float* srpb = (float*)(smem + 73728);
  const int tid = otid(), lane = tid & 63, wid = tid >> 6, fr = lane & 15, fq = lane >> 4;
  const bf16_t* Z = (const bf16_t*)(p.ws + WS_Z);
  const bf16_t* VT = (const bf16_t*)(p.ws + WS_VTNA) + VT_LAT + (size_t)(b * 512 + h * 64) * 2048;
  const bf16_t* CK = (const bf16_t*)(p.ws + WS_CKNA) + (size_t)(b * 8 + h) * 32768;
  const bf16_t* CVT = (const bf16_t*)(p.ws + WS_CVNA) + (size_t)(b * 8 + h) * 32768;
  bf16_t* Y4 = (bf16_t*)(p.ws + WS_Y4);
  for (int i = tid; i < 465; i += 256) srpb[i] = p.in[19][(size_t)(l * 8 + h) * 465 + i];
  const int rowbase = NCTX + b * 2048;
  const int qcol = wid * 16 + fr;
  const int qrow = rowbase + r * 64 + qcol;
  bf16x8 qf[2];
#pragma unroll
  for (int ks = 0; ks < 2; ++ks) qf[ks] = *(const bf16x8*)(Z + (size_t)qrow * ZLD + ZC_NAQ + h * 64 + ks * 32 + fq * 8);
  f32x4 O[4];
#pragma unroll
  for (int dt = 0; dt < 4; ++dt) O[dt] = f32x4{0.f, 0.f, 0.f, 0.f};
  float m = -1e30f, lsum = 0.f;
  int rs = r - 4;
  rs = rs < 0 ? 0 : (rs > 24 ? 24 : rs);
  int cstart = qcol - 8;
  cstart = cstart < 0 ? 0 : (cstart > 48 ? 48 : cstart);
  const bf16_t* Kb = Z + (size_t)rowbase * ZLD + ZC_NAK + h * 64;
  attn_loop<64, true, 2>(16,
      [&](int j, const bf16_t*& Kg, int& ldk, const bf16_t*& Vg, int& ldv) __attribute__((always_inline)) {
        if (j < 8) { Kg = Kb + (size_t)(rs + j) * 64 * ZLD; ldk = ZLD; Vg = VT + (rs + j) * 64; ldv = 2048; }
        else { Kg = CK + (size_t)(j - 8) * 64 * 64; ldk = 64; Vg = CVT + (j - 8) * 64; ldv = 512; }
      },
      [&](int j, f32x4 (&S)[4]) __attribute__((always_inline)) {
        if (j < 8) {
          const int dr = rs + j - r + 7;
#pragma unroll
          for (int s = 0; s < 4; ++s)
#pragma unroll
            for (int i = 0; i < 4; ++i) {
              int kcol = s * 16 + fq * 4 + i;
              bool ok = (kcol >= cstart) && (kcol < cstart + 16);
              int dc = kcol - qcol + 15;
              dc = dc < 0 ? 0 : (dc > 30 ? 30 : dc);
              float bias = srpb[dr * 31 + dc];
              S[s][i] = ok ? (S[s][i] * 0.18033688f + bias * 1.44269504f) : -1e30f;
            }
        } else {
          scale_scores(S);
        }
      },
      qf, O, m, lsum, (bf16_t*)smem, tid);
  const float lt = xsum32(xsum16(lsum));
  const float inv = 1.f / lt;
#pragma unroll
  for (int dt = 0; dt < 4; ++dt)
    *(bf16x4*)(Y4 + (size_t)qrow * 2048 + h * 64 + dt * 16 + fq * 4) = pack4(O[dt][0] * inv, O[dt][1] * inv, O[dt][2] * inv, O[dt][3] * inv);
}

DI void diff_item(const P& p, int l, bool latent, int b, int h, int qb, char* smem) {
  const int tid = otid(), lane = tid & 63, wid = tid >> 6, fr = lane & 15, fq = lane >> 4;
  const bf16_t* Z = (const bf16_t*)(p.ws + WS_Z);
  const int T = latent ? 2048 : 256;
  const int rowbase = latent ? NCTX + b * 2048 : b * 256;
  const bf16_t* VT = (const bf16_t*)(p.ws + WS_VTDF) + (latent ? (size_t)VT_LAT + (size_t)(b * 512 + h * 128) * 2048 : (size_t)(b * 512 + h * 128) * 256);
  const bf16_t* CVT = (const bf16_t*)(p.ws + WS_CVDF) + (size_t)(b * 4 + h) * 65536;
  bf16_t* Y4 = (bf16_t*)(p.ws + WS_Y4);
  const int qrow = rowbase + qb * 64 + wid * 16 + fr;
  float d1 = p.in[20][l * 64 + lane] * p.in[21][l * 64 + lane];
  float d2 = p.in[22][l * 64 + lane] * p.in[23][l * 64 + lane];
  d1 = wave_sum(d1);
  d2 = wave_sum(d2);
  const float lam_init = 0.8f - 0.6f * expf(-0.3f * (float)l);
  const float lam = expf(d1) - expf(d2) + lam_init;
  const int nown = T >> 6;
  const int ntiles = nown + (latent ? 8 : 0);

  f32x4 O1[8];
  f32x4 O[8];
  {
    bf16x8 q1[2], q2[2];
#pragma unroll
    for (int ks = 0; ks < 2; ++ks) {
      q1[ks] = *(const bf16x8*)(Z + (size_t)qrow * ZLD + ZC_DFQ + h * 64 + ks * 32 + fq * 8);
      q2[ks] = *(const bf16x8*)(Z + (size_t)qrow * ZLD + ZC_DFQ + 256 + h * 64 + ks * 32 + fq * 8);
    }
#pragma unroll
    for (int dt = 0; dt < 8; ++dt) { O1[dt] = f32x4{0.f, 0.f, 0.f, 0.f}; O[dt] = f32x4{0.f, 0.f, 0.f, 0.f}; }
    float m1 = -1e30f, l1 = 0.f, m2 = -1e30f, l2 = 0.f;
    const bf16_t* Kb = Z + (size_t)rowbase * ZLD + ZC_DFK + h * 64;
    const bf16_t* CK = (const bf16_t*)(p.ws + WS_CKDF) + (size_t)((b * 2) * 4 + h) * 32768;
    diff_loop(ntiles,
        [&](int j, const bf16_t*& K1g, const bf16_t*& K2g, int& ldk, const bf16_t*& Vg, int& ldv) __attribute__((always_inline)) {
          if (j < nown) { K1g = Kb + (size_t)j * 64 * ZLD; K2g = K1g + 256; ldk = ZLD; Vg = VT + j * 64; ldv = T; }
          else { K1g = CK + (size_t)(j - nown) * 64 * 64; K2g = K1g + 4 * 32768; ldk = 64; Vg = CVT + (j - nown) * 64; ldv = 512; }
        },
        q1, q2, O1, O, m1, l1, m2, l2, (bf16_t*)smem, tid);
    const float inv1 = 1.f / xsum32(xsum16(l1));
    const float inv2 = lam / xsum32(xsum16(l2));
#pragma unroll
    for (int dt = 0; dt < 8; ++dt) {
      O[dt][0] = O1[dt][0] * inv1 - O[dt][0] * inv2;
      O[dt][1] = O1[dt][1] * inv1 - O[dt][1] * inv2;
      O[dt][2] = O1[dt][2] * inv1 - O[dt][2] * inv2;
      O[dt][3] = O1[dt][3] * inv1 - O[dt][3] * inv2;
    }
  }
  float ss = 0.f;
#pragma unroll
  for (int dt = 0; dt < 8; ++dt) ss += O[dt][0] * O[dt][0] + O[dt][1] * O[dt][1] + O[dt][2] * O[dt][2] + O[dt][3] * O[dt][3];
  ss = xsum32(xsum16(ss));
  const float rsn = rsqrtf(ss * (1.f / 128.f) + 1e-6f) * (1.f - lam_init);
  const float* gn = p.in[24] + l * 128;
#pragma unroll
  for (int dt = 0; dt < 8; ++dt) {
    int dv = dt * 16 + fq * 4;
    float4 g = *(const float4*)(gn + dv);
    *(bf16x4*)(Y4 + (size_t)qrow * 2048 + 512 + h * 128 + dv) = pack4(O[dt][0] * rsn * g.x, O[dt][1] * rsn * g.y, O[dt][2] * rsn * g.z, O[dt][3] * rsn * g.w);
  }
}

DI void ret_item(const P& p, int l, bool latent, int b, int h, int qb, char* smem) {
  bf16_t* sV0 = (bf16_t*)smem + 64 * LDT;
  const int tid = otid(), lane = tid & 63, wid = tid >> 6, fr = lane & 15, fq = lane >> 4;
  const bf16_t* Z = (const bf16_t*)(p.ws + WS_Z);
  const int T = latent ? 2048 : 256;
  const int rowbase = latent ? NCTX + b * 2048 : b * 256;
  const bf16_t* VT = (const bf16_t*)(p.ws + WS_VTRT) + (latent ? (size_t)VT_LAT + (size_t)(b * 512 + h * 64) * 2048 : (size_t)(b * 512 + h * 64) * 256);
  bf16_t* Y4 = (bf16_t*)(p.ws + WS_Y4);
  const int tq = qb * 64 + wid * 16 + fr;
  const int qrow = rowbase + tq;
  const float lgf = log1pf(-expf(p.in[25][l * 8 + h]));
  const float lgb = log1pf(-expf(p.in[26][l * 8 + h]));
  bf16x8 qf[2];
#pragma unroll
  for (int ks = 0; ks < 2; ++ks) qf[ks] = *(const bf16x8*)(Z + (size_t)qrow * ZLD + ZC_RTQ + h * 64 + ks * 32 + fq * 8);
  f32x4 O[4];
#pragma unroll
  for (int dt = 0; dt < 4; ++dt) O[dt] = f32x4{0.f, 0.f, 0.f, 0.f};
  float mdummy = 0.f, ldummy = 0.f;
  const int dq = wid * 16 + fr;
  float AF[4], BF[4], AB[4], BB[4];
#pragma unroll
  for (int u = 0; u < 4; ++u) {
    AF[u] = __expf(-lgf * (float)(u * 16));
    AB[u] = __expf(lgb * (float)(u * 16));
    BF[u] = __expf(-lgf * (float)(fq * 4 + u));
    BB[u] = __expf(lgb * (float)(fq * 4 + u));
  }
  const bf16_t* Kb = Z + (size_t)rowbase * ZLD + ZC_RTK + h * 64;
  attn_loop<64, false, 2>(T >> 6,
      [&](int j, const bf16_t*& Kg, int& ldk, const bf16_t*& Vg, int& ldv) __attribute__((always_inline)) { Kg = Kb + (size_t)j * 64 * ZLD; ldk = ZLD; Vg = VT + j * 64; ldv = T; },
      [&](int j, f32x4 (&S)[4]) __attribute__((always_inline)) {
        if (j == qb) {
#pragma unroll
          for (int s = 0; s < 4; ++s)
#pragma unroll
            for (int i = 0; i < 4; ++i) {
              int tk = j * 64 + s * 16 + fq * 4 + i;
              int dd = tq - tk;
              float w = dd >= 0 ? __expf(lgf * (float)dd) : __expf(lgb * (float)(-dd));
              S[s][i] *= w;
            }
        } else if (j < qb) {
          const float qfac = __expf(lgf * (float)((qb - j) * 64 + dq));
#pragma unroll
          for (int s = 0; s < 4; ++s) {
            const float f = qfac * AF[s];
            S[s][0] *= f * BF[0]; S[s][1] *= f * BF[1]; S[s][2] *= f * BF[2]; S[s][3] *= f * BF[3];
          }
        } else {
          const float qfac = __expf(lgb * (float)((j - qb) * 64 - dq));
#pragma unroll
          for (int s = 0; s < 4; ++s) {
            const float f = qfac * AB[s];
            S[s][0] *= f * BB[0]; S[s][1] *= f * BB[1]; S[s][2] *= f * BB[2]; S[s][3] *= f * BB[3];
          }
        }
      },
      qf, O, mdummy, ldummy, (bf16_t*)smem, tid);
  if (latent) {
    for (int dir = 0; dir < 2; ++dir) {
      const float* S0 = (dir == 0 ? p.in[6] : p.in[7]) + ((size_t)((b * 4 + l) * 8 + h)) * 4096;
#pragma unroll
      for (int i = 0; i < 4; ++i) {
        int e = (tid + i * 256) * 4;
        float4 v = *(const float4*)(S0 + e);
        int dk = e >> 6, dv = e & 63;
        sV0[(dv + 0) * LDT + dk] = f2bf(v.x);
        sV0[(dv + 1) * LDT + dk] = f2bf(v.y);
        sV0[(dv + 2) * LDT + dk] = f2bf(v.z);
        sV0[(dv + 3) * LDT + dk] = f2bf(v.w);
      }
      __syncthreads();
      const float sc = dir == 0 ? __expf(lgf * (float)(tq + 1)) : __expf(lgb * (float)(T - tq));
      bf16x8 pb[2];
#pragma unroll
      for (int s2 = 0; s2 < 2; ++s2) {
        const bf16_t* qp = Z + (size_t)qrow * ZLD + ZC_RTQ + h * 64 + 32 * s2 + 4 * fq;
        bf16x4 lo = *(const bf16x4*)qp;
        bf16x4 hi = *(const bf16x4*)(qp + 16);
        f32x4 flo = {bfs2f(lo[0]) * sc, bfs2f(lo[1]) * sc, bfs2f(lo[2]) * sc, bfs2f(lo[3]) * sc};
        f32x4 fhi = {bfs2f(hi[0]) * sc, bfs2f(hi[1]) * sc, bfs2f(hi[2]) * sc, bfs2f(hi[3]) * sc};
        pb[s2] = pack8(flo, fhi);
      }
      pv_step<64>(pb, sV0, O, fr, fq);
      __syncthreads();
    }
  }
  float ss = 0.f;
#pragma unroll
  for (int dt = 0; dt < 4; ++dt) ss += O[dt][0] * O[dt][0] + O[dt][1] * O[dt][1] + O[dt][2] * O[dt][2] + O[dt][3] * O[dt][3];
  ss = xsum32(xsum16(ss));
  const float rsn = rsqrtf(ss * (1.f / 64.f) + 1e-6f);
  const float* gn = p.in[27] + l * 512 + h * 64;
#pragma unroll
  for (int dt = 0; dt < 4; ++dt) {
    int dv = dt * 16 + fq * 4;
    float4 g = *(const float4*)(gn + dv);
    bf16x4 sg = *(const bf16x4*)(Z + (size_t)qrow * ZLD + ZC_RTG + h * 64 + dv);
    *(bf16x4*)(Y4 + (size_t)qrow * 2048 + 1024 + h * 64 + dv) =
        pack4(O[dt][0] * rsn * g.x * bfs2f(sg[0]), O[dt][1] * rsn * g.y * bfs2f(sg[1]), O[dt][2] * rsn * g.z * bfs2f(sg[2]), O[dt][3] * rsn * g.w * bfs2f(sg[3]));
  }
}

DI void ret_state_item(const P& p, int l, int b, int h) {
  const int tid_ = otid(), lane = tid_ & 63, wid = tid_ >> 6, fr = lane & 15, fq = lane >> 4;
  const bf16_t* KT = (const bf16_t*)(p.ws + WS_KTRT) + (size_t)(b * 512 + h * 64) * 256;
  const bf16_t* VT = (const bf16_t*)(p.ws + WS_VTRT) + (size_t)(b * 512 + h * 64) * 256;
  const float lgf = log1pf(-expf(p.in[25][l * 8 + h]));
  const float lgb = log1pf(-expf(p.in[26][l * 8 + h]));
  f32x4 af[4], ab[4];
#pragma unroll
  for (int nt = 0; nt < 4; ++nt) { af[nt] = f32x4{0.f, 0.f, 0.f, 0.f}; ab[nt] = f32x4{0.f, 0.f, 0.f, 0.f}; }
  for (int ks = 0; ks < 8; ++ks) {
    const int t0 = ks * 32 + fq * 8;
    bf16x8 kraw = *(const bf16x8*)(KT + (size_t)(wid * 16 + fr) * 256 + t0);
    bf16x8 kf, kb;
#pragma unroll
    for (int j = 0; j < 8; ++j) {
      float kv = bfs2f(kraw[j]);
      int t = t0 + j;
      kf[j] = (short)f2bf(kv * __expf(lgf * (float)(255 - t)));
      kb[j] = (short)f2bf(kv * __expf(lgb * (float)t));
    }
#pragma unroll
    for (int nt = 0; nt < 4; ++nt) {
      bf16x8 vb = *(const bf16x8*)(VT + (size_t)(nt * 16 + fr) * 256 + t0);
      af[nt] = MFMA16(kf, vb, af[nt]);
      ab[nt] = MFMA16(kb, vb, ab[nt]);
    }
  }
  float* of = p.out + O_RF + ((size_t)((b * 4 + l) * 8 + h)) * 4096;
  float* ob = p.out + O_RB + ((size_t)((b * 4 + l) * 8 + h)) * 4096;
#pragma unroll
  for (int nt = 0; nt < 4; ++nt)
#pragma unroll
    for (int i = 0; i < 4; ++i) {
      int dk = wid * 16 + fq * 4 + i, dv = nt * 16 + fr;
      of[dk * 64 + dv] = af[nt][i];
      ob[dk * 64 + dv] = ab[nt][i];
    }
}

DI void lru_gates_item(const P& p, int l, int chunk, int n, char* smem) {
  float* XDf = (float*)smem;
  bf16_t* XDb = (bf16_t*)(XDf + 4096);
  const int tid = otid(), lane = tid & 63, wid = tid >> 6, fr = lane & 15, fq = lane >> 4;
  const int row0 = chunk * 64;
  const bool latent = row0 >= NCTX;
  const int T = latent ? 2048 : 256;
  const int tseq0 = latent ? ((row0 - NCTX) & 2047) : (row0 & 255);
  const bf16_t* Z = (const bf16_t*)(p.ws + WS_Z);
  const bf16_t* WL = (const bf16_t*)(p.ws + WS_WLRU);
  bf16_t* LA = (bf16_t*)(p.ws + WS_LA);
  bf16_t* LU = (bf16_t*)(p.ws + WS_LU);
  const int ch0 = n * 64;
  {
    const float cw0 = p.in[28][(l * 4 + 0) * 512 + ch0 + lane];
    const float cw1 = p.in[28][(l * 4 + 1) * 512 + ch0 + lane];
    const float cw2 = p.in[28][(l * 4 + 2) * 512 + ch0 + lane];
    const float cw3 = p.in[28][(l * 4 + 3) * 512 + ch0 + lane];
    const float cb = p.in[29][l * 512 + ch0 + lane];
    const bf16_t* xcol = Z + (size_t)row0 * ZLD + ZC_LRX + ch0 + lane;
    const int t0 = wid * 16;
    auto ld = [&](int tl) -> float {
      int ts = tseq0 + tl;
      return (ts < 0 || ts >= T) ? 0.f : bf2f(xcol[(ptrdiff_t)tl * ZLD]);
    };
    float xm1 = ld(t0 - 1), x0 = ld(t0), x1 = ld(t0 + 1);
#pragma unroll
    for (int i = 0; i < 16; ++i) {
      float x2 = ld(t0 + i + 2);
      float xd = cw0 * xm1 + cw1 * x0 + cw2 * x1 + cw3 * x2 + cb;
      XDf[(t0 + i) * 64 + lane] = xd;
      XDb[(t0 + i) * LDT + lane] = f2bf(xd);
      xm1 = x0; x0 = x1; x1 = x2;
    }
  }
  __syncthreads();
  bf16x8 af[2];
#pragma unroll
  for (int ks = 0; ks < 2; ++ks) af[ks] = *(const bf16x8*)(XDb + (wid * 16 + fr) * LDT + ks * 32 + fq * 8);
#pragma unroll 1
  for (int dir = 0; dir < 2; ++dir) {
    const float* bav = (dir == 0 ? p.in[31] : p.in[36]) + l * 512 + ch0;
    const float* bxv = (dir == 0 ? p.in[33] : p.in[38]) + l * 512 + ch0;
    const float* lamv = (dir == 0 ? p.in[34] : p.in[39]) + l * 512 + ch0;
#pragma unroll
    for (int et = 0; et < 4; ++et) {
      f32x4 da = {0.f, 0.f, 0.f, 0.f}, dx = {0.f, 0.f, 0.f, 0.f};
#pragma unroll
      for (int ks = 0; ks < 2; ++ks) {
        bf16x8 wa = *(const bf16x8*)(WL + (size_t)((dir * 2 + 0) * 8 + n) * 4096 + (et * 16 + fr) * 64 + ks * 32 + fq * 8);
        bf16x8 wx = *(const bf16x8*)(WL + (size_t)((dir * 2 + 1) * 8 + n) * 4096 + (et * 16 + fr) * 64 + ks * 32 + fq * 8);
        da = MFMA16(af[ks], wa, da);
        dx = MFMA16(af[ks], wx, dx);
      }
      const int e = et * 16 + fr;
      const float ba_ = bav[e], bx_ = bxv[e];
      const float sp = log1pf(expf(-lamv[e]));
      float lav[4], uv[4];
#pragma unroll
      for (int i = 0; i < 4; ++i) {
        int tl = wid * 16 + fq * 4 + i;
        float rg = sigmoidf_(da[i] + ba_);
        float ig = sigmoidf_(dx[i] + bx_);
        float la = -8.f * rg * sp;
        lav[i] = la;
        uv[i] = sqrtf(1.f - __expf(2.f * la)) * (ig * XDf[tl * 64 + e]);
      }
      const size_t idx = (size_t)dir * 8388608 + ((size_t)chunk * 512 + ch0 + e) * 64 + wid * 16 + fq * 4;
      *(bf16x4*)(LA + idx) = pack4(lav[0], lav[1], lav[2], lav[3]);
      *(bf16x4*)(LU + idx) = pack4(uv[0], uv[1], uv[2], uv[3]);
    }
  }
  __syncthreads();
}

DI void lru_scan_witem(const P& p, int l, int bglob, int g, int lane) {
  const bool latent = bglob >= 32;
  const int T = latent ? 2048 : 256;
  const int rowbase = latent ? NCTX + (bglob - 32) * 2048 : bglob * 256;
  const int chunk0 = rowbase >> 6, nch = T >> 6;
  const int ch = g * 64 + lane;
  const bf16_t* LA = (const bf16_t*)(p.ws + WS_LA);
  const bf16_t* LU = (const bf16_t*)(p.ws + WS_LU);
  bf16_t* HF = (bf16_t*)(p.ws + WS_HF);
  const bf16_t* LG = (const bf16_t*)(p.ws + WS_LG);
  bf16_t* Y4 = (bf16_t*)(p.ws + WS_Y4);
  {
    float h = latent ? p.in[8][((bglob - 32) * 4 + l) * 512 + ch] : 0.f;
    bf16x8 ca[8], cu[8], na[8], nu[8];
    {
      const size_t b0 = ((size_t)chunk0 * 512 + ch) * 64;
#pragma unroll
      for (int q = 0; q < 8; ++q) { ca[q] = *(const bf16x8*)(LA + b0 + q * 8); cu[q] = *(const bf16x8*)(LU + b0 + q * 8); }
    }
    for (int cc = 0; cc < nch; ++cc) {
      const size_t cbase = ((size_t)(chunk0 + cc) * 512 + ch) * 64;
      const int cn = (cc + 1 < nch) ? cc + 1 : cc;
      const size_t nb = ((size_t)(chunk0 + cn) * 512 + ch) * 64;
#pragma unroll
      for (int q = 0; q < 8; ++q) { na[q] = *(const bf16x8*)(LA + nb + q * 8); nu[q] = *(const bf16x8*)(LU + nb + q * 8); }
#pragma unroll
      for (int q = 0; q < 8; ++q) {
        bf16x8 ho;
#pragma unroll
        for (int j = 0; j < 8; ++j) {
          float a = __expf(bfs2f(ca[q][j]));
          h = a * h + bfs2f(cu[q][j]);
          ho[j] = (short)f2bf(h);
        }
        *(bf16x8*)(HF + cbase + q * 8) = ho;
      }
#pragma unroll
      for (int q = 0; q < 8; ++q) { ca[q] = na[q]; cu[q] = nu[q]; }
    }
    if (!latent) p.out[O_LF + (size_t)(bglob * 4 + l) * 512 + ch] = h;
  }
  {
    float h = latent ? p.in[9][((bglob - 32) * 4 + l) * 512 + ch] : 0.f;
    const bf16_t* LAb = LA + 8388608;
    const bf16_t* LUb = LU + 8388608;
    bf16x8 ca[4], cu[4], chf[4], cg_[4], na[4], nu[4], nhf[4], ng[4];
    const int nb_ = 2 * nch;
    {
      const size_t b0 = ((size_t)(chunk0 + nch - 1) * 512 + ch) * 64 + 32;
#pragma unroll
      for (int q = 0; q < 4; ++q) {
        ca[q] = *(const bf16x8*)(LAb + b0 + q * 8); cu[q] = *(const bf16x8*)(LUb + b0 + q * 8);
        chf[q] = *(const bf16x8*)(HF + b0 + q * 8); cg_[q] = *(const bf16x8*)(LG + b0 + q * 8);
      }
    }
    for (int bi = 0; bi < nb_; ++bi) {
      const int chunk = nch - 1 - (bi >> 1), half = 1 - (bi & 1);
      const int bn = (bi + 1 < nb_) ? bi + 1 : bi;
      const int chunkn = nch - 1 - (bn >> 1), halfn = 1 - (bn & 1);
      const size_t nb = ((size_t)(chunk0 + chunkn) * 512 + ch) * 64 + halfn * 32;
#pragma unroll
      for (int q = 0; q < 4; ++q) {
        na[q] = *(const bf16x8*)(LAb + nb + q * 8); nu[q] = *(const bf16x8*)(LUb + nb + q * 8);
        nhf[q] = *(const bf16x8*)(HF + nb + q * 8); ng[q] = *(const bf16x8*)(LG + nb + q * 8);
      }
      bf16_t* yrow = Y4 + (size_t)(rowbase + chunk * 64 + half * 32) * 2048 + 1536 + ch;
#pragma unroll
      for (int q = 3; q >= 0; --q) {
#pragma unroll
        for (int j = 7; j >= 0; --j) {
          float a = __expf(bfs2f(ca[q][j]));
          h = a * h + bfs2f(cu[q][j]);
          float y = (bfs2f(chf[q][j]) + h) * bfs2f(cg_[q][j]);
          yrow[(size_t)(q * 8 + j) * 2048] = f2bf(y);
        }
      }
#pragma unroll
      for (int q = 0; q < 4; ++q) { ca[q] = na[q]; cu[q] = nu[q]; chf[q] = nhf[q]; cg_[q] = ng[q]; }
    }
    if (!latent) p.out[O_LB + (size_t)(bglob * 4 + l) * 512 + ch] = h;
  }
}

DI int next_item(unsigned* ctr, int* s_item) {
  __syncthreads();
  if (threadIdx.x == 0) *s_item = (int)atomicAdd(ctr, 1u);
  __syncthreads();
  return *s_item;
}
DI void phase_mixa(const P& p, int l, char* smem, int* s_item) {
  unsigned* ctr = (unsigned*)(p.ws + WS_BAR + 14336) + l * 2;
  const int NGRAB = 512 + 512;
  for (;;) {
    int q = next_item(ctr, s_item);
    if (q >= NGRAB) break;
    if (q < 512) { diff_item(p, l, true, q >> 7, (q >> 5) & 3, q & 31, smem); continue; }
    q -= 512;
#pragma unroll 1
    for (int u = 0; u < 4; ++u) { const int g = q * 4 + u; lru_gates_item(p, l, g >> 3, g & 7, smem); }
  }
}
DI void phase_mixb(const P& p, int l, char* smem, int* s_item) {
  unsigned* ctr = (unsigned*)(p.ws + WS_BAR + 14336) + l * 2 + 1;
  const int NGRAB = 72 + 1024 + 1024 + 256 + 256 + 256 + 32;
  for (;;) {
    int q = next_item(ctr, s_item);
    if (q >= NGRAB) break;
    if (q < 72) {
      const int tid = otid(), lane = tid & 63, wid = tid >> 6;
      int bglob, g;
      if (q < 32) {
        if (wid == 0) { bglob = 32 + (q >> 3); g = q & 7; }
        else { int ci = q * 3 + wid - 1; bglob = ci >> 3; g = ci & 7; }
      } else {
        int ci = 96 + (q - 32) * 4 + wid;
        bglob = ci >> 3; g = ci & 7;
      }
      lru_scan_witem(p, l, bglob, g, lane);
      continue;
    }
    q -= 72;
    if (q < 1024) { ret_item(p, l, true, q >> 8, (q >> 5) & 7, q & 31, smem); continue; }
    q -= 1024;
    if (q < 1024) { na_item(p, l, q >> 8, (q >> 5) & 7, q & 31, smem); continue; }
    q -= 1024;
    if (q < 256) {
#pragma unroll 1
      for (int u = 0; u < 2; ++u) { const int g = q * 2 + u; diff_item(p, l, false, g >> 4, (g >> 2) & 3, g & 3, smem); }
      continue;
    }
    q -= 256;
    if (q < 256) {
#pragma unroll 1
      for (int u = 0; u < 4; ++u) { const int g = q * 4 + u; dense_item(p, g >> 5, (g >> 2) & 7, g & 3, smem); }
      continue;
    }
    q -= 256;
    if (q < 256) {
#pragma unroll 1
      for (int u = 0; u < 4; ++u) { const int g = q * 4 + u; ret_item(p, l, false, g >> 5, (g >> 2) & 7, g & 3, smem); }
      continue;
    }
    q -= 256;
#pragma unroll 1
    for (int u = 0; u < 8; ++u) { const int g = q * 8 + u; ret_state_item(p, l, g >> 3, g & 7); }
  }
}

#define XB_TMO 128
#define XB_XCNT(j) (256 + 64 * (j))
#define XB_XSUB(j) (1280 + 64 * (j))
#define XB_XGEN(j) (2304 + 64 * (j))
#define XB_TOP 3328
#define XB_TOPGEN 3392
#define XCD_BAR_WORDS 3456
#define XB_SPIN_CAP (1u << 18)
#define LAS __attribute__((address_space(3)))
DI unsigned xb_ld(unsigned* p) { return __hip_atomic_load(p, __ATOMIC_RELAXED, __HIP_MEMORY_SCOPE_AGENT); }
DI unsigned xb_add(unsigned* p, unsigned v) { return __hip_atomic_fetch_add(p, v, __ATOMIC_RELAXED, __HIP_MEMORY_SCOPE_AGENT); }
DI unsigned xb_xcc_id() { return (unsigned)__builtin_amdgcn_s_getreg((3 << 11) | 20) & 0xFu; }
#define XB_SPIN(cond, bar) do { unsigned _sp = 0; while (cond) { __builtin_amdgcn_s_sleep(1); \
    if ((++_sp & 255u) == 0u) { if (xb_ld(&(bar)[XB_TMO])) break; if (_sp > XB_SPIN_CAP) { atomicAdd(&(bar)[XB_TMO], 1u); break; } } } } while (0)
struct XcdBarrier { unsigned* bar; unsigned x; volatile LAS unsigned* st; };
DI XcdBarrier xcd_barrier_post(unsigned* bar, volatile LAS unsigned* st) {
  XcdBarrier b; b.bar = bar; b.x = xb_xcc_id(); b.st = st;
  if (threadIdx.x == 0) (void)xb_add(&bar[XB_XCNT(b.x)], 1u);
  return b;
}
DI void xcd_barrier_complete(unsigned* bar, unsigned x, unsigned& nloc, unsigned& nx) {
  const unsigned G = gridDim.x * gridDim.y * gridDim.z;
  unsigned sum, cnt, mine, sp = 0u;
  for (;;) {
    sum = 0u; cnt = 0u; mine = 0u;
#pragma unroll
    for (unsigned j = 0; j < 16; ++j) { const unsigned c = xb_ld(&bar[XB_XCNT(j)]); sum += c; cnt += (c > 0u) ? 1u : 0u; mine = (j == x) ? c : mine; }
    if (sum == G) break;
    __builtin_amdgcn_s_sleep(1);
    if ((++sp & 255u) == 0u) { if (xb_ld(&bar[XB_TMO])) break; if (sp > XB_SPIN_CAP) { atomicAdd(&bar[XB_TMO], 1u); break; } }
  }
  nloc = mine > 0u ? mine : 1u; nx = cnt > 0u ? cnt : 1u;
}
DI void xcd_barrier(const XcdBarrier& b) {
  asm volatile("s_waitcnt vmcnt(0)" ::: "memory");
  __syncthreads();
  if (threadIdx.x == 0) {
    unsigned* bar = b.bar;
    __builtin_amdgcn_s_waitcnt(0);
    unsigned nloc = b.st[0], nx = b.st[1];
    if (nloc == 0u) { xcd_barrier_complete(bar, b.x, nloc, nx); b.st[0] = nloc; b.st[1] = nx; }
    const unsigned old = xb_add(&bar[XB_XSUB(b.x)], 1u);
    const unsigned gen = old / nloc;
    if (old + 1u == (gen + 1u) * nloc) {
      __builtin_amdgcn_fence(__ATOMIC_RELEASE, "agent");
      asm volatile("s_waitcnt vmcnt(0)" ::: "memory");
      const unsigned og = xb_add(&bar[XB_TOP], 1u);
      const unsigned tg = og / nx;
      if (og + 1u == (tg + 1u) * nx) xb_add(&bar[XB_TOPGEN], 1u);
      else XB_SPIN(xb_ld(&bar[XB_TOPGEN]) == tg, bar);
      __builtin_amdgcn_fence(__ATOMIC_ACQUIRE, "agent");
      xb_add(&bar[XB_XGEN(b.x)], 1u);
      asm volatile("s_waitcnt vmcnt(0)" ::: "memory");
    } else {
      XB_SPIN(xb_ld(&bar[XB_XGEN(b.x)]) == gen, bar);
      __builtin_amdgcn_fence(__ATOMIC_ACQUIRE, "agent");
      asm volatile("s_waitcnt vmcnt(0)" ::: "memory");
    }
  }
  __syncthreads();
}

enum { PH_INIT = 0, PH_PRE0, PH_GIN, PH_MIXA, PH_MIXB, PH_MERGE, PH_OUT, PH_POSTMIX, PH_FF1, PH_FF2, PH_POSTFFN };

DI void run_phase(const P& p, int ph, int l, char* smem, int* s_item) {
  switch (ph) {
    case PH_INIT:
      phase_mod(p, smem);
      phase_convert(p, 0, smem);
      break;
    case PH_PRE0: phase_row(p, 0, 0); break;
    case PH_GIN: phase_gin(p, l, smem); break;
    case PH_MIXA: phase_mixa(p, l, smem, s_item); break;
    case PH_MIXB: phase_mixb(p, l, smem, s_item); break;
    case PH_MERGE: phase_merge(p, smem); break;
    case PH_OUT:
      phase_gemm_plain<0>((const bf16_t*)(p.ws + WS_H), 1024, (const bf16_t*)(p.ws + WS_WOUT), 1024, (bf16_t*)(p.ws + WS_Y), smem);
      break;
    case PH_POSTMIX: phase_row(p, l, 1); break;
    case PH_FF1:
      phase_gemm_plain<1>((const bf16_t*)(p.ws + WS_H), 1024, (const bf16_t*)(p.ws + WS_W1), 4096, (bf16_t*)(p.ws + WS_U), smem);
      break;
    case PH_FF2:
      phase_gemm_plain<0>((const bf16_t*)(p.ws + WS_U), 4096, (const bf16_t*)(p.ws + WS_W2), 1024, (bf16_t*)(p.ws + WS_Y), smem);
      break;
    case PH_POSTFFN:
      phase_row(p, l, 2);
      if (l < 3) phase_convert(p, l + 1, smem);
      break;
    default: break;
  }
}

DI void decode_step(int step, int& ph, int& l) {
  if (step < 2) { ph = step; l = 0; }
  else { int s = step - 2; l = s / 9; ph = PH_GIN + (s % 9); }
}
constexpr int NSTEPS = 38;

__global__ void __launch_bounds__(256, 2) hybrid_flow_mega(P p) {
  __shared__ __attribute__((aligned(16))) char smem[SMEM_BYTES];
  __shared__ uint4 xb_words;
  __shared__ int s_item;
  cg::grid_group grid = cg::this_grid();
  if (threadIdx.x == 0) xb_words = make_uint4(0u, 0u, 0u, 0u);
  __syncthreads();
  XcdBarrier xb = xcd_barrier_post((unsigned*)(p.ws + WS_BAR), (volatile LAS unsigned*)&xb_words);
  for (int step = 0; step < NSTEPS; ++step) {
    int ph, l;
    decode_step(step, ph, l);
#ifdef PROBE_DUP
    const int reps = (ph == PROBE_DUP) ? 2 : 1;
    for (int rep = 0; rep < reps; ++rep)
#endif
    run_phase(p, ph, l, smem, &s_item);
#ifdef PROBE_CONV
    if (ph == PH_POSTFFN && l < 3) phase_convert(p, l + 1, smem);
#endif
    if (p.ws == nullptr) grid.sync();
    if (step + 1 < NSTEPS) xcd_barrier(xb);
#ifdef PROBE_SYNC
    if (step + 1 < NSTEPS) xcd_barrier(xb);
#endif
  }
}

#if !ONE_LAUNCH
__global__ void __launch_bounds__(256, 2) hybrid_flow_phase(P p, int ph, int l) {
  __shared__ __attribute__((aligned(16))) char smem[SMEM_BYTES];
  __shared__ int s_item;
  run_phase(p, ph, l, smem, &s_item);
}
#endif

extern "C" void kernel_launch(void* const* d_in, const int* in_sizes, int n_in, void* d_out, int out_size, void* d_ws,
                              size_t ws_size, hipStream_t stream) {
  (void)in_sizes; (void)n_in; (void)out_size; (void)ws_size;
  P p{};
  for (int i = 0; i < 44; ++i) p.in[i] = (const float*)d_in[i];
  p.out = (float*)d_out;
  p.ws = (char*)d_ws;
#if ONE_LAUNCH
  static int grid_blocks = 0;
  if (!grid_blocks) {
    int dev = 0, cus = 0, per_cu = 0;
    hipGetDevice(&dev);
    hipDeviceGetAttribute(&cus, hipDeviceAttributeMultiprocessorCount, dev);
    hipOccupancyMaxActiveBlocksPerMultiprocessor(&per_cu, hybrid_flow_mega, 256, 0);
    if (per_cu < 1) per_cu = 1;
    if (per_cu > 2) per_cu = 2;
    grid_blocks = cus * per_cu;
  }
  (void)hipMemsetAsync((char*)d_ws + WS_BAR, 0, 16384, stream);
  void* args[] = {&p};
  hipError_t e = hipLaunchCooperativeKernel((void*)hybrid_flow_mega, dim3(grid_blocks), dim3(256), args, 0, stream);
  if (e != hipSuccess) fprintf(stderr, "cooperative launch failed: %s (grid %d)\n", hipGetErrorString(e), grid_blocks);
#else
  const int grid_blocks = 512;
  for (int step = 0; step < NSTEPS; ++step) {
    int ph, l;
    if (step < 2) { ph = step; l = 0; }
    else { int s = step - 2; l = s / 9; ph = PH_GIN + (s % 9); }
    hipLaunchKernelGGL(hybrid_flow_phase, dim3(grid_blocks), dim3(256), 0, stream, p, ph, l);
  }
#endif
}
```

```cpp
#include <hip/hip_runtime.h>
#include <hip/hip_cooperative_groups.h>
#include <cstdio>
namespace cg = cooperative_groups;

#ifndef ONE_LAUNCH
#define ONE_LAUNCH 1
#endif

typedef unsigned short bf16_t;
using bf16x8 = __attribute__((ext_vector_type(8))) short;
using bf16x4 = __attribute__((ext_vector_type(4))) short;
using f32x4 = __attribute__((ext_vector_type(4))) float;
using u32x4 = __attribute__((ext_vector_type(4))) unsigned;
#define DI __device__ __forceinline__
#define MFMA16(a, b, c) __builtin_amdgcn_mfma_f32_16x16x32_bf16((a), (b), (c), 0, 0, 0)

struct P {
  const float* in[44];
  float* out;
  char* ws;
};

constexpr int D = 1024, NCTX = 8192;
constexpr int ZLD = 4160;
constexpr int ZC_NAQ = 0, ZC_NAK = 512, ZC_DFQ = 1024, ZC_DFK = 1536, ZC_RTQ = 2048, ZC_RTK = 2560, ZC_RTG = 3072,
              ZC_LRX = 3584;
constexpr int LDT = 72;

constexpr size_t WS_WIN = 0;
constexpr size_t WS_WBR = WS_WIN + (size_t)10240 * 1024 * 2;
constexpr size_t WS_WOUT = WS_WBR + (size_t)1024 * 2048 * 2;
constexpr size_t WS_W1 = WS_WOUT + (size_t)1024 * 1024 * 2;
constexpr size_t WS_W2 = WS_W1 + (size_t)4096 * 1024 * 2;
constexpr size_t WS_WLRU = WS_W2 + (size_t)4096 * 1024 * 2;
constexpr size_t WS_CKNA = WS_WLRU + (size_t)32 * 4096 * 2;
constexpr size_t WS_CVNA = WS_CKNA + (size_t)4 * 262144 * 2;
constexpr size_t WS_CKDF = WS_CVNA + (size_t)4 * 262144 * 2;
constexpr size_t WS_CVDF = WS_CKDF + (size_t)4 * 262144 * 2;
constexpr size_t WS_MOD = WS_CVDF + (size_t)4 * 262144 * 2;
constexpr size_t WS_H = WS_MOD + (size_t)4 * 5 * 6144 * 4;
constexpr size_t WS_Y4 = WS_H + (size_t)16384 * 1024 * 2;
constexpr size_t WS_VTNA = WS_Y4 + (size_t)16384 * 2048 * 2;
constexpr size_t WS_VTDF = WS_VTNA + (size_t)16384 * 512 * 2;
constexpr size_t WS_VTRT = WS_VTDF + (size_t)16384 * 512 * 2;
constexpr size_t WS_KTRT = WS_VTRT + (size_t)16384 * 512 * 2;
constexpr size_t WS_Z = WS_KTRT + (size_t)8192 * 512 * 2;
constexpr size_t WS_GF = WS_Z + (size_t)16384 * ZLD * 2;
constexpr size_t WS_Y = WS_Z;
constexpr size_t WS_U = WS_Z + (size_t)16384 * 1024 * 4;
constexpr size_t WS_LA = WS_GF + (size_t)16384 * 4096 * 2;
constexpr size_t WS_LU = WS_LA + (size_t)2 * 16384 * 512 * 2;
constexpr size_t WS_HF = WS_LU + (size_t)2 * 16384 * 512 * 2;
constexpr size_t WS_LG = WS_HF + (size_t)16384 * 512 * 2;
constexpr size_t WS_BAR = WS_LG + (size_t)16384 * 512 * 2;
constexpr size_t WS_END = WS_BAR + 16384;

constexpr size_t O_NAK = 16777216, O_NAV = 33554432, O_DFK = 50331648, O_DFV = 67108864, O_RF = 83886080,
                 O_RB = 88080384, O_LF = 92274688, O_LB = 92340224;
constexpr int VT_LAT = 4194304;

constexpr int SMEM_BYTES = 75776;

DI int otid() {
  int t = threadIdx.x;
  asm volatile("" : "+v"(t));
  return t;
}
typedef __bf16 hwbf2 __attribute__((ext_vector_type(2)));
typedef float f32v2 __attribute__((ext_vector_type(2)));
using u32x2 = __attribute__((ext_vector_type(2))) unsigned;
DI unsigned pk2(float a, float b) {
  f32v2 v = {a, b};
  return __builtin_bit_cast(unsigned, __builtin_convertvector(v, hwbf2));
}
DI bf16_t f2bf(float x) { return (bf16_t)(pk2(x, 0.f) & 0xffffu); }
DI float bf2f(bf16_t b) { return __uint_as_float(((unsigned)b) << 16); }
DI float bfs2f(short b) { return __uint_as_float(((unsigned)(unsigned short)b) << 16); }
DI float wave_sum(float v) {
#pragma unroll
  for (int o = 32; o > 0; o >>= 1) v += __shfl_xor(v, o);
  return v;
}
DI float xmax16(float v) {
  unsigned u = __float_as_uint(v);
  auto r = __builtin_amdgcn_permlane16_swap(u, u, false, false);
  return fmaxf(__uint_as_float(r[0]), __uint_as_float(r[1]));
}
DI float xmax32(float v) {
  unsigned u = __float_as_uint(v);
  auto r = __builtin_amdgcn_permlane32_swap(u, u, false, false);
  return fmaxf(__uint_as_float(r[0]), __uint_as_float(r[1]));
}
DI float xsum16(float v) {
  unsigned u = __float_as_uint(v);
  auto r = __builtin_amdgcn_permlane16_swap(u, u, false, false);
  return __uint_as_float(r[0]) + __uint_as_float(r[1]);
}
DI float xsum32(float v) {
  unsigned u = __float_as_uint(v);
  auto r = __builtin_amdgcn_permlane32_swap(u, u, false, false);
  return __uint_as_float(r[0]) + __uint_as_float(r[1]);
}
DI float sigmoidf_(float x) { return 1.f / (1.f + __expf(-x)); }
DI float gelu_tanh(float x) {
  float u = 0.7978845608028654f * (x + 0.044715f * x * x * x);
  return x * sigmoidf_(2.f * u);
}
DI bf16x8 pack8(const f32x4& a, const f32x4& b) {
  u32x4 r = {pk2(a[0], a[1]), pk2(a[2], a[3]), pk2(b[0], b[1]), pk2(b[2], b[3])};
  return __builtin_bit_cast(bf16x8, r);
}
DI bf16x4 pack4(float a, float b, float c, float d) {
  u32x2 r = {pk2(a, b), pk2(c, d)};
  return __builtin_bit_cast(bf16x4, r);
}

constexpr int GEMM_BUF_BYTES = 32768;
DI int swz_off(int rr, int c4) {
  int ob = rr * 64 + c4 * 16;
  return ob ^ (((ob >> 9) & 1) << 5);
}
template <int NI>
DI void gemm_mainloop(const bf16_t* __restrict__ A, int lda, const bf16_t* __restrict__ Bt, int ldb, int K, int row0,
                      int col0, char* smem, f32x4 (&acc)[4][NI]) {
  const int tid = otid(), lane = tid & 63, wid = tid >> 6;
  const int wm = wid >> 1, wn = wid & 1, fr = lane & 15, fq = lane >> 4;
  const int c4 = tid & 3, kh = (tid >> 3) & 1;
  const int srow = ((tid >> 4) << 1) + ((tid >> 2) & 1);
  const int gk = (kh * 4 + c4) * 8;
  const int soff = ((srow >> 4) * 2 + kh) * 1024 + swz_off(srow & 15, c4);
  const bf16_t* Ag = A + (size_t)(row0 + srow) * lda + gk;
  const bf16_t* Bg = Bt + (size_t)(col0 + srow) * ldb + gk;
  const int aoff = wm * 8192 + swz_off(fr, fq);
  const int boff = 16384 + wn * NI * 2048 + swz_off(fr, fq);
  u32x4 ra[4], rb[NI];
#pragma unroll
  for (int i = 0; i < 4; ++i) ra[i] = *(const u32x4*)(Ag + (size_t)(i * 32) * lda);
#pragma unroll
  for (int i = 0; i < NI; ++i) rb[i] = *(const u32x4*)(Bg + (size_t)(i * 32) * ldb);
#pragma unroll
  for (int i = 0; i < 4; ++i) *(u32x4*)(smem + soff + i * 4096) = ra[i];
#pragma unroll
  for (int i = 0; i < NI; ++i) *(u32x4*)(smem + 16384 + soff + i * 4096) = rb[i];
  __syncthreads();
  const int nk = K >> 6;
  for (int kt = 0; kt < nk; ++kt) {
    const bool more = (kt + 1) < nk;
    if (more) {
      const int k1 = (kt + 1) * 64;
#pragma unroll
      for (int i = 0; i < 4; ++i) ra[i] = *(const u32x4*)(Ag + (size_t)(i * 32) * lda + k1);
#pragma unroll
      for (int i = 0; i < NI; ++i) rb[i] = *(const u32x4*)(Bg + (size_t)(i * 32) * ldb + k1);
    }
    asm volatile("" ::: "memory");
    const char* sb = smem + (kt & 1) * GEMM_BUF_BYTES;
#pragma unroll
    for (int ks = 0; ks < 2; ++ks) {
      bf16x8 af[4], bfr[NI];
#pragma unroll
      for (int mi = 0; mi < 4; ++mi) af[mi] = *(const bf16x8*)(sb + aoff + mi * 2048 + ks * 1024);
#pragma unroll
      for (int ni = 0; ni < NI; ++ni) bfr[ni] = *(const bf16x8*)(sb + boff + ni * 2048 + ks * 1024);
#pragma unroll
      for (int mi = 0; mi < 4; ++mi)
#pragma unroll
        for (int ni = 0; ni < NI; ++ni) acc[mi][ni] = MFMA16(bfr[ni], af[mi], acc[mi][ni]);
    }
    __builtin_amdgcn_sched_barrier(0);
    if (more) {
      char* db = smem + ((kt + 1) & 1) * GEMM_BUF_BYTES;
#pragma unroll
      for (int i = 0; i < 4; ++i) *(u32x4*)(db + soff + i * 4096) = ra[i];
#pragma unroll
      for (int i = 0; i < NI; ++i) *(u32x4*)(db + 16384 + soff + i * 4096) = rb[i];
    }
    __syncthreads();
  }
}

DI void zero_acc(f32x4 (&acc)[4][4]) {
#pragma unroll
  for (int mi = 0; mi < 4; ++mi)
#pragma unroll
    for (int ni = 0; ni < 4; ++ni) acc[mi][ni] = f32x4{0.f, 0.f, 0.f, 0.f};
}
DI bool tile_sched(int iter, int tmt, int ntn, int& tm, int& tn) {
  const int G = gridDim.x, b = blockIdx.x;
  if ((G & 63) == 0 && (ntn & 7) == 0 && (tmt & 7) == 0) {
    const int groups = G >> 6, xg = b % groups, j = b / groups;
    const int srows = tmt >> 3;
    const int s = iter * groups + xg, nsuper = srows * (ntn >> 3);
    if (s >= nsuper) return false;
    tm = (s % srows) * 8 + (j & 7);
    tn = (s / srows) * 8 + (j >> 3);
    return true;
  }
  const int id = b + iter * G;
  if (id >= tmt * ntn) return false;
  tm = id % tmt;
  tn = id / tmt;
  return true;
}

constexpr int G2_STAGE = 24576;
DI void zero_acc2(f32x4 (&acc)[8][4]) {
#pragma unroll
  for (int mi = 0; mi < 8; ++mi)
#pragma unroll
    for (int ni = 0; ni < 4; ++ni) acc[mi][ni] = f32x4{0.f, 0.f, 0.f, 0.f};
}
DI void gemm2_mainloop(const bf16_t* __restrict__ A, int lda, const bf16_t* __restrict__ Bt, int ldb, int K, int row0,
                       int col0, char* smem, f32x4 (&acc)[8][4]) {
  const int tid = otid(), lane = tid & 63, wid = tid >> 6;
  const int wm = wid >> 1, wn = wid & 1, fr = lane & 15, fq = lane >> 4;
  const int c4 = tid & 3, srow = tid >> 2;
  const int soff = (srow >> 4) * 1024 + swz_off(srow & 15, c4);
  const bf16_t* Ag = A + (size_t)(row0 + srow) * lda + c4 * 8;
  const bf16_t* Bg = Bt + (size_t)(col0 + srow) * ldb + c4 * 8;
  const int aoff = wm * 8192 + swz_off(fr, fq);
  const int boff = 16384 + wn * 4096 + swz_off(fr, fq);
  u32x4 raA[4], rbA[2], raB[4], rbB[2];
  const int nk = K >> 5;
  auto gload = [&](int kt, u32x4 (&ra)[4], u32x4 (&rb)[2]) __attribute__((always_inline)) {
    const int k1 = kt * 32;
#pragma unroll
    for (int i = 0; i < 4; ++i) ra[i] = *(const u32x4*)(Ag + (size_t)(i * 64) * lda + k1);
#pragma unroll
    for (int i = 0; i < 2; ++i) rb[i] = *(const u32x4*)(Bg + (size_t)(i * 64) * ldb + k1);
  };
  auto sstore = [&](int st, const u32x4 (&ra)[4], const u32x4 (&rb)[2]) __attribute__((always_inline)) {
    char* db = smem + st * G2_STAGE;
#pragma unroll
    for (int i = 0; i < 4; ++i) *(u32x4*)(db + soff + i * 4096) = ra[i];
#pragma unroll
    for (int i = 0; i < 2; ++i) *(u32x4*)(db + 16384 + soff + i * 4096) = rb[i];
  };
  auto step = [&](int st, int ktn, u32x4 (&ra)[4], u32x4 (&rb)[2], const u32x4 (&wa)[4], const u32x4 (&wb)[2]) __attribute__((always_inline)) {
    const char* sb = smem + st * G2_STAGE;
    bf16x8 bfr[4];
#pragma unroll
    for (int ni = 0; ni < 4; ++ni) bfr[ni] = *(const bf16x8*)(sb + boff + ni * 1024);
    bf16x8 af0 = *(const bf16x8*)(sb + aoff);
    asm volatile("" ::: "memory");
    gload(ktn, ra, rb);
    asm volatile("" ::: "memory");
    __builtin_amdgcn_s_setprio(1);
#pragma unroll
    for (int mi = 0; mi < 4; ++mi) {
      bf16x8 af = af0;
      if (mi > 0) af = *(const bf16x8*)(sb + aoff + mi * 1024);
#pragma unroll
      for (int ni = 0; ni < 4; ++ni) acc[mi][ni] = MFMA16(bfr[ni], af, acc[mi][ni]);
    }
    __builtin_amdgcn_s_setprio(0);
    __builtin_amdgcn_sched_barrier(0);
    sstore(st ^ 1, wa, wb);
    __builtin_amdgcn_sched_barrier(0);
    __builtin_amdgcn_s_setprio(1);
#pragma unroll
    for (int mi = 4; mi < 8; ++mi) {
      bf16x8 af = *(const bf16x8*)(sb + aoff + mi * 1024);
#pragma unroll
      for (int ni = 0; ni < 4; ++ni) acc[mi][ni] = MFMA16(bfr[ni], af, acc[mi][ni]);
    }
    __builtin_amdgcn_s_setprio(0);
  };
  gload(0, raA, rbA);
  gload(1, raB, rbB);
  sstore(0, raA, rbA);
  __syncthreads();
  for (int kt = 0; kt < nk; kt += 2) {
    step(0, kt + 2 < nk ? kt + 2 : nk - 1, raA, rbA, raB, rbB);
    __syncthreads();
    step(1, kt + 3 < nk ? kt + 3 : nk - 1, raB, rbB, raA, rbA);
    __syncthreads();
  }
}

constexpr int G3_STAGE = 16384;
DI void gemm3_mainloop(const bf16_t* __restrict__ A, int lda, const bf16_t* __restrict__ Bt, int ldb, int K, int row0,
                       int col0, char* smem, f32x4 (&acc)[4][4]) {
  const int tid = otid(), lane = tid & 63, wid = tid >> 6;
  const int wm = wid >> 1, wn = wid & 1, fr = lane & 15, fq = lane >> 4;
  const int c4 = tid & 3, srow = tid >> 2;
  const int soff = (srow >> 4) * 1024 + swz_off(srow & 15, c4);
  const bf16_t* Ag = A + (size_t)(row0 + srow) * lda + c4 * 8;
  const bf16_t* Bg = Bt + (size_t)(col0 + srow) * ldb + c4 * 8;
  const int aoff = wm * 4096 + swz_off(fr, fq);
  const int boff = 8192 + wn * 4096 + swz_off(fr, fq);
  u32x4 raA[2], rbA[2], raB[2], rbB[2];
  const int nk = K >> 5;
  auto gload = [&](int kt, u32x4 (&ra)[2], u32x4 (&rb)[2]) __attribute__((always_inline)) {
    const int k1 = kt * 32;
#pragma unroll
    for (int i = 0; i < 2; ++i) { ra[i] = *(const u32x4*)(Ag + (size_t)(i * 64) * lda + k1); rb[i] = *(const u32x4*)(Bg + (size_t)(i * 64) * ldb + k1); }
  };
  auto sstore = [&](int st, const u32x4 (&ra)[2], const u32x4 (&rb)[2]) __attribute__((always_inline)) {
    char* db = smem + st * G3_STAGE;
#pragma unroll
    for (int i = 0; i < 2; ++i) { *(u32x4*)(db + soff + i * 4096) = ra[i]; *(u32x4*)(db + 8192 + soff + i * 4096) = rb[i]; }
  };
  auto step = [&](int st, int ktn, u32x4 (&ra)[2], u32x4 (&rb)[2], const u32x4 (&wa)[2], const u32x4 (&wb)[2]) __attribute__((always_inline)) {
    const char* sb = smem + st * G3_STAGE;
    bf16x8 bfr[4];
#pragma unroll
    for (int ni = 0; ni < 4; ++ni) bfr[ni] = *(const bf16x8*)(sb + boff + ni * 1024);
    bf16x8 af0 = *(const bf16x8*)(sb + aoff);
    asm volatile("" ::: "memory");
    gload(ktn, ra, rb);
    asm volatile("" ::: "memory");
    __builtin_amdgcn_s_setprio(1);
#pragma unroll
    for (int mi = 0; mi < 2; ++mi) {
      bf16x8 af = af0;
      if (mi > 0) af = *(const bf16x8*)(sb + aoff + mi * 1024);
#pragma unroll
      for (int ni = 0; ni < 4; ++ni) acc[mi][ni] = MFMA16(bfr[ni], af, acc[mi][ni]);
    }
    __builtin_amdgcn_s_setprio(0);
    __builtin_amdgcn_sched_barrier(0);
    sstore(st ^ 1, wa, wb);
    __builtin_amdgcn_sched_barrier(0);
    __builtin_amdgcn_s_setprio(1);
#pragma unroll
    for (int mi = 2; mi < 4; ++mi) {
      bf16x8 af = *(const bf16x8*)(sb + aoff + mi * 1024);
#pragma unroll
      for (int ni = 0; ni < 4; ++ni) acc[mi][ni] = MFMA16(bfr[ni], af, acc[mi][ni]);
    }
    __builtin_amdgcn_s_setprio(0);
  };
  gload(0, raA, rbA);
  gload(1, raB, rbB);
  sstore(0, raA, rbA);
  __syncthreads();
  for (int kt = 0; kt < nk; kt += 2) {
    step(0, kt + 2 < nk ? kt + 2 : nk - 1, raA, rbA, raB, rbB);
    __syncthreads();
    step(1, kt + 3 < nk ? kt + 3 : nk - 1, raB, rbB, raA, rbA);
    __syncthreads();
  }
}

constexpr int CST_B = 272;
constexpr int CST_T = 528;
template <int MI, int NI, class F>
DI void stage_rowmajor(char* smem, f32x4 (&acc)[MI][NI], int wm, int wn, int fr, int fq, F&& tf) {
#pragma unroll
  for (int mi = 0; mi < MI; ++mi)
#pragma unroll
    for (int ni = 0; ni < NI; ++ni) {
      f32x4 v = tf(acc[mi][ni]);
      *(bf16x4*)(smem + (wm * MI * 16 + mi * 16 + fr) * CST_B + (wn * NI * 16 + ni * 16 + fq * 4) * 2) = pack4(v[0], v[1], v[2], v[3]);
      if (ni == NI - 1) __builtin_amdgcn_sched_barrier(0);
    }
}
template <int MI, int NI, class F>
DI void stage_transposed(char* smem, f32x4 (&acc)[MI][NI], int wm, int wn, int fr, int fq, F&& tf) {
#pragma unroll
  for (int mi = 0; mi < MI; ++mi)
#pragma unroll
    for (int ni = 0; ni < NI; ++ni) {
      f32x4 v = tf(acc[mi][ni]);
      char* base = smem + (wn * NI * 16 + ni * 16 + fq * 4) * CST_T + (wm * MI * 16 + mi * 16 + fr) * 2;
      *(bf16_t*)(base) = f2bf(v[0]);
      *(bf16_t*)(base + CST_T) = f2bf(v[1]);
      *(bf16_t*)(base + 2 * CST_T) = f2bf(v[2]);
      *(bf16_t*)(base + 3 * CST_T) = f2bf(v[3]);
      if (ni == NI - 1) __builtin_amdgcn_sched_barrier(0);
    }
}
template <int LINES, int CPL, int STRIDE, class D>
DI void writeout(const char* smem, int tid, D&& dst) {
#pragma unroll 4
  for (int j = 0; j < LINES * CPL / 256; ++j) {
    const int id = tid + j * 256, line = id / CPL, c = id % CPL;
    u32x4 v = *(const u32x4*)(smem + line * STRIDE + c * 16);
    *(u32x4*)dst(line, c) = v;
  }
}

DI void stage_rowmajor_rope(char* smem, f32x4 (&acc)[8][4], int wm, int wn, int fr, int fq, int rtok) {
  float inv[4];
#pragma unroll
  for (int i = 0; i < 4; ++i) inv[i] = exp2f(-(float)(fq * 4 + i) * 0.8304820237218406f);
#pragma unroll
  for (int mi = 0; mi < 8; ++mi) {
    const int t = (rtok + mi * 16 - NCTX) & 2047;
    const float gr = (float)(t >> 6), gc = (float)(t & 63);
    f32x4 o0, o1, o2, o3;
#pragma unroll
    for (int i = 0; i < 4; ++i) {
      const float sr = __sinf(gr * inv[i]), cr = __cosf(gr * inv[i]);
      const float sc = __sinf(gc * inv[i]), cc = __cosf(gc * inv[i]);
      const float a0 = acc[mi][0][i], a1 = acc[mi][1][i], a2 = acc[mi][2][i], a3 = acc[mi][3][i];
      o0[i] = a0 * cr - a1 * sr;
      o1[i] = a1 * cr + a0 * sr;
      o2[i] = a2 * cc - a3 * sc;
      o3[i] = a3 * cc + a2 * sc;
    }
    char* base = smem + (wm * 128 + mi * 16 + fr) * CST_B + (wn * 64 + fq * 4) * 2;
    *(bf16x4*)(base) = pack4(o0[0], o0[1], o0[2], o0[3]);
    *(bf16x4*)(base + 32) = pack4(o1[0], o1[1], o1[2], o1[3]);
    *(bf16x4*)(base + 64) = pack4(o2[0], o2[1], o2[2], o2[3]);
    *(bf16x4*)(base + 96) = pack4(o3[0], o3[1], o3[2], o3[3]);
    __builtin_amdgcn_sched_barrier(0);
  }
}

DI void epi_in(const P& p, int l, int row0, int col0, f32x4 (&acc)[8][4], char* smem) {
  const int tid_ = otid(), lane = tid_ & 63, wid = tid_ >> 6, wm = wid >> 1, wn = wid & 1, fr = lane & 15, fq = lane >> 4;
  const int seg = col0 >> 9;
  const bool ctx = row0 < NCTX;
  if (seg >= 12) {
    bf16_t* GF = (bf16_t*)(p.ws + WS_GF);
    const int k = (seg - 12) >> 1, tn = ((col0 - 6144) & 1023) >> 7, tm = row0 >> 8;
    bf16_t* dst = GF + (((size_t)k * 64 + tm) * 8 + tn) * 32768 + tid_ * 4;
#pragma unroll
    for (int mi = 0; mi < 8; ++mi)
#pragma unroll
      for (int ni = 0; ni < 4; ++ni)
        *(bf16x4*)(dst + (mi * 4 + ni) * 1024) = pack4(sigmoidf_(acc[mi][ni][0]), sigmoidf_(acc[mi][ni][1]), sigmoidf_(acc[mi][ni][2]), sigmoidf_(acc[mi][ni][3]));
    return;
  }
  const int ctile = col0 & 511;
  const int cseg0 = ctile + wn * 64;
  const int rtok = row0 + wm * 128 + fr;
  if (ctx && (seg == 1 || seg == 2 || seg == 4 || seg == 5)) {
    float* out = p.out;
#pragma unroll
    for (int mi = 0; mi < 8; ++mi) {
      const int r = rtok + mi * 16, b = r >> 8, t = r & 255;
      size_t off;
      if (seg == 1 || seg == 2) {
        const int h = cseg0 >> 6;
        off = (seg == 1 ? O_NAK : O_NAV) + (((size_t)(b * 4 + l) * 8 + h) * 256 + t) * 64;
      } else if (seg == 4) {
        const int comp = cseg0 >> 8, h = (cseg0 >> 6) & 3;
        off = O_DFK + ((((size_t)(b * 4 + l) * 2 + comp) * 4 + h) * 256 + t) * 64;
      } else {
        const int h = cseg0 >> 7;
        off = O_DFV + (((size_t)(b * 4 + l) * 4 + h) * 256 + t) * 128 + (cseg0 & 127);
      }
#pragma unroll
      for (int ni = 0; ni < 4; ++ni) *(f32x4*)(out + off + ni * 16 + fq * 4) = acc[mi][ni];
      __builtin_amdgcn_sched_barrier(0);
    }
  }
  auto tf_none = [](const f32x4& a) -> f32x4 { return a; };
  auto tf_scale = [](const f32x4& a) -> f32x4 { return f32x4{a[0] * 0.125f, a[1] * 0.125f, a[2] * 0.125f, a[3] * 0.125f}; };
  auto tf_silu = [](const f32x4& a) -> f32x4 { return f32x4{a[0] * sigmoidf_(a[0]), a[1] * sigmoidf_(a[1]), a[2] * sigmoidf_(a[2]), a[3] * sigmoidf_(a[3])}; };
  auto tf_gelu = [](const f32x4& a) -> f32x4 { return f32x4{gelu_tanh(a[0]), gelu_tanh(a[1]), gelu_tanh(a[2]), gelu_tanh(a[3])}; };
  const bool rowmajor = !(seg == 2 || seg == 5 || seg == 8 || seg == 11);
  if (rowmajor) {
    int zc;
    switch (seg) {
      case 0: zc = ZC_NAQ; break;
      case 1: zc = ZC_NAK; break;
      case 3: zc = ZC_DFQ; break;
      case 4: zc = ZC_DFK; break;
      case 6: zc = ZC_RTQ; break;
      case 7: zc = ZC_RTK; break;
      case 9: zc = ZC_RTG; break;
      default: zc = ZC_LRX; break;
    }
    if (!ctx && (seg == 3 || seg == 4)) stage_rowmajor_rope(smem, acc, wm, wn, fr, fq, rtok);
    else if (seg == 7) stage_rowmajor<8, 4>(smem, acc, wm, wn, fr, fq, tf_scale);
    else if (seg == 9) stage_rowmajor<8, 4>(smem, acc, wm, wn, fr, fq, tf_silu);
    else stage_rowmajor<8, 4>(smem, acc, wm, wn, fr, fq, tf_none);
    __syncthreads();
    bf16_t* zb = (bf16_t*)(p.ws + WS_Z) + (size_t)row0 * ZLD + zc + ctile;
    writeout<256, 16, CST_B>(smem, tid_, [&](int line, int c) { return zb + (size_t)line * ZLD + c * 8; });
    __syncthreads();
  }
  if (!rowmajor || (seg == 7 && ctx)) {
    if (seg == 7) stage_transposed<8, 4>(smem, acc, wm, wn, fr, fq, tf_scale);
    else if (seg == 11) stage_transposed<8, 4>(smem, acc, wm, wn, fr, fq, tf_gelu);
    else stage_transposed<8, 4>(smem, acc, wm, wn, fr, fq, tf_none);
    __syncthreads();
    if (seg == 11) {
      bf16_t* lg = (bf16_t*)(p.ws + WS_LG) + ((size_t)(row0 >> 6) * 512 + ctile) * 64;
      writeout<128, 32, CST_T>(smem, tid_, [&](int line, int c) { return lg + ((size_t)(c >> 3) * 512 + line) * 64 + (c & 7) * 8; });
    } else {
      bf16_t* tb = (bf16_t*)(p.ws + (seg == 2 ? WS_VTNA : seg == 5 ? WS_VTDF : seg == 8 ? WS_VTRT : WS_KTRT));
      int T;
      if (ctx) { T = 256; tb += ((size_t)((row0 >> 8) * 512 + ctile)) * 256 + (row0 & 255); }
      else { const int rr = row0 - NCTX; T = 2048; tb += (size_t)VT_LAT + ((size_t)((rr >> 11) * 512 + ctile)) * 2048 + (rr & 2047); }
      writeout<128, 32, CST_T>(smem, tid_, [&](int line, int c) { return tb + (size_t)line * T + c * 8; });
    }
    __syncthreads();
  }
}

DI void phase_gin(const P& p, int l, char* smem) {
  const bf16_t* A = (const bf16_t*)(p.ws + WS_H);
  const bf16_t* Bt = (const bf16_t*)(p.ws + WS_WIN);
  for (int it = 0;; ++it) {
    int tm, tn;
    if (!tile_sched(it, 64, 80, tm, tn)) break;
    f32x4 acc[8][4];
    zero_acc2(acc);
    gemm2_mainloop(A, 1024, Bt, 1024, 1024, tm * 256, tn * 128, smem, acc);
    epi_in(p, l, tm * 256, tn * 128, acc, smem);
  }
}

DI void phase_merge(const P& p, char* smem) {
  const bf16_t* Y4 = (const bf16_t*)(p.ws + WS_Y4);
  const bf16_t* WB = (const bf16_t*)(p.ws + WS_WBR);
  const bf16_t* GF = (const bf16_t*)(p.ws + WS_GF);
  bf16_t* G = (bf16_t*)(p.ws + WS_H);
  const int tid_ = otid(), lane = tid_ & 63, wid = tid_ >> 6, wm = wid >> 1, wn = wid & 1, fr = lane & 15, fq = lane >> 4;
  for (int it = 0;; ++it) {
    int tm, tn;
    if (!tile_sched(it, 128, 8, tm, tn)) break;
    const int row0 = tm * 128, col0 = tn * 128;
    f32x4 o[4][4];
    zero_acc(o);
#pragma unroll 1
    for (int k = 0; k < 4; ++k) {
      f32x4 acc[4][4];
      zero_acc(acc);
      gemm3_mainloop(Y4 + k * 512, 2048, WB + k * 512, 2048, 512, row0, col0, smem, acc);
      const bf16_t* gsrc = GF + (((size_t)k * 64 + (tm >> 1)) * 8 + tn) * 32768 + (((tm & 1) * 2 + wn) * 64 + lane) * 4 + (wm * 16) * 1024;
#pragma unroll
      for (int mi = 0; mi < 4; ++mi) {
        bf16x4 gq[4];
#pragma unroll
        for (int ni = 0; ni < 4; ++ni) gq[ni] = *(const bf16x4*)(gsrc + (mi * 4 + ni) * 1024);
#pragma unroll
        for (int ni = 0; ni < 4; ++ni)
#pragma unroll
          for (int i = 0; i < 4; ++i) o[mi][ni][i] += bfs2f(gq[ni][i]) * acc[mi][ni][i];
      }
    }
    stage_rowmajor<4, 4>(smem, o, wm, wn, fr, fq, [](const f32x4& a) { return a; });
    __syncthreads();
    bf16_t* gb = G + (size_t)row0 * 1024 + col0;
    writeout<128, 16, CST_B>(smem, tid_, [&](int line, int c) { return gb + (size_t)line * 1024 + c * 8; });
    __syncthreads();
  }
}

template <int MODE>
DI void phase_gemm_plain(const bf16_t* A, int K, const bf16_t* Bt, int N, bf16_t* outp, char* smem) {
  const int tid_ = otid(), lane = tid_ & 63, wid = tid_ >> 6, wm = wid >> 1, wn = wid & 1, fr = lane & 15, fq = lane >> 4;
  const int ntn = N / 128;
  for (int it = 0;; ++it) {
    int tm, tn;
    if (!tile_sched(it, 64, ntn, tm, tn)) break;
    const int row0 = tm * 256, col0 = tn * 128;
    f32x4 acc[8][4];
    zero_acc2(acc);
    gemm2_mainloop(A, K, Bt, K, K, row0, col0, smem, acc);
    stage_rowmajor<8, 4>(smem, acc, wm, wn, fr, fq, [](const f32x4& a) {
      f32x4 v = a;
      if (MODE == 1) {
        v[0] = fmaxf(v[0], 0.f); v[1] = fmaxf(v[1], 0.f); v[2] = fmaxf(v[2], 0.f); v[3] = fmaxf(v[3], 0.f);
        v[0] *= v[0]; v[1] *= v[1]; v[2] *= v[2]; v[3] *= v[3];
      }
      return v;
    });
    __syncthreads();
    bf16_t* ob = outp + (size_t)row0 * N + col0;
    writeout<256, 16, CST_B>(smem, tid_, [&](int line, int c) { return ob + (size_t)line * N + c * 8; });
    __syncthreads();
  }
}

DI void phase_mod(const P& p, char* smem) {
  float* ssil = (float*)smem;
  float* red = ssil + 5 * 1024;
  const int tid = otid();
  float* MOD = (float*)(p.ws + WS_MOD);
  for (int idx = tid; idx < 5120; idx += 256) {
    int j = idx >> 10, k = idx & 1023;
    float cv = (j == 0) ? p.in[11][k] : p.in[10][(j - 1) * 1024 + k];
    ssil[idx] = cv / (1.f + expf(-cv));
  }
  __syncthreads();
  const int cl = tid & 63, kg = tid >> 6;
  for (int item = blockIdx.x; item < 384; item += gridDim.x) {
    int l = item / 96, cgp = item % 96;
    int col = cgp * 64 + cl;
    const float* W = p.in[12] + (size_t)l * 1024 * 6144 + col;
    float a0 = 0, a1 = 0, a2 = 0, a3 = 0, a4 = 0;
#pragma unroll 8
    for (int k = kg * 256; k < kg * 256 + 256; ++k) {
      float w = W[(size_t)k * 6144];
      a0 += ssil[k] * w;
      a1 += ssil[1024 + k] * w;
      a2 += ssil[2048 + k] * w;
      a3 += ssil[3072 + k] * w;
      a4 += ssil[4096 + k] * w;
    }
    red[(kg * 5 + 0) * 64 + cl] = a0;
    red[(kg * 5 + 1) * 64 + cl] = a1;
    red[(kg * 5 + 2) * 64 + cl] = a2;
    red[(kg * 5 + 3) * 64 + cl] = a3;
    red[(kg * 5 + 4) * 64 + cl] = a4;
    __syncthreads();
    if (kg == 0) {
      float bias = p.in[13][l * 6144 + col];
#pragma unroll
      for (int j = 0; j < 5; ++j) {
        float s = red[(0 * 5 + j) * 64 + cl] + red[(1 * 5 + j) * 64 + cl] + red[(2 * 5 + j) * 64 + cl] + red[(3 * 5 + j) * 64 + cl];
        MOD[(size_t)(l * 5 + j) * 6144 + col] = s + bias;
      }
    }
    __syncthreads();
  }
}

DI void transpose_tile(const float* __restrict__ src, int lds_, bf16_t* __restrict__ dst, int ldd, float* tile) {
  const int tid = otid();
#pragma unroll 4
  for (int i = 0; i < 16; ++i) {
    int idx = tid + i * 256, r = idx >> 6, c = idx & 63;
    tile[r * 65 + c] = src[(size_t)r * lds_ + c];
  }
  __syncthreads();
#pragma unroll 4
  for (int i = 0; i < 16; ++i) {
    int idx = tid + i * 256, c = idx >> 6, r = idx & 63;
    dst[(size_t)c * ldd + r] = f2bf(tile[r * 65 + c]);
  }
  __syncthreads();
}

DI void phase_convert(const P& p, int l, char* smem) {
  float* tile = (float*)smem;
  char* ws = p.ws;
  const int NJ = 6432;
  for (int j = blockIdx.x; j < NJ; j += gridDim.x) {
    int q = j;
    if (q < 2560) {
      int tr = q / 160, tc = q % 160;
      transpose_tile(p.in[18] + (size_t)l * 1024 * 10240 + (size_t)tr * 64 * 10240 + tc * 64, 10240,
                     (bf16_t*)(ws + WS_WIN) + (size_t)tc * 64 * 1024 + tr * 64, 1024, tile);
      continue;
    }
    q -= 2560;
    if (q < 512) {
      int tr = q / 16, tc = q % 16;
      transpose_tile(p.in[40] + (size_t)l * 2048 * 1024 + (size_t)tr * 64 * 1024 + tc * 64, 1024,
                     (bf16_t*)(ws + WS_WBR) + (size_t)tc * 64 * 2048 + tr * 64, 2048, tile);
      continue;
    }
    q -= 512;
    if (q < 256) {
      int tr = q / 16, tc = q % 16;
      transpose_tile(p.in[41] + (size_t)l * 1024 * 1024 + (size_t)tr * 64 * 1024 + tc * 64, 1024,
                     (bf16_t*)(ws + WS_WOUT) + (size_t)tc * 64 * 1024 + tr * 64, 1024, tile);
      continue;
    }
    q -= 256;
    if (q < 1024) {
      int tr = q / 64, tc = q % 64;
      transpose_tile(p.in[42] + (size_t)l * 1024 * 4096 + (size_t)tr * 64 * 4096 + tc * 64, 4096,
                     (bf16_t*)(ws + WS_W1) + (size_t)tc * 64 * 1024 + tr * 64, 1024, tile);
      continue;
    }
    q -= 1024;
    if (q < 1024) {
      int tr = q / 16, tc = q % 16;
      transpose_tile(p.in[43] + (size_t)l * 4096 * 1024 + (size_t)tr * 64 * 1024 + tc * 64, 1024,
                     (bf16_t*)(ws + WS_W2) + (size_t)tc * 64 * 4096 + tr * 64, 4096, tile);
      continue;
    }
    q -= 1024;
    if (q < 32) {
      int type = q >> 3, n = q & 7;
      const float* src = (type == 0 ? p.in[30] : type == 1 ? p.in[32] : type == 2 ? p.in[35] : p.in[37]) + (size_t)(l * 8 + n) * 4096;
      transpose_tile(src, 64, (bf16_t*)(ws + WS_WLRU) + (size_t)(type * 8 + n) * 4096, 64, tile);
      continue;
    }
    q -= 32;
    if (q < 256) {
      int bh = q >> 3, tr = q & 7, b = bh >> 3, h = bh & 7;
      transpose_tile(p.in[3] + ((size_t)((b * 4 + l) * 8 + h)) * 32768 + (size_t)tr * 64 * 64, 64,
                     (bf16_t*)(ws + WS_CVNA) + (size_t)bh * 32768 + tr * 64, 512, tile);
      continue;
    }
    q -= 256;
    if (q < 256) {
      int bh = q >> 4, t2 = q & 15, tr = t2 >> 1, tc = t2 & 1, b = bh >> 2, h = bh & 3;
      transpose_tile(p.in[5] + ((size_t)((b * 4 + l) * 4 + h)) * 65536 + (size_t)tr * 64 * 128 + tc * 64, 128,
                     (bf16_t*)(ws + WS_CVDF) + (size_t)bh * 65536 + (size_t)tc * 64 * 512 + tr * 64, 512, tile);
      continue;
    }
    q -= 256;
    {
      int tensor = q >> 8, b = (q >> 6) & 3, chunk = q & 63;
      const float* src = (tensor == 0 ? p.in[2] : p.in[4]) + (size_t)(b * 4 + l) * 262144 + (size_t)chunk * 4096;
      bf16_t* dst = (bf16_t*)(ws + (tensor == 0 ? WS_CKNA : WS_CKDF)) + (size_t)b * 262144 + (size_t)chunk * 4096;
#pragma unroll
      for (int i = 0; i < 4; ++i) {
        int e = (otid() + i * 256) * 4;
        float4 v = *(const float4*)(src + e);
        *(bf16x4*)(dst + e) = pack4(v.x, v.y, v.z, v.w);
      }
    }
  }
}

DI void phase_row(const P& p, int l, int mode) {
  const int tid_ = otid(), lane = tid_ & 63, wid = tid_ >> 6;
  const float* MOD = (const float*)(p.ws + WS_MOD);
  float* X = p.out;
  bf16_t* H = (bf16_t*)(p.ws + WS_H);
  const bf16_t* Y = (const bf16_t*)(p.ws + WS_Y);
  const bool from_inputs = (mode == 0 || (mode == 1 && l == 0));
  auto xsrc = [&](int r) -> const float* {
    return from_inputs ? ((r < NCTX) ? (p.in[0] + (size_t)r * D) : (p.in[1] + (size_t)(r - NCTX) * D)) : (X + (size_t)r * D);
  };
  int rb = blockIdx.x;
  if (rb >= 4096) return;
  float4 xn[4];
  bf16x4 yn[4];
  {
    const int r = rb * 4 + wid;
    const float* xs = xsrc(r);
#pragma unroll
    for (int j = 0; j < 4; ++j) xn[j] = *(const float4*)(xs + j * 256 + lane * 4);
    if (mode != 0) {
#pragma unroll
      for (int j = 0; j < 4; ++j) yn[j] = *(const bf16x4*)(Y + (size_t)r * D + j * 256 + lane * 4);
    }
  }
  for (; rb < 4096; rb += gridDim.x) {
    const int r = rb * 4 + wid;
    const int mi = r < NCTX ? 0 : 1 + ((r - NCTX) >> 11);
    float4 xv[4], yv[4];
#pragma unroll
    for (int j = 0; j < 4; ++j) { xv[j] = xn[j]; yv[j] = make_float4(bfs2f(yn[j][0]), bfs2f(yn[j][1]), bfs2f(yn[j][2]), bfs2f(yn[j][3])); }
    {
      const int rbn = (rb + (int)gridDim.x < 4096) ? rb + (int)gridDim.x : rb;
      const int rn = rbn * 4 + wid;
      const float* xs = xsrc(rn);
#pragma unroll
      for (int j = 0; j < 4; ++j) xn[j] = *(const float4*)(xs + j * 256 + lane * 4);
      if (mode != 0) {
#pragma unroll
        for (int j = 0; j < 4; ++j) yn[j] = *(const bf16x4*)(Y + (size_t)rn * D + j * 256 + lane * 4);
      }
    }
    if (mode != 0) {
      float ss = 0.f;
#pragma unroll
      for (int j = 0; j < 4; ++j) ss += yv[j].x * yv[j].x + yv[j].y * yv[j].y + yv[j].z * yv[j].z + yv[j].w * yv[j].w;
      ss = wave_sum(ss);
      const float rs = rsqrtf(ss * (1.f / 1024.f) + 1e-6f);
      const float* gpost = (mode == 1 ? p.in[15] : p.in[17]) + l * D;
      const float* gate = MOD + (size_t)(l * 5 + mi) * 6144 + (mode == 1 ? 2048 : 5120);
#pragma unroll
      for (int j = 0; j < 4; ++j) {
        float4 g = *(const float4*)(gpost + j * 256 + lane * 4);
        float4 gt = *(const float4*)(gate + j * 256 + lane * 4);
        xv[j].x += gt.x * (yv[j].x * rs * g.x);
        xv[j].y += gt.y * (yv[j].y * rs * g.y);
        xv[j].z += gt.z * (yv[j].z * rs * g.z);
        xv[j].w += gt.w * (yv[j].w * rs * g.w);
        *(float4*)(X + (size_t)r * D + j * 256 + lane * 4) = xv[j];
      }
    }
    int ln, off_sh, off_sc;
    const float* gpre;
    if (mode == 0) { ln = 0; gpre = p.in[14]; off_sh = 0; off_sc = 1024; }
    else if (mode == 1) { ln = l; gpre = p.in[16] + l * D; off_sh = 3072; off_sc = 4096; }
    else { ln = l + 1; gpre = p.in[14] + (l + 1) * D; off_sh = 0; off_sc = 1024; }
    if (ln < 4) {
      float ss = 0.f;
#pragma unroll
      for (int j = 0; j < 4; ++j) ss += xv[j].x * xv[j].x + xv[j].y * xv[j].y + xv[j].z * xv[j].z + xv[j].w * xv[j].w;
      ss = wave_sum(ss);
      const float rs = rsqrtf(ss * (1.f / 1024.f) + 1e-6f);
      const float* mrow = MOD + (size_t)(ln * 5 + mi) * 6144;
#pragma unroll
      for (int j = 0; j < 4; ++j) {
        int c = j * 256 + lane * 4;
        float4 g = *(const float4*)(gpre + c);
        float4 sc = *(const float4*)(mrow + off_sc + c);
        float4 sh = *(const float4*)(mrow + off_sh + c);
        *(bf16x4*)(H + (size_t)r * D + c) = pack4(xv[j].x * rs * g.x * (1.f + sc.x) + sh.x, xv[j].y * rs * g.y * (1.f + sc.y) + sh.y,
                                                  xv[j].z * rs * g.z * (1.f + sc.z) + sh.z, xv[j].w * rs * g.w * (1.f + sc.w) + sh.w);
      }
    }
  }
}

constexpr int ATT_BUF = 192 * LDT;
DI void qk_scores(const bf16x8 (&qf)[2], const bf16_t* sK, f32x4 (&S)[4], int fr, int fq) {
  __builtin_amdgcn_s_setprio(1);
#pragma unroll
  for (int s = 0; s < 4; ++s) {
    f32x4 z = {0.f, 0.f, 0.f, 0.f};
#pragma unroll
    for (int ks = 0; ks < 2; ++ks) {
      bf16x8 a = *(const bf16x8*)((const char*)sK + (s * 2 + ks) * 1024 + swz_off(fr, fq));
      z = MFMA16(a, qf[ks], z);
    }
    S[s] = z;
  }
  __builtin_amdgcn_s_setprio(0);
}
template <int DV>
DI void pv_step(const bf16x8 (&pb)[2], const bf16_t* sV, f32x4 (&O)[DV / 16], int fr, int fq) {
  __builtin_amdgcn_s_setprio(1);
#pragma unroll
  for (int dt = 0; dt < DV / 16; ++dt) {
#pragma unroll
    for (int s2 = 0; s2 < 2; ++s2) {
      const bf16_t* base = sV + (dt * 16 + fr) * LDT + 32 * s2 + 4 * fq;
      bf16x4 lo = *(const bf16x4*)base;
      bf16x4 hi = *(const bf16x4*)(base + 16);
      bf16x8 a = __builtin_shufflevector(lo, hi, 0, 1, 2, 3, 4, 5, 6, 7);
      O[dt] = MFMA16(a, pb[s2], O[dt]);
    }
  }
  __builtin_amdgcn_s_setprio(0);
}
template <int DV>
DI void softmax_pv(f32x4 (&S)[4], const bf16_t* sV, f32x4 (&O)[DV / 16], float& m, float& lsum, int fr, int fq) {
  float tm = -1e30f;
#pragma unroll
  for (int s = 0; s < 4; ++s)
#pragma unroll
    for (int i = 0; i < 4; ++i) tm = fmaxf(tm, S[s][i]);
  tm = xmax32(xmax16(tm));
  const float mn = fmaxf(m, tm);
  const float alpha = __builtin_amdgcn_exp2f(m - mn);
  const bool grew = mn != m;
  m = mn;
  float ps = 0.f;
#pragma unroll
  for (int s = 0; s < 4; ++s)
#pragma unroll
    for (int i = 0; i < 4; ++i) {
      float pv = __builtin_amdgcn_exp2f(S[s][i] - mn);
      S[s][i] = pv;
      ps += pv;
    }
  lsum = lsum * alpha + ps;
  if (__any(grew)) {
#pragma unroll
    for (int dt = 0; dt < DV / 16; ++dt) {
      O[dt][0] *= alpha; O[dt][1] *= alpha; O[dt][2] *= alpha; O[dt][3] *= alpha;
    }
  }
  bf16x8 pb[2];
  pb[0] = pack8(S[0], S[1]);
  pb[1] = pack8(S[2], S[3]);
  pv_step<DV>(pb, sV, O, fr, fq);
}
template <int DV, bool SOFTMAX, int TPS, class TileFn, class ScoreFn>
DI void attn_loop(int ntiles, TileFn&& tile, ScoreFn&& score, const bf16x8 (&qf)[2], f32x4 (&O)[DV / 16], float& m, float& lsum,
                  bf16_t* smem, int tid) {
  const int lane = tid & 63, fr = lane & 15, fq = lane >> 4;
  constexpr int TILE_EL = (64 + DV) * LDT, STAGE_EL = TPS * TILE_EL;
  u32x4 rkA[TPS][2], rvA[TPS][DV / 32], rkB[TPS][2], rvB[TPS][DV / 32];
  const int sr = tid >> 3, sc = (tid & 7) * 8;
  const int ksoff = ((sr >> 4) * 2 + ((tid & 7) >> 2)) * 1024 + swz_off(sr & 15, tid & 3);
  auto gload = [&](int step, u32x4 (&rk)[TPS][2], u32x4 (&rv)[TPS][DV / 32]) __attribute__((always_inline)) {
#pragma unroll
    for (int u = 0; u < TPS; ++u) {
      const bf16_t* Kg; const bf16_t* Vg; int ldk, ldv;
      tile(step * TPS + u, Kg, ldk, Vg, ldv);
#pragma unroll
      for (int i = 0; i < 2; ++i) rk[u][i] = *(const u32x4*)(Kg + (size_t)(sr + i * 32) * ldk + sc);
#pragma unroll
      for (int i = 0; i < DV / 32; ++i) rv[u][i] = *(const u32x4*)(Vg + (size_t)(sr + i * 32) * ldv + sc);
    }
  };
  auto sstore = [&](int buf, const u32x4 (&rk)[TPS][2], const u32x4 (&rv)[TPS][DV / 32]) __attribute__((always_inline)) {
#pragma unroll
    for (int u = 0; u < TPS; ++u) {
      bf16_t* sK = smem + buf * STAGE_EL + u * TILE_EL;
      bf16_t* sV = sK + 64 * LDT;
#pragma unroll
      for (int i = 0; i < 2; ++i) *(u32x4*)((char*)sK + ksoff + i * 4096) = rk[u][i];
#pragma unroll
      for (int i = 0; i < DV / 32; ++i) *(u32x4*)(sV + (sr + i * 32) * LDT + sc) = rv[u][i];
    }
  };
  auto compute = [&](int buf, int step) __attribute__((always_inline)) {
#pragma unroll
    for (int u = 0; u < TPS; ++u) {
      const bf16_t* sK = smem + buf * STAGE_EL + u * TILE_EL;
      const bf16_t* sV = sK + 64 * LDT;
      f32x4 S[4];
      qk_scores(qf, sK, S, fr, fq);
      score(step * TPS + u, S);
      if (SOFTMAX) {
        softmax_pv<DV>(S, sV, O, m, lsum, fr, fq);
      } else {
        bf16x8 pb[2];
        pb[0] = pack8(S[0], S[1]);
        pb[1] = pack8(S[2], S[3]);
        pv_step<DV>(pb, sV, O, fr, fq);
      }
    }
  };
  const int nsteps = ntiles / TPS, last = nsteps - 1;
  if (TPS > 1) {
    gload(0, rkA, rvA);
    sstore(0, rkA, rvA);
    __syncthreads();
    for (int j = 0; j < nsteps; ++j) {
      gload(j + 1 < last ? j + 1 : last, rkA, rvA);
      asm volatile("" ::: "memory");
      compute(j & 1, j);
      __builtin_amdgcn_sched_barrier(0);
      sstore((j + 1) & 1, rkA, rvA);
      __syncthreads();
    }
    return;
  }
  gload(0, rkA, rvA);
  gload(last < 1 ? last : 1, rkB, rvB);
  sstore(0, rkA, rvA);
  __syncthreads();
  for (int j = 0; j < nsteps; j += 2) {
    gload(j + 2 < last ? j + 2 : last, rkA, rvA);
    asm volatile("" ::: "memory");
    compute(0, j);
    __builtin_amdgcn_sched_barrier(0);
    sstore(1, rkB, rvB);
    __syncthreads();
    if (j + 1 >= nsteps) break;
    gload(j + 3 < last ? j + 3 : last, rkB, rvB);
    asm volatile("" ::: "memory");
    compute(1, j + 1);
    __builtin_amdgcn_sched_barrier(0);
    sstore(0, rkA, rvA);
    __syncthreads();
  }
}
DI void scale_scores(f32x4 (&S)[4]) {
#pragma unroll
  for (int s = 0; s < 4; ++s) { S[s][0] *= 0.18033688f; S[s][1] *= 0.18033688f; S[s][2] *= 0.18033688f; S[s][3] *= 0.18033688f; }
}

DI void softmax_only(f32x4 (&S)[4], f32x4 (&O)[8], float& m, float& lsum, bf16x8 (&pb)[2]) {
  float tm = -1e30f;
#pragma unroll
  for (int s = 0; s < 4; ++s)
#pragma unroll
    for (int i = 0; i < 4; ++i) tm = fmaxf(tm, S[s][i]);
  tm = xmax32(xmax16(tm));
  const float mn = fmaxf(m, tm);
  const float alpha = __builtin_amdgcn_exp2f(m - mn);
  const bool grew = mn != m;
  m = mn;
  float ps = 0.f;
#pragma unroll
  for (int s = 0; s < 4; ++s)
#pragma unroll
    for (int i = 0; i < 4; ++i) {
      float pv = __builtin_amdgcn_exp2f(S[s][i] - mn);
      S[s][i] = pv;
      ps += pv;
    }
  lsum = lsum * alpha + ps;
  if (__any(grew)) {
#pragma unroll
    for (int dt = 0; dt < 8; ++dt) { O[dt][0] *= alpha; O[dt][1] *= alpha; O[dt][2] *= alpha; O[dt][3] *= alpha; }
  }
  pb[0] = pack8(S[0], S[1]);
  pb[1] = pack8(S[2], S[3]);
}
template <class TileFn>
DI void diff_loop(int ntiles, TileFn&& tile, const bf16x8 (&q1)[2], const bf16x8 (&q2)[2], f32x4 (&O1)[8], f32x4 (&O2)[8],
                  float& m1, float& l1, float& m2, float& l2, bf16_t* smem, int tid) {
  const int lane = tid & 63, fr = lane & 15, fq = lane >> 4;
  constexpr int STAGE_EL = 256 * LDT;
  u32x4 rk1[2], rk2[2], rv[4];
  const int sr = tid >> 3, sc = (tid & 7) * 8;
  const int ksoff = ((sr >> 4) * 2 + ((tid & 7) >> 2)) * 1024 + swz_off(sr & 15, tid & 3);
  auto gload = [&](int j) __attribute__((always_inline)) {
    const bf16_t* K1g; const bf16_t* K2g; const bf16_t* Vg; int ldk, ldv;
    tile(j, K1g, K2g, ldk, Vg, ldv);
#pragma unroll
    for (int i = 0; i < 2; ++i) {
      rk1[i] = *(const u32x4*)(K1g + (size_t)(sr + i * 32) * ldk + sc);
      rk2[i] = *(const u32x4*)(K2g + (size_t)(sr + i * 32) * ldk + sc);
    }
#pragma unroll
    for (int i = 0; i < 4; ++i) rv[i] = *(const u32x4*)(Vg + (size_t)(sr + i * 32) * ldv + sc);
  };
  auto sstore = [&](int buf) __attribute__((always_inline)) {
    bf16_t* sb = smem + buf * STAGE_EL;
#pragma unroll
    for (int i = 0; i < 2; ++i) {
      *(u32x4*)((char*)sb + ksoff + i * 4096) = rk1[i];
      *(u32x4*)((char*)(sb + 64 * LDT) + ksoff + i * 4096) = rk2[i];
    }
#pragma unroll
    for (int i = 0; i < 4; ++i) *(u32x4*)(sb + (128 + sr + i * 32) * LDT + sc) = rv[i];
  };
  const int last = ntiles - 1;
  gload(0);
  sstore(0);
  __syncthreads();
  for (int j = 0; j < ntiles; ++j) {
    gload(j + 1 < last ? j + 1 : last);
    asm volatile("" ::: "memory");
    {
      const bf16_t* sb = smem + (j & 1) * STAGE_EL;
      const bf16_t* sV = sb + 128 * LDT;
      f32x4 S1[4], S2[4];
      qk_scores(q1, sb, S1, fr, fq);
      qk_scores(q2, sb + 64 * LDT, S2, fr, fq);
      scale_scores(S1);
      scale_scores(S2);
      bf16x8 pb1[2], pb2[2];
      softmax_only(S1, O1, m1, l1, pb1);
      softmax_only(S2, O2, m2, l2, pb2);
      __builtin_amdgcn_s_setprio(1);
#pragma unroll
      for (int dt = 0; dt < 8; ++dt) {
#pragma unroll
        for (int s2 = 0; s2 < 2; ++s2) {
          const bf16_t* base = sV + (dt * 16 + fr) * LDT + 32 * s2 + 4 * fq;
          bf16x4 lo = *(const bf16x4*)base;
          bf16x4 hi = *(const bf16x4*)(base + 16);
          bf16x8 a = __builtin_shufflevector(lo, hi, 0, 1, 2, 3, 4, 5, 6, 7);
          O1[dt] = MFMA16(a, pb1[s2], O1[dt]);
          O2[dt] = MFMA16(a, pb2[s2], O2[dt]);
        }
      }
      __builtin_amdgcn_s_setprio(0);
    }
    __builtin_amdgcn_sched_barrier(0);
    sstore((j + 1) & 1);
    __syncthreads();
  }
}


DI void dense_item(const P& p, int b, int h, int qb, char* smem) {
  const int tid = otid(), lane = tid & 63, wid = tid >> 6, fr = lane & 15, fq = lane >> 4;
  const bf16_t* Z = (const bf16_t*)(p.ws + WS_Z);
  const bf16_t* VT = (const bf16_t*)(p.ws + WS_VTNA) + (size_t)(b * 512 + h * 64) * 256;
  bf16_t* Y4 = (bf16_t*)(p.ws + WS_Y4);
  const int rowbase = b * 256;
  const int qrow = rowbase + qb * 64 + wid * 16 + fr;
  bf16x8 qf[2];
#pragma unroll
  for (int ks = 0; ks < 2; ++ks) qf[ks] = *(const bf16x8*)(Z + (size_t)qrow * ZLD + ZC_NAQ + h * 64 + ks * 32 + fq * 8);
  f32x4 O[4];
#pragma unroll
  for (int dt = 0; dt < 4; ++dt) O[dt] = f32x4{0.f, 0.f, 0.f, 0.f};
  float m = -1e30f, lsum = 0.f;
  const bf16_t* Kb = Z + (size_t)rowbase * ZLD + ZC_NAK + h * 64;
  attn_loop<64, true, 2>(4,
      [&](int j, const bf16_t*& Kg, int& ldk, const bf16_t*& Vg, int& ldv) __attribute__((always_inline)) { Kg = Kb + (size_t)j * 64 * ZLD; ldk = ZLD; Vg = VT + j * 64; ldv = 256; },
      [&](int, f32x4 (&S)[4]) __attribute__((always_inline)) { scale_scores(S); }, qf, O, m, lsum, (bf16_t*)smem, tid);
  const float lt = xsum32(xsum16(lsum));
  const float inv = 1.f / lt;
#pragma unroll
  for (int dt = 0; dt < 4; ++dt)
    *(bf16x4*)(Y4 + (size_t)qrow * 2048 + h * 64 + dt * 16 + fq * 4) = pack4(O[dt][0] * inv, O[dt][1] * inv, O[dt][2] * inv, O[dt][3] * inv);
}

DI void na_item(const P& p, int l, int b, int h, int r, char* smem) {
  float* srpb = (float*)(smem + 73728);
  const int tid = otid(), lane = tid & 63, wid = tid >> 6, fr = lane & 15, fq = lane >> 4;
  const bf16_t* Z = (const bf16_t*)(p.ws + WS_Z);
  const bf16_t* VT = (const bf16_t*)(p.ws + WS_VTNA) + VT_LAT + (size_t)(b * 512 + h * 64) * 2048;
  const bf16_t* CK = (const bf16_t*)(p.ws + WS_CKNA) + (size_t)(b * 8 + h) * 32768;
  const bf16_t* CVT = (const bf16_t*)(p.ws + WS_CVNA) + (size_t)(b * 8 + h) * 32768;
  bf16_t* Y4 = (bf16_t*)(p.ws + WS_Y4);
  for (int i = tid; i < 465; i += 256) srpb[i] = p.in[19][(size_t)(l * 8 + h) * 465 + i];
  const int rowbase = NCTX + b * 2048;
  const int qcol = wid * 16 + fr;
  const int qrow = rowbase + r * 64 + qcol;
  bf16x8 qf[2];
#pragma unroll
  for (int ks = 0; ks < 2; ++ks) qf[ks] = *(const bf16x8*)(Z + (size_t)qrow * ZLD + ZC_NAQ + h * 64 + ks * 32 + fq * 8);
  f32x4 O[4];
#pragma unroll
  for (int dt = 0; dt < 4; ++dt) O[dt] = f32x4{0.f, 0.f, 0.f, 0.f};
  float m = -1e30f, lsum = 0.f;
  int rs = r - 4;
  rs = rs < 0 ? 0 : (rs > 24 ? 24 : rs);
  int cstart = qcol - 8;
  cstart = cstart < 0 ? 0 : (cstart > 48 ? 48 : cstart);
  const bf16_t* Kb = Z + (size_t)rowbase * ZLD + ZC_NAK + h * 64;
  attn_loop<64, true, 2>(16,
      [&](int j, const bf16_t*& Kg, int& ldk, const bf16_t*& Vg, int& ldv) __attribute__((always_inline)) {
        if (j < 8) { Kg = Kb + (size_t)(rs + j) * 64 * ZLD; ldk = ZLD; Vg = VT + (rs + j) * 64; ldv = 2048; }
        else { Kg = CK + (size_t)(j - 8) * 64 * 64; ldk = 64; Vg = CVT + (j - 8) * 64; ldv = 512; }
      },
      [&](int j, f32x4 (&S)[4]) __attribute__((always_inline)) {
        if (j < 8) {
          const int dr = rs + j - r + 7;
#pragma unroll
          for (int s = 0; s < 4; ++s)
#pragma unroll
            for (int i = 0; i < 4; ++i) {
              int kcol = s * 16 + fq * 4 + i;
              bool ok = (kcol >= cstart) && (kcol < cstart + 16);
              int dc = kcol - qcol + 15;
              dc = dc < 0 ? 0 : (dc > 30 ? 30 : dc);
              float bias = srpb[dr * 31 + dc];
              S[s][i] = ok ? (S[s][i] * 0.18033688f + bias * 1.44269504f) : -1e30f;
            }
        } else {
          scale_scores(S);
        }
      },
      qf, O, m, lsum, (bf16_t*)smem, tid);
  const float lt = xsum32(xsum16(lsum));
  const float inv = 1.f / lt;
#pragma unroll
  for (int dt = 0; dt < 4; ++dt)
    *(bf16x4*)(Y4 + (size_t)qrow * 2048 + h * 64 + dt * 16 + fq * 4) = pack4(O[dt][0] * inv, O[dt][1] * inv, O[dt][2] * inv, O[dt][3] * inv);
}

DI void diff_item(const P& p, int l, bool latent, int b, int h, int qb, char* smem) {
  const int tid = otid(), lane = tid & 63, wid = tid >> 6, fr = lane & 15, fq = lane >> 4;
  const bf16_t* Z = (const bf16_t*)(p.ws + WS_Z);
  const int T = latent ? 2048 : 256;
  const int rowbase = latent ? NCTX + b * 2048 : b * 256;
  const bf16_t* VT = (const bf16_t*)(p.ws + WS_VTDF) + (latent ? (size_t)VT_LAT + (size_t)(b * 512 + h * 128) * 2048 : (size_t)(b * 512 + h * 128) * 256);
  const bf16_t* CVT = (const bf16_t*)(p.ws + WS_CVDF) + (size_t)(b * 4 + h) * 65536;
  bf16_t* Y4 = (bf16_t*)(p.ws + WS_Y4);
  const int qrow = rowbase + qb * 64 + wid * 16 + fr;
  float d1 = p.in[20][l * 64 + lane] * p.in[21][l * 64 + lane];
  float d2 = p.in[22][l * 64 + lane] * p.in[23][l * 64 + lane];
  d1 = wave_sum(d1);
  d2 = wave_sum(d2);
  const float lam_init = 0.8f - 0.6f * expf(-0.3f * (float)l);
  const float lam = expf(d1) - expf(d2) + lam_init;
  const int nown = T >> 6;
  const int ntiles = nown + (latent ? 8 : 0);

  f32x4 O1[8];
  f32x4 O[8];
  {
    bf16x8 q1[2], q2[2];
#pragma unroll
    for (int ks = 0; ks < 2; ++ks) {
      q1[ks] = *(const bf16x8*)(Z + (size_t)qrow * ZLD + ZC_DFQ + h * 64 + ks * 32 + fq * 8);
      q2[ks] = *(const bf16x8*)(Z + (size_t)qrow * ZLD + ZC_DFQ + 256 + h * 64 + ks * 32 + fq * 8);
    }
#pragma unroll
    for (int dt = 0; dt < 8; ++dt) { O1[dt] = f32x4{0.f, 0.f, 0.f, 0.f}; O[dt] = f32x4{0.f, 0.f, 0.f, 0.f}; }
    float m1 = -1e30f, l1 = 0.f, m2 = -1e30f, l2 = 0.f;
    const bf16_t* Kb = Z + (size_t)rowbase * ZLD + ZC_DFK + h * 64;
    const bf16_t* CK = (const bf16_t*)(p.ws + WS_CKDF) + (size_t)((b * 2) * 4 + h) * 32768;
    diff_loop(ntiles,
        [&](int j, const bf16_t*& K1g, const bf16_t*& K2g, int& ldk, const bf16_t*& Vg, int& ldv) __attribute__((always_inline)) {
          if (j < nown) { K1g = Kb + (size_t)j * 64 * ZLD; K2g = K1g + 256; ldk = ZLD; Vg = VT + j * 64; ldv = T; }
          else { K1g = CK + (size_t)(j - nown) * 64 * 64; K2g = K1g + 4 * 32768; ldk = 64; Vg = CVT + (j - nown) * 64; ldv = 512; }
        },
        q1, q2, O1, O, m1, l1, m2, l2, (bf16_t*)smem, tid);
    const float inv1 = 1.f / xsum32(xsum16(l1));
    const float inv2 = lam / xsum32(xsum16(l2));
#pragma unroll
    for (int dt = 0; dt < 8; ++dt) {
      O[dt][0] = O1[dt][0] * inv1 - O[dt][0] * inv2;
      O[dt][1] = O1[dt][1] * inv1 - O[dt][1] * inv2;
      O[dt][2] = O1[dt][2] * inv1 - O[dt][2] * inv2;
      O[dt][3] = O1[dt][3] * inv1 - O[dt][3] * inv2;
    }
  }
  float ss = 0.f;
#pragma unroll
  for (int dt = 0; dt < 8; ++dt) ss += O[dt][0] * O[dt][0] + O[dt][1] * O[dt][1] + O[dt][2] * O[dt][2] + O[dt][3] * O[dt][3];
  ss = xsum32(xsum16(ss));
  const float rsn = rsqrtf(ss * (1.f / 128.f) + 1e-6f) * (1.f - lam_init);
  const float* gn = p.in[24] + l * 128;
#pragma unroll
  for (int dt = 0; dt < 8; ++dt) {
    int dv = dt * 16 + fq * 4;
    float4 g = *(const float4*)(gn + dv);
    *(bf16x4*)(Y4 + (size_t)qrow * 2048 + 512 + h * 128 + dv) = pack4(O[dt][0] * rsn * g.x, O[dt][1] * rsn * g.y, O[dt][2] * rsn * g.z, O[dt][3] * rsn * g.w);
  }
}

DI void ret_item(const P& p, int l, bool latent, int b, int h, int qb, char* smem) {
  bf16_t* sV0 = (bf16_t*)smem + 64 * LDT;
  const int tid = otid(), lane = tid & 63, wid = tid >> 6, fr = lane & 15, fq = lane >> 4;
  const bf16_t* Z = (const bf16_t*)(p.ws + WS_Z);
  const int T = latent ? 2048 : 256;
  const int rowbase = latent ? NCTX + b * 2048 : b * 256;
  const bf16_t* VT = (const bf16_t*)(p.ws + WS_VTRT) + (latent ? (size_t)VT_LAT + (size_t)(b * 512 + h * 64) * 2048 : (size_t)(b * 512 + h * 64) * 256);
  bf16_t* Y4 = (bf16_t*)(p.ws + WS_Y4);
  const int tq = qb * 64 + wid * 16 + fr;
  const int qrow = rowbase + tq;
  const float lgf = log1pf(-expf(p.in[25][l * 8 + h]));
  const float lgb = log1pf(-expf(p.in[26][l * 8 + h]));
  bf16x8 qf[2];
#pragma unroll
  for (int ks = 0; ks < 2; ++ks) qf[ks] = *(const bf16x8*)(Z + (size_t)qrow * ZLD + ZC_RTQ + h * 64 + ks * 32 + fq * 8);
  f32x4 O[4];
#pragma unroll
  for (int dt = 0; dt < 4; ++dt) O[dt] = f32x4{0.f, 0.f, 0.f, 0.f};
  float mdummy = 0.f, ldummy = 0.f;
  const int dq = wid * 16 + fr;
  float AF[4], BF[4], AB[4], BB[4];
#pragma unroll
  for (int u = 0; u < 4; ++u) {
    AF[u] = __expf(-lgf * (float)(u * 16));
    AB[u] = __expf(lgb * (float)(u * 16));
    BF[u] = __expf(-lgf * (float)(fq * 4 + u));
    BB[u] = __expf(lgb * (float)(fq * 4 + u));
  }
  const bf16_t* Kb = Z + (size_t)rowbase * ZLD + ZC_RTK + h * 64;
  attn_loop<64, false, 2>(T >> 6,
      [&](int j, const bf16_t*& Kg, int& ldk, const bf16_t*& Vg, int& ldv) __attribute__((always_inline)) { Kg = Kb + (size_t)j * 64 * ZLD; ldk = ZLD; Vg = VT + j * 64; ldv = T; },
      [&](int j, f32x4 (&S)[4]) __attribute__((always_inline)) {
        if (j == qb) {
#pragma unroll
          for (int s = 0; s < 4; ++s)
#pragma unroll
            for (int i = 0; i < 4; ++i) {
              int tk = j * 64 + s * 16 + fq * 4 + i;
              int dd = tq - tk;
              float w = dd >= 0 ? __expf(lgf * (float)dd) : __expf(lgb * (float)(-dd));
              S[s][i] *= w;
            }
        } else if (j < qb) {
          const float qfac = __expf(lgf * (float)((qb - j) * 64 + dq));
#pragma unroll
          for (int s = 0; s < 4; ++s) {
            const float f = qfac * AF[s];
            S[s][0] *= f * BF[0]; S[s][1] *= f * BF[1]; S[s][2] *= f * BF[2]; S[s][3] *= f * BF[3];
          }
        } else {
          const float qfac = __expf(lgb * (float)((j - qb) * 64 - dq));
#pragma unroll
          for (int s = 0; s < 4; ++s) {
            const float f = qfac * AB[s];
            S[s][0] *= f * BB[0]; S[s][1] *= f * BB[1]; S[s][2] *= f * BB[2]; S[s][3] *= f * BB[3];
          }
        }
      },
      qf, O, mdummy, ldummy, (bf16_t*)smem, tid);
  if (latent) {
    for (int dir = 0; dir < 2; ++dir) {
      const float* S0 = (dir == 0 ? p.in[6] : p.in[7]) + ((size_t)((b * 4 + l) * 8 + h)) * 4096;
#pragma unroll
      for (int i = 0; i < 4; ++i) {
        int e = (tid + i * 256) * 4;
        float4 v = *(const float4*)(S0 + e);
        int dk = e >> 6, dv = e & 63;
        sV0[(dv + 0) * LDT + dk] = f2bf(v.x);
        sV0[(dv + 1) * LDT + dk] = f2bf(v.y);
        sV0[(dv + 2) * LDT + dk] = f2bf(v.z);
        sV0[(dv + 3) * LDT + dk] = f2bf(v.w);
      }
      __syncthreads();
      const float sc = dir == 0 ? __expf(lgf * (float)(tq + 1)) : __expf(lgb * (float)(T - tq));
      bf16x8 pb[2];
#pragma unroll
      for (int s2 = 0; s2 < 2; ++s2) {
        const bf16_t* qp = Z + (size_t)qrow * ZLD + ZC_RTQ + h * 64 + 32 * s2 + 4 * fq;
        bf16x4 lo = *(const bf16x4*)qp;
        bf16x4 hi = *(const bf16x4*)(qp + 16);
        f32x4 flo = {bfs2f(lo[0]) * sc, bfs2f(lo[1]) * sc, bfs2f(lo[2]) * sc, bfs2f(lo[3]) * sc};
        f32x4 fhi = {bfs2f(hi[0]) * sc, bfs2f(hi[1]) * sc, bfs2f(hi[2]) * sc, bfs2f(hi[3]) * sc};
        pb[s2] = pack8(flo, fhi);
      }
      pv_step<64>(pb, sV0, O, fr, fq);
      __syncthreads();
    }
  }
  float ss = 0.f;
#pragma unroll
  for (int dt = 0; dt < 4; ++dt) ss += O[dt][0] * O[dt][0] + O[dt][1] * O[dt][1] + O[dt][2] * O[dt][2] + O[dt][3] * O[dt][3];
  ss = xsum32(xsum16(ss));
  const float rsn = rsqrtf(ss * (1.f / 64.f) + 1e-6f);
  const float* gn = p.in[27] + l * 512 + h * 64;
#pragma unroll
  for (int dt = 0; dt < 4; ++dt) {
    int dv = dt * 16 + fq * 4;
    float4 g = *(const float4*)(gn + dv);
    bf16x4 sg = *(const bf16x4*)(Z + (size_t)qrow * ZLD + ZC_RTG + h * 64 + dv);
    *(bf16x4*)(Y4 + (size_t)qrow * 2048 + 1024 + h * 64 + dv) =
        pack4(O[dt][0] * rsn * g.x * bfs2f(sg[0]), O[dt][1] * rsn * g.y * bfs2f(sg[1]), O[dt][2] * rsn * g.z * bfs2f(sg[2]), O[dt][3] * rsn * g.w * bfs2f(sg[3]));
  }
}

DI void ret_state_item(const P& p, int l, int b, int h) {
  const int tid_ = otid(), lane = tid_ & 63, wid = tid_ >> 6, fr = lane & 15, fq = lane >> 4;
  const bf16_t* KT = (const bf16_t*)(p.ws + WS_KTRT) + (size_t)(b * 512 + h * 64) * 256;
  const bf16_t* VT = (const bf16_t*)(p.ws + WS_VTRT) + (size_t)(b * 512 + h * 64) * 256;
  const float lgf = log1pf(-expf(p.in[25][l * 8 + h]));
  const float lgb = log1pf(-expf(p.in[26][l * 8 + h]));
  f32x4 af[4], ab[4];
#pragma unroll
  for (int nt = 0; nt < 4; ++nt) { af[nt] = f32x4{0.f, 0.f, 0.f, 0.f}; ab[nt] = f32x4{0.f, 0.f, 0.f, 0.f}; }
  for (int ks = 0; ks < 8; ++ks) {
    const int t0 = ks * 32 + fq * 8;
    bf16x8 kraw = *(const bf16x8*)(KT + (size_t)(wid * 16 + fr) * 256 + t0);
    bf16x8 kf, kb;
#pragma unroll
    for (int j = 0; j < 8; ++j) {
      float kv = bfs2f(kraw[j]);
      int t = t0 + j;
      kf[j] = (short)f2bf(kv * __expf(lgf * (float)(255 - t)));
      kb[j] = (short)f2bf(kv * __expf(lgb * (float)t));
    }
#pragma unroll
    for (int nt = 0; nt < 4; ++nt) {
      bf16x8 vb = *(const bf16x8*)(VT + (size_t)(nt * 16 + fr) * 256 + t0);
      af[nt] = MFMA16(kf, vb, af[nt]);
      ab[nt] = MFMA16(kb, vb, ab[nt]);
    }
  }
  float* of = p.out + O_RF + ((size_t)((b * 4 + l) * 8 + h)) * 4096;
  float* ob = p.out + O_RB + ((size_t)((b * 4 + l) * 8 + h)) * 4096;
#pragma unroll
  for (int nt = 0; nt < 4; ++nt)
#pragma unroll
    for (int i = 0; i < 4; ++i) {
      int dk = wid * 16 + fq * 4 + i, dv = nt * 16 + fr;
      of[dk * 64 + dv] = af[nt][i];
      ob[dk * 64 + dv] = ab[nt][i];
    }
}

DI void lru_gates_item(const P& p, int l, int chunk, int n, char* smem) {
  float* XDf = (float*)smem;
  bf16_t* XDb = (bf16_t*)(XDf + 4096);
  const int tid = otid(), lane = tid & 63, wid = tid >> 6, fr = lane & 15, fq = lane >> 4;
  const int row0 = chunk * 64;
  const bool latent = row0 >= NCTX;
  const int T = latent ? 2048 : 256;
  const int tseq0 = latent ? ((row0 - NCTX) & 2047) : (row0 & 255);
  const bf16_t* Z = (const bf16_t*)(p.ws + WS_Z);
  const bf16_t* WL = (const bf16_t*)(p.ws + WS_WLRU);
  bf16_t* LA = (bf16_t*)(p.ws + WS_LA);
  bf16_t* LU = (bf16_t*)(p.ws + WS_LU);
  const int ch0 = n * 64;
  {
    const float cw0 = p.in[28][(l * 4 + 0) * 512 + ch0 + lane];
    const float cw1 = p.in[28][(l * 4 + 1) * 512 + ch0 + lane];
    const float cw2 = p.in[28][(l * 4 + 2) * 512 + ch0 + lane];
    const float cw3 = p.in[28][(l * 4 + 3) * 512 + ch0 + lane];
    const float cb = p.in[29][l * 512 + ch0 + lane];
    const bf16_t* xcol = Z + (size_t)row0 * ZLD + ZC_LRX + ch0 + lane;
    const int t0 = wid * 16;
    auto ld = [&](int tl) -> float {
      int ts = tseq0 + tl;
      return (ts < 0 || ts >= T) ? 0.f : bf2f(xcol[(ptrdiff_t)tl * ZLD]);
    };
    float xm1 = ld(t0 - 1), x0 = ld(t0), x1 = ld(t0 + 1);
#pragma unroll
    for (int i = 0; i < 16; ++i) {
      float x2 = ld(t0 + i + 2);
      float xd = cw0 * xm1 + cw1 * x0 + cw2 * x1 + cw3 * x2 + cb;
      XDf[(t0 + i) * 64 + lane] = xd;
      XDb[(t0 + i) * LDT + lane] = f2bf(xd);
      xm1 = x0; x0 = x1; x1 = x2;
    }
  }
  __syncthreads();
  bf16x8 af[2];
#pragma unroll
  for (int ks = 0; ks < 2; ++ks) af[ks] = *(const bf16x8*)(XDb + (wid * 16 + fr) * LDT + ks * 32 + fq * 8);
#pragma unroll 1
  for (int dir = 0; dir < 2; ++dir) {
    const float* bav = (dir == 0 ? p.in[31] : p.in[36]) + l * 512 + ch0;
    const float* bxv = (dir == 0 ? p.in[33] : p.in[38]) + l * 512 + ch0;
    const float* lamv = (dir == 0 ? p.in[34] : p.in[39]) + l * 512 + ch0;
#pragma unroll
    for (int et = 0; et < 4; ++et) {
      f32x4 da = {0.f, 0.f, 0.f, 0.f}, dx = {0.f, 0.f, 0.f, 0.f};
#pragma unroll
      for (int ks = 0; ks < 2; ++ks) {
        bf16x8 wa = *(const bf16x8*)(WL + (size_t)((dir * 2 + 0) * 8 + n) * 4096 + (et * 16 + fr) * 64 + ks * 32 + fq * 8);
        bf16x8 wx = *(const bf16x8*)(WL + (size_t)((dir * 2 + 1) * 8 + n) * 4096 + (et * 16 + fr) * 64 + ks * 32 + fq * 8);
        da = MFMA16(af[ks], wa, da);
        dx = MFMA16(af[ks], wx, dx);
      }
      const int e = et * 16 + fr;
      const float ba_ = bav[e], bx_ = bxv[e];
      const float sp = log1pf(expf(-lamv[e]));
      float lav[4], uv[4];
#pragma unroll
      for (int i = 0; i < 4; ++i) {
        int tl = wid * 16 + fq * 4 + i;
        float rg = sigmoidf_(da[i] + ba_);
        float ig = sigmoidf_(dx[i] + bx_);
        float la = -8.f * rg * sp;
        lav[i] = la;
        uv[i] = sqrtf(1.f - __expf(2.f * la)) * (ig * XDf[tl * 64 + e]);
      }
      const size_t idx = (size_t)dir * 8388608 + ((size_t)chunk * 512 + ch0 + e) * 64 + wid * 16 + fq * 4;
      *(bf16x4*)(LA + idx) = pack4(lav[0], lav[1], lav[2], lav[3]);
      *(bf16x4*)(LU + idx) = pack4(uv[0], uv[1], uv[2], uv[3]);
    }
  }
  __syncthreads();
}

DI void lru_scan_witem(const P& p, int l, int bglob, int g, int lane) {
  const bool latent = bglob >= 32;
  const int T = latent ? 2048 : 256;
  const int rowbase = latent ? NCTX + (bglob - 32) * 2048 : bglob * 256;
  const int chunk0 = rowbase >> 6, nch = T >> 6;
  const int ch = g * 64 + lane;
  const bf16_t* LA = (const bf16_t*)(p.ws + WS_LA);
  const bf16_t* LU = (const bf16_t*)(p.ws + WS_LU);
  bf16_t* HF = (bf16_t*)(p.ws + WS_HF);
  const bf16_t* LG = (const bf16_t*)(p.ws + WS_LG);
  bf16_t* Y4 = (bf16_t*)(p.ws + WS_Y4);
  {
    float h = latent ? p.in[8][((bglob - 32) * 4 + l) * 512 + ch] : 0.f;
    bf16x8 ca[8], cu[8], na[8], nu[8];
    {
      const size_t b0 = ((size_t)chunk0 * 512 + ch) * 64;
#pragma unroll
      for (int q = 0; q < 8; ++q) { ca[q] = *(const bf16x8*)(LA + b0 + q * 8); cu[q] = *(const bf16x8*)(LU + b0 + q * 8); }
    }
    for (int cc = 0; cc < nch; ++cc) {
      const size_t cbase = ((size_t)(chunk0 + cc) * 512 + ch) * 64;
      const int cn = (cc + 1 < nch) ? cc + 1 : cc;
      const size_t nb = ((size_t)(chunk0 + cn) * 512 + ch) * 64;
#pragma unroll
      for (int q = 0; q < 8; ++q) { na[q] = *(const bf16x8*)(LA + nb + q * 8); nu[q] = *(const bf16x8*)(LU + nb + q * 8); }
#pragma unroll
      for (int q = 0; q < 8; ++q) {
        bf16x8 ho;
#pragma unroll
        for (int j = 0; j < 8; ++j) {
          float a = __expf(bfs2f(ca[q][j]));
          h = a * h + bfs2f(cu[q][j]);
          ho[j] = (short)f2bf(h);
        }
        *(bf16x8*)(HF + cbase + q * 8) = ho;
      }
#pragma unroll
      for (int q = 0; q < 8; ++q) { ca[q] = na[q]; cu[q] = nu[q]; }
    }
    if (!latent) p.out[O_LF + (size_t)(bglob * 4 + l) * 512 + ch] = h;
  }
  {
    float h = latent ? p.in[9][((bglob - 32) * 4 + l) * 512 + ch] : 0.f;
    const bf16_t* LAb = LA + 8388608;
    const bf16_t* LUb = LU + 8388608;
    bf16x8 ca[4], cu[4], chf[4], cg_[4], na[4], nu[4], nhf[4], ng[4];
    const int nb_ = 2 * nch;
    {
      const size_t b0 = ((size_t)(chunk0 + nch - 1) * 512 + ch) * 64 + 32;
#pragma unroll
      for (int q = 0; q < 4; ++q) {
        ca[q] = *(const bf16x8*)(LAb + b0 + q * 8); cu[q] = *(const bf16x8*)(LUb + b0 + q * 8);
        chf[q] = *(const bf16x8*)(HF + b0 + q * 8); cg_[q] = *(const bf16x8*)(LG + b0 + q * 8);
      }
    }
    for (int bi = 0; bi < nb_; ++bi) {
      const int chunk = nch - 1 - (bi >> 1), half = 1 - (bi & 1);
      const int bn = (bi + 1 < nb_) ? bi + 1 : bi;
      const int chunkn = nch - 1 - (bn >> 1), halfn = 1 - (bn & 1);
      const size_t nb = ((size_t)(chunk0 + chunkn) * 512 + ch) * 64 + halfn * 32;
#pragma unroll
      for (int q = 0; q < 4; ++q) {
        na[q] = *(const bf16x8*)(LAb + nb + q * 8); nu[q] = *(const bf16x8*)(LUb + nb + q * 8);
        nhf[q] = *(const bf16x8*)(HF + nb + q * 8); ng[q] = *(const bf16x8*)(LG + nb + q * 8);
      }
      bf16_t* yrow = Y4 + (size_t)(rowbase + chunk * 64 + half * 32) * 2048 + 1536 + ch;
#pragma unroll
      for (int q = 3; q >= 0; --q) {
#pragma unroll
        for (int j = 7; j >= 0; --j) {
          float a = __expf(bfs2f(ca[q][j]));
          h = a * h + bfs2f(cu[q][j]);
          float y = (bfs2f(chf[q][j]) + h) * bfs2f(cg_[q][j]);
          yrow[(size_t)(q * 8 + j) * 2048] = f2bf(y);
        }
      }
#pragma unroll
      for (int q = 0; q < 4; ++q) { ca[q] = na[q]; cu[q] = nu[q]; chf[q] = nhf[q]; cg_[q] = ng[q]; }
    }
    if (!latent) p.out[O_LB + (size_t)(bglob * 4 + l) * 512 + ch] = h;
  }
}

DI int next_item(unsigned* ctr, int* s_item) {
  __syncthreads();
  if (threadIdx.x == 0) *s_item = (int)atomicAdd(ctr, 1u);
  __syncthreads();
  return *s_item;
}
DI void phase_mixa(const P& p, int l, char* smem, int* s_item) {
  unsigned* ctr = (unsigned*)(p.ws + WS_BAR + 14336) + l * 2;
  const int NGRAB = 512 + 512;
  for (;;) {
    int q = next_item(ctr, s_item);
    if (q >= NGRAB) break;
    if (q < 512) { diff_item(p, l, true, q >> 7, (q >> 5) & 3, q & 31, smem); continue; }
    q -= 512;
#pragma unroll 1
    for (int u = 0; u < 4; ++u) { const int g = q * 4 + u; lru_gates_item(p, l, g >> 3, g & 7, smem); }
  }
}
DI void phase_mixb(const P& p, int l, char* smem, int* s_item) {
  unsigned* ctr = (unsigned*)(p.ws + WS_BAR + 14336) + l * 2 + 1;
  const int NGRAB = 72 + 1024 + 1024 + 256 + 256 + 256 + 32;
  for (;;) {
    int q = next_item(ctr, s_item);
    if (q >= NGRAB) break;
    if (q < 72) {
      const int tid = otid(), lane = tid & 63, wid = tid >> 6;
      int bglob, g;
      if (q < 32) {
        if (wid == 0) { bglob = 32 + (q >> 3); g = q & 7; }
        else { int ci = q * 3 + wid - 1; bglob = ci >> 3; g = ci & 7; }
      } else {
        int ci = 96 + (q - 32) * 4 + wid;
        bglob = ci >> 3; g = ci & 7;
      }
      lru_scan_witem(p, l, bglob, g, lane);
      continue;
    }
    q -= 72;
    if (q < 1024) { ret_item(p, l, true, q >> 8, (q >> 5) & 7, q & 31, smem); continue; }
    q -= 1024;
    if (q < 1024) { na_item(p, l, q >> 8, (q >> 5) & 7, q & 31, smem); continue; }
    q -= 1024;
    if (q < 256) {
#pragma unroll 1
      for (int u = 0; u < 2; ++u) { const int g = q * 2 + u; diff_item(p, l, false, g >> 4, (g >> 2) & 3, g & 3, smem); }
      continue;
    }
    q -= 256;
    if (q < 256) {
#pragma unroll 1
      for (int u = 0; u < 4; ++u) { const int g = q * 4 + u; dense_item(p, g >> 5, (g >> 2) & 7, g & 3, smem); }
      continue;
    }
    q -= 256;
    if (q < 256) {
#pragma unroll 1
      for (int u = 0; u < 4; ++u) { const int g = q * 4 + u; ret_item(p, l, false, g >> 5, (g >> 2) & 7, g & 3, smem); }
      continue;
    }
    q -= 256;
#pragma unroll 1
    for (int u = 0; u < 8; ++u) { const int g = q * 8 + u; ret_state_item(p, l, g >> 3, g & 7); }
  }
}

#define XB_TMO 128
#define XB_XCNT(j) (256 + 64 * (j))
#define XB_XSUB(j) (1280 + 64 * (j))
#define XB_XGEN(j) (2304 + 64 * (j))
#define XB_TOP 3328
#define XB_TOPGEN 3392
#define XCD_BAR_WORDS 3456
#define XB_SPIN_CAP (1u << 18)
#define LAS __attribute__((address_space(3)))
DI unsigned xb_ld(unsigned* p) { return __hip_atomic_load(p, __ATOMIC_RELAXED, __HIP_MEMORY_SCOPE_AGENT); }
DI unsigned xb_add(unsigned* p, unsigned v) { return __hip_atomic_fetch_add(p, v, __ATOMIC_RELAXED, __HIP_MEMORY_SCOPE_AGENT); }
DI unsigned xb_xcc_id() { return (unsigned)__builtin_amdgcn_s_getreg((3 << 11) | 20) & 0xFu; }
#define XB_SPIN(cond, bar) do { unsigned _sp = 0; while (cond) { __builtin_amdgcn_s_sleep(1); \
    if ((++_sp & 255u) == 0u) { if (xb_ld(&(bar)[XB_TMO])) break; if (_sp > XB_SPIN_CAP) { atomicAdd(&(bar)[XB_TMO], 1u); break; } } } } while (0)
struct XcdBarrier { unsigned* bar; unsigned x; volatile LAS unsigned* st; };
DI XcdBarrier xcd_barrier_post(unsigned* bar, volatile LAS unsigned* st) {
  XcdBarrier b; b.bar = bar; b.x = xb_xcc_id(); b.st = st;
  if (threadIdx.x == 0) (void)xb_add(&bar[XB_XCNT(b.x)], 1u);
  return b;
}
DI void xcd_barrier_complete(unsigned* bar, unsigned x, unsigned& nloc, unsigned& nx) {
  const unsigned G = gridDim.x * gridDim.y * gridDim.z;
  unsigned sum, cnt, mine, sp = 0u;
  for (;;) {
    sum = 0u; cnt = 0u; mine = 0u;
#pragma unroll
    for (unsigned j = 0; j < 16; ++j) { const unsigned c = xb_ld(&bar[XB_XCNT(j)]); sum += c; cnt += (c > 0u) ? 1u : 0u; mine = (j == x) ? c : mine; }
    if (sum == G) break;
    __builtin_amdgcn_s_sleep(1);
    if ((++sp & 255u) == 0u) { if (xb_ld(&bar[XB_TMO])) break; if (sp > XB_SPIN_CAP) { atomicAdd(&bar[XB_TMO], 1u); break; } }
  }
  nloc = mine > 0u ? mine : 1u; nx = cnt > 0u ? cnt : 1u;
}
DI void xcd_barrier(const XcdBarrier& b) {
  asm volatile("s_waitcnt vmcnt(0)" ::: "memory");
  __syncthreads();
  if (threadIdx.x == 0) {
    unsigned* bar = b.bar;
    __builtin_amdgcn_s_waitcnt(0);
    unsigned nloc = b.st[0], nx = b.st[1];
    if (nloc == 0u) { xcd_barrier_complete(bar, b.x, nloc, nx); b.st[0] = nloc; b.st[1] = nx; }
    const unsigned old = xb_add(&bar[XB_XSUB(b.x)], 1u);
    const unsigned gen = old / nloc;
    if (old + 1u == (gen + 1u) * nloc) {
      __builtin_amdgcn_fence(__ATOMIC_RELEASE, "agent");
      asm volatile("s_waitcnt vmcnt(0)" ::: "memory");
      const unsigned og = xb_add(&bar[XB_TOP], 1u);
      const unsigned tg = og / nx;
      if (og + 1u == (tg + 1u) * nx) xb_add(&bar[XB_TOPGEN], 1u);
      else XB_SPIN(xb_ld(&bar[XB_TOPGEN]) == tg, bar);
      __builtin_amdgcn_fence(__ATOMIC_ACQUIRE, "agent");
      xb_add(&bar[XB_XGEN(b.x)], 1u);
      asm volatile("s_waitcnt vmcnt(0)" ::: "memory");
    } else {
      XB_SPIN(xb_ld(&bar[XB_XGEN(b.x)]) == gen, bar);
      __builtin_amdgcn_fence(__ATOMIC_ACQUIRE, "agent");
      asm volatile("s_waitcnt vmcnt(0)" ::: "memory");
    }
  }
  __syncthreads();
}

enum { PH_INIT = 0, PH_PRE0, PH_GIN, PH_MIXA, PH_MIXB, PH_MERGE, PH_OUT, PH_POSTMIX, PH_FF1, PH_FF2, PH_POSTFFN };

DI void run_phase(const P& p, int ph, int l, char* smem, int* s_item) {
  switch (ph) {
    case PH_INIT:
      phase_mod(p, smem);
      phase_convert(p, 0, smem);
      break;
    case PH_PRE0: phase_row(p, 0, 0); break;
    case PH_GIN: phase_gin(p, l, smem); break;
    case PH_MIXA: phase_mixa(p, l, smem, s_item); break;
    case PH_MIXB: phase_mixb(p, l, smem, s_item); break;
    case PH_MERGE: phase_merge(p, smem); break;
    case PH_OUT:
      phase_gemm_plain<0>((const bf16_t*)(p.ws + WS_H), 1024, (const bf16_t*)(p.ws + WS_WOUT), 1024, (bf16_t*)(p.ws + WS_Y), smem);
      break;
    case PH_POSTMIX: phase_row(p, l, 1); break;
    case PH_FF1:
      phase_gemm_plain<1>((const bf16_t*)(p.ws + WS_H), 1024, (const bf16_t*)(p.ws + WS_W1), 4096, (bf16_t*)(p.ws + WS_U), smem);
      break;
    case PH_FF2:
      phase_gemm_plain<0>((const bf16_t*)(p.ws + WS_U), 4096, (const bf16_t*)(p.ws + WS_W2), 1024, (bf16_t*)(p.ws + WS_Y), smem);
      break;
    case PH_POSTFFN:
      phase_row(p, l, 2);
      if (l < 3) phase_convert(p, l + 1, smem);
      break;
    default: break;
  }
}

DI void decode_step(int step, int& ph, int& l) {
  if (step < 2) { ph = step; l = 0; }
  else { int s = step - 2; l = s / 9; ph = PH_GIN + (s % 9); }
}
constexpr int NSTEPS = 38;

__global__ void __launch_bounds__(256, 2) hybrid_flow_mega(P p) {
  __shared__ __attribute__((aligned(16))) char smem[SMEM_BYTES];
  __shared__ uint4 xb_words;
  __shared__ int s_item;
  cg::grid_group grid = cg::this_grid();
  if (threadIdx.x == 0) xb_words = make_uint4(0u, 0u, 0u, 0u);
  __syncthreads();
  XcdBarrier xb = xcd_barrier_post((unsigned*)(p.ws + WS_BAR), (volatile LAS unsigned*)&xb_words);
  for (int step = 0; step < NSTEPS; ++step) {
    int ph, l;
    decode_step(step, ph, l);
#ifdef PROBE_DUP
    const int reps = (ph == PROBE_DUP) ? 2 : 1;
    for (int rep = 0; rep < reps; ++rep)
#endif
    run_phase(p, ph, l, smem, &s_item);
#ifdef PROBE_CONV
    if (ph == PH_POSTFFN && l < 3) phase_convert(p, l + 1, smem);
#endif
    if (p.ws == nullptr) grid.sync();
    if (step + 1 < NSTEPS) xcd_barrier(xb);
#ifdef PROBE_SYNC
    if (step + 1 < NSTEPS) xcd_barrier(xb);
#endif
  }
}

#if !ONE_LAUNCH
__global__ void __launch_bounds__(256, 2) hybrid_flow_phase(P p, int ph, int l) {
  __shared__ __attribute__((aligned(16))) char smem[SMEM_BYTES];
  __shared__ int s_item;
  run_phase(p, ph, l, smem, &s_item);
}
#endif

extern "C" void kernel_launch(void* const* d_in, const int* in_sizes, int n_in, void* d_out, int out_size, void* d_ws,
                              size_t ws_size, hipStream_t stream) {
  (void)in_sizes; (void)n_in; (void)out_size; (void)ws_size;
  P p{};
  for (int i = 0; i < 44; ++i) p.in[i] = (const float*)d_in[i];
  p.out = (float*)d_out;
  p.ws = (char*)d_ws;
#if ONE_LAUNCH
  static int grid_blocks = 0;
  if (!grid_blocks) {
    int dev = 0, cus = 0, per_cu = 0;
    hipGetDevice(&dev);
    hipDeviceGetAttribute(&cus, hipDeviceAttributeMultiprocessorCount, dev);
    hipOccupancyMaxActiveBlocksPerMultiprocessor(&per_cu, hybrid_flow_mega, 256, 0);
    if (per_cu < 1) per_cu = 1;
    if (per_cu > 2) per_cu = 2;
    grid_blocks = cus * per_cu;
  }
  (void)hipMemsetAsync((char*)d_ws + WS_BAR, 0, 16384, stream);
  void* args[] = {&p};
  hipError_t e = hipLaunchCooperativeKernel((void*)hybrid_flow_mega, dim3(grid_blocks), dim3(256), args, 0, stream);
  if (e != hipSuccess) fprintf(stderr, "cooperative launch failed: %s (grid %d)\n", hipGetErrorString(e), grid_blocks);
#else
  const int grid_blocks = 512;
  for (int step = 0; step < NSTEPS; ++step) {
    int ph, l;
    if (step < 2) { ph = step; l = 0; }
    else { int s = step - 2; l = s / 9; ph = PH_GIN + (s % 9); }
    hipLaunchKernelGGL(hybrid_flow_phase, dim3(grid_blocks), dim3(256), 0, stream, p, ph, l);
  }
#endif
}
```
